# Optimizing an MI355X kernel written in HIP

```python
import math
import jax, jax.numpy as jnp
from jax import lax
import numpy as np

D_MODEL = 1024
BATCH = 2
SEQ = 8192
DEPTH = 2
DEC_BATCH = 128
DEC_SEQ = 8
PAST_LEN = 8192
PAGE_SIZE = 128

HEAD_DIM = 64
ATTN_HEADS = D_MODEL // HEAD_DIM
ATTN_KV_HEADS = ATTN_HEADS // 4
WINDOW = 128
D_RNN = D_MODEL
RNN_BLOCKS = 16
RNN_BLOCK = D_RNN // RNN_BLOCKS
CONV_W = 4
RG_C = 8.0
RWKV_HEADS = D_MODEL // HEAD_DIM
RW_D = RWKV_HEADS * HEAD_DIM
LORA_W = 64
LORA_A = 64
LORA_G = 160
GN_EPS = 64e-5
LN_EPS = 1e-5
_FF_RAW = (8 * D_MODEL + 2) // 3
D_FF = ((_FF_RAW + 255) // 256) * 256
ALPHA = (2 * DEPTH) ** 0.25
BETA = (8 * DEPTH) ** -0.25

Q_W = ATTN_HEADS * HEAD_DIM
KV_W = ATTN_KV_HEADS * HEAD_DIM
OFF_Q = 0
OFF_K = OFF_Q + Q_W
OFF_V = OFF_K + KV_W
OFF_RNN = OFF_V + KV_W
OFF_RW = OFF_RNN + D_RNN
SHIFT_W = 3 * RW_D + LORA_W + LORA_A + LORA_G
OFF_GATE = OFF_RW + SHIFT_W
N_BRANCH = 3
IN_COLS = OFF_GATE + N_BRANCH * D_MODEL

kernel_name = 'hybrid_swa_rglru_rwkv7_step'


def layer_norm(x, g, b):
    xf = x.astype(jnp.float32)
    mu = xf.mean(-1, keepdims=True)
    var = jnp.square(xf - mu).mean(-1, keepdims=True)
    return ((xf - mu) * lax.rsqrt(var + LN_EPS) * g.astype(jnp.float32) + b.astype(jnp.float32)).astype(x.dtype)


def alibi_slopes():
    h = jnp.arange(1, ATTN_HEADS + 1, dtype=jnp.float32)
    return 2.0 ** (-8.0 * h / ATTN_HEADS)


def sink_attend(q, k, v, sinks, rel, valid):
    n, tq, h, d = q.shape
    kvh = k.shape[2]
    g = h // kvh
    qg = q.reshape(n, tq, kvh, g, d)
    s = jnp.einsum('nqcgd,nscd->ncgqs', qg, k).astype(jnp.float32) * (d ** -0.5)
    s = s - alibi_slopes().reshape(kvh, g, 1, 1) * rel
    s = jnp.where(valid, s, -jnp.inf)
    sink = sinks.astype(jnp.float32).reshape(1, kvh, g, 1, 1)
    m = jnp.maximum(s.max(-1, keepdims=True), sink)
    e = jnp.exp(s - m)
    den = e.sum(-1, keepdims=True) + jnp.exp(sink - m)
    p = (e / den).astype(v.dtype)
    o = jnp.einsum('ncgqs,nscd->nqcgd', p, v)
    return o.reshape(n, tq, h * d)


def attn_prompt(q, k, v, sinks):
    b, t, h, d = q.shape
    w = WINDOW
    nb = t // w
    kvh = k.shape[2]
    qb = q.reshape(b * nb, w, h, d)
    kb = k.reshape(b, nb, w, kvh, d)
    vb = v.reshape(b, nb, w, kvh, d)
    kc = jnp.concatenate([jnp.concatenate([jnp.zeros_like(kb[:, :1]), kb[:, :-1]], axis=1), kb], axis=2)
    vc = jnp.concatenate([jnp.concatenate([jnp.zeros_like(vb[:, :1]), vb[:, :-1]], axis=1), vb], axis=2)
    kc = kc.reshape(b * nb, 2 * w, kvh, d)
    vc = vc.reshape(b * nb, 2 * w, kvh, d)
    tpos = w + jnp.arange(w)
    spos = jnp.arange(2 * w)
    rel_i = tpos[:, None] - spos[None, :]
    band = (rel_i >= 0) & (rel_i < WINDOW)
    has_prev = (jnp.arange(nb) > 0)[:, None, None] | (spos >= w)[None, None, :]
    valid = band[None] & has_prev
    valid = jnp.tile(valid, (b, 1, 1)).reshape(b * nb, 1, 1, w, 2 * w)
    o = sink_attend(qb, kc, vc, sinks, rel_i.astype(jnp.float32), valid)
    return o.reshape(b, t, h * d)


def attn_sample(q, k, v, sinks, win_k, win_v):
    t = q.shape[1]
    wb = win_k.shape[1]
    kc = jnp.concatenate([win_k.astype(k.dtype), k], axis=1)
    vc = jnp.concatenate([win_v.astype(v.dtype), v], axis=1)
    rel_i = (wb + jnp.arange(t))[:, None] - jnp.arange(wb + t)[None, :]
    valid = ((rel_i >= 0) & (rel_i < WINDOW))[None, None, None]
    o = sink_attend(q, kc, vc, sinks, rel_i.astype(jnp.float32), valid)
    return o, kc[:, -wb:], vc[:, -wb:]


def causal_conv(x, buf, w, b):
    t = x.shape[1]
    xp = jnp.concatenate([buf.astype(x.dtype), x], axis=1)
    y = b + sum(w[i] * xp[:, i:i + t] for i in range(CONV_W))
    return y, xp[:, -(CONV_W - 1):]


def rglru(x, conv_buf, h0, conv_w, conv_b, wa, ba, wx, bx, lam):
    xc, new_buf = causal_conv(x, conv_buf, conv_w, conv_b)
    n, t, _ = xc.shape
    xb = xc.reshape(n, t, RNN_BLOCKS, RNN_BLOCK)
    r = jax.nn.sigmoid(jnp.einsum('ntbi,bij->ntbj', xb, wa).reshape(n, t, D_RNN) + ba)
    i = jax.nn.sigmoid(jnp.einsum('ntbi,bij->ntbj', xb, wx).reshape(n, t, D_RNN) + bx)
    log_a = -RG_C * r.astype(jnp.float32) * jax.nn.softplus(-lam.astype(jnp.float32))
    a = jnp.exp(log_a)
    u = jnp.sqrt(-jnp.expm1(2.0 * log_a)) * (i * xc).astype(jnp.float32)
    u = u.at[:, 0].add(a[:, 0] * h0.astype(jnp.float32))

    def combine(c1, c2):
        a1, b1 = c1
        a2, b2 = c2
        return a1 * a2, a2 * b1 + b2

    _, h = lax.associative_scan(combine, (a, u), axis=1)
    return h.astype(x.dtype), new_buf, h[:, -1].astype(h0.dtype)


def wkv_scan(r, w, k, v, kk, a, s0):
    xs = tuple(jnp.moveaxis(z.astype(jnp.float32), 1, 0) for z in (r, w, k, v, kk, a))

    def step(s, inp):
        rt, wt, kt, vt, kkt, at = inp
        sa = jnp.einsum('nhvk,nhk->nhv', s, -kkt)
        s = s * wt[:, :, None, :] + sa[..., None] * (kkt * at)[:, :, None, :] + vt[..., None] * kt[:, :, None, :]
        return s, jnp.einsum('nhvk,nhk->nhv', s, rt)

    s_fin, y = lax.scan(step, s0.astype(jnp.float32), xs)
    return jnp.moveaxis(y, 0, 1), s_fin.astype(s0.dtype)


def rwkv_tmix(pc, shift0, s0, p):
    n, t, _ = pc.shape
    prev = jnp.concatenate([shift0[:, None].astype(pc.dtype), pc[:, :-1]], axis=1)
    ps = pc + p['rw_mu'] * (prev - pc)
    new_shift = pc[:, -1]
    o1 = 3 * RW_D
    r = ps[..., :RW_D]
    k = ps[..., RW_D:2 * RW_D]
    v = ps[..., 2 * RW_D:o1]
    lw = ps[..., o1:o1 + LORA_W]
    la = ps[..., o1 + LORA_W:o1 + LORA_W + LORA_A]
    lg = ps[..., o1 + LORA_W + LORA_A:]
    wlog = -jax.nn.softplus(-(p['rw_w0'] + jnp.tanh(lw) @ p['rw_wup'])) - 0.5
    decay = jnp.exp(-jnp.exp(wlog.astype(jnp.float32)))
    a = jax.nn.sigmoid(p['rw_a0'] + la @ p['rw_aup'])
    g = jax.nn.sigmoid(lg) @ p['rw_gup']

    def hs(z):
        return z.reshape(n, t, RWKV_HEADS, HEAD_DIM)

    kk = hs(k * p['rw_kk']).astype(jnp.float32)
    kk = kk / jnp.maximum(jnp.sqrt(jnp.sum(kk * kk, -1, keepdims=True)), 1e-12)
    k = k * (1.0 + (a - 1.0) * p['rw_ka'])
    y, s_new = wkv_scan(hs(r), hs(decay), hs(k), hs(v), kk, hs(a), s0)
    mu = y.mean(-1, keepdims=True)
    var = jnp.square(y - mu).mean(-1, keepdims=True)
    y = ((y - mu) * lax.rsqrt(var + GN_EPS)).reshape(n, t, RW_D)
    y = y * p['rw_lnw'].astype(jnp.float32) + p['rw_lnb'].astype(jnp.float32)
    bonus = (jnp.sum(hs(r).astype(jnp.float32) * hs(k).astype(jnp.float32) * p['rw_rk'].astype(jnp.float32), -1, keepdims=True)
             * hs(v).astype(jnp.float32)).reshape(n, t, RW_D)
    o = ((y + bonus) * g.astype(jnp.float32)).astype(pc.dtype)
    return o, new_shift, s_new


def hybrid_layer(x, win_k, win_v, conv_buf, h0, shift0, s0, win_rows, p):
    n, t, _ = x.shape
    proj = x @ p['w_in']
    q = proj[..., OFF_Q:OFF_K].reshape(n, t, ATTN_HEADS, HEAD_DIM)
    k = proj[..., OFF_K:OFF_V].reshape(n, t, ATTN_KV_HEADS, HEAD_DIM)
    v = proj[..., OFF_V:OFF_RNN].reshape(n, t, ATTN_KV_HEADS, HEAD_DIM)
    if win_k is None:
        o_a = attn_prompt(q, k, v, p['attn_sinks'])
        new_k, new_v = k[:, -win_rows:], v[:, -win_rows:]
    else:
        o_a, new_k, new_v = attn_sample(q, k, v, p['attn_sinks'], win_k, win_v)
    o_b, new_conv, new_h = rglru(proj[..., OFF_RNN:OFF_RW], conv_buf, h0, p['conv_w'], p['conv_b'],
                                 p['rg_wa'], p['rg_ba'], p['rg_wx'], p['rg_bx'], p['rg_lambda'])
    o_c, new_shift, new_s = rwkv_tmix(proj[..., OFF_RW:OFF_GATE], shift0, s0, p)
    gates = jax.nn.sigmoid(proj[..., OFF_GATE:]).reshape(n, t, N_BRANCH, D_MODEL)
    mixed = gates[..., 0, :] * o_a + gates[..., 1, :] * o_b + gates[..., 2, :] * o_c
    x = layer_norm(ALPHA * x + mixed @ p['w_out'], p['ln1_g'], p['ln1_b'])
    gu = x @ p['w_gu']
    ff = (jax.nn.silu(gu[..., :D_FF]) * gu[..., D_FF:]) @ p['w_down']
    x = layer_norm(ALPHA * x + ff, p['ln2_g'], p['ln2_b'])
    return x, (new_k, new_v, new_conv, new_h, new_shift, new_s)


def _nrm(key, shape, scale):
    return scale * jax.random.normal(key, shape, jnp.float32)


def setup_inputs(seed: int = 0) -> dict:
    key = jax.random.key(seed)
    ks = jax.random.split(key, 40)
    win_buf = min(WINDOW, PAST_LEN)
    col_scale = jnp.ones((IN_COLS,), jnp.float32).at[OFF_V:OFF_RNN].set(BETA).at[OFF_RW + 2 * RW_D:OFF_RW + 3 * RW_D].set(BETA)
    a_init = jax.random.uniform(ks[16], (DEPTH, D_RNN), jnp.float32, 0.9, 0.999)
    sig_l = a_init ** (1.0 / RG_C)
    ramp = -6.5 + 5.0 * jnp.linspace(0.0, 1.0, RW_D) ** 0.85
    return {
        'x_prompt': _nrm(ks[0], (BATCH, SEQ, D_MODEL), 1.0),
        'x_sample': _nrm(ks[1], (DEC_BATCH, DEC_SEQ, D_MODEL), 1.0),
        'cache_k': _nrm(ks[2], (DEPTH, DEC_BATCH, win_buf, ATTN_KV_HEADS, HEAD_DIM), 1.0),
        'cache_v': _nrm(ks[3], (DEPTH, DEC_BATCH, win_buf, ATTN_KV_HEADS, HEAD_DIM), BETA),
        'state_conv': _nrm(ks[4], (DEPTH, DEC_BATCH, CONV_W - 1, D_RNN), 1.0),
        'state_rglru': _nrm(ks[5], (DEPTH, DEC_BATCH, D_RNN), 0.5),
        'state_shift': _nrm(ks[6], (DEPTH, DEC_BATCH, SHIFT_W), 1.0),
        'state_wkv': _nrm(ks[7], (DEPTH, DEC_BATCH, RWKV_HEADS, HEAD_DIM, HEAD_DIM), 0.3),
        'w_in': _nrm(ks[8], (DEPTH, D_MODEL, IN_COLS), D_MODEL ** -0.5) * col_scale,
        'attn_sinks': _nrm(ks[9], (DEPTH, ATTN_HEADS), 0.5),
        'conv_w': _nrm(ks[10], (DEPTH, CONV_W, D_RNN), CONV_W ** -0.5),
        'conv_b': _nrm(ks[11], (DEPTH, D_RNN), 0.02),
        'rg_wa': _nrm(ks[12], (DEPTH, RNN_BLOCKS, RNN_BLOCK, RNN_BLOCK), RNN_BLOCK ** -0.5),
        'rg_ba': _nrm(ks[13], (DEPTH, D_RNN), 0.02),
        'rg_wx': _nrm(ks[14], (DEPTH, RNN_BLOCKS, RNN_BLOCK, RNN_BLOCK), RNN_BLOCK ** -0.5),
        'rg_bx': _nrm(ks[15], (DEPTH, D_RNN), 0.02),
        'rg_lambda': jnp.log(sig_l) - jnp.log1p(-sig_l),
        'rw_mu': jax.random.uniform(ks[17], (DEPTH, SHIFT_W), jnp.float32),
        'rw_w0': ramp[None, :] + _nrm(ks[18], (DEPTH, RW_D), 0.1),
        'rw_wup': _nrm(ks[19], (DEPTH, LORA_W, RW_D), 0.1 * LORA_W ** -0.5),
        'rw_a0': _nrm(ks[20], (DEPTH, RW_D), 0.1),
        'rw_aup': _nrm(ks[21], (DEPTH, LORA_A, RW_D), 0.5 * LORA_A ** -0.5),
        'rw_gup': _nrm(ks[22], (DEPTH, LORA_G, RW_D), LORA_G ** -0.5),
        'rw_kk': 0.85 + _nrm(ks[23], (DEPTH, RW_D), 0.05),
        'rw_ka': 1.0 + _nrm(ks[24], (DEPTH, RW_D), 0.05),
        'rw_rk': _nrm(ks[25], (DEPTH, RWKV_HEADS, HEAD_DIM), 0.1),
        'rw_lnw': 1.0 + _nrm(ks[26], (DEPTH, RW_D), 0.05),
        'rw_lnb': _nrm(ks[27], (DEPTH, RW_D), 0.02),
        'w_out': _nrm(ks[28], (DEPTH, D_MODEL, D_MODEL), BETA * D_MODEL ** -0.5),
        'ln1_g': 1.0 + _nrm(ks[29], (DEPTH, D_MODEL), 0.05),
        'ln1_b': _nrm(ks[30], (DEPTH, D_MODEL), 0.02),
        'w_gu': _nrm(ks[31], (DEPTH, D_MODEL, 2 * D_FF), D_MODEL ** -0.5),
        'w_down': _nrm(ks[32], (DEPTH, D_FF, D_MODEL), BETA * D_FF ** -0.5),
        'ln2_g': 1.0 + _nrm(ks[33], (DEPTH, D_MODEL), 0.05),
        'ln2_b': _nrm(ks[34], (DEPTH, D_MODEL), 0.02),
    }


def reference(x_prompt, x_sample, cache_k, cache_v, state_conv, state_rglru, state_shift, state_wkv,
              w_in, attn_sinks, conv_w, conv_b, rg_wa, rg_ba, rg_wx, rg_bx, rg_lambda,
              rw_mu, rw_w0, rw_wup, rw_a0, rw_aup, rw_gup, rw_kk, rw_ka, rw_rk, rw_lnw, rw_lnb,
              w_out, ln1_g, ln1_b, w_gu, w_down, ln2_g, ln2_b):
    win_rows = cache_k.shape[2]
    bp = x_prompt.shape[0]
    dt = x_prompt.dtype
    yp = x_prompt
    ys = x_sample
    st_p = []
    st_s = []
    for l in range(DEPTH):
        p = dict(w_in=w_in[l], attn_sinks=attn_sinks[l], conv_w=conv_w[l], conv_b=conv_b[l],
                 rg_wa=rg_wa[l], rg_ba=rg_ba[l], rg_wx=rg_wx[l], rg_bx=rg_bx[l], rg_lambda=rg_lambda[l],
                 rw_mu=rw_mu[l], rw_w0=rw_w0[l], rw_wup=rw_wup[l], rw_a0=rw_a0[l], rw_aup=rw_aup[l],
                 rw_gup=rw_gup[l], rw_kk=rw_kk[l], rw_ka=rw_ka[l], rw_rk=rw_rk[l], rw_lnw=rw_lnw[l],
                 rw_lnb=rw_lnb[l], w_out=w_out[l], ln1_g=ln1_g[l], ln1_b=ln1_b[l], w_gu=w_gu[l],
                 w_down=w_down[l], ln2_g=ln2_g[l], ln2_b=ln2_b[l])
        yp, sp = hybrid_layer(yp, None, None,
                              jnp.zeros((bp, CONV_W - 1, D_RNN), dt), jnp.zeros((bp, D_RNN), dt),
                              jnp.zeros((bp, SHIFT_W), dt),
                              jnp.zeros((bp, RWKV_HEADS, HEAD_DIM, HEAD_DIM), jnp.float32), win_rows, p)
        ys, ss = hybrid_layer(ys, cache_k[l], cache_v[l], state_conv[l], state_rglru[l], state_shift[l],
                              state_wkv[l], win_rows, p)
        st_p.append(sp)
        st_s.append(ss)
    p_k = jnp.stack([s[0] for s in st_p])
    p_v = jnp.stack([s[1] for s in st_p])
    p_conv = jnp.stack([s[2] for s in st_p])
    p_h = jnp.stack([s[3] for s in st_p])
    p_shift = jnp.stack([s[4] for s in st_p])
    p_wkv = jnp.stack([s[5] for s in st_p])
    s_k = jnp.stack([s[0] for s in st_s])
    s_v = jnp.stack([s[1] for s in st_s])
    s_conv = jnp.stack([s[2] for s in st_s])
    s_h = jnp.stack([s[3] for s in st_s])
    s_shift = jnp.stack([s[4] for s in st_s])
    s_wkv = jnp.stack([s[5] for s in st_s])
    return (yp, ys, p_k, p_v, p_conv, p_h, p_shift, p_wkv, s_k, s_v, s_conv, s_h, s_shift, s_wkv)
```

```cpp
#include <hip/hip_runtime.h>
#include <cstdint>
#include <cstdio>

typedef unsigned short bf16_t;
__device__ __forceinline__ float bf2f(bf16_t v) { return __uint_as_float(((unsigned)v) << 16); }
__device__ __forceinline__ bf16_t f2bf(float f) { unsigned u = __float_as_uint(f); return (bf16_t)((u + 0x7fffu + ((u >> 16) & 1u)) >> 16); }
__device__ __forceinline__ float sigmoidf_(float x) { return 1.f / (1.f + __expf(-x)); }
__device__ __forceinline__ float softplusf_(float x) { return fmaxf(x, 0.f) + log1pf(__expf(-fabsf(x))); }
__device__ __forceinline__ float wave_sum(float v) {
#pragma unroll
    for (int o = 1; o < 64; o <<= 1) v += __shfl_xor(v, o);
    return v;
}

constexpr int D = 1024, MP = 16384, MS = 1024, M = MP + MS, SEQ = 8192, DSEQ = 8, NBATCH = 2, DBATCH = 128, DEPTH = 2;
constexpr int NP = 9216, IN_COLS = 8992;
constexpr int CQ = 0, CK = 1024, CV = 1280, CRNN = 1536, CRW = 2560, CG = 6144;
constexpr int SHIFT_W = 3360, DFF = 2816;
constexpr float ALPHA = 1.4142135623730951f;
constexpr float LN_EPS = 1e-5f, GN_EPS = 64e-5f;

constexpr size_t O_YP = 0, O_YS = 16777216, O_PK = 17825792, O_PV = 17956864, O_PCONV = 18087936, O_PH = 18100224,
                 O_PSHIFT = 18104320, O_PWKV = 18117760, O_SK = 18379904, O_SV = 26768512, O_SCONV = 35157120,
                 O_SH = 35943552, O_SSHIFT = 36205696, O_SWKV = 37065856, O_END = 53843072;

constexpr size_t MiB = 1u << 20;
constexpr size_t WS_XB = 1 * MiB;
constexpr size_t WS_XF = WS_XB + (size_t)M * D * 2;
constexpr size_t WS_OA = WS_XF + (size_t)M * D * 4;
constexpr size_t WS_OB = WS_OA + (size_t)M * D * 2;
constexpr size_t WS_OC = WS_OB + (size_t)M * D * 2;
constexpr size_t WS_MIX = WS_OC + (size_t)M * D * 2;
constexpr size_t WS_P = WS_MIX + (size_t)M * D * 2;
constexpr size_t WS_Z = WS_P;
constexpr size_t WS_X1F = WS_Z + (size_t)M * D * 4;
constexpr size_t WS_X1B = WS_X1F + (size_t)M * D * 4;
constexpr size_t WS_H = WS_X1B + (size_t)M * D * 2;
constexpr size_t WS_END = WS_P + (size_t)M * NP * 2;
static_assert(WS_H + (size_t)M * DFF * 2 <= WS_END, "overlay fits");

constexpr int RPT = 8;

__global__ void k_prep_x(const float* __restrict__ xp, const float* __restrict__ xs, float* XF, bf16_t* XB) {
    size_t i = (size_t)blockIdx.x * 256 + threadIdx.x;
    if (i >= (size_t)M * D) return;
    const size_t np = (size_t)MP * D;
    float v = i < np ? xp[i] : xs[i - np];
    XF[i] = v; XB[i] = f2bf(v);
}

__global__ void __launch_bounds__(256) k_in_naive(const bf16_t* __restrict__ XB, const float* __restrict__ W, bf16_t* P) {
    const int n = blockIdx.x * 256 + threadIdx.x;
    const int m0 = blockIdx.y * RPT;
    const int wc = n < 5920 ? n : (n < 6144 ? -1 : n - 224);
    float acc[RPT];
#pragma unroll
    for (int i = 0; i < RPT; ++i) acc[i] = 0.f;
    if (wc >= 0) {
        for (int k = 0; k < D; ++k) {
            const float w = W[(size_t)k * IN_COLS + wc];
#pragma unroll
            for (int i = 0; i < RPT; ++i) acc[i] += bf2f(XB[(size_t)(m0 + i) * D + k]) * w;
        }
    }
#pragma unroll
    for (int i = 0; i < RPT; ++i) {
        float v = acc[i];
        if (n >= CG) v = sigmoidf_(v);
        P[(size_t)(m0 + i) * NP + n] = f2bf(v);
    }
}

__global__ void __launch_bounds__(256) k_out_naive(const bf16_t* __restrict__ A, const float* __restrict__ W, const float* __restrict__ XF, float* Z) {
    const int n = blockIdx.x * 256 + threadIdx.x;
    const int m0 = blockIdx.y * RPT;
    float acc[RPT];
#pragma unroll
    for (int i = 0; i < RPT; ++i) acc[i] = 0.f;
    for (int k = 0; k < D; ++k) {
        const float w = W[(size_t)k * D + n];
#pragma unroll
        for (int i = 0; i < RPT; ++i) acc[i] += bf2f(A[(size_t)(m0 + i) * D + k]) * w;
    }
#pragma unroll
    for (int i = 0; i < RPT; ++i) Z[(size_t)(m0 + i) * D + n] = ALPHA * XF[(size_t)(m0 + i) * D + n] + acc[i];
}

__global__ void __launch_bounds__(256) k_gu_naive(const bf16_t* __restrict__ A, const float* __restrict__ W, bf16_t* H) {
    const int j = blockIdx.x * 256 + threadIdx.x;
    const int m0 = blockIdx.y * RPT;
    float ag[RPT], au[RPT];
#pragma unroll
    for (int i = 0; i < RPT; ++i) { ag[i] = 0.f; au[i] = 0.f; }
    for (int k = 0; k < D; ++k) {
        const float wg = W[(size_t)k * (2 * DFF) + j], wu = W[(size_t)k * (2 * DFF) + DFF + j];
#pragma unroll
        for (int i = 0; i < RPT; ++i) { const float a = bf2f(A[(size_t)(m0 + i) * D + k]); ag[i] += a * wg; au[i] += a * wu; }
    }
#pragma unroll
    for (int i = 0; i < RPT; ++i) { const float g = ag[i]; H[(size_t)(m0 + i) * DFF + j] = f2bf(g * sigmoidf_(g) * au[i]); }
}

__global__ void __launch_bounds__(256) k_down_naive(const bf16_t* __restrict__ A, const float* __restrict__ W, const float* __restrict__ XF, float* Z) {
    const int n = blockIdx.x * 256 + threadIdx.x;
    const int m0 = blockIdx.y * RPT;
    float acc[RPT];
#pragma unroll
    for (int i = 0; i < RPT; ++i) acc[i] = 0.f;
    for (int k = 0; k < DFF; ++k) {
        const float w = W[(size_t)k * D + n];
#pragma unroll
        for (int i = 0; i < RPT; ++i) acc[i] += bf2f(A[(size_t)(m0 + i) * DFF + k]) * w;
    }
#pragma unroll
    for (int i = 0; i < RPT; ++i) Z[(size_t)(m0 + i) * D + n] = ALPHA * XF[(size_t)(m0 + i) * D + n] + acc[i];
}

__global__ void __launch_bounds__(256) k_ln(const float* __restrict__ Z, const float* __restrict__ g, const float* __restrict__ b, float* OF, bf16_t* OB) {
    const int lane = threadIdx.x & 63, m = blockIdx.x * 4 + (threadIdx.x >> 6);
    const float* z = Z + (size_t)m * D;
    float v[16]; float s = 0.f;
#pragma unroll
    for (int j = 0; j < 16; ++j) { v[j] = z[j * 64 + lane]; s += v[j]; }
    const float mean = wave_sum(s) * (1.f / D);
    float q = 0.f;
#pragma unroll
    for (int j = 0; j < 16; ++j) { v[j] -= mean; q += v[j] * v[j]; }
    const float rstd = rsqrtf(wave_sum(q) * (1.f / D) + LN_EPS);
#pragma unroll
    for (int j = 0; j < 16; ++j) {
        const int c = j * 64 + lane;
        const float y = v[j] * rstd * g[c] + b[c];
        OF[(size_t)m * D + c] = y;
        if (OB) OB[(size_t)m * D + c] = f2bf(y);
    }
}

__global__ void __launch_bounds__(256) k_attn_naive(const bf16_t* __restrict__ P, const float* __restrict__ ck, const float* __restrict__ cv,
                                                    const float* __restrict__ sinks, bf16_t* OA) {
    const int idx = blockIdx.x * 256 + threadIdx.x;
    const int m = idx >> 4, h = idx & 15;
    if (m >= M) return;
    const int c = h >> 2;
    const float slope = exp2f(-0.5f * (float)(h + 1));
    float q[64], o[64];
#pragma unroll
    for (int d = 0; d < 64; ++d) { q[d] = bf2f(P[(size_t)m * NP + CQ + 64 * h + d]) * 0.125f; o[d] = 0.f; }
    float mx = sinks[h], l = 1.f;
    if (m < MP) {
        const int b = m / SEQ, t = m % SEQ;
        const int p0 = t - 127 < 0 ? 0 : t - 127;
        for (int pos = p0; pos <= t; ++pos) {
            const bf16_t* kr = P + (size_t)(b * SEQ + pos) * NP + CK + 64 * c;
            const bf16_t* vr = P + (size_t)(b * SEQ + pos) * NP + CV + 64 * c;
            float s = 0.f;
#pragma unroll
            for (int d = 0; d < 64; ++d) s += q[d] * bf2f(kr[d]);
            s -= slope * (float)(t - pos);
            const float mn = fmaxf(mx, s), sc = __expf(mx - mn), e = __expf(s - mn);
            l = l * sc + e; mx = mn;
#pragma unroll
            for (int d = 0; d < 64; ++d) o[d] = o[d] * sc + e * bf2f(vr[d]);
        }
    } else {
        const int b = (m - MP) / DSEQ, t = (m - MP) % DSEQ;
        for (int s_ = t + 1; s_ <= t + 128; ++s_) {
            float s = 0.f; float vv[64];
            if (s_ < 128) {
                const float* kr = ck + ((size_t)(b * 128 + s_) * 4 + c) * 64;
                const float* vr = cv + ((size_t)(b * 128 + s_) * 4 + c) * 64;
#pragma unroll
                for (int d = 0; d < 64; ++d) { s += q[d] * kr[d]; vv[d] = vr[d]; }
            } else {
                const bf16_t* kr = P + (size_t)(MP + b * DSEQ + (s_ - 128)) * NP + CK + 64 * c;
                const bf16_t* vr = P + (size_t)(MP + b * DSEQ + (s_ - 128)) * NP + CV + 64 * c;
#pragma unroll
                for (int d = 0; d < 64; ++d) { s += q[d] * bf2f(kr[d]); vv[d] = bf2f(vr[d]); }
            }
            s -= slope * (float)(128 + t - s_);
            const float mn = fmaxf(mx, s), sc = __expf(mx - mn), e = __expf(s - mn);
            l = l * sc + e; mx = mn;
#pragma unroll
            for (int d = 0; d < 64; ++d) o[d] = o[d] * sc + e * vv[d];
        }
    }
    const float inv = 1.f / l;
#pragma unroll
    for (int d = 0; d < 64; ++d) OA[(size_t)m * D + 64 * h + d] = f2bf(o[d] * inv);
}

__global__ void __launch_bounds__(64) k_wkv_naive(const bf16_t* __restrict__ P, const float* __restrict__ mu, const float* __restrict__ w0, const float* __restrict__ wup,
                                                  const float* __restrict__ a0, const float* __restrict__ aup, const float* __restrict__ gup, const float* __restrict__ rwkk,
                                                  const float* __restrict__ rwka, const float* __restrict__ rk, const float* __restrict__ lnw, const float* __restrict__ lnb,
                                                  const float* __restrict__ shift0, const float* __restrict__ s0, bf16_t* OC, float* out_p, float* out_s) {
    __shared__ float s_lw[64], s_la[64], s_lg[160], s_w[64], s_kk[64], s_b[64], s_k[64], s_r[64];
    const int seq = blockIdx.x >> 4, h = blockIdx.x & 15, j = threadIdx.x, c = 64 * h + j;
    int row0, T; const float* sh0 = nullptr; float* outS;
    float S[64];
    if (seq < NBATCH) { row0 = seq * SEQ; T = SEQ; outS = out_p + ((size_t)(seq * 16 + h) * 64 + j) * 64;
#pragma unroll
        for (int i = 0; i < 64; ++i) S[i] = 0.f;
    } else { const int b = seq - NBATCH; row0 = MP + b * DSEQ; T = DSEQ; sh0 = shift0 + (size_t)b * SHIFT_W; outS = out_s + ((size_t)(b * 16 + h) * 64 + j) * 64;
        const float* sp = s0 + ((size_t)(b * 16 + h) * 64 + j) * 64;
#pragma unroll
        for (int i = 0; i < 64; ++i) S[i] = sp[i];
    }
    const float w0c = w0[c], a0c = a0[c], kkc = rwkk[c], kac = rwka[c], rkc = rk[c], lnwc = lnw[c], lnbc = lnb[c];
    for (int t = 0; t < T; ++t) {
        const size_t m = (size_t)row0 + t;
        const bf16_t* pr = P + m * NP + CRW;
        const bf16_t* pp = P + (m - 1) * NP + CRW;
        auto shifted = [&](int ch) -> float {
            const float pc = bf2f(pr[ch]);
            const float pv = t == 0 ? (sh0 ? sh0[ch] : 0.f) : bf2f(pp[ch]);
            return pc + mu[ch] * (pv - pc);
        };
        for (int i = j; i < 288; i += 64) {
            const float ps = shifted(3072 + i);
            if (i < 64) s_lw[i] = tanhf(ps); else if (i < 128) s_la[i - 64] = ps; else s_lg[i - 128] = sigmoidf_(ps);
        }
        const float r = shifted(c), k = shifted(1024 + c), v = shifted(2048 + c);
        __syncthreads();
        float accw = w0c, acca = a0c, accg = 0.f;
        for (int i = 0; i < 64; ++i) { accw += s_lw[i] * wup[i * D + c]; acca += s_la[i] * aup[i * D + c]; }
        for (int i = 0; i < 160; ++i) accg += s_lg[i] * gup[i * D + c];
        const float wlog = -softplusf_(-accw) - 0.5f;
        const float decay = __expf(-__expf(wlog));
        const float a = sigmoidf_(acca);
        float kk = k * kkc;
        const float nrm = sqrtf(wave_sum(kk * kk));
        kk = kk / fmaxf(nrm, 1e-12f);
        const float k2 = k * (1.f + (a - 1.f) * kac);
        const float bdot = wave_sum(r * k2 * rkc);
        s_w[j] = decay; s_kk[j] = kk; s_b[j] = kk * a; s_k[j] = k2; s_r[j] = r;
        __syncthreads();
        float sa = 0.f;
#pragma unroll
        for (int i = 0; i < 64; ++i) sa -= S[i] * s_kk[i];
        float y = 0.f;
#pragma unroll
        for (int i = 0; i < 64; ++i) { S[i] = S[i] * s_w[i] + sa * s_b[i] + v * s_k[i]; y += S[i] * s_r[i]; }
        const float mean = wave_sum(y) * (1.f / 64.f);
        const float dy = y - mean;
        const float var = wave_sum(dy * dy) * (1.f / 64.f);
        const float yn = dy * rsqrtf(var + GN_EPS) * lnwc + lnbc;
        OC[m * D + c] = f2bf((yn + bdot * v) * accg);
        __syncthreads();
    }
#pragma unroll
    for (int i = 0; i < 64; ++i) outS[i] = S[i];
}

__global__ void __launch_bounds__(64) k_rglru_naive(const bf16_t* __restrict__ P, const float* __restrict__ cw, const float* __restrict__ cb, const float* __restrict__ wa,
                                                    const float* __restrict__ ba, const float* __restrict__ wx, const float* __restrict__ bx, const float* __restrict__ lam,
                                                    const float* __restrict__ conv0, const float* __restrict__ h0, bf16_t* OB,
                                                    float* out_pconv, float* out_ph, float* out_sconv, float* out_sh) {
    __shared__ float s_xc[64];
    const int seq = blockIdx.x >> 4, bk = blockIdx.x & 15, j = threadIdx.x, c = 64 * bk + j;
    int row0, T; float x1 = 0.f, x2 = 0.f, x3 = 0.f, h = 0.f; float *oc, *oh;
    if (seq < NBATCH) { row0 = seq * SEQ; T = SEQ; oc = out_pconv + (size_t)seq * 3 * D; oh = out_ph + (size_t)seq * D; }
    else { const int b = seq - NBATCH; row0 = MP + b * DSEQ; T = DSEQ; oc = out_sconv + (size_t)b * 3 * D; oh = out_sh + (size_t)b * D;
        x3 = conv0[((size_t)b * 3 + 0) * D + c]; x2 = conv0[((size_t)b * 3 + 1) * D + c]; x1 = conv0[((size_t)b * 3 + 2) * D + c]; h = h0[(size_t)b * D + c]; }
    float war[64], wxr[64];
#pragma unroll
    for (int i = 0; i < 64; ++i) { war[i] = wa[((size_t)bk * 64 + i) * 64 + j]; wxr[i] = wx[((size_t)bk * 64 + i) * 64 + j]; }
    const float c0 = cw[0 * D + c], c1 = cw[1 * D + c], c2 = cw[2 * D + c], c3 = cw[3 * D + c], cbc = cb[c], bac = ba[c], bxc = bx[c];
    const float spl = softplusf_(-lam[c]);
    for (int t = 0; t < T; ++t) {
        const size_t m = (size_t)row0 + t;
        const float x = bf2f(P[m * NP + CRNN + c]);
        const float xc = cbc + c0 * x3 + c1 * x2 + c2 * x1 + c3 * x;
        s_xc[j] = xc;
        __syncthreads();
        float r = bac, ig = bxc;
#pragma unroll
        for (int i = 0; i < 64; ++i) { const float xi = s_xc[i]; r += xi * war[i]; ig += xi * wxr[i]; }
        r = sigmoidf_(r); ig = sigmoidf_(ig);
        const float log_a = -8.f * r * spl;
        const float a = __expf(log_a);
        const float u = sqrtf(-expm1f(2.f * log_a)) * (ig * xc);
        h = a * h + u;
        OB[m * D + c] = f2bf(h);
        x3 = x2; x2 = x1; x1 = x;
        __syncthreads();
    }
    oh[c] = h; oc[0 * D + c] = x3; oc[1 * D + c] = x2; oc[2 * D + c] = x1;
}

__global__ void k_mix(const bf16_t* __restrict__ P, const bf16_t* __restrict__ OA, const bf16_t* __restrict__ OB, const bf16_t* __restrict__ OC, bf16_t* MIX) {
    size_t i = (size_t)blockIdx.x * 256 + threadIdx.x;
    if (i >= (size_t)M * D) return;
    const size_t m = i / D; const int c = (int)(i % D);
    const bf16_t* pg = P + m * NP + CG + c;
    const float v = bf2f(pg[0]) * bf2f(OA[i]) + bf2f(pg[1024]) * bf2f(OB[i]) + bf2f(pg[2048]) * bf2f(OC[i]);
    MIX[i] = f2bf(v);
}

__global__ void k_states(const bf16_t* __restrict__ P, const float* __restrict__ ck, const float* __restrict__ cv,
                         float* pk, float* pv, float* pshift, float* sk, float* sv, float* sshift) {
    const size_t i = (size_t)blockIdx.x * 256 + threadIdx.x;
    const size_t n_pk = (size_t)NBATCH * 128 * 256, n_sk = (size_t)DBATCH * 128 * 256, n_ps = (size_t)NBATCH * SHIFT_W, n_ss = (size_t)DBATCH * SHIFT_W;
    if (i < n_pk) {
        const int b = (int)(i / (128 * 256)), s = (int)((i / 256) % 128), e = (int)(i % 256);
        const size_t row = (size_t)b * SEQ + (SEQ - 128) + s;
        pk[i] = bf2f(P[row * NP + CK + e]); pv[i] = bf2f(P[row * NP + CV + e]);
        return;
    }
    size_t k = i - n_pk;
    if (k < n_sk) {
        const int b = (int)(k / (128 * 256)), s = (int)((k / 256) % 128), e = (int)(k % 256);
        if (s < 120) { sk[k] = ck[((size_t)b * 128 + s + 8) * 256 + e]; sv[k] = cv[((size_t)b * 128 + s + 8) * 256 + e]; }
        else { const size_t row = (size_t)MP + b * DSEQ + (s - 120); sk[k] = bf2f(P[row * NP + CK + e]); sv[k] = bf2f(P[row * NP + CV + e]); }
        return;
    }
    k -= n_sk;
    if (k < n_ps) { const int b = (int)(k / SHIFT_W), ch = (int)(k % SHIFT_W); pshift[k] = bf2f(P[((size_t)b * SEQ + SEQ - 1) * NP + CRW + ch]); return; }
    k -= n_ps;
    if (k < n_ss) { const int b = (int)(k / SHIFT_W), ch = (int)(k % SHIFT_W); sshift[k] = bf2f(P[((size_t)MP + b * DSEQ + DSEQ - 1) * NP + CRW + ch]); return; }
}

extern "C" void kernel_launch(void* const* d_in, const int* in_sizes, int n_in, void* d_out, int out_size,
                              void* d_ws, size_t ws_size, hipStream_t stream) {
    if (ws_size < WS_END || out_size != (int)O_END || n_in != 35) { fprintf(stderr, "kernel_launch: unexpected sizes ws=%zu out=%d n_in=%d\n", ws_size, out_size, n_in); return; }
    const float* const* in = (const float* const*)d_in;
    unsigned char* ws = (unsigned char*)d_ws;
    float* out = (float*)d_out;
    bf16_t* XB = (bf16_t*)(ws + WS_XB); float* XF = (float*)(ws + WS_XF);
    bf16_t* OA = (bf16_t*)(ws + WS_OA); bf16_t* OB = (bf16_t*)(ws + WS_OB); bf16_t* OC = (bf16_t*)(ws + WS_OC); bf16_t* MIX = (bf16_t*)(ws + WS_MIX);
    bf16_t* P = (bf16_t*)(ws + WS_P); float* Z = (float*)(ws + WS_Z); float* X1F = (float*)(ws + WS_X1F); bf16_t* X1B = (bf16_t*)(ws + WS_X1B); bf16_t* H = (bf16_t*)(ws + WS_H);
    const int nel = M * D;
    k_prep_x<<<(nel + 255) / 256, 256, 0, stream>>>(in[0], in[1], XF, XB);
    for (int l = 0; l < DEPTH; ++l) {
        const float* ck = in[2] + (size_t)l * DBATCH * 128 * 256; const float* cv = in[3] + (size_t)l * DBATCH * 128 * 256;
        const float* conv0 = in[4] + (size_t)l * DBATCH * 3 * D; const float* h0 = in[5] + (size_t)l * DBATCH * D;
        const float* shift0 = in[6] + (size_t)l * DBATCH * SHIFT_W; const float* s0 = in[7] + (size_t)l * DBATCH * 16 * 4096;
        k_in_naive<<<dim3(NP / 256, M / RPT), 256, 0, stream>>>(XB, in[8] + (size_t)l * D * IN_COLS, P);
        k_attn_naive<<<M * 16 / 256, 256, 0, stream>>>(P, ck, cv, in[9] + l * 16, OA);
        k_wkv_naive<<<(NBATCH + DBATCH) * 16, 64, 0, stream>>>(P, in[17] + (size_t)l * SHIFT_W, in[18] + l * D, in[19] + (size_t)l * 64 * D, in[20] + l * D, in[21] + (size_t)l * 64 * D,
            in[22] + (size_t)l * 160 * D, in[23] + l * D, in[24] + l * D, in[25] + l * D, in[26] + l * D, in[27] + l * D, shift0, s0, OC,
            out + O_PWKV + (size_t)l * NBATCH * 16 * 4096, out + O_SWKV + (size_t)l * DBATCH * 16 * 4096);
        k_rglru_naive<<<(NBATCH + DBATCH) * 16, 64, 0, stream>>>(P, in[10] + (size_t)l * 4 * D, in[11] + l * D, in[12] + (size_t)l * 16 * 4096, in[13] + l * D, in[14] + (size_t)l * 16 * 4096,
            in[15] + l * D, in[16] + l * D, conv0, h0, OB,
            out + O_PCONV + (size_t)l * NBATCH * 3 * D, out + O_PH + (size_t)l * NBATCH * D, out + O_SCONV + (size_t)l * DBATCH * 3 * D, out + O_SH + (size_t)l * DBATCH * D);
        {
            const size_t tot = (size_t)NBATCH * 128 * 256 + (size_t)DBATCH * 128 * 256 + (size_t)NBATCH * SHIFT_W + (size_t)DBATCH * SHIFT_W;
            k_states<<<(unsigned)((tot + 255) / 256), 256, 0, stream>>>(P, ck, cv, out + O_PK + (size_t)l * NBATCH * 128 * 256, out + O_PV + (size_t)l * NBATCH * 128 * 256,
                out + O_PSHIFT + (size_t)l * NBATCH * SHIFT_W, out + O_SK + (size_t)l * DBATCH * 128 * 256, out + O_SV + (size_t)l * DBATCH * 128 * 256,
                out + O_SSHIFT + (size_t)l * DBATCH * SHIFT_W);
        }
        k_mix<<<(nel + 255) / 256, 256, 0, stream>>>(P, OA, OB, OC, MIX);
        k_out_naive<<<dim3(D / 256, M / RPT), 256, 0, stream>>>(MIX, in[28] + (size_t)l * D * D, XF, Z);
        k_ln<<<M / 4, 256, 0, stream>>>(Z, in[29] + l * D, in[30] + l * D, X1F, X1B);
        k_gu_naive<<<dim3(DFF / 256, M / RPT), 256, 0, stream>>>(X1B, in[31] + (size_t)l * D * 2 * DFF, H);
        k_down_naive<<<dim3(D / 256, M / RPT), 256, 0, stream>>>(H, in[32] + (size_t)l * DFF * D, X1F, Z);
        if (l == DEPTH - 1) k_ln<<<M / 4, 256, 0, stream>>>(Z, in[33] + l * D, in[34] + l * D, out + O_YP, nullptr);
        else k_ln<<<M / 4, 256, 0, stream>>>(Z, in[33] + l * D, in[34] + l * D, XF, XB);
    }
}
```

```cpp
#include <hip/hip_runtime.h>
#include <cstdint>
#include <cstdio>

typedef unsigned short bf16_t;
__device__ __forceinline__ float bf2f(bf16_t v) { return __uint_as_float(((unsigned)v) << 16); }
__device__ __forceinline__ bf16_t f2bf(float f) { unsigned u = __float_as_uint(f); return (bf16_t)((u + 0x7fffu + ((u >> 16) & 1u)) >> 16); }
__device__ __forceinline__ float sigmoidf_(float x) { return 1.f / (1.f + __expf(-x)); }
__device__ __forceinline__ float softplusf_(float x) { return fmaxf(x, 0.f) + log1pf(__expf(-fabsf(x))); }
__device__ __forceinline__ float wave_sum(float v) {
#pragma unroll
    for (int o = 1; o < 64; o <<= 1) v += __shfl_xor(v, o);
    return v;
}

constexpr int D = 1024, MP = 16384, MS = 1024, M = MP + MS, SEQ = 8192, DSEQ = 8, NBATCH = 2, DBATCH = 128, DEPTH = 2;
constexpr int NP = 9216, IN_COLS = 8992;
constexpr int CQ = 0, CK = 1024, CV = 1280, CRNN = 1536, CRW = 2560, CG = 6144;
constexpr int SHIFT_W = 3360, DFF = 2816;
constexpr float ALPHA = 1.4142135623730951f;
constexpr float LN_EPS = 1e-5f, GN_EPS = 64e-5f;

constexpr size_t O_YP = 0, O_YS = 16777216, O_PK = 17825792, O_PV = 17956864, O_PCONV = 18087936, O_PH = 18100224,
                 O_PSHIFT = 18104320, O_PWKV = 18117760, O_SK = 18379904, O_SV = 26768512, O_SCONV = 35157120,
                 O_SH = 35943552, O_SSHIFT = 36205696, O_SWKV = 37065856, O_END = 53843072;


constexpr size_t MiB = 1u << 20;
constexpr size_t WS_CTL = 0;
constexpr size_t WIN_T_BYTES = (size_t)NP * D * 2, WOUT_T_BYTES = (size_t)D * D * 2, WGU_T_BYTES = (size_t)2 * DFF * D * 2, WDN_T_BYTES = (size_t)D * DFF * 2;
constexpr size_t WS_WIN = 1 * MiB;
constexpr size_t WS_WOUT = WS_WIN + 2 * WIN_T_BYTES;
constexpr size_t WS_WGU = WS_WOUT + 2 * WOUT_T_BYTES;
constexpr size_t WS_WDN = WS_WGU + 2 * WGU_T_BYTES;
constexpr size_t WS_XB = WS_WDN + 2 * WDN_T_BYTES;
constexpr size_t WS_XF = WS_XB + (size_t)M * D * 2;
constexpr size_t WS_OA = WS_XF + (size_t)M * D * 4;
constexpr size_t WS_OB = WS_OA + (size_t)M * D * 2;
constexpr size_t WS_OC = WS_OB + (size_t)M * D * 2;
constexpr size_t WS_MIX = WS_OC + (size_t)M * D * 2;
constexpr size_t WS_P = WS_MIX + (size_t)M * D * 2;
constexpr size_t WS_Z = WS_P;
constexpr size_t WS_X1F = WS_Z + (size_t)M * D * 4;
constexpr size_t WS_X1B = WS_X1F + (size_t)M * D * 4;
constexpr size_t WS_H = WS_X1B + (size_t)M * D * 2;
constexpr size_t WS_END = WS_P + (size_t)M * NP * 2;
static_assert(WS_H + (size_t)M * DFF * 2 <= WS_END, "overlay fits");
static_assert(WS_XB % 256 == 0 && WS_P % 256 == 0, "alignment");
namespace pg8 {
#define PG8_LAS __attribute__((address_space(3)))
typedef unsigned short bf16_t;
typedef short bf16x8 __attribute__((ext_vector_type(8)));
typedef float f32x4 __attribute__((ext_vector_type(4)));
typedef unsigned u32x4 __attribute__((ext_vector_type(4)));
constexpr int BM = 256, BK = 64, HALF = 128, HTB = HALF * BK * 2  , STAGE_BYTES = 8 * HTB, NXCD = 8, WGM = 8;

__host__ __device__ __forceinline__ int lds_byte(int r, int c) { const int st = (r >> 4) * 2 + (c >> 5), rr = r & 15, cc = c & 31, ob = rr * 64 + cc * 2; return st * 1024 + (ob ^ (((ob >> 9) & 1) << 5)); }
__host__ __device__ __forceinline__ void stage_rc(int b, int& R, int& C) { const int st = b / 1024, sb = b % 1024, swz = sb ^ (((sb >> 9) & 1) << 5); R = (st >> 1) * 16 + swz / 64; C = (st & 1) * 32 + (swz % 64) / 2; }
__host__ __device__ __forceinline__ int perm32(int rho) { const int n = rho >> 4, i = rho & 15; return 8 * (i >> 2) + 4 * n + (i & 3); }

struct Unit { int pm, pn; };
struct Gemm { const bf16_t* A; const bf16_t* Bt; int M, N, K; };

struct StaticOrder {
    int nM, nN, nwg, G, c;
    __host__ __device__ void init(int M, int N, int G_, int c_) { nM = M / BM; nN = N / BM; nwg = nM * nN; G = G_; c = c_; }
    __host__ __device__ bool next(int i, Unit& u) const {
        const long L = (long)i * G + c; if (L >= nwg) return false;
        int wgid = (int)L; { const int q = nwg / NXCD, r = nwg % NXCD, xcd = wgid % NXCD, off = wgid / NXCD; wgid = (xcd < r ? xcd * (q + 1) : r * (q + 1) + (xcd - r) * q) + off; }
        const int nig = WGM * nN, gid = wgid / nig, fm = gid * WGM, gsz = (nM - fm) < WGM ? (nM - fm) : WGM;
        u.pm = fm + ((wgid % nig) % gsz); u.pn = (wgid % nig) / gsz; return true;
    }
    __device__ __forceinline__ void a_ready(const Unit&) const {}
    __device__ __forceinline__ void done(const Unit&) const {}
};

__device__ __forceinline__ unsigned cvt_pk_bf16(float lo, float hi) { unsigned r; asm volatile("v_cvt_pk_bf16_f32 %0, %1, %2" : "=v"(r) : "v"(lo), "v"(hi)); return r; }
typedef float f32x2 __attribute__((ext_vector_type(2)));
template <class Epi, class Sched, bool ALIGN_EPI = false, bool SP2 = false>
__device__ __forceinline__ void gemm_phase(PG8_LAS unsigned char* lds, const Gemm g, const Sched& S, const Epi& E) {
    const int tid = threadIdx.x, wid = __builtin_amdgcn_readfirstlane(tid >> 6), lane = tid & 63, wr = wid >> 2, wc = wid & 3, fr = lane & 15, fq = lane >> 4;
    const int K = g.K, nt = K / BK;
    unsigned voffA[2], voffB[2];
#pragma unroll
    for (int i = 0; i < 2; ++i) { int R, C; stage_rc(tid * 16 + i * 8192, R, C); const int Rb = Epi::PERM ? ((R & ~31) + perm32(R & 31)) : R;
        voffA[i] = (unsigned)(R * K + C) * 2u; voffB[i] = (unsigned)(Rb * K + C) * 2u; }
    const size_t kstep = (size_t)(BK * 2);
    const size_t hstep = (size_t)HALF * K * 2;
    const size_t tstep = 2 * hstep;
    const unsigned ldsw = (unsigned)wid * 1024u;
    const int aoff = lds_byte(wr * 64 + fr, fq * 8), boff = lds_byte(wc * 32 + fr, fq * 8);
#define PG8_SA(b, h) (((b) * 2 + (h)) * HTB)
#define PG8_SB(b, h) ((4 + (b) * 2 + (h)) * HTB)
#define PG8_STAGE(bufoff, gbase, voff) do { _Pragma("unroll") for (int _i = 0; _i < 2; ++_i) \
        __builtin_amdgcn_global_load_lds((const unsigned*)((const char*)(gbase) + (voff)[_i]), (PG8_LAS unsigned*)(lds + (bufoff) + ldsw + _i * 8192), 16, 0, 0); } while (0)
#define PG8_LDA(dst, b, h) do { _Pragma("unroll") for (int m = 0; m < 4; ++m) _Pragma("unroll") for (int k = 0; k < 2; ++k) dst[m][k] = *(const PG8_LAS bf16x8*)(lds + PG8_SA(b, h) + aoff + m * 2048 + k * 1024); } while (0)
#define PG8_LDB(dst, b, h) do { _Pragma("unroll") for (int n = 0; n < 2; ++n) _Pragma("unroll") for (int k = 0; k < 2; ++k) dst[n][k] = *(const PG8_LAS bf16x8*)(lds + PG8_SB(b, h) + boff + n * 2048 + k * 1024); } while (0)
#define PG8_MMA(ai, bj, At, Bt) do { __builtin_amdgcn_s_setprio(1); _Pragma("unroll") for (int m = 0; m < 4; ++m) _Pragma("unroll") for (int n = 0; n < 2; ++n) _Pragma("unroll") for (int k = 0; k < 2; ++k) \
        acc[ai][bj][m][n] = __builtin_amdgcn_mfma_f32_16x16x32_bf16(Bt[n][k], At[m][k], acc[ai][bj][m][n], 0, 0, 0); __builtin_amdgcn_s_setprio(0); } while (0)
#define PG8_WAIT_V(n) asm volatile("s_waitcnt vmcnt(" #n ")" ::: "memory")
#define PG8_WAIT_L(n) asm volatile("s_waitcnt lgkmcnt(" #n ")" ::: "memory")
#define PG8_BAR __builtin_amdgcn_s_barrier()
#define PG8_SCHED __builtin_amdgcn_sched_barrier(0)
    Unit cur, nxt; int ui = 0;
    if (!S.next(0, cur)) return;
    f32x4 acc[2][2][4][2];
#pragma unroll
    for (int a = 0; a < 2; ++a)
#pragma unroll
        for (int b = 0; b < 2; ++b)
#pragma unroll
            for (int m = 0; m < 4; ++m)
#pragma unroll
                for (int n = 0; n < 2; ++n) acc[a][b][m][n] = (f32x4){0.f, 0.f, 0.f, 0.f};
    bf16x8 At[4][2], B0[2][2], B1[2][2];
    const char* cA = (const char*)g.A + (size_t)cur.pm * tstep; const char* cB = (const char*)g.Bt + (size_t)cur.pn * tstep;
    S.a_ready(cur);
    if constexpr (SP2) {
        PG8_STAGE(PG8_SB(0, 0), cB, voffB); PG8_STAGE(PG8_SB(0, 1), cB + hstep, voffB); PG8_STAGE(PG8_SA(0, 0), cA, voffA); PG8_STAGE(PG8_SA(0, 1), cA + hstep, voffA);
        if (wr == 1) PG8_BAR;
        PG8_WAIT_V(2); PG8_BAR;
        PG8_STAGE(PG8_SB(1, 0), cB + kstep, voffB); PG8_STAGE(PG8_SA(1, 0), cA + kstep, voffA); PG8_STAGE(PG8_SB(1, 1), cB + hstep + kstep, voffB);
        PG8_WAIT_V(6); PG8_BAR;
    } else {
        PG8_STAGE(PG8_SB(0, 0), cB, voffB); PG8_STAGE(PG8_SA(0, 0), cA, voffA); PG8_STAGE(PG8_SB(0, 1), cB + hstep, voffB); PG8_STAGE(PG8_SA(0, 1), cA + hstep, voffA);
        if (wr == 1) PG8_BAR;
        PG8_WAIT_V(4); PG8_BAR;
        PG8_STAGE(PG8_SB(1, 0), cB + kstep, voffB); PG8_STAGE(PG8_SA(1, 0), cA + kstep, voffA); PG8_STAGE(PG8_SB(1, 1), cB + hstep + kstep, voffB);
        PG8_WAIT_V(6); PG8_BAR;
    }
    for (;;) {
        const bool has_next = S.next(ui + 1, nxt);
        const char* nA = has_next ? (const char*)g.A + (size_t)nxt.pm * tstep : cA; const char* nB = has_next ? (const char*)g.Bt + (size_t)nxt.pn * tstep : cB;
        for (int t = 0; t < nt; t += 2) {
            const bool last = (t == nt - 2);
            const char* a1 = cA + (size_t)(t + 1) * kstep;
            const char* a2 = last ? nA : cA + (size_t)(t + 2) * kstep; const char* b2 = last ? nB : cB + (size_t)(t + 2) * kstep;
            const char* a3 = a2 + kstep; const char* b3 = b2 + kstep;
            if (last && has_next) S.a_ready(nxt);
            if constexpr (SP2) {
            PG8_LDB(B0, 0, 0); PG8_LDB(B1, 0, 1); PG8_SCHED; PG8_LDA(At, 0, 0); PG8_STAGE(PG8_SA(1, 1), a1 + hstep, voffA);
            PG8_WAIT_V(8); PG8_WAIT_L(0); PG8_BAR; PG8_MMA(0, 0, At, B0); PG8_MMA(0, 1, At, B1); PG8_BAR; PG8_SCHED;
            PG8_LDA(At, 0, 1); PG8_STAGE(PG8_SB(0, 0), b2, voffB); PG8_STAGE(PG8_SB(0, 1), b2 + hstep, voffB); PG8_STAGE(PG8_SA(0, 0), a2, voffA);
            PG8_WAIT_V(8); PG8_WAIT_L(0); PG8_BAR; PG8_MMA(1, 0, At, B0); PG8_MMA(1, 1, At, B1); PG8_BAR; PG8_SCHED;
            PG8_LDB(B0, 1, 0); PG8_LDB(B1, 1, 1); PG8_SCHED; PG8_LDA(At, 1, 0); PG8_STAGE(PG8_SA(0, 1), a2 + hstep, voffA);
            PG8_WAIT_V(8); PG8_WAIT_L(0); PG8_BAR; PG8_MMA(0, 0, At, B0); PG8_MMA(0, 1, At, B1); PG8_BAR; PG8_SCHED;
            PG8_LDA(At, 1, 1); PG8_STAGE(PG8_SB(1, 0), b3, voffB); PG8_STAGE(PG8_SB(1, 1), b3 + hstep, voffB); PG8_STAGE(PG8_SA(1, 0), a3, voffA);
            PG8_WAIT_V(8); PG8_WAIT_L(0); PG8_BAR; PG8_MMA(1, 0, At, B0); PG8_MMA(1, 1, At, B1); PG8_BAR; PG8_SCHED;
            } else {
            PG8_LDB(B0, 0, 0); PG8_SCHED; PG8_LDA(At, 0, 0); PG8_STAGE(PG8_SA(1, 1), a1 + hstep, voffA);
            PG8_WAIT_L(8); PG8_BAR; PG8_WAIT_L(0); PG8_MMA(0, 0, At, B0); PG8_BAR; PG8_SCHED;
            PG8_LDB(B1, 0, 1); PG8_STAGE(PG8_SB(0, 0), b2, voffB);
            PG8_BAR; PG8_WAIT_L(0); PG8_MMA(0, 1, At, B1); PG8_BAR;
            PG8_LDA(At, 0, 1); PG8_STAGE(PG8_SA(0, 0), a2, voffA);
            PG8_BAR; PG8_WAIT_L(0); PG8_MMA(1, 0, At, B0); PG8_BAR; PG8_SCHED;
            PG8_STAGE(PG8_SB(0, 1), b2 + hstep, voffB);
            PG8_WAIT_V(6); PG8_BAR; PG8_MMA(1, 1, At, B1); PG8_BAR;
            PG8_LDB(B0, 1, 0); PG8_SCHED; PG8_LDA(At, 1, 0); PG8_STAGE(PG8_SA(0, 1), a2 + hstep, voffA);
            PG8_WAIT_L(8); PG8_BAR; PG8_WAIT_L(0); PG8_MMA(0, 0, At, B0); PG8_BAR; PG8_SCHED;
            PG8_LDB(B1, 1, 1); PG8_STAGE(PG8_SB(1, 0), b3, voffB);
            PG8_BAR; PG8_WAIT_L(0); PG8_MMA(0, 1, At, B1); PG8_BAR;
            PG8_LDA(At, 1, 1); PG8_STAGE(PG8_SA(1, 0), a3, voffA);
            PG8_BAR; PG8_WAIT_L(0); PG8_MMA(1, 0, At, B0); PG8_BAR; PG8_SCHED;
            PG8_STAGE(PG8_SB(1, 1), b3 + hstep, voffB);
            PG8_WAIT_V(6); PG8_BAR; PG8_MMA(1, 1, At, B1); PG8_BAR;
            }
        }
        if constexpr (ALIGN_EPI) { if (wr == 0) PG8_BAR; }
        if constexpr (!Epi::AFTER_DRAIN) { E(acc, cur, wr, wc, fr, fq); S.done(cur); }
        if (!has_next) break;
#pragma unroll
        for (int a = 0; a < 2; ++a)
#pragma unroll
            for (int b = 0; b < 2; ++b)
#pragma unroll
                for (int m = 0; m < 4; ++m)
#pragma unroll
                    for (int n = 0; n < 2; ++n) acc[a][b][m][n] = (f32x4){0.f, 0.f, 0.f, 0.f};
        cur = nxt; cA = nA; cB = nB; ++ui;
        if constexpr (ALIGN_EPI) { if (wr == 1) PG8_BAR; }
    }
    PG8_WAIT_V(0);
    if constexpr (!ALIGN_EPI) { if (wr == 0) PG8_BAR; }
    PG8_BAR;
    if constexpr (Epi::AFTER_DRAIN) { E.fused(acc, cur, wr, wc, fr, fq, lds, wid, lane); S.done(cur); }
#undef PG8_SA
#undef PG8_SB
#undef PG8_STAGE
#undef PG8_LDA
#undef PG8_LDB
#undef PG8_MMA
#undef PG8_WAIT_V
#undef PG8_WAIT_L
#undef PG8_BAR
#undef PG8_SCHED
}
}
constexpr int RPT = 8;

__global__ void k_prep_x(const float* __restrict__ xp, const float* __restrict__ xs, float* XF, bf16_t* XB) {
    size_t i = (size_t)blockIdx.x * 256 + threadIdx.x;
    if (i >= (size_t)M * D) return;
    const size_t np = (size_t)MP * D;
    float v = i < np ? xp[i] : xs[i - np];
    XF[i] = v; XB[i] = f2bf(v);
}

__global__ void __launch_bounds__(256) k_in_naive(const bf16_t* __restrict__ XB, const float* __restrict__ W, bf16_t* P) {
    const int n = blockIdx.x * 256 + threadIdx.x;
    const int m0 = blockIdx.y * RPT;
    const int wc = n < 5920 ? n : (n < 6144 ? -1 : n - 224);
    float acc[RPT];
#pragma unroll
    for (int i = 0; i < RPT; ++i) acc[i] = 0.f;
    if (wc >= 0) {
        for (int k = 0; k < D; ++k) {
            const float w = W[(size_t)k * IN_COLS + wc];
#pragma unroll
            for (int i = 0; i < RPT; ++i) acc[i] += bf2f(XB[(size_t)(m0 + i) * D + k]) * w;
        }
    }
#pragma unroll
    for (int i = 0; i < RPT; ++i) {
        float v = acc[i];
        if (n >= CG) v = sigmoidf_(v);
        P[(size_t)(m0 + i) * NP + n] = f2bf(v);
    }
}

__global__ void __launch_bounds__(256) k_out_naive(const bf16_t* __restrict__ A, const float* __restrict__ W, const float* __restrict__ XF, float* Z) {
    const int n = blockIdx.x * 256 + threadIdx.x;
    const int m0 = blockIdx.y * RPT;
    float acc[RPT];
#pragma unroll
    for (int i = 0; i < RPT; ++i) acc[i] = 0.f;
    for (int k = 0; k < D; ++k) {
        const float w = W[(size_t)k * D + n];
#pragma unroll
        for (int i = 0; i < RPT; ++i) acc[i] += bf2f(A[(size_t)(m0 + i) * D + k]) * w;
    }
#pragma unroll
    for (int i = 0; i < RPT; ++i) Z[(size_t)(m0 + i) * D + n] = ALPHA * XF[(size_t)(m0 + i) * D + n] + acc[i];
}

__global__ void __launch_bounds__(256) k_gu_naive(const bf16_t* __restrict__ A, const float* __restrict__ W, bf16_t* H) {
    const int j = blockIdx.x * 256 + threadIdx.x;
    const int m0 = blockIdx.y * RPT;
    float ag[RPT], au[RPT];
#pragma unroll
    for (int i = 0; i < RPT; ++i) { ag[i] = 0.f; au[i] = 0.f; }
    for (int k = 0; k < D; ++k) {
        const float wg = W[(size_t)k * (2 * DFF) + j], wu = W[(size_t)k * (2 * DFF) + DFF + j];
#pragma unroll
        for (int i = 0; i < RPT; ++i) { const float a = bf2f(A[(size_t)(m0 + i) * D + k]); ag[i] += a * wg; au[i] += a * wu; }
    }
#pragma unroll
    for (int i = 0; i < RPT; ++i) { const float g = ag[i]; H[(size_t)(m0 + i) * DFF + j] = f2bf(g * sigmoidf_(g) * au[i]); }
}

__global__ void __launch_bounds__(256) k_down_naive(const bf16_t* __restrict__ A, const float* __restrict__ W, const float* __restrict__ XF, float* Z) {
    const int n = blockIdx.x * 256 + threadIdx.x;
    const int m0 = blockIdx.y * RPT;
    float acc[RPT];
#pragma unroll
    for (int i = 0; i < RPT; ++i) acc[i] = 0.f;
    for (int k = 0; k < DFF; ++k) {
        const float w = W[(size_t)k * D + n];
#pragma unroll
        for (int i = 0; i < RPT; ++i) acc[i] += bf2f(A[(size_t)(m0 + i) * DFF + k]) * w;
    }
#pragma unroll
    for (int i = 0; i < RPT; ++i) Z[(size_t)(m0 + i) * D + n] = ALPHA * XF[(size_t)(m0 + i) * D + n] + acc[i];
}

__global__ void __launch_bounds__(256) k_ln(const float* __restrict__ Z, const float* __restrict__ g, const float* __restrict__ b, float* OF, bf16_t* OB) {
    const int lane = threadIdx.x & 63, m = blockIdx.x * 4 + (threadIdx.x >> 6);
    const float* z = Z + (size_t)m * D;
    float v[16]; float s = 0.f;
#pragma unroll
    for (int j = 0; j < 16; ++j) { v[j] = z[j * 64 + lane]; s += v[j]; }
    const float mean = wave_sum(s) * (1.f / D);
    float q = 0.f;
#pragma unroll
    for (int j = 0; j < 16; ++j) { v[j] -= mean; q += v[j] * v[j]; }
    const float rstd = rsqrtf(wave_sum(q) * (1.f / D) + LN_EPS);
#pragma unroll
    for (int j = 0; j < 16; ++j) {
        const int c = j * 64 + lane;
        const float y = v[j] * rstd * g[c] + b[c];
        OF[(size_t)m * D + c] = y;
        if (OB) OB[(size_t)m * D + c] = f2bf(y);
    }
}

__global__ void __launch_bounds__(256) k_attn_naive(const bf16_t* __restrict__ P, const float* __restrict__ ck, const float* __restrict__ cv,
                                                    const float* __restrict__ sinks, bf16_t* OA) {
    const int idx = blockIdx.x * 256 + threadIdx.x;
    const int m = idx >> 4, h = idx & 15;
    if (m >= M) return;
    const int c = h >> 2;
    const float slope = exp2f(-0.5f * (float)(h + 1));
    float q[64], o[64];
#pragma unroll
    for (int d = 0; d < 64; ++d) { q[d] = bf2f(P[(size_t)m * NP + CQ + 64 * h + d]) * 0.125f; o[d] = 0.f; }
    float mx = sinks[h], l = 1.f;
    if (m < MP) {
        const int b = m / SEQ, t = m % SEQ;
        const int p0 = t - 127 < 0 ? 0 : t - 127;
        for (int pos = p0; pos <= t; ++pos) {
            const bf16_t* kr = P + (size_t)(b * SEQ + pos) * NP + CK + 64 * c;
            const bf16_t* vr = P + (size_t)(b * SEQ + pos) * NP + CV + 64 * c;
            float s = 0.f;
#pragma unroll
            for (int d = 0; d < 64; ++d) s += q[d] * bf2f(kr[d]);
            s -= slope * (float)(t - pos);
            const float mn = fmaxf(mx, s), sc = __expf(mx - mn), e = __expf(s - mn);
            l = l * sc + e; mx = mn;
#pragma unroll
            for (int d = 0; d < 64; ++d) o[d] = o[d] * sc + e * bf2f(vr[d]);
        }
    } else {
        const int b = (m - MP) / DSEQ, t = (m - MP) % DSEQ;
        for (int s_ = t + 1; s_ <= t + 128; ++s_) {
            float s = 0.f; float vv[64];
            if (s_ < 128) {
                const float* kr = ck + ((size_t)(b * 128 + s_) * 4 + c) * 64;
                const float* vr = cv + ((size_t)(b * 128 + s_) * 4 + c) * 64;
#pragma unroll
                for (int d = 0; d < 64; ++d) { s += q[d] * kr[d]; vv[d] = vr[d]; }
            } else {
                const bf16_t* kr = P + (size_t)(MP + b * DSEQ + (s_ - 128)) * NP + CK + 64 * c;
                const bf16_t* vr = P + (size_t)(MP + b * DSEQ + (s_ - 128)) * NP + CV + 64 * c;
#pragma unroll
                for (int d = 0; d < 64; ++d) { s += q[d] * bf2f(kr[d]); vv[d] = bf2f(vr[d]); }
            }
            s -= slope * (float)(128 + t - s_);
            const float mn = fmaxf(mx, s), sc = __expf(mx - mn), e = __expf(s - mn);
            l = l * sc + e; mx = mn;
#pragma unroll
            for (int d = 0; d < 64; ++d) o[d] = o[d] * sc + e * vv[d];
        }
    }
    const float inv = 1.f / l;
#pragma unroll
    for (int d = 0; d < 64; ++d) OA[(size_t)m * D + 64 * h + d] = f2bf(o[d] * inv);
}

__global__ void __launch_bounds__(64) k_wkv_naive(const bf16_t* __restrict__ P, const float* __restrict__ mu, const float* __restrict__ w0, const float* __restrict__ wup,
                                                  const float* __restrict__ a0, const float* __restrict__ aup, const float* __restrict__ gup, const float* __restrict__ rwkk,
                                                  const float* __restrict__ rwka, const float* __restrict__ rk, const float* __restrict__ lnw, const float* __restrict__ lnb,
                                                  const float* __restrict__ shift0, const float* __restrict__ s0, bf16_t* OC, float* out_p, float* out_s) {
    __shared__ float s_lw[64], s_la[64], s_lg[160], s_w[64], s_kk[64], s_b[64], s_k[64], s_r[64];
    const int seq = blockIdx.x >> 4, h = blockIdx.x & 15, j = threadIdx.x, c = 64 * h + j;
    int row0, T; const float* sh0 = nullptr; float* outS;
    float S[64];
    if (seq < NBATCH) { row0 = seq * SEQ; T = SEQ; outS = out_p + ((size_t)(seq * 16 + h) * 64 + j) * 64;
#pragma unroll
        for (int i = 0; i < 64; ++i) S[i] = 0.f;
    } else { const int b = seq - NBATCH; row0 = MP + b * DSEQ; T = DSEQ; sh0 = shift0 + (size_t)b * SHIFT_W; outS = out_s + ((size_t)(b * 16 + h) * 64 + j) * 64;
        const float* sp = s0 + ((size_t)(b * 16 + h) * 64 + j) * 64;
#pragma unroll
        for (int i = 0; i < 64; ++i) S[i] = sp[i];
    }
    const float w0c = w0[c], a0c = a0[c], kkc = rwkk[c], kac = rwka[c], rkc = rk[c], lnwc = lnw[c], lnbc = lnb[c];
    for (int t = 0; t < T; ++t) {
        const size_t m = (size_t)row0 + t;
        const bf16_t* pr = P + m * NP + CRW;
        const bf16_t* pp = P + (m - 1) * NP + CRW;
        auto shifted = [&](int ch) -> float {
            const float pc = bf2f(pr[ch]);
            const float pv = t == 0 ? (sh0 ? sh0[ch] : 0.f) : bf2f(pp[ch]);
            return pc + mu[ch] * (pv - pc);
        };
        for (int i = j; i < 288; i += 64) {
            const float ps = shifted(3072 + i);
            if (i < 64) s_lw[i] = tanhf(ps); else if (i < 128) s_la[i - 64] = ps; else s_lg[i - 128] = sigmoidf_(ps);
        }
        const float r = shifted(c), k = shifted(1024 + c), v = shifted(2048 + c);
        __syncthreads();
        float accw = w0c, acca = a0c, accg = 0.f;
        for (int i = 0; i < 64; ++i) { accw += s_lw[i] * wup[i * D + c]; acca += s_la[i] * aup[i * D + c]; }
        for (int i = 0; i < 160; ++i) accg += s_lg[i] * gup[i * D + c];
        const float wlog = -softplusf_(-accw) - 0.5f;
        const float decay = __expf(-__expf(wlog));
        const float a = sigmoidf_(acca);
        float kk = k * kkc;
        const float nrm = sqrtf(wave_sum(kk * kk));
        kk = kk / fmaxf(nrm, 1e-12f);
        const float k2 = k * (1.f + (a - 1.f) * kac);
        const float bdot = wave_sum(r * k2 * rkc);
        s_w[j] = decay; s_kk[j] = kk; s_b[j] = kk * a; s_k[j] = k2; s_r[j] = r;
        __syncthreads();
        float sa = 0.f;
#pragma unroll
        for (int i = 0; i < 64; ++i) sa -= S[i] * s_kk[i];
        float y = 0.f;
#pragma unroll
        for (int i = 0; i < 64; ++i) { S[i] = S[i] * s_w[i] + sa * s_b[i] + v * s_k[i]; y += S[i] * s_r[i]; }
        const float mean = wave_sum(y) * (1.f / 64.f);
        const float dy = y - mean;
        const float var = wave_sum(dy * dy) * (1.f / 64.f);
        const float yn = dy * rsqrtf(var + GN_EPS) * lnwc + lnbc;
        OC[m * D + c] = f2bf((yn + bdot * v) * accg);
        __syncthreads();
    }
#pragma unroll
    for (int i = 0; i < 64; ++i) outS[i] = S[i];
}

__global__ void __launch_bounds__(64) k_rglru_naive(const bf16_t* __restrict__ P, const float* __restrict__ cw, const float* __restrict__ cb, const float* __restrict__ wa,
                                                    const float* __restrict__ ba, const float* __restrict__ wx, const float* __restrict__ bx, const float* __restrict__ lam,
                                                    const float* __restrict__ conv0, const float* __restrict__ h0, bf16_t* OB,
                                                    float* out_pconv, float* out_ph, float* out_sconv, float* out_sh) {
    __shared__ float s_xc[64];
    const int seq = blockIdx.x >> 4, bk = blockIdx.x & 15, j = threadIdx.x, c = 64 * bk + j;
    int row0, T; float x1 = 0.f, x2 = 0.f, x3 = 0.f, h = 0.f; float *oc, *oh;
    if (seq < NBATCH) { row0 = seq * SEQ; T = SEQ; oc = out_pconv + (size_t)seq * 3 * D; oh = out_ph + (size_t)seq * D; }
    else { const int b = seq - NBATCH; row0 = MP + b * DSEQ; T = DSEQ; oc = out_sconv + (size_t)b * 3 * D; oh = out_sh + (size_t)b * D;
        x3 = conv0[((size_t)b * 3 + 0) * D + c]; x2 = conv0[((size_t)b * 3 + 1) * D + c]; x1 = conv0[((size_t)b * 3 + 2) * D + c]; h = h0[(size_t)b * D + c]; }
    float war[64], wxr[64];
#pragma unroll
    for (int i = 0; i < 64; ++i) { war[i] = wa[((size_t)bk * 64 + i) * 64 + j]; wxr[i] = wx[((size_t)bk * 64 + i) * 64 + j]; }
    const float c0 = cw[0 * D + c], c1 = cw[1 * D + c], c2 = cw[2 * D + c], c3 = cw[3 * D + c], cbc = cb[c], bac = ba[c], bxc = bx[c];
    const float spl = softplusf_(-lam[c]);
    for (int t = 0; t < T; ++t) {
        const size_t m = (size_t)row0 + t;
        const float x = bf2f(P[m * NP + CRNN + c]);
        const float xc = cbc + c0 * x3 + c1 * x2 + c2 * x1 + c3 * x;
        s_xc[j] = xc;
        __syncthreads();
        float r = bac, ig = bxc;
#pragma unroll
        for (int i = 0; i < 64; ++i) { const float xi = s_xc[i]; r += xi * war[i]; ig += xi * wxr[i]; }
        r = sigmoidf_(r); ig = sigmoidf_(ig);
        const float log_a = -8.f * r * spl;
        const float a = __expf(log_a);
        const float u = sqrtf(-expm1f(2.f * log_a)) * (ig * xc);
        h = a * h + u;
        OB[m * D + c] = f2bf(h);
        x3 = x2; x2 = x1; x1 = x;
        __syncthreads();
    }
    oh[c] = h; oc[0 * D + c] = x3; oc[1 * D + c] = x2; oc[2 * D + c] = x1;
}

__global__ void k_mix(const bf16_t* __restrict__ P, const bf16_t* __restrict__ OA, const bf16_t* __restrict__ OB, const bf16_t* __restrict__ OC, bf16_t* MIX) {
    size_t i = (size_t)blockIdx.x * 256 + threadIdx.x;
    if (i >= (size_t)M * D) return;
    const size_t m = i / D; const int c = (int)(i % D);
    const bf16_t* pg = P + m * NP + CG + c;
    const float v = bf2f(pg[0]) * bf2f(OA[i]) + bf2f(pg[1024]) * bf2f(OB[i]) + bf2f(pg[2048]) * bf2f(OC[i]);
    MIX[i] = f2bf(v);
}

__global__ void k_states(const bf16_t* __restrict__ P, const float* __restrict__ ck, const float* __restrict__ cv,
                         float* pk, float* pv, float* pshift, float* sk, float* sv, float* sshift) {
    const size_t i = (size_t)blockIdx.x * 256 + threadIdx.x;
    const size_t n_pk = (size_t)NBATCH * 128 * 256, n_sk = (size_t)DBATCH * 128 * 256, n_ps = (size_t)NBATCH * SHIFT_W, n_ss = (size_t)DBATCH * SHIFT_W;
    if (i < n_pk) {
        const int b = (int)(i / (128 * 256)), s = (int)((i / 256) % 128), e = (int)(i % 256);
        const size_t row = (size_t)b * SEQ + (SEQ - 128) + s;
        pk[i] = bf2f(P[row * NP + CK + e]); pv[i] = bf2f(P[row * NP + CV + e]);
        return;
    }
    size_t k = i - n_pk;
    if (k < n_sk) {
        const int b = (int)(k / (128 * 256)), s = (int)((k / 256) % 128), e = (int)(k % 256);
        if (s < 120) { sk[k] = ck[((size_t)b * 128 + s + 8) * 256 + e]; sv[k] = cv[((size_t)b * 128 + s + 8) * 256 + e]; }
        else { const size_t row = (size_t)MP + b * DSEQ + (s - 120); sk[k] = bf2f(P[row * NP + CK + e]); sv[k] = bf2f(P[row * NP + CV + e]); }
        return;
    }
    k -= n_sk;
    if (k < n_ps) { const int b = (int)(k / SHIFT_W), ch = (int)(k % SHIFT_W); pshift[k] = bf2f(P[((size_t)b * SEQ + SEQ - 1) * NP + CRW + ch]); return; }
    k -= n_ps;
    if (k < n_ss) { const int b = (int)(k / SHIFT_W), ch = (int)(k % SHIFT_W); sshift[k] = bf2f(P[((size_t)MP + b * DSEQ + DSEQ - 1) * NP + CRW + ch]); return; }
}


#include <hip/hip_cooperative_groups.h>
namespace cg = cooperative_groups;
#define LAS __attribute__((address_space(3)))
typedef float f32x4 __attribute__((ext_vector_type(4)));
typedef unsigned u32x4 __attribute__((ext_vector_type(4)));
typedef unsigned u32x2 __attribute__((ext_vector_type(2)));

constexpr int NTHREADS = 512, NWAVES = 8;
constexpr int LDS_BYTES = 147456;

constexpr int PH_PREP = 0, PH_PER_LAYER = 8, PH_L0 = 1;
constexpr int PHO_IN = 0, PHO_MIXA = 1, PHO_MIXB = 2, PHO_OUT = 3, PHO_LN1 = 4, PHO_GU = 5, PHO_DOWN = 6, PHO_LN2 = 7;
constexpr int N_PHASES = PH_L0 + DEPTH * PH_PER_LAYER;

struct Args { const float* in[35]; float* out; unsigned char* ws; int ph_lo, ph_hi; };

__device__ __forceinline__ unsigned pk2bf(float lo, float hi) { return pg8::cvt_pk_bf16(lo, hi); }

struct EpiIn {
    static constexpr bool PERM = true, AFTER_DRAIN = false;
    bf16_t* O; int ldc; int sig_pn;
    __device__ __forceinline__ void operator()(const f32x4 (&acc)[2][2][4][2], const pg8::Unit& u, int wr, int wc, int fr, int fq) const {
        const int row0 = u.pm * 256 + wr * 64 + fr, col0 = u.pn * 256 + wc * 32 + 8 * fq;
        const bool sg = u.pn >= sig_pn;
#pragma unroll
        for (int ai = 0; ai < 2; ++ai)
#pragma unroll
            for (int m = 0; m < 4; ++m) {
                bf16_t* rowp = O + (size_t)(row0 + ai * 128 + m * 16) * ldc + col0;
#pragma unroll
                for (int bj = 0; bj < 2; ++bj) {
                    f32x4 v0 = acc[ai][bj][m][0], v1 = acc[ai][bj][m][1];
                    if (sg) {
#pragma unroll
                        for (int i = 0; i < 4; ++i) { v0[i] = sigmoidf_(v0[i]); v1[i] = sigmoidf_(v1[i]); }
                    }
                    u32x4 w; w.x = pk2bf(v0[0], v0[1]); w.y = pk2bf(v0[2], v0[3]); w.z = pk2bf(v1[0], v1[1]); w.w = pk2bf(v1[2], v1[3]);
                    *(u32x4*)(rowp + bj * 128) = w;
                }
                asm volatile("" ::: "memory");
            }
    }
};
struct EpiRes {
    static constexpr bool PERM = false, AFTER_DRAIN = false;
    const float* res; float* Z; int ldc;
    __device__ __forceinline__ void operator()(const f32x4 (&acc)[2][2][4][2], const pg8::Unit& u, int wr, int wc, int fr, int fq) const {
        const int col0 = u.pn * 256 + wc * 32 + 4 * fq;
#pragma unroll
        for (int ai = 0; ai < 2; ++ai)
#pragma unroll
            for (int m = 0; m < 4; ++m) {
                const size_t off = (size_t)(u.pm * 256 + ai * 128 + wr * 64 + m * 16 + fr) * ldc + col0;
#pragma unroll
                for (int bj = 0; bj < 2; ++bj)
#pragma unroll
                    for (int n = 0; n < 2; ++n) {
                        const f32x4 r = *(const f32x4*)(res + off + bj * 128 + n * 16);
                        *(f32x4*)(Z + off + bj * 128 + n * 16) = r * ALPHA + acc[ai][bj][m][n];
                    }
                asm volatile("" ::: "memory");
            }
    }
};
struct EpiSwiGLU {
    static constexpr bool PERM = true, AFTER_DRAIN = false;
    bf16_t* H; int ldc;
    __device__ __forceinline__ void operator()(const f32x4 (&acc)[2][2][4][2], const pg8::Unit& u, int wr, int wc, int fr, int fq) const {
        const int row0 = u.pm * 256 + wr * 64 + fr, col0 = u.pn * 128 + wc * 32 + 8 * fq;
#pragma unroll
        for (int ai = 0; ai < 2; ++ai)
#pragma unroll
            for (int m = 0; m < 4; ++m) {
                bf16_t* rowp = H + (size_t)(row0 + ai * 128 + m * 16) * ldc + col0;
                float o[8];
#pragma unroll
                for (int n = 0; n < 2; ++n)
#pragma unroll
                    for (int i = 0; i < 4; ++i) { const float g = acc[ai][0][m][n][i], up = acc[ai][1][m][n][i]; o[n * 4 + i] = g * sigmoidf_(g) * up; }
                u32x4 w; w.x = pk2bf(o[0], o[1]); w.y = pk2bf(o[2], o[3]); w.z = pk2bf(o[4], o[5]); w.w = pk2bf(o[6], o[7]);
                *(u32x4*)rowp = w;
                asm volatile("" ::: "memory");
            }
    }
};

template <int MODE> __device__ __forceinline__ int colmap(int n) {
    if (MODE == 0) return n < 5920 ? n : (n < 6144 ? -1 : n - 224);
    if (MODE == 2) { const int pn = n >> 8, q = n & 255; return q < 128 ? pn * 128 + q : DFF + pn * 128 + (q - 128); }
    return n;
}
template <int MODE> __device__ __forceinline__ void transpose_item(const float* __restrict__ W, int K, int ldw, bf16_t* WT, int item, int nblk, LAS float* tile, int tid) {
    const int kb = item / nblk, nb = item % nblk, k0 = kb * 64, n0 = nb * 64;
    {
        const int nn = tid & 63; const int col = colmap<MODE>(n0 + nn);
#pragma unroll
        for (int i = 0; i < 8; ++i) { const int kk = i * 8 + (tid >> 6); tile[kk * 65 + nn] = col >= 0 ? W[(size_t)(k0 + kk) * ldw + col] : 0.f; }
    }
    __syncthreads();
    {
        const int nn = tid >> 3, c = tid & 7; const LAS float* s = tile + (8 * c) * 65 + nn;
        u32x4 o; o.x = pk2bf(s[0], s[65]); o.y = pk2bf(s[2 * 65], s[3 * 65]); o.z = pk2bf(s[4 * 65], s[5 * 65]); o.w = pk2bf(s[6 * 65], s[7 * 65]);
        *(u32x4*)(WT + (size_t)(n0 + nn) * K + k0 + 8 * c) = o;
    }
    __syncthreads();
}
__device__ __forceinline__ void phase_prep(const Args& a, LAS unsigned char* lds) {
    const int tid = threadIdx.x, G = gridDim.x, bx = blockIdx.x;
    LAS float* tile = (LAS float*)lds;
    constexpr int I_IN = (D / 64) * (NP / 64), I_OUT = (D / 64) * (D / 64), I_GU = (D / 64) * (2 * DFF / 64), I_DN = (DFF / 64) * (D / 64);
    constexpr int I_LAYER = I_IN + I_OUT + I_GU + I_DN;
    for (int it = bx; it < DEPTH * I_LAYER; it += G) {
        const int l = it / I_LAYER; int r = it % I_LAYER;
        if (r < I_IN) { transpose_item<0>(a.in[8] + (size_t)l * D * IN_COLS, D, IN_COLS, (bf16_t*)(a.ws + WS_WIN + l * WIN_T_BYTES), r, NP / 64, tile, tid); continue; } r -= I_IN;
        if (r < I_OUT) { transpose_item<1>(a.in[28] + (size_t)l * D * D, D, D, (bf16_t*)(a.ws + WS_WOUT + l * WOUT_T_BYTES), r, D / 64, tile, tid); continue; } r -= I_OUT;
        if (r < I_GU) { transpose_item<2>(a.in[31] + (size_t)l * D * 2 * DFF, D, 2 * DFF, (bf16_t*)(a.ws + WS_WGU + l * WGU_T_BYTES), r, 2 * DFF / 64, tile, tid); continue; } r -= I_GU;
        transpose_item<1>(a.in[32] + (size_t)l * DFF * D, DFF, D, (bf16_t*)(a.ws + WS_WDN + l * WDN_T_BYTES), r, D / 64, tile, tid);
    }
    float* XF = (float*)(a.ws + WS_XF); bf16_t* XB = (bf16_t*)(a.ws + WS_XB);
    const size_t n4 = (size_t)M * D / 4, np4 = (size_t)MP * D / 4;
    for (size_t i = (size_t)bx * NTHREADS + tid; i < n4; i += (size_t)G * NTHREADS) {
        const f32x4 v = i < np4 ? ((const f32x4*)a.in[0])[i] : ((const f32x4*)a.in[1])[i - np4];
        ((f32x4*)XF)[i] = v;
        u32x2 w; w.x = pk2bf(v[0], v[1]); w.y = pk2bf(v[2], v[3]);
        ((u32x2*)XB)[i] = w;
    }
}

__device__ __forceinline__ void phase_ln(const float* __restrict__ Z, const float* __restrict__ g, const float* __restrict__ b, float* OF, bf16_t* OB) {
    const int lane = threadIdx.x & 63, wv = threadIdx.x >> 6;
    f32x4 gv[4], bv[4];
#pragma unroll
    for (int j = 0; j < 4; ++j) { gv[j] = ((const f32x4*)g)[j * 64 + lane]; bv[j] = ((const f32x4*)b)[j * 64 + lane]; }
    for (int m = blockIdx.x * NWAVES + wv; m < M; m += gridDim.x * NWAVES) {
        const f32x4* z = (const f32x4*)(Z + (size_t)m * D);
        f32x4 v[4]; float s = 0.f;
#pragma unroll
        for (int j = 0; j < 4; ++j) { v[j] = z[j * 64 + lane]; s += (v[j][0] + v[j][1]) + (v[j][2] + v[j][3]); }
        const float mean = wave_sum(s) * (1.f / D);
        float q = 0.f;
#pragma unroll
        for (int j = 0; j < 4; ++j) { v[j] = v[j] - mean; q += (v[j][0] * v[j][0] + v[j][1] * v[j][1]) + (v[j][2] * v[j][2] + v[j][3] * v[j][3]); }
        const float rstd = rsqrtf(wave_sum(q) * (1.f / D) + LN_EPS);
#pragma unroll
        for (int j = 0; j < 4; ++j) {
            const f32x4 y = v[j] * rstd * gv[j] + bv[j];
            ((f32x4*)(OF + (size_t)m * D))[j * 64 + lane] = y;
            if (OB) { u32x2 w; w.x = pk2bf(y[0], y[1]); w.y = pk2bf(y[2], y[3]); ((u32x2*)(OB + (size_t)m * D))[j * 64 + lane] = w; }
        }
    }
}

#define PH_IN(k) (lo <= (k) && (k) < hi)
#define PH_SYNC(k) do { if (lo < (k) && (k) < hi) cg::this_grid().sync(); } while (0)
template <int L> __device__ __forceinline__ void layer_phases(const Args& a, LAS unsigned char* lds, int lo, int hi) {
    unsigned char* ws = a.ws;
    const int G = gridDim.x;
    constexpr int base = PH_L0 + L * PH_PER_LAYER;
    PH_SYNC(base + PHO_IN);
    if (PH_IN(base + PHO_IN)) {
        pg8::Gemm g{(const bf16_t*)(ws + WS_XB), (const bf16_t*)(ws + WS_WIN + L * WIN_T_BYTES), M, NP, D}; pg8::StaticOrder S; S.init(M, NP, G, (int)blockIdx.x);
        EpiIn E{(bf16_t*)(ws + WS_P), NP, CG / 256};
        pg8::gemm_phase<EpiIn, pg8::StaticOrder, true, true>(lds, g, S, E);
    }
    PH_SYNC(base + PHO_MIXA);
    PH_SYNC(base + PHO_MIXB);
    PH_SYNC(base + PHO_OUT);
    if (PH_IN(base + PHO_OUT)) {
        pg8::Gemm g{(const bf16_t*)(ws + WS_MIX), (const bf16_t*)(ws + WS_WOUT + L * WOUT_T_BYTES), M, D, D}; pg8::StaticOrder S; S.init(M, D, G, (int)blockIdx.x);
        EpiRes E{(const float*)(ws + WS_XF), (float*)(ws + WS_Z), D};
        pg8::gemm_phase<EpiRes, pg8::StaticOrder, true, true>(lds, g, S, E);
    }
    PH_SYNC(base + PHO_LN1);
    if (PH_IN(base + PHO_LN1)) phase_ln((const float*)(ws + WS_Z), a.in[29] + L * D, a.in[30] + L * D, (float*)(ws + WS_X1F), (bf16_t*)(ws + WS_X1B));
    PH_SYNC(base + PHO_GU);
    if (PH_IN(base + PHO_GU)) {
        pg8::Gemm g{(const bf16_t*)(ws + WS_X1B), (const bf16_t*)(ws + WS_WGU + L * WGU_T_BYTES), M, 2 * DFF, D}; pg8::StaticOrder S; S.init(M, 2 * DFF, G, (int)blockIdx.x);
        EpiSwiGLU E{(bf16_t*)(ws + WS_H), DFF};
        pg8::gemm_phase<EpiSwiGLU, pg8::StaticOrder, true, true>(lds, g, S, E);
    }
    PH_SYNC(base + PHO_DOWN);
    if (PH_IN(base + PHO_DOWN)) {
        pg8::Gemm g{(const bf16_t*)(ws + WS_H), (const bf16_t*)(ws + WS_WDN + L * WDN_T_BYTES), M, D, DFF}; pg8::StaticOrder S; S.init(M, D, G, (int)blockIdx.x);
        EpiRes E{(const float*)(ws + WS_X1F), (float*)(ws + WS_Z), D};
        pg8::gemm_phase<EpiRes, pg8::StaticOrder, true, true>(lds, g, S, E);
    }
    PH_SYNC(base + PHO_LN2);
    if (PH_IN(base + PHO_LN2)) {
        if (L == DEPTH - 1) phase_ln((const float*)(ws + WS_Z), a.in[33] + L * D, a.in[34] + L * D, a.out + O_YP, nullptr);
        else phase_ln((const float*)(ws + WS_Z), a.in[33] + L * D, a.in[34] + L * D, (float*)(ws + WS_XF), (bf16_t*)(ws + WS_XB));
    }
}
__global__ void __launch_bounds__(NTHREADS, 2) mega(Args a) {
    extern __shared__ __attribute__((aligned(16))) unsigned char lds_raw[];
    LAS unsigned char* lds = (LAS unsigned char*)lds_raw;
    const int lo = a.ph_lo, hi = a.ph_hi;
    if (PH_IN(PH_PREP)) phase_prep(a, lds);
    layer_phases<0>(a, lds, lo, hi);
    layer_phases<1>(a, lds, lo, hi);
}

static void launch_mega(Args a, int lo, int hi, int grid, hipStream_t s) {
    a.ph_lo = lo; a.ph_hi = hi;
    void* args[] = {&a};
    hipError_t e;
    if (hi - lo > 1) e = hipLaunchCooperativeKernel((void*)mega, dim3(grid), dim3(NTHREADS), args, LDS_BYTES, s);
    else e = hipLaunchKernel((void*)mega, dim3(grid), dim3(NTHREADS), args, LDS_BYTES, s);
    if (e != hipSuccess) fprintf(stderr, "mega launch [%d,%d) failed: %s (grid %d)\n", lo, hi, hipGetErrorString(e), grid);
}

extern "C" void kernel_launch(void* const* d_in, const int* in_sizes, int n_in, void* d_out, int out_size,
                              void* d_ws, size_t ws_size, hipStream_t stream) {
    if (ws_size < WS_END || out_size != (int)O_END || n_in != 35) { fprintf(stderr, "kernel_launch: unexpected sizes ws=%zu out=%d n_in=%d\n", ws_size, out_size, n_in); return; }
    static int grid = 0;
    if (!grid) {
        int dev = 0, cus = 0, per_cu = 0;
        (void)hipGetDevice(&dev);
        (void)hipDeviceGetAttribute(&cus, hipDeviceAttributeMultiprocessorCount, dev);
        (void)hipFuncSetAttribute((const void*)mega, hipFuncAttributeMaxDynamicSharedMemorySize, LDS_BYTES);
        (void)hipOccupancyMaxActiveBlocksPerMultiprocessor(&per_cu, (const void*)mega, NTHREADS, LDS_BYTES);
        if (per_cu < 1) { fprintf(stderr, "occupancy query says %d blocks per CU\n", per_cu); per_cu = 1; }
        grid = cus * per_cu;
    }
    const float* const* in = (const float* const*)d_in;
    unsigned char* ws = (unsigned char*)d_ws;
    float* out = (float*)d_out;
    Args a{};
    for (int i = 0; i < 35; ++i) a.in[i] = in[i];
    a.out = out; a.ws = ws;
    bf16_t* OA = (bf16_t*)(ws + WS_OA); bf16_t* OB = (bf16_t*)(ws + WS_OB); bf16_t* OC = (bf16_t*)(ws + WS_OC); bf16_t* MIX = (bf16_t*)(ws + WS_MIX);
    bf16_t* P = (bf16_t*)(ws + WS_P);
    const int nel = M * D;
    launch_mega(a, PH_PREP, PH_PREP + 1, grid, stream);
    for (int l = 0; l < DEPTH; ++l) {
        const int base = PH_L0 + l * PH_PER_LAYER;
        const float* ck = in[2] + (size_t)l * DBATCH * 128 * 256; const float* cv = in[3] + (size_t)l * DBATCH * 128 * 256;
        const float* conv0 = in[4] + (size_t)l * DBATCH * 3 * D; const float* h0 = in[5] + (size_t)l * DBATCH * D;
        const float* shift0 = in[6] + (size_t)l * DBATCH * SHIFT_W; const float* s0 = in[7] + (size_t)l * DBATCH * 16 * 4096;
        launch_mega(a, base + PHO_IN, base + PHO_IN + 1, grid, stream);
        k_attn_naive<<<M * 16 / 256, 256, 0, stream>>>(P, ck, cv, in[9] + l * 16, OA);
        k_wkv_naive<<<(NBATCH + DBATCH) * 16, 64, 0, stream>>>(P, in[17] + (size_t)l * SHIFT_W, in[18] + l * D, in[19] + (size_t)l * 64 * D, in[20] + l * D, in[21] + (size_t)l * 64 * D,
            in[22] + (size_t)l * 160 * D, in[23] + l * D, in[24] + l * D, in[25] + l * D, in[26] + l * D, in[27] + l * D, shift0, s0, OC,
            out + O_PWKV + (size_t)l * NBATCH * 16 * 4096, out + O_SWKV + (size_t)l * DBATCH * 16 * 4096);
        k_rglru_naive<<<(NBATCH + DBATCH) * 16, 64, 0, stream>>>(P, in[10] + (size_t)l * 4 * D, in[11] + l * D, in[12] + (size_t)l * 16 * 4096, in[13] + l * D, in[14] + (size_t)l * 16 * 4096,
            in[15] + l * D, in[16] + l * D, conv0, h0, OB,
            out + O_PCONV + (size_t)l * NBATCH * 3 * D, out + O_PH + (size_t)l * NBATCH * D, out + O_SCONV + (size_t)l * DBATCH * 3 * D, out + O_SH + (size_t)l * DBATCH * D);
        {
            const size_t tot = (size_t)NBATCH * 128 * 256 + (size_t)DBATCH * 128 * 256 + (size_t)NBATCH * SHIFT_W + (size_t)DBATCH * SHIFT_W;
            k_states<<<(unsigned)((tot + 255) / 256), 256, 0, stream>>>(P, ck, cv, out + O_PK + (size_t)l * NBATCH * 128 * 256, out + O_PV + (size_t)l * NBATCH * 128 * 256,
                out + O_PSHIFT + (size_t)l * NBATCH * SHIFT_W, out + O_SK + (size_t)l * DBATCH * 128 * 256, out + O_SV + (size_t)l * DBATCH * 128 * 256,
                out + O_SSHIFT + (size_t)l * DBATCH * SHIFT_W);
        }
        k_mix<<<(nel + 255) / 256, 256, 0, stream>>>(P, OA, OB, OC, MIX);
        launch_mega(a, base + PHO_OUT, base + PH_PER_LAYER, grid, stream);
    }
}
```

```cpp
#include <hip/hip_runtime.h>
#include <cstdint>
#include <cstdio>

typedef unsigned short bf16_t;
__device__ __forceinline__ float bf2f(bf16_t v) { return __uint_as_float(((unsigned)v) << 16); }
__device__ __forceinline__ bf16_t f2bf(float f) { unsigned u = __float_as_uint(f); return (bf16_t)((u + 0x7fffu + ((u >> 16) & 1u)) >> 16); }
__device__ __forceinline__ float sigmoidf_(float x) { return 1.f / (1.f + __expf(-x)); }
__device__ __forceinline__ float softplusf_(float x) { return fmaxf(x, 0.f) + log1pf(__expf(-fabsf(x))); }
__device__ __forceinline__ float wave_sum(float v) {
#pragma unroll
    for (int o = 1; o < 64; o <<= 1) v += __shfl_xor(v, o);
    return v;
}

constexpr int D = 1024, MP = 16384, MS = 1024, M = MP + MS, SEQ = 8192, DSEQ = 8, NBATCH = 2, DBATCH = 128, DEPTH = 2;
constexpr int NP = 9216, IN_COLS = 8992;
constexpr int CQ = 0, CK = 1024, CV = 1280, CRNN = 1536, CRW = 2560, CG = 6144;
constexpr int SHIFT_W = 3360, DFF = 2816;
constexpr float ALPHA = 1.4142135623730951f;
constexpr float LN_EPS = 1e-5f, GN_EPS = 64e-5f;

constexpr size_t O_YP = 0, O_YS = 16777216, O_PK = 17825792, O_PV = 17956864, O_PCONV = 18087936, O_PH = 18100224,
                 O_PSHIFT = 18104320, O_PWKV = 18117760, O_SK = 18379904, O_SV = 26768512, O_SCONV = 35157120,
                 O_SH = 35943552, O_SSHIFT = 36205696, O_SWKV = 37065856, O_END = 53843072;


constexpr size_t MiB = 1u << 20;
constexpr size_t WS_CTL = 0;
constexpr size_t WIN_T_BYTES = (size_t)NP * D * 2, WOUT_T_BYTES = (size_t)D * D * 2, WGU_T_BYTES = (size_t)2 * DFF * D * 2, WDN_T_BYTES = (size_t)D * DFF * 2;
constexpr size_t WS_WIN = 1 * MiB;
constexpr size_t WS_WOUT = WS_WIN + 2 * WIN_T_BYTES;
constexpr size_t WS_WGU = WS_WOUT + 2 * WOUT_T_BYTES;
constexpr size_t WS_WDN = WS_WGU + 2 * WGU_T_BYTES;
constexpr size_t WS_XB = WS_WDN + 2 * WDN_T_BYTES;
constexpr size_t WS_XF = WS_XB + (size_t)M * D * 2;
constexpr size_t WS_OA = WS_XF + (size_t)M * D * 4;
constexpr size_t WS_MIX = WS_OA;
constexpr size_t WS_OB = WS_OA + (size_t)M * D * 2;
constexpr size_t WS_P = WS_OB + (size_t)M * D * 2;
constexpr size_t WS_Z = WS_P;
constexpr size_t WS_X1F = WS_Z + (size_t)M * D * 4;
constexpr size_t WS_X1B = WS_X1F + (size_t)M * D * 4;
constexpr size_t WS_H = WS_X1B + (size_t)M * D * 2;
constexpr size_t WS_PEND = WS_P + (size_t)M * NP * 2;
constexpr size_t WS_RS = WS_PEND;
constexpr int ACAT_K = 384;
constexpr size_t WS_ACAT = WS_RS + (size_t)2 * 128 * 1024 * 2 * 4;
constexpr size_t WLORA_BYTES = (size_t)3072 * ACAT_K * 2;
constexpr size_t WS_WLORA = WS_ACAT + (size_t)M * ACAT_K * 2;
constexpr size_t WS_WAW = WS_WLORA + 2 * WLORA_BYTES;
constexpr size_t WS_WAA = WS_WAW + (size_t)M * D * 4;
constexpr size_t WS_WAG = WS_WAA + (size_t)M * D * 2;
constexpr size_t WS_Y = WS_WAG + (size_t)M * D * 2;
constexpr size_t WS_OC = WS_Y;
constexpr size_t WS_BD = WS_Y + (size_t)M * D * 4;
constexpr size_t WS_END = WS_BD + (size_t)M * 16 * 4;
static_assert(WS_END <= (size_t)861000000, "workspace budget (4 x output bytes = 861.5 MB)");
static_assert(WS_H + (size_t)M * DFF * 2 <= WS_PEND, "overlay fits");
static_assert(WS_XB % 256 == 0 && WS_P % 256 == 0, "alignment");
namespace pg8 {
#define PG8_LAS __attribute__((address_space(3)))
typedef unsigned short bf16_t;
typedef short bf16x8 __attribute__((ext_vector_type(8)));
typedef float f32x4 __attribute__((ext_vector_type(4)));
typedef unsigned u32x4 __attribute__((ext_vector_type(4)));
constexpr int BM = 256, BK = 64, HALF = 128, HTB = HALF * BK * 2  , STAGE_BYTES = 8 * HTB, NXCD = 8, WGM = 8;

__host__ __device__ __forceinline__ int lds_byte(int r, int c) { const int st = (r >> 4) * 2 + (c >> 5), rr = r & 15, cc = c & 31, ob = rr * 64 + cc * 2; return st * 1024 + (ob ^ (((ob >> 9) & 1) << 5)); }
__host__ __device__ __forceinline__ void stage_rc(int b, int& R, int& C) { const int st = b / 1024, sb = b % 1024, swz = sb ^ (((sb >> 9) & 1) << 5); R = (st >> 1) * 16 + swz / 64; C = (st & 1) * 32 + (swz % 64) / 2; }
__host__ __device__ __forceinline__ int perm32(int rho) { const int n = rho >> 4, i = rho & 15; return 8 * (i >> 2) + 4 * n + (i & 3); }

struct Unit { int pm, pn; };
struct Gemm { const bf16_t* A; const bf16_t* Bt; int M, N, K; };

struct StaticOrder {
    int nM, nN, nwg, G, c;
    __host__ __device__ void init(int M, int N, int G_, int c_) { nM = M / BM; nN = N / BM; nwg = nM * nN; G = G_; c = c_; }
    __host__ __device__ bool next(int i, Unit& u) const {
        const long L = (long)i * G + c; if (L >= nwg) return false;
        int wgid = (int)L; { const int q = nwg / NXCD, r = nwg % NXCD, xcd = wgid % NXCD, off = wgid / NXCD; wgid = (xcd < r ? xcd * (q + 1) : r * (q + 1) + (xcd - r) * q) + off; }
        const int nig = WGM * nN, gid = wgid / nig, fm = gid * WGM, gsz = (nM - fm) < WGM ? (nM - fm) : WGM;
        u.pm = fm + ((wgid % nig) % gsz); u.pn = (wgid % nig) / gsz; return true;
    }
    __device__ __forceinline__ void a_ready(const Unit&) const {}
    __device__ __forceinline__ void done(const Unit&) const {}
};

__device__ __forceinline__ unsigned cvt_pk_bf16(float lo, float hi) { unsigned r; asm volatile("v_cvt_pk_bf16_f32 %0, %1, %2" : "=v"(r) : "v"(lo), "v"(hi)); return r; }
typedef float f32x2 __attribute__((ext_vector_type(2)));
template <class Epi, class Sched, bool ALIGN_EPI = false, bool SP2 = false>
__device__ __forceinline__ void gemm_phase(PG8_LAS unsigned char* lds, const Gemm g, const Sched& S, const Epi& E) {
    const int tid = threadIdx.x, wid = __builtin_amdgcn_readfirstlane(tid >> 6), lane = tid & 63, wr = wid >> 2, wc = wid & 3, fr = lane & 15, fq = lane >> 4;
    const int K = g.K, nt = K / BK;
    unsigned voffA[2], voffB[2];
#pragma unroll
    for (int i = 0; i < 2; ++i) { int R, C; stage_rc(tid * 16 + i * 8192, R, C); const int Rb = Epi::PERM ? ((R & ~31) + perm32(R & 31)) : R;
        voffA[i] = (unsigned)(R * K + C) * 2u; voffB[i] = (unsigned)(Rb * K + C) * 2u; }
    const size_t kstep = (size_t)(BK * 2);
    const size_t hstep = (size_t)HALF * K * 2;
    const size_t tstep = 2 * hstep;
    const unsigned ldsw = (unsigned)wid * 1024u;
    const int aoff = lds_byte(wr * 64 + fr, fq * 8), boff = lds_byte(wc * 32 + fr, fq * 8);
#define PG8_SA(b, h) (((b) * 2 + (h)) * HTB)
#define PG8_SB(b, h) ((4 + (b) * 2 + (h)) * HTB)
#define PG8_STAGE(bufoff, gbase, voff) do { _Pragma("unroll") for (int _i = 0; _i < 2; ++_i) \
        __builtin_amdgcn_global_load_lds((const unsigned*)((const char*)(gbase) + (voff)[_i]), (PG8_LAS unsigned*)(lds + (bufoff) + ldsw + _i * 8192), 16, 0, 0); } while (0)
#define PG8_LDA(dst, b, h) do { _Pragma("unroll") for (int m = 0; m < 4; ++m) _Pragma("unroll") for (int k = 0; k < 2; ++k) dst[m][k] = *(const PG8_LAS bf16x8*)(lds + PG8_SA(b, h) + aoff + m * 2048 + k * 1024); } while (0)
#define PG8_LDB(dst, b, h) do { _Pragma("unroll") for (int n = 0; n < 2; ++n) _Pragma("unroll") for (int k = 0; k < 2; ++k) dst[n][k] = *(const PG8_LAS bf16x8*)(lds + PG8_SB(b, h) + boff + n * 2048 + k * 1024); } while (0)
#define PG8_MMA(ai, bj, At, Bt) do { __builtin_amdgcn_s_setprio(1); _Pragma("unroll") for (int m = 0; m < 4; ++m) _Pragma("unroll") for (int n = 0; n < 2; ++n) _Pragma("unroll") for (int k = 0; k < 2; ++k) \
        acc[ai][bj][m][n] = __builtin_amdgcn_mfma_f32_16x16x32_bf16(Bt[n][k], At[m][k], acc[ai][bj][m][n], 0, 0, 0); __builtin_amdgcn_s_setprio(0); } while (0)
#define PG8_WAIT_V(n) asm volatile("s_waitcnt vmcnt(" #n ")" ::: "memory")
#define PG8_WAIT_L(n) asm volatile("s_waitcnt lgkmcnt(" #n ")" ::: "memory")
#define PG8_BAR __builtin_amdgcn_s_barrier()
#define PG8_SCHED __builtin_amdgcn_sched_barrier(0)
    Unit cur, nxt; int ui = 0;
    if (!S.next(0, cur)) return;
    f32x4 acc[2][2][4][2];
#pragma unroll
    for (int a = 0; a < 2; ++a)
#pragma unroll
        for (int b = 0; b < 2; ++b)
#pragma unroll
            for (int m = 0; m < 4; ++m)
#pragma unroll
                for (int n = 0; n < 2; ++n) acc[a][b][m][n] = (f32x4){0.f, 0.f, 0.f, 0.f};
    bf16x8 At[4][2], B0[2][2], B1[2][2];
    const char* cA = (const char*)g.A + (size_t)cur.pm * tstep; const char* cB = (const char*)g.Bt + (size_t)cur.pn * tstep;
    S.a_ready(cur);
    if constexpr (SP2) {
        PG8_STAGE(PG8_SB(0, 0), cB, voffB); PG8_STAGE(PG8_SB(0, 1), cB + hstep, voffB); PG8_STAGE(PG8_SA(0, 0), cA, voffA); PG8_STAGE(PG8_SA(0, 1), cA + hstep, voffA);
        if (wr == 1) PG8_BAR;
        PG8_WAIT_V(2); PG8_BAR;
        PG8_STAGE(PG8_SB(1, 0), cB + kstep, voffB); PG8_STAGE(PG8_SA(1, 0), cA + kstep, voffA); PG8_STAGE(PG8_SB(1, 1), cB + hstep + kstep, voffB);
        PG8_WAIT_V(6); PG8_BAR;
    } else {
        PG8_STAGE(PG8_SB(0, 0), cB, voffB); PG8_STAGE(PG8_SA(0, 0), cA, voffA); PG8_STAGE(PG8_SB(0, 1), cB + hstep, voffB); PG8_STAGE(PG8_SA(0, 1), cA + hstep, voffA);
        if (wr == 1) PG8_BAR;
        PG8_WAIT_V(4); PG8_BAR;
        PG8_STAGE(PG8_SB(1, 0), cB + kstep, voffB); PG8_STAGE(PG8_SA(1, 0), cA + kstep, voffA); PG8_STAGE(PG8_SB(1, 1), cB + hstep + kstep, voffB);
        PG8_WAIT_V(6); PG8_BAR;
    }
    for (;;) {
        const bool has_next = S.next(ui + 1, nxt);
        const char* nA = has_next ? (const char*)g.A + (size_t)nxt.pm * tstep : cA; const char* nB = has_next ? (const char*)g.Bt + (size_t)nxt.pn * tstep : cB;
#pragma nounroll
        for (int t = 0; t < nt; t += 2) {
            const bool last = (t == nt - 2);
            const char* a1 = cA + (size_t)(t + 1) * kstep;
            const char* a2 = last ? nA : cA + (size_t)(t + 2) * kstep; const char* b2 = last ? nB : cB + (size_t)(t + 2) * kstep;
            const char* a3 = a2 + kstep; const char* b3 = b2 + kstep;
            if (last && has_next) S.a_ready(nxt);
            if constexpr (SP2) {
            PG8_LDB(B0, 0, 0); PG8_LDB(B1, 0, 1); PG8_SCHED; PG8_LDA(At, 0, 0); PG8_STAGE(PG8_SA(1, 1), a1 + hstep, voffA);
            PG8_WAIT_V(8); PG8_WAIT_L(0); PG8_BAR; PG8_MMA(0, 0, At, B0); PG8_MMA(0, 1, At, B1); PG8_BAR; PG8_SCHED;
            PG8_LDA(At, 0, 1); PG8_STAGE(PG8_SB(0, 0), b2, voffB); PG8_STAGE(PG8_SB(0, 1), b2 + hstep, voffB); PG8_STAGE(PG8_SA(0, 0), a2, voffA);
            PG8_WAIT_V(8); PG8_WAIT_L(0); PG8_BAR; PG8_MMA(1, 0, At, B0); PG8_MMA(1, 1, At, B1); PG8_BAR; PG8_SCHED;
            PG8_LDB(B0, 1, 0); PG8_LDB(B1, 1, 1); PG8_SCHED; PG8_LDA(At, 1, 0); PG8_STAGE(PG8_SA(0, 1), a2 + hstep, voffA);
            PG8_WAIT_V(8); PG8_WAIT_L(0); PG8_BAR; PG8_MMA(0, 0, At, B0); PG8_MMA(0, 1, At, B1); PG8_BAR; PG8_SCHED;
            PG8_LDA(At, 1, 1); PG8_STAGE(PG8_SB(1, 0), b3, voffB); PG8_STAGE(PG8_SB(1, 1), b3 + hstep, voffB); PG8_STAGE(PG8_SA(1, 0), a3, voffA);
            PG8_WAIT_V(8); PG8_WAIT_L(0); PG8_BAR; PG8_MMA(1, 0, At, B0); PG8_MMA(1, 1, At, B1); PG8_BAR; PG8_SCHED;
            } else {
            PG8_LDB(B0, 0, 0); PG8_SCHED; PG8_LDA(At, 0, 0); PG8_STAGE(PG8_SA(1, 1), a1 + hstep, voffA);
            PG8_WAIT_L(8); PG8_BAR; PG8_WAIT_L(0); PG8_MMA(0, 0, At, B0); PG8_BAR; PG8_SCHED;
            PG8_LDB(B1, 0, 1); PG8_STAGE(PG8_SB(0, 0), b2, voffB);
            PG8_BAR; PG8_WAIT_L(0); PG8_MMA(0, 1, At, B1); PG8_BAR;
            PG8_LDA(At, 0, 1); PG8_STAGE(PG8_SA(0, 0), a2, voffA);
            PG8_BAR; PG8_WAIT_L(0); PG8_MMA(1, 0, At, B0); PG8_BAR; PG8_SCHED;
            PG8_STAGE(PG8_SB(0, 1), b2 + hstep, voffB);
            PG8_WAIT_V(6); PG8_BAR; PG8_MMA(1, 1, At, B1); PG8_BAR;
            PG8_LDB(B0, 1, 0); PG8_SCHED; PG8_LDA(At, 1, 0); PG8_STAGE(PG8_SA(0, 1), a2 + hstep, voffA);
            PG8_WAIT_L(8); PG8_BAR; PG8_WAIT_L(0); PG8_MMA(0, 0, At, B0); PG8_BAR; PG8_SCHED;
            PG8_LDB(B1, 1, 1); PG8_STAGE(PG8_SB(1, 0), b3, voffB);
            PG8_BAR; PG8_WAIT_L(0); PG8_MMA(0, 1, At, B1); PG8_BAR;
            PG8_LDA(At, 1, 1); PG8_STAGE(PG8_SA(1, 0), a3, voffA);
            PG8_BAR; PG8_WAIT_L(0); PG8_MMA(1, 0, At, B0); PG8_BAR; PG8_SCHED;
            PG8_STAGE(PG8_SB(1, 1), b3 + hstep, voffB);
            PG8_WAIT_V(6); PG8_BAR; PG8_MMA(1, 1, At, B1); PG8_BAR;
            }
        }
        if constexpr (ALIGN_EPI) { if (wr == 0) PG8_BAR; }
        if constexpr (!Epi::AFTER_DRAIN) { E(acc, cur, wr, wc, fr, fq); S.done(cur); }
        if (!has_next) break;
#pragma unroll
        for (int a = 0; a < 2; ++a)
#pragma unroll
            for (int b = 0; b < 2; ++b)
#pragma unroll
                for (int m = 0; m < 4; ++m)
#pragma unroll
                    for (int n = 0; n < 2; ++n) acc[a][b][m][n] = (f32x4){0.f, 0.f, 0.f, 0.f};
        cur = nxt; cA = nA; cB = nB; ++ui;
        if constexpr (ALIGN_EPI) { if (wr == 1) PG8_BAR; }
    }
    PG8_WAIT_V(0);
    if constexpr (!ALIGN_EPI) { if (wr == 0) PG8_BAR; }
    PG8_BAR;
    if constexpr (Epi::AFTER_DRAIN) { E.fused(acc, cur, wr, wc, fr, fq, lds, wid, lane); S.done(cur); }
#undef PG8_SA
#undef PG8_SB
#undef PG8_STAGE
#undef PG8_LDA
#undef PG8_LDB
#undef PG8_MMA
#undef PG8_WAIT_V
#undef PG8_WAIT_L
#undef PG8_BAR
#undef PG8_SCHED
}
}

#include <hip/hip_cooperative_groups.h>
namespace cg = cooperative_groups;
#define LAS __attribute__((address_space(3)))
typedef float f32x4 __attribute__((ext_vector_type(4)));
typedef unsigned u32x4 __attribute__((ext_vector_type(4)));
typedef unsigned u32x2 __attribute__((ext_vector_type(2)));

constexpr int NTHREADS = 512, NWAVES = 8;
constexpr int LDS_BYTES = 147456;

constexpr int PH_PREP = 0, PH_PER_LAYER = 10, PH_L0 = 1;
constexpr int PHO_IN = 0, PHO_MIXA = 1, PHO_LORA = 2, PHO_MIXB = 3, PHO_MIXC = 4, PHO_OUT = 5, PHO_LN1 = 6, PHO_GU = 7, PHO_DOWN = 8, PHO_LN2 = 9;
constexpr int N_PHASES = PH_L0 + DEPTH * PH_PER_LAYER;

struct Args { const float* in[35]; float* out; unsigned char* ws; int ph_lo, ph_hi; };

typedef float f32x2_t __attribute__((ext_vector_type(2))); typedef __bf16 bf16x2_t __attribute__((ext_vector_type(2)));
__device__ __forceinline__ unsigned pk2bf(float lo, float hi) { f32x2_t v = {lo, hi}; bf16x2_t b = __builtin_convertvector(v, bf16x2_t); return __builtin_bit_cast(unsigned, b); }

struct EpiIn {
    static constexpr bool PERM = true, AFTER_DRAIN = false;
    bf16_t* O; int ldc; int sig_pn;
    __device__ __forceinline__ void operator()(const f32x4 (&acc)[2][2][4][2], const pg8::Unit& u, int wr, int wc, int fr, int fq) const {
        const int row0 = u.pm * 256 + wr * 64 + fr, col0 = u.pn * 256 + wc * 32 + 8 * fq;
        const bool sg = u.pn >= sig_pn;
#pragma unroll
        for (int ai = 0; ai < 2; ++ai)
#pragma unroll
            for (int m = 0; m < 4; ++m) {
                bf16_t* rowp = O + (size_t)(row0 + ai * 128 + m * 16) * ldc + col0;
#pragma unroll
                for (int bj = 0; bj < 2; ++bj) {
                    f32x4 v0 = acc[ai][bj][m][0], v1 = acc[ai][bj][m][1];
                    if (sg) {
#pragma unroll
                        for (int i = 0; i < 4; ++i) { v0[i] = sigmoidf_(v0[i]); v1[i] = sigmoidf_(v1[i]); }
                    }
                    u32x4 w; w.x = pk2bf(v0[0], v0[1]); w.y = pk2bf(v0[2], v0[3]); w.z = pk2bf(v1[0], v1[1]); w.w = pk2bf(v1[2], v1[3]);
                    *(u32x4*)(rowp + bj * 128) = w;
                }
                asm volatile("" ::: "memory");
            }
    }
};
struct EpiRes {
    static constexpr bool PERM = false, AFTER_DRAIN = false;
    const float* res; float* Z; int ldc;
    __device__ __forceinline__ void operator()(const f32x4 (&acc)[2][2][4][2], const pg8::Unit& u, int wr, int wc, int fr, int fq) const {
        const int col0 = u.pn * 256 + wc * 32 + 4 * fq;
#pragma unroll
        for (int ai = 0; ai < 2; ++ai)
#pragma unroll
            for (int m = 0; m < 4; ++m) {
                const size_t off = (size_t)(u.pm * 256 + ai * 128 + wr * 64 + m * 16 + fr) * ldc + col0;
#pragma unroll
                for (int bj = 0; bj < 2; ++bj)
#pragma unroll
                    for (int n = 0; n < 2; ++n) {
                        const f32x4 r = *(const f32x4*)(res + off + bj * 128 + n * 16);
                        *(f32x4*)(Z + off + bj * 128 + n * 16) = r * ALPHA + acc[ai][bj][m][n];
                    }
                asm volatile("" ::: "memory");
            }
    }
};
struct EpiSwiGLU {
    static constexpr bool PERM = true, AFTER_DRAIN = false;
    bf16_t* H; int ldc;
    __device__ __forceinline__ void operator()(const f32x4 (&acc)[2][2][4][2], const pg8::Unit& u, int wr, int wc, int fr, int fq) const {
        const int row0 = u.pm * 256 + wr * 64 + fr, col0 = u.pn * 128 + wc * 32 + 8 * fq;
#pragma unroll
        for (int ai = 0; ai < 2; ++ai)
#pragma unroll
            for (int m = 0; m < 4; ++m) {
                bf16_t* rowp = H + (size_t)(row0 + ai * 128 + m * 16) * ldc + col0;
                float o[8];
#pragma unroll
                for (int n = 0; n < 2; ++n)
#pragma unroll
                    for (int i = 0; i < 4; ++i) { const float g = acc[ai][0][m][n][i], up = acc[ai][1][m][n][i]; o[n * 4 + i] = g * sigmoidf_(g) * up; }
                u32x4 w; w.x = pk2bf(o[0], o[1]); w.y = pk2bf(o[2], o[3]); w.z = pk2bf(o[4], o[5]); w.w = pk2bf(o[6], o[7]);
                *(u32x4*)rowp = w;
                asm volatile("" ::: "memory");
            }
    }
};

template <int MODE> __device__ __forceinline__ int colmap(int n) {
    if (MODE == 0) return n < 5920 ? n : (n < 6144 ? -1 : n - 224);
    if (MODE == 2) { const int pn = n >> 8, q = n & 255; return q < 128 ? pn * 128 + q : DFF + pn * 128 + (q - 128); }
    return n;
}
template <int MODE> __device__ __forceinline__ void transpose_item(const float* __restrict__ W, int K, int ldw, bf16_t* WT, int item, int nblk, LAS float* tile, int tid) {
    const int kb = item / nblk, nb = item % nblk, k0 = kb * 64, n0 = nb * 64;
    {
        const int nn = tid & 63; const int col = colmap<MODE>(n0 + nn);
#pragma unroll
        for (int i = 0; i < 8; ++i) { const int kk = i * 8 + (tid >> 6); tile[kk * 65 + nn] = col >= 0 ? W[(size_t)(k0 + kk) * ldw + col] : 0.f; }
    }
    __syncthreads();
    {
        const int nn = tid >> 3, c = tid & 7; const LAS float* s = tile + (8 * c) * 65 + nn;
        u32x4 o; o.x = pk2bf(s[0], s[65]); o.y = pk2bf(s[2 * 65], s[3 * 65]); o.z = pk2bf(s[4 * 65], s[5 * 65]); o.w = pk2bf(s[6 * 65], s[7 * 65]);
        *(u32x4*)(WT + (size_t)(n0 + nn) * K + k0 + 8 * c) = o;
    }
    __syncthreads();
}
__device__ __forceinline__ void phase_prep(const Args& a, LAS unsigned char* lds) {
    const int tid = threadIdx.x, G = gridDim.x, bx = blockIdx.x;
    LAS float* tile = (LAS float*)lds;
    constexpr int I_IN = (D / 64) * (NP / 64), I_OUT = (D / 64) * (D / 64), I_GU = (D / 64) * (2 * DFF / 64), I_DN = (DFF / 64) * (D / 64);
    constexpr int I_LAYER = I_IN + I_OUT + I_GU + I_DN;
    for (int it = bx; it < DEPTH * I_LAYER; it += G) {
        const int l = it / I_LAYER; int r = it % I_LAYER;
        if (r < I_IN) { transpose_item<0>(a.in[8] + (size_t)l * D * IN_COLS, D, IN_COLS, (bf16_t*)(a.ws + WS_WIN + l * WIN_T_BYTES), r, NP / 64, tile, tid); continue; } r -= I_IN;
        if (r < I_OUT) { transpose_item<1>(a.in[28] + (size_t)l * D * D, D, D, (bf16_t*)(a.ws + WS_WOUT + l * WOUT_T_BYTES), r, D / 64, tile, tid); continue; } r -= I_OUT;
        if (r < I_GU) { transpose_item<2>(a.in[31] + (size_t)l * D * 2 * DFF, D, 2 * DFF, (bf16_t*)(a.ws + WS_WGU + l * WGU_T_BYTES), r, 2 * DFF / 64, tile, tid); continue; } r -= I_GU;
        transpose_item<1>(a.in[32] + (size_t)l * DFF * D, DFF, D, (bf16_t*)(a.ws + WS_WDN + l * WDN_T_BYTES), r, D / 64, tile, tid);
    }
    float* XF = (float*)(a.ws + WS_XF); bf16_t* XB = (bf16_t*)(a.ws + WS_XB);
    const size_t n4 = (size_t)M * D / 4, np4 = (size_t)MP * D / 4;
    for (size_t i = (size_t)bx * NTHREADS + tid; i < n4; i += (size_t)G * NTHREADS) {
        const f32x4 v = i < np4 ? ((const f32x4*)a.in[0])[i] : ((const f32x4*)a.in[1])[i - np4];
        ((f32x4*)XF)[i] = v;
        u32x2 w; w.x = pk2bf(v[0], v[1]); w.y = pk2bf(v[2], v[3]);
        ((u32x2*)XB)[i] = w;
    }
}

__device__ __forceinline__ void phase_ln(const float* __restrict__ Z, const float* __restrict__ g, const float* __restrict__ b, float* OF, bf16_t* OB) {
    const int lane = threadIdx.x & 63, wv = threadIdx.x >> 6;
    f32x4 gv[4], bv[4];
#pragma unroll
    for (int j = 0; j < 4; ++j) { gv[j] = ((const f32x4*)g)[j * 64 + lane]; bv[j] = ((const f32x4*)b)[j * 64 + lane]; }
    for (int m = blockIdx.x * NWAVES + wv; m < M; m += gridDim.x * NWAVES) {
        const f32x4* z = (const f32x4*)(Z + (size_t)m * D);
        f32x4 v[4]; float s = 0.f;
#pragma unroll
        for (int j = 0; j < 4; ++j) { v[j] = z[j * 64 + lane]; s += (v[j][0] + v[j][1]) + (v[j][2] + v[j][3]); }
        const float mean = wave_sum(s) * (1.f / D);
        float q = 0.f;
#pragma unroll
        for (int j = 0; j < 4; ++j) { v[j] = v[j] - mean; q += (v[j][0] * v[j][0] + v[j][1] * v[j][1]) + (v[j][2] * v[j][2] + v[j][3] * v[j][3]); }
        const float rstd = rsqrtf(wave_sum(q) * (1.f / D) + LN_EPS);
#pragma unroll
        for (int j = 0; j < 4; ++j) {
            const f32x4 y = v[j] * rstd * gv[j] + bv[j];
            ((f32x4*)(OF + (size_t)m * D))[j * 64 + lane] = y;
            if (OB) { u32x2 w; w.x = pk2bf(y[0], y[1]); w.y = pk2bf(y[2], y[3]); ((u32x2*)(OB + (size_t)m * D))[j * 64 + lane] = w; }
        }
    }
}


typedef short bf16x8_t __attribute__((ext_vector_type(8)));
typedef short bf16x4_t __attribute__((ext_vector_type(4)));
#define LDSW() asm volatile("s_waitcnt lgkmcnt(0)" ::: "memory")

constexpr int AT_KPB = 144;
constexpr int AT_VPB = 528;
constexpr int AT_K_OFF = 0, AT_V_OFF = 256 * AT_KPB;
constexpr int AT_LDS = AT_V_OFF + 64 * AT_VPB;

template <bool SAMPLE>
__device__ __forceinline__ void attn_unit(const bf16_t* __restrict__ P, bf16_t* OA, const float* __restrict__ sinks, const float* __restrict__ ck, const float* __restrict__ cv,
                                          int b, int qb, int c, LAS unsigned char* lds) {
    const int tid = threadIdx.x, lane = tid & 63, wv = __builtin_amdgcn_readfirstlane(tid >> 6), i16 = lane & 15, qp = lane >> 4;
    LAS unsigned char* ldsK = lds + AT_K_OFF; LAS unsigned char* ldsV = lds + AT_V_OFF;
    if (!SAMPLE) {
        const size_t row_base = (size_t)b * SEQ + (size_t)(qb - 1) * 128;
#pragma unroll
        for (int it = 0; it < 4; ++it) {
            const int ci = tid + 512 * it, s = ci >> 3, part = ci & 7;
            u32x4 kv = (u32x4){0u, 0u, 0u, 0u}, vv = (u32x4){0u, 0u, 0u, 0u};
            if (qb > 0 || s >= 128) {
                const bf16_t* pr = P + (row_base + s) * NP;
                kv = *(const u32x4*)(pr + CK + 64 * c + 8 * part);
                vv = *(const u32x4*)(pr + CV + 64 * c + 8 * part);
            }
            *(LAS u32x4*)(ldsK + s * AT_KPB + part * 16) = kv;
            const unsigned w4[4] = {vv.x, vv.y, vv.z, vv.w};
#pragma unroll
            for (int e = 0; e < 8; ++e) *(LAS unsigned short*)(ldsV + (8 * part + e) * AT_VPB + 2 * s) = (unsigned short)((w4[e >> 1] >> (16 * (e & 1))) & 0xffffu);
        }
    } else {
        for (int ci = tid; ci < 144 * 16; ci += 512) {
            const int s = ci >> 4, part = ci & 15;
            float kf[4] = {0.f, 0.f, 0.f, 0.f}, vf[4] = {0.f, 0.f, 0.f, 0.f};
            if (s < 128) {
                const f32x4 k4 = *(const f32x4*)(ck + ((size_t)(b * 128 + s) * 4 + c) * 64 + 4 * part);
                const f32x4 v4 = *(const f32x4*)(cv + ((size_t)(b * 128 + s) * 4 + c) * 64 + 4 * part);
#pragma unroll
                for (int e = 0; e < 4; ++e) { kf[e] = k4[e]; vf[e] = v4[e]; }
            } else if (s < 136) {
                const bf16_t* pr = P + (size_t)(MP + b * DSEQ + (s - 128)) * NP;
#pragma unroll
                for (int e = 0; e < 4; ++e) { kf[e] = bf2f(pr[CK + 64 * c + 4 * part + e]); vf[e] = bf2f(pr[CV + 64 * c + 4 * part + e]); }
            }
            u32x2 kw; kw.x = pk2bf(kf[0], kf[1]); kw.y = pk2bf(kf[2], kf[3]);
            *(LAS u32x2*)(ldsK + s * AT_KPB + part * 8) = kw;
#pragma unroll
            for (int e = 0; e < 4; ++e) *(LAS unsigned short*)(ldsV + (4 * part + e) * AT_VPB + 2 * s) = f2bf(vf[e]);
        }
    }
    __syncthreads();
    const int n_mt = SAMPLE ? 1 : 4;
    if (!SAMPLE || wv < 2) {
        for (int mt = 0; mt < n_mt; ++mt) {
            int h, tq, nt0; size_t qrow;
            if (!SAMPLE) { const int g = wv >> 1, qh = wv & 1; h = 4 * c + g; tq = 64 * qh + 16 * mt + i16; nt0 = (64 * qh + 16 * mt) >> 4; qrow = (size_t)b * SEQ + (size_t)qb * 128 + tq; }
            else { const int rho = 16 * wv + i16; h = 4 * c + (rho >> 3); tq = rho & 7; nt0 = 0; qrow = (size_t)MP + b * DSEQ + tq; }
            const float slope = exp2f(-0.5f * (float)(h + 1)), sink = sinks[h];
            bf16x8_t qf[2];
#pragma unroll
            for (int ks = 0; ks < 2; ++ks) qf[ks] = *(const bf16x8_t*)(P + qrow * NP + CQ + 64 * h + 32 * ks + 8 * qp);
            f32x4 sc[9];
#pragma unroll
            for (int jn = 0; jn < 9; ++jn) {
                const int nt = nt0 + jn;
                f32x4 acc = (f32x4){0.f, 0.f, 0.f, 0.f};
                if (SAMPLE || qb > 0 || nt >= 8) {
#pragma unroll
                    for (int ks = 0; ks < 2; ++ks) {
                        const bf16x8_t kfr = *(const LAS bf16x8_t*)(ldsK + (16 * nt + i16) * AT_KPB + (32 * ks + 8 * qp) * 2);
                        acc = __builtin_amdgcn_mfma_f32_16x16x32_bf16(kfr, qf[ks], acc, 0, 0, 0);
                    }
                }
#pragma unroll
                for (int r = 0; r < 4; ++r) {
                    const int sidx = 16 * nt + 4 * qp + r;
                    const int rel = 128 + tq - sidx;
                    bool valid = rel >= 0 && rel < 128;
                    if (!SAMPLE) valid = valid && (qb > 0 || sidx >= 128);
                    acc[r] = valid ? acc[r] * 0.125f - slope * (float)rel : -INFINITY;
                }
                sc[jn] = acc;
            }
            float mx = sink;
#pragma unroll
            for (int jn = 0; jn < 9; ++jn)
#pragma unroll
                for (int r = 0; r < 4; ++r) mx = fmaxf(mx, sc[jn][r]);
            mx = fmaxf(mx, __shfl_xor(mx, 16)); mx = fmaxf(mx, __shfl_xor(mx, 32));
            float sum = 0.f;
#pragma unroll
            for (int jn = 0; jn < 9; ++jn)
#pragma unroll
                for (int r = 0; r < 4; ++r) { const float e = __expf(sc[jn][r] - mx); sc[jn][r] = e; sum += e; }
            sum += __shfl_xor(sum, 16); sum += __shfl_xor(sum, 32);
            const float inv = 1.f / (sum + __expf(sink - mx));
            bf16x8_t pf[5];
#pragma unroll
            for (int ks = 0; ks < 5; ++ks) {
                u32x4 w;
                w.x = pk2bf(sc[2 * ks][0] * inv, sc[2 * ks][1] * inv); w.y = pk2bf(sc[2 * ks][2] * inv, sc[2 * ks][3] * inv);
                if (ks < 4) { w.z = pk2bf(sc[2 * ks + 1][0] * inv, sc[2 * ks + 1][1] * inv); w.w = pk2bf(sc[2 * ks + 1][2] * inv, sc[2 * ks + 1][3] * inv); }
                else { w.z = 0u; w.w = 0u; }
                pf[ks] = __builtin_bit_cast(bf16x8_t, w);
            }
#pragma unroll
            for (int dt = 0; dt < 4; ++dt) {
                f32x4 o = (f32x4){0.f, 0.f, 0.f, 0.f};
#pragma unroll
                for (int ks = 0; ks < 5; ++ks) {
                    const int ntA = nt0 + 2 * ks, ntB = (ks < 4) ? nt0 + 2 * ks + 1 : nt0 + 2 * ks;
                    const LAS unsigned char* vr = ldsV + (16 * dt + i16) * AT_VPB;
                    const u32x2 lo = *(const LAS u32x2*)(vr + 2 * (16 * ntA + 4 * qp));
                    const u32x2 hi = *(const LAS u32x2*)(vr + 2 * (16 * ntB + 4 * qp));
                    const u32x4 w = (u32x4){lo.x, lo.y, hi.x, hi.y};
                    o = __builtin_amdgcn_mfma_f32_16x16x32_bf16(__builtin_bit_cast(bf16x8_t, w), pf[ks], o, 0, 0, 0);
                }
                u32x2 ow; ow.x = pk2bf(o[0], o[1]); ow.y = pk2bf(o[2], o[3]);
                *(u32x2*)(OA + qrow * D + 64 * h + 16 * dt + 4 * qp) = ow;
            }
        }
    }
    __syncthreads();
}

template <bool PASS2>
__device__ __forceinline__ void rglru_unit(const Args& a, int L, int unit, LAS unsigned char* lds) {
    const int tid = threadIdx.x, lane = tid & 63, wv = __builtin_amdgcn_readfirstlane(tid >> 6);
    const bf16_t* P = (const bf16_t*)(a.ws + WS_P); bf16_t* OB = (bf16_t*)(a.ws + WS_OB); float* RS = (float*)(a.ws + WS_RS);
    const float* cw = a.in[10] + (size_t)L * 4 * D; const float* cb = a.in[11] + L * D; const float* wa = a.in[12] + (size_t)L * 16 * 4096; const float* ba = a.in[13] + L * D;
    const float* wx = a.in[14] + (size_t)L * 16 * 4096; const float* bx = a.in[15] + L * D; const float* lam = a.in[16] + L * D;
    const float* conv0 = a.in[4] + (size_t)L * DBATCH * 3 * D; const float* h0 = a.in[5] + (size_t)L * DBATCH * D;
    LAS float* s_xc = (LAS float*)lds + wv * 64;
    const int m0 = unit * 64;
    const bool sample = m0 >= MP;
    for (int bb = 0; bb < 2; ++bb) {
        const int bk = 2 * wv + bb, c = 64 * bk + lane;
        float war[64], wxr[64];
#pragma unroll
        for (int i = 0; i < 64; ++i) { war[i] = wa[((size_t)bk * 64 + i) * 64 + lane]; wxr[i] = wx[((size_t)bk * 64 + i) * 64 + lane]; }
        const float c0 = cw[0 * D + c], c1 = cw[1 * D + c], c2 = cw[2 * D + c], c3 = cw[3 * D + c], cbc = cb[c], bac = ba[c], bxc = bx[c];
        const float spl = softplusf_(-lam[c]);
        float x1 = 0.f, x2 = 0.f, x3 = 0.f, h = 0.f, Ap = 1.f;
        int bseq = 0, chunk = 0;
        if (!sample) {
            bseq = m0 / SEQ; chunk = (m0 % SEQ) / 64;
            if (chunk > 0) {
                x1 = bf2f(P[(size_t)(m0 - 1) * NP + CRNN + c]); x2 = bf2f(P[(size_t)(m0 - 2) * NP + CRNN + c]); x3 = bf2f(P[(size_t)(m0 - 3) * NP + CRNN + c]);
                if (PASS2) { for (int cc = 0; cc < chunk; ++cc) { const float2 ab = *(const float2*)(RS + (((size_t)bseq * 128 + cc) * D + c) * 2); h = ab.x * h + ab.y; } }
            }
        }
        for (int t = 0; t < 64; ++t) {
            const size_t m = (size_t)m0 + t;
            if (sample && (t & 7) == 0) {
                if (!PASS2) break;
                const int b = (int)(m - MP) >> 3;
                x3 = conv0[((size_t)b * 3 + 0) * D + c]; x2 = conv0[((size_t)b * 3 + 1) * D + c]; x1 = conv0[((size_t)b * 3 + 2) * D + c]; h = h0[(size_t)b * D + c];
            }
            const float x = bf2f(P[m * NP + CRNN + c]);
            const float xc = cbc + c0 * x3 + c1 * x2 + c2 * x1 + c3 * x;
            LDSW(); s_xc[lane] = xc; LDSW();
            float r = bac, ig = bxc;
#pragma unroll
            for (int i4 = 0; i4 < 16; ++i4) { const f32x4 xv = *(const LAS f32x4*)(s_xc + 4 * i4);
#pragma unroll
                for (int e = 0; e < 4; ++e) { r += xv[e] * war[4 * i4 + e]; ig += xv[e] * wxr[4 * i4 + e]; } }
            r = sigmoidf_(r); ig = sigmoidf_(ig);
            const float log_a = -8.f * r * spl;
            const float av = __expf(log_a);
            const float u = sqrtf(-expm1f(2.f * log_a)) * (ig * xc);
            h = av * h + u; Ap *= av;
            if (PASS2) OB[m * D + c] = f2bf(h);
            x3 = x2; x2 = x1; x1 = x;
            if (PASS2 && sample && (t & 7) == 7) {
                const int b = (int)(m - MP) >> 3;
                float* oc = a.out + O_SCONV + ((size_t)L * DBATCH + b) * 3 * D; float* oh = a.out + O_SH + ((size_t)L * DBATCH + b) * D;
                oh[c] = h; oc[0 * D + c] = x3; oc[1 * D + c] = x2; oc[2 * D + c] = x1;
            }
        }
        if (!sample) {
            if (!PASS2) { *(float2*)(RS + (((size_t)bseq * 128 + chunk) * D + c) * 2) = make_float2(Ap, h); }
            else if (chunk == 127) {
                float* oc = a.out + O_PCONV + ((size_t)L * NBATCH + bseq) * 3 * D; float* oh = a.out + O_PH + ((size_t)L * NBATCH + bseq) * D;
                oh[c] = h; oc[0 * D + c] = x3; oc[1 * D + c] = x2; oc[2 * D + c] = x1;
            }
        }
    }
}

__device__ __forceinline__ void phase_elem_mixa(const Args& a, int L) {
    const bf16_t* P = (const bf16_t*)(a.ws + WS_P); bf16_t* AC = (bf16_t*)(a.ws + WS_ACAT);
    const float* mu = a.in[17] + (size_t)L * SHIFT_W; const float* shift0 = a.in[6] + (size_t)L * DBATCH * SHIFT_W;
    const size_t gt = (size_t)blockIdx.x * NTHREADS + threadIdx.x, gs = (size_t)gridDim.x * NTHREADS;
    for (size_t i = gt; i < (size_t)M * ACAT_K; i += gs) {
        const size_t m = i / ACAT_K; const int j = (int)(i % ACAT_K);
        float o = 0.f;
        if (j < 288) {
            const int ch = 3072 + j;
            const float pc = bf2f(P[m * NP + CRW + ch]);
            float pv;
            if (m < MP) pv = (m % SEQ) == 0 ? 0.f : bf2f(P[(m - 1) * NP + CRW + ch]);
            else pv = ((m - MP) % DSEQ) == 0 ? shift0[((m - MP) / DSEQ) * SHIFT_W + ch] : bf2f(P[(m - 1) * NP + CRW + ch]);
            const float ps = pc + mu[ch] * (pv - pc);
            o = j < 64 ? tanhf(ps) : (j < 128 ? ps : sigmoidf_(ps));
        }
        AC[i] = f2bf(o);
    }
    const float* ck = a.in[2] + (size_t)L * DBATCH * 128 * 256; const float* cv = a.in[3] + (size_t)L * DBATCH * 128 * 256;
    float* pk = a.out + O_PK + (size_t)L * NBATCH * 128 * 256; float* pv_ = a.out + O_PV + (size_t)L * NBATCH * 128 * 256;
    float* pshift = a.out + O_PSHIFT + (size_t)L * NBATCH * SHIFT_W; float* sk = a.out + O_SK + (size_t)L * DBATCH * 128 * 256; float* sv = a.out + O_SV + (size_t)L * DBATCH * 128 * 256;
    float* sshift = a.out + O_SSHIFT + (size_t)L * DBATCH * SHIFT_W;
    const size_t n_pk = (size_t)NBATCH * 128 * 256, n_sk = (size_t)DBATCH * 128 * 256, n_ps = (size_t)NBATCH * SHIFT_W, n_ss = (size_t)DBATCH * SHIFT_W;
    for (size_t i = gt; i < n_pk + n_sk + n_ps + n_ss; i += gs) {
        if (i < n_pk) {
            const int b = (int)(i / (128 * 256)), s = (int)((i / 256) % 128), e = (int)(i % 256);
            const size_t row = (size_t)b * SEQ + (SEQ - 128) + s;
            pk[i] = bf2f(P[row * NP + CK + e]); pv_[i] = bf2f(P[row * NP + CV + e]);
            continue;
        }
        size_t k = i - n_pk;
        if (k < n_sk) {
            const int b = (int)(k / (128 * 256)), s = (int)((k / 256) % 128), e = (int)(k % 256);
            if (s < 120) { sk[k] = ck[((size_t)b * 128 + s + 8) * 256 + e]; sv[k] = cv[((size_t)b * 128 + s + 8) * 256 + e]; }
            else { const size_t row = (size_t)MP + b * DSEQ + (s - 120); sk[k] = bf2f(P[row * NP + CK + e]); sv[k] = bf2f(P[row * NP + CV + e]); }
            continue;
        }
        k -= n_sk;
        if (k < n_ps) { const int b = (int)(k / SHIFT_W), ch = (int)(k % SHIFT_W); pshift[k] = bf2f(P[((size_t)b * SEQ + SEQ - 1) * NP + CRW + ch]); continue; }
        k -= n_ps;
        { const int b = (int)(k / SHIFT_W), ch = (int)(k % SHIFT_W); sshift[k] = bf2f(P[((size_t)MP + b * DSEQ + DSEQ - 1) * NP + CRW + ch]); }
    }
}

__device__ __forceinline__ void phase_mixa(const Args& a, int L, LAS unsigned char* lds) {
    phase_elem_mixa(a, L);
    const bf16_t* P = (const bf16_t*)(a.ws + WS_P); bf16_t* OA = (bf16_t*)(a.ws + WS_OA);
    const float* sinks = a.in[9] + L * 16; const float* ck = a.in[2] + (size_t)L * DBATCH * 128 * 256; const float* cv = a.in[3] + (size_t)L * DBATCH * 128 * 256;
    constexpr int N_RG1 = MP / 64, N_AP = NBATCH * 64 * 4, N_AS = DBATCH * 4;
    for (int it = blockIdx.x; it < N_RG1; it += gridDim.x) { rglru_unit<false>(a, L, it, lds); __syncthreads(); }
    for (int r = blockIdx.x; r < N_AP; r += gridDim.x) { const int c = r & 3, qb = (r >> 2) & 63, b = r >> 8; attn_unit<false>(P, OA, sinks, ck, cv, b, qb, c, lds); }
    for (int r = blockIdx.x; r < N_AS; r += gridDim.x) { const int c = r & 3, b = r >> 2; attn_unit<true>(P, OA, sinks, ck, cv, b, 0, c, lds); }
}

__device__ __forceinline__ void phase_mixb_rg(const Args& a, int L, LAS unsigned char* lds, int first_block) {
    const int nb = gridDim.x - first_block;
    if ((int)blockIdx.x < first_block) return;
    for (int it = blockIdx.x - first_block; it < M / 64; it += nb) { rglru_unit<true>(a, L, it, lds); __syncthreads(); }
}

struct EpiLora {
    static constexpr bool PERM = true, AFTER_DRAIN = false;
    float* WAW; bf16_t* WAA; bf16_t* WAG; const float* w0; const float* a0;
    __device__ __forceinline__ void operator()(const f32x4 (&acc)[2][2][4][2], const pg8::Unit& u, int wr, int wc, int fr, int fq) const {
        const int row0 = u.pm * 256 + wr * 64 + fr, kind = u.pn >> 2, colb = (u.pn & 3) * 256 + wc * 32 + 8 * fq;
        const float* bsrc = kind == 0 ? w0 : a0;
        f32x4 bias[2][2];
#pragma unroll
        for (int bj = 0; bj < 2; ++bj)
#pragma unroll
            for (int n = 0; n < 2; ++n) bias[bj][n] = kind == 2 ? (f32x4){0.f, 0.f, 0.f, 0.f} : *(const f32x4*)(bsrc + colb + bj * 128 + 4 * n);
#pragma unroll
        for (int ai = 0; ai < 2; ++ai)
#pragma unroll
            for (int m = 0; m < 4; ++m) {
                const size_t off = (size_t)(row0 + ai * 128 + m * 16) * D + colb;
#pragma unroll
                for (int bj = 0; bj < 2; ++bj) {
                    f32x4 v0 = acc[ai][bj][m][0] + bias[bj][0], v1 = acc[ai][bj][m][1] + bias[bj][1];
                    if (kind == 0) { *(f32x4*)(WAW + off + bj * 128) = v0; *(f32x4*)(WAW + off + bj * 128 + 4) = v1; }
                    else {
                        if (kind == 1) {
#pragma unroll
                            for (int i = 0; i < 4; ++i) { v0[i] = sigmoidf_(v0[i]); v1[i] = sigmoidf_(v1[i]); }
                        }
                        u32x4 w; w.x = pk2bf(v0[0], v0[1]); w.y = pk2bf(v0[2], v0[3]); w.z = pk2bf(v1[0], v1[1]); w.w = pk2bf(v1[2], v1[3]);
                        *(u32x4*)((kind == 1 ? WAA : WAG) + off + bj * 128) = w;
                    }
                }
                asm volatile("" ::: "memory");
            }
    }
};

__device__ __forceinline__ void prep_wlora(const Args& a) {
    const size_t gt = (size_t)blockIdx.x * NTHREADS + threadIdx.x, gs = (size_t)gridDim.x * NTHREADS;
    for (size_t i = gt; i < (size_t)DEPTH * 3072 * ACAT_K; i += gs) {
        const int l = (int)(i / ((size_t)3072 * ACAT_K)); const int r = (int)(i % ((size_t)3072 * ACAT_K));
        const int n = r / ACAT_K, k = r % ACAT_K, kind = n >> 10, c = n & 1023;
        float v = 0.f;
        if (kind == 0 && k < 64) v = a.in[19][((size_t)l * 64 + k) * D + c];
        else if (kind == 1 && k >= 64 && k < 128) v = a.in[21][((size_t)l * 64 + (k - 64)) * D + c];
        else if (kind == 2 && k >= 128 && k < 288) v = a.in[22][((size_t)l * 160 + (k - 128)) * D + c];
        ((bf16_t*)(a.ws + WS_WLORA))[i] = f2bf(v);
    }
}

__device__ __forceinline__ float dpp_add16(float x) {
    x += __builtin_bit_cast(float, __builtin_amdgcn_update_dpp(0, __builtin_bit_cast(int, x), 0xB1, 0xF, 0xF, true));
    x += __builtin_bit_cast(float, __builtin_amdgcn_update_dpp(0, __builtin_bit_cast(int, x), 0x4E, 0xF, 0xF, true));
    x += __builtin_bit_cast(float, __builtin_amdgcn_update_dpp(0, __builtin_bit_cast(int, x), 0x124, 0xF, 0xF, true));
    x += __builtin_bit_cast(float, __builtin_amdgcn_update_dpp(0, __builtin_bit_cast(int, x), 0x128, 0xF, 0xF, true));
    return x;
}
constexpr int SC_TB = 32;
__device__ __forceinline__ void wkv_scan_unit(const Args& a, int L, int seq, int h, int half, LAS unsigned char* lds) {
    const int tid = threadIdx.x, lane = tid & 63, wv = __builtin_amdgcn_readfirstlane(tid >> 6);
    const bf16_t* P = (const bf16_t*)(a.ws + WS_P); const float* WAW = (const float*)(a.ws + WS_WAW); const bf16_t* WAA = (const bf16_t*)(a.ws + WS_WAA);
    float* Y = (float*)(a.ws + WS_Y); float* BD = (float*)(a.ws + WS_BD);
    const float* mu = a.in[17] + (size_t)L * SHIFT_W; const float* shift0 = a.in[6] + (size_t)L * DBATCH * SHIFT_W;
    LAS float* buf = (LAS float*)lds;
    const int e = lane & 15, v = 32 * half + 4 * wv + (lane >> 4);
    int row0, T; const float* sh0 = nullptr; float* outS;
    f32x4 S = (f32x4){0.f, 0.f, 0.f, 0.f};
    if (seq < NBATCH) { row0 = seq * SEQ; T = SEQ; outS = a.out + O_PWKV + ((((size_t)L * NBATCH + seq) * 16 + h) * 64 + v) * 64 + 4 * e; }
    else { const int b = seq - NBATCH; row0 = MP + b * DSEQ; T = DSEQ; sh0 = shift0 + (size_t)b * SHIFT_W;
        outS = a.out + O_SWKV + ((((size_t)L * DBATCH + b) * 16 + h) * 64 + v) * 64 + 4 * e;
        S = *(const f32x4*)(a.in[7] + ((((size_t)L * DBATCH + b) * 16 + h) * 64 + v) * 64 + 4 * e); }
    const int c = 64 * h + lane;
    const float mu_r = mu[c], mu_k = mu[1024 + c], mu_v = mu[2048 + c];
    const float kkc = a.in[23][L * D + c], kac = a.in[24][L * D + c], rkc = a.in[25][L * D + c];
    for (int t0 = 0; t0 < T; t0 += SC_TB) {
        const int nb = (T - t0) < SC_TB ? (T - t0) : SC_TB;
        for (int tok = wv; tok < nb; tok += NWAVES) {
            const int t = t0 + tok; const size_t m = (size_t)row0 + t;
            const bf16_t* pr = P + m * NP + CRW; const bf16_t* pp = pr - NP;
            float pr_r = bf2f(pr[c]), pr_k = bf2f(pr[1024 + c]), pr_v = bf2f(pr[2048 + c]);
            float pv_r, pv_k, pv_v;
            if (t == 0) { pv_r = sh0 ? sh0[c] : 0.f; pv_k = sh0 ? sh0[1024 + c] : 0.f; pv_v = sh0 ? sh0[2048 + c] : 0.f; }
            else { pv_r = bf2f(pp[c]); pv_k = bf2f(pp[1024 + c]); pv_v = bf2f(pp[2048 + c]); }
            const float r = pr_r + mu_r * (pv_r - pr_r), kx = pr_k + mu_k * (pv_k - pr_k), vv = pr_v + mu_v * (pv_v - pr_v);
            const float w = __expf(-__expf(-softplusf_(-WAW[m * D + c]) - 0.5f)), av = bf2f(WAA[m * D + c]);
            float kk = kx * kkc;
            const float nrm = sqrtf(wave_sum(kk * kk));
            kk = kk / fmaxf(nrm, 1e-12f);
            const float k2 = kx * (1.f + (av - 1.f) * kac);
            const float bd = wave_sum(r * k2 * rkc);
            if (half == 0 && lane == 0) BD[m * 16 + h] = bd;
            LAS float* bt = buf + tok * 384;
            bt[lane] = w; bt[64 + lane] = kk; bt[128 + lane] = kk * av; bt[192 + lane] = k2; bt[256 + lane] = r; bt[320 + lane] = vv;
        }
        __syncthreads();
        for (int tok = 0; tok < nb; ++tok) {
            const LAS float* bt = buf + tok * 384;
            const f32x4 w4 = *(const LAS f32x4*)(bt + 4 * e), kk4 = *(const LAS f32x4*)(bt + 64 + 4 * e), b4 = *(const LAS f32x4*)(bt + 128 + 4 * e),
                        k4 = *(const LAS f32x4*)(bt + 192 + 4 * e), r4 = *(const LAS f32x4*)(bt + 256 + 4 * e);
            const float vv = bt[320 + v];
            float sa = -((S[0] * kk4[0] + S[1] * kk4[1]) + (S[2] * kk4[2] + S[3] * kk4[3]));
            sa = dpp_add16(sa);
            S = S * w4 + (b4 * sa + k4 * vv);
            float y = (S[0] * r4[0] + S[1] * r4[1]) + (S[2] * r4[2] + S[3] * r4[3]);
            y = dpp_add16(y);
            if (e == 0) Y[((size_t)row0 + t0 + tok) * D + 64 * h + v] = y;
        }
        __syncthreads();
    }
    *(f32x4*)outS = S;
}

__device__ __forceinline__ void phase_mixb(const Args& a, int L, LAS unsigned char* lds) {
    constexpr int N_PS = NBATCH * 16 * 2;
    const int G = gridDim.x, bx = blockIdx.x;
    const int first_other = (G > 2 * N_PS) ? N_PS : 0;
    for (int it = bx; it < N_PS; it += G) wkv_scan_unit(a, L, it >> 5, (it >> 1) & 15, it & 1, lds);
    if (bx < first_other) return;
    const int nb = G - first_other, id = bx - first_other;
    for (int it = id; it < M / 64; it += nb) { rglru_unit<true>(a, L, it, lds); __syncthreads(); }
    for (int it = id; it < DBATCH * 32; it += nb) wkv_scan_unit(a, L, NBATCH + (it >> 5), (it >> 1) & 15, it & 1, lds);
}

__device__ __forceinline__ void phase_mixc(const Args& a, int L) {
    const int lane = threadIdx.x & 63, wv = threadIdx.x >> 6;
    const bf16_t* P = (const bf16_t*)(a.ws + WS_P); const bf16_t* WAG = (const bf16_t*)(a.ws + WS_WAG); const float* Y = (const float*)(a.ws + WS_Y); const float* BD = (const float*)(a.ws + WS_BD);
    bf16_t* OA = (bf16_t*)(a.ws + WS_OA); const bf16_t* OB = (const bf16_t*)(a.ws + WS_OB);
    const float* mu = a.in[17] + (size_t)L * SHIFT_W + 2048; const float* shift0 = a.in[6] + (size_t)L * DBATCH * SHIFT_W + 2048;
    const int c0 = 16 * lane, h = lane >> 2;
    float lw[16], lb[16], muv[16];
#pragma unroll
    for (int i = 0; i < 16; ++i) { lw[i] = a.in[26][L * D + c0 + i]; lb[i] = a.in[27][L * D + c0 + i]; muv[i] = mu[c0 + i]; }
    for (int m = blockIdx.x * NWAVES + wv; m < M; m += gridDim.x * NWAVES) {
        float y[16];
#pragma unroll
        for (int j = 0; j < 4; ++j) { const f32x4 t4 = *(const f32x4*)(Y + (size_t)m * D + c0 + 4 * j); y[4 * j] = t4[0]; y[4 * j + 1] = t4[1]; y[4 * j + 2] = t4[2]; y[4 * j + 3] = t4[3]; }
        float s = 0.f;
#pragma unroll
        for (int i = 0; i < 16; ++i) s += y[i];
        s += __shfl_xor(s, 1); s += __shfl_xor(s, 2);
        const float mean = s * (1.f / 64.f);
        float q = 0.f;
#pragma unroll
        for (int i = 0; i < 16; ++i) { y[i] -= mean; q += y[i] * y[i]; }
        q += __shfl_xor(q, 1); q += __shfl_xor(q, 2);
        const float rstd = rsqrtf(q * (1.f / 64.f) + GN_EPS);
        const float bd = BD[(size_t)m * 16 + h];
        const bool first = m < MP ? (m % SEQ) == 0 : ((m - MP) % DSEQ) == 0;
        const bf16_t* pr = P + (size_t)m * NP + CRW + 2048 + c0;
#define BFX(v, i) __uint_as_float((((i) & 1) ? ((v)[(i) >> 3][((i) >> 1) & 3] & 0xffff0000u) : ((v)[(i) >> 3][((i) >> 1) & 3] << 16)))
        u32x4 pcv[2], ppv[2], gv[2], gav[2], gbv[2], gcv[2], oav[2], obv[2];
        pcv[0] = *(const u32x4*)pr; pcv[1] = *(const u32x4*)(pr + 8);
        ppv[0] = pcv[0]; ppv[1] = pcv[1];
        if (!first) { ppv[0] = *(const u32x4*)(pr - NP); ppv[1] = *(const u32x4*)(pr - NP + 8); }
        gv[0] = *(const u32x4*)(WAG + (size_t)m * D + c0); gv[1] = *(const u32x4*)(WAG + (size_t)m * D + c0 + 8);
        const bf16_t* pg = P + (size_t)m * NP + CG + c0;
        gav[0] = *(const u32x4*)pg; gav[1] = *(const u32x4*)(pg + 8);
        gbv[0] = *(const u32x4*)(pg + 1024); gbv[1] = *(const u32x4*)(pg + 1024 + 8);
        gcv[0] = *(const u32x4*)(pg + 2048); gcv[1] = *(const u32x4*)(pg + 2048 + 8);
        oav[0] = *(const u32x4*)(OA + (size_t)m * D + c0); oav[1] = *(const u32x4*)(OA + (size_t)m * D + c0 + 8);
        obv[0] = *(const u32x4*)(OB + (size_t)m * D + c0); obv[1] = *(const u32x4*)(OB + (size_t)m * D + c0 + 8);
        float o[16];
#pragma unroll
        for (int i = 0; i < 16; ++i) {
            const float pc = BFX(pcv, i);
            float pv;
            if (first) pv = m < MP ? 0.f : shift0[(size_t)((m - MP) / DSEQ) * SHIFT_W + c0 + i];
            else pv = BFX(ppv, i);
            const float vv = pc + muv[i] * (pv - pc);
            const float yn = y[i] * rstd * lw[i] + lb[i];
            const float oc = (yn + bd * vv) * BFX(gv, i);
            o[i] = BFX(gav, i) * BFX(oav, i) + BFX(gbv, i) * BFX(obv, i) + BFX(gcv, i) * oc;
        }
        u32x4 w0, w1;
        w0.x = pk2bf(o[0], o[1]); w0.y = pk2bf(o[2], o[3]); w0.z = pk2bf(o[4], o[5]); w0.w = pk2bf(o[6], o[7]);
        w1.x = pk2bf(o[8], o[9]); w1.y = pk2bf(o[10], o[11]); w1.z = pk2bf(o[12], o[13]); w1.w = pk2bf(o[14], o[15]);
        *(u32x4*)(OA + (size_t)m * D + c0) = w0; *(u32x4*)(OA + (size_t)m * D + c0 + 8) = w1;
    }
}
#define PH_IN(k) (lo <= (k) && (k) < hi)
#define PH_SYNC(k) do { if (lo < (k) && (k) < hi) cg::this_grid().sync(); } while (0)
template <int L> __device__ __forceinline__ void layer_phases(const Args& a, LAS unsigned char* lds, int lo, int hi) {
    unsigned char* ws = a.ws;
    const int G = gridDim.x;
    constexpr int base = PH_L0 + L * PH_PER_LAYER;
    PH_SYNC(base + PHO_IN);
    if (PH_IN(base + PHO_IN)) {
        pg8::Gemm g{(const bf16_t*)(ws + WS_XB), (const bf16_t*)(ws + WS_WIN + L * WIN_T_BYTES), M, NP, D}; pg8::StaticOrder S; S.init(M, NP, G, (int)blockIdx.x);
        EpiIn E{(bf16_t*)(ws + WS_P), NP, CG / 256};
        pg8::gemm_phase<EpiIn, pg8::StaticOrder, true, true>(lds, g, S, E);
    }
    PH_SYNC(base + PHO_MIXA);
    if (PH_IN(base + PHO_MIXA)) phase_mixa(a, L, lds);
    PH_SYNC(base + PHO_LORA);
    if (PH_IN(base + PHO_LORA)) {
        pg8::Gemm g{(const bf16_t*)(ws + WS_ACAT), (const bf16_t*)(ws + WS_WLORA + L * WLORA_BYTES), M, 3072, ACAT_K}; pg8::StaticOrder S; S.init(M, 3072, G, (int)blockIdx.x);
        EpiLora E{(float*)(ws + WS_WAW), (bf16_t*)(ws + WS_WAA), (bf16_t*)(ws + WS_WAG), a.in[18] + L * D, a.in[20] + L * D};
        pg8::gemm_phase<EpiLora, pg8::StaticOrder, true, true>(lds, g, S, E);
    }
    PH_SYNC(base + PHO_MIXB);
    if (PH_IN(base + PHO_MIXB)) phase_mixb(a, L, lds);
    PH_SYNC(base + PHO_MIXC);
    if (PH_IN(base + PHO_MIXC)) phase_mixc(a, L);
    PH_SYNC(base + PHO_OUT);
    if (PH_IN(base + PHO_OUT)) {
        pg8::Gemm g{(const bf16_t*)(ws + WS_MIX), (const bf16_t*)(ws + WS_WOUT + L * WOUT_T_BYTES), M, D, D}; pg8::StaticOrder S; S.init(M, D, G, (int)blockIdx.x);
        EpiRes E{(const float*)(ws + WS_XF), (float*)(ws + WS_Z), D};
        pg8::gemm_phase<EpiRes, pg8::StaticOrder, true, true>(lds, g, S, E);
    }
    PH_SYNC(base + PHO_LN1);
    if (PH_IN(base + PHO_LN1)) phase_ln((const float*)(ws + WS_Z), a.in[29] + L * D, a.in[30] + L * D, (float*)(ws + WS_X1F), (bf16_t*)(ws + WS_X1B));
    PH_SYNC(base + PHO_GU);
    if (PH_IN(base + PHO_GU)) {
        pg8::Gemm g{(const bf16_t*)(ws + WS_X1B), (const bf16_t*)(ws + WS_WGU + L * WGU_T_BYTES), M, 2 * DFF, D}; pg8::StaticOrder S; S.init(M, 2 * DFF, G, (int)blockIdx.x);
        EpiSwiGLU E{(bf16_t*)(ws + WS_H), DFF};
        pg8::gemm_phase<EpiSwiGLU, pg8::StaticOrder, true, true>(lds, g, S, E);
    }
    PH_SYNC(base + PHO_DOWN);
    if (PH_IN(base + PHO_DOWN)) {
        pg8::Gemm g{(const bf16_t*)(ws + WS_H), (const bf16_t*)(ws + WS_WDN + L * WDN_T_BYTES), M, D, DFF}; pg8::StaticOrder S; S.init(M, D, G, (int)blockIdx.x);
        EpiRes E{(const float*)(ws + WS_X1F), (float*)(ws + WS_Z), D};
        pg8::gemm_phase<EpiRes, pg8::StaticOrder, true, true>(lds, g, S, E);
    }
    PH_SYNC(base + PHO_LN2);
    if (PH_IN(base + PHO_LN2)) {
        if (L == DEPTH - 1) phase_ln((const float*)(ws + WS_Z), a.in[33] + L * D, a.in[34] + L * D, a.out + O_YP, nullptr);
        else phase_ln((const float*)(ws + WS_Z), a.in[33] + L * D, a.in[34] + L * D, (float*)(ws + WS_XF), (bf16_t*)(ws + WS_XB));
    }
}
__global__ void __launch_bounds__(NTHREADS, 2) mega(Args a) {
    extern __shared__ __attribute__((aligned(16))) unsigned char lds_raw[];
    LAS unsigned char* lds = (LAS unsigned char*)lds_raw;
    const int lo = a.ph_lo, hi = a.ph_hi;
    if (PH_IN(PH_PREP)) { phase_prep(a, lds); prep_wlora(a); }
    layer_phases<0>(a, lds, lo, hi);
    layer_phases<1>(a, lds, lo, hi);
}

static void launch_mega(Args a, int lo, int hi, int grid, hipStream_t s) {
    a.ph_lo = lo; a.ph_hi = hi;
    void* args[] = {&a};
    hipError_t e;
    if (hi - lo > 1) e = hipLaunchCooperativeKernel((void*)mega, dim3(grid), dim3(NTHREADS), args, LDS_BYTES, s);
    else e = hipLaunchKernel((void*)mega, dim3(grid), dim3(NTHREADS), args, LDS_BYTES, s);
    if (e != hipSuccess) fprintf(stderr, "mega launch [%d,%d) failed: %s (grid %d)\n", lo, hi, hipGetErrorString(e), grid);
}

extern "C" void kernel_launch(void* const* d_in, const int* in_sizes, int n_in, void* d_out, int out_size,
                              void* d_ws, size_t ws_size, hipStream_t stream) {
    if (ws_size < WS_END || out_size != (int)O_END || n_in != 35) { fprintf(stderr, "kernel_launch: unexpected sizes ws=%zu out=%d n_in=%d\n", ws_size, out_size, n_in); return; }
    static int grid = 0;
    if (!grid) {
        int dev = 0, cus = 0, per_cu = 0;
        (void)hipGetDevice(&dev);
        (void)hipDeviceGetAttribute(&cus, hipDeviceAttributeMultiprocessorCount, dev);
        (void)hipFuncSetAttribute((const void*)mega, hipFuncAttributeMaxDynamicSharedMemorySize, LDS_BYTES);
        (void)hipOccupancyMaxActiveBlocksPerMultiprocessor(&per_cu, (const void*)mega, NTHREADS, LDS_BYTES);
        if (per_cu < 1) { fprintf(stderr, "occupancy query says %d blocks per CU\n", per_cu); per_cu = 1; }
        grid = cus * per_cu;
    }
    const float* const* in = (const float* const*)d_in;
    unsigned char* ws = (unsigned char*)d_ws;
    float* out = (float*)d_out;
    Args a{};
    for (int i = 0; i < 35; ++i) a.in[i] = in[i];
    a.out = out; a.ws = ws;
    launch_mega(a, 0, N_PHASES, grid, stream);
}
```

```cpp
#include <hip/hip_runtime.h>
#include <cstdint>
#include <cstdio>

typedef unsigned short bf16_t;
__device__ __forceinline__ float bf2f(bf16_t v) { return __uint_as_float(((unsigned)v) << 16); }
__device__ __forceinline__ bf16_t f2bf(float f) { unsigned u = __float_as_uint(f); return (bf16_t)((u + 0x7fffu + ((u >> 16) & 1u)) >> 16); }
__device__ __forceinline__ float sigmoidf_(float x) { return 1.f / (1.f + __expf(-x)); }
__device__ __forceinline__ float softplusf_(float x) { return fmaxf(x, 0.f) + log1pf(__expf(-fabsf(x))); }
__device__ __forceinline__ float wave_sum(float v) {
#pragma unroll
    for (int o = 1; o < 64; o <<= 1) v += __shfl_xor(v, o);
    return v;
}

constexpr int D = 1024, MP = 16384, MS = 1024, M = MP + MS, SEQ = 8192, DSEQ = 8, NBATCH = 2, DBATCH = 128, DEPTH = 2;
constexpr int NP = 9216, IN_COLS = 8992;
constexpr int CQ = 0, CK = 1024, CV = 1280, CRNN = 1536, CRW = 2560, CG = 6144;
constexpr int SHIFT_W = 3360, DFF = 2816;
constexpr float ALPHA = 1.4142135623730951f;
constexpr float LN_EPS = 1e-5f, GN_EPS = 64e-5f;

constexpr size_t O_YP = 0, O_YS = 16777216, O_PK = 17825792, O_PV = 17956864, O_PCONV = 18087936, O_PH = 18100224,
                 O_PSHIFT = 18104320, O_PWKV = 18117760, O_SK = 18379904, O_SV = 26768512, O_SCONV = 35157120,
                 O_SH = 35943552, O_SSHIFT = 36205696, O_SWKV = 37065856, O_END = 53843072;


constexpr size_t MiB = 1u << 20;
constexpr size_t WS_CTL = 0;
constexpr size_t WIN_T_BYTES = (size_t)NP * D * 2, WOUT_T_BYTES = (size_t)D * D * 2, WGU_T_BYTES = (size_t)2 * DFF * D * 2, WDN_T_BYTES = (size_t)D * DFF * 2;
constexpr size_t WS_WIN = 1 * MiB;
constexpr size_t WS_WOUT = WS_WIN + 2 * WIN_T_BYTES;
constexpr size_t WS_WGU = WS_WOUT + 2 * WOUT_T_BYTES;
constexpr size_t WS_WDN = WS_WGU + 2 * WGU_T_BYTES;
constexpr size_t WS_XB = WS_WDN + 2 * WDN_T_BYTES;
constexpr size_t WS_XF = WS_XB + (size_t)M * D * 2;
constexpr size_t WS_OA = WS_XF + (size_t)M * D * 4;
constexpr size_t WS_MIX = WS_OA;
constexpr size_t WS_OB = WS_OA + (size_t)M * D * 2;
constexpr size_t WS_P = WS_OB + (size_t)M * D * 2;
constexpr size_t WS_Z = WS_P;
constexpr size_t WS_X1F = WS_Z + (size_t)M * D * 4;
constexpr size_t WS_X1B = WS_X1F + (size_t)M * D * 4;
constexpr size_t WS_H = WS_X1B + (size_t)M * D * 2;
constexpr size_t WS_PEND = WS_P + (size_t)M * NP * 2;
constexpr size_t WS_RS = WS_PEND;
constexpr int ACAT_K = 384;
constexpr size_t WS_ACAT = WS_RS + (size_t)2 * 128 * 1024 * 2 * 4;
constexpr size_t WLORA_BYTES = (size_t)3072 * ACAT_K * 2;
constexpr size_t WS_WLORA = WS_ACAT + (size_t)M * ACAT_K * 2;
constexpr size_t WS_WAW = WS_WLORA + 2 * WLORA_BYTES;
constexpr size_t WS_WAA = WS_WAW + (size_t)M * D * 4;
constexpr size_t WS_WAG = WS_WAA + (size_t)M * D * 2;
constexpr size_t WS_Y = WS_WAG + (size_t)M * D * 2;
constexpr size_t WS_OC = WS_Y;
constexpr size_t WS_BD = WS_Y + (size_t)M * D * 4;
constexpr size_t WS_END = WS_BD + (size_t)M * 16 * 4;
static_assert(WS_END <= (size_t)861000000, "workspace budget (4 x output bytes = 861.5 MB)");
static_assert(WS_H + (size_t)M * DFF * 2 <= WS_PEND, "overlay fits");
static_assert(WS_XB % 256 == 0 && WS_P % 256 == 0, "alignment");
namespace pg8 {
#define PG8_LAS __attribute__((address_space(3)))
typedef unsigned short bf16_t;
typedef short bf16x8 __attribute__((ext_vector_type(8)));
typedef float f32x4 __attribute__((ext_vector_type(4)));
typedef unsigned u32x4 __attribute__((ext_vector_type(4)));
constexpr int BM = 256, BK = 64, HALF = 128, HTB = HALF * BK * 2  , STAGE_BYTES = 8 * HTB, NXCD = 8, WGM = 8;

__host__ __device__ __forceinline__ int lds_byte(int r, int c) { const int st = (r >> 4) * 2 + (c >> 5), rr = r & 15, cc = c & 31, ob = rr * 64 + cc * 2; return st * 1024 + (ob ^ (((ob >> 9) & 1) << 5)); }
__host__ __device__ __forceinline__ void stage_rc(int b, int& R, int& C) { const int st = b / 1024, sb = b % 1024, swz = sb ^ (((sb >> 9) & 1) << 5); R = (st >> 1) * 16 + swz / 64; C = (st & 1) * 32 + (swz % 64) / 2; }
__host__ __device__ __forceinline__ int perm32(int rho) { const int n = rho >> 4, i = rho & 15; return 8 * (i >> 2) + 4 * n + (i & 3); }

struct Unit { int pm, pn; };
struct Gemm { const bf16_t* A; const bf16_t* Bt; int M, N, K; };

struct StaticOrder {
    int nM, nN, nwg, G, c;
    __host__ __device__ void init(int M, int N, int G_, int c_) { nM = M / BM; nN = N / BM; nwg = nM * nN; G = G_; c = c_; }
    __host__ __device__ bool next(int i, Unit& u) const {
        const long L = (long)i * G + c; if (L >= nwg) return false;
        int wgid = (int)L; { const int q = nwg / NXCD, r = nwg % NXCD, xcd = wgid % NXCD, off = wgid / NXCD; wgid = (xcd < r ? xcd * (q + 1) : r * (q + 1) + (xcd - r) * q) + off; }
        const int nig = WGM * nN, gid = wgid / nig, fm = gid * WGM, gsz = (nM - fm) < WGM ? (nM - fm) : WGM;
        u.pm = fm + ((wgid % nig) % gsz); u.pn = (wgid % nig) / gsz; return true;
    }
    __device__ __forceinline__ void a_ready(const Unit&) const {}
    __device__ __forceinline__ void done(const Unit&) const {}
};

__device__ __forceinline__ unsigned cvt_pk_bf16(float lo, float hi) { unsigned r; asm volatile("v_cvt_pk_bf16_f32 %0, %1, %2" : "=v"(r) : "v"(lo), "v"(hi)); return r; }
typedef float f32x2 __attribute__((ext_vector_type(2)));
template <class Epi, class Sched, bool ALIGN_EPI = false, bool SP2 = false>
__device__ __forceinline__ void gemm_phase(PG8_LAS unsigned char* lds, const Gemm g, const Sched& S, const Epi& E) {
    const int tid = threadIdx.x, wid = __builtin_amdgcn_readfirstlane(tid >> 6), lane = tid & 63, wr = wid >> 2, wc = wid & 3, fr = lane & 15, fq = lane >> 4;
    const int K = g.K, nt = K / BK;
    unsigned voffA[2], voffB[2];
#pragma unroll
    for (int i = 0; i < 2; ++i) { int R, C; stage_rc(tid * 16 + i * 8192, R, C); const int Rb = Epi::PERM ? ((R & ~31) + perm32(R & 31)) : R;
        voffA[i] = (unsigned)(R * K + C) * 2u; voffB[i] = (unsigned)(Rb * K + C) * 2u; }
    const size_t kstep = (size_t)(BK * 2);
    const size_t hstep = (size_t)HALF * K * 2;
    const size_t tstep = 2 * hstep;
    const unsigned ldsw = (unsigned)wid * 1024u;
    const int aoff = lds_byte(wr * 64 + fr, fq * 8), boff = lds_byte(wc * 32 + fr, fq * 8);
#define PG8_SA(b, h) (((b) * 2 + (h)) * HTB)
#define PG8_SB(b, h) ((4 + (b) * 2 + (h)) * HTB)
#define PG8_STAGE(bufoff, gbase, voff) do { _Pragma("unroll") for (int _i = 0; _i < 2; ++_i) \
        __builtin_amdgcn_global_load_lds((const unsigned*)((const char*)(gbase) + (voff)[_i]), (PG8_LAS unsigned*)(lds + (bufoff) + ldsw + _i * 8192), 16, 0, 0); } while (0)
#define PG8_LDA(dst, b, h) do { _Pragma("unroll") for (int m = 0; m < 4; ++m) _Pragma("unroll") for (int k = 0; k < 2; ++k) dst[m][k] = *(const PG8_LAS bf16x8*)(lds + PG8_SA(b, h) + aoff + m * 2048 + k * 1024); } while (0)
#define PG8_LDB(dst, b, h) do { _Pragma("unroll") for (int n = 0; n < 2; ++n) _Pragma("unroll") for (int k = 0; k < 2; ++k) dst[n][k] = *(const PG8_LAS bf16x8*)(lds + PG8_SB(b, h) + boff + n * 2048 + k * 1024); } while (0)
#define PG8_MMA(ai, bj, At, Bt) do { __builtin_amdgcn_s_setprio(1); _Pragma("unroll") for (int m = 0; m < 4; ++m) _Pragma("unroll") for (int n = 0; n < 2; ++n) _Pragma("unroll") for (int k = 0; k < 2; ++k) \
        acc[ai][bj][m][n] = __builtin_amdgcn_mfma_f32_16x16x32_bf16(Bt[n][k], At[m][k], acc[ai][bj][m][n], 0, 0, 0); __builtin_amdgcn_s_setprio(0); } while (0)
#define PG8_WAIT_V(n) asm volatile("s_waitcnt vmcnt(" #n ")" ::: "memory")
#define PG8_WAIT_L(n) asm volatile("s_waitcnt lgkmcnt(" #n ")" ::: "memory")
#define PG8_BAR __builtin_amdgcn_s_barrier()
#define PG8_SCHED __builtin_amdgcn_sched_barrier(0)
    Unit cur, nxt; int ui = 0;
    if (!S.next(0, cur)) return;
    f32x4 acc[2][2][4][2];
#pragma unroll
    for (int a = 0; a < 2; ++a)
#pragma unroll
        for (int b = 0; b < 2; ++b)
#pragma unroll
            for (int m = 0; m < 4; ++m)
#pragma unroll
                for (int n = 0; n < 2; ++n) acc[a][b][m][n] = (f32x4){0.f, 0.f, 0.f, 0.f};
    bf16x8 At[4][2], B0[2][2], B1[2][2];
    const char* cA = (const char*)g.A + (size_t)cur.pm * tstep; const char* cB = (const char*)g.Bt + (size_t)cur.pn * tstep;
    S.a_ready(cur);
    if constexpr (SP2) {
        PG8_STAGE(PG8_SB(0, 0), cB, voffB); PG8_STAGE(PG8_SB(0, 1), cB + hstep, voffB); PG8_STAGE(PG8_SA(0, 0), cA, voffA); PG8_STAGE(PG8_SA(0, 1), cA + hstep, voffA);
        if (wr == 1) PG8_BAR;
        PG8_WAIT_V(2); PG8_BAR;
        PG8_STAGE(PG8_SB(1, 0), cB + kstep, voffB); PG8_STAGE(PG8_SA(1, 0), cA + kstep, voffA); PG8_STAGE(PG8_SB(1, 1), cB + hstep + kstep, voffB);
        PG8_WAIT_V(6); PG8_BAR;
    } else {
        PG8_STAGE(PG8_SB(0, 0), cB, voffB); PG8_STAGE(PG8_SA(0, 0), cA, voffA); PG8_STAGE(PG8_SB(0, 1), cB + hstep, voffB); PG8_STAGE(PG8_SA(0, 1), cA + hstep, voffA);
        if (wr == 1) PG8_BAR;
        PG8_WAIT_V(4); PG8_BAR;
        PG8_STAGE(PG8_SB(1, 0), cB + kstep, voffB); PG8_STAGE(PG8_SA(1, 0), cA + kstep, voffA); PG8_STAGE(PG8_SB(1, 1), cB + hstep + kstep, voffB);
        PG8_WAIT_V(6); PG8_BAR;
    }
    for (;;) {
        const bool has_next = S.next(ui + 1, nxt);
        const char* nA = has_next ? (const char*)g.A + (size_t)nxt.pm * tstep : cA; const char* nB = has_next ? (const char*)g.Bt + (size_t)nxt.pn * tstep : cB;
#pragma nounroll
        for (int t = 0; t < nt; t += 2) {
            const bool last = (t == nt - 2);
            const char* a1 = cA + (size_t)(t + 1) * kstep;
            const char* a2 = last ? nA : cA + (size_t)(t + 2) * kstep; const char* b2 = last ? nB : cB + (size_t)(t + 2) * kstep;
            const char* a3 = a2 + kstep; const char* b3 = b2 + kstep;
            if (last && has_next) S.a_ready(nxt);
            if constexpr (SP2) {
            PG8_LDB(B0, 0, 0); PG8_LDB(B1, 0, 1); PG8_SCHED; PG8_LDA(At, 0, 0); PG8_STAGE(PG8_SA(1, 1), a1 + hstep, voffA);
            PG8_WAIT_V(8); PG8_WAIT_L(0); PG8_BAR; PG8_MMA(0, 0, At, B0); PG8_MMA(0, 1, At, B1); PG8_BAR; PG8_SCHED;
            PG8_LDA(At, 0, 1); PG8_STAGE(PG8_SB(0, 0), b2, voffB); PG8_STAGE(PG8_SB(0, 1), b2 + hstep, voffB); PG8_STAGE(PG8_SA(0, 0), a2, voffA);
            PG8_WAIT_V(8); PG8_WAIT_L(0); PG8_BAR; PG8_MMA(1, 0, At, B0); PG8_MMA(1, 1, At, B1); PG8_BAR; PG8_SCHED;
            PG8_LDB(B0, 1, 0); PG8_LDB(B1, 1, 1); PG8_SCHED; PG8_LDA(At, 1, 0); PG8_STAGE(PG8_SA(0, 1), a2 + hstep, voffA);
            PG8_WAIT_V(8); PG8_WAIT_L(0); PG8_BAR; PG8_MMA(0, 0, At, B0); PG8_MMA(0, 1, At, B1); PG8_BAR; PG8_SCHED;
            PG8_LDA(At, 1, 1); PG8_STAGE(PG8_SB(1, 0), b3, voffB); PG8_STAGE(PG8_SB(1, 1), b3 + hstep, voffB); PG8_STAGE(PG8_SA(1, 0), a3, voffA);
            PG8_WAIT_V(8); PG8_WAIT_L(0); PG8_BAR; PG8_MMA(1, 0, At, B0); PG8_MMA(1, 1, At, B1); PG8_BAR; PG8_SCHED;
            } else {
            PG8_LDB(B0, 0, 0); PG8_SCHED; PG8_LDA(At, 0, 0); PG8_STAGE(PG8_SA(1, 1), a1 + hstep, voffA);
            PG8_WAIT_L(8); PG8_BAR; PG8_WAIT_L(0); PG8_MMA(0, 0, At, B0); PG8_BAR; PG8_SCHED;
            PG8_LDB(B1, 0, 1); PG8_STAGE(PG8_SB(0, 0), b2, voffB);
            PG8_BAR; PG8_WAIT_L(0); PG8_MMA(0, 1, At, B1); PG8_BAR;
            PG8_LDA(At, 0, 1); PG8_STAGE(PG8_SA(0, 0), a2, voffA);
            PG8_BAR; PG8_WAIT_L(0); PG8_MMA(1, 0, At, B0); PG8_BAR; PG8_SCHED;
            PG8_STAGE(PG8_SB(0, 1), b2 + hstep, voffB);
            PG8_WAIT_V(6); PG8_BAR; PG8_MMA(1, 1, At, B1); PG8_BAR;
            PG8_LDB(B0, 1, 0); PG8_SCHED; PG8_LDA(At, 1, 0); PG8_STAGE(PG8_SA(0, 1), a2 + hstep, voffA);
            PG8_WAIT_L(8); PG8_BAR; PG8_WAIT_L(0); PG8_MMA(0, 0, At, B0); PG8_BAR; PG8_SCHED;
            PG8_LDB(B1, 1, 1); PG8_STAGE(PG8_SB(1, 0), b3, voffB);
            PG8_BAR; PG8_WAIT_L(0); PG8_MMA(0, 1, At, B1); PG8_BAR;
            PG8_LDA(At, 1, 1); PG8_STAGE(PG8_SA(1, 0), a3, voffA);
            PG8_BAR; PG8_WAIT_L(0); PG8_MMA(1, 0, At, B0); PG8_BAR; PG8_SCHED;
            PG8_STAGE(PG8_SB(1, 1), b3 + hstep, voffB);
            PG8_WAIT_V(6); PG8_BAR; PG8_MMA(1, 1, At, B1); PG8_BAR;
            }
        }
        if constexpr (ALIGN_EPI) { if (wr == 0) PG8_BAR; }
        if constexpr (!Epi::AFTER_DRAIN) { E(acc, cur, wr, wc, fr, fq); S.done(cur); }
        if (!has_next) break;
#pragma unroll
        for (int a = 0; a < 2; ++a)
#pragma unroll
            for (int b = 0; b < 2; ++b)
#pragma unroll
                for (int m = 0; m < 4; ++m)
#pragma unroll
                    for (int n = 0; n < 2; ++n) acc[a][b][m][n] = (f32x4){0.f, 0.f, 0.f, 0.f};
        cur = nxt; cA = nA; cB = nB; ++ui;
        if constexpr (ALIGN_EPI) { if (wr == 1) PG8_BAR; }
    }
    PG8_WAIT_V(0);
    if constexpr (!ALIGN_EPI) { if (wr == 0) PG8_BAR; }
    PG8_BAR;
    if constexpr (Epi::AFTER_DRAIN) { E.fused(acc, cur, wr, wc, fr, fq, lds, wid, lane); S.done(cur); }
#undef PG8_SA
#undef PG8_SB
#undef PG8_STAGE
#undef PG8_LDA
#undef PG8_LDB
#undef PG8_MMA
#undef PG8_WAIT_V
#undef PG8_WAIT_L
#undef PG8_BAR
#undef PG8_SCHED
}
}

#include <hip/hip_cooperative_groups.h>
namespace cg = cooperative_groups;
#define LAS __attribute__((address_space(3)))
typedef float f32x4 __attribute__((ext_vector_type(4)));
typedef unsigned u32x4 __attribute__((ext_vector_type(4)));
typedef unsigned u32x2 __attribute__((ext_vector_type(2)));

constexpr int NTHREADS = 512, NWAVES = 8;
constexpr int LDS_BYTES = 147456;

constexpr int PH_PREP = 0, PH_PER_LAYER = 10, PH_L0 = 1;
constexpr int PHO_IN = 0, PHO_MIXA = 1, PHO_LORA = 2, PHO_MIXB = 3, PHO_MIXC = 4, PHO_OUT = 5, PHO_LN1 = 6, PHO_GU = 7, PHO_DOWN = 8, PHO_LN2 = 9;
constexpr int N_PHASES = PH_L0 + DEPTH * PH_PER_LAYER;

struct Args { const float* in[35]; float* out; unsigned char* ws; int ph_lo, ph_hi; };

typedef float f32x2_t __attribute__((ext_vector_type(2))); typedef __bf16 bf16x2_t __attribute__((ext_vector_type(2)));
__device__ __forceinline__ unsigned pk2bf(float lo, float hi) { f32x2_t v = {lo, hi}; bf16x2_t b = __builtin_convertvector(v, bf16x2_t); return __builtin_bit_cast(unsigned, b); }

struct EpiIn {
    static constexpr bool PERM = true, AFTER_DRAIN = false;
    bf16_t* O; int ldc; int sig_pn;
    __device__ __forceinline__ void operator()(const f32x4 (&acc)[2][2][4][2], const pg8::Unit& u, int wr, int wc, int fr, int fq) const {
        const int row0 = u.pm * 256 + wr * 64 + fr, col0 = u.pn * 256 + wc * 32 + 8 * fq;
        const bool sg = u.pn >= sig_pn;
#pragma unroll
        for (int ai = 0; ai < 2; ++ai)
#pragma unroll
            for (int m = 0; m < 4; ++m) {
                bf16_t* rowp = O + (size_t)(row0 + ai * 128 + m * 16) * ldc + col0;
#pragma unroll
                for (int bj = 0; bj < 2; ++bj) {
                    f32x4 v0 = acc[ai][bj][m][0], v1 = acc[ai][bj][m][1];
                    if (sg) {
#pragma unroll
                        for (int i = 0; i < 4; ++i) { v0[i] = sigmoidf_(v0[i]); v1[i] = sigmoidf_(v1[i]); }
                    }
                    u32x4 w; w.x = pk2bf(v0[0], v0[1]); w.y = pk2bf(v0[2], v0[3]); w.z = pk2bf(v1[0], v1[1]); w.w = pk2bf(v1[2], v1[3]);
                    *(u32x4*)(rowp + bj * 128) = w;
                }
                asm volatile("" ::: "memory");
            }
    }
};
struct EpiRes {
    static constexpr bool PERM = false, AFTER_DRAIN = false;
    const float* res; float* Z; int ldc;
    __device__ __forceinline__ void operator()(const f32x4 (&acc)[2][2][4][2], const pg8::Unit& u, int wr, int wc, int fr, int fq) const {
        const int col0 = u.pn * 256 + wc * 32 + 4 * fq;
#pragma unroll
        for (int ai = 0; ai < 2; ++ai)
#pragma unroll
            for (int m = 0; m < 4; ++m) {
                const size_t off = (size_t)(u.pm * 256 + ai * 128 + wr * 64 + m * 16 + fr) * ldc + col0;
#pragma unroll
                for (int bj = 0; bj < 2; ++bj)
#pragma unroll
                    for (int n = 0; n < 2; ++n) {
                        const f32x4 r = *(const f32x4*)(res + off + bj * 128 + n * 16);
                        *(f32x4*)(Z + off + bj * 128 + n * 16) = r * ALPHA + acc[ai][bj][m][n];
                    }
                asm volatile("" ::: "memory");
            }
    }
};
struct EpiSwiGLU {
    static constexpr bool PERM = true, AFTER_DRAIN = false;
    bf16_t* H; int ldc;
    __device__ __forceinline__ void operator()(const f32x4 (&acc)[2][2][4][2], const pg8::Unit& u, int wr, int wc, int fr, int fq) const {
        const int row0 = u.pm * 256 + wr * 64 + fr, col0 = u.pn * 128 + wc * 32 + 8 * fq;
#pragma unroll
        for (int ai = 0; ai < 2; ++ai)
#pragma unroll
            for (int m = 0; m < 4; ++m) {
                bf16_t* rowp = H + (size_t)(row0 + ai * 128 + m * 16) * ldc + col0;
                float o[8];
#pragma unroll
                for (int n = 0; n < 2; ++n)
#pragma unroll
                    for (int i = 0; i < 4; ++i) { const float g = acc[ai][0][m][n][i], up = acc[ai][1][m][n][i]; o[n * 4 + i] = g * sigmoidf_(g) * up; }
                u32x4 w; w.x = pk2bf(o[0], o[1]); w.y = pk2bf(o[2], o[3]); w.z = pk2bf(o[4], o[5]); w.w = pk2bf(o[6], o[7]);
                *(u32x4*)rowp = w;
                asm volatile("" ::: "memory");
            }
    }
};

template <int MODE> __device__ __forceinline__ int colmap(int n) {
    if (MODE == 0) return n < 5920 ? n : (n < 6144 ? -1 : n - 224);
    if (MODE == 2) { const int pn = n >> 8, q = n & 255; return q < 128 ? pn * 128 + q : DFF + pn * 128 + (q - 128); }
    return n;
}
template <int MODE> __device__ __forceinline__ void transpose_item(const float* __restrict__ W, int K, int ldw, bf16_t* WT, int item, int nblk, LAS float* tile, int tid) {
    const int kb = item / nblk, nb = item % nblk, k0 = kb * 64, n0 = nb * 64;
    {
        const int nn = tid & 63; const int col = colmap<MODE>(n0 + nn);
#pragma unroll
        for (int i = 0; i < 8; ++i) { const int kk = i * 8 + (tid >> 6); tile[kk * 65 + nn] = col >= 0 ? W[(size_t)(k0 + kk) * ldw + col] : 0.f; }
    }
    __syncthreads();
    {
        const int nn = tid >> 3, c = tid & 7; const LAS float* s = tile + (8 * c) * 65 + nn;
        u32x4 o; o.x = pk2bf(s[0], s[65]); o.y = pk2bf(s[2 * 65], s[3 * 65]); o.z = pk2bf(s[4 * 65], s[5 * 65]); o.w = pk2bf(s[6 * 65], s[7 * 65]);
        *(u32x4*)(WT + (size_t)(n0 + nn) * K + k0 + 8 * c) = o;
    }
    __syncthreads();
}
__device__ __forceinline__ void phase_prep(const Args& a, LAS unsigned char* lds) {
    const int tid = threadIdx.x, G = gridDim.x, bx = blockIdx.x;
    LAS float* tile = (LAS float*)lds;
    constexpr int I_IN = (D / 64) * (NP / 64), I_OUT = (D / 64) * (D / 64), I_GU = (D / 64) * (2 * DFF / 64), I_DN = (DFF / 64) * (D / 64);
    constexpr int I_LAYER = I_IN + I_OUT + I_GU + I_DN;
    for (int it = bx; it < DEPTH * I_LAYER; it += G) {
        const int l = it / I_LAYER; int r = it % I_LAYER;
        if (r < I_IN) { transpose_item<0>(a.in[8] + (size_t)l * D * IN_COLS, D, IN_COLS, (bf16_t*)(a.ws + WS_WIN + l * WIN_T_BYTES), r, NP / 64, tile, tid); continue; } r -= I_IN;
        if (r < I_OUT) { transpose_item<1>(a.in[28] + (size_t)l * D * D, D, D, (bf16_t*)(a.ws + WS_WOUT + l * WOUT_T_BYTES), r, D / 64, tile, tid); continue; } r -= I_OUT;
        if (r < I_GU) { transpose_item<2>(a.in[31] + (size_t)l * D * 2 * DFF, D, 2 * DFF, (bf16_t*)(a.ws + WS_WGU + l * WGU_T_BYTES), r, 2 * DFF / 64, tile, tid); continue; } r -= I_GU;
        transpose_item<1>(a.in[32] + (size_t)l * DFF * D, DFF, D, (bf16_t*)(a.ws + WS_WDN + l * WDN_T_BYTES), r, D / 64, tile, tid);
    }
    float* XF = (float*)(a.ws + WS_XF); bf16_t* XB = (bf16_t*)(a.ws + WS_XB);
    const size_t n4 = (size_t)M * D / 4, np4 = (size_t)MP * D / 4;
    for (size_t i = (size_t)bx * NTHREADS + tid; i < n4; i += (size_t)G * NTHREADS) {
        const f32x4 v = i < np4 ? ((const f32x4*)a.in[0])[i] : ((const f32x4*)a.in[1])[i - np4];
        ((f32x4*)XF)[i] = v;
        u32x2 w; w.x = pk2bf(v[0], v[1]); w.y = pk2bf(v[2], v[3]);
        ((u32x2*)XB)[i] = w;
    }
}

__device__ __forceinline__ void phase_ln(const float* __restrict__ Z, const float* __restrict__ g, const float* __restrict__ b, float* OF, bf16_t* OB) {
    const int lane = threadIdx.x & 63, wv = threadIdx.x >> 6;
    f32x4 gv[4], bv[4];
#pragma unroll
    for (int j = 0; j < 4; ++j) { gv[j] = ((const f32x4*)g)[j * 64 + lane]; bv[j] = ((const f32x4*)b)[j * 64 + lane]; }
    for (int m = blockIdx.x * NWAVES + wv; m < M; m += gridDim.x * NWAVES) {
        const f32x4* z = (const f32x4*)(Z + (size_t)m * D);
        f32x4 v[4]; float s = 0.f;
#pragma unroll
        for (int j = 0; j < 4; ++j) { v[j] = z[j * 64 + lane]; s += (v[j][0] + v[j][1]) + (v[j][2] + v[j][3]); }
        const float mean = wave_sum(s) * (1.f / D);
        float q = 0.f;
#pragma unroll
        for (int j = 0; j < 4; ++j) { v[j] = v[j] - mean; q += (v[j][0] * v[j][0] + v[j][1] * v[j][1]) + (v[j][2] * v[j][2] + v[j][3] * v[j][3]); }
        const float rstd = rsqrtf(wave_sum(q) * (1.f / D) + LN_EPS);
#pragma unroll
        for (int j = 0; j < 4; ++j) {
            const f32x4 y = v[j] * rstd * gv[j] + bv[j];
            ((f32x4*)(OF + (size_t)m * D))[j * 64 + lane] = y;
            if (OB) { u32x2 w; w.x = pk2bf(y[0], y[1]); w.y = pk2bf(y[2], y[3]); ((u32x2*)(OB + (size_t)m * D))[j * 64 + lane] = w; }
        }
    }
}


typedef short bf16x8_t __attribute__((ext_vector_type(8)));
typedef short bf16x4_t __attribute__((ext_vector_type(4)));
#define LDSW() asm volatile("s_waitcnt lgkmcnt(0)" ::: "memory")

constexpr int AT_KPB = 144;
constexpr int AT_VPB = 528;
constexpr int AT_K_OFF = 0, AT_V_OFF = 256 * AT_KPB;
constexpr int AT_LDS = AT_V_OFF + 64 * AT_VPB;

template <bool SAMPLE>
__device__ __forceinline__ void attn_unit(const bf16_t* __restrict__ P, bf16_t* OA, const float* __restrict__ sinks, const float* __restrict__ ck, const float* __restrict__ cv,
                                          int b, int qb, int c, LAS unsigned char* lds) {
    const int tid = threadIdx.x, lane = tid & 63, wv = __builtin_amdgcn_readfirstlane(tid >> 6), i16 = lane & 15, qp = lane >> 4;
    LAS unsigned char* ldsK = lds + AT_K_OFF; LAS unsigned char* ldsV = lds + AT_V_OFF;
    if (!SAMPLE) {
        const size_t row_base = (size_t)b * SEQ + (size_t)(qb - 1) * 128;
#pragma unroll
        for (int it = 0; it < 4; ++it) {
            const int ci = tid + 512 * it, s = ci >> 3, part = ci & 7;
            u32x4 kv = (u32x4){0u, 0u, 0u, 0u}, vv = (u32x4){0u, 0u, 0u, 0u};
            if (qb > 0 || s >= 128) {
                const bf16_t* pr = P + (row_base + s) * NP;
                kv = *(const u32x4*)(pr + CK + 64 * c + 8 * part);
                vv = *(const u32x4*)(pr + CV + 64 * c + 8 * part);
            }
            *(LAS u32x4*)(ldsK + s * AT_KPB + part * 16) = kv;
            const unsigned w4[4] = {vv.x, vv.y, vv.z, vv.w};
#pragma unroll
            for (int e = 0; e < 8; ++e) *(LAS unsigned short*)(ldsV + (8 * part + e) * AT_VPB + 2 * s) = (unsigned short)((w4[e >> 1] >> (16 * (e & 1))) & 0xffffu);
        }
    } else {
        for (int ci = tid; ci < 144 * 16; ci += 512) {
            const int s = ci >> 4, part = ci & 15;
            float kf[4] = {0.f, 0.f, 0.f, 0.f}, vf[4] = {0.f, 0.f, 0.f, 0.f};
            if (s < 128) {
                const f32x4 k4 = *(const f32x4*)(ck + ((size_t)(b * 128 + s) * 4 + c) * 64 + 4 * part);
                const f32x4 v4 = *(const f32x4*)(cv + ((size_t)(b * 128 + s) * 4 + c) * 64 + 4 * part);
#pragma unroll
                for (int e = 0; e < 4; ++e) { kf[e] = k4[e]; vf[e] = v4[e]; }
            } else if (s < 136) {
                const bf16_t* pr = P + (size_t)(MP + b * DSEQ + (s - 128)) * NP;
#pragma unroll
                for (int e = 0; e < 4; ++e) { kf[e] = bf2f(pr[CK + 64 * c + 4 * part + e]); vf[e] = bf2f(pr[CV + 64 * c + 4 * part + e]); }
            }
            u32x2 kw; kw.x = pk2bf(kf[0], kf[1]); kw.y = pk2bf(kf[2], kf[3]);
            *(LAS u32x2*)(ldsK + s * AT_KPB + part * 8) = kw;
#pragma unroll
            for (int e = 0; e < 4; ++e) *(LAS unsigned short*)(ldsV + (4 * part + e) * AT_VPB + 2 * s) = f2bf(vf[e]);
        }
    }
    __syncthreads();
    const int n_mt = SAMPLE ? 1 : 4;
    if (!SAMPLE || wv < 2) {
        for (int mt = 0; mt < n_mt; ++mt) {
            int h, tq, nt0; size_t qrow;
            if (!SAMPLE) { const int g = wv >> 1, qh = wv & 1; h = 4 * c + g; tq = 64 * qh + 16 * mt + i16; nt0 = (64 * qh + 16 * mt) >> 4; qrow = (size_t)b * SEQ + (size_t)qb * 128 + tq; }
            else { const int rho = 16 * wv + i16; h = 4 * c + (rho >> 3); tq = rho & 7; nt0 = 0; qrow = (size_t)MP + b * DSEQ + tq; }
            const float slope = exp2f(-0.5f * (float)(h + 1)), sink = sinks[h];
            bf16x8_t qf[2];
#pragma unroll
            for (int ks = 0; ks < 2; ++ks) qf[ks] = *(const bf16x8_t*)(P + qrow * NP + CQ + 64 * h + 32 * ks + 8 * qp);
            f32x4 sc[9];
#pragma unroll
            for (int jn = 0; jn < 9; ++jn) {
                const int nt = nt0 + jn;
                f32x4 acc = (f32x4){0.f, 0.f, 0.f, 0.f};
                if (SAMPLE || qb > 0 || nt >= 8) {
#pragma unroll
                    for (int ks = 0; ks < 2; ++ks) {
                        const bf16x8_t kfr = *(const LAS bf16x8_t*)(ldsK + (16 * nt + i16) * AT_KPB + (32 * ks + 8 * qp) * 2);
                        acc = __builtin_amdgcn_mfma_f32_16x16x32_bf16(kfr, qf[ks], acc, 0, 0, 0);
                    }
                }
#pragma unroll
                for (int r = 0; r < 4; ++r) {
                    const int sidx = 16 * nt + 4 * qp + r;
                    const int rel = 128 + tq - sidx;
                    bool valid = rel >= 0 && rel < 128;
                    if (!SAMPLE) valid = valid && (qb > 0 || sidx >= 128);
                    acc[r] = valid ? acc[r] * 0.125f - slope * (float)rel : -INFINITY;
                }
                sc[jn] = acc;
            }
            float mx = sink;
#pragma unroll
            for (int jn = 0; jn < 9; ++jn)
#pragma unroll
                for (int r = 0; r < 4; ++r) mx = fmaxf(mx, sc[jn][r]);
            mx = fmaxf(mx, __shfl_xor(mx, 16)); mx = fmaxf(mx, __shfl_xor(mx, 32));
            float sum = 0.f;
#pragma unroll
            for (int jn = 0; jn < 9; ++jn)
#pragma unroll
                for (int r = 0; r < 4; ++r) { const float e = __expf(sc[jn][r] - mx); sc[jn][r] = e; sum += e; }
            sum += __shfl_xor(sum, 16); sum += __shfl_xor(sum, 32);
            const float inv = 1.f / (sum + __expf(sink - mx));
            bf16x8_t pf[5];
#pragma unroll
            for (int ks = 0; ks < 5; ++ks) {
                u32x4 w;
                w.x = pk2bf(sc[2 * ks][0] * inv, sc[2 * ks][1] * inv); w.y = pk2bf(sc[2 * ks][2] * inv, sc[2 * ks][3] * inv);
                if (ks < 4) { w.z = pk2bf(sc[2 * ks + 1][0] * inv, sc[2 * ks + 1][1] * inv); w.w = pk2bf(sc[2 * ks + 1][2] * inv, sc[2 * ks + 1][3] * inv); }
                else { w.z = 0u; w.w = 0u; }
                pf[ks] = __builtin_bit_cast(bf16x8_t, w);
            }
#pragma unroll
            for (int dt = 0; dt < 4; ++dt) {
                f32x4 o = (f32x4){0.f, 0.f, 0.f, 0.f};
#pragma unroll
                for (int ks = 0; ks < 5; ++ks) {
                    const int ntA = nt0 + 2 * ks, ntB = (ks < 4) ? nt0 + 2 * ks + 1 : nt0 + 2 * ks;
                    const LAS unsigned char* vr = ldsV + (16 * dt + i16) * AT_VPB;
                    const u32x2 lo = *(const LAS u32x2*)(vr + 2 * (16 * ntA + 4 * qp));
                    const u32x2 hi = *(const LAS u32x2*)(vr + 2 * (16 * ntB + 4 * qp));
                    const u32x4 w = (u32x4){lo.x, lo.y, hi.x, hi.y};
                    o = __builtin_amdgcn_mfma_f32_16x16x32_bf16(__builtin_bit_cast(bf16x8_t, w), pf[ks], o, 0, 0, 0);
                }
                u32x2 ow; ow.x = pk2bf(o[0], o[1]); ow.y = pk2bf(o[2], o[3]);
                *(u32x2*)(OA + qrow * D + 64 * h + 16 * dt + 4 * qp) = ow;
            }
        }
    }
    __syncthreads();
}

template <bool PASS2>
__device__ __forceinline__ void rglru_unit(const Args& a, int L, int unit, LAS unsigned char* lds) {
    const int tid = threadIdx.x, lane = tid & 63, wv = __builtin_amdgcn_readfirstlane(tid >> 6);
    const bf16_t* P = (const bf16_t*)(a.ws + WS_P); bf16_t* OB = (bf16_t*)(a.ws + WS_OB); float* RS = (float*)(a.ws + WS_RS);
    const float* cw = a.in[10] + (size_t)L * 4 * D; const float* cb = a.in[11] + L * D; const float* wa = a.in[12] + (size_t)L * 16 * 4096; const float* ba = a.in[13] + L * D;
    const float* wx = a.in[14] + (size_t)L * 16 * 4096; const float* bx = a.in[15] + L * D; const float* lam = a.in[16] + L * D;
    const float* conv0 = a.in[4] + (size_t)L * DBATCH * 3 * D; const float* h0 = a.in[5] + (size_t)L * DBATCH * D;
    LAS float* s_xc = (LAS float*)lds + wv * 64;
    const int m0 = unit * 64;
    const bool sample = m0 >= MP;
    for (int bb = 0; bb < 2; ++bb) {
        const int bk = 2 * wv + bb, c = 64 * bk + lane;
        float war[64], wxr[64];
#pragma unroll
        for (int i = 0; i < 64; ++i) { war[i] = wa[((size_t)bk * 64 + i) * 64 + lane]; wxr[i] = wx[((size_t)bk * 64 + i) * 64 + lane]; }
        const float c0 = cw[0 * D + c], c1 = cw[1 * D + c], c2 = cw[2 * D + c], c3 = cw[3 * D + c], cbc = cb[c], bac = ba[c], bxc = bx[c];
        const float spl = softplusf_(-lam[c]);
        float x1 = 0.f, x2 = 0.f, x3 = 0.f, h = 0.f, Ap = 1.f;
        int bseq = 0, chunk = 0;
        if (!sample) {
            bseq = m0 / SEQ; chunk = (m0 % SEQ) / 64;
            if (chunk > 0) {
                x1 = bf2f(P[(size_t)(m0 - 1) * NP + CRNN + c]); x2 = bf2f(P[(size_t)(m0 - 2) * NP + CRNN + c]); x3 = bf2f(P[(size_t)(m0 - 3) * NP + CRNN + c]);
                if (PASS2) { for (int cc = 0; cc < chunk; ++cc) { const float2 ab = *(const float2*)(RS + (((size_t)bseq * 128 + cc) * D + c) * 2); h = ab.x * h + ab.y; } }
            }
        }
        for (int t = 0; t < 64; ++t) {
            const size_t m = (size_t)m0 + t;
            if (sample && (t & 7) == 0) {
                if (!PASS2) break;
                const int b = (int)(m - MP) >> 3;
                x3 = conv0[((size_t)b * 3 + 0) * D + c]; x2 = conv0[((size_t)b * 3 + 1) * D + c]; x1 = conv0[((size_t)b * 3 + 2) * D + c]; h = h0[(size_t)b * D + c];
            }
            const float x = bf2f(P[m * NP + CRNN + c]);
            const float xc = cbc + c0 * x3 + c1 * x2 + c2 * x1 + c3 * x;
            LDSW(); s_xc[lane] = xc; LDSW();
            float r = bac, ig = bxc;
#pragma unroll
            for (int i4 = 0; i4 < 16; ++i4) { const f32x4 xv = *(const LAS f32x4*)(s_xc + 4 * i4);
#pragma unroll
                for (int e = 0; e < 4; ++e) { r += xv[e] * war[4 * i4 + e]; ig += xv[e] * wxr[4 * i4 + e]; } }
            r = sigmoidf_(r); ig = sigmoidf_(ig);
            const float log_a = -8.f * r * spl;
            const float av = __expf(log_a);
            const float u = sqrtf(-expm1f(2.f * log_a)) * (ig * xc);
            h = av * h + u; Ap *= av;
            if (PASS2) OB[m * D + c] = f2bf(h);
            x3 = x2; x2 = x1; x1 = x;
            if (PASS2 && sample && (t & 7) == 7) {
                const int b = (int)(m - MP) >> 3;
                float* oc = a.out + O_SCONV + ((size_t)L * DBATCH + b) * 3 * D; float* oh = a.out + O_SH + ((size_t)L * DBATCH + b) * D;
                oh[c] = h; oc[0 * D + c] = x3; oc[1 * D + c] = x2; oc[2 * D + c] = x1;
            }
        }
        if (!sample) {
            if (!PASS2) { *(float2*)(RS + (((size_t)bseq * 128 + chunk) * D + c) * 2) = make_float2(Ap, h); }
            else if (chunk == 127) {
                float* oc = a.out + O_PCONV + ((size_t)L * NBATCH + bseq) * 3 * D; float* oh = a.out + O_PH + ((size_t)L * NBATCH + bseq) * D;
                oh[c] = h; oc[0 * D + c] = x3; oc[1 * D + c] = x2; oc[2 * D + c] = x1;
            }
        }
    }
}

__device__ __forceinline__ void phase_elem_mixa(const Args& a, int L) {
    const bf16_t* P = (const bf16_t*)(a.ws + WS_P); bf16_t* AC = (bf16_t*)(a.ws + WS_ACAT);
    const float* mu = a.in[17] + (size_t)L * SHIFT_W; const float* shift0 = a.in[6] + (size_t)L * DBATCH * SHIFT_W;
    const size_t gt = (size_t)blockIdx.x * NTHREADS + threadIdx.x, gs = (size_t)gridDim.x * NTHREADS;
    for (size_t i = gt; i < (size_t)M * ACAT_K; i += gs) {
        const size_t m = i / ACAT_K; const int j = (int)(i % ACAT_K);
        float o = 0.f;
        if (j < 288) {
            const int ch = 3072 + j;
            const float pc = bf2f(P[m * NP + CRW + ch]);
            float pv;
            if (m < MP) pv = (m % SEQ) == 0 ? 0.f : bf2f(P[(m - 1) * NP + CRW + ch]);
            else pv = ((m - MP) % DSEQ) == 0 ? shift0[((m - MP) / DSEQ) * SHIFT_W + ch] : bf2f(P[(m - 1) * NP + CRW + ch]);
            const float ps = pc + mu[ch] * (pv - pc);
            o = j < 64 ? tanhf(ps) : (j < 128 ? ps : sigmoidf_(ps));
        }
        AC[i] = f2bf(o);
    }
    const float* ck = a.in[2] + (size_t)L * DBATCH * 128 * 256; const float* cv = a.in[3] + (size_t)L * DBATCH * 128 * 256;
    float* pk = a.out + O_PK + (size_t)L * NBATCH * 128 * 256; float* pv_ = a.out + O_PV + (size_t)L * NBATCH * 128 * 256;
    float* pshift = a.out + O_PSHIFT + (size_t)L * NBATCH * SHIFT_W; float* sk = a.out + O_SK + (size_t)L * DBATCH * 128 * 256; float* sv = a.out + O_SV + (size_t)L * DBATCH * 128 * 256;
    float* sshift = a.out + O_SSHIFT + (size_t)L * DBATCH * SHIFT_W;
    const size_t n_pk = (size_t)NBATCH * 128 * 256, n_sk = (size_t)DBATCH * 128 * 256, n_ps = (size_t)NBATCH * SHIFT_W, n_ss = (size_t)DBATCH * SHIFT_W;
    for (size_t i = gt; i < n_pk + n_sk + n_ps + n_ss; i += gs) {
        if (i < n_pk) {
            const int b = (int)(i / (128 * 256)), s = (int)((i / 256) % 128), e = (int)(i % 256);
            const size_t row = (size_t)b * SEQ + (SEQ - 128) + s;
            pk[i] = bf2f(P[row * NP + CK + e]); pv_[i] = bf2f(P[row * NP + CV + e]);
            continue;
        }
        size_t k = i - n_pk;
        if (k < n_sk) {
            const int b = (int)(k / (128 * 256)), s = (int)((k / 256) % 128), e = (int)(k % 256);
            if (s < 120) { sk[k] = ck[((size_t)b * 128 + s + 8) * 256 + e]; sv[k] = cv[((size_t)b * 128 + s + 8) * 256 + e]; }
            else { const size_t row = (size_t)MP + b * DSEQ + (s - 120); sk[k] = bf2f(P[row * NP + CK + e]); sv[k] = bf2f(P[row * NP + CV + e]); }
            continue;
        }
        k -= n_sk;
        if (k < n_ps) { const int b = (int)(k / SHIFT_W), ch = (int)(k % SHIFT_W); pshift[k] = bf2f(P[((size_t)b * SEQ + SEQ - 1) * NP + CRW + ch]); continue; }
        k -= n_ps;
        { const int b = (int)(k / SHIFT_W), ch = (int)(k % SHIFT_W); sshift[k] = bf2f(P[((size_t)MP + b * DSEQ + DSEQ - 1) * NP + CRW + ch]); }
    }
}

__device__ __forceinline__ void phase_mixa(const Args& a, int L, LAS unsigned char* lds) {
    phase_elem_mixa(a, L);
    const bf16_t* P = (const bf16_t*)(a.ws + WS_P); bf16_t* OA = (bf16_t*)(a.ws + WS_OA);
    const float* sinks = a.in[9] + L * 16; const float* ck = a.in[2] + (size_t)L * DBATCH * 128 * 256; const float* cv = a.in[3] + (size_t)L * DBATCH * 128 * 256;
    constexpr int N_RG1 = MP / 64, N_AP = NBATCH * 64 * 4, N_AS = DBATCH * 4;
    for (int it = blockIdx.x; it < N_RG1; it += gridDim.x) { rglru_unit<false>(a, L, it, lds); __syncthreads(); }
    for (int r = blockIdx.x; r < N_AP; r += gridDim.x) { const int c = r & 3, qb = (r >> 2) & 63, b = r >> 8; attn_unit<false>(P, OA, sinks, ck, cv, b, qb, c, lds); }
    for (int r = blockIdx.x; r < N_AS; r += gridDim.x) { const int c = r & 3, b = r >> 2; attn_unit<true>(P, OA, sinks, ck, cv, b, 0, c, lds); }
}

__device__ __forceinline__ void phase_mixb_rg(const Args& a, int L, LAS unsigned char* lds, int first_block) {
    const int nb = gridDim.x - first_block;
    if ((int)blockIdx.x < first_block) return;
    for (int it = blockIdx.x - first_block; it < M / 64; it += nb) { rglru_unit<true>(a, L, it, lds); __syncthreads(); }
}

struct EpiLora {
    static constexpr bool PERM = true, AFTER_DRAIN = false;
    float* WAW; bf16_t* WAA; bf16_t* WAG; const float* w0; const float* a0;
    __device__ __forceinline__ void operator()(const f32x4 (&acc)[2][2][4][2], const pg8::Unit& u, int wr, int wc, int fr, int fq) const {
        const int row0 = u.pm * 256 + wr * 64 + fr, kind = u.pn >> 2, colb = (u.pn & 3) * 256 + wc * 32 + 8 * fq;
        const float* bsrc = kind == 0 ? w0 : a0;
        f32x4 bias[2][2];
#pragma unroll
        for (int bj = 0; bj < 2; ++bj)
#pragma unroll
            for (int n = 0; n < 2; ++n) bias[bj][n] = kind == 2 ? (f32x4){0.f, 0.f, 0.f, 0.f} : *(const f32x4*)(bsrc + colb + bj * 128 + 4 * n);
#pragma unroll
        for (int ai = 0; ai < 2; ++ai)
#pragma unroll
            for (int m = 0; m < 4; ++m) {
                const size_t off = (size_t)(row0 + ai * 128 + m * 16) * D + colb;
#pragma unroll
                for (int bj = 0; bj < 2; ++bj) {
                    f32x4 v0 = acc[ai][bj][m][0] + bias[bj][0], v1 = acc[ai][bj][m][1] + bias[bj][1];
                    if (kind == 0) { *(f32x4*)(WAW + off + bj * 128) = v0; *(f32x4*)(WAW + off + bj * 128 + 4) = v1; }
                    else {
                        if (kind == 1) {
#pragma unroll
                            for (int i = 0; i < 4; ++i) { v0[i] = sigmoidf_(v0[i]); v1[i] = sigmoidf_(v1[i]); }
                        }
                        u32x4 w; w.x = pk2bf(v0[0], v0[1]); w.y = pk2bf(v0[2], v0[3]); w.z = pk2bf(v1[0], v1[1]); w.w = pk2bf(v1[2], v1[3]);
                        *(u32x4*)((kind == 1 ? WAA : WAG) + off + bj * 128) = w;
                    }
                }
                asm volatile("" ::: "memory");
            }
    }
};

__device__ __forceinline__ void prep_wlora(const Args& a) {
    const size_t gt = (size_t)blockIdx.x * NTHREADS + threadIdx.x, gs = (size_t)gridDim.x * NTHREADS;
    for (size_t i = gt; i < (size_t)DEPTH * 3072 * ACAT_K; i += gs) {
        const int l = (int)(i / ((size_t)3072 * ACAT_K)); const int r = (int)(i % ((size_t)3072 * ACAT_K));
        const int n = r / ACAT_K, k = r % ACAT_K, kind = n >> 10, c = n & 1023;
        float v = 0.f;
        if (kind == 0 && k < 64) v = a.in[19][((size_t)l * 64 + k) * D + c];
        else if (kind == 1 && k >= 64 && k < 128) v = a.in[21][((size_t)l * 64 + (k - 64)) * D + c];
        else if (kind == 2 && k >= 128 && k < 288) v = a.in[22][((size_t)l * 160 + (k - 128)) * D + c];
        ((bf16_t*)(a.ws + WS_WLORA))[i] = f2bf(v);
    }
}

__device__ __forceinline__ float dpp_add16(float x) {
    x += __builtin_bit_cast(float, __builtin_amdgcn_update_dpp(0, __builtin_bit_cast(int, x), 0xB1, 0xF, 0xF, true));
    x += __builtin_bit_cast(float, __builtin_amdgcn_update_dpp(0, __builtin_bit_cast(int, x), 0x4E, 0xF, 0xF, true));
    x += __builtin_bit_cast(float, __builtin_amdgcn_update_dpp(0, __builtin_bit_cast(int, x), 0x124, 0xF, 0xF, true));
    x += __builtin_bit_cast(float, __builtin_amdgcn_update_dpp(0, __builtin_bit_cast(int, x), 0x128, 0xF, 0xF, true));
    return x;
}
constexpr int SC_TB = 32;
__device__ __forceinline__ void wkv_scan_unit(const Args& a, int L, int seq, int h, int half, LAS unsigned char* lds) {
    const int tid = threadIdx.x, lane = tid & 63, wv = __builtin_amdgcn_readfirstlane(tid >> 6);
    const bf16_t* P = (const bf16_t*)(a.ws + WS_P); const float* WAW = (const float*)(a.ws + WS_WAW); const bf16_t* WAA = (const bf16_t*)(a.ws + WS_WAA);
    float* Y = (float*)(a.ws + WS_Y); float* BD = (float*)(a.ws + WS_BD);
    const float* mu = a.in[17] + (size_t)L * SHIFT_W; const float* shift0 = a.in[6] + (size_t)L * DBATCH * SHIFT_W;
    LAS float* buf = (LAS float*)lds;
    const int e = lane & 15, v = 32 * half + 4 * wv + (lane >> 4);
    int row0, T; const float* sh0 = nullptr; float* outS;
    f32x4 S = (f32x4){0.f, 0.f, 0.f, 0.f};
    if (seq < NBATCH) { row0 = seq * SEQ; T = SEQ; outS = a.out + O_PWKV + ((((size_t)L * NBATCH + seq) * 16 + h) * 64 + v) * 64 + 4 * e; }
    else { const int b = seq - NBATCH; row0 = MP + b * DSEQ; T = DSEQ; sh0 = shift0 + (size_t)b * SHIFT_W;
        outS = a.out + O_SWKV + ((((size_t)L * DBATCH + b) * 16 + h) * 64 + v) * 64 + 4 * e;
        S = *(const f32x4*)(a.in[7] + ((((size_t)L * DBATCH + b) * 16 + h) * 64 + v) * 64 + 4 * e); }
    const int c = 64 * h + lane;
    const float mu_r = mu[c], mu_k = mu[1024 + c], mu_v = mu[2048 + c];
    const float kkc = a.in[23][L * D + c], kac = a.in[24][L * D + c], rkc = a.in[25][L * D + c];
    for (int t0 = 0; t0 < T; t0 += SC_TB) {
        const int nb = (T - t0) < SC_TB ? (T - t0) : SC_TB;
        for (int tok = wv; tok < nb; tok += NWAVES) {
            const int t = t0 + tok; const size_t m = (size_t)row0 + t;
            const bf16_t* pr = P + m * NP + CRW; const bf16_t* pp = pr - NP;
            float pr_r = bf2f(pr[c]), pr_k = bf2f(pr[1024 + c]), pr_v = bf2f(pr[2048 + c]);
            float pv_r, pv_k, pv_v;
            if (t == 0) { pv_r = sh0 ? sh0[c] : 0.f; pv_k = sh0 ? sh0[1024 + c] : 0.f; pv_v = sh0 ? sh0[2048 + c] : 0.f; }
            else { pv_r = bf2f(pp[c]); pv_k = bf2f(pp[1024 + c]); pv_v = bf2f(pp[2048 + c]); }
            const float r = pr_r + mu_r * (pv_r - pr_r), kx = pr_k + mu_k * (pv_k - pr_k), vv = pr_v + mu_v * (pv_v - pr_v);
            const float w = __expf(-__expf(-softplusf_(-WAW[m * D + c]) - 0.5f)), av = bf2f(WAA[m * D + c]);
            float kk = kx * kkc;
            const float nrm = sqrtf(wave_sum(kk * kk));
            kk = kk / fmaxf(nrm, 1e-12f);
            const float k2 = kx * (1.f + (av - 1.f) * kac);
            const float bd = wave_sum(r * k2 * rkc);
            if (half == 0 && lane == 0) BD[m * 16 + h] = bd;
            LAS float* bt = buf + tok * 384;
            bt[lane] = w; bt[64 + lane] = kk; bt[128 + lane] = kk * av; bt[192 + lane] = k2; bt[256 + lane] = r; bt[320 + lane] = vv;
        }
        __syncthreads();
        for (int tok = 0; tok < nb; ++tok) {
            const LAS float* bt = buf + tok * 384;
            const f32x4 w4 = *(const LAS f32x4*)(bt + 4 * e), kk4 = *(const LAS f32x4*)(bt + 64 + 4 * e), b4 = *(const LAS f32x4*)(bt + 128 + 4 * e),
                        k4 = *(const LAS f32x4*)(bt + 192 + 4 * e), r4 = *(const LAS f32x4*)(bt + 256 + 4 * e);
            const float vv = bt[320 + v];
            float sa = -((S[0] * kk4[0] + S[1] * kk4[1]) + (S[2] * kk4[2] + S[3] * kk4[3]));
            sa = dpp_add16(sa);
            S = S * w4 + (b4 * sa + k4 * vv);
            float y = (S[0] * r4[0] + S[1] * r4[1]) + (S[2] * r4[2] + S[3] * r4[3]);
            y = dpp_add16(y);
            if (e == 0) Y[((size_t)row0 + t0 + tok) * D + 64 * h + v] = y;
        }
        __syncthreads();
    }
    *(f32x4*)outS = S;
}

__device__ __forceinline__ void phase_mixb(const Args& a, int L, LAS unsigned char* lds) {
    constexpr int N_PS = NBATCH * 16 * 2;
    const int G = gridDim.x, bx = blockIdx.x;
    const int first_other = (G > 2 * N_PS) ? N_PS : 0;
    for (int it = bx; it < N_PS; it += G) wkv_scan_unit(a, L, it >> 5, (it >> 1) & 15, it & 1, lds);
    if (bx < first_other) return;
    const int nb = G - first_other, id = bx - first_other;
    for (int it = id; it < M / 64; it += nb) { rglru_unit<true>(a, L, it, lds); __syncthreads(); }
    for (int it = id; it < DBATCH * 32; it += nb) wkv_scan_unit(a, L, NBATCH + (it >> 5), (it >> 1) & 15, it & 1, lds);
}

__device__ __forceinline__ void phase_mixc(const Args& a, int L) {
    const int lane = threadIdx.x & 63, wv = threadIdx.x >> 6;
    const bf16_t* P = (const bf16_t*)(a.ws + WS_P); const bf16_t* WAG = (const bf16_t*)(a.ws + WS_WAG); const float* Y = (const float*)(a.ws + WS_Y); const float* BD = (const float*)(a.ws + WS_BD);
    bf16_t* OA = (bf16_t*)(a.ws + WS_OA); const bf16_t* OB = (const bf16_t*)(a.ws + WS_OB);
    const float* mu = a.in[17] + (size_t)L * SHIFT_W + 2048; const float* shift0 = a.in[6] + (size_t)L * DBATCH * SHIFT_W + 2048;
    const int c0 = 16 * lane, h = lane >> 2;
    float lw[16], lb[16], muv[16];
#pragma unroll
    for (int i = 0; i < 16; ++i) { lw[i] = a.in[26][L * D + c0 + i]; lb[i] = a.in[27][L * D + c0 + i]; muv[i] = mu[c0 + i]; }
    for (int m = blockIdx.x * NWAVES + wv; m < M; m += gridDim.x * NWAVES) {
        float y[16];
#pragma unroll
        for (int j = 0; j < 4; ++j) { const f32x4 t4 = *(const f32x4*)(Y + (size_t)m * D + c0 + 4 * j); y[4 * j] = t4[0]; y[4 * j + 1] = t4[1]; y[4 * j + 2] = t4[2]; y[4 * j + 3] = t4[3]; }
        float s = 0.f;
#pragma unroll
        for (int i = 0; i < 16; ++i) s += y[i];
        s += __shfl_xor(s, 1); s += __shfl_xor(s, 2);
        const float mean = s * (1.f / 64.f);
        float q = 0.f;
#pragma unroll
        for (int i = 0; i < 16; ++i) { y[i] -= mean; q += y[i] * y[i]; }
        q += __shfl_xor(q, 1); q += __shfl_xor(q, 2);
        const float rstd = rsqrtf(q * (1.f / 64.f) + GN_EPS);
        const float bd = BD[(size_t)m * 16 + h];
        const bool first = m < MP ? (m % SEQ) == 0 : ((m - MP) % DSEQ) == 0;
        const bf16_t* pr = P + (size_t)m * NP + CRW + 2048 + c0;
#define BFX(v, i) __uint_as_float((((i) & 1) ? ((v)[(i) >> 3][((i) >> 1) & 3] & 0xffff0000u) : ((v)[(i) >> 3][((i) >> 1) & 3] << 16)))
        u32x4 pcv[2], ppv[2], gv[2], gav[2], gbv[2], gcv[2], oav[2], obv[2];
        pcv[0] = *(const u32x4*)pr; pcv[1] = *(const u32x4*)(pr + 8);
        ppv[0] = pcv[0]; ppv[1] = pcv[1];
        if (!first) { ppv[0] = *(const u32x4*)(pr - NP); ppv[1] = *(const u32x4*)(pr - NP + 8); }
        gv[0] = *(const u32x4*)(WAG + (size_t)m * D + c0); gv[1] = *(const u32x4*)(WAG + (size_t)m * D + c0 + 8);
        const bf16_t* pg = P + (size_t)m * NP + CG + c0;
        gav[0] = *(const u32x4*)pg; gav[1] = *(const u32x4*)(pg + 8);
        gbv[0] = *(const u32x4*)(pg + 1024); gbv[1] = *(const u32x4*)(pg + 1024 + 8);
        gcv[0] = *(const u32x4*)(pg + 2048); gcv[1] = *(const u32x4*)(pg + 2048 + 8);
        oav[0] = *(const u32x4*)(OA + (size_t)m * D + c0); oav[1] = *(const u32x4*)(OA + (size_t)m * D + c0 + 8);
        obv[0] = *(const u32x4*)(OB + (size_t)m * D + c0); obv[1] = *(const u32x4*)(OB + (size_t)m * D + c0 + 8);
        float o[16];
#pragma unroll
        for (int i = 0; i < 16; ++i) {
            const float pc = BFX(pcv, i);
            float pv;
            if (first) pv = m < MP ? 0.f : shift0[(size_t)((m - MP) / DSEQ) * SHIFT_W + c0 + i];
            else pv = BFX(ppv, i);
            const float vv = pc + muv[i] * (pv - pc);
            const float yn = y[i] * rstd * lw[i] + lb[i];
            const float oc = (yn + bd * vv) * BFX(gv, i);
            o[i] = BFX(gav, i) * BFX(oav, i) + BFX(gbv, i) * BFX(obv, i) + BFX(gcv, i) * oc;
        }
        u32x4 w0, w1;
        w0.x = pk2bf(o[0], o[1]); w0.y = pk2bf(o[2], o[3]); w0.z = pk2bf(o[4], o[5]); w0.w = pk2bf(o[6], o[7]);
        w1.x = pk2bf(o[8], o[9]); w1.y = pk2bf(o[10], o[11]); w1.z = pk2bf(o[12], o[13]); w1.w = pk2bf(o[14], o[15]);
        *(u32x4*)(OA + (size_t)m * D + c0) = w0; *(u32x4*)(OA + (size_t)m * D + c0 + 8) = w1;
    }
}

typedef short v4i16_t __attribute__((ext_vector_type(4)));
constexpr int CH_OFF_AA = 0, CH_OFF_RA = 2048, CH_OFF_MC = 4096, CH_OFF_TL = 5120, CH_OFF_BT = 6144, CH_OFF_KT = 8320, CH_OFF_VT = 10496, CH_OFF_GM = 12672, CH_SLOT = 13056;
constexpr int CH_TP = 136;
__device__ __forceinline__ u32x2 tr_read4(LAS unsigned char* p) { return __builtin_bit_cast(u32x2, __builtin_amdgcn_ds_read_tr16_b64_v4i16((LAS v4i16_t*)p)); }
__device__ __forceinline__ bf16x8_t mk_frag(u32x2 lo, u32x2 hi) { const u32x4 w = (u32x4){lo.x, lo.y, hi.x, hi.y}; return __builtin_bit_cast(bf16x8_t, w); }
__device__ __forceinline__ u32x2 pk4(float a, float b, float c, float d) { u32x2 w; w.x = pk2bf(a, b); w.y = pk2bf(c, d); return w; }
__device__ __forceinline__ float row_prefix16(float x) {
    x += __builtin_bit_cast(float, __builtin_amdgcn_update_dpp(0, __builtin_bit_cast(int, x), 0x111, 0xF, 0xF, true));
    x += __builtin_bit_cast(float, __builtin_amdgcn_update_dpp(0, __builtin_bit_cast(int, x), 0x112, 0xF, 0xF, true));
    x += __builtin_bit_cast(float, __builtin_amdgcn_update_dpp(0, __builtin_bit_cast(int, x), 0x114, 0xF, 0xF, true));
    x += __builtin_bit_cast(float, __builtin_amdgcn_update_dpp(0, __builtin_bit_cast(int, x), 0x118, 0xF, 0xF, true));
    return x;
}
__device__ __forceinline__ f32x4 prod16(const f32x4 xt, const f32x4 y) {
    f32x4 z = (f32x4){0.f, 0.f, 0.f, 0.f};
#pragma unroll
    for (int r = 0; r < 4; ++r) z = __builtin_amdgcn_mfma_f32_16x16x4f32(xt[r], y[r], z, 0, 0, 0);
    return z;
}
__device__ __forceinline__ f32x4 gram(const bf16x8_t (&x)[2], const bf16x8_t (&y)[2]) {
    f32x4 z = (f32x4){0.f, 0.f, 0.f, 0.f};
    z = __builtin_amdgcn_mfma_f32_16x16x32_bf16(x[0], y[0], z, 0, 0, 0);
    z = __builtin_amdgcn_mfma_f32_16x16x32_bf16(x[1], y[1], z, 0, 0, 0);
    return z;
}

__device__ __forceinline__ void chunk_precompute(const Args& a, int L, size_t m0, int h, int ntok, bool seq_start, const float* sh0, LAS unsigned char* slot, int lane) {
    asm volatile("" : "+v"(lane));
    const int i16 = lane & 15, qp = lane >> 4;
    const bf16_t* P = (const bf16_t*)(a.ws + WS_P); const float* WAW = (const float*)(a.ws + WS_WAW); const bf16_t* WAA = (const bf16_t*)(a.ws + WS_WAA);
    float* BD = (float*)(a.ws + WS_BD);
    const float* mu = a.in[17] + (size_t)L * SHIFT_W; const float* p_kk = a.in[23] + L * D; const float* p_ka = a.in[24] + L * D; const float* p_rk = a.in[25] + L * D;
    const bool valid = i16 < ntok;
    const size_t m = m0 + (valid ? i16 : 0);
    const bool use_sh = seq_start && i16 == 0;
    float abu[16], bbu[16];
    u32x2 pa[4], pb[4], pkk[4], prr[4];
    float ssq = 0.f, bdp = 0.f;
#pragma unroll
    for (int r = 0; r < 4; ++r) {
        const int cb = 16 * r + 4 * qp, c = 64 * h + cb;
        const bf16_t* pr = P + m * NP + CRW + c;
        const u32x2 cr = *(const u32x2*)pr, ck_ = *(const u32x2*)(pr + 1024), cv_ = *(const u32x2*)(pr + 2048);
        u32x2 pr_ = cr, pk_ = ck_, pv_ = cv_;
        if (!use_sh) { const bf16_t* pp = pr - NP; pr_ = *(const u32x2*)pp; pk_ = *(const u32x2*)(pp + 1024); pv_ = *(const u32x2*)(pp + 2048); }
        const f32x4 mur = *(const f32x4*)(mu + c), muk = *(const f32x4*)(mu + 1024 + c), muv = *(const f32x4*)(mu + 2048 + c);
        const f32x4 x4 = *(const f32x4*)(WAW + m * D + c);
        const u32x2 a4 = *(const u32x2*)(WAA + m * D + c);
        const f32x4 kkc = *(const f32x4*)(p_kk + c), kac = *(const f32x4*)(p_ka + c), rkc = *(const f32x4*)(p_rk + c);
        f32x4 s_r = (f32x4){0.f, 0.f, 0.f, 0.f}, s_k = s_r, s_v = s_r;
        if (use_sh && sh0) { s_r = *(const f32x4*)(sh0 + c); s_k = *(const f32x4*)(sh0 + 1024 + c); s_v = *(const f32x4*)(sh0 + 2048 + c); }
        float vv[4], kb[4], rb[4];
#pragma unroll
        for (int i = 0; i < 4; ++i) {
            const unsigned wr_ = i < 2 ? cr.x : cr.y, wk_ = i < 2 ? ck_.x : ck_.y, wv_ = i < 2 ? cv_.x : cv_.y, wa_ = i < 2 ? a4.x : a4.y;
            const unsigned qr_ = i < 2 ? pr_.x : pr_.y, qk_ = i < 2 ? pk_.x : pk_.y, qv_ = i < 2 ? pv_.x : pv_.y;
            const float c_r = __uint_as_float((i & 1) ? (wr_ & 0xffff0000u) : (wr_ << 16)), c_k = __uint_as_float((i & 1) ? (wk_ & 0xffff0000u) : (wk_ << 16)),
                        c_v = __uint_as_float((i & 1) ? (wv_ & 0xffff0000u) : (wv_ << 16)), a_ = __uint_as_float((i & 1) ? (wa_ & 0xffff0000u) : (wa_ << 16));
            float p_r = __uint_as_float((i & 1) ? (qr_ & 0xffff0000u) : (qr_ << 16)), p_k = __uint_as_float((i & 1) ? (qk_ & 0xffff0000u) : (qk_ << 16)),
                  p_v = __uint_as_float((i & 1) ? (qv_ & 0xffff0000u) : (qv_ << 16));
            if (use_sh) { p_r = s_r[i]; p_k = s_k[i]; p_v = s_v[i]; }
            float r_ = c_r + mur[i] * (p_r - c_r), kx = c_k + muk[i] * (p_k - c_k), v_ = c_v + muv[i] * (p_v - c_v);
            float lw_ = -__expf(-(fmaxf(-x4[i], 0.f) + __logf(1.f + __expf(-fabsf(x4[i])))) - 0.5f);
            if (!valid) { r_ = 0.f; kx = 0.f; v_ = 0.f; lw_ = 0.f; }
            const float kkr = kx * kkc[i];
            const float k2_ = kx * (1.f + (a_ - 1.f) * kac[i]);
            ssq += kkr * kkr; bdp += r_ * k2_ * rkc[i];
            const float g = row_prefix16(lw_);
            const float eg = __expf(g), egx = __expf(g - lw_), eng = __expf(-g);
            const int e = 4 * r + i;
            abu[e] = -kkr * egx; bbu[e] = kkr * a_ * eng; kb[i] = k2_ * eng; rb[i] = r_ * eg; vv[i] = v_;
            if (i16 == 15) *(LAS float*)(slot + CH_OFF_GM + 4 * (cb + i)) = eg;
        }
        const int off = i16 * CH_TP + cb * 2;
        pkk[r] = pk4(kb[0], kb[1], kb[2], kb[3]); prr[r] = pk4(rb[0], rb[1], rb[2], rb[3]);
        *(LAS u32x2*)(slot + CH_OFF_VT + off) = pk4(vv[0], vv[1], vv[2], vv[3]);
        *(LAS u32x2*)(slot + CH_OFF_KT + off) = pkk[r];
        asm volatile("" ::: "memory"); __builtin_amdgcn_sched_barrier(0);
    }
    ssq += __shfl_xor(ssq, 16); ssq += __shfl_xor(ssq, 32);
    bdp += __shfl_xor(bdp, 16); bdp += __shfl_xor(bdp, 32);
    if (valid && qp == 0) BD[m * 16 + h] = bdp;
    const float inrm = 1.f / fmaxf(sqrtf(ssq), 1e-12f);
#pragma unroll
    for (int r = 0; r < 4; ++r) {
        pa[r] = pk4(abu[4 * r] * inrm, abu[4 * r + 1] * inrm, abu[4 * r + 2] * inrm, abu[4 * r + 3] * inrm);
        pb[r] = pk4(bbu[4 * r] * inrm, bbu[4 * r + 1] * inrm, bbu[4 * r + 2] * inrm, bbu[4 * r + 3] * inrm);
        const int off = i16 * CH_TP + (16 * r + 4 * qp) * 2;
        *(LAS u32x2*)(slot + CH_OFF_AA + off) = pa[r];
        *(LAS u32x2*)(slot + CH_OFF_BT + off) = pb[r];
    }
    __builtin_amdgcn_sched_barrier(0);
    bf16x8_t fa[2], fb[2], fk[2], fr[2];
#pragma unroll
    for (int ks = 0; ks < 2; ++ks) { fa[ks] = mk_frag(pa[2 * ks], pa[2 * ks + 1]); fb[ks] = mk_frag(pb[2 * ks], pb[2 * ks + 1]); fk[ks] = mk_frag(pkk[2 * ks], pkk[2 * ks + 1]); fr[ks] = mk_frag(prr[2 * ks], prr[2 * ks + 1]); }
    f32x4 Lc = gram(fa, fb), Nc = gram(fb, fa), Lak = gram(fa, fk), MrbT = gram(fb, fr), MrkT = gram(fk, fr);
#pragma unroll
    for (int r = 0; r < 4; ++r) {
        const int row = 4 * qp + r;
        Lc[r] = row > i16 ? Lc[r] : 0.f;
        Lak[r] = row > i16 ? Lak[r] : 0.f;
        Nc[r] = row < i16 ? Nc[r] : 0.f;
        MrbT[r] = row <= i16 ? MrbT[r] : 0.f;
        MrkT[r] = row <= i16 ? MrkT[r] : 0.f;
    }
    __builtin_amdgcn_sched_barrier(0);
    f32x4 eye;
#pragma unroll
    for (int r = 0; r < 4; ++r) eye[r] = (4 * qp + r == i16) ? 1.f : 0.f;
    const f32x4 L2 = prod16(Nc, Lc), N2 = prod16(Lc, Nc);
    const f32x4 L4 = prod16(N2, L2), N4 = prod16(L2, N2);
    const f32x4 N8 = prod16(L4, N4);
    const f32x4 Q1 = prod16(Lc + eye, N2 + eye), Q1T = prod16(N2 + eye, Lc + eye), Q2 = prod16(L4 + eye, N8 + eye);
    const f32x4 TT = prod16(Q1T, Q2);
    const f32x4 TLk = prod16(Lak, TT);
    __builtin_amdgcn_sched_barrier(0);
    LDSW();
    const bf16x8_t ttf = mk_frag(pk4(TT[0], TT[1], TT[2], TT[3]), (u32x2){0u, 0u});
    f32x4 at[4];
#pragma unroll
    for (int kt = 0; kt < 4; ++kt) {
        const u32x2 ac = tr_read4(slot + CH_OFF_AA + (4 * qp + (i16 >> 2)) * CH_TP + (16 * kt + 4 * (i16 & 3)) * 2);
        at[kt] = __builtin_amdgcn_mfma_f32_16x16x32_bf16(mk_frag(ac, (u32x2){0u, 0u}), ttf, (f32x4){0.f, 0.f, 0.f, 0.f}, 0, 0, 0);
    }
    LDSW();
#pragma unroll
    for (int ks = 0; ks < 2; ++ks) {
        const u32x2 lo = pk4(at[2 * ks][0], at[2 * ks][1], at[2 * ks][2], at[2 * ks][3]), hi = pk4(at[2 * ks + 1][0], at[2 * ks + 1][1], at[2 * ks + 1][2], at[2 * ks + 1][3]);
        *(LAS u32x4*)(slot + CH_OFF_AA + ks * 1024 + lane * 16) = (u32x4){lo.x, lo.y, hi.x, hi.y};
        *(LAS u32x4*)(slot + CH_OFF_RA + ks * 1024 + lane * 16) = __builtin_bit_cast(u32x4, fr[ks]);
    }
    {
        const u32x2 mb = pk4(MrbT[0], MrbT[1], MrbT[2], MrbT[3]), mk = pk4(MrkT[0], MrkT[1], MrkT[2], MrkT[3]), tl = pk4(TLk[0], TLk[1], TLk[2], TLk[3]);
        *(LAS u32x4*)(slot + CH_OFF_MC + lane * 16) = (u32x4){mb.x, mb.y, mk.x, mk.y};
        *(LAS u32x4*)(slot + CH_OFF_TL + lane * 16) = (u32x4){tl.x, tl.y, 0u, 0u};
    }
}

__device__ __forceinline__ f32x4 chain_step(LAS unsigned char* slot, f32x4 (&ST)[4], int vq, int lane) {
    asm volatile("" : "+v"(lane));
    const int i16 = lane & 15, qp = lane >> 4;
    bf16x8_t sb[2];
#pragma unroll
    for (int ks = 0; ks < 2; ++ks) sb[ks] = mk_frag(pk4(ST[2 * ks][0], ST[2 * ks][1], ST[2 * ks][2], ST[2 * ks][3]), pk4(ST[2 * ks + 1][0], ST[2 * ks + 1][1], ST[2 * ks + 1][2], ST[2 * ks + 1][3]));
    const int troff = (4 * qp + (i16 >> 2)) * CH_TP + 8 * (i16 & 3);
    const u32x2 vq4 = tr_read4(slot + CH_OFF_VT + troff + 32 * vq);
    const bf16x8_t aa0 = __builtin_bit_cast(bf16x8_t, *(const LAS u32x4*)(slot + CH_OFF_AA + lane * 16)), aa1 = __builtin_bit_cast(bf16x8_t, *(const LAS u32x4*)(slot + CH_OFF_AA + 1024 + lane * 16));
    const bf16x8_t ra0 = __builtin_bit_cast(bf16x8_t, *(const LAS u32x4*)(slot + CH_OFF_RA + lane * 16)), ra1 = __builtin_bit_cast(bf16x8_t, *(const LAS u32x4*)(slot + CH_OFF_RA + 1024 + lane * 16));
    const bf16x8_t mc = __builtin_bit_cast(bf16x8_t, *(const LAS u32x4*)(slot + CH_OFF_MC + lane * 16)), tl = __builtin_bit_cast(bf16x8_t, *(const LAS u32x4*)(slot + CH_OFF_TL + lane * 16));
    f32x4 U = (f32x4){0.f, 0.f, 0.f, 0.f};
    U = __builtin_amdgcn_mfma_f32_16x16x32_bf16(tl, mk_frag(vq4, vq4), U, 0, 0, 0);
    U = __builtin_amdgcn_mfma_f32_16x16x32_bf16(aa0, sb[0], U, 0, 0, 0);
    U = __builtin_amdgcn_mfma_f32_16x16x32_bf16(aa1, sb[1], U, 0, 0, 0);
    f32x4 Y = (f32x4){0.f, 0.f, 0.f, 0.f};
    Y = __builtin_amdgcn_mfma_f32_16x16x32_bf16(ra0, sb[0], Y, 0, 0, 0);
    Y = __builtin_amdgcn_mfma_f32_16x16x32_bf16(ra1, sb[1], Y, 0, 0, 0);
    const bf16x8_t uv = mk_frag(pk4(U[0], U[1], U[2], U[3]), vq4);
    Y = __builtin_amdgcn_mfma_f32_16x16x32_bf16(mc, uv, Y, 0, 0, 0);
#pragma unroll
    for (int kt = 0; kt < 4; ++kt) {
        const u32x2 b4 = tr_read4(slot + CH_OFF_BT + troff + 32 * kt), k4 = tr_read4(slot + CH_OFF_KT + troff + 32 * kt);
        ST[kt] = __builtin_amdgcn_mfma_f32_16x16x32_bf16(mk_frag(b4, k4), uv, ST[kt], 0, 0, 0);
        const f32x4 gm = *(const LAS f32x4*)(slot + CH_OFF_GM + 4 * (16 * kt + 4 * qp));
        ST[kt] = ST[kt] * gm;
    }
    return Y;
}

__device__ __forceinline__ void wkv_prompt_unit(const Args& a, int L, int b, int h, LAS unsigned char* lds) {
    const int tid = threadIdx.x, lane = tid & 63, wv = __builtin_amdgcn_readfirstlane(tid >> 6), i16 = lane & 15, qp = lane >> 4;
    float* Y = (float*)(a.ws + WS_Y);
    f32x4 ST[4];
#pragma unroll
    for (int kt = 0; kt < 4; ++kt) ST[kt] = (f32x4){0.f, 0.f, 0.f, 0.f};
    for (int rd = 0; rd < SEQ / 128; ++rd) {
        const size_t mr = (size_t)b * SEQ + (size_t)rd * 128;
        chunk_precompute(a, L, mr + 16 * wv, h, 16, rd == 0 && wv == 0, nullptr, lds + wv * CH_SLOT, lane);
        __syncthreads();
        if (wv < 4) {
            for (int j = 0; j < 8; ++j) {
                const f32x4 y = chain_step(lds + j * CH_SLOT, ST, wv, lane);
#pragma unroll
                for (int r = 0; r < 4; ++r) Y[(mr + 16 * j + 4 * qp + r) * D + 64 * h + 16 * wv + i16] = y[r];
            }
        }
        __syncthreads();
    }
    if (wv < 4) {
        float* o = a.out + O_PWKV + ((((size_t)L * NBATCH + b) * 16 + h) * 64 + 16 * wv + i16) * 64;
#pragma unroll
        for (int kt = 0; kt < 4; ++kt) *(f32x4*)(o + 16 * kt + 4 * qp) = ST[kt];
    }
}
__device__ __forceinline__ void wkv_sample_unit(const Args& a, int L, int b, int ho, LAS unsigned char* lds) {
    const int tid = threadIdx.x, lane = tid & 63, wv = __builtin_amdgcn_readfirstlane(tid >> 6), i16 = lane & 15, qp = lane >> 4;
    const int h = 8 * ho + wv;
    float* Y = (float*)(a.ws + WS_Y);
    LAS unsigned char* slot = lds + wv * CH_SLOT;
    const size_t m0 = (size_t)MP + (size_t)b * DSEQ;
    chunk_precompute(a, L, m0, h, DSEQ, true, a.in[6] + ((size_t)L * DBATCH + b) * SHIFT_W, slot, lane);
    LDSW();
    for (int vq = 0; vq < 4; ++vq) {
        const size_t so = ((((size_t)L * DBATCH + b) * 16 + h) * 64 + 16 * vq + i16) * 64;
        f32x4 ST[4];
#pragma unroll
        for (int kt = 0; kt < 4; ++kt) ST[kt] = *(const f32x4*)(a.in[7] + so + 16 * kt + 4 * qp);
        const f32x4 y = chain_step(slot, ST, vq, lane);
#pragma unroll
        for (int r = 0; r < 4; ++r) if (4 * qp + r < DSEQ) Y[(m0 + 4 * qp + r) * D + 64 * h + 16 * vq + i16] = y[r];
#pragma unroll
        for (int kt = 0; kt < 4; ++kt) *(f32x4*)(a.out + O_SWKV + so + 16 * kt + 4 * qp) = ST[kt];
    }
    __syncthreads();
}

__device__ __forceinline__ void phase_mixb2(const Args& a, int L, LAS unsigned char* lds) {
    constexpr int N_PC = NBATCH * 16;
    const int G = gridDim.x, bx = blockIdx.x;
    const int first_other = (G > 2 * N_PC) ? N_PC : 0;
    for (int it = bx; it < N_PC; it += G) wkv_prompt_unit(a, L, it >> 4, it & 15, lds);
    if (bx < first_other) return;
    const int nb = G - first_other, id = bx - first_other;
    for (int it = id; it < DBATCH * 2; it += nb) wkv_sample_unit(a, L, it >> 1, it & 1, lds);
    for (int it = id; it < M / 64; it += nb) { rglru_unit<true>(a, L, it, lds); __syncthreads(); }
}
#define PH_IN(k) (lo <= (k) && (k) < hi)
#define PH_SYNC(k) do { if (lo < (k) && (k) < hi) cg::this_grid().sync(); } while (0)
template <int L> __device__ __forceinline__ void layer_phases(const Args& a, LAS unsigned char* lds, int lo, int hi) {
    unsigned char* ws = a.ws;
    const int G = gridDim.x;
    constexpr int base = PH_L0 + L * PH_PER_LAYER;
    PH_SYNC(base + PHO_IN);
    if (PH_IN(base + PHO_IN)) {
        pg8::Gemm g{(const bf16_t*)(ws + WS_XB), (const bf16_t*)(ws + WS_WIN + L * WIN_T_BYTES), M, NP, D}; pg8::StaticOrder S; S.init(M, NP, G, (int)blockIdx.x);
        EpiIn E{(bf16_t*)(ws + WS_P), NP, CG / 256};
        pg8::gemm_phase<EpiIn, pg8::StaticOrder, true, true>(lds, g, S, E);
    }
    PH_SYNC(base + PHO_MIXA);
    if (PH_IN(base + PHO_MIXA)) phase_mixa(a, L, lds);
    PH_SYNC(base + PHO_LORA);
    if (PH_IN(base + PHO_LORA)) {
        pg8::Gemm g{(const bf16_t*)(ws + WS_ACAT), (const bf16_t*)(ws + WS_WLORA + L * WLORA_BYTES), M, 3072, ACAT_K}; pg8::StaticOrder S; S.init(M, 3072, G, (int)blockIdx.x);
        EpiLora E{(float*)(ws + WS_WAW), (bf16_t*)(ws + WS_WAA), (bf16_t*)(ws + WS_WAG), a.in[18] + L * D, a.in[20] + L * D};
        pg8::gemm_phase<EpiLora, pg8::StaticOrder, true, true>(lds, g, S, E);
    }
    PH_SYNC(base + PHO_MIXB);
    if (PH_IN(base + PHO_MIXB)) phase_mixb2(a, L, lds);
    PH_SYNC(base + PHO_MIXC);
    if (PH_IN(base + PHO_MIXC)) phase_mixc(a, L);
    PH_SYNC(base + PHO_OUT);
    if (PH_IN(base + PHO_OUT)) {
        pg8::Gemm g{(const bf16_t*)(ws + WS_MIX), (const bf16_t*)(ws + WS_WOUT + L * WOUT_T_BYTES), M, D, D}; pg8::StaticOrder S; S.init(M, D, G, (int)blockIdx.x);
        EpiRes E{(const float*)(ws + WS_XF), (float*)(ws + WS_Z), D};
        pg8::gemm_phase<EpiRes, pg8::StaticOrder, true, true>(lds, g, S, E);
    }
    PH_SYNC(base + PHO_LN1);
    if (PH_IN(base + PHO_LN1)) phase_ln((const float*)(ws + WS_Z), a.in[29] + L * D, a.in[30] + L * D, (float*)(ws + WS_X1F), (bf16_t*)(ws + WS_X1B));
    PH_SYNC(base + PHO_GU);
    if (PH_IN(base + PHO_GU)) {
        pg8::Gemm g{(const bf16_t*)(ws + WS_X1B), (const bf16_t*)(ws + WS_WGU + L * WGU_T_BYTES), M, 2 * DFF, D}; pg8::StaticOrder S; S.init(M, 2 * DFF, G, (int)blockIdx.x);
        EpiSwiGLU E{(bf16_t*)(ws + WS_H), DFF};
        pg8::gemm_phase<EpiSwiGLU, pg8::StaticOrder, true, true>(lds, g, S, E);
    }
    PH_SYNC(base + PHO_DOWN);
    if (PH_IN(base + PHO_DOWN)) {
        pg8::Gemm g{(const bf16_t*)(ws + WS_H), (const bf16_t*)(ws + WS_WDN + L * WDN_T_BYTES), M, D, DFF}; pg8::StaticOrder S; S.init(M, D, G, (int)blockIdx.x);
        EpiRes E{(const float*)(ws + WS_X1F), (float*)(ws + WS_Z), D};
        pg8::gemm_phase<EpiRes, pg8::StaticOrder, true, true>(lds, g, S, E);
    }
    PH_SYNC(base + PHO_LN2);
    if (PH_IN(base + PHO_LN2)) {
        if (L == DEPTH - 1) phase_ln((const float*)(ws + WS_Z), a.in[33] + L * D, a.in[34] + L * D, a.out + O_YP, nullptr);
        else phase_ln((const float*)(ws + WS_Z), a.in[33] + L * D, a.in[34] + L * D, (float*)(ws + WS_XF), (bf16_t*)(ws + WS_XB));
    }
}
__global__ void __launch_bounds__(NTHREADS, 2) mega(Args a) {
    extern __shared__ __attribute__((aligned(16))) unsigned char lds_raw[];
    LAS unsigned char* lds = (LAS unsigned char*)lds_raw;
    const int lo = a.ph_lo, hi = a.ph_hi;
    if (PH_IN(PH_PREP)) { phase_prep(a, lds); prep_wlora(a); }
    layer_phases<0>(a, lds, lo, hi);
    layer_phases<1>(a, lds, lo, hi);
}

static void launch_mega(Args a, int lo, int hi, int grid, hipStream_t s) {
    a.ph_lo = lo; a.ph_hi = hi;
    void* args[] = {&a};
    hipError_t e;
    if (hi - lo > 1) e = hipLaunchCooperativeKernel((void*)mega, dim3(grid), dim3(NTHREADS), args, LDS_BYTES, s);
    else e = hipLaunchKernel((void*)mega, dim3(grid), dim3(NTHREADS), args, LDS_BYTES, s);
    if (e != hipSuccess) fprintf(stderr, "mega launch [%d,%d) failed: %s (grid %d)\n", lo, hi, hipGetErrorString(e), grid);
}

extern "C" void kernel_launch(void* const* d_in, const int* in_sizes, int n_in, void* d_out, int out_size,
                              void* d_ws, size_t ws_size, hipStream_t stream) {
    if (ws_size < WS_END || out_size != (int)O_END || n_in != 35) { fprintf(stderr, "kernel_launch: unexpected sizes ws=%zu out=%d n_in=%d\n", ws_size, out_size, n_in); return; }
    static int grid = 0;
    if (!grid) {
        int dev = 0, cus = 0, per_cu = 0;
        (void)hipGetDevice(&dev);
        (void)hipDeviceGetAttribute(&cus, hipDeviceAttributeMultiprocessorCount, dev);
        (void)hipFuncSetAttribute((const void*)mega, hipFuncAttributeMaxDynamicSharedMemorySize, LDS_BYTES);
        (void)hipOccupancyMaxActiveBlocksPerMultiprocessor(&per_cu, (const void*)mega, NTHREADS, LDS_BYTES);
        if (per_cu < 1) { fprintf(stderr, "occupancy query says %d blocks per CU\n", per_cu); per_cu = 1; }
        grid = cus * per_cu;
    }
    const float* const* in = (const float* const*)d_in;
    unsigned char* ws = (unsigned char*)d_ws;
    float* out = (float*)d_out;
    Args a{};
    for (int i = 0; i < 35; ++i) a.in[i] = in[i];
    a.out = out; a.ws = ws;
    launch_mega(a, 0, N_PHASES, grid, stream);
}
```

```cpp
#include <hip/hip_runtime.h>
#include <cstdint>
#include <cstdio>

typedef unsigned short bf16_t;
__device__ __forceinline__ float bf2f(bf16_t v) { return __uint_as_float(((unsigned)v) << 16); }
__device__ __forceinline__ bf16_t f2bf(float f) { unsigned u = __float_as_uint(f); return (bf16_t)((u + 0x7fffu + ((u >> 16) & 1u)) >> 16); }
__device__ __forceinline__ float sigmoidf_(float x) { return 1.f / (1.f + __expf(-x)); }
__device__ __forceinline__ float softplusf_(float x) { return fmaxf(x, 0.f) + log1pf(__expf(-fabsf(x))); }
__device__ __forceinline__ float wave_sum(float v) {
#pragma unroll
    for (int o = 1; o < 64; o <<= 1) v += __shfl_xor(v, o);
    return v;
}

constexpr int D = 1024, MP = 16384, MS = 1024, M = MP + MS, SEQ = 8192, DSEQ = 8, NBATCH = 2, DBATCH = 128, DEPTH = 2;
constexpr int NP = 9216, IN_COLS = 8992;
constexpr int CQ = 0, CK = 1024, CV = 1280, CRNN = 1536, CRW = 2560, CG = 6144;
constexpr int SHIFT_W = 3360, DFF = 2816;
constexpr float ALPHA = 1.4142135623730951f;
constexpr float LN_EPS = 1e-5f, GN_EPS = 64e-5f;

constexpr size_t O_YP = 0, O_YS = 16777216, O_PK = 17825792, O_PV = 17956864, O_PCONV = 18087936, O_PH = 18100224,
                 O_PSHIFT = 18104320, O_PWKV = 18117760, O_SK = 18379904, O_SV = 26768512, O_SCONV = 35157120,
                 O_SH = 35943552, O_SSHIFT = 36205696, O_SWKV = 37065856, O_END = 53843072;


constexpr size_t MiB = 1u << 20;
constexpr size_t WS_CTL = 0;
constexpr size_t WIN_T_BYTES = (size_t)NP * D * 2, WOUT_T_BYTES = (size_t)D * D * 2, WGU_T_BYTES = (size_t)2 * DFF * D * 2, WDN_T_BYTES = (size_t)D * DFF * 2;
constexpr int ACAT_K = 384;
constexpr size_t WLORA_BYTES = (size_t)3072 * ACAT_K * 2;
constexpr size_t WS_WIN = 1 * MiB;
constexpr size_t WS_WOUT = WS_WIN + WIN_T_BYTES;
constexpr size_t WS_WGU = WS_WOUT + WOUT_T_BYTES;
constexpr size_t WS_WDN = WS_WGU + WGU_T_BYTES;
constexpr size_t WS_WLORA = WS_WDN + WDN_T_BYTES;
constexpr size_t WS_XB = WS_WLORA + WLORA_BYTES;
constexpr size_t WS_OA = WS_XB + (size_t)M * D * 2;
constexpr size_t WS_MIX = WS_OA;
constexpr size_t WS_OB = WS_OA + (size_t)M * D * 2;
constexpr size_t WS_P = WS_OB + (size_t)M * D * 2;
constexpr size_t WS_Z = WS_P;
constexpr size_t WS_Z1 = WS_Z + (size_t)M * D * 4;
constexpr size_t WS_X1B = WS_Z1 + (size_t)M * D * 4;
constexpr size_t WS_H = WS_X1B + (size_t)M * D * 2;
constexpr size_t WS_PEND = WS_P + (size_t)M * NP * 2;
constexpr size_t WS_RS = WS_PEND;
constexpr size_t WS_WAW = WS_RS + (size_t)2 * 128 * 1024 * 2 * 4;
constexpr size_t WS_WAA = WS_WAW + (size_t)M * D * 2;
constexpr size_t WS_WAG = WS_WAA + (size_t)M * D * 2;
constexpr size_t WS_Y = WS_WAG + (size_t)M * D * 2;
constexpr size_t WS_BD = WS_Y + (size_t)M * D * 2;
constexpr size_t WS_ACAT = WS_BD + (size_t)M * 16 * 4;
constexpr size_t WS_CB = WS_ACAT;
constexpr size_t WS_END = WS_ACAT + (size_t)M * ACAT_K * 2;
static_assert(WS_END <= (size_t)861000000, "workspace budget (4 x output bytes = 861.5 MB)");
static_assert(WS_H + (size_t)M * DFF * 2 <= WS_PEND, "overlay fits");
static_assert(WS_WAA == WS_WAW + (size_t)M * D * 2 && WS_WAG == WS_WAA + (size_t)M * D * 2, "lora outputs contiguous");
static_assert(WS_XB % 256 == 0 && WS_P % 256 == 0 && WS_WLORA % 256 == 0 && WS_ACAT % 256 == 0, "alignment");
namespace pg8 {
#define PG8_LAS __attribute__((address_space(3)))
typedef unsigned short bf16_t;
typedef short bf16x8 __attribute__((ext_vector_type(8)));
typedef float f32x4 __attribute__((ext_vector_type(4)));
typedef unsigned u32x4 __attribute__((ext_vector_type(4)));
constexpr int BM = 256, BK = 64, HALF = 128, HTB = HALF * BK * 2  , STAGE_BYTES = 8 * HTB, NXCD = 8, WGM = 8;

__host__ __device__ __forceinline__ int lds_byte(int r, int c) { const int st = (r >> 4) * 2 + (c >> 5), rr = r & 15, cc = c & 31, ob = rr * 64 + cc * 2; return st * 1024 + (ob ^ (((ob >> 9) & 1) << 5)); }
__host__ __device__ __forceinline__ void stage_rc(int b, int& R, int& C) { const int st = b / 1024, sb = b % 1024, swz = sb ^ (((sb >> 9) & 1) << 5); R = (st >> 1) * 16 + swz / 64; C = (st & 1) * 32 + (swz % 64) / 2; }
__host__ __device__ __forceinline__ int perm32(int rho) { const int n = rho >> 4, i = rho & 15; return 8 * (i >> 2) + 4 * n + (i & 3); }

struct Unit { int pm, pn; };
struct Gemm { const bf16_t* A; const bf16_t* Bt; int M, N, K; int lda = 0, ldb = 0, nsplit = 0; size_t a_koff = 0; };

struct StaticOrder {
    int nM, nN, nwg, G, c;
    __host__ __device__ void init(int M, int N, int G_, int c_) { nM = M / BM; nN = N / BM; nwg = nM * nN; G = G_; c = c_; }
    __host__ __device__ bool next(int i, Unit& u) const {
        const long L = (long)i * G + c; if (L >= nwg) return false;
        int wgid = (int)L; { const int q = nwg / NXCD, r = nwg % NXCD, xcd = wgid % NXCD, off = wgid / NXCD; wgid = (xcd < r ? xcd * (q + 1) : r * (q + 1) + (xcd - r) * q) + off; }
        const int nig = WGM * nN, gid = wgid / nig, fm = gid * WGM, gsz = (nM - fm) < WGM ? (nM - fm) : WGM;
        u.pm = fm + ((wgid % nig) % gsz); u.pn = (wgid % nig) / gsz; return true;
    }
    __device__ __forceinline__ void a_ready(const Unit&) const {}
    __device__ __forceinline__ void done(const Unit&) const {}
};

__device__ __forceinline__ unsigned cvt_pk_bf16(float lo, float hi) { unsigned r; asm volatile("v_cvt_pk_bf16_f32 %0, %1, %2" : "=v"(r) : "v"(lo), "v"(hi)); return r; }
typedef float f32x2 __attribute__((ext_vector_type(2)));
template <class Epi, class Sched, bool ALIGN_EPI = false, bool SP2 = false>
__device__ __forceinline__ void gemm_phase(PG8_LAS unsigned char* lds, const Gemm g, const Sched& S, const Epi& E) {
    const int tid = threadIdx.x, wid = __builtin_amdgcn_readfirstlane(tid >> 6), lane = tid & 63, wr = wid >> 2, wc = wid & 3, fr = lane & 15, fq = lane >> 4;
    const int K = g.K, nt = K / BK, lda = g.lda ? g.lda : K, ldb = g.ldb ? g.ldb : K;
    unsigned voffA[2], voffB[2];
#pragma unroll
    for (int i = 0; i < 2; ++i) { int R, C; stage_rc(tid * 16 + i * 8192, R, C); const int Rb = Epi::PERM ? ((R & ~31) + perm32(R & 31)) : R;
        voffA[i] = (unsigned)(R * lda + C) * 2u; voffB[i] = (unsigned)(Rb * ldb + C) * 2u; }
    const size_t kstep = (size_t)(BK * 2);
    const size_t hstepA = (size_t)HALF * lda * 2, hstepB = (size_t)HALF * ldb * 2;
    const size_t tstepA = 2 * hstepA, tstepB = 2 * hstepB;
#define PG8_ABASE(u) ((const char*)g.A + (size_t)(u).pm * tstepA + (g.nsplit ? (size_t)((u).pn / g.nsplit) * g.a_koff : (size_t)0))
    const unsigned ldsw = (unsigned)wid * 1024u;
    const int aoff = lds_byte(wr * 64 + fr, fq * 8), boff = lds_byte(wc * 32 + fr, fq * 8);
#define PG8_SA(b, h) (((b) * 2 + (h)) * HTB)
#define PG8_SB(b, h) ((4 + (b) * 2 + (h)) * HTB)
#define PG8_STAGE(bufoff, gbase, voff) do { _Pragma("unroll") for (int _i = 0; _i < 2; ++_i) \
        __builtin_amdgcn_global_load_lds((const unsigned*)((const char*)(gbase) + (voff)[_i]), (PG8_LAS unsigned*)(lds + (bufoff) + ldsw + _i * 8192), 16, 0, 0); } while (0)
#define PG8_LDA(dst, b, h) do { _Pragma("unroll") for (int m = 0; m < 4; ++m) _Pragma("unroll") for (int k = 0; k < 2; ++k) dst[m][k] = *(const PG8_LAS bf16x8*)(lds + PG8_SA(b, h) + aoff + m * 2048 + k * 1024); } while (0)
#define PG8_LDB(dst, b, h) do { _Pragma("unroll") for (int n = 0; n < 2; ++n) _Pragma("unroll") for (int k = 0; k < 2; ++k) dst[n][k] = *(const PG8_LAS bf16x8*)(lds + PG8_SB(b, h) + boff + n * 2048 + k * 1024); } while (0)
#define PG8_MMA(ai, bj, At, Bt) do { __builtin_amdgcn_s_setprio(1); _Pragma("unroll") for (int m = 0; m < 4; ++m) _Pragma("unroll") for (int n = 0; n < 2; ++n) _Pragma("unroll") for (int k = 0; k < 2; ++k) \
        acc[ai][bj][m][n] = __builtin_amdgcn_mfma_f32_16x16x32_bf16(Bt[n][k], At[m][k], acc[ai][bj][m][n], 0, 0, 0); __builtin_amdgcn_s_setprio(0); } while (0)
#define PG8_WAIT_V(n) asm volatile("s_waitcnt vmcnt(" #n ")" ::: "memory")
#define PG8_WAIT_L(n) asm volatile("s_waitcnt lgkmcnt(" #n ")" ::: "memory")
#define PG8_BAR __builtin_amdgcn_s_barrier()
#define PG8_SCHED __builtin_amdgcn_sched_barrier(0)
    Unit cur, nxt; int ui = 0;
    if (!S.next(0, cur)) return;
    f32x4 acc[2][2][4][2];
#pragma unroll
    for (int a = 0; a < 2; ++a)
#pragma unroll
        for (int b = 0; b < 2; ++b)
#pragma unroll
            for (int m = 0; m < 4; ++m)
#pragma unroll
                for (int n = 0; n < 2; ++n) acc[a][b][m][n] = (f32x4){0.f, 0.f, 0.f, 0.f};
    bf16x8 At[4][2], B0[2][2], B1[2][2];
    const char* cA = PG8_ABASE(cur); const char* cB = (const char*)g.Bt + (size_t)cur.pn * tstepB;
    S.a_ready(cur);
    if constexpr (SP2) {
        PG8_STAGE(PG8_SB(0, 0), cB, voffB); PG8_STAGE(PG8_SB(0, 1), cB + hstepB, voffB); PG8_STAGE(PG8_SA(0, 0), cA, voffA); PG8_STAGE(PG8_SA(0, 1), cA + hstepA, voffA);
        if (wr == 1) PG8_BAR;
        PG8_WAIT_V(2); PG8_BAR;
        PG8_STAGE(PG8_SB(1, 0), cB + kstep, voffB); PG8_STAGE(PG8_SA(1, 0), cA + kstep, voffA); PG8_STAGE(PG8_SB(1, 1), cB + hstepB + kstep, voffB);
        PG8_WAIT_V(6); PG8_BAR;
    } else {
        PG8_STAGE(PG8_SB(0, 0), cB, voffB); PG8_STAGE(PG8_SA(0, 0), cA, voffA); PG8_STAGE(PG8_SB(0, 1), cB + hstepB, voffB); PG8_STAGE(PG8_SA(0, 1), cA + hstepA, voffA);
        if (wr == 1) PG8_BAR;
        PG8_WAIT_V(4); PG8_BAR;
        PG8_STAGE(PG8_SB(1, 0), cB + kstep, voffB); PG8_STAGE(PG8_SA(1, 0), cA + kstep, voffA); PG8_STAGE(PG8_SB(1, 1), cB + hstepB + kstep, voffB);
        PG8_WAIT_V(6); PG8_BAR;
    }
    for (;;) {
        const bool has_next = S.next(ui + 1, nxt);
        const char* nA = has_next ? PG8_ABASE(nxt) : cA; const char* nB = has_next ? (const char*)g.Bt + (size_t)nxt.pn * tstepB : cB;
#pragma nounroll
        for (int t = 0; t < nt; t += 2) {
            const bool last = (t == nt - 2);
            const char* a1 = cA + (size_t)(t + 1) * kstep;
            const char* a2 = last ? nA : cA + (size_t)(t + 2) * kstep; const char* b2 = last ? nB : cB + (size_t)(t + 2) * kstep;
            const char* a3 = a2 + kstep; const char* b3 = b2 + kstep;
            if (last && has_next) S.a_ready(nxt);
            if constexpr (SP2) {
            PG8_LDB(B0, 0, 0); PG8_LDB(B1, 0, 1); PG8_SCHED; PG8_LDA(At, 0, 0); PG8_STAGE(PG8_SA(1, 1), a1 + hstepA, voffA);
            PG8_WAIT_V(8); PG8_WAIT_L(0); PG8_BAR; PG8_MMA(0, 0, At, B0); PG8_MMA(0, 1, At, B1); PG8_BAR; PG8_SCHED;
            PG8_LDA(At, 0, 1); PG8_STAGE(PG8_SB(0, 0), b2, voffB); PG8_STAGE(PG8_SB(0, 1), b2 + hstepB, voffB); PG8_STAGE(PG8_SA(0, 0), a2, voffA);
            PG8_WAIT_V(8); PG8_WAIT_L(0); PG8_BAR; PG8_MMA(1, 0, At, B0); PG8_MMA(1, 1, At, B1); PG8_BAR; PG8_SCHED;
            PG8_LDB(B0, 1, 0); PG8_LDB(B1, 1, 1); PG8_SCHED; PG8_LDA(At, 1, 0); PG8_STAGE(PG8_SA(0, 1), a2 + hstepA, voffA);
            PG8_WAIT_V(8); PG8_WAIT_L(0); PG8_BAR; PG8_MMA(0, 0, At, B0); PG8_MMA(0, 1, At, B1); PG8_BAR; PG8_SCHED;
            PG8_LDA(At, 1, 1); PG8_STAGE(PG8_SB(1, 0), b3, voffB); PG8_STAGE(PG8_SB(1, 1), b3 + hstepB, voffB); PG8_STAGE(PG8_SA(1, 0), a3, voffA);
            PG8_WAIT_V(8); PG8_WAIT_L(0); PG8_BAR; PG8_MMA(1, 0, At, B0); PG8_MMA(1, 1, At, B1); PG8_BAR; PG8_SCHED;
            } else {
            PG8_LDB(B0, 0, 0); PG8_SCHED; PG8_LDA(At, 0, 0); PG8_STAGE(PG8_SA(1, 1), a1 + hstepA, voffA);
            PG8_WAIT_L(8); PG8_BAR; PG8_WAIT_L(0); PG8_MMA(0, 0, At, B0); PG8_BAR; PG8_SCHED;
            PG8_LDB(B1, 0, 1); PG8_STAGE(PG8_SB(0, 0), b2, voffB);
            PG8_BAR; PG8_WAIT_L(0); PG8_MMA(0, 1, At, B1); PG8_BAR;
            PG8_LDA(At, 0, 1); PG8_STAGE(PG8_SA(0, 0), a2, voffA);
            PG8_BAR; PG8_WAIT_L(0); PG8_MMA(1, 0, At, B0); PG8_BAR; PG8_SCHED;
            PG8_STAGE(PG8_SB(0, 1), b2 + hstepB, voffB);
            PG8_WAIT_V(6); PG8_BAR; PG8_MMA(1, 1, At, B1); PG8_BAR;
            PG8_LDB(B0, 1, 0); PG8_SCHED; PG8_LDA(At, 1, 0); PG8_STAGE(PG8_SA(0, 1), a2 + hstepA, voffA);
            PG8_WAIT_L(8); PG8_BAR; PG8_WAIT_L(0); PG8_MMA(0, 0, At, B0); PG8_BAR; PG8_SCHED;
            PG8_LDB(B1, 1, 1); PG8_STAGE(PG8_SB(1, 0), b3, voffB);
            PG8_BAR; PG8_WAIT_L(0); PG8_MMA(0, 1, At, B1); PG8_BAR;
            PG8_LDA(At, 1, 1); PG8_STAGE(PG8_SA(1, 0), a3, voffA);
            PG8_BAR; PG8_WAIT_L(0); PG8_MMA(1, 0, At, B0); PG8_BAR; PG8_SCHED;
            PG8_STAGE(PG8_SB(1, 1), b3 + hstepB, voffB);
            PG8_WAIT_V(6); PG8_BAR; PG8_MMA(1, 1, At, B1); PG8_BAR;
            }
        }
        if constexpr (ALIGN_EPI) { if (wr == 0) PG8_BAR; }
        if constexpr (!Epi::AFTER_DRAIN) { E(acc, cur, wr, wc, fr, fq); S.done(cur); }
        if (!has_next) break;
#pragma unroll
        for (int a = 0; a < 2; ++a)
#pragma unroll
            for (int b = 0; b < 2; ++b)
#pragma unroll
                for (int m = 0; m < 4; ++m)
#pragma unroll
                    for (int n = 0; n < 2; ++n) acc[a][b][m][n] = (f32x4){0.f, 0.f, 0.f, 0.f};
        cur = nxt; cA = nA; cB = nB; ++ui;
        if constexpr (ALIGN_EPI) { if (wr == 1) PG8_BAR; }
    }
    PG8_WAIT_V(0);
    if constexpr (!ALIGN_EPI) { if (wr == 0) PG8_BAR; }
    PG8_BAR;
    if constexpr (Epi::AFTER_DRAIN) { E.fused(acc, cur, wr, wc, fr, fq, lds, wid, lane); S.done(cur); }
#undef PG8_ABASE
#undef PG8_SA
#undef PG8_SB
#undef PG8_STAGE
#undef PG8_LDA
#undef PG8_LDB
#undef PG8_MMA
#undef PG8_WAIT_V
#undef PG8_WAIT_L
#undef PG8_BAR
#undef PG8_SCHED
}
}

#include <hip/hip_cooperative_groups.h>
namespace cg = cooperative_groups;
#define LAS __attribute__((address_space(3)))
typedef float f32x4 __attribute__((ext_vector_type(4)));
typedef unsigned u32x4 __attribute__((ext_vector_type(4)));
typedef unsigned u32x2 __attribute__((ext_vector_type(2)));

constexpr int NTHREADS = 512, NWAVES = 8;
constexpr int LDS_BYTES = 147456;

constexpr int PH_PREP = 0, PH_PER_LAYER = 11, PH_L0 = 1;
constexpr int PHO_IN = 0, PHO_MIXA = 1, PHO_LORA = 2, PHO_C1 = 3, PHO_MIXB = 4, PHO_MIXC = 5, PHO_OUT = 6, PHO_LN1 = 7, PHO_GU = 8, PHO_DOWN = 9, PHO_LN2 = 10;
constexpr int N_PHASES = PH_L0 + DEPTH * PH_PER_LAYER;

struct Args { const float* in[35]; float* out; unsigned char* ws; int ph_lo, ph_hi; };

typedef float f32x2_t __attribute__((ext_vector_type(2))); typedef __bf16 bf16x2_t __attribute__((ext_vector_type(2)));
__device__ __forceinline__ unsigned pk2bf(float lo, float hi) { f32x2_t v = {lo, hi}; bf16x2_t b = __builtin_convertvector(v, bf16x2_t); return __builtin_bit_cast(unsigned, b); }

struct EpiIn {
    static constexpr bool PERM = true, AFTER_DRAIN = false;
    bf16_t* O; int ldc; int sig_pn;
    __device__ __forceinline__ void operator()(const f32x4 (&acc)[2][2][4][2], const pg8::Unit& u, int wr, int wc, int fr, int fq) const {
        const int row0 = u.pm * 256 + wr * 64 + fr, col0 = u.pn * 256 + wc * 32 + 8 * fq;
        const bool sg = u.pn >= sig_pn;
#pragma unroll
        for (int ai = 0; ai < 2; ++ai)
#pragma unroll
            for (int m = 0; m < 4; ++m) {
                bf16_t* rowp = O + (size_t)(row0 + ai * 128 + m * 16) * ldc + col0;
#pragma unroll
                for (int bj = 0; bj < 2; ++bj) {
                    f32x4 v0 = acc[ai][bj][m][0], v1 = acc[ai][bj][m][1];
                    if (sg) {
#pragma unroll
                        for (int i = 0; i < 4; ++i) { v0[i] = sigmoidf_(v0[i]); v1[i] = sigmoidf_(v1[i]); }
                    }
                    u32x4 w; w.x = pk2bf(v0[0], v0[1]); w.y = pk2bf(v0[2], v0[3]); w.z = pk2bf(v1[0], v1[1]); w.w = pk2bf(v1[2], v1[3]);
                    *(u32x4*)(rowp + bj * 128) = w;
                }
                asm volatile("" ::: "memory");
            }
    }
};
template <bool RESB> struct EpiSplit {
    static constexpr bool PERM = false, AFTER_DRAIN = false;
    const void* res0; const void* res1; int split; float* Z0; float* Z1; int ldc;
    __device__ __forceinline__ void operator()(const f32x4 (&acc)[2][2][4][2], const pg8::Unit& u, int wr, int wc, int fr, int fq) const {
        const int ks = u.pn >> 2, col0 = (u.pn & 3) * 256 + wc * 32 + 4 * fq;
        float* Z = ks ? Z1 : Z0;
        const float* rf = u.pm * 256 < split ? (const float*)res0 : (const float*)res1 - (size_t)split * ldc;
        const bf16_t* rb = (const bf16_t*)res0;
#pragma unroll
        for (int ai = 0; ai < 2; ++ai)
#pragma unroll
            for (int m = 0; m < 4; ++m) {
                const size_t off = (size_t)(u.pm * 256 + ai * 128 + wr * 64 + m * 16 + fr) * ldc + col0;
#pragma unroll
                for (int bj = 0; bj < 2; ++bj)
#pragma unroll
                    for (int n = 0; n < 2; ++n) {
                        f32x4 o = acc[ai][bj][m][n];
                        if (ks == 0) {
                            f32x4 r;
                            if (RESB) { const u32x2 w = *(const u32x2*)(rb + off + bj * 128 + n * 16);
                                r = (f32x4){__uint_as_float(w.x << 16), __uint_as_float(w.x & 0xffff0000u), __uint_as_float(w.y << 16), __uint_as_float(w.y & 0xffff0000u)}; }
                            else r = *(const f32x4*)(rf + off + bj * 128 + n * 16);
                            o = r * ALPHA + o;
                        }
                        *(f32x4*)(Z + off + bj * 128 + n * 16) = o;
                    }
                asm volatile("" ::: "memory");
            }
    }
};
struct EpiSwiGLU {
    static constexpr bool PERM = true, AFTER_DRAIN = false;
    bf16_t* H; int ldc;
    __device__ __forceinline__ void operator()(const f32x4 (&acc)[2][2][4][2], const pg8::Unit& u, int wr, int wc, int fr, int fq) const {
        const int row0 = u.pm * 256 + wr * 64 + fr, col0 = u.pn * 128 + wc * 32 + 8 * fq;
#pragma unroll
        for (int ai = 0; ai < 2; ++ai)
#pragma unroll
            for (int m = 0; m < 4; ++m) {
                bf16_t* rowp = H + (size_t)(row0 + ai * 128 + m * 16) * ldc + col0;
                float o[8];
#pragma unroll
                for (int n = 0; n < 2; ++n)
#pragma unroll
                    for (int i = 0; i < 4; ++i) { const float g = acc[ai][0][m][n][i], up = acc[ai][1][m][n][i]; o[n * 4 + i] = g * sigmoidf_(g) * up; }
                u32x4 w; w.x = pk2bf(o[0], o[1]); w.y = pk2bf(o[2], o[3]); w.z = pk2bf(o[4], o[5]); w.w = pk2bf(o[6], o[7]);
                *(u32x4*)rowp = w;
                asm volatile("" ::: "memory");
            }
    }
};

template <int MODE> __device__ __forceinline__ int colmap(int n) {
    if (MODE == 0) return n < 5920 ? n : (n < 6144 ? -1 : n - 224);
    if (MODE == 2) { const int pn = n >> 8, q = n & 255; return q < 128 ? pn * 128 + q : DFF + pn * 128 + (q - 128); }
    return n;
}
template <int MODE> __device__ __forceinline__ void transpose_item(const float* __restrict__ W, int K, int ldw, bf16_t* WT, int item, int nblk, LAS float* tile, int tid, int khalf = 0, int nrows = 0) {
    const int kb = item / nblk, nb = item % nblk, k0 = kb * 64, n0 = nb * 64;
    {
        const int nn = tid & 63; const int col = colmap<MODE>(n0 + nn);
#pragma unroll
        for (int i = 0; i < 8; ++i) { const int kk = i * 8 + (tid >> 6); tile[kk * 65 + nn] = col >= 0 ? W[(size_t)(k0 + kk) * ldw + col] : 0.f; }
    }
    __syncthreads();
    {
        const int nn = tid >> 3, c = tid & 7; const LAS float* s = tile + (8 * c) * 65 + nn;
        u32x4 o; o.x = pk2bf(s[0], s[65]); o.y = pk2bf(s[2 * 65], s[3 * 65]); o.z = pk2bf(s[4 * 65], s[5 * 65]); o.w = pk2bf(s[6 * 65], s[7 * 65]);
        if (khalf) { const int ks = k0 / khalf; *(u32x4*)(WT + ((size_t)ks * nrows + n0 + nn) * khalf + (k0 - ks * khalf) + 8 * c) = o; }
        else *(u32x4*)(WT + (size_t)(n0 + nn) * K + k0 + 8 * c) = o;
    }
    __syncthreads();
}
__device__ __forceinline__ void prep_rg_weights(const Args& a, int l);
__device__ __forceinline__ void phase_prep_weights(const Args& a, int l, LAS unsigned char* lds) {
    const int tid = threadIdx.x, G = gridDim.x, bx = blockIdx.x;
    LAS float* tile = (LAS float*)lds;
    constexpr int I_IN = (D / 64) * (NP / 64), I_OUT = (D / 64) * (D / 64), I_GU = (D / 64) * (2 * DFF / 64), I_DN = (DFF / 64) * (D / 64);
    constexpr int I_LAYER = I_IN + I_OUT + I_GU + I_DN;
    for (int it = bx; it < I_LAYER; it += G) {
        int r = it;
        if (r < I_IN) { transpose_item<0>(a.in[8] + (size_t)l * D * IN_COLS, D, IN_COLS, (bf16_t*)(a.ws + WS_WIN), r, NP / 64, tile, tid); continue; } r -= I_IN;
        if (r < I_OUT) { transpose_item<1>(a.in[28] + (size_t)l * D * D, D, D, (bf16_t*)(a.ws + WS_WOUT), r, D / 64, tile, tid, D / 2, D); continue; } r -= I_OUT;
        if (r < I_GU) { transpose_item<2>(a.in[31] + (size_t)l * D * 2 * DFF, D, 2 * DFF, (bf16_t*)(a.ws + WS_WGU), r, 2 * DFF / 64, tile, tid); continue; } r -= I_GU;
        transpose_item<1>(a.in[32] + (size_t)l * DFF * D, DFF, D, (bf16_t*)(a.ws + WS_WDN), r, D / 64, tile, tid, DFF / 2, D);
    }
    const size_t gt = (size_t)bx * NTHREADS + tid, gs = (size_t)G * NTHREADS;
    for (size_t i = gt; i < (size_t)3072 * ACAT_K; i += gs) {
        const int n = (int)(i / ACAT_K), k = (int)(i % ACAT_K), kind = n >> 10, c = n & 1023;
        float v = 0.f;
        if (kind == 0 && k < 64) v = a.in[19][((size_t)l * 64 + k) * D + c];
        else if (kind == 1 && k >= 64 && k < 128) v = a.in[21][((size_t)l * 64 + (k - 64)) * D + c];
        else if (kind == 2 && k >= 128 && k < 288) v = a.in[22][((size_t)l * 160 + (k - 128)) * D + c];
        ((bf16_t*)(a.ws + WS_WLORA))[i] = f2bf(v);
    }
    prep_rg_weights(a, l);
}
__device__ __forceinline__ void phase_prep_x(const Args& a) {
    bf16_t* XB = (bf16_t*)(a.ws + WS_XB);
    const size_t n4 = (size_t)M * D / 4, np4 = (size_t)MP * D / 4;
    for (size_t i = (size_t)blockIdx.x * NTHREADS + threadIdx.x; i < n4; i += (size_t)gridDim.x * NTHREADS) {
        const f32x4 v = i < np4 ? ((const f32x4*)a.in[0])[i] : ((const f32x4*)a.in[1])[i - np4];
        u32x2 w; w.x = pk2bf(v[0], v[1]); w.y = pk2bf(v[2], v[3]);
        ((u32x2*)XB)[i] = w;
    }
}

__device__ __forceinline__ float wave_sum_fast(float x) {
    x += __builtin_bit_cast(float, __builtin_amdgcn_update_dpp(0, __builtin_bit_cast(int, x), 0xB1, 0xF, 0xF, true));
    x += __builtin_bit_cast(float, __builtin_amdgcn_update_dpp(0, __builtin_bit_cast(int, x), 0x4E, 0xF, 0xF, true));
    x += __builtin_bit_cast(float, __builtin_amdgcn_update_dpp(0, __builtin_bit_cast(int, x), 0x124, 0xF, 0xF, true));
    x += __builtin_bit_cast(float, __builtin_amdgcn_update_dpp(0, __builtin_bit_cast(int, x), 0x128, 0xF, 0xF, true));
    x += __shfl_xor(x, 16); x += __shfl_xor(x, 32);
    return x;
}
__device__ __forceinline__ void phase_ln(const float* __restrict__ Z, const float* __restrict__ Z1, const float* __restrict__ g, const float* __restrict__ b, float* OF, bf16_t* OB) {
    const int lane = threadIdx.x & 63, wv = threadIdx.x >> 6;
    f32x4 gv[4], bv[4];
#pragma unroll
    for (int j = 0; j < 4; ++j) { gv[j] = ((const f32x4*)g)[j * 64 + lane]; bv[j] = ((const f32x4*)b)[j * 64 + lane]; }
    const int stride = gridDim.x * NWAVES;
    int m = blockIdx.x * NWAVES + wv;
    f32x4 nx[4], nx1[4];
    if (m < M) {
#pragma unroll
        for (int j = 0; j < 4; ++j) { nx[j] = ((const f32x4*)(Z + (size_t)m * D))[j * 64 + lane]; nx1[j] = ((const f32x4*)(Z1 + (size_t)m * D))[j * 64 + lane]; }
    }
    for (; m < M; m += stride) {
        f32x4 v[4]; float s = 0.f;
#pragma unroll
        for (int j = 0; j < 4; ++j) { v[j] = nx[j] + nx1[j]; s += (v[j][0] + v[j][1]) + (v[j][2] + v[j][3]); }
        if (m + stride < M) {
#pragma unroll
            for (int j = 0; j < 4; ++j) { nx[j] = ((const f32x4*)(Z + (size_t)(m + stride) * D))[j * 64 + lane]; nx1[j] = ((const f32x4*)(Z1 + (size_t)(m + stride) * D))[j * 64 + lane]; }
        }
        const float mean = wave_sum_fast(s) * (1.f / D);
        float q = 0.f;
#pragma unroll
        for (int j = 0; j < 4; ++j) { v[j] = v[j] - mean; q += (v[j][0] * v[j][0] + v[j][1] * v[j][1]) + (v[j][2] * v[j][2] + v[j][3] * v[j][3]); }
        const float rstd = rsqrtf(wave_sum_fast(q) * (1.f / D) + LN_EPS);
#pragma unroll
        for (int j = 0; j < 4; ++j) {
            const f32x4 y = v[j] * rstd * gv[j] + bv[j];
            if (OF) ((f32x4*)(OF + (size_t)m * D))[j * 64 + lane] = y;
            if (OB) { u32x2 w; w.x = pk2bf(y[0], y[1]); w.y = pk2bf(y[2], y[3]); ((u32x2*)(OB + (size_t)m * D))[j * 64 + lane] = w; }
        }
    }
}


typedef short bf16x8_t __attribute__((ext_vector_type(8)));
typedef short bf16x4_t __attribute__((ext_vector_type(4)));
typedef short v4i16_t __attribute__((ext_vector_type(4)));
#define LDSW() asm volatile("s_waitcnt lgkmcnt(0)" ::: "memory")
__device__ __forceinline__ u32x2 tr_read4(LAS unsigned char* p) { return __builtin_bit_cast(u32x2, __builtin_amdgcn_ds_read_tr16_b64_v4i16((LAS v4i16_t*)p)); }
__device__ __forceinline__ bf16x8_t mk_frag(u32x2 lo, u32x2 hi) { const u32x4 w = (u32x4){lo.x, lo.y, hi.x, hi.y}; return __builtin_bit_cast(bf16x8_t, w); }
__device__ __forceinline__ u32x2 pk4(float a, float b, float c, float d) { u32x2 w; w.x = pk2bf(a, b); w.y = pk2bf(c, d); return w; }

constexpr size_t WS_WRG = WS_CTL + 4096;
constexpr int RG_TP = 144;
__device__ __forceinline__ void prep_rg_weights(const Args& a, int l) {
    const size_t gt = (size_t)blockIdx.x * NTHREADS + threadIdx.x, gs = (size_t)gridDim.x * NTHREADS;
    bf16_t* W = (bf16_t*)(a.ws + WS_WRG);
    for (size_t i = gt; i < (size_t)2 * 16 * 4096; i += gs) {
        const int gate = (int)(i >> 16), bk = (int)(i >> 12) & 15, j = (int)(i >> 6) & 63, ii = (int)i & 63;
        W[i] = f2bf(a.in[gate ? 14 : 12][(size_t)l * 16 * 4096 + ((size_t)bk * 64 + ii) * 64 + j]);
    }
}
__device__ __forceinline__ float one_minus_exp(float x) {
    const float s = -x * (1.f + x * (0.5f + x * (0.16666667f + x * (0.041666668f + x * 0.0083333333f))));
    return x > -0.25f ? s : 1.f - __expf(x);
}
template <bool PASS2>
__device__ __forceinline__ void rglru_unit2(const Args& a, int L, int unit, LAS unsigned char* lds) {
    int lane = threadIdx.x & 63; const int wv = __builtin_amdgcn_readfirstlane(threadIdx.x >> 6);
    asm volatile("" : "+v"(lane));
    const int i16 = lane & 15, qp = lane >> 4;
    const bf16_t* P = (const bf16_t*)(a.ws + WS_P); bf16_t* OB = (bf16_t*)(a.ws + WS_OB); float* RS = (float*)(a.ws + WS_RS);
    const bf16_t* WRG = (const bf16_t*)(a.ws + WS_WRG);
    const float* cw = a.in[10] + (size_t)L * 4 * D; const float* cb = a.in[11] + L * D; const float* ba = a.in[13] + L * D;
    const float* bx = a.in[15] + L * D; const float* lam = a.in[16] + L * D;
    const float* conv0 = a.in[4] + (size_t)L * DBATCH * 3 * D; const float* h0 = a.in[5] + (size_t)L * DBATCH * D;
    LAS unsigned char* tile = lds + wv * (64 * RG_TP);
    const int m0 = unit * 64;
    const bool sample = m0 >= MP;
    const int bseq = sample ? 0 : m0 / SEQ, chunk = sample ? 0 : (m0 % SEQ) / 64;
    for (int bb = 0; bb < 2; ++bb) {
        const int bk = 2 * wv + bb, c0 = 64 * bk;
        bf16x8_t af[4][2];
#pragma unroll
        for (int ks = 0; ks < 2; ++ks) {
            const int cc = c0 + 32 * ks + 8 * qp;
            f32x4 w0[2], w1[2], w2[2], w3[2], wb[2];
#pragma unroll
            for (int hh = 0; hh < 2; ++hh) { w0[hh] = *(const f32x4*)(cw + 0 * D + cc + 4 * hh); w1[hh] = *(const f32x4*)(cw + 1 * D + cc + 4 * hh); w2[hh] = *(const f32x4*)(cw + 2 * D + cc + 4 * hh);
                w3[hh] = *(const f32x4*)(cw + 3 * D + cc + 4 * hh); wb[hh] = *(const f32x4*)(cb + cc + 4 * hh); }
#pragma unroll
            for (int mt = 0; mt < 4; ++mt) {
                const int tok = 16 * mt + i16; const size_t m = (size_t)m0 + tok;
                const int tseq = sample ? (tok & 7) : (chunk * 64 + tok);
                float xv[4][8];
#pragma unroll
                for (int k = 0; k < 4; ++k) {
                    const int back = 3 - k;
                    const bool ok = tseq - back >= 0;
                    const u32x4 v = *(const u32x4*)(P + (m - (ok ? back : 0)) * NP + CRNN + cc);
                    const unsigned w4[4] = {v.x, v.y, v.z, v.w};
#pragma unroll
                    for (int e = 0; e < 8; ++e) xv[k][e] = ok ? __uint_as_float((e & 1) ? (w4[e >> 1] & 0xffff0000u) : (w4[e >> 1] << 16)) : 0.f;
                    if (sample && back > 0) {
                        const int b = (int)(m - MP) >> 3; const int ci = ok ? 0 : 3 + tseq - back;
                        const float* cp = conv0 + ((size_t)b * 3 + ci) * D + cc;
                        const f32x4 v0 = *(const f32x4*)cp, v1 = *(const f32x4*)(cp + 4);
#pragma unroll
                        for (int e = 0; e < 4; ++e) { xv[k][e] = ok ? xv[k][e] : v0[e]; xv[k][4 + e] = ok ? xv[k][4 + e] : v1[e]; }
                    }
                }
                float xc[8];
#pragma unroll
                for (int e = 0; e < 8; ++e) xc[e] = wb[e >> 2][e & 3] + w0[e >> 2][e & 3] * xv[0][e] + w1[e >> 2][e & 3] * xv[1][e] + w2[e >> 2][e & 3] * xv[2][e] + w3[e >> 2][e & 3] * xv[3][e];
                const u32x4 pk = (u32x4){pk2bf(xc[0], xc[1]), pk2bf(xc[2], xc[3]), pk2bf(xc[4], xc[5]), pk2bf(xc[6], xc[7])};
                af[mt][ks] = __builtin_bit_cast(bf16x8_t, pk);
                *(LAS u32x4*)(tile + tok * RG_TP + (32 * ks + 8 * qp) * 2) = pk;
            }
        }
        LDSW();
#pragma unroll 1
        for (int nt = 0; nt < 4; ++nt) {
            const int j = 16 * nt + i16, c = c0 + j;
            bf16x8_t ba_[2], bx_[2];
#pragma unroll
            for (int ks = 0; ks < 2; ++ks) { ba_[ks] = *(const bf16x8_t*)(WRG + ((size_t)(0 * 16 + bk) * 64 + j) * 64 + 32 * ks + 8 * qp); bx_[ks] = *(const bf16x8_t*)(WRG + ((size_t)(1 * 16 + bk) * 64 + j) * 64 + 32 * ks + 8 * qp); }
            const float bac = ba[c], bxc = bx[c], spl = softplusf_(-lam[c]);
            float av[4][4], uv[4][4];
#pragma unroll
            for (int mt = 0; mt < 4; ++mt) {
                f32x4 ar = (f32x4){0.f, 0.f, 0.f, 0.f}, ai = ar;
#pragma unroll
                for (int ks = 0; ks < 2; ++ks) { ar = __builtin_amdgcn_mfma_f32_16x16x32_bf16(af[mt][ks], ba_[ks], ar, 0, 0, 0); ai = __builtin_amdgcn_mfma_f32_16x16x32_bf16(af[mt][ks], bx_[ks], ai, 0, 0, 0); }
                const u32x2 xcp = tr_read4(tile + (16 * mt + 4 * qp + (i16 >> 2)) * RG_TP + (16 * nt + 4 * (i16 & 3)) * 2);
#pragma unroll
                for (int r = 0; r < 4; ++r) {
                    const unsigned xw = r < 2 ? xcp.x : xcp.y;
                    const float xcv = __uint_as_float((r & 1) ? (xw & 0xffff0000u) : (xw << 16));
                    const float rg = sigmoidf_(ar[r] + bac), ig = sigmoidf_(ai[r] + bxc);
                    const float log_a = -8.f * rg * spl;
                    av[mt][r] = __expf(log_a);
                    uv[mt][r] = sqrtf(one_minus_exp(2.f * log_a)) * (ig * xcv);
                }
            }
            float H = 0.f, Atot = 1.f;
            if (PASS2 && !sample && chunk > 0) H = RS[(((size_t)bseq * 128 + chunk) * D + c) * 2 + 1];
#pragma unroll
            for (int mt = 0; mt < 4; ++mt) {
                const float As = av[mt][0] * av[mt][1] * av[mt][2] * av[mt][3];
                const float Bs = ((uv[mt][0] * av[mt][1] + uv[mt][1]) * av[mt][2] + uv[mt][2]) * av[mt][3] + uv[mt][3];
                float Aq[4], Bq[4];
#pragma unroll
                for (int q = 0; q < 4; ++q) { Aq[q] = __shfl(As, i16 + 16 * q); Bq[q] = __shfl(Bs, i16 + 16 * q); }
                float hs;
                if (!sample) {
                    const float h1 = Aq[0] * H + Bq[0], h2 = Aq[1] * h1 + Bq[1], h3 = Aq[2] * h2 + Bq[2];
                    hs = qp == 0 ? H : (qp == 1 ? h1 : (qp == 2 ? h2 : h3));
                    H = Aq[3] * h3 + Bq[3]; Atot *= Aq[0] * Aq[1] * Aq[2] * Aq[3];
                } else {
                    const int b0 = ((m0 - MP) >> 3) + 2 * mt;
                    const float hA = h0[(size_t)b0 * D + c], hB = h0[(size_t)(b0 + 1) * D + c];
                    const float hA1 = Aq[0] * hA + Bq[0], hB1 = Aq[2] * hB + Bq[2];
                    hs = qp == 0 ? hA : (qp == 1 ? hA1 : (qp == 2 ? hB : hB1));
                    if (PASS2 && qp == 0) {
                        a.out[O_SH + ((size_t)L * DBATCH + b0) * D + c] = Aq[1] * hA1 + Bq[1];
                        a.out[O_SH + ((size_t)L * DBATCH + b0 + 1) * D + c] = Aq[3] * hB1 + Bq[3];
                    }
                }
                if (PASS2) {
                    float h = hs;
#pragma unroll
                    for (int r = 0; r < 4; ++r) { h = av[mt][r] * h + uv[mt][r]; OB[((size_t)m0 + 16 * mt + 4 * qp + r) * D + c] = f2bf(h); }
                }
            }
            if (!sample && qp == 0) {
                if (!PASS2) *(float2*)(RS + (((size_t)bseq * 128 + chunk) * D + c) * 2) = make_float2(Atot, H);
                else if (chunk == 127) a.out[O_PH + ((size_t)L * NBATCH + bseq) * D + c] = H;
            }
        }
        LDSW();
    }
    if (PASS2) {
        const int t = threadIdx.x;
        if (sample) {
            for (int i = t; i < 8 * 3 * D; i += NTHREADS) { const int s = i / (3 * D), k = (i / D) % 3, c = i % D; const int b = ((m0 - MP) >> 3) + s;
                a.out[O_SCONV + (((size_t)L * DBATCH + b) * 3 + k) * D + c] = bf2f(P[((size_t)MP + b * DSEQ + 5 + k) * NP + CRNN + c]); }
        } else if (chunk == 127) {
            for (int i = t; i < 3 * D; i += NTHREADS) { const int k = i / D, c = i % D;
                a.out[O_PCONV + (((size_t)L * NBATCH + bseq) * 3 + k) * D + c] = bf2f(P[((size_t)m0 + 61 + k) * NP + CRNN + c]); }
        }
    }
}
__device__ __forceinline__ void rglru_prefix(const Args& a) {
    float* RS = (float*)(a.ws + WS_RS);
    const int gid = blockIdx.x * NTHREADS + threadIdx.x;
    if (gid >= NBATCH * D) return;
    const int b = gid / D, c = gid % D;
    float h = 0.f;
    for (int c0 = 0; c0 < 128; c0 += 16) {
        float2 ab[16];
#pragma unroll
        for (int i = 0; i < 16; ++i) ab[i] = *(const float2*)(RS + (((size_t)b * 128 + c0 + i) * D + c) * 2);
#pragma unroll
        for (int i = 0; i < 16; ++i) { RS[(((size_t)b * 128 + c0 + i) * D + c) * 2 + 1] = h; h = ab[i].x * h + ab[i].y; }
    }
}


constexpr int AT_KPB = 144;
constexpr int AT_VPB = 528;
constexpr int AT_K_OFF = 0, AT_V_OFF = 256 * AT_KPB;
constexpr int AT_LDS = AT_V_OFF + 64 * AT_VPB;

template <bool SAMPLE>
__device__ __forceinline__ void attn_unit(const bf16_t* __restrict__ P, bf16_t* OA, const float* __restrict__ sinks, const float* __restrict__ ck, const float* __restrict__ cv,
                                          int b, int qb, int c, LAS unsigned char* lds) {
    const int tid = threadIdx.x, lane = tid & 63, wv = __builtin_amdgcn_readfirstlane(tid >> 6), i16 = lane & 15, qp = lane >> 4;
    LAS unsigned char* ldsK = lds + AT_K_OFF; LAS unsigned char* ldsV = lds + AT_V_OFF;
    if (!SAMPLE) {
        const size_t row_base = (size_t)b * SEQ + (size_t)(qb - 1) * 128;
#pragma unroll
        for (int it = 0; it < 4; ++it) {
            const int ci = tid + 512 * it, s = ci >> 3, part = ci & 7;
            u32x4 kv = (u32x4){0u, 0u, 0u, 0u}, vv = (u32x4){0u, 0u, 0u, 0u};
            if (qb > 0 || s >= 128) {
                const bf16_t* pr = P + (row_base + s) * NP;
                kv = *(const u32x4*)(pr + CK + 64 * c + 8 * part);
                vv = *(const u32x4*)(pr + CV + 64 * c + 8 * part);
            }
            *(LAS u32x4*)(ldsK + s * AT_KPB + part * 16) = kv;
            const unsigned w4[4] = {vv.x, vv.y, vv.z, vv.w};
#pragma unroll
            for (int e = 0; e < 8; ++e) *(LAS unsigned short*)(ldsV + (8 * part + e) * AT_VPB + 2 * s) = (unsigned short)((w4[e >> 1] >> (16 * (e & 1))) & 0xffffu);
        }
    } else {
        for (int ci = tid; ci < 144 * 16; ci += 512) {
            const int s = ci >> 4, part = ci & 15;
            float kf[4] = {0.f, 0.f, 0.f, 0.f}, vf[4] = {0.f, 0.f, 0.f, 0.f};
            if (s < 128) {
                const f32x4 k4 = *(const f32x4*)(ck + ((size_t)(b * 128 + s) * 4 + c) * 64 + 4 * part);
                const f32x4 v4 = *(const f32x4*)(cv + ((size_t)(b * 128 + s) * 4 + c) * 64 + 4 * part);
#pragma unroll
                for (int e = 0; e < 4; ++e) { kf[e] = k4[e]; vf[e] = v4[e]; }
            } else if (s < 136) {
                const bf16_t* pr = P + (size_t)(MP + b * DSEQ + (s - 128)) * NP;
#pragma unroll
                for (int e = 0; e < 4; ++e) { kf[e] = bf2f(pr[CK + 64 * c + 4 * part + e]); vf[e] = bf2f(pr[CV + 64 * c + 4 * part + e]); }
            }
            u32x2 kw; kw.x = pk2bf(kf[0], kf[1]); kw.y = pk2bf(kf[2], kf[3]);
            *(LAS u32x2*)(ldsK + s * AT_KPB + part * 8) = kw;
#pragma unroll
            for (int e = 0; e < 4; ++e) *(LAS unsigned short*)(ldsV + (4 * part + e) * AT_VPB + 2 * s) = f2bf(vf[e]);
        }
    }
    __syncthreads();
    const int n_mt = SAMPLE ? 1 : 4;
    if (!SAMPLE || wv < 2) {
        for (int mt = 0; mt < n_mt; ++mt) {
            int h, tq, nt0; size_t qrow;
            if (!SAMPLE) { const int g = wv >> 1, qh = wv & 1; h = 4 * c + g; tq = 64 * qh + 16 * mt + i16; nt0 = (64 * qh + 16 * mt) >> 4; qrow = (size_t)b * SEQ + (size_t)qb * 128 + tq; }
            else { const int rho = 16 * wv + i16; h = 4 * c + (rho >> 3); tq = rho & 7; nt0 = 0; qrow = (size_t)MP + b * DSEQ + tq; }
            const float slope = exp2f(-0.5f * (float)(h + 1)), sink = sinks[h];
            bf16x8_t qf[2];
#pragma unroll
            for (int ks = 0; ks < 2; ++ks) qf[ks] = *(const bf16x8_t*)(P + qrow * NP + CQ + 64 * h + 32 * ks + 8 * qp);
            f32x4 sc[9];
#pragma unroll
            for (int jn = 0; jn < 9; ++jn) {
                const int nt = nt0 + jn;
                f32x4 acc = (f32x4){0.f, 0.f, 0.f, 0.f};
                if (SAMPLE || qb > 0 || nt >= 8) {
#pragma unroll
                    for (int ks = 0; ks < 2; ++ks) {
                        const bf16x8_t kfr = *(const LAS bf16x8_t*)(ldsK + (16 * nt + i16) * AT_KPB + (32 * ks + 8 * qp) * 2);
                        acc = __builtin_amdgcn_mfma_f32_16x16x32_bf16(kfr, qf[ks], acc, 0, 0, 0);
                    }
                }
#pragma unroll
                for (int r = 0; r < 4; ++r) {
                    const int sidx = 16 * nt + 4 * qp + r;
                    const int rel = 128 + tq - sidx;
                    bool valid = rel >= 0 && rel < 128;
                    if (!SAMPLE) valid = valid && (qb > 0 || sidx >= 128);
                    acc[r] = valid ? acc[r] * 0.125f - slope * (float)rel : -INFINITY;
                }
                sc[jn] = acc;
            }
            float mx = sink;
#pragma unroll
            for (int jn = 0; jn < 9; ++jn)
#pragma unroll
                for (int r = 0; r < 4; ++r) mx = fmaxf(mx, sc[jn][r]);
            mx = fmaxf(mx, __shfl_xor(mx, 16)); mx = fmaxf(mx, __shfl_xor(mx, 32));
            float sum = 0.f;
#pragma unroll
            for (int jn = 0; jn < 9; ++jn)
#pragma unroll
                for (int r = 0; r < 4; ++r) { const float e = __expf(sc[jn][r] - mx); sc[jn][r] = e; sum += e; }
            sum += __shfl_xor(sum, 16); sum += __shfl_xor(sum, 32);
            const float inv = 1.f / (sum + __expf(sink - mx));
            bf16x8_t pf[5];
#pragma unroll
            for (int ks = 0; ks < 5; ++ks) {
                u32x4 w;
                w.x = pk2bf(sc[2 * ks][0] * inv, sc[2 * ks][1] * inv); w.y = pk2bf(sc[2 * ks][2] * inv, sc[2 * ks][3] * inv);
                if (ks < 4) { w.z = pk2bf(sc[2 * ks + 1][0] * inv, sc[2 * ks + 1][1] * inv); w.w = pk2bf(sc[2 * ks + 1][2] * inv, sc[2 * ks + 1][3] * inv); }
                else { w.z = 0u; w.w = 0u; }
                pf[ks] = __builtin_bit_cast(bf16x8_t, w);
            }
#pragma unroll
            for (int dt = 0; dt < 4; ++dt) {
                f32x4 o = (f32x4){0.f, 0.f, 0.f, 0.f};
#pragma unroll
                for (int ks = 0; ks < 5; ++ks) {
                    const int ntA = nt0 + 2 * ks, ntB = (ks < 4) ? nt0 + 2 * ks + 1 : nt0 + 2 * ks;
                    const LAS unsigned char* vr = ldsV + (16 * dt + i16) * AT_VPB;
                    const u32x2 lo = *(const LAS u32x2*)(vr + 2 * (16 * ntA + 4 * qp));
                    const u32x2 hi = *(const LAS u32x2*)(vr + 2 * (16 * ntB + 4 * qp));
                    const u32x4 w = (u32x4){lo.x, lo.y, hi.x, hi.y};
                    o = __builtin_amdgcn_mfma_f32_16x16x32_bf16(__builtin_bit_cast(bf16x8_t, w), pf[ks], o, 0, 0, 0);
                }
                u32x2 ow; ow.x = pk2bf(o[0], o[1]); ow.y = pk2bf(o[2], o[3]);
                *(u32x2*)(OA + qrow * D + 64 * h + 16 * dt + 4 * qp) = ow;
            }
        }
    }
    __syncthreads();
}

template <bool PASS2>
__device__ __forceinline__ void rglru_unit(const Args& a, int L, int unit, LAS unsigned char* lds) {
    const int tid = threadIdx.x, lane = tid & 63, wv = __builtin_amdgcn_readfirstlane(tid >> 6);
    const bf16_t* P = (const bf16_t*)(a.ws + WS_P); bf16_t* OB = (bf16_t*)(a.ws + WS_OB); float* RS = (float*)(a.ws + WS_RS);
    const float* cw = a.in[10] + (size_t)L * 4 * D; const float* cb = a.in[11] + L * D; const float* wa = a.in[12] + (size_t)L * 16 * 4096; const float* ba = a.in[13] + L * D;
    const float* wx = a.in[14] + (size_t)L * 16 * 4096; const float* bx = a.in[15] + L * D; const float* lam = a.in[16] + L * D;
    const float* conv0 = a.in[4] + (size_t)L * DBATCH * 3 * D; const float* h0 = a.in[5] + (size_t)L * DBATCH * D;
    LAS float* s_xc = (LAS float*)lds + wv * 64;
    const int m0 = unit * 64;
    const bool sample = m0 >= MP;
    for (int bb = 0; bb < 2; ++bb) {
        const int bk = 2 * wv + bb, c = 64 * bk + lane;
        float war[64], wxr[64];
#pragma unroll
        for (int i = 0; i < 64; ++i) { war[i] = wa[((size_t)bk * 64 + i) * 64 + lane]; wxr[i] = wx[((size_t)bk * 64 + i) * 64 + lane]; }
        const float c0 = cw[0 * D + c], c1 = cw[1 * D + c], c2 = cw[2 * D + c], c3 = cw[3 * D + c], cbc = cb[c], bac = ba[c], bxc = bx[c];
        const float spl = softplusf_(-lam[c]);
        float x1 = 0.f, x2 = 0.f, x3 = 0.f, h = 0.f, Ap = 1.f;
        int bseq = 0, chunk = 0;
        if (!sample) {
            bseq = m0 / SEQ; chunk = (m0 % SEQ) / 64;
            if (chunk > 0) {
                x1 = bf2f(P[(size_t)(m0 - 1) * NP + CRNN + c]); x2 = bf2f(P[(size_t)(m0 - 2) * NP + CRNN + c]); x3 = bf2f(P[(size_t)(m0 - 3) * NP + CRNN + c]);
                if (PASS2) { for (int cc = 0; cc < chunk; ++cc) { const float2 ab = *(const float2*)(RS + (((size_t)bseq * 128 + cc) * D + c) * 2); h = ab.x * h + ab.y; } }
            }
        }
        for (int t = 0; t < 64; ++t) {
            const size_t m = (size_t)m0 + t;
            if (sample && (t & 7) == 0) {
                if (!PASS2) break;
                const int b = (int)(m - MP) >> 3;
                x3 = conv0[((size_t)b * 3 + 0) * D + c]; x2 = conv0[((size_t)b * 3 + 1) * D + c]; x1 = conv0[((size_t)b * 3 + 2) * D + c]; h = h0[(size_t)b * D + c];
            }
            const float x = bf2f(P[m * NP + CRNN + c]);
            const float xc = cbc + c0 * x3 + c1 * x2 + c2 * x1 + c3 * x;
            LDSW(); s_xc[lane] = xc; LDSW();
            float r = bac, ig = bxc;
#pragma unroll
            for (int i4 = 0; i4 < 16; ++i4) { const f32x4 xv = *(const LAS f32x4*)(s_xc + 4 * i4);
#pragma unroll
                for (int e = 0; e < 4; ++e) { r += xv[e] * war[4 * i4 + e]; ig += xv[e] * wxr[4 * i4 + e]; } }
            r = sigmoidf_(r); ig = sigmoidf_(ig);
            const float log_a = -8.f * r * spl;
            const float av = __expf(log_a);
            const float u = sqrtf(-expm1f(2.f * log_a)) * (ig * xc);
            h = av * h + u; Ap *= av;
            if (PASS2) OB[m * D + c] = f2bf(h);
            x3 = x2; x2 = x1; x1 = x;
            if (PASS2 && sample && (t & 7) == 7) {
                const int b = (int)(m - MP) >> 3;
                float* oc = a.out + O_SCONV + ((size_t)L * DBATCH + b) * 3 * D; float* oh = a.out + O_SH + ((size_t)L * DBATCH + b) * D;
                oh[c] = h; oc[0 * D + c] = x3; oc[1 * D + c] = x2; oc[2 * D + c] = x1;
            }
        }
        if (!sample) {
            if (!PASS2) { *(float2*)(RS + (((size_t)bseq * 128 + chunk) * D + c) * 2) = make_float2(Ap, h); }
            else if (chunk == 127) {
                float* oc = a.out + O_PCONV + ((size_t)L * NBATCH + bseq) * 3 * D; float* oh = a.out + O_PH + ((size_t)L * NBATCH + bseq) * D;
                oh[c] = h; oc[0 * D + c] = x3; oc[1 * D + c] = x2; oc[2 * D + c] = x1;
            }
        }
    }
}

__device__ __forceinline__ void phase_elem_mixa(const Args& a, int L) {
    const bf16_t* P = (const bf16_t*)(a.ws + WS_P); bf16_t* AC = (bf16_t*)(a.ws + WS_ACAT);
    const float* mu = a.in[17] + (size_t)L * SHIFT_W; const float* shift0 = a.in[6] + (size_t)L * DBATCH * SHIFT_W;
    const size_t gt = (size_t)blockIdx.x * NTHREADS + threadIdx.x, gs = (size_t)gridDim.x * NTHREADS;
    for (size_t i = gt; i < (size_t)M * ACAT_K; i += gs) {
        const size_t m = i / ACAT_K; const int j = (int)(i % ACAT_K);
        float o = 0.f;
        if (j < 288) {
            const int ch = 3072 + j;
            const float pc = bf2f(P[m * NP + CRW + ch]);
            float pv;
            if (m < MP) pv = (m % SEQ) == 0 ? 0.f : bf2f(P[(m - 1) * NP + CRW + ch]);
            else pv = ((m - MP) % DSEQ) == 0 ? shift0[((m - MP) / DSEQ) * SHIFT_W + ch] : bf2f(P[(m - 1) * NP + CRW + ch]);
            const float ps = pc + mu[ch] * (pv - pc);
            o = j < 64 ? 1.f - 2.f / (__expf(2.f * ps) + 1.f) : (j < 128 ? ps : sigmoidf_(ps));
        }
        AC[i] = f2bf(o);
    }
    const float* ck = a.in[2] + (size_t)L * DBATCH * 128 * 256; const float* cv = a.in[3] + (size_t)L * DBATCH * 128 * 256;
    float* pk = a.out + O_PK + (size_t)L * NBATCH * 128 * 256; float* pv_ = a.out + O_PV + (size_t)L * NBATCH * 128 * 256;
    float* pshift = a.out + O_PSHIFT + (size_t)L * NBATCH * SHIFT_W; float* sk = a.out + O_SK + (size_t)L * DBATCH * 128 * 256; float* sv = a.out + O_SV + (size_t)L * DBATCH * 128 * 256;
    float* sshift = a.out + O_SSHIFT + (size_t)L * DBATCH * SHIFT_W;
    const size_t n_pk = (size_t)NBATCH * 128 * 256, n_sk = (size_t)DBATCH * 128 * 256, n_ps = (size_t)NBATCH * SHIFT_W, n_ss = (size_t)DBATCH * SHIFT_W;
    for (size_t i = gt; i < n_pk + n_sk + n_ps + n_ss; i += gs) {
        if (i < n_pk) {
            const int b = (int)(i / (128 * 256)), s = (int)((i / 256) % 128), e = (int)(i % 256);
            const size_t row = (size_t)b * SEQ + (SEQ - 128) + s;
            pk[i] = bf2f(P[row * NP + CK + e]); pv_[i] = bf2f(P[row * NP + CV + e]);
            continue;
        }
        size_t k = i - n_pk;
        if (k < n_sk) {
            const int b = (int)(k / (128 * 256)), s = (int)((k / 256) % 128), e = (int)(k % 256);
            if (s < 120) { sk[k] = ck[((size_t)b * 128 + s + 8) * 256 + e]; sv[k] = cv[((size_t)b * 128 + s + 8) * 256 + e]; }
            else { const size_t row = (size_t)MP + b * DSEQ + (s - 120); sk[k] = bf2f(P[row * NP + CK + e]); sv[k] = bf2f(P[row * NP + CV + e]); }
            continue;
        }
        k -= n_sk;
        if (k < n_ps) { const int b = (int)(k / SHIFT_W), ch = (int)(k % SHIFT_W); pshift[k] = bf2f(P[((size_t)b * SEQ + SEQ - 1) * NP + CRW + ch]); continue; }
        k -= n_ps;
        { const int b = (int)(k / SHIFT_W), ch = (int)(k % SHIFT_W); sshift[k] = bf2f(P[((size_t)MP + b * DSEQ + DSEQ - 1) * NP + CRW + ch]); }
    }
}

#ifndef PROBE_MIXA
#define PROBE_MIXA 0
#endif
__device__ __forceinline__ void phase_mixa(const Args& a, int L, LAS unsigned char* lds) {
    const bf16_t* P = (const bf16_t*)(a.ws + WS_P); bf16_t* OA = (bf16_t*)(a.ws + WS_OA);
    const float* sinks = a.in[9] + L * 16; const float* ck = a.in[2] + (size_t)L * DBATCH * 128 * 256; const float* cv = a.in[3] + (size_t)L * DBATCH * 128 * 256;
    constexpr int N_RG1 = MP / 64, N_AP = NBATCH * 64 * 4, N_AS = DBATCH * 4;
    phase_elem_mixa(a, L);
    if (PROBE_MIXA & 1) phase_elem_mixa(a, L);
    for (int it = blockIdx.x; it < N_RG1; it += gridDim.x) { rglru_unit2<false>(a, L, it, lds); __syncthreads(); }
    if (PROBE_MIXA & 2) for (int it = blockIdx.x; it < N_RG1; it += gridDim.x) { rglru_unit2<false>(a, L, it, lds); __syncthreads(); }
    for (int r = blockIdx.x; r < N_AP; r += gridDim.x) { const int c = r & 3, qb = (r >> 2) & 63, b = r >> 8; attn_unit<false>(P, OA, sinks, ck, cv, b, qb, c, lds); }
    if (PROBE_MIXA & 4) for (int r = blockIdx.x; r < N_AP; r += gridDim.x) { const int c = r & 3, qb = (r >> 2) & 63, b = r >> 8; attn_unit<false>(P, OA, sinks, ck, cv, b, qb, c, lds); }
    for (int r = blockIdx.x; r < N_AS; r += gridDim.x) { const int c = r & 3, b = r >> 2; attn_unit<true>(P, OA, sinks, ck, cv, b, 0, c, lds); }
    if (PROBE_MIXA & 8) for (int r = blockIdx.x; r < N_AS; r += gridDim.x) { const int c = r & 3, b = r >> 2; attn_unit<true>(P, OA, sinks, ck, cv, b, 0, c, lds); }
}

struct EpiLora {
    static constexpr bool PERM = true, AFTER_DRAIN = false;
    bf16_t* WAW; bf16_t* WAA; bf16_t* WAG; const float* w0; const float* a0;
    __device__ __forceinline__ void operator()(const f32x4 (&acc)[2][2][4][2], const pg8::Unit& u, int wr, int wc, int fr, int fq) const {
        const int row0 = u.pm * 256 + wr * 64 + fr, kind = u.pn >> 2, colb = (u.pn & 3) * 256 + wc * 32 + 8 * fq;
        const float* bsrc = kind == 0 ? w0 : a0;
        f32x4 bias[2][2];
#pragma unroll
        for (int bj = 0; bj < 2; ++bj)
#pragma unroll
            for (int n = 0; n < 2; ++n) bias[bj][n] = kind == 2 ? (f32x4){0.f, 0.f, 0.f, 0.f} : *(const f32x4*)(bsrc + colb + bj * 128 + 4 * n);
#pragma unroll
        for (int ai = 0; ai < 2; ++ai)
#pragma unroll
            for (int m = 0; m < 4; ++m) {
                const size_t off = (size_t)(row0 + ai * 128 + m * 16) * D + colb;
#pragma unroll
                for (int bj = 0; bj < 2; ++bj) {
                    f32x4 v0 = acc[ai][bj][m][0] + bias[bj][0], v1 = acc[ai][bj][m][1] + bias[bj][1];
                    if (kind == 0) {
#pragma unroll
                        for (int i = 0; i < 4; ++i) {
                            v0[i] = -__expf(-(fmaxf(-v0[i], 0.f) + __logf(1.f + __expf(-fabsf(v0[i])))) - 0.5f);
                            v1[i] = -__expf(-(fmaxf(-v1[i], 0.f) + __logf(1.f + __expf(-fabsf(v1[i])))) - 0.5f);
                        }
                    } else if (kind == 1) {
#pragma unroll
                        for (int i = 0; i < 4; ++i) { v0[i] = sigmoidf_(v0[i]); v1[i] = sigmoidf_(v1[i]); }
                    }
                    u32x4 w; w.x = pk2bf(v0[0], v0[1]); w.y = pk2bf(v0[2], v0[3]); w.z = pk2bf(v1[0], v1[1]); w.w = pk2bf(v1[2], v1[3]);
                    *(u32x4*)(WAW + (size_t)kind * ((size_t)M * D) + off + bj * 128) = w;
                }
                asm volatile("" ::: "memory");
            }
    }
};

__device__ __forceinline__ void phase_mixc(const Args& a, int L) {
    const int lane = threadIdx.x & 63, wv = threadIdx.x >> 6;
    const bf16_t* P = (const bf16_t*)(a.ws + WS_P); const bf16_t* WAG = (const bf16_t*)(a.ws + WS_WAG); const bf16_t* Y = (const bf16_t*)(a.ws + WS_Y); const float* BD = (const float*)(a.ws + WS_BD);
    bf16_t* OA = (bf16_t*)(a.ws + WS_OA); const bf16_t* OB = (const bf16_t*)(a.ws + WS_OB);
    const float* mu = a.in[17] + (size_t)L * SHIFT_W + 2048; const float* shift0 = a.in[6] + (size_t)L * DBATCH * SHIFT_W + 2048;
    const int c0 = 16 * lane, h = lane >> 2;
    float lw[16], lb[16], muv[16];
#pragma unroll
    for (int i = 0; i < 16; ++i) { lw[i] = a.in[26][L * D + c0 + i]; lb[i] = a.in[27][L * D + c0 + i]; muv[i] = mu[c0 + i]; }
    for (int m = blockIdx.x * NWAVES + wv; m < M; m += gridDim.x * NWAVES) {
        float y[16];
        { u32x4 yv[2]; yv[0] = *(const u32x4*)(Y + (size_t)m * D + c0); yv[1] = *(const u32x4*)(Y + (size_t)m * D + c0 + 8);
#pragma unroll
          for (int i = 0; i < 16; ++i) y[i] = __uint_as_float((i & 1) ? (yv[i >> 3][(i >> 1) & 3] & 0xffff0000u) : (yv[i >> 3][(i >> 1) & 3] << 16)); }
        float s = 0.f;
#pragma unroll
        for (int i = 0; i < 16; ++i) s += y[i];
        s += __shfl_xor(s, 1); s += __shfl_xor(s, 2);
        const float mean = s * (1.f / 64.f);
        float q = 0.f;
#pragma unroll
        for (int i = 0; i < 16; ++i) { y[i] -= mean; q += y[i] * y[i]; }
        q += __shfl_xor(q, 1); q += __shfl_xor(q, 2);
        const float rstd = rsqrtf(q * (1.f / 64.f) + GN_EPS);
        const float bd = BD[(size_t)m * 16 + h];
        const bool first = m < MP ? (m % SEQ) == 0 : ((m - MP) % DSEQ) == 0;
        const bf16_t* pr = P + (size_t)m * NP + CRW + 2048 + c0;
#define BFX(v, i) __uint_as_float((((i) & 1) ? ((v)[(i) >> 3][((i) >> 1) & 3] & 0xffff0000u) : ((v)[(i) >> 3][((i) >> 1) & 3] << 16)))
        u32x4 pcv[2], ppv[2], gv[2], gav[2], gbv[2], gcv[2], oav[2], obv[2];
        pcv[0] = *(const u32x4*)pr; pcv[1] = *(const u32x4*)(pr + 8);
        ppv[0] = pcv[0]; ppv[1] = pcv[1];
        if (!first) { ppv[0] = *(const u32x4*)(pr - NP); ppv[1] = *(const u32x4*)(pr - NP + 8); }
        gv[0] = *(const u32x4*)(WAG + (size_t)m * D + c0); gv[1] = *(const u32x4*)(WAG + (size_t)m * D + c0 + 8);
        const bf16_t* pg = P + (size_t)m * NP + CG + c0;
        gav[0] = *(const u32x4*)pg; gav[1] = *(const u32x4*)(pg + 8);
        gbv[0] = *(const u32x4*)(pg + 1024); gbv[1] = *(const u32x4*)(pg + 1024 + 8);
        gcv[0] = *(const u32x4*)(pg + 2048); gcv[1] = *(const u32x4*)(pg + 2048 + 8);
        oav[0] = *(const u32x4*)(OA + (size_t)m * D + c0); oav[1] = *(const u32x4*)(OA + (size_t)m * D + c0 + 8);
        obv[0] = *(const u32x4*)(OB + (size_t)m * D + c0); obv[1] = *(const u32x4*)(OB + (size_t)m * D + c0 + 8);
        float o[16];
#pragma unroll
        for (int i = 0; i < 16; ++i) {
            const float pc = BFX(pcv, i);
            float pv;
            if (first) pv = m < MP ? 0.f : shift0[(size_t)((m - MP) / DSEQ) * SHIFT_W + c0 + i];
            else pv = BFX(ppv, i);
            const float vv = pc + muv[i] * (pv - pc);
            const float yn = y[i] * rstd * lw[i] + lb[i];
            const float oc = (yn + bd * vv) * BFX(gv, i);
            o[i] = BFX(gav, i) * BFX(oav, i) + BFX(gbv, i) * BFX(obv, i) + BFX(gcv, i) * oc;
        }
        u32x4 w0, w1;
        w0.x = pk2bf(o[0], o[1]); w0.y = pk2bf(o[2], o[3]); w0.z = pk2bf(o[4], o[5]); w0.w = pk2bf(o[6], o[7]);
        w1.x = pk2bf(o[8], o[9]); w1.y = pk2bf(o[10], o[11]); w1.z = pk2bf(o[12], o[13]); w1.w = pk2bf(o[14], o[15]);
        *(u32x4*)(OA + (size_t)m * D + c0) = w0; *(u32x4*)(OA + (size_t)m * D + c0 + 8) = w1;
    }
}

constexpr int CH_OFF_AA = 0, CH_OFF_RA = 2048, CH_OFF_MC = 4096, CH_OFF_TL = 5120, CH_OFF_BT = 6144, CH_OFF_KT = 8320, CH_OFF_VT = 10496, CH_OFF_GM = 12672, CH_SLOT = 13056;
constexpr int CH_TP = 136;
__device__ __forceinline__ float row_prefix16(float x) {
    x += __builtin_bit_cast(float, __builtin_amdgcn_update_dpp(0, __builtin_bit_cast(int, x), 0x111, 0xF, 0xF, true));
    x += __builtin_bit_cast(float, __builtin_amdgcn_update_dpp(0, __builtin_bit_cast(int, x), 0x112, 0xF, 0xF, true));
    x += __builtin_bit_cast(float, __builtin_amdgcn_update_dpp(0, __builtin_bit_cast(int, x), 0x114, 0xF, 0xF, true));
    x += __builtin_bit_cast(float, __builtin_amdgcn_update_dpp(0, __builtin_bit_cast(int, x), 0x118, 0xF, 0xF, true));
    return x;
}
__device__ __forceinline__ f32x4 prod16(const f32x4 xt, const f32x4 y) {
    f32x4 z = (f32x4){0.f, 0.f, 0.f, 0.f};
#pragma unroll
    for (int r = 0; r < 4; ++r) z = __builtin_amdgcn_mfma_f32_16x16x4f32(xt[r], y[r], z, 0, 0, 0);
    return z;
}
__device__ __forceinline__ f32x4 gram(const bf16x8_t (&x)[2], const bf16x8_t (&y)[2]) {
    f32x4 z = (f32x4){0.f, 0.f, 0.f, 0.f};
    z = __builtin_amdgcn_mfma_f32_16x16x32_bf16(x[0], y[0], z, 0, 0, 0);
    z = __builtin_amdgcn_mfma_f32_16x16x32_bf16(x[1], y[1], z, 0, 0, 0);
    return z;
}

struct ChunkRaw { u32x2 cr[4], ck[4], cv[4], pr[4], pk[4], pv[4], a[4], x[4]; };
constexpr int CH_PAR_OFF = 8 * CH_SLOT;
constexpr int CH_PAR_BYTES = 6 * 64 * 4;
__device__ __forceinline__ void stage_head_params(const Args& a, int L, int h, LAS unsigned char* par, int lane) {
    LAS float* p = (LAS float*)par; const int c = 64 * h + lane;
    p[lane] = a.in[17][(size_t)L * SHIFT_W + c]; p[64 + lane] = a.in[17][(size_t)L * SHIFT_W + 1024 + c]; p[128 + lane] = a.in[17][(size_t)L * SHIFT_W + 2048 + c];
    p[192 + lane] = a.in[23][L * D + c]; p[256 + lane] = a.in[24][L * D + c]; p[320 + lane] = a.in[25][L * D + c];
}
__device__ __forceinline__ void chunk_load(const Args& a, size_t m0, int h, int ntok, bool seq_start, const float* sh0, int lane, ChunkRaw& R) {
    asm volatile("" : "+v"(lane));
    const int i16 = lane & 15, qp = lane >> 4;
    const bf16_t* P = (const bf16_t*)(a.ws + WS_P); const bf16_t* WAW = (const bf16_t*)(a.ws + WS_WAW); const bf16_t* WAA = (const bf16_t*)(a.ws + WS_WAA);
    const size_t m = m0 + (i16 < ntok ? i16 : 0);
    const bool use_sh = seq_start && i16 == 0;
#pragma unroll
    for (int r = 0; r < 4; ++r) {
        const int c = 64 * h + 16 * r + 4 * qp;
        const bf16_t* pr = P + m * NP + CRW + c;
        R.cr[r] = *(const u32x2*)pr; R.ck[r] = *(const u32x2*)(pr + 1024); R.cv[r] = *(const u32x2*)(pr + 2048);
        const bf16_t* pp = use_sh ? pr : pr - NP;
        R.pr[r] = *(const u32x2*)pp; R.pk[r] = *(const u32x2*)(pp + 1024); R.pv[r] = *(const u32x2*)(pp + 2048);
        R.x[r] = *(const u32x2*)(WAW + m * D + c);
        R.a[r] = *(const u32x2*)(WAA + m * D + c);
        if (seq_start) {
            u32x2 sr = (u32x2){0u, 0u}, sk = sr, sv = sr;
            if (sh0) { const f32x4 fr_ = *(const f32x4*)(sh0 + c), fk_ = *(const f32x4*)(sh0 + 1024 + c), fv_ = *(const f32x4*)(sh0 + 2048 + c);
                sr = pk4(fr_[0], fr_[1], fr_[2], fr_[3]); sk = pk4(fk_[0], fk_[1], fk_[2], fk_[3]); sv = pk4(fv_[0], fv_[1], fv_[2], fv_[3]); }
            if (use_sh) { R.pr[r] = sr; R.pk[r] = sk; R.pv[r] = sv; }
        }
    }
}
__device__ __forceinline__ void chunk_compute(const Args& a, const ChunkRaw& R, size_t m0, int h, int ntok, const LAS unsigned char* par_, LAS unsigned char* slot, int lane) {
    asm volatile("" : "+v"(lane));
    const int i16 = lane & 15, qp = lane >> 4;
    float* BD = (float*)(a.ws + WS_BD);
    const LAS float* par = (const LAS float*)par_;
    const bool valid = i16 < ntok;
    const size_t m = m0 + (valid ? i16 : 0);
    float abu[16], bbu[16];
    u32x2 pa[4], pb[4], pkk[4], prr[4];
    float ssq = 0.f, bdp = 0.f;
#pragma unroll
    for (int r = 0; r < 4; ++r) {
        const int cb = 16 * r + 4 * qp, c = 64 * h + cb;
        const u32x2 cr = R.cr[r], ck_ = R.ck[r], cv_ = R.cv[r], pr_ = R.pr[r], pk_ = R.pk[r], pv_ = R.pv[r], a4 = R.a[r];
        const u32x2 x4 = R.x[r];
        const f32x4 mur = *(const LAS f32x4*)(par + cb), muk = *(const LAS f32x4*)(par + 64 + cb), muv = *(const LAS f32x4*)(par + 128 + cb);
        const f32x4 kkc = *(const LAS f32x4*)(par + 192 + cb), kac = *(const LAS f32x4*)(par + 256 + cb), rkc = *(const LAS f32x4*)(par + 320 + cb);
        float vv[4], kb[4], rb[4];
#pragma unroll
        for (int i = 0; i < 4; ++i) {
            const unsigned wr_ = i < 2 ? cr.x : cr.y, wk_ = i < 2 ? ck_.x : ck_.y, wv_ = i < 2 ? cv_.x : cv_.y, wa_ = i < 2 ? a4.x : a4.y, wx_ = i < 2 ? x4.x : x4.y;
            const unsigned qr_ = i < 2 ? pr_.x : pr_.y, qk_ = i < 2 ? pk_.x : pk_.y, qv_ = i < 2 ? pv_.x : pv_.y;
            const float c_r = __uint_as_float((i & 1) ? (wr_ & 0xffff0000u) : (wr_ << 16)), c_k = __uint_as_float((i & 1) ? (wk_ & 0xffff0000u) : (wk_ << 16)),
                        c_v = __uint_as_float((i & 1) ? (wv_ & 0xffff0000u) : (wv_ << 16)), a_ = __uint_as_float((i & 1) ? (wa_ & 0xffff0000u) : (wa_ << 16));
            const float p_r = __uint_as_float((i & 1) ? (qr_ & 0xffff0000u) : (qr_ << 16)), p_k = __uint_as_float((i & 1) ? (qk_ & 0xffff0000u) : (qk_ << 16)),
                  p_v = __uint_as_float((i & 1) ? (qv_ & 0xffff0000u) : (qv_ << 16));
            float r_ = c_r + mur[i] * (p_r - c_r), kx = c_k + muk[i] * (p_k - c_k), v_ = c_v + muv[i] * (p_v - c_v);
            float lw_ = __uint_as_float((i & 1) ? (wx_ & 0xffff0000u) : (wx_ << 16));
            if (!valid) { r_ = 0.f; kx = 0.f; v_ = 0.f; lw_ = 0.f; }
            const float kkr = kx * kkc[i];
            const float k2_ = kx * (1.f + (a_ - 1.f) * kac[i]);
            ssq += kkr * kkr; bdp += r_ * k2_ * rkc[i];
            const float g = row_prefix16(lw_);
            const float eg = __expf(g), egx = __expf(g - lw_), eng = __expf(-g);
            const int e = 4 * r + i;
            abu[e] = -kkr * egx; bbu[e] = kkr * a_ * eng; kb[i] = k2_ * eng; rb[i] = r_ * eg; vv[i] = v_;
            if (i16 == 15) *(LAS float*)(slot + CH_OFF_GM + 4 * (cb + i)) = eg;
        }
        const int off = i16 * CH_TP + cb * 2;
        pkk[r] = pk4(kb[0], kb[1], kb[2], kb[3]); prr[r] = pk4(rb[0], rb[1], rb[2], rb[3]);
        *(LAS u32x2*)(slot + CH_OFF_VT + off) = pk4(vv[0], vv[1], vv[2], vv[3]);
        *(LAS u32x2*)(slot + CH_OFF_KT + off) = pkk[r];
        asm volatile("" : "+v"(ssq), "+v"(bdp));
        __builtin_amdgcn_sched_barrier(0);
    }
    ssq += __shfl_xor(ssq, 16); ssq += __shfl_xor(ssq, 32);
    bdp += __shfl_xor(bdp, 16); bdp += __shfl_xor(bdp, 32);
    if (valid && qp == 0) BD[m * 16 + h] = bdp;
    const float inrm = 1.f / fmaxf(sqrtf(ssq), 1e-12f);
#pragma unroll
    for (int r = 0; r < 4; ++r) {
        pa[r] = pk4(abu[4 * r] * inrm, abu[4 * r + 1] * inrm, abu[4 * r + 2] * inrm, abu[4 * r + 3] * inrm);
        pb[r] = pk4(bbu[4 * r] * inrm, bbu[4 * r + 1] * inrm, bbu[4 * r + 2] * inrm, bbu[4 * r + 3] * inrm);
        const int off = i16 * CH_TP + (16 * r + 4 * qp) * 2;
        *(LAS u32x2*)(slot + CH_OFF_AA + off) = pa[r];
        *(LAS u32x2*)(slot + CH_OFF_BT + off) = pb[r];
    }
    __builtin_amdgcn_sched_barrier(0);
    bf16x8_t fa[2], fb[2], fk[2], fr[2];
#pragma unroll
    for (int ks = 0; ks < 2; ++ks) { fa[ks] = mk_frag(pa[2 * ks], pa[2 * ks + 1]); fb[ks] = mk_frag(pb[2 * ks], pb[2 * ks + 1]); fk[ks] = mk_frag(pkk[2 * ks], pkk[2 * ks + 1]); fr[ks] = mk_frag(prr[2 * ks], prr[2 * ks + 1]); }
    f32x4 Lc = gram(fa, fb), Nc = gram(fb, fa), Lak = gram(fa, fk), MrbT = gram(fb, fr), MrkT = gram(fk, fr);
#pragma unroll
    for (int r = 0; r < 4; ++r) {
        const int row = 4 * qp + r;
        Lc[r] = row > i16 ? Lc[r] : 0.f;
        Lak[r] = row > i16 ? Lak[r] : 0.f;
        Nc[r] = row < i16 ? Nc[r] : 0.f;
        MrbT[r] = row <= i16 ? MrbT[r] : 0.f;
        MrkT[r] = row <= i16 ? MrkT[r] : 0.f;
    }
    __builtin_amdgcn_sched_barrier(0);
    f32x4 eye;
#pragma unroll
    for (int r = 0; r < 4; ++r) eye[r] = (4 * qp + r == i16) ? 1.f : 0.f;
    const f32x4 L2 = prod16(Nc, Lc), N2 = prod16(Lc, Nc);
    const f32x4 L4 = prod16(N2, L2), N4 = prod16(L2, N2);
    const f32x4 N8 = prod16(L4, N4);
    const f32x4 Q1 = prod16(Lc + eye, N2 + eye), Q1T = prod16(N2 + eye, Lc + eye), Q2 = prod16(L4 + eye, N8 + eye);
    const f32x4 TT = prod16(Q1T, Q2);
    const f32x4 TLk = prod16(Lak, TT);
    __builtin_amdgcn_sched_barrier(0);
    LDSW();
    const bf16x8_t ttf = mk_frag(pk4(TT[0], TT[1], TT[2], TT[3]), (u32x2){0u, 0u});
    f32x4 at[4];
#pragma unroll
    for (int kt = 0; kt < 4; ++kt) {
        const u32x2 ac = tr_read4(slot + CH_OFF_AA + (4 * qp + (i16 >> 2)) * CH_TP + (16 * kt + 4 * (i16 & 3)) * 2);
        at[kt] = __builtin_amdgcn_mfma_f32_16x16x32_bf16(mk_frag(ac, (u32x2){0u, 0u}), ttf, (f32x4){0.f, 0.f, 0.f, 0.f}, 0, 0, 0);
    }
    LDSW();
#pragma unroll
    for (int ks = 0; ks < 2; ++ks) {
        const u32x2 lo = pk4(at[2 * ks][0], at[2 * ks][1], at[2 * ks][2], at[2 * ks][3]), hi = pk4(at[2 * ks + 1][0], at[2 * ks + 1][1], at[2 * ks + 1][2], at[2 * ks + 1][3]);
        *(LAS u32x4*)(slot + CH_OFF_AA + ks * 1024 + lane * 16) = (u32x4){lo.x, lo.y, hi.x, hi.y};
        *(LAS u32x4*)(slot + CH_OFF_RA + ks * 1024 + lane * 16) = __builtin_bit_cast(u32x4, fr[ks]);
    }
    {
        const u32x2 mb = pk4(MrbT[0], MrbT[1], MrbT[2], MrbT[3]), mk = pk4(MrkT[0], MrkT[1], MrkT[2], MrkT[3]), tl = pk4(TLk[0], TLk[1], TLk[2], TLk[3]);
        *(LAS u32x4*)(slot + CH_OFF_MC + lane * 16) = (u32x4){mb.x, mb.y, mk.x, mk.y};
        *(LAS u32x4*)(slot + CH_OFF_TL + lane * 16) = (u32x4){tl.x, tl.y, 0u, 0u};
    }
}

struct ChainFrag { u32x4 aa0, aa1, ra0, ra1, mc, tl; u32x2 vq4, b4[4], k4[4]; f32x4 gm[4]; };
__device__ __forceinline__ void chain_fetch(LAS unsigned char* slot, int vq, int lane, ChainFrag& F) {
    const int i16 = lane & 15, qp = lane >> 4;
    const int troff = (4 * qp + (i16 >> 2)) * CH_TP + 8 * (i16 & 3);
    F.tl = *(const LAS u32x4*)(slot + CH_OFF_TL + lane * 16);
    F.vq4 = tr_read4(slot + CH_OFF_VT + troff + 32 * vq);
    F.aa0 = *(const LAS u32x4*)(slot + CH_OFF_AA + lane * 16); F.aa1 = *(const LAS u32x4*)(slot + CH_OFF_AA + 1024 + lane * 16);
    F.ra0 = *(const LAS u32x4*)(slot + CH_OFF_RA + lane * 16); F.ra1 = *(const LAS u32x4*)(slot + CH_OFF_RA + 1024 + lane * 16);
    F.mc = *(const LAS u32x4*)(slot + CH_OFF_MC + lane * 16);
#pragma unroll
    for (int kt = 0; kt < 4; ++kt) {
        F.b4[kt] = tr_read4(slot + CH_OFF_BT + troff + 32 * kt); F.k4[kt] = tr_read4(slot + CH_OFF_KT + troff + 32 * kt);
        F.gm[kt] = *(const LAS f32x4*)(slot + CH_OFF_GM + 4 * (16 * kt + 4 * qp));
    }
}
__device__ __forceinline__ f32x4 chain_math(const ChainFrag& F, f32x4 (&ST)[4]) {
    const f32x4 z4 = (f32x4){0.f, 0.f, 0.f, 0.f};
    const f32x4 tlv = __builtin_amdgcn_mfma_f32_16x16x32_bf16(__builtin_bit_cast(bf16x8_t, F.tl), mk_frag(F.vq4, F.vq4), z4, 0, 0, 0);
    bf16x8_t sb[2];
#pragma unroll
    for (int ks = 0; ks < 2; ++ks) sb[ks] = mk_frag(pk4(ST[2 * ks][0], ST[2 * ks][1], ST[2 * ks][2], ST[2 * ks][3]), pk4(ST[2 * ks + 1][0], ST[2 * ks + 1][1], ST[2 * ks + 1][2], ST[2 * ks + 1][3]));
    const f32x4 u1 = __builtin_amdgcn_mfma_f32_16x16x32_bf16(__builtin_bit_cast(bf16x8_t, F.aa0), sb[0], z4, 0, 0, 0);
    const f32x4 u2 = __builtin_amdgcn_mfma_f32_16x16x32_bf16(__builtin_bit_cast(bf16x8_t, F.aa1), sb[1], tlv, 0, 0, 0);
    f32x4 Y = __builtin_amdgcn_mfma_f32_16x16x32_bf16(__builtin_bit_cast(bf16x8_t, F.ra0), sb[0], z4, 0, 0, 0);
    const f32x4 y2 = __builtin_amdgcn_mfma_f32_16x16x32_bf16(__builtin_bit_cast(bf16x8_t, F.ra1), sb[1], z4, 0, 0, 0);
    const f32x4 U = u1 + u2;
    const bf16x8_t uv = mk_frag(pk4(U[0], U[1], U[2], U[3]), F.vq4);
#pragma unroll
    for (int kt = 0; kt < 4; ++kt) {
        ST[kt] = __builtin_amdgcn_mfma_f32_16x16x32_bf16(mk_frag(F.b4[kt], F.k4[kt]), uv, ST[kt], 0, 0, 0);
        ST[kt] = ST[kt] * F.gm[kt];
    }
    Y = __builtin_amdgcn_mfma_f32_16x16x32_bf16(__builtin_bit_cast(bf16x8_t, F.mc), uv, Y, 0, 0, 0);
    return Y + y2;
}
struct ChainFrag2 { u32x4 aa0, aa1, ra0, ra1, mc, tl; u32x2 va, vb, b4[4], k4[4]; f32x4 gm[4]; };
__device__ __forceinline__ void chain_fetch2(LAS unsigned char* slot, int vq0, int lane, ChainFrag2& F) {
    const int i16 = lane & 15, qp = lane >> 4;
    const int troff = (4 * qp + (i16 >> 2)) * CH_TP + 8 * (i16 & 3);
    F.tl = *(const LAS u32x4*)(slot + CH_OFF_TL + lane * 16);
    F.va = tr_read4(slot + CH_OFF_VT + troff + 32 * vq0); F.vb = tr_read4(slot + CH_OFF_VT + troff + 32 * (vq0 + 1));
    F.aa0 = *(const LAS u32x4*)(slot + CH_OFF_AA + lane * 16); F.aa1 = *(const LAS u32x4*)(slot + CH_OFF_AA + 1024 + lane * 16);
    F.ra0 = *(const LAS u32x4*)(slot + CH_OFF_RA + lane * 16); F.ra1 = *(const LAS u32x4*)(slot + CH_OFF_RA + 1024 + lane * 16);
    F.mc = *(const LAS u32x4*)(slot + CH_OFF_MC + lane * 16);
#pragma unroll
    for (int kt = 0; kt < 4; ++kt) {
        F.b4[kt] = tr_read4(slot + CH_OFF_BT + troff + 32 * kt); F.k4[kt] = tr_read4(slot + CH_OFF_KT + troff + 32 * kt);
        F.gm[kt] = *(const LAS f32x4*)(slot + CH_OFF_GM + 4 * (16 * kt + 4 * qp));
    }
}
__device__ __forceinline__ void chain_math2(const ChainFrag2& F, f32x4 (&SA)[4], f32x4 (&SB)[4], f32x4& YA, f32x4& YB) {
    const f32x4 z4 = (f32x4){0.f, 0.f, 0.f, 0.f};
    const bf16x8_t tl = __builtin_bit_cast(bf16x8_t, F.tl), aa0 = __builtin_bit_cast(bf16x8_t, F.aa0), aa1 = __builtin_bit_cast(bf16x8_t, F.aa1),
                   ra0 = __builtin_bit_cast(bf16x8_t, F.ra0), ra1 = __builtin_bit_cast(bf16x8_t, F.ra1), mc = __builtin_bit_cast(bf16x8_t, F.mc);
    const f32x4 tlva = __builtin_amdgcn_mfma_f32_16x16x32_bf16(tl, mk_frag(F.va, F.va), z4, 0, 0, 0);
    const f32x4 tlvb = __builtin_amdgcn_mfma_f32_16x16x32_bf16(tl, mk_frag(F.vb, F.vb), z4, 0, 0, 0);
    bf16x8_t sa[2], sb[2];
#pragma unroll
    for (int ks = 0; ks < 2; ++ks) {
        sa[ks] = mk_frag(pk4(SA[2 * ks][0], SA[2 * ks][1], SA[2 * ks][2], SA[2 * ks][3]), pk4(SA[2 * ks + 1][0], SA[2 * ks + 1][1], SA[2 * ks + 1][2], SA[2 * ks + 1][3]));
        sb[ks] = mk_frag(pk4(SB[2 * ks][0], SB[2 * ks][1], SB[2 * ks][2], SB[2 * ks][3]), pk4(SB[2 * ks + 1][0], SB[2 * ks + 1][1], SB[2 * ks + 1][2], SB[2 * ks + 1][3]));
    }
    const f32x4 ua1 = __builtin_amdgcn_mfma_f32_16x16x32_bf16(aa0, sa[0], z4, 0, 0, 0);
    const f32x4 ub1 = __builtin_amdgcn_mfma_f32_16x16x32_bf16(aa0, sb[0], z4, 0, 0, 0);
    const f32x4 ua2 = __builtin_amdgcn_mfma_f32_16x16x32_bf16(aa1, sa[1], tlva, 0, 0, 0);
    const f32x4 ub2 = __builtin_amdgcn_mfma_f32_16x16x32_bf16(aa1, sb[1], tlvb, 0, 0, 0);
    f32x4 ya = __builtin_amdgcn_mfma_f32_16x16x32_bf16(ra0, sa[0], z4, 0, 0, 0);
    f32x4 yb = __builtin_amdgcn_mfma_f32_16x16x32_bf16(ra0, sb[0], z4, 0, 0, 0);
    const f32x4 ya2 = __builtin_amdgcn_mfma_f32_16x16x32_bf16(ra1, sa[1], z4, 0, 0, 0);
    const f32x4 yb2 = __builtin_amdgcn_mfma_f32_16x16x32_bf16(ra1, sb[1], z4, 0, 0, 0);
    const f32x4 UA = ua1 + ua2, UB = ub1 + ub2;
    const bf16x8_t uva = mk_frag(pk4(UA[0], UA[1], UA[2], UA[3]), F.va), uvb = mk_frag(pk4(UB[0], UB[1], UB[2], UB[3]), F.vb);
#pragma unroll
    for (int kt = 0; kt < 4; ++kt) {
        const bf16x8_t bk = mk_frag(F.b4[kt], F.k4[kt]);
        SA[kt] = __builtin_amdgcn_mfma_f32_16x16x32_bf16(bk, uva, SA[kt], 0, 0, 0);
        SB[kt] = __builtin_amdgcn_mfma_f32_16x16x32_bf16(bk, uvb, SB[kt], 0, 0, 0);
    }
#pragma unroll
    for (int kt = 0; kt < 4; ++kt) { SA[kt] = SA[kt] * F.gm[kt]; SB[kt] = SB[kt] * F.gm[kt]; }
    ya = __builtin_amdgcn_mfma_f32_16x16x32_bf16(mc, uva, ya, 0, 0, 0);
    yb = __builtin_amdgcn_mfma_f32_16x16x32_bf16(mc, uvb, yb, 0, 0, 0);
    YA = ya + ya2; YB = yb + yb2;
}
__device__ __forceinline__ f32x4 chain_step(LAS unsigned char* slot, f32x4 (&ST)[4], int vq, int lane) { ChainFrag F; chain_fetch(slot, vq, lane, F); return chain_math(F, ST); }

constexpr int N_CH_P = MP / 16 * 16, N_CH_S = DBATCH * 16, N_CH = N_CH_P + N_CH_S;
static_assert(WS_CB + (size_t)N_CH * CH_SLOT <= (size_t)861000000, "chunk buffer fits the workspace");
constexpr int CH_VEC = CH_SLOT / 16;
__device__ __forceinline__ void slot_to_global(const LAS unsigned char* slot, unsigned char* g, int lane) {
#pragma unroll
    for (int i = 0; i < 13; ++i) { const int v = i * 64 + lane; if (v < CH_VEC) *(u32x4*)(g + (size_t)v * 16) = *(const LAS u32x4*)(slot + v * 16); }
}
struct SlotRegs { u32x4 v[13]; };
__device__ __forceinline__ void slot_load(const unsigned char* g, int lane, SlotRegs& S) {
    asm volatile("" : "+v"(lane));
#pragma unroll
    for (int i = 0; i < 13; ++i) { const int v = i * 64 + lane; S.v[i] = *(const u32x4*)(g + (size_t)(v < CH_VEC ? v : 0) * 16); }
}
__device__ __forceinline__ void slot_store(LAS unsigned char* slot, int lane, const SlotRegs& S) {
    asm volatile("" : "+v"(lane));
#pragma unroll
    for (int i = 0; i < 13; ++i) { const int v = i * 64 + lane; if (v < CH_VEC) *(LAS u32x4*)(slot + v * 16) = S.v[i]; }
}
__device__ __forceinline__ void phase_c1(const Args& a, int L, LAS unsigned char* lds) {
    const int tid = threadIdx.x, lane = tid & 63, wv = __builtin_amdgcn_readfirstlane(tid >> 6);
    LAS unsigned char* slot = lds + wv * CH_SLOT; LAS unsigned char* par = lds + CH_PAR_OFF + wv * CH_PAR_BYTES;
    unsigned char* CB = a.ws + WS_CB;
    rglru_prefix(a);
    for (int ci = blockIdx.x * NWAVES + wv; ci < N_CH; ci += gridDim.x * NWAVES) {
        const int h = ci & 15;
        size_t m0; int ntok; bool ss; const float* sh0 = nullptr;
        if (ci < N_CH_P) { const int chunk = ci >> 4; m0 = (size_t)chunk * 16; ntok = 16; ss = (chunk & (SEQ / 16 - 1)) == 0; }
        else { const int b = (ci - N_CH_P) >> 4; m0 = (size_t)MP + (size_t)b * DSEQ; ntok = DSEQ; ss = true; sh0 = a.in[6] + ((size_t)L * DBATCH + b) * SHIFT_W; }
        stage_head_params(a, L, h, par, lane);
        ChunkRaw R;
        chunk_load(a, m0, h, ntok, ss, sh0, lane, R);
        LDSW();
        chunk_compute(a, R, m0, h, ntok, par, slot, lane);
        LDSW();
        const size_t sid = ci < N_CH_P ? ((size_t)((ci >> 4) >> 9) * 16 + h) * (SEQ / 16) + ((ci >> 4) & (SEQ / 16 - 1)) : (size_t)ci;
        slot_to_global(slot, CB + sid * CH_SLOT, lane);
        LDSW();
    }
}

#define WG_BAR() do { asm volatile("s_waitcnt lgkmcnt(0)" ::: "memory"); __builtin_amdgcn_s_barrier(); asm volatile("" ::: "memory"); } while (0)
template <int DRY> __device__ __forceinline__ void wkv_prompt_chain(const Args& a, int L, int b, int h, LAS unsigned char* lds) {
    const int tid = threadIdx.x, lane = tid & 63, wv = __builtin_amdgcn_readfirstlane(tid >> 6), i16 = lane & 15, qp = lane >> 4;
    bf16_t* Y = (bf16_t*)(a.ws + WS_Y);
    const unsigned char* CB = a.ws + WS_CB;
    constexpr int NR = SEQ / 64;
    const size_t ci0 = ((size_t)b * 16 + h) * (SEQ / 16);
    if (wv >= 4) {
        const int lw = wv - 4;
        SlotRegs S0, S1, S2;
#define CB_GROUP(k) (CB + (ci0 + (size_t)(4 * (k) + lw)) * CH_SLOT)
        slot_load(CB_GROUP(0), lane, S0);
        slot_store(lds + lw * CH_SLOT, lane, S0);
        slot_load(CB_GROUP(1), lane, S1); slot_load(CB_GROUP(2), lane, S2); slot_load(CB_GROUP(3), lane, S0);
        WG_BAR();
        for (int g = 0; g < NR; g += 6) {
#define LROUND(r, SET) do { if ((r) < NR) { if (DRY != 2) if ((r) + 1 < NR) slot_store(lds + ((((r) + 1) & 1) * 4 + lw) * CH_SLOT, lane, SET); if (DRY != 2) if ((r) + 4 < NR) slot_load(CB_GROUP((r) + 4), lane, SET); WG_BAR(); } } while (0)
            LROUND(g, S1); LROUND(g + 1, S2); LROUND(g + 2, S0); LROUND(g + 3, S1); LROUND(g + 4, S2); LROUND(g + 5, S0);
#undef LROUND
        }
#undef CB_GROUP
    } else if (wv < 2) {
        f32x4 SA[4], SB[4];
#pragma unroll
        for (int kt = 0; kt < 4; ++kt) { SA[kt] = (f32x4){0.f, 0.f, 0.f, 0.f}; SB[kt] = SA[kt]; }
        WG_BAR();
        bf16_t* yrow = Y + ((size_t)b * SEQ) * D + 64 * h + 32 * wv;
        for (int g = 0; g < NR; ++g) {
            LAS unsigned char* gs = lds + (g & 1) * 4 * CH_SLOT;
            ChainFrag2 FA, FB;
            f32x4 ya[4], yb[4];
#define SB0() __builtin_amdgcn_sched_barrier(0)
            if (DRY == 3) { WG_BAR(); continue; }
            chain_fetch2(gs, 2 * wv, lane, FA);
            chain_fetch2(gs + CH_SLOT, 2 * wv, lane, FB); SB0();
            chain_math2(FA, SA, SB, ya[0], yb[0]); SB0();
            chain_fetch2(gs + 2 * CH_SLOT, 2 * wv, lane, FA); SB0();
            chain_math2(FB, SA, SB, ya[1], yb[1]); SB0();
            chain_fetch2(gs + 3 * CH_SLOT, 2 * wv, lane, FB); SB0();
            chain_math2(FA, SA, SB, ya[2], yb[2]); SB0();
            chain_math2(FB, SA, SB, ya[3], yb[3]); SB0();
#undef SB0
            {
                LAS unsigned char* yt = lds + CH_PAR_OFF + wv * 4608;
#pragma unroll
                for (int j = 0; j < 4; ++j)
#pragma unroll
                    for (int r = 0; r < 4; ++r) {
                        *(LAS unsigned short*)(yt + (16 * j + 4 * qp + r) * 72 + 2 * i16) = f2bf(ya[j][r]);
                        *(LAS unsigned short*)(yt + (16 * j + 4 * qp + r) * 72 + 2 * (16 + i16)) = f2bf(yb[j][r]);
                    }
                LDSW();
#pragma unroll
                for (int j = 0; j < 4; ++j) {
                    const int row = 16 * j + (lane >> 2), pc = lane & 3;
                    const u32x2 lo = *(const LAS u32x2*)(yt + row * 72 + pc * 16), hi = *(const LAS u32x2*)(yt + row * 72 + pc * 16 + 8);
                    if (DRY == 0) *(u32x4*)(yrow + (size_t)row * D + 8 * pc) = (u32x4){lo.x, lo.y, hi.x, hi.y};
                    else asm volatile("" :: "v"(lo), "v"(hi));
                }
                LDSW();
            }
            yrow += (size_t)64 * D;
            WG_BAR();
        }
        float* o = a.out + O_PWKV + ((((size_t)L * NBATCH + b) * 16 + h) * 64 + 32 * wv + i16) * 64;
#pragma unroll
        for (int kt = 0; kt < 4; ++kt) { if (DRY == 0) { *(f32x4*)(o + 16 * kt + 4 * qp) = SA[kt]; *(f32x4*)(o + 16 * 64 + 16 * kt + 4 * qp) = SB[kt]; } else asm volatile("" :: "v"(SA[kt]), "v"(SB[kt])); }
    } else {
        WG_BAR();
        for (int g = 0; g < NR; ++g) WG_BAR();
    }
    __syncthreads();
}
#undef WG_BAR
__device__ __forceinline__ void wkv_sample_chain(const Args& a, int L, int b, int ho, LAS unsigned char* lds) {
    const int tid = threadIdx.x, lane = tid & 63, wv = __builtin_amdgcn_readfirstlane(tid >> 6), i16 = lane & 15, qp = lane >> 4;
    const int h = 8 * ho + wv;
    bf16_t* Y = (bf16_t*)(a.ws + WS_Y);
    LAS unsigned char* slot = lds + wv * CH_SLOT;
    const size_t m0 = (size_t)MP + (size_t)b * DSEQ;
    { SlotRegs S; slot_load(a.ws + WS_CB + ((size_t)N_CH_P + (size_t)b * 16 + h) * CH_SLOT, lane, S); slot_store(slot, lane, S); }
    LDSW();
    for (int vp = 0; vp < 2; ++vp) {
        const size_t so = ((((size_t)L * DBATCH + b) * 16 + h) * 64 + 32 * vp + i16) * 64;
        f32x4 SA[4], SB[4];
#pragma unroll
        for (int kt = 0; kt < 4; ++kt) { SA[kt] = *(const f32x4*)(a.in[7] + so + 16 * kt + 4 * qp); SB[kt] = *(const f32x4*)(a.in[7] + so + 16 * 64 + 16 * kt + 4 * qp); }
        ChainFrag2 F; chain_fetch2(slot, 2 * vp, lane, F);
        f32x4 ya, yb; chain_math2(F, SA, SB, ya, yb);
#pragma unroll
        for (int r = 0; r < 4; ++r) if (4 * qp + r < DSEQ) { Y[(m0 + 4 * qp + r) * D + 64 * h + 32 * vp + i16] = f2bf(ya[r]); Y[(m0 + 4 * qp + r) * D + 64 * h + 32 * vp + 16 + i16] = f2bf(yb[r]); }
#pragma unroll
        for (int kt = 0; kt < 4; ++kt) { *(f32x4*)(a.out + O_SWKV + so + 16 * kt + 4 * qp) = SA[kt]; *(f32x4*)(a.out + O_SWKV + so + 16 * 64 + 16 * kt + 4 * qp) = SB[kt]; }
    }
    __syncthreads();
}

#ifndef PROBE_MIXB
#define PROBE_MIXB 0
#endif
__device__ __forceinline__ void phase_mixb2(const Args& a, int L, LAS unsigned char* lds) {
    constexpr int N_PC = NBATCH * 16;
    const int G = gridDim.x, bx = blockIdx.x;
    const int first_other = (G > 2 * N_PC) ? N_PC : 0;
    for (int it = bx; it < N_PC; it += G) wkv_prompt_chain<0>(a, L, it >> 4, it & 15, lds);
    if (PROBE_MIXB & 1) for (int it = bx; it < N_PC; it += G) wkv_prompt_chain<0>(a, L, it >> 4, it & 15, lds);
    if (PROBE_MIXB & 8) for (int it = bx; it < N_PC; it += G) wkv_prompt_chain<1>(a, L, it >> 4, it & 15, lds);
    if (PROBE_MIXB & 16) for (int it = bx; it < N_PC; it += G) wkv_prompt_chain<2>(a, L, it >> 4, it & 15, lds);
    if (PROBE_MIXB & 32) for (int it = bx; it < N_PC; it += G) wkv_prompt_chain<3>(a, L, it >> 4, it & 15, lds);
    if (bx < first_other) return;
    const int nb = G - first_other, id = bx - first_other;
    constexpr int N_RG2 = M / 64, N_SC = DBATCH * 2;
    for (int it = id; it < N_RG2; it += nb) { rglru_unit2<true>(a, L, it, lds); __syncthreads(); }
    if (PROBE_MIXB & 4) for (int it = id; it < N_RG2; it += nb) { rglru_unit2<true>(a, L, it, lds); __syncthreads(); }
    {
        const int second = (N_RG2 > nb) ? N_RG2 - nb : 0;
        const int start = id >= second ? id - second : id + (nb - second);
        for (int it = start; it < N_SC; it += nb) wkv_sample_chain(a, L, it >> 1, it & 1, lds);
        if (PROBE_MIXB & 2) for (int it = start; it < N_SC; it += nb) wkv_sample_chain(a, L, it >> 1, it & 1, lds);
    }
}
#ifndef PROBE_MASK
#define PROBE_MASK 0
#endif
#define PH_IN(k) (lo <= (k) && (k) < hi)
#define RUN_PHASE(po, ...) do { { __VA_ARGS__ } if (((PROBE_MASK >> (po)) & 1) && PH_IN(base + (po))) { cg::this_grid().sync(); { __VA_ARGS__ } } } while (0)
#define PH_SYNC(k) do { if (lo < (k) && (k) < hi) cg::this_grid().sync(); } while (0)
template <int L> __device__ __forceinline__ void layer_phases(const Args& a, LAS unsigned char* lds, int lo, int hi) {
    unsigned char* ws = a.ws;
    const int G = gridDim.x;
    constexpr int base = PH_L0 + L * PH_PER_LAYER;
    PH_SYNC(base + PHO_IN);
    RUN_PHASE(PHO_IN, if (PH_IN(base + PHO_IN)) {
        pg8::Gemm g{(const bf16_t*)(ws + WS_XB), (const bf16_t*)(ws + WS_WIN), M, NP, D}; pg8::StaticOrder S; S.init(M, NP, G, (int)blockIdx.x);
        EpiIn E{(bf16_t*)(ws + WS_P), NP, CG / 256};
        pg8::gemm_phase<EpiIn, pg8::StaticOrder, true, true>(lds, g, S, E);
    });
    PH_SYNC(base + PHO_MIXA);
    RUN_PHASE(PHO_MIXA, if (PH_IN(base + PHO_MIXA)) phase_mixa(a, L, lds););
    PH_SYNC(base + PHO_LORA);
    RUN_PHASE(PHO_LORA, if (PH_IN(base + PHO_LORA)) {
        pg8::Gemm g{(const bf16_t*)(ws + WS_ACAT), (const bf16_t*)(ws + WS_WLORA), M, 3072, ACAT_K}; pg8::StaticOrder S; S.init(M, 3072, G, (int)blockIdx.x);
        EpiLora E{(bf16_t*)(ws + WS_WAW), (bf16_t*)(ws + WS_WAA), (bf16_t*)(ws + WS_WAG), a.in[18] + L * D, a.in[20] + L * D};
        pg8::gemm_phase<EpiLora, pg8::StaticOrder, true, true>(lds, g, S, E);
    });
    PH_SYNC(base + PHO_C1);
    RUN_PHASE(PHO_C1, if (PH_IN(base + PHO_C1)) phase_c1(a, L, lds););
    PH_SYNC(base + PHO_MIXB);
    RUN_PHASE(PHO_MIXB, if (PH_IN(base + PHO_MIXB)) phase_mixb2(a, L, lds););
    PH_SYNC(base + PHO_MIXC);
    if (PH_IN(base + PHO_MIXC)) phase_mixc(a, L);
    PH_SYNC(base + PHO_OUT);
    RUN_PHASE(PHO_OUT, if (PH_IN(base + PHO_OUT)) {
        pg8::Gemm g{(const bf16_t*)(ws + WS_MIX), (const bf16_t*)(ws + WS_WOUT), M, 2 * D, D / 2, D, D / 2, 4, (size_t)D}; pg8::StaticOrder S; S.init(M, 2 * D, G, (int)blockIdx.x);
        if (L == 0) { EpiSplit<false> E{a.in[0], a.in[1], MP, (float*)(ws + WS_Z), (float*)(ws + WS_Z1), D}; pg8::gemm_phase<EpiSplit<false>, pg8::StaticOrder, true, true>(lds, g, S, E); }
        else { EpiSplit<true> E{ws + WS_XB, nullptr, 0, (float*)(ws + WS_Z), (float*)(ws + WS_Z1), D}; pg8::gemm_phase<EpiSplit<true>, pg8::StaticOrder, true, true>(lds, g, S, E); }
    });
    PH_SYNC(base + PHO_LN1);
    RUN_PHASE(PHO_LN1, if (PH_IN(base + PHO_LN1)) phase_ln((const float*)(ws + WS_Z), (const float*)(ws + WS_Z1), a.in[29] + L * D, a.in[30] + L * D, nullptr, (bf16_t*)(ws + WS_X1B)););
    PH_SYNC(base + PHO_GU);
    RUN_PHASE(PHO_GU, if (PH_IN(base + PHO_GU)) {
        pg8::Gemm g{(const bf16_t*)(ws + WS_X1B), (const bf16_t*)(ws + WS_WGU), M, 2 * DFF, D}; pg8::StaticOrder S; S.init(M, 2 * DFF, G, (int)blockIdx.x);
        EpiSwiGLU E{(bf16_t*)(ws + WS_H), DFF};
        pg8::gemm_phase<EpiSwiGLU, pg8::StaticOrder, true, true>(lds, g, S, E);
    });
    PH_SYNC(base + PHO_DOWN);
    RUN_PHASE(PHO_DOWN, if (PH_IN(base + PHO_DOWN)) {
        pg8::Gemm g{(const bf16_t*)(ws + WS_H), (const bf16_t*)(ws + WS_WDN), M, 2 * D, DFF / 2, DFF, DFF / 2, 4, (size_t)DFF}; pg8::StaticOrder S; S.init(M, 2 * D, G, (int)blockIdx.x);
        EpiSplit<true> E{ws + WS_X1B, nullptr, 0, (float*)(ws + WS_Z), (float*)(ws + WS_Z1), D};
        pg8::gemm_phase<EpiSplit<true>, pg8::StaticOrder, true, true>(lds, g, S, E);
    });
    PH_SYNC(base + PHO_LN2);
    RUN_PHASE(PHO_LN2, if (PH_IN(base + PHO_LN2)) {
        if (L == DEPTH - 1) phase_ln((const float*)(ws + WS_Z), (const float*)(ws + WS_Z1), a.in[33] + L * D, a.in[34] + L * D, a.out + O_YP, nullptr);
        else { phase_ln((const float*)(ws + WS_Z), (const float*)(ws + WS_Z1), a.in[33] + L * D, a.in[34] + L * D, nullptr, (bf16_t*)(ws + WS_XB)); phase_prep_weights(a, L + 1, lds); }
    });
}
__global__ void __launch_bounds__(NTHREADS, 2) mega(Args a) {
    extern __shared__ __attribute__((aligned(16))) unsigned char lds_raw[];
    LAS unsigned char* lds = (LAS unsigned char*)lds_raw;
    const int lo = a.ph_lo, hi = a.ph_hi;
    if (PH_IN(PH_PREP)) { phase_prep_weights(a, 0, lds); phase_prep_x(a); }
    layer_phases<0>(a, lds, lo, hi);
    layer_phases<1>(a, lds, lo, hi);
}

static void launch_mega(Args a, int lo, int hi, int grid, hipStream_t s) {
    a.ph_lo = lo; a.ph_hi = hi;
    void* args[] = {&a};
    hipError_t e;
    if (hi - lo > 1) e = hipLaunchCooperativeKernel((void*)mega, dim3(grid), dim3(NTHREADS), args, LDS_BYTES, s);
    else e = hipLaunchKernel((void*)mega, dim3(grid), dim3(NTHREADS), args, LDS_BYTES, s);
    if (e != hipSuccess) fprintf(stderr, "mega launch [%d,%d) failed: %s (grid %d)\n", lo, hi, hipGetErrorString(e), grid);
}

extern "C" void kernel_launch(void* const* d_in, const int* in_sizes, int n_in, void* d_out, int out_size,
                              void* d_ws, size_t ws_size, hipStream_t stream) {
    if (ws_size < WS_END || out_size != (int)O_END || n_in != 35) { fprintf(stderr, "kernel_launch: unexpected sizes ws=%zu out=%d n_in=%d\n", ws_size, out_size, n_in); return; }
    static int grid = 0;
    if (!grid) {
        int dev = 0, cus = 0, per_cu = 0;
        (void)hipGetDevice(&dev);
        (void)hipDeviceGetAttribute(&cus, hipDeviceAttributeMultiprocessorCount, dev);
        (void)hipFuncSetAttribute((const void*)mega, hipFuncAttributeMaxDynamicSharedMemorySize, LDS_BYTES);
        (void)hipOccupancyMaxActiveBlocksPerMultiprocessor(&per_cu, (const void*)mega, NTHREADS, LDS_BYTES);
        if (per_cu < 1) { fprintf(stderr, "occupancy query says %d blocks per CU\n", per_cu); per_cu = 1; }
        grid = cus * per_cu;
    }
    const float* const* in = (const float* const*)d_in;
    unsigned char* ws = (unsigned char*)d_ws;
    float* out = (float*)d_out;
    Args a{};
    for (int i = 0; i < 35; ++i) a.in[i] = in[i];
    a.out = out; a.ws = ws;
    launch_mega(a, 0, N_PHASES, grid, stream);
}
```

```cpp
#include <hip/hip_runtime.h>
#include <cstdint>
#include <cstdio>

typedef unsigned short bf16_t;
__device__ __forceinline__ float bf2f(bf16_t v) { return __uint_as_float(((unsigned)v) << 16); }
__device__ __forceinline__ bf16_t f2bf(float f) { unsigned u = __float_as_uint(f); return (bf16_t)((u + 0x7fffu + ((u >> 16) & 1u)) >> 16); }
__device__ __forceinline__ float sigmoidf_(float x) { return 1.f / (1.f + __expf(-x)); }
__device__ __forceinline__ float softplusf_(float x) { return fmaxf(x, 0.f) + log1pf(__expf(-fabsf(x))); }
__device__ __forceinline__ float wave_sum(float v) {
#pragma unroll
    for (int o = 1; o < 64; o <<= 1) v += __shfl_xor(v, o);
    return v;
}

constexpr int D = 1024, MP = 16384, MS = 1024, M = MP + MS, SEQ = 8192, DSEQ = 8, NBATCH = 2, DBATCH = 128, DEPTH = 2;
constexpr int NP = 9216, IN_COLS = 8992;
constexpr int CQ = 0, CK = 1024, CV = 1280, CRNN = 1536, CRW = 2560, CG = 6144;
constexpr int SHIFT_W = 3360, DFF = 2816;
constexpr float ALPHA = 1.4142135623730951f;
constexpr float LN_EPS = 1e-5f, GN_EPS = 64e-5f;

constexpr size_t O_YP = 0, O_YS = 16777216, O_PK = 17825792, O_PV = 17956864, O_PCONV = 18087936, O_PH = 18100224,
                 O_PSHIFT = 18104320, O_PWKV = 18117760, O_SK = 18379904, O_SV = 26768512, O_SCONV = 35157120,
                 O_SH = 35943552, O_SSHIFT = 36205696, O_SWKV = 37065856, O_END = 53843072;


constexpr size_t MiB = 1u << 20;
constexpr size_t WS_CTL = 0;
constexpr size_t WIN_T_BYTES = (size_t)NP * D * 2, WOUT_T_BYTES = (size_t)D * D * 2, WGU_T_BYTES = (size_t)2 * DFF * D * 2, WDN_T_BYTES = (size_t)D * DFF * 2;
constexpr int ACAT_K = 384;
constexpr size_t WLORA_BYTES = (size_t)3072 * ACAT_K * 2;
constexpr size_t WS_WIN = 1 * MiB;
constexpr size_t WS_WOUT = WS_WIN + WIN_T_BYTES;
constexpr size_t WS_WGU = WS_WOUT + WOUT_T_BYTES;
constexpr size_t WS_WDN = WS_WGU + WGU_T_BYTES;
constexpr size_t WS_WOUTS = WS_WDN + WDN_T_BYTES;
constexpr size_t WS_WDNS = WS_WOUTS + WOUT_T_BYTES;
constexpr size_t WS_WLORA = WS_WDNS + WDN_T_BYTES;
constexpr size_t WS_XB = WS_WLORA + WLORA_BYTES;
constexpr size_t WS_OA = WS_XB + (size_t)M * D * 2;
constexpr size_t WS_MIX = WS_OA;
constexpr size_t WS_OB = WS_OA + (size_t)M * D * 2;
constexpr size_t WS_P = WS_OB + (size_t)M * D * 2;
constexpr size_t WS_Z = WS_P;
constexpr size_t WS_ZS = WS_Z + (size_t)M * D * 4;
constexpr size_t WS_X1B = WS_ZS + (size_t)11 * MS * D * 4;
constexpr size_t WS_H = WS_X1B + (size_t)M * D * 2;
constexpr size_t WS_PEND = WS_P + (size_t)M * NP * 2;
constexpr size_t WS_RS = WS_PEND;
constexpr size_t WS_WAW = WS_RS + (size_t)2 * 128 * 1024 * 2 * 4;
constexpr size_t WS_WAA = WS_WAW + (size_t)M * D * 2;
constexpr size_t WS_WAG = WS_WAA + (size_t)M * D * 2;
constexpr size_t WS_Y = WS_WAG + (size_t)M * D * 2;
constexpr size_t WS_BD = WS_Y + (size_t)M * D * 2;
constexpr size_t WS_ACAT = WS_BD + (size_t)M * 16 * 4;
constexpr size_t WS_CB = WS_ACAT;
constexpr size_t WS_END = WS_ACAT + (size_t)M * ACAT_K * 2;
static_assert(WS_END <= (size_t)861000000, "workspace budget (4 x output bytes = 861.5 MB)");
static_assert(WS_H + (size_t)M * DFF * 2 <= WS_PEND, "overlay fits");
static_assert(WS_WAA == WS_WAW + (size_t)M * D * 2 && WS_WAG == WS_WAA + (size_t)M * D * 2, "lora outputs contiguous");
static_assert(WS_XB % 256 == 0 && WS_P % 256 == 0 && WS_WLORA % 256 == 0 && WS_ACAT % 256 == 0, "alignment");
namespace pg8 {
#define PG8_LAS __attribute__((address_space(3)))
typedef unsigned short bf16_t;
typedef short bf16x8 __attribute__((ext_vector_type(8)));
typedef float f32x4 __attribute__((ext_vector_type(4)));
typedef unsigned u32x4 __attribute__((ext_vector_type(4)));
constexpr int BM = 256, BK = 64, HALF = 128, HTB = HALF * BK * 2  , STAGE_BYTES = 8 * HTB, NXCD = 8, WGM = 8;

__host__ __device__ __forceinline__ int lds_byte(int r, int c) { const int st = (r >> 4) * 2 + (c >> 5), rr = r & 15, cc = c & 31, ob = rr * 64 + cc * 2; return st * 1024 + (ob ^ (((ob >> 9) & 1) << 5)); }
__host__ __device__ __forceinline__ void stage_rc(int b, int& R, int& C) { const int st = b / 1024, sb = b % 1024, swz = sb ^ (((sb >> 9) & 1) << 5); R = (st >> 1) * 16 + swz / 64; C = (st & 1) * 32 + (swz % 64) / 2; }
__host__ __device__ __forceinline__ int perm32(int rho) { const int n = rho >> 4, i = rho & 15; return 8 * (i >> 2) + 4 * n + (i & 3); }

struct Unit { int pm, pn; };
struct Gemm { const bf16_t* A; const bf16_t* Bt; int M, N, K; int lda = 0, ldb = 0, nsplit = 0; size_t a_koff = 0; };

struct StaticOrder {
    int nM, nN, nwg, G, c;
    __host__ __device__ void init(int M, int N, int G_, int c_) { nM = M / BM; nN = N / BM; nwg = nM * nN; G = G_; c = c_; }
    __host__ __device__ bool next(int i, Unit& u) const {
        const long L = (long)i * G + c; if (L >= nwg) return false;
        int wgid = (int)L; { const int q = nwg / NXCD, r = nwg % NXCD, xcd = wgid % NXCD, off = wgid / NXCD; wgid = (xcd < r ? xcd * (q + 1) : r * (q + 1) + (xcd - r) * q) + off; }
        const int nig = WGM * nN, gid = wgid / nig, fm = gid * WGM, gsz = (nM - fm) < WGM ? (nM - fm) : WGM;
        u.pm = fm + ((wgid % nig) % gsz); u.pn = (wgid % nig) / gsz; return true;
    }
    __device__ __forceinline__ void a_ready(const Unit&) const {}
    __device__ __forceinline__ void done(const Unit&) const {}
};

__device__ __forceinline__ unsigned cvt_pk_bf16(float lo, float hi) { unsigned r; asm volatile("v_cvt_pk_bf16_f32 %0, %1, %2" : "=v"(r) : "v"(lo), "v"(hi)); return r; }
typedef float f32x2 __attribute__((ext_vector_type(2)));
template <class Epi, class Sched, bool ALIGN_EPI = false, bool SP2 = false>
__device__ __forceinline__ void gemm_phase(PG8_LAS unsigned char* lds, const Gemm g, const Sched& S, const Epi& E) {
    const int tid = threadIdx.x, wid = __builtin_amdgcn_readfirstlane(tid >> 6), lane = tid & 63, wr = wid >> 2, wc = wid & 3, fr = lane & 15, fq = lane >> 4;
    const int K = g.K, nt = K / BK, lda = g.lda ? g.lda : K, ldb = g.ldb ? g.ldb : K;
    unsigned voffA[2], voffB[2];
#pragma unroll
    for (int i = 0; i < 2; ++i) { int R, C; stage_rc(tid * 16 + i * 8192, R, C); const int Rb = Epi::PERM ? ((R & ~31) + perm32(R & 31)) : R;
        voffA[i] = (unsigned)(R * lda + C) * 2u; voffB[i] = (unsigned)(Rb * ldb + C) * 2u; }
    const size_t kstep = (size_t)(BK * 2);
    const size_t hstepA = (size_t)HALF * lda * 2, hstepB = (size_t)HALF * ldb * 2;
    const size_t tstepA = 2 * hstepA, tstepB = 2 * hstepB;
#define PG8_ABASE(u) ((const char*)g.A + (size_t)(u).pm * tstepA + (g.nsplit ? (size_t)((u).pn / g.nsplit) * g.a_koff : (size_t)0))
    const unsigned ldsw = (unsigned)wid * 1024u;
    const int aoff = lds_byte(wr * 64 + fr, fq * 8), boff = lds_byte(wc * 32 + fr, fq * 8);
#define PG8_SA(b, h) (((b) * 2 + (h)) * HTB)
#define PG8_SB(b, h) ((4 + (b) * 2 + (h)) * HTB)
#define PG8_STAGE(bufoff, gbase, voff) do { _Pragma("unroll") for (int _i = 0; _i < 2; ++_i) \
        __builtin_amdgcn_global_load_lds((const unsigned*)((const char*)(gbase) + (voff)[_i]), (PG8_LAS unsigned*)(lds + (bufoff) + ldsw + _i * 8192), 16, 0, 0); } while (0)
#define PG8_LDA(dst, b, h) do { _Pragma("unroll") for (int m = 0; m < 4; ++m) _Pragma("unroll") for (int k = 0; k < 2; ++k) dst[m][k] = *(const PG8_LAS bf16x8*)(lds + PG8_SA(b, h) + aoff + m * 2048 + k * 1024); } while (0)
#define PG8_LDB(dst, b, h) do { _Pragma("unroll") for (int n = 0; n < 2; ++n) _Pragma("unroll") for (int k = 0; k < 2; ++k) dst[n][k] = *(const PG8_LAS bf16x8*)(lds + PG8_SB(b, h) + boff + n * 2048 + k * 1024); } while (0)
#define PG8_MMA(ai, bj, At, Bt) do { __builtin_amdgcn_s_setprio(1); _Pragma("unroll") for (int m = 0; m < 4; ++m) _Pragma("unroll") for (int n = 0; n < 2; ++n) _Pragma("unroll") for (int k = 0; k < 2; ++k) \
        acc[ai][bj][m][n] = __builtin_amdgcn_mfma_f32_16x16x32_bf16(Bt[n][k], At[m][k], acc[ai][bj][m][n], 0, 0, 0); __builtin_amdgcn_s_setprio(0); } while (0)
#define PG8_WAIT_V(n) asm volatile("s_waitcnt vmcnt(" #n ")" ::: "memory")
#define PG8_WAIT_L(n) asm volatile("s_waitcnt lgkmcnt(" #n ")" ::: "memory")
#define PG8_BAR __builtin_amdgcn_s_barrier()
#define PG8_SCHED __builtin_amdgcn_sched_barrier(0)
    Unit cur, nxt; int ui = 0;
    if (!S.next(0, cur)) return;
    f32x4 acc[2][2][4][2];
#pragma unroll
    for (int a = 0; a < 2; ++a)
#pragma unroll
        for (int b = 0; b < 2; ++b)
#pragma unroll
            for (int m = 0; m < 4; ++m)
#pragma unroll
                for (int n = 0; n < 2; ++n) acc[a][b][m][n] = (f32x4){0.f, 0.f, 0.f, 0.f};
    bf16x8 At[4][2], B0[2][2], B1[2][2];
    const char* cA = PG8_ABASE(cur); const char* cB = (const char*)g.Bt + (size_t)cur.pn * tstepB;
    S.a_ready(cur);
    if constexpr (SP2) {
        PG8_STAGE(PG8_SB(0, 0), cB, voffB); PG8_STAGE(PG8_SB(0, 1), cB + hstepB, voffB); PG8_STAGE(PG8_SA(0, 0), cA, voffA); PG8_STAGE(PG8_SA(0, 1), cA + hstepA, voffA);
        if (wr == 1) PG8_BAR;
        PG8_WAIT_V(2); PG8_BAR;
        PG8_STAGE(PG8_SB(1, 0), cB + kstep, voffB); PG8_STAGE(PG8_SA(1, 0), cA + kstep, voffA); PG8_STAGE(PG8_SB(1, 1), cB + hstepB + kstep, voffB);
        PG8_WAIT_V(6); PG8_BAR;
    } else {
        PG8_STAGE(PG8_SB(0, 0), cB, voffB); PG8_STAGE(PG8_SA(0, 0), cA, voffA); PG8_STAGE(PG8_SB(0, 1), cB + hstepB, voffB); PG8_STAGE(PG8_SA(0, 1), cA + hstepA, voffA);
        if (wr == 1) PG8_BAR;
        PG8_WAIT_V(4); PG8_BAR;
        PG8_STAGE(PG8_SB(1, 0), cB + kstep, voffB); PG8_STAGE(PG8_SA(1, 0), cA + kstep, voffA); PG8_STAGE(PG8_SB(1, 1), cB + hstepB + kstep, voffB);
        PG8_WAIT_V(6); PG8_BAR;
    }
    for (;;) {
        const bool has_next = S.next(ui + 1, nxt);
        const char* nA = has_next ? PG8_ABASE(nxt) : cA; const char* nB = has_next ? (const char*)g.Bt + (size_t)nxt.pn * tstepB : cB;
#pragma nounroll
        for (int t = 0; t < nt; t += 2) {
            const bool last = (t == nt - 2);
            const char* a1 = cA + (size_t)(t + 1) * kstep;
            const char* a2 = last ? nA : cA + (size_t)(t + 2) * kstep; const char* b2 = last ? nB : cB + (size_t)(t + 2) * kstep;
            const char* a3 = a2 + kstep; const char* b3 = b2 + kstep;
            if (last && has_next) S.a_ready(nxt);
            if constexpr (SP2) {
            PG8_LDB(B0, 0, 0); PG8_LDB(B1, 0, 1); PG8_SCHED; PG8_LDA(At, 0, 0); PG8_STAGE(PG8_SA(1, 1), a1 + hstepA, voffA);
            PG8_WAIT_V(8); PG8_WAIT_L(0); PG8_BAR; PG8_MMA(0, 0, At, B0); PG8_MMA(0, 1, At, B1); PG8_BAR; PG8_SCHED;
            PG8_LDA(At, 0, 1); PG8_STAGE(PG8_SB(0, 0), b2, voffB); PG8_STAGE(PG8_SB(0, 1), b2 + hstepB, voffB); PG8_STAGE(PG8_SA(0, 0), a2, voffA);
            PG8_WAIT_V(8); PG8_WAIT_L(0); PG8_BAR; PG8_MMA(1, 0, At, B0); PG8_MMA(1, 1, At, B1); PG8_BAR; PG8_SCHED;
            PG8_LDB(B0, 1, 0); PG8_LDB(B1, 1, 1); PG8_SCHED; PG8_LDA(At, 1, 0); PG8_STAGE(PG8_SA(0, 1), a2 + hstepA, voffA);
            PG8_WAIT_V(8); PG8_WAIT_L(0); PG8_BAR; PG8_MMA(0, 0, At, B0); PG8_MMA(0, 1, At, B1); PG8_BAR; PG8_SCHED;
            PG8_LDA(At, 1, 1); PG8_STAGE(PG8_SB(1, 0), b3, voffB); PG8_STAGE(PG8_SB(1, 1), b3 + hstepB, voffB); PG8_STAGE(PG8_SA(1, 0), a3, voffA);
            PG8_WAIT_V(8); PG8_WAIT_L(0); PG8_BAR; PG8_MMA(1, 0, At, B0); PG8_MMA(1, 1, At, B1); PG8_BAR; PG8_SCHED;
            } else {
            PG8_LDB(B0, 0, 0); PG8_SCHED; PG8_LDA(At, 0, 0); PG8_STAGE(PG8_SA(1, 1), a1 + hstepA, voffA);
            PG8_WAIT_L(8); PG8_BAR; PG8_WAIT_L(0); PG8_MMA(0, 0, At, B0); PG8_BAR; PG8_SCHED;
            PG8_LDB(B1, 0, 1); PG8_STAGE(PG8_SB(0, 0), b2, voffB);
            PG8_BAR; PG8_WAIT_L(0); PG8_MMA(0, 1, At, B1); PG8_BAR;
            PG8_LDA(At, 0, 1); PG8_STAGE(PG8_SA(0, 0), a2, voffA);
            PG8_BAR; PG8_WAIT_L(0); PG8_MMA(1, 0, At, B0); PG8_BAR; PG8_SCHED;
            PG8_STAGE(PG8_SB(0, 1), b2 + hstepB, voffB);
            PG8_WAIT_V(6); PG8_BAR; PG8_MMA(1, 1, At, B1); PG8_BAR;
            PG8_LDB(B0, 1, 0); PG8_SCHED; PG8_LDA(At, 1, 0); PG8_STAGE(PG8_SA(0, 1), a2 + hstepA, voffA);
            PG8_WAIT_L(8); PG8_BAR; PG8_WAIT_L(0); PG8_MMA(0, 0, At, B0); PG8_BAR; PG8_SCHED;
            PG8_LDB(B1, 1, 1); PG8_STAGE(PG8_SB(1, 0), b3, voffB);
            PG8_BAR; PG8_WAIT_L(0); PG8_MMA(0, 1, At, B1); PG8_BAR;
            PG8_LDA(At, 1, 1); PG8_STAGE(PG8_SA(1, 0), a3, voffA);
            PG8_BAR; PG8_WAIT_L(0); PG8_MMA(1, 0, At, B0); PG8_BAR; PG8_SCHED;
            PG8_STAGE(PG8_SB(1, 1), b3 + hstepB, voffB);
            PG8_WAIT_V(6); PG8_BAR; PG8_MMA(1, 1, At, B1); PG8_BAR;
            }
        }
        if constexpr (ALIGN_EPI) { if (wr == 0) PG8_BAR; }
        if constexpr (!Epi::AFTER_DRAIN) { E(acc, cur, wr, wc, fr, fq); S.done(cur); }
        if (!has_next) break;
#pragma unroll
        for (int a = 0; a < 2; ++a)
#pragma unroll
            for (int b = 0; b < 2; ++b)
#pragma unroll
                for (int m = 0; m < 4; ++m)
#pragma unroll
                    for (int n = 0; n < 2; ++n) acc[a][b][m][n] = (f32x4){0.f, 0.f, 0.f, 0.f};
        cur = nxt; cA = nA; cB = nB; ++ui;
        if constexpr (ALIGN_EPI) { if (wr == 1) PG8_BAR; }
    }
    PG8_WAIT_V(0);
    if constexpr (!ALIGN_EPI) { if (wr == 0) PG8_BAR; }
    PG8_BAR;
    if constexpr (Epi::AFTER_DRAIN) { E.fused(acc, cur, wr, wc, fr, fq, lds, wid, lane); S.done(cur); }
#undef PG8_ABASE
#undef PG8_SA
#undef PG8_SB
#undef PG8_STAGE
#undef PG8_LDA
#undef PG8_LDB
#undef PG8_MMA
#undef PG8_WAIT_V
#undef PG8_WAIT_L
#undef PG8_BAR
#undef PG8_SCHED
}
}

#include <hip/hip_cooperative_groups.h>
namespace cg = cooperative_groups;
#define LAS __attribute__((address_space(3)))
typedef float f32x4 __attribute__((ext_vector_type(4)));
typedef unsigned u32x4 __attribute__((ext_vector_type(4)));
typedef unsigned u32x2 __attribute__((ext_vector_type(2)));

constexpr int NTHREADS = 512, NWAVES = 8;
constexpr int LDS_BYTES = 147456;

constexpr int PH_PREP = 0, PH_PER_LAYER = 11, PH_L0 = 1;
constexpr int PHO_IN = 0, PHO_MIXA = 1, PHO_LORA = 2, PHO_C1 = 3, PHO_MIXB = 4, PHO_MIXC = 5, PHO_OUT = 6, PHO_LN1 = 7, PHO_GU = 8, PHO_DOWN = 9, PHO_LN2 = 10;
constexpr int N_PHASES = PH_L0 + DEPTH * PH_PER_LAYER;

struct Args { const float* in[35]; float* out; unsigned char* ws; int ph_lo, ph_hi; };

typedef float f32x2_t __attribute__((ext_vector_type(2))); typedef __bf16 bf16x2_t __attribute__((ext_vector_type(2)));
__device__ __forceinline__ unsigned pk2bf(float lo, float hi) { f32x2_t v = {lo, hi}; bf16x2_t b = __builtin_convertvector(v, bf16x2_t); return __builtin_bit_cast(unsigned, b); }

struct EpiIn {
    static constexpr bool PERM = true, AFTER_DRAIN = false;
    bf16_t* O; int ldc; int sig_pn;
    __device__ __forceinline__ void operator()(const f32x4 (&acc)[2][2][4][2], const pg8::Unit& u, int wr, int wc, int fr, int fq) const {
        const int row0 = u.pm * 256 + wr * 64 + fr, col0 = u.pn * 256 + wc * 32 + 8 * fq;
        const bool sg = u.pn >= sig_pn;
#pragma unroll
        for (int ai = 0; ai < 2; ++ai)
#pragma unroll
            for (int m = 0; m < 4; ++m) {
                bf16_t* rowp = O + (size_t)(row0 + ai * 128 + m * 16) * ldc + col0;
#pragma unroll
                for (int bj = 0; bj < 2; ++bj) {
                    f32x4 v0 = acc[ai][bj][m][0], v1 = acc[ai][bj][m][1];
                    if (sg) {
#pragma unroll
                        for (int i = 0; i < 4; ++i) { v0[i] = sigmoidf_(v0[i]); v1[i] = sigmoidf_(v1[i]); }
                    }
                    u32x4 w; w.x = pk2bf(v0[0], v0[1]); w.y = pk2bf(v0[2], v0[3]); w.z = pk2bf(v1[0], v1[1]); w.w = pk2bf(v1[2], v1[3]);
                    *(u32x4*)(rowp + bj * 128) = w;
                }
                asm volatile("" ::: "memory");
            }
    }
};
template <bool RESB> struct EpiZ {
    static constexpr bool PERM = false, AFTER_DRAIN = false;
    const void* res; float* Z; int ldc;
    __device__ __forceinline__ void operator()(const f32x4 (&acc)[2][2][4][2], const pg8::Unit& u, int wr, int wc, int fr, int fq) const {
        const int col0 = u.pn * 256 + wc * 32 + 4 * fq;
#pragma unroll
        for (int ai = 0; ai < 2; ++ai)
#pragma unroll
            for (int m = 0; m < 4; ++m) {
                const size_t off = (size_t)(u.pm * 256 + ai * 128 + wr * 64 + m * 16 + fr) * ldc + col0;
#pragma unroll
                for (int bj = 0; bj < 2; ++bj)
#pragma unroll
                    for (int n = 0; n < 2; ++n) {
                        f32x4 r;
                        if (RESB) { const u32x2 w = *(const u32x2*)((const bf16_t*)res + off + bj * 128 + n * 16);
                            r = (f32x4){__uint_as_float(w.x << 16), __uint_as_float(w.x & 0xffff0000u), __uint_as_float(w.y << 16), __uint_as_float(w.y & 0xffff0000u)}; }
                        else r = *(const f32x4*)((const float*)res + off + bj * 128 + n * 16);
                        *(f32x4*)(Z + off + bj * 128 + n * 16) = r * ALPHA + acc[ai][bj][m][n];
                    }
                asm volatile("" ::: "memory");
            }
    }
};
template <bool RESB> struct EpiZS {
    static constexpr bool PERM = false, AFTER_DRAIN = false;
    const void* res; float* ZS; int ldc;
    __device__ __forceinline__ void operator()(const f32x4 (&acc)[2][2][4][2], const pg8::Unit& u, int wr, int wc, int fr, int fq) const {
        const int ks = u.pn >> 2, col0 = (u.pn & 3) * 256 + wc * 32 + 4 * fq;
        float* Z = ZS + (size_t)ks * MS * D;
#pragma unroll
        for (int ai = 0; ai < 2; ++ai)
#pragma unroll
            for (int m = 0; m < 4; ++m) {
                const size_t off = (size_t)(u.pm * 256 + ai * 128 + wr * 64 + m * 16 + fr) * ldc + col0;
#pragma unroll
                for (int bj = 0; bj < 2; ++bj)
#pragma unroll
                    for (int n = 0; n < 2; ++n) {
                        f32x4 o = acc[ai][bj][m][n];
                        if (ks == 0) {
                            f32x4 r;
                            if (RESB) { const u32x2 w = *(const u32x2*)((const bf16_t*)res + off + bj * 128 + n * 16);
                                r = (f32x4){__uint_as_float(w.x << 16), __uint_as_float(w.x & 0xffff0000u), __uint_as_float(w.y << 16), __uint_as_float(w.y & 0xffff0000u)}; }
                            else r = *(const f32x4*)((const float*)res + off + bj * 128 + n * 16);
                            o = r * ALPHA + o;
                        }
                        *(f32x4*)(Z + off + bj * 128 + n * 16) = o;
                    }
                asm volatile("" ::: "memory");
            }
    }
};
struct EpiSwiGLU {
    static constexpr bool PERM = true, AFTER_DRAIN = false;
    bf16_t* H; int ldc;
    __device__ __forceinline__ void operator()(const f32x4 (&acc)[2][2][4][2], const pg8::Unit& u, int wr, int wc, int fr, int fq) const {
        const int row0 = u.pm * 256 + wr * 64 + fr, col0 = u.pn * 128 + wc * 32 + 8 * fq;
#pragma unroll
        for (int ai = 0; ai < 2; ++ai)
#pragma unroll
            for (int m = 0; m < 4; ++m) {
                bf16_t* rowp = H + (size_t)(row0 + ai * 128 + m * 16) * ldc + col0;
                float o[8];
#pragma unroll
                for (int n = 0; n < 2; ++n)
#pragma unroll
                    for (int i = 0; i < 4; ++i) { const float g = acc[ai][0][m][n][i], up = acc[ai][1][m][n][i]; o[n * 4 + i] = g * sigmoidf_(g) * up; }
                u32x4 w; w.x = pk2bf(o[0], o[1]); w.y = pk2bf(o[2], o[3]); w.z = pk2bf(o[4], o[5]); w.w = pk2bf(o[6], o[7]);
                *(u32x4*)rowp = w;
                asm volatile("" ::: "memory");
            }
    }
};

template <int MODE> __device__ __forceinline__ int colmap(int n) {
    if (MODE == 0) return n < 5920 ? n : (n < 6144 ? -1 : n - 224);
    if (MODE == 2) { const int pn = n >> 8, q = n & 255; return q < 128 ? pn * 128 + q : DFF + pn * 128 + (q - 128); }
    return n;
}
template <int MODE> __device__ __forceinline__ void transpose_item(const float* __restrict__ W, int K, int ldw, bf16_t* WT, int item, int nblk, LAS float* tile, int tid, int khalf = 0, int nrows = 0) {
    const int kb = item / nblk, nb = item % nblk, k0 = kb * 64, n0 = nb * 64;
    {
        const int nn = tid & 63; const int col = colmap<MODE>(n0 + nn);
#pragma unroll
        for (int i = 0; i < 8; ++i) { const int kk = i * 8 + (tid >> 6); tile[kk * 65 + nn] = col >= 0 ? W[(size_t)(k0 + kk) * ldw + col] : 0.f; }
    }
    __syncthreads();
    {
        const int nn = tid >> 3, c = tid & 7; const LAS float* s = tile + (8 * c) * 65 + nn;
        u32x4 o; o.x = pk2bf(s[0], s[65]); o.y = pk2bf(s[2 * 65], s[3 * 65]); o.z = pk2bf(s[4 * 65], s[5 * 65]); o.w = pk2bf(s[6 * 65], s[7 * 65]);
        if (khalf) { const int ks = k0 / khalf; *(u32x4*)(WT + ((size_t)ks * nrows + n0 + nn) * khalf + (k0 - ks * khalf) + 8 * c) = o; }
        else *(u32x4*)(WT + (size_t)(n0 + nn) * K + k0 + 8 * c) = o;
    }
    __syncthreads();
}
__device__ __forceinline__ void prep_rg_weights(const Args& a, int l);
__device__ __forceinline__ void phase_prep_weights(const Args& a, int l, LAS unsigned char* lds) {
    const int tid = threadIdx.x, G = gridDim.x, bx = blockIdx.x;
    LAS float* tile = (LAS float*)lds;
    constexpr int I_IN = (D / 64) * (NP / 64), I_OUT = (D / 64) * (D / 64), I_GU = (D / 64) * (2 * DFF / 64), I_DN = (DFF / 64) * (D / 64);
    constexpr int I_LAYER = I_IN + I_OUT + I_GU + I_DN;
    for (int it = bx; it < I_LAYER; it += G) {
        int r = it;
        if (r < I_IN) { transpose_item<0>(a.in[8] + (size_t)l * D * IN_COLS, D, IN_COLS, (bf16_t*)(a.ws + WS_WIN), r, NP / 64, tile, tid); continue; } r -= I_IN;
        if (r < I_OUT) { transpose_item<1>(a.in[28] + (size_t)l * D * D, D, D, (bf16_t*)(a.ws + WS_WOUT), r, D / 64, tile, tid); transpose_item<1>(a.in[28] + (size_t)l * D * D, D, D, (bf16_t*)(a.ws + WS_WOUTS), r, D / 64, tile, tid, 256, D); continue; } r -= I_OUT;
        if (r < I_GU) { transpose_item<2>(a.in[31] + (size_t)l * D * 2 * DFF, D, 2 * DFF, (bf16_t*)(a.ws + WS_WGU), r, 2 * DFF / 64, tile, tid); continue; } r -= I_GU;
        transpose_item<1>(a.in[32] + (size_t)l * DFF * D, DFF, D, (bf16_t*)(a.ws + WS_WDN), r, D / 64, tile, tid); transpose_item<1>(a.in[32] + (size_t)l * DFF * D, DFF, D, (bf16_t*)(a.ws + WS_WDNS), r, D / 64, tile, tid, 256, D);
    }
    const size_t gt = (size_t)bx * NTHREADS + tid, gs = (size_t)G * NTHREADS;
    for (size_t i = gt; i < (size_t)3072 * ACAT_K; i += gs) {
        const int n = (int)(i / ACAT_K), k = (int)(i % ACAT_K), kind = n >> 10, c = n & 1023;
        float v = 0.f;
        if (kind == 0 && k < 64) v = a.in[19][((size_t)l * 64 + k) * D + c];
        else if (kind == 1 && k >= 64 && k < 128) v = a.in[21][((size_t)l * 64 + (k - 64)) * D + c];
        else if (kind == 2 && k >= 128 && k < 288) v = a.in[22][((size_t)l * 160 + (k - 128)) * D + c];
        ((bf16_t*)(a.ws + WS_WLORA))[i] = f2bf(v);
    }
    prep_rg_weights(a, l);
}
__device__ __forceinline__ void phase_prep_x(const Args& a) {
    bf16_t* XB = (bf16_t*)(a.ws + WS_XB);
    const size_t n4 = (size_t)M * D / 4, np4 = (size_t)MP * D / 4;
    for (size_t i = (size_t)blockIdx.x * NTHREADS + threadIdx.x; i < n4; i += (size_t)gridDim.x * NTHREADS) {
        const f32x4 v = i < np4 ? ((const f32x4*)a.in[0])[i] : ((const f32x4*)a.in[1])[i - np4];
        u32x2 w; w.x = pk2bf(v[0], v[1]); w.y = pk2bf(v[2], v[3]);
        ((u32x2*)XB)[i] = w;
    }
}

__device__ __forceinline__ float wave_sum_fast(float x) {
    x += __builtin_bit_cast(float, __builtin_amdgcn_update_dpp(0, __builtin_bit_cast(int, x), 0xB1, 0xF, 0xF, true));
    x += __builtin_bit_cast(float, __builtin_amdgcn_update_dpp(0, __builtin_bit_cast(int, x), 0x4E, 0xF, 0xF, true));
    x += __builtin_bit_cast(float, __builtin_amdgcn_update_dpp(0, __builtin_bit_cast(int, x), 0x124, 0xF, 0xF, true));
    x += __builtin_bit_cast(float, __builtin_amdgcn_update_dpp(0, __builtin_bit_cast(int, x), 0x128, 0xF, 0xF, true));
    x += __shfl_xor(x, 16); x += __shfl_xor(x, 32);
    return x;
}
template <int NS> __device__ __forceinline__ void phase_ln(const float* __restrict__ Z, const float* __restrict__ ZS, const float* __restrict__ g, const float* __restrict__ b, float* OF, bf16_t* OB) {
    const int lane = threadIdx.x & 63, wv = threadIdx.x >> 6;
    f32x4 gv[4], bv[4];
#pragma unroll
    for (int j = 0; j < 4; ++j) { gv[j] = ((const f32x4*)g)[j * 64 + lane]; bv[j] = ((const f32x4*)b)[j * 64 + lane]; }
    const int stride = gridDim.x * NWAVES;
    int m = blockIdx.x * NWAVES + wv;
    f32x4 nx[4];
    auto load_row = [&](int mm) {
        if (mm < MP) {
#pragma unroll
            for (int j = 0; j < 4; ++j) nx[j] = ((const f32x4*)(Z + (size_t)mm * D))[j * 64 + lane];
        } else {
#pragma unroll
            for (int j = 0; j < 4; ++j) nx[j] = ((const f32x4*)(ZS + (size_t)(mm - MP) * D))[j * 64 + lane];
#pragma unroll
            for (int ks = 1; ks < NS; ++ks)
#pragma unroll
                for (int j = 0; j < 4; ++j) nx[j] = nx[j] + ((const f32x4*)(ZS + ((size_t)ks * MS + (mm - MP)) * D))[j * 64 + lane];
        }
    };
    if (m < M) load_row(m);
    for (; m < M; m += stride) {
        f32x4 v[4]; float s = 0.f;
#pragma unroll
        for (int j = 0; j < 4; ++j) { v[j] = nx[j]; s += (v[j][0] + v[j][1]) + (v[j][2] + v[j][3]); }
        if (m + stride < M) load_row(m + stride);
        const float mean = wave_sum_fast(s) * (1.f / D);
        float q = 0.f;
#pragma unroll
        for (int j = 0; j < 4; ++j) { v[j] = v[j] - mean; q += (v[j][0] * v[j][0] + v[j][1] * v[j][1]) + (v[j][2] * v[j][2] + v[j][3] * v[j][3]); }
        const float rstd = rsqrtf(wave_sum_fast(q) * (1.f / D) + LN_EPS);
#pragma unroll
        for (int j = 0; j < 4; ++j) {
            const f32x4 y = v[j] * rstd * gv[j] + bv[j];
            if (OF) ((f32x4*)(OF + (size_t)m * D))[j * 64 + lane] = y;
            if (OB) { u32x2 w; w.x = pk2bf(y[0], y[1]); w.y = pk2bf(y[2], y[3]); ((u32x2*)(OB + (size_t)m * D))[j * 64 + lane] = w; }
        }
    }
}


typedef short bf16x8_t __attribute__((ext_vector_type(8)));
typedef short bf16x4_t __attribute__((ext_vector_type(4)));
typedef short v4i16_t __attribute__((ext_vector_type(4)));
#define LDSW() asm volatile("s_waitcnt lgkmcnt(0)" ::: "memory")
__device__ __forceinline__ u32x2 tr_read4(LAS unsigned char* p) { return __builtin_bit_cast(u32x2, __builtin_amdgcn_ds_read_tr16_b64_v4i16((LAS v4i16_t*)p)); }
__device__ __forceinline__ bf16x8_t mk_frag(u32x2 lo, u32x2 hi) { const u32x4 w = (u32x4){lo.x, lo.y, hi.x, hi.y}; return __builtin_bit_cast(bf16x8_t, w); }
__device__ __forceinline__ u32x2 pk4(float a, float b, float c, float d) { u32x2 w; w.x = pk2bf(a, b); w.y = pk2bf(c, d); return w; }

constexpr size_t WS_WRG = WS_CTL + 4096;
constexpr int RG_TP = 144;
__device__ __forceinline__ void prep_rg_weights(const Args& a, int l) {
    const size_t gt = (size_t)blockIdx.x * NTHREADS + threadIdx.x, gs = (size_t)gridDim.x * NTHREADS;
    bf16_t* W = (bf16_t*)(a.ws + WS_WRG);
    for (size_t i = gt; i < (size_t)2 * 16 * 4096; i += gs) {
        const int gate = (int)(i >> 16), bk = (int)(i >> 12) & 15, j = (int)(i >> 6) & 63, ii = (int)i & 63;
        W[i] = f2bf(a.in[gate ? 14 : 12][(size_t)l * 16 * 4096 + ((size_t)bk * 64 + ii) * 64 + j]);
    }
}
__device__ __forceinline__ float one_minus_exp(float x) {
    const float s = -x * (1.f + x * (0.5f + x * (0.16666667f + x * (0.041666668f + x * 0.0083333333f))));
    return x > -0.25f ? s : 1.f - __expf(x);
}
template <bool PASS2>
__device__ __forceinline__ void rglru_unit2(const Args& a, int L, int unit, LAS unsigned char* lds) {
    int lane = threadIdx.x & 63; const int wv = __builtin_amdgcn_readfirstlane(threadIdx.x >> 6);
    asm volatile("" : "+v"(lane));
    const int i16 = lane & 15, qp = lane >> 4;
    const bf16_t* P = (const bf16_t*)(a.ws + WS_P); bf16_t* OB = (bf16_t*)(a.ws + WS_OB); float* RS = (float*)(a.ws + WS_RS);
    const bf16_t* WRG = (const bf16_t*)(a.ws + WS_WRG);
    const float* cw = a.in[10] + (size_t)L * 4 * D; const float* cb = a.in[11] + L * D; const float* ba = a.in[13] + L * D;
    const float* bx = a.in[15] + L * D; const float* lam = a.in[16] + L * D;
    const float* conv0 = a.in[4] + (size_t)L * DBATCH * 3 * D; const float* h0 = a.in[5] + (size_t)L * DBATCH * D;
    LAS unsigned char* tile = lds + wv * (64 * RG_TP);
    const int m0 = unit * 64;
    const bool sample = m0 >= MP;
    const int bseq = sample ? 0 : m0 / SEQ, chunk = sample ? 0 : (m0 % SEQ) / 64;
    for (int bb = 0; bb < 2; ++bb) {
        const int bk = 2 * wv + bb, c0 = 64 * bk;
        bf16x8_t af[4][2];
#pragma unroll
        for (int ks = 0; ks < 2; ++ks) {
            const int cc = c0 + 32 * ks + 8 * qp;
            f32x4 w0[2], w1[2], w2[2], w3[2], wb[2];
#pragma unroll
            for (int hh = 0; hh < 2; ++hh) { w0[hh] = *(const f32x4*)(cw + 0 * D + cc + 4 * hh); w1[hh] = *(const f32x4*)(cw + 1 * D + cc + 4 * hh); w2[hh] = *(const f32x4*)(cw + 2 * D + cc + 4 * hh);
                w3[hh] = *(const f32x4*)(cw + 3 * D + cc + 4 * hh); wb[hh] = *(const f32x4*)(cb + cc + 4 * hh); }
#pragma unroll
            for (int mt = 0; mt < 4; ++mt) {
                const int tok = 16 * mt + i16; const size_t m = (size_t)m0 + tok;
                const int tseq = sample ? (tok & 7) : (chunk * 64 + tok);
                float xv[4][8];
#pragma unroll
                for (int k = 0; k < 4; ++k) {
                    const int back = 3 - k;
                    const bool ok = tseq - back >= 0;
                    const u32x4 v = *(const u32x4*)(P + (m - (ok ? back : 0)) * NP + CRNN + cc);
                    const unsigned w4[4] = {v.x, v.y, v.z, v.w};
#pragma unroll
                    for (int e = 0; e < 8; ++e) xv[k][e] = ok ? __uint_as_float((e & 1) ? (w4[e >> 1] & 0xffff0000u) : (w4[e >> 1] << 16)) : 0.f;
                    if (sample && back > 0) {
                        const int b = (int)(m - MP) >> 3; const int ci = ok ? 0 : 3 + tseq - back;
                        const float* cp = conv0 + ((size_t)b * 3 + ci) * D + cc;
                        const f32x4 v0 = *(const f32x4*)cp, v1 = *(const f32x4*)(cp + 4);
#pragma unroll
                        for (int e = 0; e < 4; ++e) { xv[k][e] = ok ? xv[k][e] : v0[e]; xv[k][4 + e] = ok ? xv[k][4 + e] : v1[e]; }
                    }
                }
                float xc[8];
#pragma unroll
                for (int e = 0; e < 8; ++e) xc[e] = wb[e >> 2][e & 3] + w0[e >> 2][e & 3] * xv[0][e] + w1[e >> 2][e & 3] * xv[1][e] + w2[e >> 2][e & 3] * xv[2][e] + w3[e >> 2][e & 3] * xv[3][e];
                const u32x4 pk = (u32x4){pk2bf(xc[0], xc[1]), pk2bf(xc[2], xc[3]), pk2bf(xc[4], xc[5]), pk2bf(xc[6], xc[7])};
                af[mt][ks] = __builtin_bit_cast(bf16x8_t, pk);
                *(LAS u32x4*)(tile + tok * RG_TP + (32 * ks + 8 * qp) * 2) = pk;
            }
        }
        LDSW();
#pragma unroll 1
        for (int nt = 0; nt < 4; ++nt) {
            const int j = 16 * nt + i16, c = c0 + j;
            bf16x8_t ba_[2], bx_[2];
#pragma unroll
            for (int ks = 0; ks < 2; ++ks) { ba_[ks] = *(const bf16x8_t*)(WRG + ((size_t)(0 * 16 + bk) * 64 + j) * 64 + 32 * ks + 8 * qp); bx_[ks] = *(const bf16x8_t*)(WRG + ((size_t)(1 * 16 + bk) * 64 + j) * 64 + 32 * ks + 8 * qp); }
            const float bac = ba[c], bxc = bx[c], spl = softplusf_(-lam[c]);
            float av[4][4], uv[4][4];
#pragma unroll
            for (int mt = 0; mt < 4; ++mt) {
                f32x4 ar = (f32x4){0.f, 0.f, 0.f, 0.f}, ai = ar;
#pragma unroll
                for (int ks = 0; ks < 2; ++ks) { ar = __builtin_amdgcn_mfma_f32_16x16x32_bf16(af[mt][ks], ba_[ks], ar, 0, 0, 0); ai = __builtin_amdgcn_mfma_f32_16x16x32_bf16(af[mt][ks], bx_[ks], ai, 0, 0, 0); }
                const u32x2 xcp = tr_read4(tile + (16 * mt + 4 * qp + (i16 >> 2)) * RG_TP + (16 * nt + 4 * (i16 & 3)) * 2);
#pragma unroll
                for (int r = 0; r < 4; ++r) {
                    const unsigned xw = r < 2 ? xcp.x : xcp.y;
                    const float xcv = __uint_as_float((r & 1) ? (xw & 0xffff0000u) : (xw << 16));
                    const float rg = sigmoidf_(ar[r] + bac), ig = sigmoidf_(ai[r] + bxc);
                    const float log_a = -8.f * rg * spl;
                    av[mt][r] = __expf(log_a);
                    uv[mt][r] = sqrtf(one_minus_exp(2.f * log_a)) * (ig * xcv);
                }
            }
            float H = 0.f, Atot = 1.f;
            if (PASS2 && !sample && chunk > 0) H = RS[(((size_t)bseq * 128 + chunk) * D + c) * 2 + 1];
#pragma unroll
            for (int mt = 0; mt < 4; ++mt) {
                const float As = av[mt][0] * av[mt][1] * av[mt][2] * av[mt][3];
                const float Bs = ((uv[mt][0] * av[mt][1] + uv[mt][1]) * av[mt][2] + uv[mt][2]) * av[mt][3] + uv[mt][3];
                float Aq[4], Bq[4];
#pragma unroll
                for (int q = 0; q < 4; ++q) { Aq[q] = __shfl(As, i16 + 16 * q); Bq[q] = __shfl(Bs, i16 + 16 * q); }
                float hs;
                if (!sample) {
                    const float h1 = Aq[0] * H + Bq[0], h2 = Aq[1] * h1 + Bq[1], h3 = Aq[2] * h2 + Bq[2];
                    hs = qp == 0 ? H : (qp == 1 ? h1 : (qp == 2 ? h2 : h3));
                    H = Aq[3] * h3 + Bq[3]; Atot *= Aq[0] * Aq[1] * Aq[2] * Aq[3];
                } else {
                    const int b0 = ((m0 - MP) >> 3) + 2 * mt;
                    const float hA = h0[(size_t)b0 * D + c], hB = h0[(size_t)(b0 + 1) * D + c];
                    const float hA1 = Aq[0] * hA + Bq[0], hB1 = Aq[2] * hB + Bq[2];
                    hs = qp == 0 ? hA : (qp == 1 ? hA1 : (qp == 2 ? hB : hB1));
                    if (PASS2 && qp == 0) {
                        a.out[O_SH + ((size_t)L * DBATCH + b0) * D + c] = Aq[1] * hA1 + Bq[1];
                        a.out[O_SH + ((size_t)L * DBATCH + b0 + 1) * D + c] = Aq[3] * hB1 + Bq[3];
                    }
                }
                if (PASS2) {
                    float h = hs;
#pragma unroll
                    for (int r = 0; r < 4; ++r) { h = av[mt][r] * h + uv[mt][r]; OB[((size_t)m0 + 16 * mt + 4 * qp + r) * D + c] = f2bf(h); }
                }
            }
            if (!sample && qp == 0) {
                if (!PASS2) *(float2*)(RS + (((size_t)bseq * 128 + chunk) * D + c) * 2) = make_float2(Atot, H);
                else if (chunk == 127) a.out[O_PH + ((size_t)L * NBATCH + bseq) * D + c] = H;
            }
        }
        LDSW();
    }
    if (PASS2) {
        const int t = threadIdx.x;
        if (sample) {
            for (int i = t; i < 8 * 3 * D; i += NTHREADS) { const int s = i / (3 * D), k = (i / D) % 3, c = i % D; const int b = ((m0 - MP) >> 3) + s;
                a.out[O_SCONV + (((size_t)L * DBATCH + b) * 3 + k) * D + c] = bf2f(P[((size_t)MP + b * DSEQ + 5 + k) * NP + CRNN + c]); }
        } else if (chunk == 127) {
            for (int i = t; i < 3 * D; i += NTHREADS) { const int k = i / D, c = i % D;
                a.out[O_PCONV + (((size_t)L * NBATCH + bseq) * 3 + k) * D + c] = bf2f(P[((size_t)m0 + 61 + k) * NP + CRNN + c]); }
        }
    }
}
__device__ __forceinline__ void rglru_prefix(const Args& a) {
    float* RS = (float*)(a.ws + WS_RS);
    const int gid = blockIdx.x * NTHREADS + threadIdx.x;
    if (gid >= NBATCH * D) return;
    const int b = gid / D, c = gid % D;
    float h = 0.f;
    for (int c0 = 0; c0 < 128; c0 += 16) {
        float2 ab[16];
#pragma unroll
        for (int i = 0; i < 16; ++i) ab[i] = *(const float2*)(RS + (((size_t)b * 128 + c0 + i) * D + c) * 2);
#pragma unroll
        for (int i = 0; i < 16; ++i) { RS[(((size_t)b * 128 + c0 + i) * D + c) * 2 + 1] = h; h = ab[i].x * h + ab[i].y; }
    }
}


constexpr int AT_KPB = 144;
constexpr int AT_VPB = 528;
constexpr int AT_K_OFF = 0, AT_V_OFF = 256 * AT_KPB;
constexpr int AT_LDS = AT_V_OFF + 64 * AT_VPB;

template <bool SAMPLE>
__device__ __forceinline__ void attn_unit(const bf16_t* __restrict__ P, bf16_t* OA, const float* __restrict__ sinks, const float* __restrict__ ck, const float* __restrict__ cv,
                                          int b, int qb, int c, LAS unsigned char* lds) {
    const int tid = threadIdx.x, lane = tid & 63, wv = __builtin_amdgcn_readfirstlane(tid >> 6), i16 = lane & 15, qp = lane >> 4;
    LAS unsigned char* ldsK = lds + AT_K_OFF; LAS unsigned char* ldsV = lds + AT_V_OFF;
    if (!SAMPLE) {
        const size_t row_base = (size_t)b * SEQ + (size_t)(qb - 1) * 128;
#pragma unroll
        for (int it = 0; it < 4; ++it) {
            const int ci = tid + 512 * it, s = ci >> 3, part = ci & 7;
            u32x4 kv = (u32x4){0u, 0u, 0u, 0u}, vv = (u32x4){0u, 0u, 0u, 0u};
            if (qb > 0 || s >= 128) {
                const bf16_t* pr = P + (row_base + s) * NP;
                kv = *(const u32x4*)(pr + CK + 64 * c + 8 * part);
                vv = *(const u32x4*)(pr + CV + 64 * c + 8 * part);
            }
            *(LAS u32x4*)(ldsK + s * AT_KPB + part * 16) = kv;
            const unsigned w4[4] = {vv.x, vv.y, vv.z, vv.w};
#pragma unroll
            for (int e = 0; e < 8; ++e) *(LAS unsigned short*)(ldsV + (8 * part + e) * AT_VPB + 2 * s) = (unsigned short)((w4[e >> 1] >> (16 * (e & 1))) & 0xffffu);
        }
    } else {
        for (int ci = tid; ci < 144 * 16; ci += 512) {
            const int s = ci >> 4, part = ci & 15;
            float kf[4] = {0.f, 0.f, 0.f, 0.f}, vf[4] = {0.f, 0.f, 0.f, 0.f};
            if (s < 128) {
                const f32x4 k4 = *(const f32x4*)(ck + ((size_t)(b * 128 + s) * 4 + c) * 64 + 4 * part);
                const f32x4 v4 = *(const f32x4*)(cv + ((size_t)(b * 128 + s) * 4 + c) * 64 + 4 * part);
#pragma unroll
                for (int e = 0; e < 4; ++e) { kf[e] = k4[e]; vf[e] = v4[e]; }
            } else if (s < 136) {
                const bf16_t* pr = P + (size_t)(MP + b * DSEQ + (s - 128)) * NP;
#pragma unroll
                for (int e = 0; e < 4; ++e) { kf[e] = bf2f(pr[CK + 64 * c + 4 * part + e]); vf[e] = bf2f(pr[CV + 64 * c + 4 * part + e]); }
            }
            u32x2 kw; kw.x = pk2bf(kf[0], kf[1]); kw.y = pk2bf(kf[2], kf[3]);
            *(LAS u32x2*)(ldsK + s * AT_KPB + part * 8) = kw;
#pragma unroll
            for (int e = 0; e < 4; ++e) *(LAS unsigned short*)(ldsV + (4 * part + e) * AT_VPB + 2 * s) = f2bf(vf[e]);
        }
    }
    __syncthreads();
    const int n_mt = SAMPLE ? 1 : 4;
    if (!SAMPLE || wv < 2) {
        for (int mt = 0; mt < n_mt; ++mt) {
            int h, tq, nt0; size_t qrow;
            if (!SAMPLE) { const int g = wv >> 1, qh = wv & 1; h = 4 * c + g; tq = 64 * qh + 16 * mt + i16; nt0 = (64 * qh + 16 * mt) >> 4; qrow = (size_t)b * SEQ + (size_t)qb * 128 + tq; }
            else { const int rho = 16 * wv + i16; h = 4 * c + (rho >> 3); tq = rho & 7; nt0 = 0; qrow = (size_t)MP + b * DSEQ + tq; }
            const float slope = exp2f(-0.5f * (float)(h + 1)), sink = sinks[h];
            bf16x8_t qf[2];
#pragma unroll
            for (int ks = 0; ks < 2; ++ks) qf[ks] = *(const bf16x8_t*)(P + qrow * NP + CQ + 64 * h + 32 * ks + 8 * qp);
            f32x4 sc[9];
#pragma unroll
            for (int jn = 0; jn < 9; ++jn) {
                const int nt = nt0 + jn;
                f32x4 acc = (f32x4){0.f, 0.f, 0.f, 0.f};
                if (SAMPLE || qb > 0 || nt >= 8) {
#pragma unroll
                    for (int ks = 0; ks < 2; ++ks) {
                        const bf16x8_t kfr = *(const LAS bf16x8_t*)(ldsK + (16 * nt + i16) * AT_KPB + (32 * ks + 8 * qp) * 2);
                        acc = __builtin_amdgcn_mfma_f32_16x16x32_bf16(kfr, qf[ks], acc, 0, 0, 0);
                    }
                }
#pragma unroll
                for (int r = 0; r < 4; ++r) {
                    const int sidx = 16 * nt + 4 * qp + r;
                    const int rel = 128 + tq - sidx;
                    bool valid = rel >= 0 && rel < 128;
                    if (!SAMPLE) valid = valid && (qb > 0 || sidx >= 128);
                    acc[r] = valid ? acc[r] * 0.125f - slope * (float)rel : -INFINITY;
                }
                sc[jn] = acc;
            }
            float mx = sink;
#pragma unroll
            for (int jn = 0; jn < 9; ++jn)
#pragma unroll
                for (int r = 0; r < 4; ++r) mx = fmaxf(mx, sc[jn][r]);
            mx = fmaxf(mx, __shfl_xor(mx, 16)); mx = fmaxf(mx, __shfl_xor(mx, 32));
            float sum = 0.f;
#pragma unroll
            for (int jn = 0; jn < 9; ++jn)
#pragma unroll
                for (int r = 0; r < 4; ++r) { const float e = __expf(sc[jn][r] - mx); sc[jn][r] = e; sum += e; }
            sum += __shfl_xor(sum, 16); sum += __shfl_xor(sum, 32);
            const float inv = 1.f / (sum + __expf(sink - mx));
            bf16x8_t pf[5];
#pragma unroll
            for (int ks = 0; ks < 5; ++ks) {
                u32x4 w;
                w.x = pk2bf(sc[2 * ks][0] * inv, sc[2 * ks][1] * inv); w.y = pk2bf(sc[2 * ks][2] * inv, sc[2 * ks][3] * inv);
                if (ks < 4) { w.z = pk2bf(sc[2 * ks + 1][0] * inv, sc[2 * ks + 1][1] * inv); w.w = pk2bf(sc[2 * ks + 1][2] * inv, sc[2 * ks + 1][3] * inv); }
                else { w.z = 0u; w.w = 0u; }
                pf[ks] = __builtin_bit_cast(bf16x8_t, w);
            }
#pragma unroll
            for (int dt = 0; dt < 4; ++dt) {
                f32x4 o = (f32x4){0.f, 0.f, 0.f, 0.f};
#pragma unroll
                for (int ks = 0; ks < 5; ++ks) {
                    const int ntA = nt0 + 2 * ks, ntB = (ks < 4) ? nt0 + 2 * ks + 1 : nt0 + 2 * ks;
                    const LAS unsigned char* vr = ldsV + (16 * dt + i16) * AT_VPB;
                    const u32x2 lo = *(const LAS u32x2*)(vr + 2 * (16 * ntA + 4 * qp));
                    const u32x2 hi = *(const LAS u32x2*)(vr + 2 * (16 * ntB + 4 * qp));
                    const u32x4 w = (u32x4){lo.x, lo.y, hi.x, hi.y};
                    o = __builtin_amdgcn_mfma_f32_16x16x32_bf16(__builtin_bit_cast(bf16x8_t, w), pf[ks], o, 0, 0, 0);
                }
                u32x2 ow; ow.x = pk2bf(o[0], o[1]); ow.y = pk2bf(o[2], o[3]);
                *(u32x2*)(OA + qrow * D + 64 * h + 16 * dt + 4 * qp) = ow;
            }
        }
    }
    __syncthreads();
}

template <bool PASS2>
__device__ __forceinline__ void rglru_unit(const Args& a, int L, int unit, LAS unsigned char* lds) {
    const int tid = threadIdx.x, lane = tid & 63, wv = __builtin_amdgcn_readfirstlane(tid >> 6);
    const bf16_t* P = (const bf16_t*)(a.ws + WS_P); bf16_t* OB = (bf16_t*)(a.ws + WS_OB); float* RS = (float*)(a.ws + WS_RS);
    const float* cw = a.in[10] + (size_t)L * 4 * D; const float* cb = a.in[11] + L * D; const float* wa = a.in[12] + (size_t)L * 16 * 4096; const float* ba = a.in[13] + L * D;
    const float* wx = a.in[14] + (size_t)L * 16 * 4096; const float* bx = a.in[15] + L * D; const float* lam = a.in[16] + L * D;
    const float* conv0 = a.in[4] + (size_t)L * DBATCH * 3 * D; const float* h0 = a.in[5] + (size_t)L * DBATCH * D;
    LAS float* s_xc = (LAS float*)lds + wv * 64;
    const int m0 = unit * 64;
    const bool sample = m0 >= MP;
    for (int bb = 0; bb < 2; ++bb) {
        const int bk = 2 * wv + bb, c = 64 * bk + lane;
        float war[64], wxr[64];
#pragma unroll
        for (int i = 0; i < 64; ++i) { war[i] = wa[((size_t)bk * 64 + i) * 64 + lane]; wxr[i] = wx[((size_t)bk * 64 + i) * 64 + lane]; }
        const float c0 = cw[0 * D + c], c1 = cw[1 * D + c], c2 = cw[2 * D + c], c3 = cw[3 * D + c], cbc = cb[c], bac = ba[c], bxc = bx[c];
        const float spl = softplusf_(-lam[c]);
        float x1 = 0.f, x2 = 0.f, x3 = 0.f, h = 0.f, Ap = 1.f;
        int bseq = 0, chunk = 0;
        if (!sample) {
            bseq = m0 / SEQ; chunk = (m0 % SEQ) / 64;
            if (chunk > 0) {
                x1 = bf2f(P[(size_t)(m0 - 1) * NP + CRNN + c]); x2 = bf2f(P[(size_t)(m0 - 2) * NP + CRNN + c]); x3 = bf2f(P[(size_t)(m0 - 3) * NP + CRNN + c]);
                if (PASS2) { for (int cc = 0; cc < chunk; ++cc) { const float2 ab = *(const float2*)(RS + (((size_t)bseq * 128 + cc) * D + c) * 2); h = ab.x * h + ab.y; } }
            }
        }
        for (int t = 0; t < 64; ++t) {
            const size_t m = (size_t)m0 + t;
            if (sample && (t & 7) == 0) {
                if (!PASS2) break;
                const int b = (int)(m - MP) >> 3;
                x3 = conv0[((size_t)b * 3 + 0) * D + c]; x2 = conv0[((size_t)b * 3 + 1) * D + c]; x1 = conv0[((size_t)b * 3 + 2) * D + c]; h = h0[(size_t)b * D + c];
            }
            const float x = bf2f(P[m * NP + CRNN + c]);
            const float xc = cbc + c0 * x3 + c1 * x2 + c2 * x1 + c3 * x;
            LDSW(); s_xc[lane] = xc; LDSW();
            float r = bac, ig = bxc;
#pragma unroll
            for (int i4 = 0; i4 < 16; ++i4) { const f32x4 xv = *(const LAS f32x4*)(s_xc + 4 * i4);
#pragma unroll
                for (int e = 0; e < 4; ++e) { r += xv[e] * war[4 * i4 + e]; ig += xv[e] * wxr[4 * i4 + e]; } }
            r = sigmoidf_(r); ig = sigmoidf_(ig);
            const float log_a = -8.f * r * spl;
            const float av = __expf(log_a);
            const float u = sqrtf(-expm1f(2.f * log_a)) * (ig * xc);
            h = av * h + u; Ap *= av;
            if (PASS2) OB[m * D + c] = f2bf(h);
            x3 = x2; x2 = x1; x1 = x;
            if (PASS2 && sample && (t & 7) == 7) {
                const int b = (int)(m - MP) >> 3;
                float* oc = a.out + O_SCONV + ((size_t)L * DBATCH + b) * 3 * D; float* oh = a.out + O_SH + ((size_t)L * DBATCH + b) * D;
                oh[c] = h; oc[0 * D + c] = x3; oc[1 * D + c] = x2; oc[2 * D + c] = x1;
            }
        }
        if (!sample) {
            if (!PASS2) { *(float2*)(RS + (((size_t)bseq * 128 + chunk) * D + c) * 2) = make_float2(Ap, h); }
            else if (chunk == 127) {
                float* oc = a.out + O_PCONV + ((size_t)L * NBATCH + bseq) * 3 * D; float* oh = a.out + O_PH + ((size_t)L * NBATCH + bseq) * D;
                oh[c] = h; oc[0 * D + c] = x3; oc[1 * D + c] = x2; oc[2 * D + c] = x1;
            }
        }
    }
}

__device__ __forceinline__ void phase_elem_mixa(const Args& a, int L) {
    const bf16_t* P = (const bf16_t*)(a.ws + WS_P); bf16_t* AC = (bf16_t*)(a.ws + WS_ACAT);
    const float* mu = a.in[17] + (size_t)L * SHIFT_W; const float* shift0 = a.in[6] + (size_t)L * DBATCH * SHIFT_W;
    const size_t gt = (size_t)blockIdx.x * NTHREADS + threadIdx.x, gs = (size_t)gridDim.x * NTHREADS;
    for (size_t i = gt; i < (size_t)M * ACAT_K; i += gs) {
        const size_t m = i / ACAT_K; const int j = (int)(i % ACAT_K);
        float o = 0.f;
        if (j < 288) {
            const int ch = 3072 + j;
            const float pc = bf2f(P[m * NP + CRW + ch]);
            float pv;
            if (m < MP) pv = (m % SEQ) == 0 ? 0.f : bf2f(P[(m - 1) * NP + CRW + ch]);
            else pv = ((m - MP) % DSEQ) == 0 ? shift0[((m - MP) / DSEQ) * SHIFT_W + ch] : bf2f(P[(m - 1) * NP + CRW + ch]);
            const float ps = pc + mu[ch] * (pv - pc);
            o = j < 64 ? 1.f - 2.f / (__expf(2.f * ps) + 1.f) : (j < 128 ? ps : sigmoidf_(ps));
        }
        AC[i] = f2bf(o);
    }
}
__device__ __forceinline__ void phase_state_copies(const Args& a, int L, int first) {
    const bf16_t* P = (const bf16_t*)(a.ws + WS_P);
    if ((int)blockIdx.x < first) return;
    const size_t gt = (size_t)(blockIdx.x - first) * NTHREADS + threadIdx.x, gs = (size_t)(gridDim.x - first) * NTHREADS;
    const float* ck = a.in[2] + (size_t)L * DBATCH * 128 * 256; const float* cv = a.in[3] + (size_t)L * DBATCH * 128 * 256;
    float* pk = a.out + O_PK + (size_t)L * NBATCH * 128 * 256; float* pv_ = a.out + O_PV + (size_t)L * NBATCH * 128 * 256;
    float* pshift = a.out + O_PSHIFT + (size_t)L * NBATCH * SHIFT_W; float* sk = a.out + O_SK + (size_t)L * DBATCH * 128 * 256; float* sv = a.out + O_SV + (size_t)L * DBATCH * 128 * 256;
    float* sshift = a.out + O_SSHIFT + (size_t)L * DBATCH * SHIFT_W;
    const size_t n_pk = (size_t)NBATCH * 128 * 256, n_sk = (size_t)DBATCH * 128 * 256, n_ps = (size_t)NBATCH * SHIFT_W, n_ss = (size_t)DBATCH * SHIFT_W;
    for (size_t i = gt; i < n_pk + n_sk + n_ps + n_ss; i += gs) {
        if (i < n_pk) {
            const int b = (int)(i / (128 * 256)), s = (int)((i / 256) % 128), e = (int)(i % 256);
            const size_t row = (size_t)b * SEQ + (SEQ - 128) + s;
            pk[i] = bf2f(P[row * NP + CK + e]); pv_[i] = bf2f(P[row * NP + CV + e]);
            continue;
        }
        size_t k = i - n_pk;
        if (k < n_sk) {
            const int b = (int)(k / (128 * 256)), s = (int)((k / 256) % 128), e = (int)(k % 256);
            if (s < 120) { sk[k] = ck[((size_t)b * 128 + s + 8) * 256 + e]; sv[k] = cv[((size_t)b * 128 + s + 8) * 256 + e]; }
            else { const size_t row = (size_t)MP + b * DSEQ + (s - 120); sk[k] = bf2f(P[row * NP + CK + e]); sv[k] = bf2f(P[row * NP + CV + e]); }
            continue;
        }
        k -= n_sk;
        if (k < n_ps) { const int b = (int)(k / SHIFT_W), ch = (int)(k % SHIFT_W); pshift[k] = bf2f(P[((size_t)b * SEQ + SEQ - 1) * NP + CRW + ch]); continue; }
        k -= n_ps;
        { const int b = (int)(k / SHIFT_W), ch = (int)(k % SHIFT_W); sshift[k] = bf2f(P[((size_t)MP + b * DSEQ + DSEQ - 1) * NP + CRW + ch]); }
    }
}

#ifndef PROBE_MIXA
#define PROBE_MIXA 0
#endif
__device__ __forceinline__ void phase_mixa(const Args& a, int L, LAS unsigned char* lds) {
    const bf16_t* P = (const bf16_t*)(a.ws + WS_P); bf16_t* OA = (bf16_t*)(a.ws + WS_OA);
    const float* sinks = a.in[9] + L * 16; const float* ck = a.in[2] + (size_t)L * DBATCH * 128 * 256; const float* cv = a.in[3] + (size_t)L * DBATCH * 128 * 256;
    constexpr int N_RG1 = MP / 64, N_AP = NBATCH * 64 * 4, N_AS = DBATCH * 4;
    phase_elem_mixa(a, L);
    if (PROBE_MIXA & 1) phase_elem_mixa(a, L);
    for (int it = blockIdx.x; it < N_RG1; it += gridDim.x) { rglru_unit2<false>(a, L, it, lds); __syncthreads(); }
    if (PROBE_MIXA & 2) for (int it = blockIdx.x; it < N_RG1; it += gridDim.x) { rglru_unit2<false>(a, L, it, lds); __syncthreads(); }
    for (int r = blockIdx.x; r < N_AP; r += gridDim.x) { const int c = r & 3, qb = (r >> 2) & 63, b = r >> 8; attn_unit<false>(P, OA, sinks, ck, cv, b, qb, c, lds); }
    if (PROBE_MIXA & 4) for (int r = blockIdx.x; r < N_AP; r += gridDim.x) { const int c = r & 3, qb = (r >> 2) & 63, b = r >> 8; attn_unit<false>(P, OA, sinks, ck, cv, b, qb, c, lds); }
    for (int r = blockIdx.x; r < N_AS; r += gridDim.x) { const int c = r & 3, b = r >> 2; attn_unit<true>(P, OA, sinks, ck, cv, b, 0, c, lds); }
    if (PROBE_MIXA & 8) for (int r = blockIdx.x; r < N_AS; r += gridDim.x) { const int c = r & 3, b = r >> 2; attn_unit<true>(P, OA, sinks, ck, cv, b, 0, c, lds); }
}

struct EpiLora {
    static constexpr bool PERM = true, AFTER_DRAIN = false;
    bf16_t* WAW; bf16_t* WAA; bf16_t* WAG; const float* w0; const float* a0;
    __device__ __forceinline__ void operator()(const f32x4 (&acc)[2][2][4][2], const pg8::Unit& u, int wr, int wc, int fr, int fq) const {
        const int row0 = u.pm * 256 + wr * 64 + fr, kind = u.pn >> 2, colb = (u.pn & 3) * 256 + wc * 32 + 8 * fq;
        const float* bsrc = kind == 0 ? w0 : a0;
        f32x4 bias[2][2];
#pragma unroll
        for (int bj = 0; bj < 2; ++bj)
#pragma unroll
            for (int n = 0; n < 2; ++n) bias[bj][n] = kind == 2 ? (f32x4){0.f, 0.f, 0.f, 0.f} : *(const f32x4*)(bsrc + colb + bj * 128 + 4 * n);
#pragma unroll
        for (int ai = 0; ai < 2; ++ai)
#pragma unroll
            for (int m = 0; m < 4; ++m) {
                const size_t off = (size_t)(row0 + ai * 128 + m * 16) * D + colb;
#pragma unroll
                for (int bj = 0; bj < 2; ++bj) {
                    f32x4 v0 = acc[ai][bj][m][0] + bias[bj][0], v1 = acc[ai][bj][m][1] + bias[bj][1];
                    if (kind == 0) {
#pragma unroll
                        for (int i = 0; i < 4; ++i) {
                            v0[i] = -__expf(-(fmaxf(-v0[i], 0.f) + __logf(1.f + __expf(-fabsf(v0[i])))) - 0.5f);
                            v1[i] = -__expf(-(fmaxf(-v1[i], 0.f) + __logf(1.f + __expf(-fabsf(v1[i])))) - 0.5f);
                        }
                    } else if (kind == 1) {
#pragma unroll
                        for (int i = 0; i < 4; ++i) { v0[i] = sigmoidf_(v0[i]); v1[i] = sigmoidf_(v1[i]); }
                    }
                    u32x4 w; w.x = pk2bf(v0[0], v0[1]); w.y = pk2bf(v0[2], v0[3]); w.z = pk2bf(v1[0], v1[1]); w.w = pk2bf(v1[2], v1[3]);
                    *(u32x4*)(WAW + (size_t)kind * ((size_t)M * D) + off + bj * 128) = w;
                }
                asm volatile("" ::: "memory");
            }
    }
};

__device__ __forceinline__ void phase_mixc(const Args& a, int L, bf16_t* DST) {
    const int lane = threadIdx.x & 63, wv = threadIdx.x >> 6;
    const bf16_t* P = (const bf16_t*)(a.ws + WS_P); const bf16_t* WAG = (const bf16_t*)(a.ws + WS_WAG); const bf16_t* Y = (const bf16_t*)(a.ws + WS_Y); const float* BD = (const float*)(a.ws + WS_BD);
    bf16_t* OA = (bf16_t*)(a.ws + WS_OA); const bf16_t* OB = (const bf16_t*)(a.ws + WS_OB);
    const float* mu = a.in[17] + (size_t)L * SHIFT_W + 2048; const float* shift0 = a.in[6] + (size_t)L * DBATCH * SHIFT_W + 2048;
    const int c0 = 16 * lane, h = lane >> 2;
    float lw[16], lb[16], muv[16];
#pragma unroll
    for (int i = 0; i < 16; ++i) { lw[i] = a.in[26][L * D + c0 + i]; lb[i] = a.in[27][L * D + c0 + i]; muv[i] = mu[c0 + i]; }
    for (int m = blockIdx.x * NWAVES + wv; m < M; m += gridDim.x * NWAVES) {
        float y[16];
        { u32x4 yv[2]; yv[0] = *(const u32x4*)(Y + (size_t)m * D + c0); yv[1] = *(const u32x4*)(Y + (size_t)m * D + c0 + 8);
#pragma unroll
          for (int i = 0; i < 16; ++i) y[i] = __uint_as_float((i & 1) ? (yv[i >> 3][(i >> 1) & 3] & 0xffff0000u) : (yv[i >> 3][(i >> 1) & 3] << 16)); }
        float s = 0.f;
#pragma unroll
        for (int i = 0; i < 16; ++i) s += y[i];
        s += __shfl_xor(s, 1); s += __shfl_xor(s, 2);
        const float mean = s * (1.f / 64.f);
        float q = 0.f;
#pragma unroll
        for (int i = 0; i < 16; ++i) { y[i] -= mean; q += y[i] * y[i]; }
        q += __shfl_xor(q, 1); q += __shfl_xor(q, 2);
        const float rstd = rsqrtf(q * (1.f / 64.f) + GN_EPS);
        const float bd = BD[(size_t)m * 16 + h];
        const bool first = m < MP ? (m % SEQ) == 0 : ((m - MP) % DSEQ) == 0;
        const bf16_t* pr = P + (size_t)m * NP + CRW + 2048 + c0;
#define BFX(v, i) __uint_as_float((((i) & 1) ? ((v)[(i) >> 3][((i) >> 1) & 3] & 0xffff0000u) : ((v)[(i) >> 3][((i) >> 1) & 3] << 16)))
        u32x4 pcv[2], ppv[2], gv[2], gav[2], gbv[2], gcv[2], oav[2], obv[2];
        pcv[0] = *(const u32x4*)pr; pcv[1] = *(const u32x4*)(pr + 8);
        ppv[0] = pcv[0]; ppv[1] = pcv[1];
        if (!first) { ppv[0] = *(const u32x4*)(pr - NP); ppv[1] = *(const u32x4*)(pr - NP + 8); }
        gv[0] = *(const u32x4*)(WAG + (size_t)m * D + c0); gv[1] = *(const u32x4*)(WAG + (size_t)m * D + c0 + 8);
        const bf16_t* pg = P + (size_t)m * NP + CG + c0;
        gav[0] = *(const u32x4*)pg; gav[1] = *(const u32x4*)(pg + 8);
        gbv[0] = *(const u32x4*)(pg + 1024); gbv[1] = *(const u32x4*)(pg + 1024 + 8);
        gcv[0] = *(const u32x4*)(pg + 2048); gcv[1] = *(const u32x4*)(pg + 2048 + 8);
        oav[0] = *(const u32x4*)(OA + (size_t)m * D + c0); oav[1] = *(const u32x4*)(OA + (size_t)m * D + c0 + 8);
        obv[0] = *(const u32x4*)(OB + (size_t)m * D + c0); obv[1] = *(const u32x4*)(OB + (size_t)m * D + c0 + 8);
        float o[16];
#pragma unroll
        for (int i = 0; i < 16; ++i) {
            const float pc = BFX(pcv, i);
            float pv;
            if (first) pv = m < MP ? 0.f : shift0[(size_t)((m - MP) / DSEQ) * SHIFT_W + c0 + i];
            else pv = BFX(ppv, i);
            const float vv = pc + muv[i] * (pv - pc);
            const float yn = y[i] * rstd * lw[i] + lb[i];
            const float oc = (yn + bd * vv) * BFX(gv, i);
            o[i] = BFX(gav, i) * BFX(oav, i) + BFX(gbv, i) * BFX(obv, i) + BFX(gcv, i) * oc;
        }
        u32x4 w0, w1;
        w0.x = pk2bf(o[0], o[1]); w0.y = pk2bf(o[2], o[3]); w0.z = pk2bf(o[4], o[5]); w0.w = pk2bf(o[6], o[7]);
        w1.x = pk2bf(o[8], o[9]); w1.y = pk2bf(o[10], o[11]); w1.z = pk2bf(o[12], o[13]); w1.w = pk2bf(o[14], o[15]);
        *(u32x4*)(DST + (size_t)m * D + c0) = w0; *(u32x4*)(DST + (size_t)m * D + c0 + 8) = w1;
    }
}

constexpr int CH_OFF_AA = 0, CH_OFF_RA = 2048, CH_OFF_MC = 4096, CH_OFF_TL = 5120  , CH_OFF_BT = 5632, CH_OFF_KT = 7808, CH_OFF_VT = 9984, CH_OFF_GM = 12160, CH_SLOT = 12416;
constexpr int CH_TP = 136;
__device__ __forceinline__ float row_prefix16(float x) {
    x += __builtin_bit_cast(float, __builtin_amdgcn_update_dpp(0, __builtin_bit_cast(int, x), 0x111, 0xF, 0xF, true));
    x += __builtin_bit_cast(float, __builtin_amdgcn_update_dpp(0, __builtin_bit_cast(int, x), 0x112, 0xF, 0xF, true));
    x += __builtin_bit_cast(float, __builtin_amdgcn_update_dpp(0, __builtin_bit_cast(int, x), 0x114, 0xF, 0xF, true));
    x += __builtin_bit_cast(float, __builtin_amdgcn_update_dpp(0, __builtin_bit_cast(int, x), 0x118, 0xF, 0xF, true));
    return x;
}
__device__ __forceinline__ f32x4 prod16(const f32x4 xt, const f32x4 y) {
    f32x4 z = (f32x4){0.f, 0.f, 0.f, 0.f};
#pragma unroll
    for (int r = 0; r < 4; ++r) z = __builtin_amdgcn_mfma_f32_16x16x4f32(xt[r], y[r], z, 0, 0, 0);
    return z;
}
__device__ __forceinline__ f32x4 gram(const bf16x8_t (&x)[2], const bf16x8_t (&y)[2]) {
    f32x4 z = (f32x4){0.f, 0.f, 0.f, 0.f};
    z = __builtin_amdgcn_mfma_f32_16x16x32_bf16(x[0], y[0], z, 0, 0, 0);
    z = __builtin_amdgcn_mfma_f32_16x16x32_bf16(x[1], y[1], z, 0, 0, 0);
    return z;
}

struct ChunkRaw { u32x2 cr[4], ck[4], cv[4], a[4], x[4]; };
constexpr int CH_PAR_OFF = 8 * CH_SLOT;
constexpr int CH_PAR_BYTES = 6 * 64 * 4;
__device__ __forceinline__ void stage_head_params(const Args& a, int L, int h, LAS unsigned char* par, int lane) {
    LAS float* p = (LAS float*)par; const int c = 64 * h + lane;
    p[lane] = a.in[17][(size_t)L * SHIFT_W + c]; p[64 + lane] = a.in[17][(size_t)L * SHIFT_W + 1024 + c]; p[128 + lane] = a.in[17][(size_t)L * SHIFT_W + 2048 + c];
    p[192 + lane] = a.in[23][L * D + c]; p[256 + lane] = a.in[24][L * D + c]; p[320 + lane] = a.in[25][L * D + c];
}
__device__ __forceinline__ void chunk_load(const Args& a, size_t m0, int h, int ntok, int lane, ChunkRaw& R) {
    asm volatile("" : "+v"(lane));
    const int i16 = lane & 15, qp = lane >> 4;
    const bf16_t* P = (const bf16_t*)(a.ws + WS_P); const bf16_t* WAW = (const bf16_t*)(a.ws + WS_WAW); const bf16_t* WAA = (const bf16_t*)(a.ws + WS_WAA);
    const size_t m = m0 + (i16 < ntok ? i16 : 0);
#pragma unroll
    for (int r = 0; r < 4; ++r) {
        const int c = 64 * h + 16 * r + 4 * qp;
        const bf16_t* pr = P + m * NP + CRW + c;
        R.cr[r] = *(const u32x2*)pr; R.ck[r] = *(const u32x2*)(pr + 1024); R.cv[r] = *(const u32x2*)(pr + 2048);
        R.x[r] = *(const u32x2*)(WAW + m * D + c);
        R.a[r] = *(const u32x2*)(WAA + m * D + c);
    }
}
__device__ __forceinline__ unsigned dpp_prev_row(unsigned old, unsigned src) { return (unsigned)__builtin_amdgcn_update_dpp((int)old, (int)src, 0x111, 0xF, 0xF, false); }
template <class PF> __device__ __forceinline__ void chunk_compute(const Args& a, const ChunkRaw& R, size_t m0, int h, int ntok, bool seq_start, const float* sh0, const LAS unsigned char* par_, LAS unsigned char* slot, int lane, PF pf) {
    asm volatile("" : "+v"(lane));
    const int i16 = lane & 15, qp = lane >> 4;
    float* BD = (float*)(a.ws + WS_BD);
    const LAS float* par = (const LAS float*)par_;
    const bool valid = i16 < ntok;
    const size_t m = m0 + (valid ? i16 : 0);
    u32x2 p0r[4], p0k[4], p0v[4];
    {
        const bf16_t* P = (const bf16_t*)(a.ws + WS_P);
#pragma unroll
        for (int r = 0; r < 4; ++r) {
            const int c = 64 * h + 16 * r + 4 * qp;
            if (!seq_start) { const bf16_t* pp = P + (m0 - 1) * NP + CRW + c; p0r[r] = *(const u32x2*)pp; p0k[r] = *(const u32x2*)(pp + 1024); p0v[r] = *(const u32x2*)(pp + 2048); }
            else if (sh0) { const f32x4 fr_ = *(const f32x4*)(sh0 + c), fk_ = *(const f32x4*)(sh0 + 1024 + c), fv_ = *(const f32x4*)(sh0 + 2048 + c);
                p0r[r] = pk4(fr_[0], fr_[1], fr_[2], fr_[3]); p0k[r] = pk4(fk_[0], fk_[1], fk_[2], fk_[3]); p0v[r] = pk4(fv_[0], fv_[1], fv_[2], fv_[3]); }
            else { p0r[r] = (u32x2){0u, 0u}; p0k[r] = p0r[r]; p0v[r] = p0r[r]; }
        }
    }
    float abu[16], bbu[16];
    u32x2 pa[4], pb[4], pkk[4], prr[4];
    float ssq = 0.f, bdp = 0.f;
#pragma unroll
    for (int r = 0; r < 4; ++r) {
        const int cb = 16 * r + 4 * qp, c = 64 * h + cb;
        const u32x2 cr = R.cr[r], ck_ = R.ck[r], cv_ = R.cv[r], a4 = R.a[r];
        u32x2 pr_, pk_, pv_;
        pr_.x = dpp_prev_row(p0r[r].x, cr.x); pr_.y = dpp_prev_row(p0r[r].y, cr.y); pk_.x = dpp_prev_row(p0k[r].x, ck_.x); pk_.y = dpp_prev_row(p0k[r].y, ck_.y);
        pv_.x = dpp_prev_row(p0v[r].x, cv_.x); pv_.y = dpp_prev_row(p0v[r].y, cv_.y);
        const u32x2 x4 = R.x[r];
        const f32x4 mur = *(const LAS f32x4*)(par + cb), muk = *(const LAS f32x4*)(par + 64 + cb), muv = *(const LAS f32x4*)(par + 128 + cb);
        const f32x4 kkc = *(const LAS f32x4*)(par + 192 + cb), kac = *(const LAS f32x4*)(par + 256 + cb), rkc = *(const LAS f32x4*)(par + 320 + cb);
        float vv[4], kb[4], rb[4];
#pragma unroll
        for (int i = 0; i < 4; ++i) {
            const unsigned wr_ = i < 2 ? cr.x : cr.y, wk_ = i < 2 ? ck_.x : ck_.y, wv_ = i < 2 ? cv_.x : cv_.y, wa_ = i < 2 ? a4.x : a4.y, wx_ = i < 2 ? x4.x : x4.y;
            const unsigned qr_ = i < 2 ? pr_.x : pr_.y, qk_ = i < 2 ? pk_.x : pk_.y, qv_ = i < 2 ? pv_.x : pv_.y;
            const float c_r = __uint_as_float((i & 1) ? (wr_ & 0xffff0000u) : (wr_ << 16)), c_k = __uint_as_float((i & 1) ? (wk_ & 0xffff0000u) : (wk_ << 16)),
                        c_v = __uint_as_float((i & 1) ? (wv_ & 0xffff0000u) : (wv_ << 16)), a_ = __uint_as_float((i & 1) ? (wa_ & 0xffff0000u) : (wa_ << 16));
            const float p_r = __uint_as_float((i & 1) ? (qr_ & 0xffff0000u) : (qr_ << 16)), p_k = __uint_as_float((i & 1) ? (qk_ & 0xffff0000u) : (qk_ << 16)),
                  p_v = __uint_as_float((i & 1) ? (qv_ & 0xffff0000u) : (qv_ << 16));
            float r_ = c_r + mur[i] * (p_r - c_r), kx = c_k + muk[i] * (p_k - c_k), v_ = c_v + muv[i] * (p_v - c_v);
            float lw_ = __uint_as_float((i & 1) ? (wx_ & 0xffff0000u) : (wx_ << 16));
            if (!valid) { r_ = 0.f; kx = 0.f; v_ = 0.f; lw_ = 0.f; }
            const float kkr = kx * kkc[i];
            const float k2_ = kx * (1.f + (a_ - 1.f) * kac[i]);
            ssq += kkr * kkr; bdp += r_ * k2_ * rkc[i];
            const float g = row_prefix16(lw_);
            const float eg = __expf(g), egx = __expf(g - lw_), eng = __expf(-g);
            const int e = 4 * r + i;
            abu[e] = -kkr * egx; bbu[e] = kkr * a_ * eng; kb[i] = k2_ * eng; rb[i] = r_ * eg; vv[i] = v_;
            if (i16 == 15) *(LAS float*)(slot + CH_OFF_GM + 4 * (cb + i)) = eg;
        }
        const int off = i16 * CH_TP + cb * 2;
        pkk[r] = pk4(kb[0], kb[1], kb[2], kb[3]); prr[r] = pk4(rb[0], rb[1], rb[2], rb[3]);
        *(LAS u32x2*)(slot + CH_OFF_VT + off) = pk4(vv[0], vv[1], vv[2], vv[3]);
        *(LAS u32x2*)(slot + CH_OFF_KT + off) = pkk[r];
        asm volatile("" : "+v"(ssq), "+v"(bdp));
        __builtin_amdgcn_sched_barrier(0);
    }
    __builtin_amdgcn_sched_barrier(0);
    pf();
    __builtin_amdgcn_sched_barrier(0);
    ssq += __shfl_xor(ssq, 16); ssq += __shfl_xor(ssq, 32);
    bdp += __shfl_xor(bdp, 16); bdp += __shfl_xor(bdp, 32);
    if (valid && qp == 0) BD[m * 16 + h] = bdp;
    const float inrm = 1.f / fmaxf(sqrtf(ssq), 1e-12f);
#pragma unroll
    for (int r = 0; r < 4; ++r) {
        pa[r] = pk4(abu[4 * r] * inrm, abu[4 * r + 1] * inrm, abu[4 * r + 2] * inrm, abu[4 * r + 3] * inrm);
        pb[r] = pk4(bbu[4 * r] * inrm, bbu[4 * r + 1] * inrm, bbu[4 * r + 2] * inrm, bbu[4 * r + 3] * inrm);
        const int off = i16 * CH_TP + (16 * r + 4 * qp) * 2;
        *(LAS u32x2*)(slot + CH_OFF_AA + off) = pa[r];
        *(LAS u32x2*)(slot + CH_OFF_BT + off) = pb[r];
    }
    __builtin_amdgcn_sched_barrier(0);
    bf16x8_t fa[2], fb[2], fk[2], fr[2];
#pragma unroll
    for (int ks = 0; ks < 2; ++ks) { fa[ks] = mk_frag(pa[2 * ks], pa[2 * ks + 1]); fb[ks] = mk_frag(pb[2 * ks], pb[2 * ks + 1]); fk[ks] = mk_frag(pkk[2 * ks], pkk[2 * ks + 1]); fr[ks] = mk_frag(prr[2 * ks], prr[2 * ks + 1]); }
    f32x4 Lc = gram(fa, fb), Nc = gram(fb, fa), Lak = gram(fa, fk), MrbT = gram(fb, fr), MrkT = gram(fk, fr);
#pragma unroll
    for (int r = 0; r < 4; ++r) {
        const int row = 4 * qp + r;
        Lc[r] = row > i16 ? Lc[r] : 0.f;
        Lak[r] = row > i16 ? Lak[r] : 0.f;
        Nc[r] = row < i16 ? Nc[r] : 0.f;
        MrbT[r] = row <= i16 ? MrbT[r] : 0.f;
        MrkT[r] = row <= i16 ? MrkT[r] : 0.f;
    }
    __builtin_amdgcn_sched_barrier(0);
    f32x4 eye;
#pragma unroll
    for (int r = 0; r < 4; ++r) eye[r] = (4 * qp + r == i16) ? 1.f : 0.f;
    const f32x4 L2 = prod16(Nc, Lc), N2 = prod16(Lc, Nc);
    const f32x4 L4 = prod16(N2, L2), N4 = prod16(L2, N2);
    const f32x4 N8 = prod16(L4, N4);
    const f32x4 Q1 = prod16(Lc + eye, N2 + eye), Q1T = prod16(N2 + eye, Lc + eye), Q2 = prod16(L4 + eye, N8 + eye);
    const f32x4 TT = prod16(Q1T, Q2);
    const f32x4 TLk = prod16(Lak, TT);
    __builtin_amdgcn_sched_barrier(0);
    LDSW();
    const bf16x8_t ttf = mk_frag(pk4(TT[0], TT[1], TT[2], TT[3]), (u32x2){0u, 0u});
    f32x4 at[4];
#pragma unroll
    for (int kt = 0; kt < 4; ++kt) {
        const u32x2 ac = tr_read4(slot + CH_OFF_AA + (4 * qp + (i16 >> 2)) * CH_TP + (16 * kt + 4 * (i16 & 3)) * 2);
        at[kt] = __builtin_amdgcn_mfma_f32_16x16x32_bf16(mk_frag(ac, (u32x2){0u, 0u}), ttf, (f32x4){0.f, 0.f, 0.f, 0.f}, 0, 0, 0);
    }
    LDSW();
#pragma unroll
    for (int ks = 0; ks < 2; ++ks) {
        const u32x2 lo = pk4(at[2 * ks][0], at[2 * ks][1], at[2 * ks][2], at[2 * ks][3]), hi = pk4(at[2 * ks + 1][0], at[2 * ks + 1][1], at[2 * ks + 1][2], at[2 * ks + 1][3]);
        *(LAS u32x4*)(slot + CH_OFF_AA + ks * 1024 + lane * 16) = (u32x4){lo.x, lo.y, hi.x, hi.y};
        *(LAS u32x4*)(slot + CH_OFF_RA + ks * 1024 + lane * 16) = __builtin_bit_cast(u32x4, fr[ks]);
    }
    {
        const u32x2 mb = pk4(MrbT[0], MrbT[1], MrbT[2], MrbT[3]), mk = pk4(MrkT[0], MrkT[1], MrkT[2], MrkT[3]), tl = pk4(TLk[0], TLk[1], TLk[2], TLk[3]);
        *(LAS u32x4*)(slot + CH_OFF_MC + lane * 16) = (u32x4){mb.x, mb.y, mk.x, mk.y};
        *(LAS u32x2*)(slot + CH_OFF_TL + lane * 8) = tl;
    }
}

struct ChainFrag { u32x4 aa0, aa1, ra0, ra1, mc, tl; u32x2 vq4, b4[4], k4[4]; f32x4 gm[4]; };
__device__ __forceinline__ void chain_fetch(LAS unsigned char* slot, int vq, int lane, ChainFrag& F) {
    const int i16 = lane & 15, qp = lane >> 4;
    const int troff = (4 * qp + (i16 >> 2)) * CH_TP + 8 * (i16 & 3);
    { const u32x2 t2 = *(const LAS u32x2*)(slot + CH_OFF_TL + lane * 8); F.tl = (u32x4){t2.x, t2.y, 0u, 0u}; }
    F.vq4 = tr_read4(slot + CH_OFF_VT + troff + 32 * vq);
    F.aa0 = *(const LAS u32x4*)(slot + CH_OFF_AA + lane * 16); F.aa1 = *(const LAS u32x4*)(slot + CH_OFF_AA + 1024 + lane * 16);
    F.ra0 = *(const LAS u32x4*)(slot + CH_OFF_RA + lane * 16); F.ra1 = *(const LAS u32x4*)(slot + CH_OFF_RA + 1024 + lane * 16);
    F.mc = *(const LAS u32x4*)(slot + CH_OFF_MC + lane * 16);
#pragma unroll
    for (int kt = 0; kt < 4; ++kt) {
        F.b4[kt] = tr_read4(slot + CH_OFF_BT + troff + 32 * kt); F.k4[kt] = tr_read4(slot + CH_OFF_KT + troff + 32 * kt);
        F.gm[kt] = *(const LAS f32x4*)(slot + CH_OFF_GM + 4 * (16 * kt + 4 * qp));
    }
}
__device__ __forceinline__ f32x4 chain_math(const ChainFrag& F, f32x4 (&ST)[4]) {
    const f32x4 z4 = (f32x4){0.f, 0.f, 0.f, 0.f};
    const f32x4 tlv = __builtin_amdgcn_mfma_f32_16x16x32_bf16(__builtin_bit_cast(bf16x8_t, F.tl), mk_frag(F.vq4, F.vq4), z4, 0, 0, 0);
    bf16x8_t sb[2];
#pragma unroll
    for (int ks = 0; ks < 2; ++ks) sb[ks] = mk_frag(pk4(ST[2 * ks][0], ST[2 * ks][1], ST[2 * ks][2], ST[2 * ks][3]), pk4(ST[2 * ks + 1][0], ST[2 * ks + 1][1], ST[2 * ks + 1][2], ST[2 * ks + 1][3]));
    const f32x4 u1 = __builtin_amdgcn_mfma_f32_16x16x32_bf16(__builtin_bit_cast(bf16x8_t, F.aa0), sb[0], z4, 0, 0, 0);
    const f32x4 u2 = __builtin_amdgcn_mfma_f32_16x16x32_bf16(__builtin_bit_cast(bf16x8_t, F.aa1), sb[1], tlv, 0, 0, 0);
    f32x4 Y = __builtin_amdgcn_mfma_f32_16x16x32_bf16(__builtin_bit_cast(bf16x8_t, F.ra0), sb[0], z4, 0, 0, 0);
    const f32x4 y2 = __builtin_amdgcn_mfma_f32_16x16x32_bf16(__builtin_bit_cast(bf16x8_t, F.ra1), sb[1], z4, 0, 0, 0);
    const f32x4 U = u1 + u2;
    const bf16x8_t uv = mk_frag(pk4(U[0], U[1], U[2], U[3]), F.vq4);
#pragma unroll
    for (int kt = 0; kt < 4; ++kt) {
        ST[kt] = __builtin_amdgcn_mfma_f32_16x16x32_bf16(mk_frag(F.b4[kt], F.k4[kt]), uv, ST[kt], 0, 0, 0);
        ST[kt] = ST[kt] * F.gm[kt];
    }
    Y = __builtin_amdgcn_mfma_f32_16x16x32_bf16(__builtin_bit_cast(bf16x8_t, F.mc), uv, Y, 0, 0, 0);
    return Y + y2;
}
struct ChainFrag2 { u32x4 aa0, aa1, ra0, ra1, mc, tl; u32x2 va, vb, b4[4], k4[4]; f32x4 gm[4]; };
__device__ __forceinline__ void chain_fetch2(LAS unsigned char* slot, int vq0, int lane, ChainFrag2& F) {
    const int i16 = lane & 15, qp = lane >> 4;
    const int troff = (4 * qp + (i16 >> 2)) * CH_TP + 8 * (i16 & 3);
    { const u32x2 t2 = *(const LAS u32x2*)(slot + CH_OFF_TL + lane * 8); F.tl = (u32x4){t2.x, t2.y, 0u, 0u}; }
    F.va = tr_read4(slot + CH_OFF_VT + troff + 32 * vq0); F.vb = tr_read4(slot + CH_OFF_VT + troff + 32 * (vq0 + 1));
    F.aa0 = *(const LAS u32x4*)(slot + CH_OFF_AA + lane * 16); F.aa1 = *(const LAS u32x4*)(slot + CH_OFF_AA + 1024 + lane * 16);
    F.ra0 = *(const LAS u32x4*)(slot + CH_OFF_RA + lane * 16); F.ra1 = *(const LAS u32x4*)(slot + CH_OFF_RA + 1024 + lane * 16);
    F.mc = *(const LAS u32x4*)(slot + CH_OFF_MC + lane * 16);
#pragma unroll
    for (int kt = 0; kt < 4; ++kt) {
        F.b4[kt] = tr_read4(slot + CH_OFF_BT + troff + 32 * kt); F.k4[kt] = tr_read4(slot + CH_OFF_KT + troff + 32 * kt);
        F.gm[kt] = *(const LAS f32x4*)(slot + CH_OFF_GM + 4 * (16 * kt + 4 * qp));
    }
}
__device__ __forceinline__ void chain_math2(const ChainFrag2& F, f32x4 (&SA)[4], f32x4 (&SB)[4], f32x4& YA, f32x4& YB) {
    const f32x4 z4 = (f32x4){0.f, 0.f, 0.f, 0.f};
    const bf16x8_t tl = __builtin_bit_cast(bf16x8_t, F.tl), aa0 = __builtin_bit_cast(bf16x8_t, F.aa0), aa1 = __builtin_bit_cast(bf16x8_t, F.aa1),
                   ra0 = __builtin_bit_cast(bf16x8_t, F.ra0), ra1 = __builtin_bit_cast(bf16x8_t, F.ra1), mc = __builtin_bit_cast(bf16x8_t, F.mc);
    const f32x4 tlva = __builtin_amdgcn_mfma_f32_16x16x32_bf16(tl, mk_frag(F.va, F.va), z4, 0, 0, 0);
    const f32x4 tlvb = __builtin_amdgcn_mfma_f32_16x16x32_bf16(tl, mk_frag(F.vb, F.vb), z4, 0, 0, 0);
    bf16x8_t sa[2], sb[2];
#pragma unroll
    for (int ks = 0; ks < 2; ++ks) {
        sa[ks] = mk_frag(pk4(SA[2 * ks][0], SA[2 * ks][1], SA[2 * ks][2], SA[2 * ks][3]), pk4(SA[2 * ks + 1][0], SA[2 * ks + 1][1], SA[2 * ks + 1][2], SA[2 * ks + 1][3]));
        sb[ks] = mk_frag(pk4(SB[2 * ks][0], SB[2 * ks][1], SB[2 * ks][2], SB[2 * ks][3]), pk4(SB[2 * ks + 1][0], SB[2 * ks + 1][1], SB[2 * ks + 1][2], SB[2 * ks + 1][3]));
    }
    const f32x4 ua1 = __builtin_amdgcn_mfma_f32_16x16x32_bf16(aa0, sa[0], z4, 0, 0, 0);
    const f32x4 ub1 = __builtin_amdgcn_mfma_f32_16x16x32_bf16(aa0, sb[0], z4, 0, 0, 0);
    const f32x4 ua2 = __builtin_amdgcn_mfma_f32_16x16x32_bf16(aa1, sa[1], tlva, 0, 0, 0);
    const f32x4 ub2 = __builtin_amdgcn_mfma_f32_16x16x32_bf16(aa1, sb[1], tlvb, 0, 0, 0);
    f32x4 ya = __builtin_amdgcn_mfma_f32_16x16x32_bf16(ra0, sa[0], z4, 0, 0, 0);
    f32x4 yb = __builtin_amdgcn_mfma_f32_16x16x32_bf16(ra0, sb[0], z4, 0, 0, 0);
    const f32x4 ya2 = __builtin_amdgcn_mfma_f32_16x16x32_bf16(ra1, sa[1], z4, 0, 0, 0);
    const f32x4 yb2 = __builtin_amdgcn_mfma_f32_16x16x32_bf16(ra1, sb[1], z4, 0, 0, 0);
    const f32x4 UA = ua1 + ua2, UB = ub1 + ub2;
    const bf16x8_t uva = mk_frag(pk4(UA[0], UA[1], UA[2], UA[3]), F.va), uvb = mk_frag(pk4(UB[0], UB[1], UB[2], UB[3]), F.vb);
#pragma unroll
    for (int kt = 0; kt < 4; ++kt) {
        const bf16x8_t bk = mk_frag(F.b4[kt], F.k4[kt]);
        SA[kt] = __builtin_amdgcn_mfma_f32_16x16x32_bf16(bk, uva, SA[kt], 0, 0, 0);
        SB[kt] = __builtin_amdgcn_mfma_f32_16x16x32_bf16(bk, uvb, SB[kt], 0, 0, 0);
    }
#pragma unroll
    for (int kt = 0; kt < 4; ++kt) { SA[kt] = SA[kt] * F.gm[kt]; SB[kt] = SB[kt] * F.gm[kt]; }
    ya = __builtin_amdgcn_mfma_f32_16x16x32_bf16(mc, uva, ya, 0, 0, 0);
    yb = __builtin_amdgcn_mfma_f32_16x16x32_bf16(mc, uvb, yb, 0, 0, 0);
    YA = ya + ya2; YB = yb + yb2;
}
__device__ __forceinline__ f32x4 chain_step(LAS unsigned char* slot, f32x4 (&ST)[4], int vq, int lane) { ChainFrag F; chain_fetch(slot, vq, lane, F); return chain_math(F, ST); }

constexpr int N_CH_P = MP / 16 * 16, N_CH_S = DBATCH * 16, N_CH = N_CH_P + N_CH_S;
static_assert(WS_CB + (size_t)N_CH * CH_SLOT <= (size_t)861000000, "chunk buffer fits the workspace");
constexpr int CH_VEC = CH_SLOT / 16;
__device__ __forceinline__ void slot_to_global(const LAS unsigned char* slot, unsigned char* g, int lane) {
#pragma unroll
    for (int i = 0; i < 13; ++i) { const int v = i * 64 + lane; if (v < CH_VEC) *(u32x4*)(g + (size_t)v * 16) = *(const LAS u32x4*)(slot + v * 16); }
}
struct SlotRegs { u32x4 v[13]; };
__device__ __forceinline__ void slot_load(const unsigned char* g, int lane, SlotRegs& S) {
    asm volatile("" : "+v"(lane));
#pragma unroll
    for (int i = 0; i < 13; ++i) { const int v = i * 64 + lane; S.v[i] = *(const u32x4*)(g + (size_t)(v < CH_VEC ? v : 0) * 16); }
}
__device__ __forceinline__ void slot_store(LAS unsigned char* slot, int lane, const SlotRegs& S) {
    asm volatile("" : "+v"(lane));
#pragma unroll
    for (int i = 0; i < 13; ++i) { const int v = i * 64 + lane; if (v < CH_VEC) *(LAS u32x4*)(slot + v * 16) = S.v[i]; }
}
__device__ __forceinline__ void phase_c1(const Args& a, int L, LAS unsigned char* lds) {
    const int tid = threadIdx.x, lane = tid & 63, wv = __builtin_amdgcn_readfirstlane(tid >> 6);
    LAS unsigned char* slot = lds + wv * CH_SLOT; LAS unsigned char* par = lds + CH_PAR_OFF + wv * CH_PAR_BYTES;
    unsigned char* CB = a.ws + WS_CB;
    rglru_prefix(a);
    const int stride = gridDim.x * NWAVES;
    auto item = [&](int ci, size_t& m0, int& ntok, bool& ss, const float*& sh0) {
        sh0 = nullptr;
        if (ci < N_CH_P) { const int chunk = ci >> 4; m0 = (size_t)chunk * 16; ntok = 16; ss = (chunk & (SEQ / 16 - 1)) == 0; }
        else { const int b = (ci - N_CH_P) >> 4; m0 = (size_t)MP + (size_t)b * DSEQ; ntok = DSEQ; ss = true; sh0 = a.in[6] + ((size_t)L * DBATCH + b) * SHIFT_W; }
    };
    auto fetch = [&](int ci, ChunkRaw& R) { size_t m0; int ntok; bool ss; const float* sh0; item(ci, m0, ntok, ss, sh0); chunk_load(a, m0, ci & 15, ntok, lane, R); };
    int ci = blockIdx.x * NWAVES + wv;
    ChunkRaw R;
    if (ci < N_CH) fetch(ci, R);
    for (; ci < N_CH; ci += stride) {
        const int h = ci & 15; size_t m0; int ntok; bool ss; const float* sh0; item(ci, m0, ntok, ss, sh0);
        stage_head_params(a, L, h, par, lane);
        LDSW();
        chunk_compute(a, R, m0, h, ntok, ss, sh0, par, slot, lane, [&]() { if (ci + stride < N_CH) fetch(ci + stride, R); });
        LDSW();
        const size_t sid = ci < N_CH_P ? ((size_t)((ci >> 4) >> 9) * 16 + h) * (SEQ / 16) + ((ci >> 4) & (SEQ / 16 - 1)) : (size_t)ci;
        slot_to_global(slot, CB + sid * CH_SLOT, lane);
        LDSW();
    }
}

#define WG_BAR() do { asm volatile("s_waitcnt lgkmcnt(0)" ::: "memory"); __builtin_amdgcn_s_barrier(); asm volatile("" ::: "memory"); } while (0)
template <int DRY> __device__ __forceinline__ void wkv_prompt_chain(const Args& a, int L, int b, int h, LAS unsigned char* lds) {
    const int tid = threadIdx.x, lane = tid & 63, wv = __builtin_amdgcn_readfirstlane(tid >> 6), i16 = lane & 15, qp = lane >> 4;
    bf16_t* Y = (bf16_t*)(a.ws + WS_Y);
    const unsigned char* CB = a.ws + WS_CB;
    constexpr int NR = SEQ / 64;
    const size_t ci0 = ((size_t)b * 16 + h) * (SEQ / 16);
    if (wv >= 4) {
        const int lw = wv - 4;
        SlotRegs S0, S1, S2;
#define CB_GROUP(k) (CB + (ci0 + (size_t)(4 * (k) + lw)) * CH_SLOT)
        slot_load(CB_GROUP(0), lane, S0);
        slot_store(lds + lw * CH_SLOT, lane, S0);
        slot_load(CB_GROUP(1), lane, S1); slot_load(CB_GROUP(2), lane, S2); slot_load(CB_GROUP(3), lane, S0);
        WG_BAR();
        for (int g = 0; g < NR; g += 6) {
#define LROUND(r, SET) do { if ((r) < NR) { if (DRY != 2) if ((r) + 1 < NR) slot_store(lds + ((((r) + 1) & 1) * 4 + lw) * CH_SLOT, lane, SET); if (DRY != 2) if ((r) + 4 < NR) slot_load(CB_GROUP((r) + 4), lane, SET); WG_BAR(); } } while (0)
            LROUND(g, S1); LROUND(g + 1, S2); LROUND(g + 2, S0); LROUND(g + 3, S1); LROUND(g + 4, S2); LROUND(g + 5, S0);
#undef LROUND
        }
#undef CB_GROUP
    } else if (wv < 2) {
        f32x4 SA[4], SB[4];
#pragma unroll
        for (int kt = 0; kt < 4; ++kt) { SA[kt] = (f32x4){0.f, 0.f, 0.f, 0.f}; SB[kt] = SA[kt]; }
        WG_BAR();
        bf16_t* yrow = Y + ((size_t)b * SEQ) * D + 64 * h + 32 * wv;
        for (int g = 0; g < NR; ++g) {
            LAS unsigned char* gs = lds + (g & 1) * 4 * CH_SLOT;
            ChainFrag2 FA, FB;
            f32x4 ya[4], yb[4];
#define SB0() __builtin_amdgcn_sched_barrier(0)
            if (DRY == 3) { WG_BAR(); continue; }
            chain_fetch2(gs, 2 * wv, lane, FA);
            chain_fetch2(gs + CH_SLOT, 2 * wv, lane, FB); SB0();
            chain_math2(FA, SA, SB, ya[0], yb[0]); SB0();
            chain_fetch2(gs + 2 * CH_SLOT, 2 * wv, lane, FA); SB0();
            chain_math2(FB, SA, SB, ya[1], yb[1]); SB0();
            chain_fetch2(gs + 3 * CH_SLOT, 2 * wv, lane, FB); SB0();
            chain_math2(FA, SA, SB, ya[2], yb[2]); SB0();
            chain_math2(FB, SA, SB, ya[3], yb[3]); SB0();
#undef SB0
            {
                LAS unsigned char* yt = lds + CH_PAR_OFF + wv * 4608;
#pragma unroll
                for (int j = 0; j < 4; ++j)
#pragma unroll
                    for (int r = 0; r < 4; ++r) {
                        *(LAS unsigned short*)(yt + (16 * j + 4 * qp + r) * 72 + 2 * i16) = f2bf(ya[j][r]);
                        *(LAS unsigned short*)(yt + (16 * j + 4 * qp + r) * 72 + 2 * (16 + i16)) = f2bf(yb[j][r]);
                    }
                LDSW();
#pragma unroll
                for (int j = 0; j < 4; ++j) {
                    const int row = 16 * j + (lane >> 2), pc = lane & 3;
                    const u32x2 lo = *(const LAS u32x2*)(yt + row * 72 + pc * 16), hi = *(const LAS u32x2*)(yt + row * 72 + pc * 16 + 8);
                    if (DRY == 0) *(u32x4*)(yrow + (size_t)row * D + 8 * pc) = (u32x4){lo.x, lo.y, hi.x, hi.y};
                    else asm volatile("" :: "v"(lo), "v"(hi));
                }
                LDSW();
            }
            yrow += (size_t)64 * D;
            WG_BAR();
        }
        float* o = a.out + O_PWKV + ((((size_t)L * NBATCH + b) * 16 + h) * 64 + 32 * wv + i16) * 64;
#pragma unroll
        for (int kt = 0; kt < 4; ++kt) { if (DRY == 0) { *(f32x4*)(o + 16 * kt + 4 * qp) = SA[kt]; *(f32x4*)(o + 16 * 64 + 16 * kt + 4 * qp) = SB[kt]; } else asm volatile("" :: "v"(SA[kt]), "v"(SB[kt])); }
    } else {
        WG_BAR();
        for (int g = 0; g < NR; ++g) WG_BAR();
    }
    __syncthreads();
}
#undef WG_BAR
__device__ __forceinline__ void wkv_sample_chain(const Args& a, int L, int b, int ho, LAS unsigned char* lds) {
    const int tid = threadIdx.x, lane = tid & 63, wv = __builtin_amdgcn_readfirstlane(tid >> 6), i16 = lane & 15, qp = lane >> 4;
    const int h = 8 * ho + wv;
    bf16_t* Y = (bf16_t*)(a.ws + WS_Y);
    LAS unsigned char* slot = lds + wv * CH_SLOT;
    const size_t m0 = (size_t)MP + (size_t)b * DSEQ;
    { SlotRegs S; slot_load(a.ws + WS_CB + ((size_t)N_CH_P + (size_t)b * 16 + h) * CH_SLOT, lane, S); slot_store(slot, lane, S); }
    LDSW();
    for (int vp = 0; vp < 2; ++vp) {
        const size_t so = ((((size_t)L * DBATCH + b) * 16 + h) * 64 + 32 * vp + i16) * 64;
        f32x4 SA[4], SB[4];
#pragma unroll
        for (int kt = 0; kt < 4; ++kt) { SA[kt] = *(const f32x4*)(a.in[7] + so + 16 * kt + 4 * qp); SB[kt] = *(const f32x4*)(a.in[7] + so + 16 * 64 + 16 * kt + 4 * qp); }
        ChainFrag2 F; chain_fetch2(slot, 2 * vp, lane, F);
        f32x4 ya, yb; chain_math2(F, SA, SB, ya, yb);
#pragma unroll
        for (int r = 0; r < 4; ++r) if (4 * qp + r < DSEQ) { Y[(m0 + 4 * qp + r) * D + 64 * h + 32 * vp + i16] = f2bf(ya[r]); Y[(m0 + 4 * qp + r) * D + 64 * h + 32 * vp + 16 + i16] = f2bf(yb[r]); }
#pragma unroll
        for (int kt = 0; kt < 4; ++kt) { *(f32x4*)(a.out + O_SWKV + so + 16 * kt + 4 * qp) = SA[kt]; *(f32x4*)(a.out + O_SWKV + so + 16 * 64 + 16 * kt + 4 * qp) = SB[kt]; }
    }
    __syncthreads();
}

#ifndef PROBE_MIXB
#define PROBE_MIXB 0
#endif
__device__ __forceinline__ void phase_mixb2(const Args& a, int L, LAS unsigned char* lds) {
    constexpr int N_PC = NBATCH * 16;
    const int G = gridDim.x, bx = blockIdx.x;
    const int first_other = (G > 2 * N_PC) ? N_PC : 0;
    for (int it = bx; it < N_PC; it += G) wkv_prompt_chain<0>(a, L, it >> 4, it & 15, lds);
    if (PROBE_MIXB & 1) for (int it = bx; it < N_PC; it += G) wkv_prompt_chain<0>(a, L, it >> 4, it & 15, lds);
    if (PROBE_MIXB & 8) for (int it = bx; it < N_PC; it += G) wkv_prompt_chain<1>(a, L, it >> 4, it & 15, lds);
    if (PROBE_MIXB & 16) for (int it = bx; it < N_PC; it += G) wkv_prompt_chain<2>(a, L, it >> 4, it & 15, lds);
    if (PROBE_MIXB & 32) for (int it = bx; it < N_PC; it += G) wkv_prompt_chain<3>(a, L, it >> 4, it & 15, lds);
    if (bx < first_other) return;
    const int nb = G - first_other, id = bx - first_other;
    constexpr int N_RG2 = M / 64, N_SC = DBATCH * 2;
    phase_state_copies(a, L, first_other);
    for (int it = id; it < N_RG2; it += nb) { rglru_unit2<true>(a, L, it, lds); __syncthreads(); }
    if (PROBE_MIXB & 4) for (int it = id; it < N_RG2; it += nb) { rglru_unit2<true>(a, L, it, lds); __syncthreads(); }
    {
        const int second = (N_RG2 > nb) ? N_RG2 - nb : 0;
        const int start = id >= second ? id - second : id + (nb - second);
        for (int it = start; it < N_SC; it += nb) wkv_sample_chain(a, L, it >> 1, it & 1, lds);
        if (PROBE_MIXB & 2) for (int it = start; it < N_SC; it += nb) wkv_sample_chain(a, L, it >> 1, it & 1, lds);
    }
}
#ifndef PROBE_MASK
#define PROBE_MASK 0
#endif
#define PH_IN(k) (lo <= (k) && (k) < hi)
#define RUN_PHASE(po, ...) do { { __VA_ARGS__ } if (((PROBE_MASK >> (po)) & 1) && PH_IN(base + (po))) { cg::this_grid().sync(); { __VA_ARGS__ } } } while (0)
#define PH_SYNC(k) do { if (lo < (k) && (k) < hi) cg::this_grid().sync(); } while (0)
template <int L> __device__ __forceinline__ void layer_phases(const Args& a, LAS unsigned char* lds, int lo, int hi) {
    unsigned char* ws = a.ws;
    const int G = gridDim.x;
    constexpr int base = PH_L0 + L * PH_PER_LAYER;
    PH_SYNC(base + PHO_IN);
    RUN_PHASE(PHO_IN, if (PH_IN(base + PHO_IN)) {
        pg8::Gemm g{(const bf16_t*)(ws + WS_XB), (const bf16_t*)(ws + WS_WIN), M, NP, D}; pg8::StaticOrder S; S.init(M, NP, G, (int)blockIdx.x);
        EpiIn E{(bf16_t*)(ws + WS_P), NP, CG / 256};
        pg8::gemm_phase<EpiIn, pg8::StaticOrder, true, true>(lds, g, S, E);
    });
    PH_SYNC(base + PHO_MIXA);
    RUN_PHASE(PHO_MIXA, if (PH_IN(base + PHO_MIXA)) phase_mixa(a, L, lds););
    PH_SYNC(base + PHO_LORA);
    RUN_PHASE(PHO_LORA, if (PH_IN(base + PHO_LORA)) {
        pg8::Gemm g{(const bf16_t*)(ws + WS_ACAT), (const bf16_t*)(ws + WS_WLORA), M, 3072, ACAT_K}; pg8::StaticOrder S; S.init(M, 3072, G, (int)blockIdx.x);
        EpiLora E{(bf16_t*)(ws + WS_WAW), (bf16_t*)(ws + WS_WAA), (bf16_t*)(ws + WS_WAG), a.in[18] + L * D, a.in[20] + L * D};
        pg8::gemm_phase<EpiLora, pg8::StaticOrder, true, true>(lds, g, S, E);
    });
    PH_SYNC(base + PHO_C1);
    RUN_PHASE(PHO_C1, if (PH_IN(base + PHO_C1)) phase_c1(a, L, lds););
    PH_SYNC(base + PHO_MIXB);
    RUN_PHASE(PHO_MIXB, if (PH_IN(base + PHO_MIXB)) phase_mixb2(a, L, lds););
    PH_SYNC(base + PHO_MIXC);
    if (PH_IN(base + PHO_MIXC)) {
#if defined(PROBE_MIXC)
        phase_mixc(a, L, (bf16_t*)(ws + WS_CB)); cg::this_grid().sync();
#endif
        phase_mixc(a, L, (bf16_t*)(ws + WS_OA));
    }
    PH_SYNC(base + PHO_OUT);
    RUN_PHASE(PHO_OUT, if (PH_IN(base + PHO_OUT)) {
        {
            pg8::Gemm g{(const bf16_t*)(ws + WS_MIX), (const bf16_t*)(ws + WS_WOUT), MP, D, D}; pg8::StaticOrder S; S.init(MP, D, G, (int)blockIdx.x);
            if (L == 0) { EpiZ<false> E{a.in[0], (float*)(ws + WS_Z), D}; pg8::gemm_phase<EpiZ<false>, pg8::StaticOrder, true, true>(lds, g, S, E); }
            else { EpiZ<true> E{ws + WS_XB, (float*)(ws + WS_Z), D}; pg8::gemm_phase<EpiZ<true>, pg8::StaticOrder, true, true>(lds, g, S, E); }
        }
        {
            pg8::Gemm g{(const bf16_t*)(ws + WS_MIX) + (size_t)MP * D, (const bf16_t*)(ws + WS_WOUTS), MS, 4 * D, 256, D, 256, 4, (size_t)512}; pg8::StaticOrder S; S.init(MS, 4 * D, G, (int)blockIdx.x);
            if (L == 0) { EpiZS<false> E{a.in[1], (float*)(ws + WS_ZS), D}; pg8::gemm_phase<EpiZS<false>, pg8::StaticOrder, true, true>(lds, g, S, E); }
            else { EpiZS<true> E{ws + WS_XB + (size_t)MP * D * 2, (float*)(ws + WS_ZS), D}; pg8::gemm_phase<EpiZS<true>, pg8::StaticOrder, true, true>(lds, g, S, E); }
        }
    });
    PH_SYNC(base + PHO_LN1);
    RUN_PHASE(PHO_LN1, if (PH_IN(base + PHO_LN1)) phase_ln<4>((const float*)(ws + WS_Z), (const float*)(ws + WS_ZS), a.in[29] + L * D, a.in[30] + L * D, nullptr, (bf16_t*)(ws + WS_X1B)););
    PH_SYNC(base + PHO_GU);
    RUN_PHASE(PHO_GU, if (PH_IN(base + PHO_GU)) {
        pg8::Gemm g{(const bf16_t*)(ws + WS_X1B), (const bf16_t*)(ws + WS_WGU), M, 2 * DFF, D}; pg8::StaticOrder S; S.init(M, 2 * DFF, G, (int)blockIdx.x);
        EpiSwiGLU E{(bf16_t*)(ws + WS_H), DFF};
        pg8::gemm_phase<EpiSwiGLU, pg8::StaticOrder, true, true>(lds, g, S, E);
    });
    PH_SYNC(base + PHO_DOWN);
    RUN_PHASE(PHO_DOWN, if (PH_IN(base + PHO_DOWN)) {
        {
            pg8::Gemm g{(const bf16_t*)(ws + WS_H), (const bf16_t*)(ws + WS_WDN), MP, D, DFF}; pg8::StaticOrder S; S.init(MP, D, G, (int)blockIdx.x);
            EpiZ<true> E{ws + WS_X1B, (float*)(ws + WS_Z), D};
            pg8::gemm_phase<EpiZ<true>, pg8::StaticOrder, true, true>(lds, g, S, E);
        }
        {
            pg8::Gemm g{(const bf16_t*)(ws + WS_H) + (size_t)MP * DFF, (const bf16_t*)(ws + WS_WDNS), MS, 11 * D, 256, DFF, 256, 4, (size_t)512}; pg8::StaticOrder S; S.init(MS, 11 * D, G, (int)blockIdx.x);
            EpiZS<true> E{ws + WS_X1B + (size_t)MP * D * 2, (float*)(ws + WS_ZS), D};
            pg8::gemm_phase<EpiZS<true>, pg8::StaticOrder, true, true>(lds, g, S, E);
        }
    });
    PH_SYNC(base + PHO_LN2);
    RUN_PHASE(PHO_LN2, if (PH_IN(base + PHO_LN2)) {
        if (L == DEPTH - 1) phase_ln<11>((const float*)(ws + WS_Z), (const float*)(ws + WS_ZS), a.in[33] + L * D, a.in[34] + L * D, a.out + O_YP, nullptr);
        else { phase_ln<11>((const float*)(ws + WS_Z), (const float*)(ws + WS_ZS), a.in[33] + L * D, a.in[34] + L * D, nullptr, (bf16_t*)(ws + WS_XB)); phase_prep_weights(a, L + 1, lds); }
    });
}
__global__ void __launch_bounds__(NTHREADS, 2) mega(Args a) {
    extern __shared__ __attribute__((aligned(16))) unsigned char lds_raw[];
    LAS unsigned char* lds = (LAS unsigned char*)lds_raw;
    const int lo = a.ph_lo, hi = a.ph_hi;
    if (PH_IN(PH_PREP)) { phase_prep_weights(a, 0, lds); phase_prep_x(a); }
    layer_phases<0>(a, lds, lo, hi);
    layer_phases<1>(a, lds, lo, hi);
}

static void launch_mega(Args a, int lo, int hi, int grid, hipStream_t s) {
    a.ph_lo = lo; a.ph_hi = hi;
    void* args[] = {&a};
    hipError_t e;
    if (hi - lo > 1) e = hipLaunchCooperativeKernel((void*)mega, dim3(grid), dim3(NTHREADS), args, LDS_BYTES, s);
    else e = hipLaunchKernel((void*)mega, dim3(grid), dim3(NTHREADS), args, LDS_BYTES, s);
    if (e != hipSuccess) fprintf(stderr, "mega launch [%d,%d) failed: %s (grid %d)\n", lo, hi, hipGetErrorString(e), grid);
}

extern "C" void kernel_launch(void* const* d_in, const int* in_sizes, int n_in, void* d_out, int out_size,
                              void* d_ws, size_t ws_size, hipStream_t stream) {
    if (ws_size < WS_END || out_size != (int)O_END || n_in != 35) { fprintf(stderr, "kernel_launch: unexpected sizes ws=%zu out=%d n_in=%d\n", ws_size, out_size, n_in); return; }
    static int grid = 0;
    if (!grid) {
        int dev = 0, cus = 0, per_cu = 0;
        (void)hipGetDevice(&dev);
        (void)hipDeviceGetAttribute(&cus, hipDeviceAttributeMultiprocessorCount, dev);
        (void)hipFuncSetAttribute((const void*)mega, hipFuncAttributeMaxDynamicSharedMemorySize, LDS_BYTES);
        (void)hipOccupancyMaxActiveBlocksPerMultiprocessor(&per_cu, (const void*)mega, NTHREADS, LDS_BYTES);
        if (per_cu < 1) { fprintf(stderr, "occupancy query says %d blocks per CU\n", per_cu); per_cu = 1; }
        grid = cus * per_cu;
    }
    const float* const* in = (const float* const*)d_in;
    unsigned char* ws = (unsigned char*)d_ws;
    float* out = (float*)d_out;
    Args a{};
    for (int i = 0; i < 35; ++i) a.in[i] = in[i];
    a.out = out; a.ws = ws;
    launch_mega(a, 0, N_PHASES, grid, stream);
}
```

```cpp
#include <hip/hip_runtime.h>
#include <cstdint>
#include <cstdio>

typedef unsigned short bf16_t;
__device__ __forceinline__ float bf2f(bf16_t v) { return __uint_as_float(((unsigned)v) << 16); }
typedef float f32x2c_t __attribute__((ext_vector_type(2))); typedef __bf16 bf16x2c_t __attribute__((ext_vector_type(2)));
__device__ __forceinline__ bf16_t f2bf(float f) { f32x2c_t v = {f, f}; bf16x2c_t b = __builtin_convertvector(v, bf16x2c_t); return (bf16_t)(__builtin_bit_cast(unsigned, b) & 0xffffu); }
__device__ __forceinline__ float sigmoidf_(float x) { return __builtin_amdgcn_rcpf(1.f + __expf(-x)); }
__device__ __forceinline__ float softplusf_(float x) { return fmaxf(x, 0.f) + log1pf(__expf(-fabsf(x))); }
__device__ __forceinline__ float wave_sum(float v) {
#pragma unroll
    for (int o = 1; o < 64; o <<= 1) v += __shfl_xor(v, o);
    return v;
}

constexpr int D = 1024, MP = 16384, MS = 1024, M = MP + MS, SEQ = 8192, DSEQ = 8, NBATCH = 2, DBATCH = 128, DEPTH = 2;
constexpr int NP = 9216, IN_COLS = 8992;
constexpr int CQ = 0, CK = 1024, CV = 1280, CRNN = 1536, CRW = 2560, CG = 6144;
constexpr int SHIFT_W = 3360, DFF = 2816;
constexpr float ALPHA = 1.4142135623730951f;
constexpr float LN_EPS = 1e-5f, GN_EPS = 64e-5f;

constexpr size_t O_YP = 0, O_YS = 16777216, O_PK = 17825792, O_PV = 17956864, O_PCONV = 18087936, O_PH = 18100224,
                 O_PSHIFT = 18104320, O_PWKV = 18117760, O_SK = 18379904, O_SV = 26768512, O_SCONV = 35157120,
                 O_SH = 35943552, O_SSHIFT = 36205696, O_SWKV = 37065856, O_END = 53843072;


constexpr size_t MiB = 1u << 20;
constexpr size_t WS_CTL = 0;
constexpr size_t WIN_T_BYTES = (size_t)NP * D * 2, WOUT_T_BYTES = (size_t)D * D * 2, WGU_T_BYTES = (size_t)2 * DFF * D * 2, WDN_T_BYTES = (size_t)D * DFF * 2;
constexpr int ACAT_K = 384;
constexpr size_t WLORA_BYTES = (size_t)3072 * ACAT_K * 2;
constexpr size_t WS_WIN = 1 * MiB;
constexpr size_t WS_WOUT = WS_WIN + WIN_T_BYTES;
constexpr size_t WS_WGU = WS_WOUT + WOUT_T_BYTES;
constexpr size_t WS_WDN = WS_WGU + WGU_T_BYTES;
constexpr size_t WS_WOUTS = WS_WDN + WDN_T_BYTES;
constexpr size_t WS_WDNS = WS_WOUTS + WOUT_T_BYTES;
constexpr size_t WS_WLORA = WS_WDNS + WDN_T_BYTES;
constexpr size_t WS_XB = WS_WLORA + WLORA_BYTES;
constexpr size_t WS_OA = WS_XB + (size_t)M * D * 2;
constexpr size_t WS_MIX = WS_OA;
constexpr size_t WS_OB = WS_OA + (size_t)M * D * 2;
constexpr size_t WS_P = WS_OB + (size_t)M * D * 2;
constexpr size_t WS_Z = WS_P;
constexpr size_t WS_ZS = WS_Z + (size_t)M * D * 4;
constexpr size_t WS_X1B = WS_ZS + (size_t)11 * MS * D * 4;
constexpr size_t WS_H = WS_X1B + (size_t)M * D * 2;
constexpr size_t WS_PEND = WS_P + (size_t)M * NP * 2;
constexpr size_t WS_RS = WS_PEND;
constexpr size_t WS_WAW = WS_RS + (size_t)2 * 128 * 1024 * 2 * 4;
constexpr size_t WS_WAA = WS_WAW + (size_t)M * D * 2;
constexpr size_t WS_WAG = WS_WAA + (size_t)M * D * 2;
constexpr size_t WS_Y = WS_WAG + (size_t)M * D * 2;
constexpr size_t WS_BD = WS_Y + (size_t)M * D * 2;
constexpr size_t WS_ACAT = WS_BD + (size_t)M * 16 * 4;
constexpr size_t WS_CB = WS_ACAT;
constexpr size_t WS_END = WS_ACAT + (size_t)M * ACAT_K * 2;
static_assert(WS_END <= (size_t)861000000, "workspace budget (4 x output bytes = 861.5 MB)");
static_assert(WS_H + (size_t)M * DFF * 2 <= WS_PEND, "overlay fits");
static_assert(WS_WAA == WS_WAW + (size_t)M * D * 2 && WS_WAG == WS_WAA + (size_t)M * D * 2, "lora outputs contiguous");
static_assert(WS_XB % 256 == 0 && WS_P % 256 == 0 && WS_WLORA % 256 == 0 && WS_ACAT % 256 == 0, "alignment");
namespace pg8 {
#define PG8_LAS __attribute__((address_space(3)))
typedef unsigned short bf16_t;
typedef short bf16x8 __attribute__((ext_vector_type(8)));
typedef float f32x4 __attribute__((ext_vector_type(4)));
typedef unsigned u32x4 __attribute__((ext_vector_type(4)));
constexpr int BM = 256, BK = 64, HALF = 128, HTB = HALF * BK * 2  , STAGE_BYTES = 8 * HTB, NXCD = 8, WGM = 8;

__host__ __device__ __forceinline__ int lds_byte(int r, int c) { const int st = (r >> 4) * 2 + (c >> 5), rr = r & 15, cc = c & 31, ob = rr * 64 + cc * 2; return st * 1024 + (ob ^ (((ob >> 9) & 1) << 5)); }
__host__ __device__ __forceinline__ void stage_rc(int b, int& R, int& C) { const int st = b / 1024, sb = b % 1024, swz = sb ^ (((sb >> 9) & 1) << 5); R = (st >> 1) * 16 + swz / 64; C = (st & 1) * 32 + (swz % 64) / 2; }
__host__ __device__ __forceinline__ int perm32(int rho) { const int n = rho >> 4, i = rho & 15; return 8 * (i >> 2) + 4 * n + (i & 3); }

struct Unit { int pm, pn; };
struct Gemm { const bf16_t* A; const bf16_t* Bt; int M, N, K; int lda = 0, ldb = 0, nsplit = 0; size_t a_koff = 0; };

struct StaticOrder {
    int nM, nN, nwg, G, c;
    __host__ __device__ void init(int M, int N, int G_, int c_) { nM = M / BM; nN = N / BM; nwg = nM * nN; G = G_; c = c_; }
    __host__ __device__ bool next(int i, Unit& u) const {
        const long L = (long)i * G + c; if (L >= nwg) return false;
        int wgid = (int)L; { const int q = nwg / NXCD, r = nwg % NXCD, xcd = wgid % NXCD, off = wgid / NXCD; wgid = (xcd < r ? xcd * (q + 1) : r * (q + 1) + (xcd - r) * q) + off; }
        const int nig = WGM * nN, gid = wgid / nig, fm = gid * WGM, gsz = (nM - fm) < WGM ? (nM - fm) : WGM;
        u.pm = fm + ((wgid % nig) % gsz); u.pn = (wgid % nig) / gsz; return true;
    }
    __device__ __forceinline__ void a_ready(const Unit&) const {}
    __device__ __forceinline__ void done(const Unit&) const {}
};

__device__ __forceinline__ unsigned cvt_pk_bf16(float lo, float hi) { unsigned r; asm volatile("v_cvt_pk_bf16_f32 %0, %1, %2" : "=v"(r) : "v"(lo), "v"(hi)); return r; }
typedef float f32x2 __attribute__((ext_vector_type(2)));
template <class Epi, class Sched, bool ALIGN_EPI = false, bool SP2 = false>
__device__ __forceinline__ void gemm_phase(PG8_LAS unsigned char* lds, const Gemm g, const Sched& S, const Epi& E) {
    const int tid = threadIdx.x, wid = __builtin_amdgcn_readfirstlane(tid >> 6), lane = tid & 63, wr = wid >> 2, wc = wid & 3, fr = lane & 15, fq = lane >> 4;
    const int K = g.K, nt = K / BK, lda = g.lda ? g.lda : K, ldb = g.ldb ? g.ldb : K;
    unsigned voffA[2], voffB[2];
#pragma unroll
    for (int i = 0; i < 2; ++i) { int R, C; stage_rc(tid * 16 + i * 8192, R, C); const int Rb = Epi::PERM ? ((R & ~31) + perm32(R & 31)) : R;
        voffA[i] = (unsigned)(R * lda + C) * 2u; voffB[i] = (unsigned)(Rb * ldb + C) * 2u; }
    const size_t kstep = (size_t)(BK * 2);
    const size_t hstepA = (size_t)HALF * lda * 2, hstepB = (size_t)HALF * ldb * 2;
    const size_t tstepA = 2 * hstepA, tstepB = 2 * hstepB;
#define PG8_ABASE(u) ((const char*)g.A + (size_t)(u).pm * tstepA + (g.nsplit ? (size_t)((u).pn / g.nsplit) * g.a_koff : (size_t)0))
    const unsigned ldsw = (unsigned)wid * 1024u;
    const int aoff = lds_byte(wr * 64 + fr, fq * 8), boff = lds_byte(wc * 32 + fr, fq * 8);
#define PG8_SA(b, h) (((b) * 2 + (h)) * HTB)
#define PG8_SB(b, h) ((4 + (b) * 2 + (h)) * HTB)
#define PG8_STAGE(bufoff, gbase, voff) do { _Pragma("unroll") for (int _i = 0; _i < 2; ++_i) \
        __builtin_amdgcn_global_load_lds((const unsigned*)((const char*)(gbase) + (voff)[_i]), (PG8_LAS unsigned*)(lds + (bufoff) + ldsw + _i * 8192), 16, 0, 0); } while (0)
#define PG8_LDA(dst, b, h) do { _Pragma("unroll") for (int m = 0; m < 4; ++m) _Pragma("unroll") for (int k = 0; k < 2; ++k) dst[m][k] = *(const PG8_LAS bf16x8*)(lds + PG8_SA(b, h) + aoff + m * 2048 + k * 1024); } while (0)
#define PG8_LDB(dst, b, h) do { _Pragma("unroll") for (int n = 0; n < 2; ++n) _Pragma("unroll") for (int k = 0; k < 2; ++k) dst[n][k] = *(const PG8_LAS bf16x8*)(lds + PG8_SB(b, h) + boff + n * 2048 + k * 1024); } while (0)
#define PG8_MMA(ai, bj, At, Bt) do { __builtin_amdgcn_s_setprio(1); _Pragma("unroll") for (int m = 0; m < 4; ++m) _Pragma("unroll") for (int n = 0; n < 2; ++n) _Pragma("unroll") for (int k = 0; k < 2; ++k) \
        acc[ai][bj][m][n] = __builtin_amdgcn_mfma_f32_16x16x32_bf16(Bt[n][k], At[m][k], acc[ai][bj][m][n], 0, 0, 0); __builtin_amdgcn_s_setprio(0); } while (0)
#define PG8_WAIT_V(n) asm volatile("s_waitcnt vmcnt(" #n ")" ::: "memory")
#define PG8_WAIT_L(n) asm volatile("s_waitcnt lgkmcnt(" #n ")" ::: "memory")
#define PG8_BAR __builtin_amdgcn_s_barrier()
#define PG8_SCHED __builtin_amdgcn_sched_barrier(0)
    Unit cur, nxt; int ui = 0;
    if (!S.next(0, cur)) return;
    f32x4 acc[2][2][4][2];
#pragma unroll
    for (int a = 0; a < 2; ++a)
#pragma unroll
        for (int b = 0; b < 2; ++b)
#pragma unroll
            for (int m = 0; m < 4; ++m)
#pragma unroll
                for (int n = 0; n < 2; ++n) acc[a][b][m][n] = (f32x4){0.f, 0.f, 0.f, 0.f};
    bf16x8 At[4][2], B0[2][2], B1[2][2];
    const char* cA = PG8_ABASE(cur); const char* cB = (const char*)g.Bt + (size_t)cur.pn * tstepB;
    S.a_ready(cur);
    if constexpr (SP2) {
        PG8_STAGE(PG8_SB(0, 0), cB, voffB); PG8_STAGE(PG8_SB(0, 1), cB + hstepB, voffB); PG8_STAGE(PG8_SA(0, 0), cA, voffA); PG8_STAGE(PG8_SA(0, 1), cA + hstepA, voffA);
        if (wr == 1) PG8_BAR;
        PG8_WAIT_V(2); PG8_BAR;
        PG8_STAGE(PG8_SB(1, 0), cB + kstep, voffB); PG8_STAGE(PG8_SA(1, 0), cA + kstep, voffA); PG8_STAGE(PG8_SB(1, 1), cB + hstepB + kstep, voffB);
        PG8_WAIT_V(6); PG8_BAR;
    } else {
        PG8_STAGE(PG8_SB(0, 0), cB, voffB); PG8_STAGE(PG8_SA(0, 0), cA, voffA); PG8_STAGE(PG8_SB(0, 1), cB + hstepB, voffB); PG8_STAGE(PG8_SA(0, 1), cA + hstepA, voffA);
        if (wr == 1) PG8_BAR;
        PG8_WAIT_V(4); PG8_BAR;
        PG8_STAGE(PG8_SB(1, 0), cB + kstep, voffB); PG8_STAGE(PG8_SA(1, 0), cA + kstep, voffA); PG8_STAGE(PG8_SB(1, 1), cB + hstepB + kstep, voffB);
        PG8_WAIT_V(6); PG8_BAR;
    }
    for (;;) {
        const bool has_next = S.next(ui + 1, nxt);
        const char* nA = has_next ? PG8_ABASE(nxt) : cA; const char* nB = has_next ? (const char*)g.Bt + (size_t)nxt.pn * tstepB : cB;
#pragma nounroll
        for (int t = 0; t < nt; t += 2) {
            const bool last = (t == nt - 2);
            const char* a1 = cA + (size_t)(t + 1) * kstep;
            const char* a2 = last ? nA : cA + (size_t)(t + 2) * kstep; const char* b2 = last ? nB : cB + (size_t)(t + 2) * kstep;
            const char* a3 = a2 + kstep; const char* b3 = b2 + kstep;
            if (last && has_next) S.a_ready(nxt);
            if constexpr (SP2) {
            PG8_LDB(B0, 0, 0); PG8_LDB(B1, 0, 1); PG8_SCHED; PG8_LDA(At, 0, 0); PG8_STAGE(PG8_SA(1, 1), a1 + hstepA, voffA);
            PG8_WAIT_V(8); PG8_WAIT_L(0); PG8_BAR; PG8_MMA(0, 0, At, B0); PG8_MMA(0, 1, At, B1); PG8_BAR; PG8_SCHED;
            PG8_LDA(At, 0, 1); PG8_STAGE(PG8_SB(0, 0), b2, voffB); PG8_STAGE(PG8_SB(0, 1), b2 + hstepB, voffB); PG8_STAGE(PG8_SA(0, 0), a2, voffA);
            PG8_WAIT_V(8); PG8_WAIT_L(0); PG8_BAR; PG8_MMA(1, 0, At, B0); PG8_MMA(1, 1, At, B1); PG8_BAR; PG8_SCHED;
            PG8_LDB(B0, 1, 0); PG8_LDB(B1, 1, 1); PG8_SCHED; PG8_LDA(At, 1, 0); PG8_STAGE(PG8_SA(0, 1), a2 + hstepA, voffA);
            PG8_WAIT_V(8); PG8_WAIT_L(0); PG8_BAR; PG8_MMA(0, 0, At, B0); PG8_MMA(0, 1, At, B1); PG8_BAR; PG8_SCHED;
            PG8_LDA(At, 1, 1); PG8_STAGE(PG8_SB(1, 0), b3, voffB); PG8_STAGE(PG8_SB(1, 1), b3 + hstepB, voffB); PG8_STAGE(PG8_SA(1, 0), a3, voffA);
            PG8_WAIT_V(8); PG8_WAIT_L(0); PG8_BAR; PG8_MMA(1, 0, At, B0); PG8_MMA(1, 1, At, B1); PG8_BAR; PG8_SCHED;
            } else {
            PG8_LDB(B0, 0, 0); PG8_SCHED; PG8_LDA(At, 0, 0); PG8_STAGE(PG8_SA(1, 1), a1 + hstepA, voffA);
            PG8_WAIT_L(8); PG8_BAR; PG8_WAIT_L(0); PG8_MMA(0, 0, At, B0); PG8_BAR; PG8_SCHED;
            PG8_LDB(B1, 0, 1); PG8_STAGE(PG8_SB(0, 0), b2, voffB);
            PG8_BAR; PG8_WAIT_L(0); PG8_MMA(0, 1, At, B1); PG8_BAR;
            PG8_LDA(At, 0, 1); PG8_STAGE(PG8_SA(0, 0), a2, voffA);
            PG8_BAR; PG8_WAIT_L(0); PG8_MMA(1, 0, At, B0); PG8_BAR; PG8_SCHED;
            PG8_STAGE(PG8_SB(0, 1), b2 + hstepB, voffB);
            PG8_WAIT_V(6); PG8_BAR; PG8_MMA(1, 1, At, B1); PG8_BAR;
            PG8_LDB(B0, 1, 0); PG8_SCHED; PG8_LDA(At, 1, 0); PG8_STAGE(PG8_SA(0, 1), a2 + hstepA, voffA);
            PG8_WAIT_L(8); PG8_BAR; PG8_WAIT_L(0); PG8_MMA(0, 0, At, B0); PG8_BAR; PG8_SCHED;
            PG8_LDB(B1, 1, 1); PG8_STAGE(PG8_SB(1, 0), b3, voffB);
            PG8_BAR; PG8_WAIT_L(0); PG8_MMA(0, 1, At, B1); PG8_BAR;
            PG8_LDA(At, 1, 1); PG8_STAGE(PG8_SA(1, 0), a3, voffA);
            PG8_BAR; PG8_WAIT_L(0); PG8_MMA(1, 0, At, B0); PG8_BAR; PG8_SCHED;
            PG8_STAGE(PG8_SB(1, 1), b3 + hstepB, voffB);
            PG8_WAIT_V(6); PG8_BAR; PG8_MMA(1, 1, At, B1); PG8_BAR;
            }
        }
        if constexpr (ALIGN_EPI) { if (wr == 0) PG8_BAR; }
        if constexpr (!Epi::AFTER_DRAIN) { E(acc, cur, wr, wc, fr, fq); S.done(cur); }
        if (!has_next) break;
#pragma unroll
        for (int a = 0; a < 2; ++a)
#pragma unroll
            for (int b = 0; b < 2; ++b)
#pragma unroll
                for (int m = 0; m < 4; ++m)
#pragma unroll
                    for (int n = 0; n < 2; ++n) acc[a][b][m][n] = (f32x4){0.f, 0.f, 0.f, 0.f};
        cur = nxt; cA = nA; cB = nB; ++ui;
        if constexpr (ALIGN_EPI) { if (wr == 1) PG8_BAR; }
    }
    PG8_WAIT_V(0);
    if constexpr (!ALIGN_EPI) { if (wr == 0) PG8_BAR; }
    PG8_BAR;
    if constexpr (Epi::AFTER_DRAIN) { E.fused(acc, cur, wr, wc, fr, fq, lds, wid, lane); S.done(cur); }
#undef PG8_ABASE
#undef PG8_SA
#undef PG8_SB
#undef PG8_STAGE
#undef PG8_LDA
#undef PG8_LDB
#undef PG8_MMA
#undef PG8_WAIT_V
#undef PG8_WAIT_L
#undef PG8_BAR
#undef PG8_SCHED
}
}

#include <hip/hip_cooperative_groups.h>
namespace cg = cooperative_groups;
#define LAS __attribute__((address_space(3)))
typedef float f32x4 __attribute__((ext_vector_type(4)));
typedef unsigned u32x4 __attribute__((ext_vector_type(4)));
typedef unsigned u32x2 __attribute__((ext_vector_type(2)));

constexpr int NTHREADS = 512, NWAVES = 8;
constexpr int LDS_BYTES = 147456;

constexpr int PH_PREP = 0, PH_PER_LAYER = 11, PH_L0 = 1;
constexpr int PHO_IN = 0, PHO_MIXA = 1, PHO_LORA = 2, PHO_C1 = 3, PHO_MIXB = 4, PHO_MIXC = 5, PHO_OUT = 6, PHO_LN1 = 7, PHO_GU = 8, PHO_DOWN = 9, PHO_LN2 = 10;
constexpr int N_PHASES = PH_L0 + DEPTH * PH_PER_LAYER;

struct Args { const float* in[35]; float* out; unsigned char* ws; int ph_lo, ph_hi; };

typedef float f32x2_t __attribute__((ext_vector_type(2))); typedef __bf16 bf16x2_t __attribute__((ext_vector_type(2)));
__device__ __forceinline__ unsigned pk2bf(float lo, float hi) { f32x2_t v = {lo, hi}; bf16x2_t b = __builtin_convertvector(v, bf16x2_t); return __builtin_bit_cast(unsigned, b); }

struct EpiIn {
    static constexpr bool PERM = true, AFTER_DRAIN = false;
    bf16_t* O; int ldc; int sig_pn;
    __device__ __forceinline__ void operator()(const f32x4 (&acc)[2][2][4][2], const pg8::Unit& u, int wr, int wc, int fr, int fq) const {
        const int row0 = u.pm * 256 + wr * 64 + fr, col0 = u.pn * 256 + wc * 32 + 8 * fq;
        const bool sg = u.pn >= sig_pn;
#pragma unroll
        for (int ai = 0; ai < 2; ++ai)
#pragma unroll
            for (int m = 0; m < 4; ++m) {
                bf16_t* rowp = O + (size_t)(row0 + ai * 128 + m * 16) * ldc + col0;
#pragma unroll
                for (int bj = 0; bj < 2; ++bj) {
                    f32x4 v0 = acc[ai][bj][m][0], v1 = acc[ai][bj][m][1];
                    if (sg) {
#pragma unroll
                        for (int i = 0; i < 4; ++i) { v0[i] = sigmoidf_(v0[i]); v1[i] = sigmoidf_(v1[i]); }
                    }
                    u32x4 w; w.x = pk2bf(v0[0], v0[1]); w.y = pk2bf(v0[2], v0[3]); w.z = pk2bf(v1[0], v1[1]); w.w = pk2bf(v1[2], v1[3]);
                    *(u32x4*)(rowp + bj * 128) = w;
                }
                asm volatile("" ::: "memory");
            }
    }
};
template <bool RESB> struct EpiZ {
    static constexpr bool PERM = false, AFTER_DRAIN = false;
    const void* res; float* Z; int ldc;
    __device__ __forceinline__ void operator()(const f32x4 (&acc)[2][2][4][2], const pg8::Unit& u, int wr, int wc, int fr, int fq) const {
        const int col0 = u.pn * 256 + wc * 32 + 4 * fq;
#pragma unroll
        for (int ai = 0; ai < 2; ++ai)
#pragma unroll
            for (int m = 0; m < 4; ++m) {
                const size_t off = (size_t)(u.pm * 256 + ai * 128 + wr * 64 + m * 16 + fr) * ldc + col0;
#pragma unroll
                for (int bj = 0; bj < 2; ++bj)
#pragma unroll
                    for (int n = 0; n < 2; ++n) {
                        f32x4 r;
                        if (RESB) { const u32x2 w = *(const u32x2*)((const bf16_t*)res + off + bj * 128 + n * 16);
                            r = (f32x4){__uint_as_float(w.x << 16), __uint_as_float(w.x & 0xffff0000u), __uint_as_float(w.y << 16), __uint_as_float(w.y & 0xffff0000u)}; }
                        else r = *(const f32x4*)((const float*)res + off + bj * 128 + n * 16);
                        *(f32x4*)(Z + off + bj * 128 + n * 16) = r * ALPHA + acc[ai][bj][m][n];
                    }
                asm volatile("" ::: "memory");
            }
    }
};
template <bool RESB> struct EpiZS {
    static constexpr bool PERM = false, AFTER_DRAIN = false;
    const void* res; float* ZS; int ldc;
    __device__ __forceinline__ void operator()(const f32x4 (&acc)[2][2][4][2], const pg8::Unit& u, int wr, int wc, int fr, int fq) const {
        const int ks = u.pn >> 2, col0 = (u.pn & 3) * 256 + wc * 32 + 4 * fq;
        float* Z = ZS + (size_t)ks * MS * D;
#pragma unroll
        for (int ai = 0; ai < 2; ++ai)
#pragma unroll
            for (int m = 0; m < 4; ++m) {
                const size_t off = (size_t)(u.pm * 256 + ai * 128 + wr * 64 + m * 16 + fr) * ldc + col0;
#pragma unroll
                for (int bj = 0; bj < 2; ++bj)
#pragma unroll
                    for (int n = 0; n < 2; ++n) {
                        f32x4 o = acc[ai][bj][m][n];
                        if (ks == 0) {
                            f32x4 r;
                            if (RESB) { const u32x2 w = *(const u32x2*)((const bf16_t*)res + off + bj * 128 + n * 16);
                                r = (f32x4){__uint_as_float(w.x << 16), __uint_as_float(w.x & 0xffff0000u), __uint_as_float(w.y << 16), __uint_as_float(w.y & 0xffff0000u)}; }
                            else r = *(const f32x4*)((const float*)res + off + bj * 128 + n * 16);
                            o = r * ALPHA + o;
                        }
                        *(f32x4*)(Z + off + bj * 128 + n * 16) = o;
                    }
                asm volatile("" ::: "memory");
            }
    }
};
struct EpiSwiGLU {
    static constexpr bool PERM = true, AFTER_DRAIN = false;
    bf16_t* H; int ldc;
    __device__ __forceinline__ void operator()(const f32x4 (&acc)[2][2][4][2], const pg8::Unit& u, int wr, int wc, int fr, int fq) const {
        const int row0 = u.pm * 256 + wr * 64 + fr, col0 = u.pn * 128 + wc * 32 + 8 * fq;
#pragma unroll
        for (int ai = 0; ai < 2; ++ai)
#pragma unroll
            for (int m = 0; m < 4; ++m) {
                bf16_t* rowp = H + (size_t)(row0 + ai * 128 + m * 16) * ldc + col0;
                float o[8];
#pragma unroll
                for (int n = 0; n < 2; ++n)
#pragma unroll
                    for (int i = 0; i < 4; ++i) { const float g = acc[ai][0][m][n][i], up = acc[ai][1][m][n][i]; o[n * 4 + i] = g * sigmoidf_(g) * up; }
                u32x4 w; w.x = pk2bf(o[0], o[1]); w.y = pk2bf(o[2], o[3]); w.z = pk2bf(o[4], o[5]); w.w = pk2bf(o[6], o[7]);
                *(u32x4*)rowp = w;
                asm volatile("" ::: "memory");
            }
    }
};

template <int MODE> __device__ __forceinline__ int colmap(int n) {
    if (MODE == 0) return n < 5920 ? n : (n < 6144 ? -1 : n - 224);
    if (MODE == 2) { const int pn = n >> 8, q = n & 255; return q < 128 ? pn * 128 + q : DFF + pn * 128 + (q - 128); }
    return n;
}
template <int MODE> __device__ __forceinline__ void transpose_item(const float* __restrict__ W, int K, int ldw, bf16_t* WT, int item, int nblk, LAS float* tile, int tid, bf16_t* WS2 = nullptr, int kpart = 0, int nrows = 0) {
    const int kb = item / nblk, nb = item % nblk, k0 = kb * 64, n0 = nb * 64;
    {
        const int n4 = tid & 15; const int col = colmap<MODE>(n0 + 4 * n4);
#pragma unroll
        for (int i = 0; i < 2; ++i) {
            const int kk = i * 32 + (tid >> 4);
            const f32x4 v = col >= 0 ? *(const f32x4*)(W + (size_t)(k0 + kk) * ldw + col) : (f32x4){0.f, 0.f, 0.f, 0.f};
            LAS float* t = tile + kk * 65 + 4 * n4; t[0] = v[0]; t[1] = v[1]; t[2] = v[2]; t[3] = v[3];
        }
    }
    __syncthreads();
    {
        const int nn = tid >> 3, c = tid & 7; const LAS float* s = tile + (8 * c) * 65 + nn;
        u32x4 o; o.x = pk2bf(s[0], s[65]); o.y = pk2bf(s[2 * 65], s[3 * 65]); o.z = pk2bf(s[4 * 65], s[5 * 65]); o.w = pk2bf(s[6 * 65], s[7 * 65]);
        *(u32x4*)(WT + (size_t)(n0 + nn) * K + k0 + 8 * c) = o;
        if (WS2) { const int ks = k0 / kpart; *(u32x4*)(WS2 + ((size_t)ks * nrows + n0 + nn) * kpart + (k0 - ks * kpart) + 8 * c) = o; }
    }
    __syncthreads();
}
__device__ __forceinline__ void prep_rg_weights(const Args& a, int l);
__device__ __forceinline__ void phase_prep_weights(const Args& a, int l, LAS unsigned char* lds) {
    const int tid = threadIdx.x, G = gridDim.x, bx = blockIdx.x;
    LAS float* tile = (LAS float*)lds;
    constexpr int I_IN = (D / 64) * (NP / 64), I_OUT = (D / 64) * (D / 64), I_GU = (D / 64) * (2 * DFF / 64), I_DN = (DFF / 64) * (D / 64);
    constexpr int I_LAYER = I_IN + I_OUT + I_GU + I_DN;
    for (int it = bx; it < I_LAYER; it += G) {
        int r = it;
        if (r < I_IN) { transpose_item<0>(a.in[8] + (size_t)l * D * IN_COLS, D, IN_COLS, (bf16_t*)(a.ws + WS_WIN), r, NP / 64, tile, tid); continue; } r -= I_IN;
        if (r < I_OUT) { transpose_item<1>(a.in[28] + (size_t)l * D * D, D, D, (bf16_t*)(a.ws + WS_WOUT), r, D / 64, tile, tid, (bf16_t*)(a.ws + WS_WOUTS), 256, D); continue; } r -= I_OUT;
        if (r < I_GU) { transpose_item<2>(a.in[31] + (size_t)l * D * 2 * DFF, D, 2 * DFF, (bf16_t*)(a.ws + WS_WGU), r, 2 * DFF / 64, tile, tid); continue; } r -= I_GU;
        transpose_item<1>(a.in[32] + (size_t)l * DFF * D, DFF, D, (bf16_t*)(a.ws + WS_WDN), r, D / 64, tile, tid, (bf16_t*)(a.ws + WS_WDNS), 256, D);
    }
    const size_t gt = (size_t)bx * NTHREADS + tid, gs = (size_t)G * NTHREADS;
    for (size_t i = gt; i < (size_t)3072 * ACAT_K; i += gs) {
        const int n = (int)(i / ACAT_K), k = (int)(i % ACAT_K), kind = n >> 10, c = n & 1023;
        float v = 0.f;
        if (kind == 0 && k < 64) v = a.in[19][((size_t)l * 64 + k) * D + c];
        else if (kind == 1 && k >= 64 && k < 128) v = a.in[21][((size_t)l * 64 + (k - 64)) * D + c];
        else if (kind == 2 && k >= 128 && k < 288) v = a.in[22][((size_t)l * 160 + (k - 128)) * D + c];
        ((bf16_t*)(a.ws + WS_WLORA))[i] = f2bf(v);
    }
    prep_rg_weights(a, l);
}
__device__ __forceinline__ void phase_prep_x(const Args& a) {
    bf16_t* XB = (bf16_t*)(a.ws + WS_XB);
    const size_t n4 = (size_t)M * D / 4, np4 = (size_t)MP * D / 4;
    for (size_t i = (size_t)blockIdx.x * NTHREADS + threadIdx.x; i < n4; i += (size_t)gridDim.x * NTHREADS) {
        const f32x4 v = i < np4 ? ((const f32x4*)a.in[0])[i] : ((const f32x4*)a.in[1])[i - np4];
        u32x2 w; w.x = pk2bf(v[0], v[1]); w.y = pk2bf(v[2], v[3]);
        ((u32x2*)XB)[i] = w;
    }
}

__device__ __forceinline__ float wave_sum_fast(float x) {
    x += __builtin_bit_cast(float, __builtin_amdgcn_update_dpp(0, __builtin_bit_cast(int, x), 0xB1, 0xF, 0xF, true));
    x += __builtin_bit_cast(float, __builtin_amdgcn_update_dpp(0, __builtin_bit_cast(int, x), 0x4E, 0xF, 0xF, true));
    x += __builtin_bit_cast(float, __builtin_amdgcn_update_dpp(0, __builtin_bit_cast(int, x), 0x124, 0xF, 0xF, true));
    x += __builtin_bit_cast(float, __builtin_amdgcn_update_dpp(0, __builtin_bit_cast(int, x), 0x128, 0xF, 0xF, true));
    x += __shfl_xor(x, 16); x += __shfl_xor(x, 32);
    return x;
}
template <int NS> __device__ __forceinline__ void phase_ln(const float* __restrict__ Z, const float* __restrict__ ZS, const float* __restrict__ g, const float* __restrict__ b, float* OF, bf16_t* OB) {
    const int lane = threadIdx.x & 63, wv = threadIdx.x >> 6;
    f32x4 gv[4], bv[4];
#pragma unroll
    for (int j = 0; j < 4; ++j) { gv[j] = ((const f32x4*)g)[j * 64 + lane]; bv[j] = ((const f32x4*)b)[j * 64 + lane]; }
    const int stride = gridDim.x * NWAVES;
    int m = blockIdx.x * NWAVES + wv;
    f32x4 nx[4];
    auto load_row = [&](int mm) {
        if (mm < MP) {
#pragma unroll
            for (int j = 0; j < 4; ++j) nx[j] = ((const f32x4*)(Z + (size_t)mm * D))[j * 64 + lane];
        } else {
#pragma unroll
            for (int j = 0; j < 4; ++j) nx[j] = ((const f32x4*)(ZS + (size_t)(mm - MP) * D))[j * 64 + lane];
#pragma unroll
            for (int ks = 1; ks < NS; ++ks)
#pragma unroll
                for (int j = 0; j < 4; ++j) nx[j] = nx[j] + ((const f32x4*)(ZS + ((size_t)ks * MS + (mm - MP)) * D))[j * 64 + lane];
        }
    };
    if (m < M) load_row(m);
    for (; m < M; m += stride) {
        f32x4 v[4]; float s = 0.f;
#pragma unroll
        for (int j = 0; j < 4; ++j) { v[j] = nx[j]; s += (v[j][0] + v[j][1]) + (v[j][2] + v[j][3]); }
        if (m + stride < M) load_row(m + stride);
        const float mean = wave_sum_fast(s) * (1.f / D);
        float q = 0.f;
#pragma unroll
        for (int j = 0; j < 4; ++j) { v[j] = v[j] - mean; q += (v[j][0] * v[j][0] + v[j][1] * v[j][1]) + (v[j][2] * v[j][2] + v[j][3] * v[j][3]); }
        const float rstd = rsqrtf(wave_sum_fast(q) * (1.f / D) + LN_EPS);
#pragma unroll
        for (int j = 0; j < 4; ++j) {
            const f32x4 y = v[j] * rstd * gv[j] + bv[j];
            if (OF) ((f32x4*)(OF + (size_t)m * D))[j * 64 + lane] = y;
            if (OB) { u32x2 w; w.x = pk2bf(y[0], y[1]); w.y = pk2bf(y[2], y[3]); ((u32x2*)(OB + (size_t)m * D))[j * 64 + lane] = w; }
        }
    }
}


typedef short bf16x8_t __attribute__((ext_vector_type(8)));
typedef short bf16x4_t __attribute__((ext_vector_type(4)));
typedef short v4i16_t __attribute__((ext_vector_type(4)));
#define LDSW() asm volatile("s_waitcnt lgkmcnt(0)" ::: "memory")
__device__ __forceinline__ u32x2 tr_read4(LAS unsigned char* p) { return __builtin_bit_cast(u32x2, __builtin_amdgcn_ds_read_tr16_b64_v4i16((LAS v4i16_t*)p)); }
__device__ __forceinline__ bf16x8_t mk_frag(u32x2 lo, u32x2 hi) { const u32x4 w = (u32x4){lo.x, lo.y, hi.x, hi.y}; return __builtin_bit_cast(bf16x8_t, w); }
__device__ __forceinline__ u32x2 pk4(float a, float b, float c, float d) { u32x2 w; w.x = pk2bf(a, b); w.y = pk2bf(c, d); return w; }

constexpr size_t WS_WRG = WS_CTL + 4096;
constexpr int RG_TP = 144;
__device__ __forceinline__ void prep_rg_weights(const Args& a, int l) {
    const size_t gt = (size_t)blockIdx.x * NTHREADS + threadIdx.x, gs = (size_t)gridDim.x * NTHREADS;
    bf16_t* W = (bf16_t*)(a.ws + WS_WRG);
    for (size_t i = gt; i < (size_t)2 * 16 * 4096; i += gs) {
        const int gate = (int)(i >> 16), bk = (int)(i >> 12) & 15, j = (int)(i >> 6) & 63, ii = (int)i & 63;
        W[i] = f2bf(a.in[gate ? 14 : 12][(size_t)l * 16 * 4096 + ((size_t)bk * 64 + ii) * 64 + j]);
    }
}
__device__ __forceinline__ float one_minus_exp(float x) {
    const float s = -x * (1.f + x * (0.5f + x * (0.16666667f + x * (0.041666668f + x * 0.0083333333f))));
    return x > -0.25f ? s : 1.f - __expf(x);
}
template <bool PASS2>
__device__ __forceinline__ void rglru_unit2(const Args& a, int L, int unit, LAS unsigned char* lds) {
    int lane = threadIdx.x & 63; const int wv = __builtin_amdgcn_readfirstlane(threadIdx.x >> 6);
    asm volatile("" : "+v"(lane));
    const int i16 = lane & 15, qp = lane >> 4;
    const bf16_t* P = (const bf16_t*)(a.ws + WS_P); bf16_t* OB = (bf16_t*)(a.ws + WS_OB); float* RS = (float*)(a.ws + WS_RS);
    const bf16_t* WRG = (const bf16_t*)(a.ws + WS_WRG);
    const float* cw = a.in[10] + (size_t)L * 4 * D; const float* cb = a.in[11] + L * D; const float* ba = a.in[13] + L * D;
    const float* bx = a.in[15] + L * D; const float* lam = a.in[16] + L * D;
    const float* conv0 = a.in[4] + (size_t)L * DBATCH * 3 * D; const float* h0 = a.in[5] + (size_t)L * DBATCH * D;
    LAS unsigned char* tile = lds + wv * (64 * RG_TP);
    LAS unsigned char* obt = lds + (NWAVES + wv) * (64 * RG_TP);
    const int m0 = unit * 64;
    const bool sample = m0 >= MP;
    const int bseq = sample ? 0 : m0 / SEQ, chunk = sample ? 0 : (m0 % SEQ) / 64;
    for (int bb = 0; bb < 2; ++bb) {
        const int bk = 2 * wv + bb, c0 = 64 * bk;
        bf16x8_t af[4][2];
#pragma unroll
        for (int ks = 0; ks < 2; ++ks) {
            const int cc = c0 + 32 * ks + 8 * qp;
            f32x4 w0[2], w1[2], w2[2], w3[2], wb[2];
#pragma unroll
            for (int hh = 0; hh < 2; ++hh) { w0[hh] = *(const f32x4*)(cw + 0 * D + cc + 4 * hh); w1[hh] = *(const f32x4*)(cw + 1 * D + cc + 4 * hh); w2[hh] = *(const f32x4*)(cw + 2 * D + cc + 4 * hh);
                w3[hh] = *(const f32x4*)(cw + 3 * D + cc + 4 * hh); wb[hh] = *(const f32x4*)(cb + cc + 4 * hh); }
#pragma unroll
            for (int mt = 0; mt < 4; ++mt) {
                const int tok = 16 * mt + i16; const size_t m = (size_t)m0 + tok;
                const int tseq = sample ? (tok & 7) : (chunk * 64 + tok);
                float xv[4][8];
#pragma unroll
                for (int k = 0; k < 4; ++k) {
                    const int back = 3 - k;
                    const bool ok = tseq - back >= 0;
                    const u32x4 v = *(const u32x4*)(P + (m - (ok ? back : 0)) * NP + CRNN + cc);
                    const unsigned w4[4] = {v.x, v.y, v.z, v.w};
#pragma unroll
                    for (int e = 0; e < 8; ++e) xv[k][e] = ok ? __uint_as_float((e & 1) ? (w4[e >> 1] & 0xffff0000u) : (w4[e >> 1] << 16)) : 0.f;
                    if (sample && back > 0) {
                        const int b = (int)(m - MP) >> 3; const int ci = ok ? 0 : 3 + tseq - back;
                        const float* cp = conv0 + ((size_t)b * 3 + ci) * D + cc;
                        const f32x4 v0 = *(const f32x4*)cp, v1 = *(const f32x4*)(cp + 4);
#pragma unroll
                        for (int e = 0; e < 4; ++e) { xv[k][e] = ok ? xv[k][e] : v0[e]; xv[k][4 + e] = ok ? xv[k][4 + e] : v1[e]; }
                    }
                }
                float xc[8];
#pragma unroll
                for (int e = 0; e < 8; ++e) xc[e] = wb[e >> 2][e & 3] + w0[e >> 2][e & 3] * xv[0][e] + w1[e >> 2][e & 3] * xv[1][e] + w2[e >> 2][e & 3] * xv[2][e] + w3[e >> 2][e & 3] * xv[3][e];
                const u32x4 pk = (u32x4){pk2bf(xc[0], xc[1]), pk2bf(xc[2], xc[3]), pk2bf(xc[4], xc[5]), pk2bf(xc[6], xc[7])};
                af[mt][ks] = __builtin_bit_cast(bf16x8_t, pk);
                *(LAS u32x4*)(tile + tok * RG_TP + (32 * ks + 8 * qp) * 2) = pk;
            }
        }
        LDSW();
#pragma unroll 1
        for (int nt = 0; nt < 4; ++nt) {
            const int j = 16 * nt + i16, c = c0 + j;
            bf16x8_t ba_[2], bx_[2];
#pragma unroll
            for (int ks = 0; ks < 2; ++ks) { ba_[ks] = *(const bf16x8_t*)(WRG + ((size_t)(0 * 16 + bk) * 64 + j) * 64 + 32 * ks + 8 * qp); bx_[ks] = *(const bf16x8_t*)(WRG + ((size_t)(1 * 16 + bk) * 64 + j) * 64 + 32 * ks + 8 * qp); }
            const float bac = ba[c], bxc = bx[c], spl = softplusf_(-lam[c]);
            float av[4][4], uv[4][4];
#pragma unroll
            for (int mt = 0; mt < 4; ++mt) {
                f32x4 ar = (f32x4){0.f, 0.f, 0.f, 0.f}, ai = ar;
#pragma unroll
                for (int ks = 0; ks < 2; ++ks) { ar = __builtin_amdgcn_mfma_f32_16x16x32_bf16(af[mt][ks], ba_[ks], ar, 0, 0, 0); ai = __builtin_amdgcn_mfma_f32_16x16x32_bf16(af[mt][ks], bx_[ks], ai, 0, 0, 0); }
                const u32x2 xcp = tr_read4(tile + (16 * mt + 4 * qp + (i16 >> 2)) * RG_TP + (16 * nt + 4 * (i16 & 3)) * 2);
#pragma unroll
                for (int r = 0; r < 4; ++r) {
                    const unsigned xw = r < 2 ? xcp.x : xcp.y;
                    const float xcv = __uint_as_float((r & 1) ? (xw & 0xffff0000u) : (xw << 16));
                    const float rg = sigmoidf_(ar[r] + bac), ig = sigmoidf_(ai[r] + bxc);
                    const float log_a = -8.f * rg * spl;
                    av[mt][r] = __expf(log_a);
                    uv[mt][r] = __builtin_amdgcn_sqrtf(one_minus_exp(2.f * log_a)) * (ig * xcv);
                }
            }
            float H = 0.f, Atot = 1.f;
            if (PASS2 && !sample && chunk > 0) H = RS[(((size_t)bseq * 128 + chunk) * D + c) * 2 + 1];
#pragma unroll
            for (int mt = 0; mt < 4; ++mt) {
                const float As = av[mt][0] * av[mt][1] * av[mt][2] * av[mt][3];
                const float Bs = ((uv[mt][0] * av[mt][1] + uv[mt][1]) * av[mt][2] + uv[mt][2]) * av[mt][3] + uv[mt][3];
                float Aq[4], Bq[4];
#pragma unroll
                for (int q = 0; q < 4; ++q) { Aq[q] = __shfl(As, i16 + 16 * q); Bq[q] = __shfl(Bs, i16 + 16 * q); }
                float hs;
                if (!sample) {
                    const float h1 = Aq[0] * H + Bq[0], h2 = Aq[1] * h1 + Bq[1], h3 = Aq[2] * h2 + Bq[2];
                    hs = qp == 0 ? H : (qp == 1 ? h1 : (qp == 2 ? h2 : h3));
                    H = Aq[3] * h3 + Bq[3]; Atot *= Aq[0] * Aq[1] * Aq[2] * Aq[3];
                } else {
                    const int b0 = ((m0 - MP) >> 3) + 2 * mt;
                    const float hA = h0[(size_t)b0 * D + c], hB = h0[(size_t)(b0 + 1) * D + c];
                    const float hA1 = Aq[0] * hA + Bq[0], hB1 = Aq[2] * hB + Bq[2];
                    hs = qp == 0 ? hA : (qp == 1 ? hA1 : (qp == 2 ? hB : hB1));
                    if (PASS2 && qp == 0) {
                        a.out[O_SH + ((size_t)L * DBATCH + b0) * D + c] = Aq[1] * hA1 + Bq[1];
                        a.out[O_SH + ((size_t)L * DBATCH + b0 + 1) * D + c] = Aq[3] * hB1 + Bq[3];
                    }
                }
                if (PASS2) {
                    float h = hs;
#pragma unroll
                    for (int r = 0; r < 4; ++r) { h = av[mt][r] * h + uv[mt][r]; *(LAS unsigned short*)(obt + (16 * mt + 4 * qp + r) * RG_TP + j * 2) = f2bf(h); }
                }
            }
            if (!sample && qp == 0) {
                if (!PASS2) *(float2*)(RS + (((size_t)bseq * 128 + chunk) * D + c) * 2) = make_float2(Atot, H);
                else if (chunk == 127) a.out[O_PH + ((size_t)L * NBATCH + bseq) * D + c] = H;
            }
        }
        LDSW();
        if (PASS2) {
#pragma unroll
            for (int p = 0; p < 8; ++p) {
                const int q = p * 64 + lane, row = q >> 3, pc = q & 7;
                *(u32x4*)(OB + ((size_t)m0 + row) * D + c0 + 8 * pc) = *(const LAS u32x4*)(obt + row * RG_TP + pc * 16);
            }
            LDSW();
        }
    }
    if (PASS2) {
        const int t = threadIdx.x;
        if (sample) {
            for (int i = t; i < 8 * 3 * D; i += NTHREADS) { const int s = i / (3 * D), k = (i / D) % 3, c = i % D; const int b = ((m0 - MP) >> 3) + s;
                a.out[O_SCONV + (((size_t)L * DBATCH + b) * 3 + k) * D + c] = bf2f(P[((size_t)MP + b * DSEQ + 5 + k) * NP + CRNN + c]); }
        } else if (chunk == 127) {
            for (int i = t; i < 3 * D; i += NTHREADS) { const int k = i / D, c = i % D;
                a.out[O_PCONV + (((size_t)L * NBATCH + bseq) * 3 + k) * D + c] = bf2f(P[((size_t)m0 + 61 + k) * NP + CRNN + c]); }
        }
    }
}
__device__ __forceinline__ void rglru_prefix(const Args& a) {
    float* RS = (float*)(a.ws + WS_RS);
    const int gid = blockIdx.x * NTHREADS + threadIdx.x;
    if (gid >= NBATCH * D) return;
    const int b = gid / D, c = gid % D;
    float h = 0.f;
    for (int c0 = 0; c0 < 128; c0 += 16) {
        float2 ab[16];
#pragma unroll
        for (int i = 0; i < 16; ++i) ab[i] = *(const float2*)(RS + (((size_t)b * 128 + c0 + i) * D + c) * 2);
#pragma unroll
        for (int i = 0; i < 16; ++i) { RS[(((size_t)b * 128 + c0 + i) * D + c) * 2 + 1] = h; h = ab[i].x * h + ab[i].y; }
    }
}


constexpr int AT_KPB = 144;
constexpr int AT_VPB = 528;
constexpr int AT_K_OFF = 0, AT_V_OFF = 256 * AT_KPB;
constexpr int AT_LDS = AT_V_OFF + 64 * AT_VPB;

template <bool SAMPLE>
__device__ __forceinline__ void attn_unit(const bf16_t* __restrict__ P, bf16_t* OA, const float* __restrict__ sinks, const float* __restrict__ ck, const float* __restrict__ cv,
                                          int b, int qb, int c, LAS unsigned char* lds) {
    const int tid = threadIdx.x, lane = tid & 63, wv = __builtin_amdgcn_readfirstlane(tid >> 6), i16 = lane & 15, qp = lane >> 4;
    LAS unsigned char* ldsK = lds + AT_K_OFF; LAS unsigned char* ldsV = lds + AT_V_OFF;
    if (!SAMPLE) {
        const size_t row_base = (size_t)b * SEQ + (size_t)(qb - 1) * 128;
#pragma unroll
        for (int it = 0; it < 4; ++it) {
            const int ci = tid + 512 * it, s = ci >> 3, part = ci & 7;
            u32x4 kv = (u32x4){0u, 0u, 0u, 0u}, vv = (u32x4){0u, 0u, 0u, 0u};
            if (qb > 0 || s >= 128) {
                const bf16_t* pr = P + (row_base + s) * NP;
                kv = *(const u32x4*)(pr + CK + 64 * c + 8 * part);
                vv = *(const u32x4*)(pr + CV + 64 * c + 8 * part);
            }
            *(LAS u32x4*)(ldsK + s * AT_KPB + part * 16) = kv;
            const unsigned w4[4] = {vv.x, vv.y, vv.z, vv.w};
#pragma unroll
            for (int e = 0; e < 8; ++e) *(LAS unsigned short*)(ldsV + (8 * part + e) * AT_VPB + 2 * s) = (unsigned short)((w4[e >> 1] >> (16 * (e & 1))) & 0xffffu);
        }
    } else {
        for (int ci = tid; ci < 144 * 16; ci += 512) {
            const int s = ci >> 4, part = ci & 15;
            float kf[4] = {0.f, 0.f, 0.f, 0.f}, vf[4] = {0.f, 0.f, 0.f, 0.f};
            if (s < 128) {
                const f32x4 k4 = *(const f32x4*)(ck + ((size_t)(b * 128 + s) * 4 + c) * 64 + 4 * part);
                const f32x4 v4 = *(const f32x4*)(cv + ((size_t)(b * 128 + s) * 4 + c) * 64 + 4 * part);
#pragma unroll
                for (int e = 0; e < 4; ++e) { kf[e] = k4[e]; vf[e] = v4[e]; }
            } else if (s < 136) {
                const bf16_t* pr = P + (size_t)(MP + b * DSEQ + (s - 128)) * NP;
#pragma unroll
                for (int e = 0; e < 4; ++e) { kf[e] = bf2f(pr[CK + 64 * c + 4 * part + e]); vf[e] = bf2f(pr[CV + 64 * c + 4 * part + e]); }
            }
            u32x2 kw; kw.x = pk2bf(kf[0], kf[1]); kw.y = pk2bf(kf[2], kf[3]);
            *(LAS u32x2*)(ldsK + s * AT_KPB + part * 8) = kw;
#pragma unroll
            for (int e = 0; e < 4; ++e) *(LAS unsigned short*)(ldsV + (4 * part + e) * AT_VPB + 2 * s) = f2bf(vf[e]);
        }
    }
    __syncthreads();
    const int n_mt = SAMPLE ? 1 : 4;
    if (!SAMPLE || wv < 2) {
        for (int mt = 0; mt < n_mt; ++mt) {
            int h, tq, nt0; size_t qrow;
            if (!SAMPLE) { const int g = wv >> 1, qh = wv & 1; h = 4 * c + g; tq = 64 * qh + 16 * mt + i16; nt0 = (64 * qh + 16 * mt) >> 4; qrow = (size_t)b * SEQ + (size_t)qb * 128 + tq; }
            else { const int rho = 16 * wv + i16; h = 4 * c + (rho >> 3); tq = rho & 7; nt0 = 0; qrow = (size_t)MP + b * DSEQ + tq; }
            const float slope = exp2f(-0.5f * (float)(h + 1)), sink = sinks[h];
            bf16x8_t qf[2];
#pragma unroll
            for (int ks = 0; ks < 2; ++ks) qf[ks] = *(const bf16x8_t*)(P + qrow * NP + CQ + 64 * h + 32 * ks + 8 * qp);
            f32x4 sc[9];
#pragma unroll
            for (int jn = 0; jn < 9; ++jn) {
                const int nt = nt0 + jn;
                f32x4 acc = (f32x4){0.f, 0.f, 0.f, 0.f};
                if (SAMPLE || qb > 0 || nt >= 8) {
#pragma unroll
                    for (int ks = 0; ks < 2; ++ks) {
                        const bf16x8_t kfr = *(const LAS bf16x8_t*)(ldsK + (16 * nt + i16) * AT_KPB + (32 * ks + 8 * qp) * 2);
                        acc = __builtin_amdgcn_mfma_f32_16x16x32_bf16(kfr, qf[ks], acc, 0, 0, 0);
                    }
                }
#pragma unroll
                for (int r = 0; r < 4; ++r) {
                    const int sidx = 16 * nt + 4 * qp + r;
                    const int rel = 128 + tq - sidx;
                    bool valid = rel >= 0 && rel < 128;
                    if (!SAMPLE) valid = valid && (qb > 0 || sidx >= 128);
                    acc[r] = valid ? acc[r] * 0.125f - slope * (float)rel : -INFINITY;
                }
                sc[jn] = acc;
            }
            float mx = sink;
#pragma unroll
            for (int jn = 0; jn < 9; ++jn)
#pragma unroll
                for (int r = 0; r < 4; ++r) mx = fmaxf(mx, sc[jn][r]);
            mx = fmaxf(mx, __shfl_xor(mx, 16)); mx = fmaxf(mx, __shfl_xor(mx, 32));
            float sum = 0.f;
#pragma unroll
            for (int jn = 0; jn < 9; ++jn)
#pragma unroll
                for (int r = 0; r < 4; ++r) { const float e = __expf(sc[jn][r] - mx); sc[jn][r] = e; sum += e; }
            sum += __shfl_xor(sum, 16); sum += __shfl_xor(sum, 32);
            const float inv = __builtin_amdgcn_rcpf(sum + __expf(sink - mx));
            bf16x8_t pf[5];
#pragma unroll
            for (int ks = 0; ks < 5; ++ks) {
                u32x4 w;
                w.x = pk2bf(sc[2 * ks][0] * inv, sc[2 * ks][1] * inv); w.y = pk2bf(sc[2 * ks][2] * inv, sc[2 * ks][3] * inv);
                if (ks < 4) { w.z = pk2bf(sc[2 * ks + 1][0] * inv, sc[2 * ks + 1][1] * inv); w.w = pk2bf(sc[2 * ks + 1][2] * inv, sc[2 * ks + 1][3] * inv); }
                else { w.z = 0u; w.w = 0u; }
                pf[ks] = __builtin_bit_cast(bf16x8_t, w);
            }
#pragma unroll
            for (int dt = 0; dt < 4; ++dt) {
                f32x4 o = (f32x4){0.f, 0.f, 0.f, 0.f};
#pragma unroll
                for (int ks = 0; ks < 5; ++ks) {
                    const int ntA = nt0 + 2 * ks, ntB = (ks < 4) ? nt0 + 2 * ks + 1 : nt0 + 2 * ks;
                    const LAS unsigned char* vr = ldsV + (16 * dt + i16) * AT_VPB;
                    const u32x2 lo = *(const LAS u32x2*)(vr + 2 * (16 * ntA + 4 * qp));
                    const u32x2 hi = *(const LAS u32x2*)(vr + 2 * (16 * ntB + 4 * qp));
                    const u32x4 w = (u32x4){lo.x, lo.y, hi.x, hi.y};
                    o = __builtin_amdgcn_mfma_f32_16x16x32_bf16(__builtin_bit_cast(bf16x8_t, w), pf[ks], o, 0, 0, 0);
                }
                u32x2 ow; ow.x = pk2bf(o[0], o[1]); ow.y = pk2bf(o[2], o[3]);
                *(u32x2*)(OA + qrow * D + 64 * h + 16 * dt + 4 * qp) = ow;
            }
        }
    }
    __syncthreads();
}

template <bool PASS2>
__device__ __forceinline__ void rglru_unit(const Args& a, int L, int unit, LAS unsigned char* lds) {
    const int tid = threadIdx.x, lane = tid & 63, wv = __builtin_amdgcn_readfirstlane(tid >> 6);
    const bf16_t* P = (const bf16_t*)(a.ws + WS_P); bf16_t* OB = (bf16_t*)(a.ws + WS_OB); float* RS = (float*)(a.ws + WS_RS);
    const float* cw = a.in[10] + (size_t)L * 4 * D; const float* cb = a.in[11] + L * D; const float* wa = a.in[12] + (size_t)L * 16 * 4096; const float* ba = a.in[13] + L * D;
    const float* wx = a.in[14] + (size_t)L * 16 * 4096; const float* bx = a.in[15] + L * D; const float* lam = a.in[16] + L * D;
    const float* conv0 = a.in[4] + (size_t)L * DBATCH * 3 * D; const float* h0 = a.in[5] + (size_t)L * DBATCH * D;
    LAS float* s_xc = (LAS float*)lds + wv * 64;
    const int m0 = unit * 64;
    const bool sample = m0 >= MP;
    for (int bb = 0; bb < 2; ++bb) {
        const int bk = 2 * wv + bb, c = 64 * bk + lane;
        float war[64], wxr[64];
#pragma unroll
        for (int i = 0; i < 64; ++i) { war[i] = wa[((size_t)bk * 64 + i) * 64 + lane]; wxr[i] = wx[((size_t)bk * 64 + i) * 64 + lane]; }
        const float c0 = cw[0 * D + c], c1 = cw[1 * D + c], c2 = cw[2 * D + c], c3 = cw[3 * D + c], cbc = cb[c], bac = ba[c], bxc = bx[c];
        const float spl = softplusf_(-lam[c]);
        float x1 = 0.f, x2 = 0.f, x3 = 0.f, h = 0.f, Ap = 1.f;
        int bseq = 0, chunk = 0;
        if (!sample) {
            bseq = m0 / SEQ; chunk = (m0 % SEQ) / 64;
            if (chunk > 0) {
                x1 = bf2f(P[(size_t)(m0 - 1) * NP + CRNN + c]); x2 = bf2f(P[(size_t)(m0 - 2) * NP + CRNN + c]); x3 = bf2f(P[(size_t)(m0 - 3) * NP + CRNN + c]);
                if (PASS2) { for (int cc = 0; cc < chunk; ++cc) { const float2 ab = *(const float2*)(RS + (((size_t)bseq * 128 + cc) * D + c) * 2); h = ab.x * h + ab.y; } }
            }
        }
        for (int t = 0; t < 64; ++t) {
            const size_t m = (size_t)m0 + t;
            if (sample && (t & 7) == 0) {
                if (!PASS2) break;
                const int b = (int)(m - MP) >> 3;
                x3 = conv0[((size_t)b * 3 + 0) * D + c]; x2 = conv0[((size_t)b * 3 + 1) * D + c]; x1 = conv0[((size_t)b * 3 + 2) * D + c]; h = h0[(size_t)b * D + c];
            }
            const float x = bf2f(P[m * NP + CRNN + c]);
            const float xc = cbc + c0 * x3 + c1 * x2 + c2 * x1 + c3 * x;
            LDSW(); s_xc[lane] = xc; LDSW();
            float r = bac, ig = bxc;
#pragma unroll
            for (int i4 = 0; i4 < 16; ++i4) { const f32x4 xv = *(const LAS f32x4*)(s_xc + 4 * i4);
#pragma unroll
                for (int e = 0; e < 4; ++e) { r += xv[e] * war[4 * i4 + e]; ig += xv[e] * wxr[4 * i4 + e]; } }
            r = sigmoidf_(r); ig = sigmoidf_(ig);
            const float log_a = -8.f * r * spl;
            const float av = __expf(log_a);
            const float u = sqrtf(-expm1f(2.f * log_a)) * (ig * xc);
            h = av * h + u; Ap *= av;
            if (PASS2) OB[m * D + c] = f2bf(h);
            x3 = x2; x2 = x1; x1 = x;
            if (PASS2 && sample && (t & 7) == 7) {
                const int b = (int)(m - MP) >> 3;
                float* oc = a.out + O_SCONV + ((size_t)L * DBATCH + b) * 3 * D; float* oh = a.out + O_SH + ((size_t)L * DBATCH + b) * D;
                oh[c] = h; oc[0 * D + c] = x3; oc[1 * D + c] = x2; oc[2 * D + c] = x1;
            }
        }
        if (!sample) {
            if (!PASS2) { *(float2*)(RS + (((size_t)bseq * 128 + chunk) * D + c) * 2) = make_float2(Ap, h); }
            else if (chunk == 127) {
                float* oc = a.out + O_PCONV + ((size_t)L * NBATCH + bseq) * 3 * D; float* oh = a.out + O_PH + ((size_t)L * NBATCH + bseq) * D;
                oh[c] = h; oc[0 * D + c] = x3; oc[1 * D + c] = x2; oc[2 * D + c] = x1;
            }
        }
    }
}

__device__ __forceinline__ void phase_elem_mixa(const Args& a, int L) {
    const bf16_t* P = (const bf16_t*)(a.ws + WS_P); bf16_t* AC = (bf16_t*)(a.ws + WS_ACAT);
    const float* mu = a.in[17] + (size_t)L * SHIFT_W; const float* shift0 = a.in[6] + (size_t)L * DBATCH * SHIFT_W;
    const size_t gt = (size_t)blockIdx.x * NTHREADS + threadIdx.x, gs = (size_t)gridDim.x * NTHREADS;
    for (unsigned i = (unsigned)gt; i < (unsigned)(M * ACAT_K); i += (unsigned)gs) {
        const unsigned m = i / ACAT_K; const int j = (int)(i - m * ACAT_K);
        float o = 0.f;
        if (j < 288) {
            const int ch = 3072 + j;
            const float pc = bf2f(P[(size_t)m * NP + CRW + ch]);
            float pv;
            if (m < (unsigned)MP) pv = (m % SEQ) == 0 ? 0.f : bf2f(P[(size_t)(m - 1) * NP + CRW + ch]);
            else pv = ((m - MP) % DSEQ) == 0 ? shift0[(size_t)((m - MP) / DSEQ) * SHIFT_W + ch] : bf2f(P[(size_t)(m - 1) * NP + CRW + ch]);
            const float ps = pc + mu[ch] * (pv - pc);
            o = j < 64 ? 1.f - 2.f * __builtin_amdgcn_rcpf(__expf(2.f * ps) + 1.f) : (j < 128 ? ps : sigmoidf_(ps));
        }
        AC[i] = f2bf(o);
    }
}
__device__ __forceinline__ void phase_state_copies(const Args& a, int L, int first) {
    const bf16_t* P = (const bf16_t*)(a.ws + WS_P);
    if ((int)blockIdx.x < first) return;
    const size_t gt = (size_t)(blockIdx.x - first) * NTHREADS + threadIdx.x, gs = (size_t)(gridDim.x - first) * NTHREADS;
    const float* ck = a.in[2] + (size_t)L * DBATCH * 128 * 256; const float* cv = a.in[3] + (size_t)L * DBATCH * 128 * 256;
    float* pk = a.out + O_PK + (size_t)L * NBATCH * 128 * 256; float* pv_ = a.out + O_PV + (size_t)L * NBATCH * 128 * 256;
    float* pshift = a.out + O_PSHIFT + (size_t)L * NBATCH * SHIFT_W; float* sk = a.out + O_SK + (size_t)L * DBATCH * 128 * 256; float* sv = a.out + O_SV + (size_t)L * DBATCH * 128 * 256;
    float* sshift = a.out + O_SSHIFT + (size_t)L * DBATCH * SHIFT_W;
    const size_t n_pk = (size_t)NBATCH * 128 * 256, n_sk = (size_t)DBATCH * 128 * 256, n_ps = (size_t)NBATCH * SHIFT_W, n_ss = (size_t)DBATCH * SHIFT_W;
    auto ld4 = [&](const bf16_t* p) -> f32x4 { const u32x2 w = *(const u32x2*)p; return (f32x4){__uint_as_float(w.x << 16), __uint_as_float(w.x & 0xffff0000u), __uint_as_float(w.y << 16), __uint_as_float(w.y & 0xffff0000u)}; };
    for (unsigned i4 = (unsigned)gt; i4 < (unsigned)((n_pk + n_sk + n_ps + n_ss) / 4); i4 += (unsigned)gs) {
        const unsigned i = 4 * i4;
        if (i < n_pk) {
            const int b = (int)(i / (128 * 256)), s = (int)((i / 256) % 128), e = (int)(i % 256);
            const size_t row = (size_t)b * SEQ + (SEQ - 128) + s;
            *(f32x4*)(pk + i) = ld4(P + row * NP + CK + e); *(f32x4*)(pv_ + i) = ld4(P + row * NP + CV + e);
            continue;
        }
        unsigned k = i - (unsigned)n_pk;
        if (k < n_sk) {
            const int b = (int)(k / (128 * 256)), s = (int)((k / 256) % 128), e = (int)(k % 256);
            if (s < 120) { *(f32x4*)(sk + k) = *(const f32x4*)(ck + ((size_t)b * 128 + s + 8) * 256 + e); *(f32x4*)(sv + k) = *(const f32x4*)(cv + ((size_t)b * 128 + s + 8) * 256 + e); }
            else { const size_t row = (size_t)MP + b * DSEQ + (s - 120); *(f32x4*)(sk + k) = ld4(P + row * NP + CK + e); *(f32x4*)(sv + k) = ld4(P + row * NP + CV + e); }
            continue;
        }
        k -= (unsigned)n_sk;
        if (k < n_ps) { const int b = (int)(k / SHIFT_W), ch = (int)(k % SHIFT_W); *(f32x4*)(pshift + k) = ld4(P + ((size_t)b * SEQ + SEQ - 1) * NP + CRW + ch); continue; }
        k -= (unsigned)n_ps;
        { const int b = (int)(k / SHIFT_W), ch = (int)(k % SHIFT_W); *(f32x4*)(sshift + k) = ld4(P + ((size_t)MP + b * DSEQ + DSEQ - 1) * NP + CRW + ch); }
    }
}

#ifndef PROBE_MIXA
#define PROBE_MIXA 0
#endif
__device__ __forceinline__ void phase_mixa(const Args& a, int L, LAS unsigned char* lds) {
    const bf16_t* P = (const bf16_t*)(a.ws + WS_P); bf16_t* OA = (bf16_t*)(a.ws + WS_OA);
    const float* sinks = a.in[9] + L * 16; const float* ck = a.in[2] + (size_t)L * DBATCH * 128 * 256; const float* cv = a.in[3] + (size_t)L * DBATCH * 128 * 256;
    constexpr int N_RG1 = MP / 64, N_AP = NBATCH * 64 * 4, N_AS = DBATCH * 4;
    phase_elem_mixa(a, L);
    if (PROBE_MIXA & 1) phase_elem_mixa(a, L);
    for (int it = blockIdx.x; it < N_RG1; it += gridDim.x) { rglru_unit2<false>(a, L, it, lds); __syncthreads(); }
    if (PROBE_MIXA & 2) for (int it = blockIdx.x; it < N_RG1; it += gridDim.x) { rglru_unit2<false>(a, L, it, lds); __syncthreads(); }
    for (int r = blockIdx.x; r < N_AP; r += gridDim.x) { const int c = r & 3, qb = (r >> 2) & 63, b = r >> 8; attn_unit<false>(P, OA, sinks, ck, cv, b, qb, c, lds); }
    if (PROBE_MIXA & 4) for (int r = blockIdx.x; r < N_AP; r += gridDim.x) { const int c = r & 3, qb = (r >> 2) & 63, b = r >> 8; attn_unit<false>(P, OA, sinks, ck, cv, b, qb, c, lds); }
    for (int r = blockIdx.x; r < N_AS; r += gridDim.x) { const int c = r & 3, b = r >> 2; attn_unit<true>(P, OA, sinks, ck, cv, b, 0, c, lds); }
    if (PROBE_MIXA & 8) for (int r = blockIdx.x; r < N_AS; r += gridDim.x) { const int c = r & 3, b = r >> 2; attn_unit<true>(P, OA, sinks, ck, cv, b, 0, c, lds); }
}

struct EpiLora {
    static constexpr bool PERM = true, AFTER_DRAIN = false;
    bf16_t* WAW; bf16_t* WAA; bf16_t* WAG; const float* w0; const float* a0;
    __device__ __forceinline__ void operator()(const f32x4 (&acc)[2][2][4][2], const pg8::Unit& u, int wr, int wc, int fr, int fq) const {
        const int row0 = u.pm * 256 + wr * 64 + fr, kind = u.pn >> 2, colb = (u.pn & 3) * 256 + wc * 32 + 8 * fq;
        const float* bsrc = kind == 0 ? w0 : a0;
        f32x4 bias[2][2];
#pragma unroll
        for (int bj = 0; bj < 2; ++bj)
#pragma unroll
            for (int n = 0; n < 2; ++n) bias[bj][n] = kind == 2 ? (f32x4){0.f, 0.f, 0.f, 0.f} : *(const f32x4*)(bsrc + colb + bj * 128 + 4 * n);
#pragma unroll
        for (int ai = 0; ai < 2; ++ai)
#pragma unroll
            for (int m = 0; m < 4; ++m) {
                const size_t off = (size_t)(row0 + ai * 128 + m * 16) * D + colb;
#pragma unroll
                for (int bj = 0; bj < 2; ++bj) {
                    f32x4 v0 = acc[ai][bj][m][0] + bias[bj][0], v1 = acc[ai][bj][m][1] + bias[bj][1];
                    if (kind == 0) {
#pragma unroll
                        for (int i = 0; i < 4; ++i) {
                            v0[i] = -__expf(-(fmaxf(-v0[i], 0.f) + __logf(1.f + __expf(-fabsf(v0[i])))) - 0.5f);
                            v1[i] = -__expf(-(fmaxf(-v1[i], 0.f) + __logf(1.f + __expf(-fabsf(v1[i])))) - 0.5f);
                        }
                    } else if (kind == 1) {
#pragma unroll
                        for (int i = 0; i < 4; ++i) { v0[i] = sigmoidf_(v0[i]); v1[i] = sigmoidf_(v1[i]); }
                    }
                    u32x4 w; w.x = pk2bf(v0[0], v0[1]); w.y = pk2bf(v0[2], v0[3]); w.z = pk2bf(v1[0], v1[1]); w.w = pk2bf(v1[2], v1[3]);
                    *(u32x4*)(WAW + (size_t)kind * ((size_t)M * D) + off + bj * 128) = w;
                }
                asm volatile("" ::: "memory");
            }
    }
};

__device__ __forceinline__ void phase_mixc(const Args& a, int L, bf16_t* DST) {
    const int lane = threadIdx.x & 63, wv = threadIdx.x >> 6;
    const bf16_t* P = (const bf16_t*)(a.ws + WS_P); const bf16_t* WAG = (const bf16_t*)(a.ws + WS_WAG); const bf16_t* Y = (const bf16_t*)(a.ws + WS_Y); const float* BD = (const float*)(a.ws + WS_BD);
    bf16_t* OA = (bf16_t*)(a.ws + WS_OA); const bf16_t* OB = (const bf16_t*)(a.ws + WS_OB);
    const float* mu = a.in[17] + (size_t)L * SHIFT_W + 2048; const float* shift0 = a.in[6] + (size_t)L * DBATCH * SHIFT_W + 2048;
    const int c0 = 16 * lane, h = lane >> 2;
    float lw[16], lb[16], muv[16];
#pragma unroll
    for (int i = 0; i < 16; ++i) { lw[i] = a.in[26][L * D + c0 + i]; lb[i] = a.in[27][L * D + c0 + i]; muv[i] = mu[c0 + i]; }
    for (int m = blockIdx.x * NWAVES + wv; m < M; m += gridDim.x * NWAVES) {
        float y[16];
        { u32x4 yv[2]; yv[0] = *(const u32x4*)(Y + (size_t)m * D + c0); yv[1] = *(const u32x4*)(Y + (size_t)m * D + c0 + 8);
#pragma unroll
          for (int i = 0; i < 16; ++i) y[i] = __uint_as_float((i & 1) ? (yv[i >> 3][(i >> 1) & 3] & 0xffff0000u) : (yv[i >> 3][(i >> 1) & 3] << 16)); }
        float s = 0.f;
#pragma unroll
        for (int i = 0; i < 16; ++i) s += y[i];
        s += __shfl_xor(s, 1); s += __shfl_xor(s, 2);
        const float mean = s * (1.f / 64.f);
        float q = 0.f;
#pragma unroll
        for (int i = 0; i < 16; ++i) { y[i] -= mean; q += y[i] * y[i]; }
        q += __shfl_xor(q, 1); q += __shfl_xor(q, 2);
        const float rstd = rsqrtf(q * (1.f / 64.f) + GN_EPS);
        const float bd = BD[(size_t)m * 16 + h];
        const bool first = m < MP ? (m % SEQ) == 0 : ((m - MP) % DSEQ) == 0;
        const bf16_t* pr = P + (size_t)m * NP + CRW + 2048 + c0;
#define BFX(v, i) __uint_as_float((((i) & 1) ? ((v)[(i) >> 3][((i) >> 1) & 3] & 0xffff0000u) : ((v)[(i) >> 3][((i) >> 1) & 3] << 16)))
        u32x4 pcv[2], ppv[2], gv[2], gav[2], gbv[2], gcv[2], oav[2], obv[2];
        pcv[0] = *(const u32x4*)pr; pcv[1] = *(const u32x4*)(pr + 8);
        ppv[0] = pcv[0]; ppv[1] = pcv[1];
        if (!first) { ppv[0] = *(const u32x4*)(pr - NP); ppv[1] = *(const u32x4*)(pr - NP + 8); }
        gv[0] = *(const u32x4*)(WAG + (size_t)m * D + c0); gv[1] = *(const u32x4*)(WAG + (size_t)m * D + c0 + 8);
        const bf16_t* pg = P + (size_t)m * NP + CG + c0;
        gav[0] = *(const u32x4*)pg; gav[1] = *(const u32x4*)(pg + 8);
        gbv[0] = *(const u32x4*)(pg + 1024); gbv[1] = *(const u32x4*)(pg + 1024 + 8);
        gcv[0] = *(const u32x4*)(pg + 2048); gcv[1] = *(const u32x4*)(pg + 2048 + 8);
        oav[0] = *(const u32x4*)(OA + (size_t)m * D + c0); oav[1] = *(const u32x4*)(OA + (size_t)m * D + c0 + 8);
        obv[0] = *(const u32x4*)(OB + (size_t)m * D + c0); obv[1] = *(const u32x4*)(OB + (size_t)m * D + c0 + 8);
        float o[16];
#pragma unroll
        for (int i = 0; i < 16; ++i) {
            const float pc = BFX(pcv, i);
            float pv;
            if (first) pv = m < MP ? 0.f : shift0[(size_t)((m - MP) / DSEQ) * SHIFT_W + c0 + i];
            else pv = BFX(ppv, i);
            const float vv = pc + muv[i] * (pv - pc);
            const float yn = y[i] * rstd * lw[i] + lb[i];
            const float oc = (yn + bd * vv) * BFX(gv, i);
            o[i] = BFX(gav, i) * BFX(oav, i) + BFX(gbv, i) * BFX(obv, i) + BFX(gcv, i) * oc;
        }
        u32x4 w0, w1;
        w0.x = pk2bf(o[0], o[1]); w0.y = pk2bf(o[2], o[3]); w0.z = pk2bf(o[4], o[5]); w0.w = pk2bf(o[6], o[7]);
        w1.x = pk2bf(o[8], o[9]); w1.y = pk2bf(o[10], o[11]); w1.z = pk2bf(o[12], o[13]); w1.w = pk2bf(o[14], o[15]);
        *(u32x4*)(DST + (size_t)m * D + c0) = w0; *(u32x4*)(DST + (size_t)m * D + c0 + 8) = w1;
    }
}

constexpr int CH_OFF_AA = 0, CH_OFF_RA = 2048, CH_OFF_MC = 4096, CH_OFF_TL = 5120  , CH_OFF_BT = 5632, CH_OFF_KT = 7808, CH_OFF_VT = 9984, CH_OFF_GM = 12160, CH_SLOT = 12416;
constexpr int CH_TP = 136;
__device__ __forceinline__ float row_prefix16(float x) {
    x += __builtin_bit_cast(float, __builtin_amdgcn_update_dpp(0, __builtin_bit_cast(int, x), 0x111, 0xF, 0xF, true));
    x += __builtin_bit_cast(float, __builtin_amdgcn_update_dpp(0, __builtin_bit_cast(int, x), 0x112, 0xF, 0xF, true));
    x += __builtin_bit_cast(float, __builtin_amdgcn_update_dpp(0, __builtin_bit_cast(int, x), 0x114, 0xF, 0xF, true));
    x += __builtin_bit_cast(float, __builtin_amdgcn_update_dpp(0, __builtin_bit_cast(int, x), 0x118, 0xF, 0xF, true));
    return x;
}
__device__ __forceinline__ f32x4 prod16(const f32x4 xt, const f32x4 y) {
    f32x4 z = (f32x4){0.f, 0.f, 0.f, 0.f};
#pragma unroll
    for (int r = 0; r < 4; ++r) z = __builtin_amdgcn_mfma_f32_16x16x4f32(xt[r], y[r], z, 0, 0, 0);
    return z;
}
__device__ __forceinline__ f32x4 gram(const bf16x8_t (&x)[2], const bf16x8_t (&y)[2]) {
    f32x4 z = (f32x4){0.f, 0.f, 0.f, 0.f};
    z = __builtin_amdgcn_mfma_f32_16x16x32_bf16(x[0], y[0], z, 0, 0, 0);
    z = __builtin_amdgcn_mfma_f32_16x16x32_bf16(x[1], y[1], z, 0, 0, 0);
    return z;
}

struct ChunkRaw { u32x2 cr[4], ck[4], cv[4], a[4], x[4]; };
constexpr int CH_PAR_OFF = 8 * CH_SLOT;
constexpr int CH_PAR_BYTES = 6 * 64 * 4;
__device__ __forceinline__ void stage_head_params(const Args& a, int L, int h, LAS unsigned char* par, int lane) {
    LAS float* p = (LAS float*)par; const int c = 64 * h + lane;
    p[lane] = a.in[17][(size_t)L * SHIFT_W + c]; p[64 + lane] = a.in[17][(size_t)L * SHIFT_W + 1024 + c]; p[128 + lane] = a.in[17][(size_t)L * SHIFT_W + 2048 + c];
    p[192 + lane] = a.in[23][L * D + c]; p[256 + lane] = a.in[24][L * D + c]; p[320 + lane] = a.in[25][L * D + c];
}
__device__ __forceinline__ void chunk_load(const Args& a, size_t m0, int h, int ntok, int lane, ChunkRaw& R) {
    asm volatile("" : "+v"(lane));
    const int i16 = lane & 15, qp = lane >> 4;
    const bf16_t* P = (const bf16_t*)(a.ws + WS_P); const bf16_t* WAW = (const bf16_t*)(a.ws + WS_WAW); const bf16_t* WAA = (const bf16_t*)(a.ws + WS_WAA);
    const size_t m = m0 + (i16 < ntok ? i16 : 0);
#pragma unroll
    for (int r = 0; r < 4; ++r) {
        const int c = 64 * h + 16 * r + 4 * qp;
        const bf16_t* pr = P + m * NP + CRW + c;
        R.cr[r] = *(const u32x2*)pr; R.ck[r] = *(const u32x2*)(pr + 1024); R.cv[r] = *(const u32x2*)(pr + 2048);
        R.x[r] = *(const u32x2*)(WAW + m * D + c);
        R.a[r] = *(const u32x2*)(WAA + m * D + c);
    }
}
__device__ __forceinline__ unsigned dpp_prev_row(unsigned old, unsigned src) { return (unsigned)__builtin_amdgcn_update_dpp((int)old, (int)src, 0x111, 0xF, 0xF, false); }
template <class PF> __device__ __forceinline__ void chunk_compute(const Args& a, const ChunkRaw& R, size_t m0, int h, int ntok, bool seq_start, const float* sh0, const LAS unsigned char* par_, LAS unsigned char* slot, int lane, PF pf) {
    asm volatile("" : "+v"(lane));
    const int i16 = lane & 15, qp = lane >> 4;
    float* BD = (float*)(a.ws + WS_BD);
    const LAS float* par = (const LAS float*)par_;
    const bool valid = i16 < ntok;
    const size_t m = m0 + (valid ? i16 : 0);
    u32x2 p0r[4], p0k[4], p0v[4];
    {
        const bf16_t* P = (const bf16_t*)(a.ws + WS_P);
#pragma unroll
        for (int r = 0; r < 4; ++r) {
            const int c = 64 * h + 16 * r + 4 * qp;
            if (!seq_start) { const bf16_t* pp = P + (m0 - 1) * NP + CRW + c; p0r[r] = *(const u32x2*)pp; p0k[r] = *(const u32x2*)(pp + 1024); p0v[r] = *(const u32x2*)(pp + 2048); }
            else if (sh0) { const f32x4 fr_ = *(const f32x4*)(sh0 + c), fk_ = *(const f32x4*)(sh0 + 1024 + c), fv_ = *(const f32x4*)(sh0 + 2048 + c);
                p0r[r] = pk4(fr_[0], fr_[1], fr_[2], fr_[3]); p0k[r] = pk4(fk_[0], fk_[1], fk_[2], fk_[3]); p0v[r] = pk4(fv_[0], fv_[1], fv_[2], fv_[3]); }
            else { p0r[r] = (u32x2){0u, 0u}; p0k[r] = p0r[r]; p0v[r] = p0r[r]; }
        }
    }
    float abu[16], bbu[16];
    u32x2 pa[4], pb[4], pkk[4], prr[4];
    float ssq = 0.f, bdp = 0.f;
#pragma unroll
    for (int r = 0; r < 4; ++r) {
        const int cb = 16 * r + 4 * qp, c = 64 * h + cb;
        const u32x2 cr = R.cr[r], ck_ = R.ck[r], cv_ = R.cv[r], a4 = R.a[r];
        u32x2 pr_, pk_, pv_;
        pr_.x = dpp_prev_row(p0r[r].x, cr.x); pr_.y = dpp_prev_row(p0r[r].y, cr.y); pk_.x = dpp_prev_row(p0k[r].x, ck_.x); pk_.y = dpp_prev_row(p0k[r].y, ck_.y);
        pv_.x = dpp_prev_row(p0v[r].x, cv_.x); pv_.y = dpp_prev_row(p0v[r].y, cv_.y);
        const u32x2 x4 = R.x[r];
        const f32x4 mur = *(const LAS f32x4*)(par + cb), muk = *(const LAS f32x4*)(par + 64 + cb), muv = *(const LAS f32x4*)(par + 128 + cb);
        const f32x4 kkc = *(const LAS f32x4*)(par + 192 + cb), kac = *(const LAS f32x4*)(par + 256 + cb), rkc = *(const LAS f32x4*)(par + 320 + cb);
        float vv[4], kb[4], rb[4];
#pragma unroll
        for (int i = 0; i < 4; ++i) {
            const unsigned wr_ = i < 2 ? cr.x : cr.y, wk_ = i < 2 ? ck_.x : ck_.y, wv_ = i < 2 ? cv_.x : cv_.y, wa_ = i < 2 ? a4.x : a4.y, wx_ = i < 2 ? x4.x : x4.y;
            const unsigned qr_ = i < 2 ? pr_.x : pr_.y, qk_ = i < 2 ? pk_.x : pk_.y, qv_ = i < 2 ? pv_.x : pv_.y;
            const float c_r = __uint_as_float((i & 1) ? (wr_ & 0xffff0000u) : (wr_ << 16)), c_k = __uint_as_float((i & 1) ? (wk_ & 0xffff0000u) : (wk_ << 16)),
                        c_v = __uint_as_float((i & 1) ? (wv_ & 0xffff0000u) : (wv_ << 16)), a_ = __uint_as_float((i & 1) ? (wa_ & 0xffff0000u) : (wa_ << 16));
            const float p_r = __uint_as_float((i & 1) ? (qr_ & 0xffff0000u) : (qr_ << 16)), p_k = __uint_as_float((i & 1) ? (qk_ & 0xffff0000u) : (qk_ << 16)),
                  p_v = __uint_as_float((i & 1) ? (qv_ & 0xffff0000u) : (qv_ << 16));
            float r_ = c_r + mur[i] * (p_r - c_r), kx = c_k + muk[i] * (p_k - c_k), v_ = c_v + muv[i] * (p_v - c_v);
            float lw_ = __uint_as_float((i & 1) ? (wx_ & 0xffff0000u) : (wx_ << 16));
            if (!valid) { r_ = 0.f; kx = 0.f; v_ = 0.f; lw_ = 0.f; }
            const float kkr = kx * kkc[i];
            const float k2_ = kx * (1.f + (a_ - 1.f) * kac[i]);
            ssq += kkr * kkr; bdp += r_ * k2_ * rkc[i];
            const float g = row_prefix16(lw_);
            const float eg = __expf(g), egx = __expf(g - lw_), eng = __expf(-g);
            const int e = 4 * r + i;
            abu[e] = -kkr * egx; bbu[e] = kkr * a_ * eng; kb[i] = k2_ * eng; rb[i] = r_ * eg; vv[i] = v_;
            if (i16 == 15) *(LAS float*)(slot + CH_OFF_GM + 4 * (cb + i)) = eg;
        }
        const int off = i16 * CH_TP + cb * 2;
        pkk[r] = pk4(kb[0], kb[1], kb[2], kb[3]); prr[r] = pk4(rb[0], rb[1], rb[2], rb[3]);
        *(LAS u32x2*)(slot + CH_OFF_VT + off) = pk4(vv[0], vv[1], vv[2], vv[3]);
        *(LAS u32x2*)(slot + CH_OFF_KT + off) = pkk[r];
        asm volatile("" : "+v"(ssq), "+v"(bdp));
        __builtin_amdgcn_sched_barrier(0);
    }
    __builtin_amdgcn_sched_barrier(0);
    pf();
    __builtin_amdgcn_sched_barrier(0);
    ssq += __shfl_xor(ssq, 16); ssq += __shfl_xor(ssq, 32);
    bdp += __shfl_xor(bdp, 16); bdp += __shfl_xor(bdp, 32);
    if (valid && qp == 0) BD[m * 16 + h] = bdp;
    const float inrm = 1.f / fmaxf(sqrtf(ssq), 1e-12f);
#pragma unroll
    for (int r = 0; r < 4; ++r) {
        pa[r] = pk4(abu[4 * r] * inrm, abu[4 * r + 1] * inrm, abu[4 * r + 2] * inrm, abu[4 * r + 3] * inrm);
        pb[r] = pk4(bbu[4 * r] * inrm, bbu[4 * r + 1] * inrm, bbu[4 * r + 2] * inrm, bbu[4 * r + 3] * inrm);
        const int off = i16 * CH_TP + (16 * r + 4 * qp) * 2;
        *(LAS u32x2*)(slot + CH_OFF_AA + off) = pa[r];
        *(LAS u32x2*)(slot + CH_OFF_BT + off) = pb[r];
    }
    __builtin_amdgcn_sched_barrier(0);
    bf16x8_t fa[2], fb[2], fk[2], fr[2];
#pragma unroll
    for (int ks = 0; ks < 2; ++ks) { fa[ks] = mk_frag(pa[2 * ks], pa[2 * ks + 1]); fb[ks] = mk_frag(pb[2 * ks], pb[2 * ks + 1]); fk[ks] = mk_frag(pkk[2 * ks], pkk[2 * ks + 1]); fr[ks] = mk_frag(prr[2 * ks], prr[2 * ks + 1]); }
    f32x4 Lc = gram(fa, fb), Nc = gram(fb, fa), Lak = gram(fa, fk), MrbT = gram(fb, fr), MrkT = gram(fk, fr);
#pragma unroll
    for (int r = 0; r < 4; ++r) {
        const int row = 4 * qp + r;
        Lc[r] = row > i16 ? Lc[r] : 0.f;
        Lak[r] = row > i16 ? Lak[r] : 0.f;
        Nc[r] = row < i16 ? Nc[r] : 0.f;
        MrbT[r] = row <= i16 ? MrbT[r] : 0.f;
        MrkT[r] = row <= i16 ? MrkT[r] : 0.f;
    }
    __builtin_amdgcn_sched_barrier(0);
    f32x4 eye;
#pragma unroll
    for (int r = 0; r < 4; ++r) eye[r] = (4 * qp + r == i16) ? 1.f : 0.f;
    const f32x4 L2 = prod16(Nc, Lc), N2 = prod16(Lc, Nc);
    const f32x4 L4 = prod16(N2, L2), N4 = prod16(L2, N2);
    const f32x4 N8 = prod16(L4, N4);
    const f32x4 Q1 = prod16(Lc + eye, N2 + eye), Q1T = prod16(N2 + eye, Lc + eye), Q2 = prod16(L4 + eye, N8 + eye);
    const f32x4 TT = prod16(Q1T, Q2);
    const f32x4 TLk = prod16(Lak, TT);
    __builtin_amdgcn_sched_barrier(0);
    LDSW();
    const bf16x8_t ttf = mk_frag(pk4(TT[0], TT[1], TT[2], TT[3]), (u32x2){0u, 0u});
    f32x4 at[4];
#pragma unroll
    for (int kt = 0; kt < 4; ++kt) {
        const u32x2 ac = tr_read4(slot + CH_OFF_AA + (4 * qp + (i16 >> 2)) * CH_TP + (16 * kt + 4 * (i16 & 3)) * 2);
        at[kt] = __builtin_amdgcn_mfma_f32_16x16x32_bf16(mk_frag(ac, (u32x2){0u, 0u}), ttf, (f32x4){0.f, 0.f, 0.f, 0.f}, 0, 0, 0);
    }
    LDSW();
#pragma unroll
    for (int ks = 0; ks < 2; ++ks) {
        const u32x2 lo = pk4(at[2 * ks][0], at[2 * ks][1], at[2 * ks][2], at[2 * ks][3]), hi = pk4(at[2 * ks + 1][0], at[2 * ks + 1][1], at[2 * ks + 1][2], at[2 * ks + 1][3]);
        *(LAS u32x4*)(slot + CH_OFF_AA + ks * 1024 + lane * 16) = (u32x4){lo.x, lo.y, hi.x, hi.y};
        *(LAS u32x4*)(slot + CH_OFF_RA + ks * 1024 + lane * 16) = __builtin_bit_cast(u32x4, fr[ks]);
    }
    {
        const u32x2 mb = pk4(MrbT[0], MrbT[1], MrbT[2], MrbT[3]), mk = pk4(MrkT[0], MrkT[1], MrkT[2], MrkT[3]), tl = pk4(TLk[0], TLk[1], TLk[2], TLk[3]);
        *(LAS u32x4*)(slot + CH_OFF_MC + lane * 16) = (u32x4){mb.x, mb.y, mk.x, mk.y};
        *(LAS u32x2*)(slot + CH_OFF_TL + lane * 8) = tl;
    }
}

struct ChainFrag { u32x4 aa0, aa1, ra0, ra1, mc, tl; u32x2 vq4, b4[4], k4[4]; f32x4 gm[4]; };
__device__ __forceinline__ void chain_fetch(LAS unsigned char* slot, int vq, int lane, ChainFrag& F) {
    const int i16 = lane & 15, qp = lane >> 4;
    const int troff = (4 * qp + (i16 >> 2)) * CH_TP + 8 * (i16 & 3);
    { const u32x2 t2 = *(const LAS u32x2*)(slot + CH_OFF_TL + lane * 8); F.tl = (u32x4){t2.x, t2.y, 0u, 0u}; }
    F.vq4 = tr_read4(slot + CH_OFF_VT + troff + 32 * vq);
    F.aa0 = *(const LAS u32x4*)(slot + CH_OFF_AA + lane * 16); F.aa1 = *(const LAS u32x4*)(slot + CH_OFF_AA + 1024 + lane * 16);
    F.ra0 = *(const LAS u32x4*)(slot + CH_OFF_RA + lane * 16); F.ra1 = *(const LAS u32x4*)(slot + CH_OFF_RA + 1024 + lane * 16);
    F.mc = *(const LAS u32x4*)(slot + CH_OFF_MC + lane * 16);
#pragma unroll
    for (int kt = 0; kt < 4; ++kt) {
        F.b4[kt] = tr_read4(slot + CH_OFF_BT + troff + 32 * kt); F.k4[kt] = tr_read4(slot + CH_OFF_KT + troff + 32 * kt);
        F.gm[kt] = *(const LAS f32x4*)(slot + CH_OFF_GM + 4 * (16 * kt + 4 * qp));
    }
}
__device__ __forceinline__ f32x4 chain_math(const ChainFrag& F, f32x4 (&ST)[4]) {
    const f32x4 z4 = (f32x4){0.f, 0.f, 0.f, 0.f};
    const f32x4 tlv = __builtin_amdgcn_mfma_f32_16x16x32_bf16(__builtin_bit_cast(bf16x8_t, F.tl), mk_frag(F.vq4, F.vq4), z4, 0, 0, 0);
    bf16x8_t sb[2];
#pragma unroll
    for (int ks = 0; ks < 2; ++ks) sb[ks] = mk_frag(pk4(ST[2 * ks][0], ST[2 * ks][1], ST[2 * ks][2], ST[2 * ks][3]), pk4(ST[2 * ks + 1][0], ST[2 * ks + 1][1], ST[2 * ks + 1][2], ST[2 * ks + 1][3]));
    const f32x4 u1 = __builtin_amdgcn_mfma_f32_16x16x32_bf16(__builtin_bit_cast(bf16x8_t, F.aa0), sb[0], z4, 0, 0, 0);
    const f32x4 u2 = __builtin_amdgcn_mfma_f32_16x16x32_bf16(__builtin_bit_cast(bf16x8_t, F.aa1), sb[1], tlv, 0, 0, 0);
    f32x4 Y = __builtin_amdgcn_mfma_f32_16x16x32_bf16(__builtin_bit_cast(bf16x8_t, F.ra0), sb[0], z4, 0, 0, 0);
    const f32x4 y2 = __builtin_amdgcn_mfma_f32_16x16x32_bf16(__builtin_bit_cast(bf16x8_t, F.ra1), sb[1], z4, 0, 0, 0);
    const f32x4 U = u1 + u2;
    const bf16x8_t uv = mk_frag(pk4(U[0], U[1], U[2], U[3]), F.vq4);
#pragma unroll
    for (int kt = 0; kt < 4; ++kt) {
        ST[kt] = __builtin_amdgcn_mfma_f32_16x16x32_bf16(mk_frag(F.b4[kt], F.k4[kt]), uv, ST[kt], 0, 0, 0);
        ST[kt] = ST[kt] * F.gm[kt];
    }
    Y = __builtin_amdgcn_mfma_f32_16x16x32_bf16(__builtin_bit_cast(bf16x8_t, F.mc), uv, Y, 0, 0, 0);
    return Y + y2;
}
struct ChainFrag2 { u32x4 aa0, aa1, ra0, ra1, mc, tl; u32x2 va, vb, b4[4], k4[4]; f32x4 gm[4]; };
__device__ __forceinline__ void chain_fetch2(LAS unsigned char* slot, int vq0, int lane, ChainFrag2& F) {
    const int i16 = lane & 15, qp = lane >> 4;
    const int troff = (4 * qp + (i16 >> 2)) * CH_TP + 8 * (i16 & 3);
    { const u32x2 t2 = *(const LAS u32x2*)(slot + CH_OFF_TL + lane * 8); F.tl = (u32x4){t2.x, t2.y, 0u, 0u}; }
    F.va = tr_read4(slot + CH_OFF_VT + troff + 32 * vq0); F.vb = tr_read4(slot + CH_OFF_VT + troff + 32 * (vq0 + 1));
    F.aa0 = *(const LAS u32x4*)(slot + CH_OFF_AA + lane * 16); F.aa1 = *(const LAS u32x4*)(slot + CH_OFF_AA + 1024 + lane * 16);
    F.ra0 = *(const LAS u32x4*)(slot + CH_OFF_RA + lane * 16); F.ra1 = *(const LAS u32x4*)(slot + CH_OFF_RA + 1024 + lane * 16);
    F.mc = *(const LAS u32x4*)(slot + CH_OFF_MC + lane * 16);
#pragma unroll
    for (int kt = 0; kt < 4; ++kt) {
        F.b4[kt] = tr_read4(slot + CH_OFF_BT + troff + 32 * kt); F.k4[kt] = tr_read4(slot + CH_OFF_KT + troff + 32 * kt);
        F.gm[kt] = *(const LAS f32x4*)(slot + CH_OFF_GM + 4 * (16 * kt + 4 * qp));
    }
}
__device__ __forceinline__ void chain_math2(const ChainFrag2& F, f32x4 (&SA)[4], f32x4 (&SB)[4], f32x4& YA, f32x4& YB) {
    const f32x4 z4 = (f32x4){0.f, 0.f, 0.f, 0.f};
    const bf16x8_t tl = __builtin_bit_cast(bf16x8_t, F.tl), aa0 = __builtin_bit_cast(bf16x8_t, F.aa0), aa1 = __builtin_bit_cast(bf16x8_t, F.aa1),
                   ra0 = __builtin_bit_cast(bf16x8_t, F.ra0), ra1 = __builtin_bit_cast(bf16x8_t, F.ra1), mc = __builtin_bit_cast(bf16x8_t, F.mc);
    const f32x4 tlva = __builtin_amdgcn_mfma_f32_16x16x32_bf16(tl, mk_frag(F.va, F.va), z4, 0, 0, 0);
    const f32x4 tlvb = __builtin_amdgcn_mfma_f32_16x16x32_bf16(tl, mk_frag(F.vb, F.vb), z4, 0, 0, 0);
    bf16x8_t sa[2], sb[2];
#pragma unroll
    for (int ks = 0; ks < 2; ++ks) {
        sa[ks] = mk_frag(pk4(SA[2 * ks][0], SA[2 * ks][1], SA[2 * ks][2], SA[2 * ks][3]), pk4(SA[2 * ks + 1][0], SA[2 * ks + 1][1], SA[2 * ks + 1][2], SA[2 * ks + 1][3]));
        sb[ks] = mk_frag(pk4(SB[2 * ks][0], SB[2 * ks][1], SB[2 * ks][2], SB[2 * ks][3]), pk4(SB[2 * ks + 1][0], SB[2 * ks + 1][1], SB[2 * ks + 1][2], SB[2 * ks + 1][3]));
    }
    const f32x4 ua1 = __builtin_amdgcn_mfma_f32_16x16x32_bf16(aa0, sa[0], z4, 0, 0, 0);
    const f32x4 ub1 = __builtin_amdgcn_mfma_f32_16x16x32_bf16(aa0, sb[0], z4, 0, 0, 0);
    const f32x4 ua2 = __builtin_amdgcn_mfma_f32_16x16x32_bf16(aa1, sa[1], tlva, 0, 0, 0);
    const f32x4 ub2 = __builtin_amdgcn_mfma_f32_16x16x32_bf16(aa1, sb[1], tlvb, 0, 0, 0);
    f32x4 ya = __builtin_amdgcn_mfma_f32_16x16x32_bf16(ra0, sa[0], z4, 0, 0, 0);
    f32x4 yb = __builtin_amdgcn_mfma_f32_16x16x32_bf16(ra0, sb[0], z4, 0, 0, 0);
    const f32x4 ya2 = __builtin_amdgcn_mfma_f32_16x16x32_bf16(ra1, sa[1], z4, 0, 0, 0);
    const f32x4 yb2 = __builtin_amdgcn_mfma_f32_16x16x32_bf16(ra1, sb[1], z4, 0, 0, 0);
    const f32x4 UA = ua1 + ua2, UB = ub1 + ub2;
    const bf16x8_t uva = mk_frag(pk4(UA[0], UA[1], UA[2], UA[3]), F.va), uvb = mk_frag(pk4(UB[0], UB[1], UB[2], UB[3]), F.vb);
#pragma unroll
    for (int kt = 0; kt < 4; ++kt) {
        const bf16x8_t bk = mk_frag(F.b4[kt], F.k4[kt]);
        SA[kt] = __builtin_amdgcn_mfma_f32_16x16x32_bf16(bk, uva, SA[kt], 0, 0, 0);
        SB[kt] = __builtin_amdgcn_mfma_f32_16x16x32_bf16(bk, uvb, SB[kt], 0, 0, 0);
    }
#pragma unroll
    for (int kt = 0; kt < 4; ++kt) { SA[kt] = SA[kt] * F.gm[kt]; SB[kt] = SB[kt] * F.gm[kt]; }
    ya = __builtin_amdgcn_mfma_f32_16x16x32_bf16(mc, uva, ya, 0, 0, 0);
    yb = __builtin_amdgcn_mfma_f32_16x16x32_bf16(mc, uvb, yb, 0, 0, 0);
    YA = ya + ya2; YB = yb + yb2;
}
__device__ __forceinline__ f32x4 chain_step(LAS unsigned char* slot, f32x4 (&ST)[4], int vq, int lane) { ChainFrag F; chain_fetch(slot, vq, lane, F); return chain_math(F, ST); }

constexpr int N_CH_P = MP / 16 * 16, N_CH_S = DBATCH * 16, N_CH = N_CH_P + N_CH_S;
static_assert(WS_CB + (size_t)N_CH * CH_SLOT <= (size_t)861000000, "chunk buffer fits the workspace");
constexpr int CH_VEC = CH_SLOT / 16;
__device__ __forceinline__ void slot_to_global(const LAS unsigned char* slot, unsigned char* g, int lane) {
#pragma unroll
    for (int i = 0; i < 13; ++i) { const int v = i * 64 + lane; if (v < CH_VEC) *(u32x4*)(g + (size_t)v * 16) = *(const LAS u32x4*)(slot + v * 16); }
}
struct SlotRegs { u32x4 v[13]; };
__device__ __forceinline__ void slot_load(const unsigned char* g, int lane, SlotRegs& S) {
    asm volatile("" : "+v"(lane));
#pragma unroll
    for (int i = 0; i < 13; ++i) { const int v = i * 64 + lane; S.v[i] = *(const u32x4*)(g + (size_t)(v < CH_VEC ? v : 0) * 16); }
}
__device__ __forceinline__ void slot_store(LAS unsigned char* slot, int lane, const SlotRegs& S) {
    asm volatile("" : "+v"(lane));
#pragma unroll
    for (int i = 0; i < 13; ++i) { const int v = i * 64 + lane; if (v < CH_VEC) *(LAS u32x4*)(slot + v * 16) = S.v[i]; }
}
__device__ __forceinline__ void phase_c1(const Args& a, int L, LAS unsigned char* lds) {
    const int tid = threadIdx.x, lane = tid & 63, wv = __builtin_amdgcn_readfirstlane(tid >> 6);
    LAS unsigned char* slot = lds + wv * CH_SLOT; LAS unsigned char* par = lds + CH_PAR_OFF + wv * CH_PAR_BYTES;
    unsigned char* CB = a.ws + WS_CB;
    rglru_prefix(a);
    const int stride = gridDim.x * NWAVES;
    auto item = [&](int ci, size_t& m0, int& ntok, bool& ss, const float*& sh0) {
        sh0 = nullptr;
        if (ci < N_CH_P) { const int chunk = ci >> 4; m0 = (size_t)chunk * 16; ntok = 16; ss = (chunk & (SEQ / 16 - 1)) == 0; }
        else { const int b = (ci - N_CH_P) >> 4; m0 = (size_t)MP + (size_t)b * DSEQ; ntok = DSEQ; ss = true; sh0 = a.in[6] + ((size_t)L * DBATCH + b) * SHIFT_W; }
    };
    auto fetch = [&](int ci, ChunkRaw& R) { size_t m0; int ntok; bool ss; const float* sh0; item(ci, m0, ntok, ss, sh0); chunk_load(a, m0, ci & 15, ntok, lane, R); };
    int ci = blockIdx.x * NWAVES + wv;
    ChunkRaw R;
    if (ci < N_CH) fetch(ci, R);
    for (; ci < N_CH; ci += stride) {
        const int h = ci & 15; size_t m0; int ntok; bool ss; const float* sh0; item(ci, m0, ntok, ss, sh0);
        stage_head_params(a, L, h, par, lane);
        LDSW();
        chunk_compute(a, R, m0, h, ntok, ss, sh0, par, slot, lane, [&]() { if (ci + stride < N_CH) fetch(ci + stride, R); });
        LDSW();
        const size_t sid = ci < N_CH_P ? ((size_t)((ci >> 4) >> 9) * 16 + h) * (SEQ / 16) + ((ci >> 4) & (SEQ / 16 - 1)) : (size_t)ci;
        slot_to_global(slot, CB + sid * CH_SLOT, lane);
        LDSW();
    }
}

#define WG_BAR() do { asm volatile("s_waitcnt lgkmcnt(0)" ::: "memory"); __builtin_amdgcn_s_barrier(); asm volatile("" ::: "memory"); } while (0)
template <int DRY> __device__ __forceinline__ void wkv_prompt_chain(const Args& a, int L, int b, int h, LAS unsigned char* lds) {
    const int tid = threadIdx.x, lane = tid & 63, wv = __builtin_amdgcn_readfirstlane(tid >> 6), i16 = lane & 15, qp = lane >> 4;
    bf16_t* Y = (bf16_t*)(a.ws + WS_Y);
    const unsigned char* CB = a.ws + WS_CB;
    constexpr int NR = SEQ / 64;
    const size_t ci0 = ((size_t)b * 16 + h) * (SEQ / 16);
    if (wv >= 4) {
        const int lw = wv - 4;
        SlotRegs S0, S1, S2;
#define CB_GROUP(k) (CB + (ci0 + (size_t)(4 * (k) + lw)) * CH_SLOT)
        slot_load(CB_GROUP(0), lane, S0);
        slot_store(lds + lw * CH_SLOT, lane, S0);
        slot_load(CB_GROUP(1), lane, S1); slot_load(CB_GROUP(2), lane, S2); slot_load(CB_GROUP(3), lane, S0);
        WG_BAR();
        for (int g = 0; g < NR; g += 6) {
#define LROUND(r, SET) do { if ((r) < NR) { if (DRY != 2) if ((r) + 1 < NR) slot_store(lds + ((((r) + 1) & 1) * 4 + lw) * CH_SLOT, lane, SET); if (DRY != 2) if ((r) + 4 < NR) slot_load(CB_GROUP((r) + 4), lane, SET); WG_BAR(); } } while (0)
            LROUND(g, S1); LROUND(g + 1, S2); LROUND(g + 2, S0); LROUND(g + 3, S1); LROUND(g + 4, S2); LROUND(g + 5, S0);
#undef LROUND
        }
#undef CB_GROUP
    } else if (wv < 2) {
        f32x4 SA[4], SB[4];
#pragma unroll
        for (int kt = 0; kt < 4; ++kt) { SA[kt] = (f32x4){0.f, 0.f, 0.f, 0.f}; SB[kt] = SA[kt]; }
        WG_BAR();
        bf16_t* yrow = Y + ((size_t)b * SEQ) * D + 64 * h + 32 * wv;
        for (int g = 0; g < NR; ++g) {
            LAS unsigned char* gs = lds + (g & 1) * 4 * CH_SLOT;
            ChainFrag2 FA, FB;
            f32x4 ya[4], yb[4];
#define SB0() __builtin_amdgcn_sched_barrier(0)
            if (DRY == 3) { WG_BAR(); continue; }
            chain_fetch2(gs, 2 * wv, lane, FA);
            chain_fetch2(gs + CH_SLOT, 2 * wv, lane, FB); SB0();
            chain_math2(FA, SA, SB, ya[0], yb[0]); SB0();
            chain_fetch2(gs + 2 * CH_SLOT, 2 * wv, lane, FA); SB0();
            chain_math2(FB, SA, SB, ya[1], yb[1]); SB0();
            chain_fetch2(gs + 3 * CH_SLOT, 2 * wv, lane, FB); SB0();
            chain_math2(FA, SA, SB, ya[2], yb[2]); SB0();
            chain_math2(FB, SA, SB, ya[3], yb[3]); SB0();
#undef SB0
            {
                LAS unsigned char* yt = lds + CH_PAR_OFF + wv * 4608;
#pragma unroll
                for (int j = 0; j < 4; ++j)
#pragma unroll
                    for (int r = 0; r < 4; ++r) {
                        *(LAS unsigned short*)(yt + (16 * j + 4 * qp + r) * 72 + 2 * i16) = f2bf(ya[j][r]);
                        *(LAS unsigned short*)(yt + (16 * j + 4 * qp + r) * 72 + 2 * (16 + i16)) = f2bf(yb[j][r]);
                    }
                LDSW();
#pragma unroll
                for (int j = 0; j < 4; ++j) {
                    const int row = 16 * j + (lane >> 2), pc = lane & 3;
                    const u32x2 lo = *(const LAS u32x2*)(yt + row * 72 + pc * 16), hi = *(const LAS u32x2*)(yt + row * 72 + pc * 16 + 8);
                    if (DRY == 0) *(u32x4*)(yrow + (size_t)row * D + 8 * pc) = (u32x4){lo.x, lo.y, hi.x, hi.y};
                    else asm volatile("" :: "v"(lo), "v"(hi));
                }
                LDSW();
            }
            yrow += (size_t)64 * D;
            WG_BAR();
        }
        float* o = a.out + O_PWKV + ((((size_t)L * NBATCH + b) * 16 + h) * 64 + 32 * wv + i16) * 64;
#pragma unroll
        for (int kt = 0; kt < 4; ++kt) { if (DRY == 0) { *(f32x4*)(o + 16 * kt + 4 * qp) = SA[kt]; *(f32x4*)(o + 16 * 64 + 16 * kt + 4 * qp) = SB[kt]; } else asm volatile("" :: "v"(SA[kt]), "v"(SB[kt])); }
    } else {
        WG_BAR();
        for (int g = 0; g < NR; ++g) WG_BAR();
    }
    __syncthreads();
}
#undef WG_BAR
__device__ __forceinline__ void wkv_sample_chain(const Args& a, int L, int b, int ho, LAS unsigned char* lds) {
    const int tid = threadIdx.x, lane = tid & 63, wv = __builtin_amdgcn_readfirstlane(tid >> 6), i16 = lane & 15, qp = lane >> 4;
    const int h = 8 * ho + wv;
    bf16_t* Y = (bf16_t*)(a.ws + WS_Y);
    LAS unsigned char* slot = lds + wv * CH_SLOT;
    const size_t m0 = (size_t)MP + (size_t)b * DSEQ;
    { SlotRegs S; slot_load(a.ws + WS_CB + ((size_t)N_CH_P + (size_t)b * 16 + h) * CH_SLOT, lane, S); slot_store(slot, lane, S); }
    LDSW();
    for (int vp = 0; vp < 2; ++vp) {
        const size_t so = ((((size_t)L * DBATCH + b) * 16 + h) * 64 + 32 * vp + i16) * 64;
        f32x4 SA[4], SB[4];
#pragma unroll
        for (int kt = 0; kt < 4; ++kt) { SA[kt] = *(const f32x4*)(a.in[7] + so + 16 * kt + 4 * qp); SB[kt] = *(const f32x4*)(a.in[7] + so + 16 * 64 + 16 * kt + 4 * qp); }
        ChainFrag2 F; chain_fetch2(slot, 2 * vp, lane, F);
        f32x4 ya, yb; chain_math2(F, SA, SB, ya, yb);
#pragma unroll
        for (int r = 0; r < 4; ++r) if (4 * qp + r < DSEQ) { Y[(m0 + 4 * qp + r) * D + 64 * h + 32 * vp + i16] = f2bf(ya[r]); Y[(m0 + 4 * qp + r) * D + 64 * h + 32 * vp + 16 + i16] = f2bf(yb[r]); }
#pragma unroll
        for (int kt = 0; kt < 4; ++kt) { *(f32x4*)(a.out + O_SWKV + so + 16 * kt + 4 * qp) = SA[kt]; *(f32x4*)(a.out + O_SWKV + so + 16 * 64 + 16 * kt + 4 * qp) = SB[kt]; }
    }
    __syncthreads();
}

#ifndef PROBE_MIXB
#define PROBE_MIXB 0
#endif
__device__ __forceinline__ void phase_mixb2(const Args& a, int L, LAS unsigned char* lds) {
    constexpr int N_PC = NBATCH * 16;
    const int G = gridDim.x, bx = blockIdx.x;
    const int first_other = (G > 2 * N_PC) ? N_PC : 0;
    for (int it = bx; it < N_PC; it += G) wkv_prompt_chain<0>(a, L, it >> 4, it & 15, lds);
    if (PROBE_MIXB & 1) for (int it = bx; it < N_PC; it += G) wkv_prompt_chain<0>(a, L, it >> 4, it & 15, lds);
    if (PROBE_MIXB & 8) for (int it = bx; it < N_PC; it += G) wkv_prompt_chain<1>(a, L, it >> 4, it & 15, lds);
    if (PROBE_MIXB & 16) for (int it = bx; it < N_PC; it += G) wkv_prompt_chain<2>(a, L, it >> 4, it & 15, lds);
    if (PROBE_MIXB & 32) for (int it = bx; it < N_PC; it += G) wkv_prompt_chain<3>(a, L, it >> 4, it & 15, lds);
    if (bx < first_other) return;
    const int nb = G - first_other, id = bx - first_other;
    constexpr int N_RG2 = M / 64, N_SC = DBATCH * 2;
    phase_state_copies(a, L, first_other);
    for (int it = id; it < N_RG2; it += nb) { rglru_unit2<true>(a, L, it, lds); __syncthreads(); }
    if (PROBE_MIXB & 4) for (int it = id; it < N_RG2; it += nb) { rglru_unit2<true>(a, L, it, lds); __syncthreads(); }
    {
        const int second = (N_RG2 > nb) ? N_RG2 - nb : 0;
        const int start = id >= second ? id - second : id + (nb - second);
        for (int it = start; it < N_SC; it += nb) wkv_sample_chain(a, L, it >> 1, it & 1, lds);
        if (PROBE_MIXB & 2) for (int it = start; it < N_SC; it += nb) wkv_sample_chain(a, L, it >> 1, it & 1, lds);
    }
}
#ifndef PROBE_MASK
#define PROBE_MASK 0
#endif
#define PH_IN(k) (lo <= (k) && (k) < hi)
#define RUN_PHASE(po, ...) do { { __VA_ARGS__ } if (((PROBE_MASK >> (po)) & 1) && PH_IN(base + (po))) { cg::this_grid().sync(); { __VA_ARGS__ } } } while (0)
#define PH_SYNC(k) do { if (lo < (k) && (k) < hi) cg::this_grid().sync(); } while (0)
template <int L> __device__ __forceinline__ void layer_phases(const Args& a, LAS unsigned char* lds, int lo, int hi) {
    unsigned char* ws = a.ws;
    const int G = gridDim.x;
    constexpr int base = PH_L0 + L * PH_PER_LAYER;
    PH_SYNC(base + PHO_IN);
    RUN_PHASE(PHO_IN, if (PH_IN(base + PHO_IN)) {
        pg8::Gemm g{(const bf16_t*)(ws + WS_XB), (const bf16_t*)(ws + WS_WIN), M, NP, D}; pg8::StaticOrder S; S.init(M, NP, G, (int)blockIdx.x);
        EpiIn E{(bf16_t*)(ws + WS_P), NP, CG / 256};
        pg8::gemm_phase<EpiIn, pg8::StaticOrder, true, true>(lds, g, S, E);
    });
    PH_SYNC(base + PHO_MIXA);
    RUN_PHASE(PHO_MIXA, if (PH_IN(base + PHO_MIXA)) phase_mixa(a, L, lds););
    PH_SYNC(base + PHO_LORA);
    RUN_PHASE(PHO_LORA, if (PH_IN(base + PHO_LORA)) {
        pg8::Gemm g{(const bf16_t*)(ws + WS_ACAT), (const bf16_t*)(ws + WS_WLORA), M, 3072, ACAT_K}; pg8::StaticOrder S; S.init(M, 3072, G, (int)blockIdx.x);
        EpiLora E{(bf16_t*)(ws + WS_WAW), (bf16_t*)(ws + WS_WAA), (bf16_t*)(ws + WS_WAG), a.in[18] + L * D, a.in[20] + L * D};
        pg8::gemm_phase<EpiLora, pg8::StaticOrder, true, true>(lds, g, S, E);
    });
    PH_SYNC(base + PHO_C1);
    RUN_PHASE(PHO_C1, if (PH_IN(base + PHO_C1)) phase_c1(a, L, lds););
    PH_SYNC(base + PHO_MIXB);
    RUN_PHASE(PHO_MIXB, if (PH_IN(base + PHO_MIXB)) phase_mixb2(a, L, lds););
    PH_SYNC(base + PHO_MIXC);
    if (PH_IN(base + PHO_MIXC)) {
#if defined(PROBE_MIXC)
        phase_mixc(a, L, (bf16_t*)(ws + WS_CB)); cg::this_grid().sync();
#endif
        phase_mixc(a, L, (bf16_t*)(ws + WS_OA));
    }
    PH_SYNC(base + PHO_OUT);
    RUN_PHASE(PHO_OUT, if (PH_IN(base + PHO_OUT)) {
        {
            pg8::Gemm g{(const bf16_t*)(ws + WS_MIX), (const bf16_t*)(ws + WS_WOUT), MP, D, D}; pg8::StaticOrder S; S.init(MP, D, G, (int)blockIdx.x);
            if (L == 0) { EpiZ<false> E{a.in[0], (float*)(ws + WS_Z), D}; pg8::gemm_phase<EpiZ<false>, pg8::StaticOrder, true, true>(lds, g, S, E); }
            else { EpiZ<true> E{ws + WS_XB, (float*)(ws + WS_Z), D}; pg8::gemm_phase<EpiZ<true>, pg8::StaticOrder, true, true>(lds, g, S, E); }
        }
        {
            pg8::Gemm g{(const bf16_t*)(ws + WS_MIX) + (size_t)MP * D, (const bf16_t*)(ws + WS_WOUTS), MS, 4 * D, 256, D, 256, 4, (size_t)512}; pg8::StaticOrder S; S.init(MS, 4 * D, G, (int)blockIdx.x);
            if (L == 0) { EpiZS<false> E{a.in[1], (float*)(ws + WS_ZS), D}; pg8::gemm_phase<EpiZS<false>, pg8::StaticOrder, true, true>(lds, g, S, E); }
            else { EpiZS<true> E{ws + WS_XB + (size_t)MP * D * 2, (float*)(ws + WS_ZS), D}; pg8::gemm_phase<EpiZS<true>, pg8::StaticOrder, true, true>(lds, g, S, E); }
        }
    });
    PH_SYNC(base + PHO_LN1);
    RUN_PHASE(PHO_LN1, if (PH_IN(base + PHO_LN1)) phase_ln<4>((const float*)(ws + WS_Z), (const float*)(ws + WS_ZS), a.in[29] + L * D, a.in[30] + L * D, nullptr, (bf16_t*)(ws + WS_X1B)););
    PH_SYNC(base + PHO_GU);
    RUN_PHASE(PHO_GU, if (PH_IN(base + PHO_GU)) {
        pg8::Gemm g{(const bf16_t*)(ws + WS_X1B), (const bf16_t*)(ws + WS_WGU), M, 2 * DFF, D}; pg8::StaticOrder S; S.init(M, 2 * DFF, G, (int)blockIdx.x);
        EpiSwiGLU E{(bf16_t*)(ws + WS_H), DFF};
        pg8::gemm_phase<EpiSwiGLU, pg8::StaticOrder, true, true>(lds, g, S, E);
    });
    PH_SYNC(base + PHO_DOWN);
    RUN_PHASE(PHO_DOWN, if (PH_IN(base + PHO_DOWN)) {
        {
            pg8::Gemm g{(const bf16_t*)(ws + WS_H), (const bf16_t*)(ws + WS_WDN), MP, D, DFF}; pg8::StaticOrder S; S.init(MP, D, G, (int)blockIdx.x);
            EpiZ<true> E{ws + WS_X1B, (float*)(ws + WS_Z), D};
            pg8::gemm_phase<EpiZ<true>, pg8::StaticOrder, true, true>(lds, g, S, E);
        }
        {
            pg8::Gemm g{(const bf16_t*)(ws + WS_H) + (size_t)MP * DFF, (const bf16_t*)(ws + WS_WDNS), MS, 11 * D, 256, DFF, 256, 4, (size_t)512}; pg8::StaticOrder S; S.init(MS, 11 * D, G, (int)blockIdx.x);
            EpiZS<true> E{ws + WS_X1B + (size_t)MP * D * 2, (float*)(ws + WS_ZS), D};
            pg8::gemm_phase<EpiZS<true>, pg8::StaticOrder, true, true>(lds, g, S, E);
        }
    });
    PH_SYNC(base + PHO_LN2);
    RUN_PHASE(PHO_LN2, if (PH_IN(base + PHO_LN2)) {
        if (L == DEPTH - 1) phase_ln<11>((const float*)(ws + WS_Z), (const float*)(ws + WS_ZS), a.in[33] + L * D, a.in[34] + L * D, a.out + O_YP, nullptr);
        else { phase_ln<11>((const float*)(ws + WS_Z), (const float*)(ws + WS_ZS), a.in[33] + L * D, a.in[34] + L * D, nullptr, (bf16_t*)(ws + WS_XB)); phase_prep_weights(a, L + 1, lds); }
    });
}
__global__ void __launch_bounds__(NTHREADS, 2) mega(Args a) {
    extern __shared__ __attribute__((aligned(16))) unsigned char lds_raw[];
    LAS unsigned char* lds = (LAS unsigned char*)lds_raw;
    const int lo = a.ph_lo, hi = a.ph_hi;
    if (PH_IN(PH_PREP)) { phase_prep_weights(a, 0, lds); phase_prep_x(a); }
    layer_phases<0>(a, lds, lo, hi);
    layer_phases<1>(a, lds, lo, hi);
}

static void launch_mega(Args a, int lo, int hi, int grid, hipStream_t s) {
    a.ph_lo = lo; a.ph_hi = hi;
    void* args[] = {&a};
    hipError_t e;
    if (hi - lo > 1) e = hipLaunchCooperativeKernel((void*)mega, dim3(grid), dim3(NTHREADS), args, LDS_BYTES, s);
    else e = hipLaunchKernel((void*)mega, dim3(grid), dim3(NTHREADS), args, LDS_BYTES, s);
    if (e != hipSuccess) fprintf(stderr, "mega launch [%d,%d) failed: %s (grid %d)\n", lo, hi, hipGetErrorString(e), grid);
}

extern "C" void kernel_launch(void* const* d_in, const int* in_sizes, int n_in, void* d_out, int out_size,
                              void* d_ws, size_t ws_size, hipStream_t stream) {
    if (ws_size < WS_END || out_size != (int)O_END || n_in != 35) { fprintf(stderr, "kernel_launch: unexpected sizes ws=%zu out=%d n_in=%d\n", ws_size, out_size, n_in); return; }
    static int grid = 0;
    if (!grid) {
        int dev = 0, cus = 0, per_cu = 0;
        (void)hipGetDevice(&dev);
        (void)hipDeviceGetAttribute(&cus, hipDeviceAttributeMultiprocessorCount, dev);
        (void)hipFuncSetAttribute((const void*)mega, hipFuncAttributeMaxDynamicSharedMemorySize, LDS_BYTES);
        (void)hipOccupancyMaxActiveBlocksPerMultiprocessor(&per_cu, (const void*)mega, NTHREADS, LDS_BYTES);
        if (per_cu < 1) { fprintf(stderr, "occupancy query says %d blocks per CU\n", per_cu); per_cu = 1; }
        grid = cus * per_cu;
    }
    const float* const* in = (const float* const*)d_in;
    unsigned char* ws = (unsigned char*)d_ws;
    float* out = (float*)d_out;
    Args a{};
    for (int i = 0; i < 35; ++i) a.in[i] = in[i];
    a.out = out; a.ws = ws;
    launch_mega(a, 0, N_PHASES, grid, stream);
}
```

```cpp
#include <hip/hip_runtime.h>
#include <cstdint>
#include <cstdio>

typedef unsigned short bf16_t;
__device__ __forceinline__ float bf2f(bf16_t v) { return __uint_as_float(((unsigned)v) << 16); }
typedef float f32x2c_t __attribute__((ext_vector_type(2))); typedef __bf16 bf16x2c_t __attribute__((ext_vector_type(2)));
__device__ __forceinline__ bf16_t f2bf(float f) { f32x2c_t v = {f, f}; bf16x2c_t b = __builtin_convertvector(v, bf16x2c_t); return (bf16_t)(__builtin_bit_cast(unsigned, b) & 0xffffu); }
__device__ __forceinline__ float sigmoidf_(float x) { return __builtin_amdgcn_rcpf(1.f + __expf(-x)); }
__device__ __forceinline__ float softplusf_(float x) { return fmaxf(x, 0.f) + log1pf(__expf(-fabsf(x))); }
__device__ __forceinline__ float wave_sum(float v) {
#pragma unroll
    for (int o = 1; o < 64; o <<= 1) v += __shfl_xor(v, o);
    return v;
}

constexpr int D = 1024, MP = 16384, MS = 1024, M = MP + MS, SEQ = 8192, DSEQ = 8, NBATCH = 2, DBATCH = 128, DEPTH = 2;
constexpr int NP = 9216, IN_COLS = 8992;
constexpr int CQ = 0, CK = 1024, CV = 1280, CRNN = 1536, CRW = 2560, CG = 6144;
constexpr int SHIFT_W = 3360, DFF = 2816;
constexpr float ALPHA = 1.4142135623730951f;
constexpr float LN_EPS = 1e-5f, GN_EPS = 64e-5f;

constexpr size_t O_YP = 0, O_YS = 16777216, O_PK = 17825792, O_PV = 17956864, O_PCONV = 18087936, O_PH = 18100224,
                 O_PSHIFT = 18104320, O_PWKV = 18117760, O_SK = 18379904, O_SV = 26768512, O_SCONV = 35157120,
                 O_SH = 35943552, O_SSHIFT = 36205696, O_SWKV = 37065856, O_END = 53843072;


constexpr size_t MiB = 1u << 20;
constexpr size_t WS_CTL = 0;
constexpr size_t WIN_T_BYTES = (size_t)NP * D * 2, WOUT_T_BYTES = (size_t)D * D * 2, WGU_T_BYTES = (size_t)2 * DFF * D * 2, WDN_T_BYTES = (size_t)D * DFF * 2;
constexpr int ACAT_K = 384;
constexpr size_t WLORA_BYTES = (size_t)3072 * ACAT_K * 2;
constexpr size_t WS_WIN = 1 * MiB;
constexpr size_t WS_WOUT = WS_WIN + WIN_T_BYTES;
constexpr size_t WS_WGU = WS_WOUT + WOUT_T_BYTES;
constexpr size_t WS_WDN = WS_WGU + WGU_T_BYTES;
constexpr size_t WS_WOUTS = WS_WDN + WDN_T_BYTES;
constexpr size_t WS_WDNS = WS_WOUTS + WOUT_T_BYTES;
constexpr size_t WS_WLORA = WS_WDNS + WDN_T_BYTES;
constexpr size_t WS_XB = WS_WLORA + WLORA_BYTES;
constexpr size_t WS_OA = WS_XB + (size_t)M * D * 2;
constexpr size_t WS_MIX = WS_OA;
constexpr size_t WS_OB = WS_OA + (size_t)M * D * 2;
constexpr size_t WS_P = WS_OB + (size_t)M * D * 2;
constexpr size_t WS_Z = WS_P;
constexpr size_t WS_ZS = WS_Z + (size_t)M * D * 4;
constexpr size_t WS_X1B = WS_ZS + (size_t)11 * MS * D * 4;
constexpr size_t WS_H = WS_X1B + (size_t)M * D * 2;
constexpr size_t WS_PEND = WS_P + (size_t)M * NP * 2;
constexpr size_t WS_RS = WS_PEND;
constexpr size_t WS_WAW = WS_RS + (size_t)2 * 128 * 1024 * 2 * 4;
constexpr size_t WS_WAA = WS_WAW + (size_t)M * D * 2;
constexpr size_t WS_WAG = WS_WAA + (size_t)M * D * 2;
constexpr size_t WS_Y = WS_WAG + (size_t)M * D * 2;
constexpr size_t WS_BD = WS_Y + (size_t)M * D * 2;
constexpr size_t WS_ACAT = WS_BD + (size_t)M * 16 * 4;
constexpr size_t WS_CB = WS_ACAT;
constexpr size_t WS_END = WS_ACAT + (size_t)M * ACAT_K * 2;
static_assert(WS_END <= (size_t)861000000, "workspace budget (4 x output bytes = 861.5 MB)");
static_assert(WS_H + (size_t)M * DFF * 2 <= WS_PEND, "overlay fits");
static_assert(WS_WAA == WS_WAW + (size_t)M * D * 2 && WS_WAG == WS_WAA + (size_t)M * D * 2, "lora outputs contiguous");
static_assert(WS_XB % 256 == 0 && WS_P % 256 == 0 && WS_WLORA % 256 == 0 && WS_ACAT % 256 == 0, "alignment");
namespace pg8 {
#define PG8_LAS __attribute__((address_space(3)))
typedef unsigned short bf16_t;
typedef short bf16x8 __attribute__((ext_vector_type(8)));
typedef float f32x4 __attribute__((ext_vector_type(4)));
typedef unsigned u32x4 __attribute__((ext_vector_type(4)));
constexpr int BM = 256, BK = 64, HALF = 128, HTB = HALF * BK * 2  , STAGE_BYTES = 8 * HTB, NXCD = 8, WGM = 8;

__host__ __device__ __forceinline__ int lds_byte(int r, int c) { const int st = (r >> 4) * 2 + (c >> 5), rr = r & 15, cc = c & 31, ob = rr * 64 + cc * 2; return st * 1024 + (ob ^ (((ob >> 9) & 1) << 5)); }
__host__ __device__ __forceinline__ void stage_rc(int b, int& R, int& C) { const int st = b / 1024, sb = b % 1024, swz = sb ^ (((sb >> 9) & 1) << 5); R = (st >> 1) * 16 + swz / 64; C = (st & 1) * 32 + (swz % 64) / 2; }
__host__ __device__ __forceinline__ int perm32(int rho) { const int n = rho >> 4, i = rho & 15; return 8 * (i >> 2) + 4 * n + (i & 3); }

struct Unit { int pm, pn; };
struct Gemm { const bf16_t* A; const bf16_t* Bt; int M, N, K; int lda = 0, ldb = 0, nsplit = 0; size_t a_koff = 0; };

struct StaticOrder {
    int nM, nN, nwg, G, c;
    __host__ __device__ void init(int M, int N, int G_, int c_) { nM = M / BM; nN = N / BM; nwg = nM * nN; G = G_; c = c_; }
    __host__ __device__ bool next(int i, Unit& u) const {
        const long L = (long)i * G + c; if (L >= nwg) return false;
        int wgid = (int)L; { const int q = nwg / NXCD, r = nwg % NXCD, xcd = wgid % NXCD, off = wgid / NXCD; wgid = (xcd < r ? xcd * (q + 1) : r * (q + 1) + (xcd - r) * q) + off; }
        const int nig = WGM * nN, gid = wgid / nig, fm = gid * WGM, gsz = (nM - fm) < WGM ? (nM - fm) : WGM;
        u.pm = fm + ((wgid % nig) % gsz); u.pn = (wgid % nig) / gsz; return true;
    }
    __device__ __forceinline__ void a_ready(const Unit&) const {}
    __device__ __forceinline__ void done(const Unit&) const {}
};

__device__ __forceinline__ unsigned cvt_pk_bf16(float lo, float hi) { unsigned r; asm volatile("v_cvt_pk_bf16_f32 %0, %1, %2" : "=v"(r) : "v"(lo), "v"(hi)); return r; }
typedef float f32x2 __attribute__((ext_vector_type(2)));
template <class Epi, class Sched, bool ALIGN_EPI = false, bool SP2 = false>
__device__ __forceinline__ void gemm_phase(PG8_LAS unsigned char* lds, const Gemm g, const Sched& S, const Epi& E) {
    const int tid = threadIdx.x, wid = __builtin_amdgcn_readfirstlane(tid >> 6), lane = tid & 63, wr = wid >> 2, wc = wid & 3, fr = lane & 15, fq = lane >> 4;
    const int K = g.K, nt = K / BK, lda = g.lda ? g.lda : K, ldb = g.ldb ? g.ldb : K;
    unsigned voffA[2], voffB[2];
#pragma unroll
    for (int i = 0; i < 2; ++i) { int R, C; stage_rc(tid * 16 + i * 8192, R, C); const int Rb = Epi::PERM ? ((R & ~31) + perm32(R & 31)) : R;
        voffA[i] = (unsigned)(R * lda + C) * 2u; voffB[i] = (unsigned)(Rb * ldb + C) * 2u; }
    const size_t kstep = (size_t)(BK * 2);
    const size_t hstepA = (size_t)HALF * lda * 2, hstepB = (size_t)HALF * ldb * 2;
    const size_t tstepA = 2 * hstepA, tstepB = 2 * hstepB;
#define PG8_ABASE(u) ((const char*)g.A + (size_t)(u).pm * tstepA + (g.nsplit ? (size_t)((u).pn / g.nsplit) * g.a_koff : (size_t)0))
    const unsigned ldsw = (unsigned)wid * 1024u;
    const int aoff = lds_byte(wr * 64 + fr, fq * 8), boff = lds_byte(wc * 32 + fr, fq * 8);
#define PG8_SA(b, h) (((b) * 2 + (h)) * HTB)
#define PG8_SB(b, h) ((4 + (b) * 2 + (h)) * HTB)
#define PG8_STAGE(bufoff, gbase, voff) do { _Pragma("unroll") for (int _i = 0; _i < 2; ++_i) \
        __builtin_amdgcn_global_load_lds((const unsigned*)((const char*)(gbase) + (voff)[_i]), (PG8_LAS unsigned*)(lds + (bufoff) + ldsw + _i * 8192), 16, 0, 0); } while (0)
#define PG8_LDA(dst, b, h) do { _Pragma("unroll") for (int m = 0; m < 4; ++m) _Pragma("unroll") for (int k = 0; k < 2; ++k) dst[m][k] = *(const PG8_LAS bf16x8*)(lds + PG8_SA(b, h) + aoff + m * 2048 + k * 1024); } while (0)
#define PG8_LDB(dst, b, h) do { _Pragma("unroll") for (int n = 0; n < 2; ++n) _Pragma("unroll") for (int k = 0; k < 2; ++k) dst[n][k] = *(const PG8_LAS bf16x8*)(lds + PG8_SB(b, h) + boff + n * 2048 + k * 1024); } while (0)
#define PG8_MMA(ai, bj, At, Bt) do { __builtin_amdgcn_s_setprio(1); _Pragma("unroll") for (int m = 0; m < 4; ++m) _Pragma("unroll") for (int n = 0; n < 2; ++n) _Pragma("unroll") for (int k = 0; k < 2; ++k) \
        acc[ai][bj][m][n] = __builtin_amdgcn_mfma_f32_16x16x32_bf16(Bt[n][k], At[m][k], acc[ai][bj][m][n], 0, 0, 0); __builtin_amdgcn_s_setprio(0); } while (0)
#define PG8_WAIT_V(n) asm volatile("s_waitcnt vmcnt(" #n ")" ::: "memory")
#define PG8_WAIT_L(n) asm volatile("s_waitcnt lgkmcnt(" #n ")" ::: "memory")
#define PG8_BAR __builtin_amdgcn_s_barrier()
#define PG8_SCHED __builtin_amdgcn_sched_barrier(0)
    Unit cur, nxt; int ui = 0;
    if (!S.next(0, cur)) return;
    f32x4 acc[2][2][4][2];
#pragma unroll
    for (int a = 0; a < 2; ++a)
#pragma unroll
        for (int b = 0; b < 2; ++b)
#pragma unroll
            for (int m = 0; m < 4; ++m)
#pragma unroll
                for (int n = 0; n < 2; ++n) acc[a][b][m][n] = (f32x4){0.f, 0.f, 0.f, 0.f};
    bf16x8 At[4][2], B0[2][2], B1[2][2];
    const char* cA = PG8_ABASE(cur); const char* cB = (const char*)g.Bt + (size_t)cur.pn * tstepB;
    S.a_ready(cur);
    if constexpr (SP2) {
        PG8_STAGE(PG8_SB(0, 0), cB, voffB); PG8_STAGE(PG8_SB(0, 1), cB + hstepB, voffB); PG8_STAGE(PG8_SA(0, 0), cA, voffA); PG8_STAGE(PG8_SA(0, 1), cA + hstepA, voffA);
        if (wr == 1) PG8_BAR;
        PG8_WAIT_V(2); PG8_BAR;
        PG8_STAGE(PG8_SB(1, 0), cB + kstep, voffB); PG8_STAGE(PG8_SA(1, 0), cA + kstep, voffA); PG8_STAGE(PG8_SB(1, 1), cB + hstepB + kstep, voffB);
        PG8_WAIT_V(6); PG8_BAR;
    } else {
        PG8_STAGE(PG8_SB(0, 0), cB, voffB); PG8_STAGE(PG8_SA(0, 0), cA, voffA); PG8_STAGE(PG8_SB(0, 1), cB + hstepB, voffB); PG8_STAGE(PG8_SA(0, 1), cA + hstepA, voffA);
        if (wr == 1) PG8_BAR;
        PG8_WAIT_V(4); PG8_BAR;
        PG8_STAGE(PG8_SB(1, 0), cB + kstep, voffB); PG8_STAGE(PG8_SA(1, 0), cA + kstep, voffA); PG8_STAGE(PG8_SB(1, 1), cB + hstepB + kstep, voffB);
        PG8_WAIT_V(6); PG8_BAR;
    }
    for (;;) {
        const bool has_next = S.next(ui + 1, nxt);
        const char* nA = has_next ? PG8_ABASE(nxt) : cA; const char* nB = has_next ? (const char*)g.Bt + (size_t)nxt.pn * tstepB : cB;
#pragma nounroll
        for (int t = 0; t < nt; t += 2) {
            const bool last = (t == nt - 2);
            const char* a1 = cA + (size_t)(t + 1) * kstep;
            const char* a2 = last ? nA : cA + (size_t)(t + 2) * kstep; const char* b2 = last ? nB : cB + (size_t)(t + 2) * kstep;
            const char* a3 = a2 + kstep; const char* b3 = b2 + kstep;
            if (last && has_next) S.a_ready(nxt);
            if constexpr (SP2) {
            PG8_LDB(B0, 0, 0); PG8_LDB(B1, 0, 1); PG8_SCHED; PG8_LDA(At, 0, 0); PG8_STAGE(PG8_SA(1, 1), a1 + hstepA, voffA);
            PG8_WAIT_V(8); PG8_WAIT_L(0); PG8_BAR; PG8_MMA(0, 0, At, B0); PG8_MMA(0, 1, At, B1); PG8_BAR; PG8_SCHED;
            PG8_LDA(At, 0, 1); PG8_STAGE(PG8_SB(0, 0), b2, voffB); PG8_STAGE(PG8_SB(0, 1), b2 + hstepB, voffB); PG8_STAGE(PG8_SA(0, 0), a2, voffA);
            PG8_WAIT_V(8); PG8_WAIT_L(0); PG8_BAR; PG8_MMA(1, 0, At, B0); PG8_MMA(1, 1, At, B1); PG8_BAR; PG8_SCHED;
            PG8_LDB(B0, 1, 0); PG8_LDB(B1, 1, 1); PG8_SCHED; PG8_LDA(At, 1, 0); PG8_STAGE(PG8_SA(0, 1), a2 + hstepA, voffA);
            PG8_WAIT_V(8); PG8_WAIT_L(0); PG8_BAR; PG8_MMA(0, 0, At, B0); PG8_MMA(0, 1, At, B1); PG8_BAR; PG8_SCHED;
            PG8_LDA(At, 1, 1); PG8_STAGE(PG8_SB(1, 0), b3, voffB); PG8_STAGE(PG8_SB(1, 1), b3 + hstepB, voffB); PG8_STAGE(PG8_SA(1, 0), a3, voffA);
            PG8_WAIT_V(8); PG8_WAIT_L(0); PG8_BAR; PG8_MMA(1, 0, At, B0); PG8_MMA(1, 1, At, B1); PG8_BAR; PG8_SCHED;
            } else {
            PG8_LDB(B0, 0, 0); PG8_SCHED; PG8_LDA(At, 0, 0); PG8_STAGE(PG8_SA(1, 1), a1 + hstepA, voffA);
            PG8_WAIT_L(8); PG8_BAR; PG8_WAIT_L(0); PG8_MMA(0, 0, At, B0); PG8_BAR; PG8_SCHED;
            PG8_LDB(B1, 0, 1); PG8_STAGE(PG8_SB(0, 0), b2, voffB);
            PG8_BAR; PG8_WAIT_L(0); PG8_MMA(0, 1, At, B1); PG8_BAR;
            PG8_LDA(At, 0, 1); PG8_STAGE(PG8_SA(0, 0), a2, voffA);
            PG8_BAR; PG8_WAIT_L(0); PG8_MMA(1, 0, At, B0); PG8_BAR; PG8_SCHED;
            PG8_STAGE(PG8_SB(0, 1), b2 + hstepB, voffB);
            PG8_WAIT_V(6); PG8_BAR; PG8_MMA(1, 1, At, B1); PG8_BAR;
            PG8_LDB(B0, 1, 0); PG8_SCHED; PG8_LDA(At, 1, 0); PG8_STAGE(PG8_SA(0, 1), a2 + hstepA, voffA);
            PG8_WAIT_L(8); PG8_BAR; PG8_WAIT_L(0); PG8_MMA(0, 0, At, B0); PG8_BAR; PG8_SCHED;
            PG8_LDB(B1, 1, 1); PG8_STAGE(PG8_SB(1, 0), b3, voffB);
            PG8_BAR; PG8_WAIT_L(0); PG8_MMA(0, 1, At, B1); PG8_BAR;
            PG8_LDA(At, 1, 1); PG8_STAGE(PG8_SA(1, 0), a3, voffA);
            PG8_BAR; PG8_WAIT_L(0); PG8_MMA(1, 0, At, B0); PG8_BAR; PG8_SCHED;
            PG8_STAGE(PG8_SB(1, 1), b3 + hstepB, voffB);
            PG8_WAIT_V(6); PG8_BAR; PG8_MMA(1, 1, At, B1); PG8_BAR;
            }
        }
        if constexpr (ALIGN_EPI) { if (wr == 0) PG8_BAR; }
        if constexpr (!Epi::AFTER_DRAIN) { E(acc, cur, wr, wc, fr, fq); S.done(cur); }
        if (!has_next) break;
#pragma unroll
        for (int a = 0; a < 2; ++a)
#pragma unroll
            for (int b = 0; b < 2; ++b)
#pragma unroll
                for (int m = 0; m < 4; ++m)
#pragma unroll
                    for (int n = 0; n < 2; ++n) acc[a][b][m][n] = (f32x4){0.f, 0.f, 0.f, 0.f};
        cur = nxt; cA = nA; cB = nB; ++ui;
        if constexpr (ALIGN_EPI) { if (wr == 1) PG8_BAR; }
    }
    PG8_WAIT_V(0);
    if constexpr (!ALIGN_EPI) { if (wr == 0) PG8_BAR; }
    PG8_BAR;
    if constexpr (Epi::AFTER_DRAIN) { E.fused(acc, cur, wr, wc, fr, fq, lds, wid, lane); S.done(cur); }
#undef PG8_ABASE
#undef PG8_SA
#undef PG8_SB
#undef PG8_STAGE
#undef PG8_LDA
#undef PG8_LDB
#undef PG8_MMA
#undef PG8_WAIT_V
#undef PG8_WAIT_L
#undef PG8_BAR
#undef PG8_SCHED
}
}

#include <hip/hip_cooperative_groups.h>
namespace cg = cooperative_groups;
#define LAS __attribute__((address_space(3)))
typedef float f32x4 __attribute__((ext_vector_type(4)));
typedef unsigned u32x4 __attribute__((ext_vector_type(4)));
typedef unsigned u32x2 __attribute__((ext_vector_type(2)));

constexpr int NTHREADS = 512, NWAVES = 8;
constexpr int LDS_BYTES = 147456;

constexpr int PH_PREP = 0, PH_PER_LAYER = 11, PH_L0 = 1;
constexpr int PHO_IN = 0, PHO_MIXA = 1, PHO_LORA = 2, PHO_C1 = 3, PHO_MIXB = 4, PHO_MIXC = 5, PHO_OUT = 6, PHO_LN1 = 7, PHO_GU = 8, PHO_DOWN = 9, PHO_LN2 = 10;
constexpr int N_PHASES = PH_L0 + DEPTH * PH_PER_LAYER;

struct Args { const float* in[35]; float* out; unsigned char* ws; int ph_lo, ph_hi; };

typedef float f32x2_t __attribute__((ext_vector_type(2))); typedef __bf16 bf16x2_t __attribute__((ext_vector_type(2)));
__device__ __forceinline__ unsigned pk2bf(float lo, float hi) { f32x2_t v = {lo, hi}; bf16x2_t b = __builtin_convertvector(v, bf16x2_t); return __builtin_bit_cast(unsigned, b); }

struct EpiIn {
    static constexpr bool PERM = true, AFTER_DRAIN = false;
    bf16_t* O; int ldc; int sig_pn;
    __device__ __forceinline__ void operator()(const f32x4 (&acc)[2][2][4][2], const pg8::Unit& u, int wr, int wc, int fr, int fq) const {
        const int row0 = u.pm * 256 + wr * 64 + fr, col0 = u.pn * 256 + wc * 32 + 8 * fq;
        const bool sg = u.pn >= sig_pn;
#pragma unroll
        for (int ai = 0; ai < 2; ++ai)
#pragma unroll
            for (int m = 0; m < 4; ++m) {
                bf16_t* rowp = O + (size_t)(row0 + ai * 128 + m * 16) * ldc + col0;
#pragma unroll
                for (int bj = 0; bj < 2; ++bj) {
                    f32x4 v0 = acc[ai][bj][m][0], v1 = acc[ai][bj][m][1];
                    if (sg) {
#pragma unroll
                        for (int i = 0; i < 4; ++i) { v0[i] = sigmoidf_(v0[i]); v1[i] = sigmoidf_(v1[i]); }
                    }
                    u32x4 w; w.x = pk2bf(v0[0], v0[1]); w.y = pk2bf(v0[2], v0[3]); w.z = pk2bf(v1[0], v1[1]); w.w = pk2bf(v1[2], v1[3]);
                    *(u32x4*)(rowp + bj * 128) = w;
                }
                asm volatile("" ::: "memory");
            }
    }
};
template <bool RESB> struct EpiZ {
    static constexpr bool PERM = false, AFTER_DRAIN = false;
    const void* res; float* Z; int ldc;
    __device__ __forceinline__ void operator()(const f32x4 (&acc)[2][2][4][2], const pg8::Unit& u, int wr, int wc, int fr, int fq) const {
        const int col0 = u.pn * 256 + wc * 32 + 4 * fq;
#pragma unroll
        for (int ai = 0; ai < 2; ++ai)
#pragma unroll
            for (int m = 0; m < 4; ++m) {
                const size_t off = (size_t)(u.pm * 256 + ai * 128 + wr * 64 + m * 16 + fr) * ldc + col0;
#pragma unroll
                for (int bj = 0; bj < 2; ++bj)
#pragma unroll
                    for (int n = 0; n < 2; ++n) {
                        f32x4 r;
                        if (RESB) { const u32x2 w = *(const u32x2*)((const bf16_t*)res + off + bj * 128 + n * 16);
                            r = (f32x4){__uint_as_float(w.x << 16), __uint_as_float(w.x & 0xffff0000u), __uint_as_float(w.y << 16), __uint_as_float(w.y & 0xffff0000u)}; }
                        else r = *(const f32x4*)((const float*)res + off + bj * 128 + n * 16);
                        *(f32x4*)(Z + off + bj * 128 + n * 16) = r * ALPHA + acc[ai][bj][m][n];
                    }
                asm volatile("" ::: "memory");
            }
    }
};
template <bool RESB> struct EpiZS {
    static constexpr bool PERM = false, AFTER_DRAIN = false;
    const void* res; float* ZS; int ldc;
    __device__ __forceinline__ void operator()(const f32x4 (&acc)[2][2][4][2], const pg8::Unit& u, int wr, int wc, int fr, int fq) const {
        const int ks = u.pn >> 2, col0 = (u.pn & 3) * 256 + wc * 32 + 4 * fq;
        float* Z = ZS + (size_t)ks * MS * D;
#pragma unroll
        for (int ai = 0; ai < 2; ++ai)
#pragma unroll
            for (int m = 0; m < 4; ++m) {
                const size_t off = (size_t)(u.pm * 256 + ai * 128 + wr * 64 + m * 16 + fr) * ldc + col0;
#pragma unroll
                for (int bj = 0; bj < 2; ++bj)
#pragma unroll
                    for (int n = 0; n < 2; ++n) {
                        f32x4 o = acc[ai][bj][m][n];
                        if (ks == 0) {
                            f32x4 r;
                            if (RESB) { const u32x2 w = *(const u32x2*)((const bf16_t*)res + off + bj * 128 + n * 16);
                                r = (f32x4){__uint_as_float(w.x << 16), __uint_as_float(w.x & 0xffff0000u), __uint_as_float(w.y << 16), __uint_as_float(w.y & 0xffff0000u)}; }
                            else r = *(const f32x4*)((const float*)res + off + bj * 128 + n * 16);
                            o = r * ALPHA + o;
                        }
                        *(f32x4*)(Z + off + bj * 128 + n * 16) = o;
                    }
                asm volatile("" ::: "memory");
            }
    }
};
struct EpiSwiGLU {
    static constexpr bool PERM = true, AFTER_DRAIN = false;
    bf16_t* H; int ldc;
    __device__ __forceinline__ void operator()(const f32x4 (&acc)[2][2][4][2], const pg8::Unit& u, int wr, int wc, int fr, int fq) const {
        const int row0 = u.pm * 256 + wr * 64 + fr, col0 = u.pn * 128 + wc * 32 + 8 * fq;
#pragma unroll
        for (int ai = 0; ai < 2; ++ai)
#pragma unroll
            for (int m = 0; m < 4; ++m) {
                bf16_t* rowp = H + (size_t)(row0 + ai * 128 + m * 16) * ldc + col0;
                float o[8];
#pragma unroll
                for (int n = 0; n < 2; ++n)
#pragma unroll
                    for (int i = 0; i < 4; ++i) { const float g = acc[ai][0][m][n][i], up = acc[ai][1][m][n][i]; o[n * 4 + i] = g * sigmoidf_(g) * up; }
                u32x4 w; w.x = pk2bf(o[0], o[1]); w.y = pk2bf(o[2], o[3]); w.z = pk2bf(o[4], o[5]); w.w = pk2bf(o[6], o[7]);
                *(u32x4*)rowp = w;
                asm volatile("" ::: "memory");
            }
    }
};

template <int MODE> __device__ __forceinline__ int colmap(int n) {
    if (MODE == 0) return n < 5920 ? n : (n < 6144 ? -1 : n - 224);
    if (MODE == 2) { const int pn = n >> 8, q = n & 255; return q < 128 ? pn * 128 + q : DFF + pn * 128 + (q - 128); }
    return n;
}
template <int MODE> __device__ __forceinline__ void transpose_item(const float* __restrict__ W, int K, int ldw, bf16_t* WT, int item, int nblk, LAS float* tile, int tid, bf16_t* WS2 = nullptr, int kpart = 0, int nrows = 0) {
    const int kb = item / nblk, nb = item % nblk, k0 = kb * 64, n0 = nb * 64;
    {
        const int n4 = tid & 15; const int col = colmap<MODE>(n0 + 4 * n4);
#pragma unroll
        for (int i = 0; i < 2; ++i) {
            const int kk = i * 32 + (tid >> 4);
            const f32x4 v = col >= 0 ? *(const f32x4*)(W + (size_t)(k0 + kk) * ldw + col) : (f32x4){0.f, 0.f, 0.f, 0.f};
            LAS float* t = tile + kk * 65 + 4 * n4; t[0] = v[0]; t[1] = v[1]; t[2] = v[2]; t[3] = v[3];
        }
    }
    __syncthreads();
    {
        const int nn = tid >> 3, c = tid & 7; const LAS float* s = tile + (8 * c) * 65 + nn;
        u32x4 o; o.x = pk2bf(s[0], s[65]); o.y = pk2bf(s[2 * 65], s[3 * 65]); o.z = pk2bf(s[4 * 65], s[5 * 65]); o.w = pk2bf(s[6 * 65], s[7 * 65]);
        *(u32x4*)(WT + (size_t)(n0 + nn) * K + k0 + 8 * c) = o;
        if (WS2) { const int ks = k0 / kpart; *(u32x4*)(WS2 + ((size_t)ks * nrows + n0 + nn) * kpart + (k0 - ks * kpart) + 8 * c) = o; }
    }
    __syncthreads();
}
__device__ __forceinline__ void prep_rg_weights(const Args& a, int l);
__device__ __forceinline__ void phase_prep_weights(const Args& a, int l, LAS unsigned char* lds) {
    const int tid = threadIdx.x, G = gridDim.x, bx = blockIdx.x;
    LAS float* tile = (LAS float*)lds;
    constexpr int I_IN = (D / 64) * (NP / 64), I_OUT = (D / 64) * (D / 64), I_GU = (D / 64) * (2 * DFF / 64), I_DN = (DFF / 64) * (D / 64);
    constexpr int I_LAYER = I_IN + I_OUT + I_GU + I_DN;
    for (int it = bx; it < I_LAYER; it += G) {
        int r = it;
        if (r < I_IN) { transpose_item<0>(a.in[8] + (size_t)l * D * IN_COLS, D, IN_COLS, (bf16_t*)(a.ws + WS_WIN), r, NP / 64, tile, tid); continue; } r -= I_IN;
        if (r < I_OUT) { transpose_item<1>(a.in[28] + (size_t)l * D * D, D, D, (bf16_t*)(a.ws + WS_WOUT), r, D / 64, tile, tid, (bf16_t*)(a.ws + WS_WOUTS), 256, D); continue; } r -= I_OUT;
        if (r < I_GU) { transpose_item<2>(a.in[31] + (size_t)l * D * 2 * DFF, D, 2 * DFF, (bf16_t*)(a.ws + WS_WGU), r, 2 * DFF / 64, tile, tid); continue; } r -= I_GU;
        transpose_item<1>(a.in[32] + (size_t)l * DFF * D, DFF, D, (bf16_t*)(a.ws + WS_WDN), r, D / 64, tile, tid, (bf16_t*)(a.ws + WS_WDNS), 256, D);
    }
    const size_t gt = (size_t)bx * NTHREADS + tid, gs = (size_t)G * NTHREADS;
    for (size_t i = gt; i < (size_t)3072 * ACAT_K; i += gs) {
        const int n = (int)(i / ACAT_K), k = (int)(i % ACAT_K), kind = n >> 10, c = n & 1023;
        float v = 0.f;
        if (kind == 0 && k < 64) v = a.in[19][((size_t)l * 64 + k) * D + c];
        else if (kind == 1 && k >= 64 && k < 128) v = a.in[21][((size_t)l * 64 + (k - 64)) * D + c];
        else if (kind == 2 && k >= 128 && k < 288) v = a.in[22][((size_t)l * 160 + (k - 128)) * D + c];
        ((bf16_t*)(a.ws + WS_WLORA))[i] = f2bf(v);
    }
    prep_rg_weights(a, l);
}
__device__ __forceinline__ void phase_prep_x(const Args& a) {
    bf16_t* XB = (bf16_t*)(a.ws + WS_XB);
    const size_t n4 = (size_t)M * D / 4, np4 = (size_t)MP * D / 4;
    for (size_t i = (size_t)blockIdx.x * NTHREADS + threadIdx.x; i < n4; i += (size_t)gridDim.x * NTHREADS) {
        const f32x4 v = i < np4 ? ((const f32x4*)a.in[0])[i] : ((const f32x4*)a.in[1])[i - np4];
        u32x2 w; w.x = pk2bf(v[0], v[1]); w.y = pk2bf(v[2], v[3]);
        ((u32x2*)XB)[i] = w;
    }
}

__device__ __forceinline__ float wave_sum_fast(float x) {
    x += __builtin_bit_cast(float, __builtin_amdgcn_update_dpp(0, __builtin_bit_cast(int, x), 0xB1, 0xF, 0xF, true));
    x += __builtin_bit_cast(float, __builtin_amdgcn_update_dpp(0, __builtin_bit_cast(int, x), 0x4E, 0xF, 0xF, true));
    x += __builtin_bit_cast(float, __builtin_amdgcn_update_dpp(0, __builtin_bit_cast(int, x), 0x124, 0xF, 0xF, true));
    x += __builtin_bit_cast(float, __builtin_amdgcn_update_dpp(0, __builtin_bit_cast(int, x), 0x128, 0xF, 0xF, true));
    x += __shfl_xor(x, 16); x += __shfl_xor(x, 32);
    return x;
}
template <int NS> __device__ __forceinline__ void phase_ln(const float* __restrict__ Z, const float* __restrict__ ZS, const float* __restrict__ g, const float* __restrict__ b, float* OF, bf16_t* OB) {
    const int lane = threadIdx.x & 63, wv = threadIdx.x >> 6;
    f32x4 gv[4], bv[4];
#pragma unroll
    for (int j = 0; j < 4; ++j) { gv[j] = ((const f32x4*)g)[j * 64 + lane]; bv[j] = ((const f32x4*)b)[j * 64 + lane]; }
    const int stride = gridDim.x * NWAVES;
    int m = blockIdx.x * NWAVES + wv;
    f32x4 nx[4];
    auto load_row = [&](int mm) {
        if (mm < MP) {
#pragma unroll
            for (int j = 0; j < 4; ++j) nx[j] = ((const f32x4*)(Z + (size_t)mm * D))[j * 64 + lane];
        } else {
#pragma unroll
            for (int j = 0; j < 4; ++j) nx[j] = ((const f32x4*)(ZS + (size_t)(mm - MP) * D))[j * 64 + lane];
#pragma unroll
            for (int ks = 1; ks < NS; ++ks)
#pragma unroll
                for (int j = 0; j < 4; ++j) nx[j] = nx[j] + ((const f32x4*)(ZS + ((size_t)ks * MS + (mm - MP)) * D))[j * 64 + lane];
        }
    };
    if (m < M) load_row(m);
    for (; m < M; m += stride) {
        f32x4 v[4]; float s = 0.f;
#pragma unroll
        for (int j = 0; j < 4; ++j) { v[j] = nx[j]; s += (v[j][0] + v[j][1]) + (v[j][2] + v[j][3]); }
        if (m + stride < M) load_row(m + stride);
        const float mean = wave_sum_fast(s) * (1.f / D);
        float q = 0.f;
#pragma unroll
        for (int j = 0; j < 4; ++j) { v[j] = v[j] - mean; q += (v[j][0] * v[j][0] + v[j][1] * v[j][1]) + (v[j][2] * v[j][2] + v[j][3] * v[j][3]); }
        const float rstd = rsqrtf(wave_sum_fast(q) * (1.f / D) + LN_EPS);
#pragma unroll
        for (int j = 0; j < 4; ++j) {
            const f32x4 y = v[j] * rstd * gv[j] + bv[j];
            if (OF) ((f32x4*)(OF + (size_t)m * D))[j * 64 + lane] = y;
            if (OB) { u32x2 w; w.x = pk2bf(y[0], y[1]); w.y = pk2bf(y[2], y[3]); ((u32x2*)(OB + (size_t)m * D))[j * 64 + lane] = w; }
        }
    }
}


typedef short bf16x8_t __attribute__((ext_vector_type(8)));
typedef short bf16x4_t __attribute__((ext_vector_type(4)));
typedef short v4i16_t __attribute__((ext_vector_type(4)));
#define LDSW() asm volatile("s_waitcnt lgkmcnt(0)" ::: "memory")
__device__ __forceinline__ u32x2 tr_read4(LAS unsigned char* p) { return __builtin_bit_cast(u32x2, __builtin_amdgcn_ds_read_tr16_b64_v4i16((LAS v4i16_t*)p)); }
__device__ __forceinline__ bf16x8_t mk_frag(u32x2 lo, u32x2 hi) { const u32x4 w = (u32x4){lo.x, lo.y, hi.x, hi.y}; return __builtin_bit_cast(bf16x8_t, w); }
__device__ __forceinline__ u32x2 pk4(float a, float b, float c, float d) { u32x2 w; w.x = pk2bf(a, b); w.y = pk2bf(c, d); return w; }

constexpr size_t WS_WRG = WS_CTL + 4096;
constexpr int RG_TP = 144;
__device__ __forceinline__ void prep_rg_weights(const Args& a, int l) {
    const size_t gt = (size_t)blockIdx.x * NTHREADS + threadIdx.x, gs = (size_t)gridDim.x * NTHREADS;
    bf16_t* W = (bf16_t*)(a.ws + WS_WRG);
    for (size_t i = gt; i < (size_t)2 * 16 * 4096; i += gs) {
        const int gate = (int)(i >> 16), bk = (int)(i >> 12) & 15, j = (int)(i >> 6) & 63, ii = (int)i & 63;
        W[i] = f2bf(a.in[gate ? 14 : 12][(size_t)l * 16 * 4096 + ((size_t)bk * 64 + ii) * 64 + j]);
    }
}
__device__ __forceinline__ float one_minus_exp(float x) {
    const float s = -x * (1.f + x * (0.5f + x * (0.16666667f + x * (0.041666668f + x * 0.0083333333f))));
    return x > -0.25f ? s : 1.f - __expf(x);
}
template <bool PASS2>
__device__ __forceinline__ void rglru_unit2(const Args& a, int L, int unit, LAS unsigned char* lds) {
    int lane = threadIdx.x & 63; const int wv = __builtin_amdgcn_readfirstlane(threadIdx.x >> 6);
    asm volatile("" : "+v"(lane));
    const int i16 = lane & 15, qp = lane >> 4;
    const bf16_t* P = (const bf16_t*)(a.ws + WS_P); bf16_t* OB = (bf16_t*)(a.ws + WS_OB); float* RS = (float*)(a.ws + WS_RS);
    const bf16_t* WRG = (const bf16_t*)(a.ws + WS_WRG);
    const float* cw = a.in[10] + (size_t)L * 4 * D; const float* cb = a.in[11] + L * D; const float* ba = a.in[13] + L * D;
    const float* bx = a.in[15] + L * D; const float* lam = a.in[16] + L * D;
    const float* conv0 = a.in[4] + (size_t)L * DBATCH * 3 * D; const float* h0 = a.in[5] + (size_t)L * DBATCH * D;
    LAS unsigned char* tile = lds + wv * (64 * RG_TP);
    LAS unsigned char* obt = lds + (NWAVES + wv) * (64 * RG_TP);
    const int m0 = unit * 64;
    const bool sample = m0 >= MP;
    const int bseq = sample ? 0 : m0 / SEQ, chunk = sample ? 0 : (m0 % SEQ) / 64;
    for (int bb = 0; bb < 2; ++bb) {
        const int bk = 2 * wv + bb, c0 = 64 * bk;
        bf16x8_t af[4][2];
#pragma unroll
        for (int ks = 0; ks < 2; ++ks) {
            const int cc = c0 + 32 * ks + 8 * qp;
            f32x4 w0[2], w1[2], w2[2], w3[2], wb[2];
#pragma unroll
            for (int hh = 0; hh < 2; ++hh) { w0[hh] = *(const f32x4*)(cw + 0 * D + cc + 4 * hh); w1[hh] = *(const f32x4*)(cw + 1 * D + cc + 4 * hh); w2[hh] = *(const f32x4*)(cw + 2 * D + cc + 4 * hh);
                w3[hh] = *(const f32x4*)(cw + 3 * D + cc + 4 * hh); wb[hh] = *(const f32x4*)(cb + cc + 4 * hh); }
#pragma unroll
            for (int mt = 0; mt < 4; ++mt) {
                const int tok = 16 * mt + i16; const size_t m = (size_t)m0 + tok;
                const int tseq = sample ? (tok & 7) : (chunk * 64 + tok);
                float xv[4][8];
#pragma unroll
                for (int k = 0; k < 4; ++k) {
                    const int back = 3 - k;
                    const bool ok = tseq - back >= 0;
                    const u32x4 v = *(const u32x4*)(P + (m - (ok ? back : 0)) * NP + CRNN + cc);
                    const unsigned w4[4] = {v.x, v.y, v.z, v.w};
#pragma unroll
                    for (int e = 0; e < 8; ++e) xv[k][e] = ok ? __uint_as_float((e & 1) ? (w4[e >> 1] & 0xffff0000u) : (w4[e >> 1] << 16)) : 0.f;
                    if (sample && back > 0) {
                        const int b = (int)(m - MP) >> 3; const int ci = ok ? 0 : 3 + tseq - back;
                        const float* cp = conv0 + ((size_t)b * 3 + ci) * D + cc;
                        const f32x4 v0 = *(const f32x4*)cp, v1 = *(const f32x4*)(cp + 4);
#pragma unroll
                        for (int e = 0; e < 4; ++e) { xv[k][e] = ok ? xv[k][e] : v0[e]; xv[k][4 + e] = ok ? xv[k][4 + e] : v1[e]; }
                    }
                }
                float xc[8];
#pragma unroll
                for (int e = 0; e < 8; ++e) xc[e] = wb[e >> 2][e & 3] + w0[e >> 2][e & 3] * xv[0][e] + w1[e >> 2][e & 3] * xv[1][e] + w2[e >> 2][e & 3] * xv[2][e] + w3[e >> 2][e & 3] * xv[3][e];
                const u32x4 pk = (u32x4){pk2bf(xc[0], xc[1]), pk2bf(xc[2], xc[3]), pk2bf(xc[4], xc[5]), pk2bf(xc[6], xc[7])};
                af[mt][ks] = __builtin_bit_cast(bf16x8_t, pk);
                *(LAS u32x4*)(tile + tok * RG_TP + (32 * ks + 8 * qp) * 2) = pk;
            }
        }
        LDSW();
#pragma unroll 1
        for (int nt = 0; nt < 4; ++nt) {
            const int j = 16 * nt + i16, c = c0 + j;
            bf16x8_t ba_[2], bx_[2];
#pragma unroll
            for (int ks = 0; ks < 2; ++ks) { ba_[ks] = *(const bf16x8_t*)(WRG + ((size_t)(0 * 16 + bk) * 64 + j) * 64 + 32 * ks + 8 * qp); bx_[ks] = *(const bf16x8_t*)(WRG + ((size_t)(1 * 16 + bk) * 64 + j) * 64 + 32 * ks + 8 * qp); }
            const float bac = ba[c], bxc = bx[c], spl = softplusf_(-lam[c]);
            float av[4][4], uv[4][4];
#pragma unroll
            for (int mt = 0; mt < 4; ++mt) {
                f32x4 ar = (f32x4){0.f, 0.f, 0.f, 0.f}, ai = ar;
#pragma unroll
                for (int ks = 0; ks < 2; ++ks) { ar = __builtin_amdgcn_mfma_f32_16x16x32_bf16(af[mt][ks], ba_[ks], ar, 0, 0, 0); ai = __builtin_amdgcn_mfma_f32_16x16x32_bf16(af[mt][ks], bx_[ks], ai, 0, 0, 0); }
                const u32x2 xcp = tr_read4(tile + (16 * mt + 4 * qp + (i16 >> 2)) * RG_TP + (16 * nt + 4 * (i16 & 3)) * 2);
#pragma unroll
                for (int r = 0; r < 4; ++r) {
                    const unsigned xw = r < 2 ? xcp.x : xcp.y;
                    const float xcv = __uint_as_float((r & 1) ? (xw & 0xffff0000u) : (xw << 16));
                    const float rg = sigmoidf_(ar[r] + bac), ig = sigmoidf_(ai[r] + bxc);
                    const float log_a = -8.f * rg * spl;
                    av[mt][r] = __expf(log_a);
                    uv[mt][r] = __builtin_amdgcn_sqrtf(one_minus_exp(2.f * log_a)) * (ig * xcv);
                }
            }
            float H = 0.f, Atot = 1.f;
            if (PASS2 && !sample && chunk > 0) H = RS[(((size_t)bseq * 128 + chunk) * D + c) * 2 + 1];
#pragma unroll
            for (int mt = 0; mt < 4; ++mt) {
                const float As = av[mt][0] * av[mt][1] * av[mt][2] * av[mt][3];
                const float Bs = ((uv[mt][0] * av[mt][1] + uv[mt][1]) * av[mt][2] + uv[mt][2]) * av[mt][3] + uv[mt][3];
                float Aq[4], Bq[4];
#pragma unroll
                for (int q = 0; q < 4; ++q) { Aq[q] = __shfl(As, i16 + 16 * q); Bq[q] = __shfl(Bs, i16 + 16 * q); }
                float hs;
                if (!sample) {
                    const float h1 = Aq[0] * H + Bq[0], h2 = Aq[1] * h1 + Bq[1], h3 = Aq[2] * h2 + Bq[2];
                    hs = qp == 0 ? H : (qp == 1 ? h1 : (qp == 2 ? h2 : h3));
                    H = Aq[3] * h3 + Bq[3]; Atot *= Aq[0] * Aq[1] * Aq[2] * Aq[3];
                } else {
                    const int b0 = ((m0 - MP) >> 3) + 2 * mt;
                    const float hA = h0[(size_t)b0 * D + c], hB = h0[(size_t)(b0 + 1) * D + c];
                    const float hA1 = Aq[0] * hA + Bq[0], hB1 = Aq[2] * hB + Bq[2];
                    hs = qp == 0 ? hA : (qp == 1 ? hA1 : (qp == 2 ? hB : hB1));
                    if (PASS2 && qp == 0) {
                        a.out[O_SH + ((size_t)L * DBATCH + b0) * D + c] = Aq[1] * hA1 + Bq[1];
                        a.out[O_SH + ((size_t)L * DBATCH + b0 + 1) * D + c] = Aq[3] * hB1 + Bq[3];
                    }
                }
                if (PASS2) {
                    float h = hs;
#pragma unroll
                    for (int r = 0; r < 4; ++r) { h = av[mt][r] * h + uv[mt][r]; *(LAS unsigned short*)(obt + (16 * mt + 4 * qp + r) * RG_TP + j * 2) = f2bf(h); }
                }
            }
            if (!sample && qp == 0) {
                if (!PASS2) *(float2*)(RS + (((size_t)bseq * 128 + chunk) * D + c) * 2) = make_float2(Atot, H);
                else if (chunk == 127) a.out[O_PH + ((size_t)L * NBATCH + bseq) * D + c] = H;
            }
        }
        LDSW();
        if (PASS2) {
#pragma unroll
            for (int p = 0; p < 8; ++p) {
                const int q = p * 64 + lane, row = q >> 3, pc = q & 7;
                *(u32x4*)(OB + ((size_t)m0 + row) * D + c0 + 8 * pc) = *(const LAS u32x4*)(obt + row * RG_TP + pc * 16);
            }
            LDSW();
        }
    }
    if (PASS2) {
        const int t = threadIdx.x;
        if (sample) {
            for (int i = t; i < 8 * 3 * D; i += NTHREADS) { const int s = i / (3 * D), k = (i / D) % 3, c = i % D; const int b = ((m0 - MP) >> 3) + s;
                a.out[O_SCONV + (((size_t)L * DBATCH + b) * 3 + k) * D + c] = bf2f(P[((size_t)MP + b * DSEQ + 5 + k) * NP + CRNN + c]); }
        } else if (chunk == 127) {
            for (int i = t; i < 3 * D; i += NTHREADS) { const int k = i / D, c = i % D;
                a.out[O_PCONV + (((size_t)L * NBATCH + bseq) * 3 + k) * D + c] = bf2f(P[((size_t)m0 + 61 + k) * NP + CRNN + c]); }
        }
    }
}
__device__ __forceinline__ void rglru_prefix(const Args& a) {
    float* RS = (float*)(a.ws + WS_RS);
    const int gid = blockIdx.x * NTHREADS + threadIdx.x;
    if (gid >= NBATCH * D) return;
    const int b = gid / D, c = gid % D;
    float h = 0.f;
    for (int c0 = 0; c0 < 128; c0 += 16) {
        float2 ab[16];
#pragma unroll
        for (int i = 0; i < 16; ++i) ab[i] = *(const float2*)(RS + (((size_t)b * 128 + c0 + i) * D + c) * 2);
#pragma unroll
        for (int i = 0; i < 16; ++i) { RS[(((size_t)b * 128 + c0 + i) * D + c) * 2 + 1] = h; h = ab[i].x * h + ab[i].y; }
    }
}


constexpr int AT_KPB = 144;
constexpr int AT_VPB = 528;
constexpr int AT_K_OFF = 0, AT_V_OFF = 256 * AT_KPB;
constexpr int AT_LDS = AT_V_OFF + 64 * AT_VPB;

template <bool SAMPLE>
__device__ __forceinline__ void attn_unit(const bf16_t* __restrict__ P, bf16_t* OA, const float* __restrict__ sinks, const float* __restrict__ ck, const float* __restrict__ cv,
                                          int b, int qb, int c, LAS unsigned char* lds) {
    const int tid = threadIdx.x, lane = tid & 63, wv = __builtin_amdgcn_readfirstlane(tid >> 6), i16 = lane & 15, qp = lane >> 4;
    LAS unsigned char* ldsK = lds + AT_K_OFF; LAS unsigned char* ldsV = lds + AT_V_OFF;
    if (!SAMPLE) {
        const size_t row_base = (size_t)b * SEQ + (size_t)(qb - 1) * 128;
#pragma unroll
        for (int it = 0; it < 4; ++it) {
            const int ci = tid + 512 * it, s = ci >> 3, part = ci & 7;
            u32x4 kv = (u32x4){0u, 0u, 0u, 0u}, vv = (u32x4){0u, 0u, 0u, 0u};
            if (qb > 0 || s >= 128) {
                const bf16_t* pr = P + (row_base + s) * NP;
                kv = *(const u32x4*)(pr + CK + 64 * c + 8 * part);
                vv = *(const u32x4*)(pr + CV + 64 * c + 8 * part);
            }
            *(LAS u32x4*)(ldsK + s * AT_KPB + part * 16) = kv;
            const unsigned w4[4] = {vv.x, vv.y, vv.z, vv.w};
#pragma unroll
            for (int e = 0; e < 8; ++e) *(LAS unsigned short*)(ldsV + (8 * part + e) * AT_VPB + 2 * s) = (unsigned short)((w4[e >> 1] >> (16 * (e & 1))) & 0xffffu);
        }
    } else {
        for (int ci = tid; ci < 144 * 16; ci += 512) {
            const int s = ci >> 4, part = ci & 15;
            float kf[4] = {0.f, 0.f, 0.f, 0.f}, vf[4] = {0.f, 0.f, 0.f, 0.f};
            if (s < 128) {
                const f32x4 k4 = *(const f32x4*)(ck + ((size_t)(b * 128 + s) * 4 + c) * 64 + 4 * part);
                const f32x4 v4 = *(const f32x4*)(cv + ((size_t)(b * 128 + s) * 4 + c) * 64 + 4 * part);
#pragma unroll
                for (int e = 0; e < 4; ++e) { kf[e] = k4[e]; vf[e] = v4[e]; }
            } else if (s < 136) {
                const bf16_t* pr = P + (size_t)(MP + b * DSEQ + (s - 128)) * NP;
#pragma unroll
                for (int e = 0; e < 4; ++e) { kf[e] = bf2f(pr[CK + 64 * c + 4 * part + e]); vf[e] = bf2f(pr[CV + 64 * c + 4 * part + e]); }
            }
            u32x2 kw; kw.x = pk2bf(kf[0], kf[1]); kw.y = pk2bf(kf[2], kf[3]);
            *(LAS u32x2*)(ldsK + s * AT_KPB + part * 8) = kw;
#pragma unroll
            for (int e = 0; e < 4; ++e) *(LAS unsigned short*)(ldsV + (4 * part + e) * AT_VPB + 2 * s) = f2bf(vf[e]);
        }
    }
    __syncthreads();
    const int n_mt = SAMPLE ? 1 : 4;
    if (!SAMPLE || wv < 2) {
        for (int mt = 0; mt < n_mt; ++mt) {
            int h, tq, nt0; size_t qrow;
            if (!SAMPLE) { const int g = wv >> 1, qh = wv & 1; h = 4 * c + g; tq = 64 * qh + 16 * mt + i16; nt0 = (64 * qh + 16 * mt) >> 4; qrow = (size_t)b * SEQ + (size_t)qb * 128 + tq; }
            else { const int rho = 16 * wv + i16; h = 4 * c + (rho >> 3); tq = rho & 7; nt0 = 0; qrow = (size_t)MP + b * DSEQ + tq; }
            const float slope = exp2f(-0.5f * (float)(h + 1)), sink = sinks[h];
            bf16x8_t qf[2];
#pragma unroll
            for (int ks = 0; ks < 2; ++ks) qf[ks] = *(const bf16x8_t*)(P + qrow * NP + CQ + 64 * h + 32 * ks + 8 * qp);
            f32x4 sc[9];
#pragma unroll
            for (int jn = 0; jn < 9; ++jn) {
                const int nt = nt0 + jn;
                f32x4 acc = (f32x4){0.f, 0.f, 0.f, 0.f};
                if (SAMPLE || qb > 0 || nt >= 8) {
#pragma unroll
                    for (int ks = 0; ks < 2; ++ks) {
                        const bf16x8_t kfr = *(const LAS bf16x8_t*)(ldsK + (16 * nt + i16) * AT_KPB + (32 * ks + 8 * qp) * 2);
                        acc = __builtin_amdgcn_mfma_f32_16x16x32_bf16(kfr, qf[ks], acc, 0, 0, 0);
                    }
                }
#pragma unroll
                for (int r = 0; r < 4; ++r) {
                    const int sidx = 16 * nt + 4 * qp + r;
                    const int rel = 128 + tq - sidx;
                    bool valid = rel >= 0 && rel < 128;
                    if (!SAMPLE) valid = valid && (qb > 0 || sidx >= 128);
                    acc[r] = valid ? acc[r] * 0.125f - slope * (float)rel : -INFINITY;
                }
                sc[jn] = acc;
            }
            float mx = sink;
#pragma unroll
            for (int jn = 0; jn < 9; ++jn)
#pragma unroll
                for (int r = 0; r < 4; ++r) mx = fmaxf(mx, sc[jn][r]);
            mx = fmaxf(mx, __shfl_xor(mx, 16)); mx = fmaxf(mx, __shfl_xor(mx, 32));
            float sum = 0.f;
#pragma unroll
            for (int jn = 0; jn < 9; ++jn)
#pragma unroll
                for (int r = 0; r < 4; ++r) { const float e = __expf(sc[jn][r] - mx); sc[jn][r] = e; sum += e; }
            sum += __shfl_xor(sum, 16); sum += __shfl_xor(sum, 32);
            const float inv = __builtin_amdgcn_rcpf(sum + __expf(sink - mx));
            bf16x8_t pf[5];
#pragma unroll
            for (int ks = 0; ks < 5; ++ks) {
                u32x4 w;
                w.x = pk2bf(sc[2 * ks][0] * inv, sc[2 * ks][1] * inv); w.y = pk2bf(sc[2 * ks][2] * inv, sc[2 * ks][3] * inv);
                if (ks < 4) { w.z = pk2bf(sc[2 * ks + 1][0] * inv, sc[2 * ks + 1][1] * inv); w.w = pk2bf(sc[2 * ks + 1][2] * inv, sc[2 * ks + 1][3] * inv); }
                else { w.z = 0u; w.w = 0u; }
                pf[ks] = __builtin_bit_cast(bf16x8_t, w);
            }
#pragma unroll
            for (int dt = 0; dt < 4; ++dt) {
                f32x4 o = (f32x4){0.f, 0.f, 0.f, 0.f};
#pragma unroll
                for (int ks = 0; ks < 5; ++ks) {
                    const int ntA = nt0 + 2 * ks, ntB = (ks < 4) ? nt0 + 2 * ks + 1 : nt0 + 2 * ks;
                    const LAS unsigned char* vr = ldsV + (16 * dt + i16) * AT_VPB;
                    const u32x2 lo = *(const LAS u32x2*)(vr + 2 * (16 * ntA + 4 * qp));
                    const u32x2 hi = *(const LAS u32x2*)(vr + 2 * (16 * ntB + 4 * qp));
                    const u32x4 w = (u32x4){lo.x, lo.y, hi.x, hi.y};
                    o = __builtin_amdgcn_mfma_f32_16x16x32_bf16(__builtin_bit_cast(bf16x8_t, w), pf[ks], o, 0, 0, 0);
                }
                u32x2 ow; ow.x = pk2bf(o[0], o[1]); ow.y = pk2bf(o[2], o[3]);
                *(u32x2*)(OA + qrow * D + 64 * h + 16 * dt + 4 * qp) = ow;
            }
        }
    }
    __syncthreads();
}

template <bool PASS2>
__device__ __forceinline__ void rglru_unit(const Args& a, int L, int unit, LAS unsigned char* lds) {
    const int tid = threadIdx.x, lane = tid & 63, wv = __builtin_amdgcn_readfirstlane(tid >> 6);
    const bf16_t* P = (const bf16_t*)(a.ws + WS_P); bf16_t* OB = (bf16_t*)(a.ws + WS_OB); float* RS = (float*)(a.ws + WS_RS);
    const float* cw = a.in[10] + (size_t)L * 4 * D; const float* cb = a.in[11] + L * D; const float* wa = a.in[12] + (size_t)L * 16 * 4096; const float* ba = a.in[13] + L * D;
    const float* wx = a.in[14] + (size_t)L * 16 * 4096; const float* bx = a.in[15] + L * D; const float* lam = a.in[16] + L * D;
    const float* conv0 = a.in[4] + (size_t)L * DBATCH * 3 * D; const float* h0 = a.in[5] + (size_t)L * DBATCH * D;
    LAS float* s_xc = (LAS float*)lds + wv * 64;
    const int m0 = unit * 64;
    const bool sample = m0 >= MP;
    for (int bb = 0; bb < 2; ++bb) {
        const int bk = 2 * wv + bb, c = 64 * bk + lane;
        float war[64], wxr[64];
#pragma unroll
        for (int i = 0; i < 64; ++i) { war[i] = wa[((size_t)bk * 64 + i) * 64 + lane]; wxr[i] = wx[((size_t)bk * 64 + i) * 64 + lane]; }
        const float c0 = cw[0 * D + c], c1 = cw[1 * D + c], c2 = cw[2 * D + c], c3 = cw[3 * D + c], cbc = cb[c], bac = ba[c], bxc = bx[c];
        const float spl = softplusf_(-lam[c]);
        float x1 = 0.f, x2 = 0.f, x3 = 0.f, h = 0.f, Ap = 1.f;
        int bseq = 0, chunk = 0;
        if (!sample) {
            bseq = m0 / SEQ; chunk = (m0 % SEQ) / 64;
            if (chunk > 0) {
                x1 = bf2f(P[(size_t)(m0 - 1) * NP + CRNN + c]); x2 = bf2f(P[(size_t)(m0 - 2) * NP + CRNN + c]); x3 = bf2f(P[(size_t)(m0 - 3) * NP + CRNN + c]);
                if (PASS2) { for (int cc = 0; cc < chunk; ++cc) { const float2 ab = *(const float2*)(RS + (((size_t)bseq * 128 + cc) * D + c) * 2); h = ab.x * h + ab.y; } }
            }
        }
        for (int t = 0; t < 64; ++t) {
            const size_t m = (size_t)m0 + t;
            if (sample && (t & 7) == 0) {
                if (!PASS2) break;
                const int b = (int)(m - MP) >> 3;
                x3 = conv0[((size_t)b * 3 + 0) * D + c]; x2 = conv0[((size_t)b * 3 + 1) * D + c]; x1 = conv0[((size_t)b * 3 + 2) * D + c]; h = h0[(size_t)b * D + c];
            }
            const float x = bf2f(P[m * NP + CRNN + c]);
            const float xc = cbc + c0 * x3 + c1 * x2 + c2 * x1 + c3 * x;
            LDSW(); s_xc[lane] = xc; LDSW();
            float r = bac, ig = bxc;
#pragma unroll
            for (int i4 = 0; i4 < 16; ++i4) { const f32x4 xv = *(const LAS f32x4*)(s_xc + 4 * i4);
#pragma unroll
                for (int e = 0; e < 4; ++e) { r += xv[e] * war[4 * i4 + e]; ig += xv[e] * wxr[4 * i4 + e]; } }
            r = sigmoidf_(r); ig = sigmoidf_(ig);
            const float log_a = -8.f * r * spl;
            const float av = __expf(log_a);
            const float u = sqrtf(-expm1f(2.f * log_a)) * (ig * xc);
            h = av * h + u; Ap *= av;
            if (PASS2) OB[m * D + c] = f2bf(h);
            x3 = x2; x2 = x1; x1 = x;
            if (PASS2 && sample && (t & 7) == 7) {
                const int b = (int)(m - MP) >> 3;
                float* oc = a.out + O_SCONV + ((size_t)L * DBATCH + b) * 3 * D; float* oh = a.out + O_SH + ((size_t)L * DBATCH + b) * D;
                oh[c] = h; oc[0 * D + c] = x3; oc[1 * D + c] = x2; oc[2 * D + c] = x1;
            }
        }
        if (!sample) {
            if (!PASS2) { *(float2*)(RS + (((size_t)bseq * 128 + chunk) * D + c) * 2) = make_float2(Ap, h); }
            else if (chunk == 127) {
                float* oc = a.out + O_PCONV + ((size_t)L * NBATCH + bseq) * 3 * D; float* oh = a.out + O_PH + ((size_t)L * NBATCH + bseq) * D;
                oh[c] = h; oc[0 * D + c] = x3; oc[1 * D + c] = x2; oc[2 * D + c] = x1;
            }
        }
    }
}

__device__ __forceinline__ void phase_elem_mixa(const Args& a, int L) {
    const bf16_t* P = (const bf16_t*)(a.ws + WS_P); bf16_t* AC = (bf16_t*)(a.ws + WS_ACAT);
    const float* mu = a.in[17] + (size_t)L * SHIFT_W; const float* shift0 = a.in[6] + (size_t)L * DBATCH * SHIFT_W;
    const size_t gt = (size_t)blockIdx.x * NTHREADS + threadIdx.x, gs = (size_t)gridDim.x * NTHREADS;
    for (unsigned i = (unsigned)gt; i < (unsigned)(M * ACAT_K); i += (unsigned)gs) {
        const unsigned m = i / ACAT_K; const int j = (int)(i - m * ACAT_K);
        float o = 0.f;
        if (j < 288) {
            const int ch = 3072 + j;
            const float pc = bf2f(P[(size_t)m * NP + CRW + ch]);
            float pv;
            if (m < (unsigned)MP) pv = (m % SEQ) == 0 ? 0.f : bf2f(P[(size_t)(m - 1) * NP + CRW + ch]);
            else pv = ((m - MP) % DSEQ) == 0 ? shift0[(size_t)((m - MP) / DSEQ) * SHIFT_W + ch] : bf2f(P[(size_t)(m - 1) * NP + CRW + ch]);
            const float ps = pc + mu[ch] * (pv - pc);
            o = j < 64 ? 1.f - 2.f * __builtin_amdgcn_rcpf(__expf(2.f * ps) + 1.f) : (j < 128 ? ps : sigmoidf_(ps));
        }
        AC[i] = f2bf(o);
    }
}
__device__ __forceinline__ void phase_state_copies(const Args& a, int L, int first) {
    const bf16_t* P = (const bf16_t*)(a.ws + WS_P);
    if ((int)blockIdx.x < first) return;
    const size_t gt = (size_t)(blockIdx.x - first) * NTHREADS + threadIdx.x, gs = (size_t)(gridDim.x - first) * NTHREADS;
    const float* ck = a.in[2] + (size_t)L * DBATCH * 128 * 256; const float* cv = a.in[3] + (size_t)L * DBATCH * 128 * 256;
    float* pk = a.out + O_PK + (size_t)L * NBATCH * 128 * 256; float* pv_ = a.out + O_PV + (size_t)L * NBATCH * 128 * 256;
    float* pshift = a.out + O_PSHIFT + (size_t)L * NBATCH * SHIFT_W; float* sk = a.out + O_SK + (size_t)L * DBATCH * 128 * 256; float* sv = a.out + O_SV + (size_t)L * DBATCH * 128 * 256;
    float* sshift = a.out + O_SSHIFT + (size_t)L * DBATCH * SHIFT_W;
    const size_t n_pk = (size_t)NBATCH * 128 * 256, n_sk = (size_t)DBATCH * 128 * 256, n_ps = (size_t)NBATCH * SHIFT_W, n_ss = (size_t)DBATCH * SHIFT_W;
    auto ld4 = [&](const bf16_t* p) -> f32x4 { const u32x2 w = *(const u32x2*)p; return (f32x4){__uint_as_float(w.x << 16), __uint_as_float(w.x & 0xffff0000u), __uint_as_float(w.y << 16), __uint_as_float(w.y & 0xffff0000u)}; };
    for (unsigned i4 = (unsigned)gt; i4 < (unsigned)((n_pk + n_sk + n_ps + n_ss) / 4); i4 += (unsigned)gs) {
        const unsigned i = 4 * i4;
        if (i < n_pk) {
            const int b = (int)(i / (128 * 256)), s = (int)((i / 256) % 128), e = (int)(i % 256);
            const size_t row = (size_t)b * SEQ + (SEQ - 128) + s;
            *(f32x4*)(pk + i) = ld4(P + row * NP + CK + e); *(f32x4*)(pv_ + i) = ld4(P + row * NP + CV + e);
            continue;
        }
        unsigned k = i - (unsigned)n_pk;
        if (k < n_sk) {
            const int b = (int)(k / (128 * 256)), s = (int)((k / 256) % 128), e = (int)(k % 256);
            if (s < 120) { *(f32x4*)(sk + k) = *(const f32x4*)(ck + ((size_t)b * 128 + s + 8) * 256 + e); *(f32x4*)(sv + k) = *(const f32x4*)(cv + ((size_t)b * 128 + s + 8) * 256 + e); }
            else { const size_t row = (size_t)MP + b * DSEQ + (s - 120); *(f32x4*)(sk + k) = ld4(P + row * NP + CK + e); *(f32x4*)(sv + k) = ld4(P + row * NP + CV + e); }
            continue;
        }
        k -= (unsigned)n_sk;
        if (k < n_ps) { const int b = (int)(k / SHIFT_W), ch = (int)(k % SHIFT_W); *(f32x4*)(pshift + k) = ld4(P + ((size_t)b * SEQ + SEQ - 1) * NP + CRW + ch); continue; }
        k -= (unsigned)n_ps;
        { const int b = (int)(k / SHIFT_W), ch = (int)(k % SHIFT_W); *(f32x4*)(sshift + k) = ld4(P + ((size_t)MP + b * DSEQ + DSEQ - 1) * NP + CRW + ch); }
    }
}

#ifndef PROBE_MIXA
#define PROBE_MIXA 0
#endif
__device__ __forceinline__ void phase_mixa(const Args& a, int L, LAS unsigned char* lds) {
    const bf16_t* P = (const bf16_t*)(a.ws + WS_P); bf16_t* OA = (bf16_t*)(a.ws + WS_OA);
    const float* sinks = a.in[9] + L * 16; const float* ck = a.in[2] + (size_t)L * DBATCH * 128 * 256; const float* cv = a.in[3] + (size_t)L * DBATCH * 128 * 256;
    constexpr int N_RG1 = MP / 64, N_AP = NBATCH * 64 * 4, N_AS = DBATCH * 4;
    phase_elem_mixa(a, L);
    if (PROBE_MIXA & 1) phase_elem_mixa(a, L);
    for (int it = blockIdx.x; it < N_RG1; it += gridDim.x) { rglru_unit2<false>(a, L, it, lds); __syncthreads(); }
    if (PROBE_MIXA & 2) for (int it = blockIdx.x; it < N_RG1; it += gridDim.x) { rglru_unit2<false>(a, L, it, lds); __syncthreads(); }
    for (int r = blockIdx.x; r < N_AP; r += gridDim.x) { const int c = r & 3, qb = (r >> 2) & 63, b = r >> 8; attn_unit<false>(P, OA, sinks, ck, cv, b, qb, c, lds); }
    if (PROBE_MIXA & 4) for (int r = blockIdx.x; r < N_AP; r += gridDim.x) { const int c = r & 3, qb = (r >> 2) & 63, b = r >> 8; attn_unit<false>(P, OA, sinks, ck, cv, b, qb, c, lds); }
    for (int r = blockIdx.x; r < N_AS; r += gridDim.x) { const int c = r & 3, b = r >> 2; attn_unit<true>(P, OA, sinks, ck, cv, b, 0, c, lds); }
    if (PROBE_MIXA & 8) for (int r = blockIdx.x; r < N_AS; r += gridDim.x) { const int c = r & 3, b = r >> 2; attn_unit<true>(P, OA, sinks, ck, cv, b, 0, c, lds); }
}

struct EpiLora {
    static constexpr bool PERM = true, AFTER_DRAIN = false;
    bf16_t* WAW; bf16_t* WAA; bf16_t* WAG; const float* w0; const float* a0;
    __device__ __forceinline__ void operator()(const f32x4 (&acc)[2][2][4][2], const pg8::Unit& u, int wr, int wc, int fr, int fq) const {
        const int row0 = u.pm * 256 + wr * 64 + fr, kind = u.pn >> 2, colb = (u.pn & 3) * 256 + wc * 32 + 8 * fq;
        const float* bsrc = kind == 0 ? w0 : a0;
        f32x4 bias[2][2];
#pragma unroll
        for (int bj = 0; bj < 2; ++bj)
#pragma unroll
            for (int n = 0; n < 2; ++n) bias[bj][n] = kind == 2 ? (f32x4){0.f, 0.f, 0.f, 0.f} : *(const f32x4*)(bsrc + colb + bj * 128 + 4 * n);
#pragma unroll
        for (int ai = 0; ai < 2; ++ai)
#pragma unroll
            for (int m = 0; m < 4; ++m) {
                const size_t off = (size_t)(row0 + ai * 128 + m * 16) * D + colb;
#pragma unroll
                for (int bj = 0; bj < 2; ++bj) {
                    f32x4 v0 = acc[ai][bj][m][0] + bias[bj][0], v1 = acc[ai][bj][m][1] + bias[bj][1];
                    if (kind == 0) {
#pragma unroll
                        for (int i = 0; i < 4; ++i) {
                            v0[i] = -__expf(-(fmaxf(-v0[i], 0.f) + __logf(1.f + __expf(-fabsf(v0[i])))) - 0.5f);
                            v1[i] = -__expf(-(fmaxf(-v1[i], 0.f) + __logf(1.f + __expf(-fabsf(v1[i])))) - 0.5f);
                        }
                    } else if (kind == 1) {
#pragma unroll
                        for (int i = 0; i < 4; ++i) { v0[i] = sigmoidf_(v0[i]); v1[i] = sigmoidf_(v1[i]); }
                    }
                    u32x4 w; w.x = pk2bf(v0[0], v0[1]); w.y = pk2bf(v0[2], v0[3]); w.z = pk2bf(v1[0], v1[1]); w.w = pk2bf(v1[2], v1[3]);
                    *(u32x4*)(WAW + (size_t)kind * ((size_t)M * D) + off + bj * 128) = w;
                }
                asm volatile("" ::: "memory");
            }
    }
};

__device__ __forceinline__ void phase_mixc(const Args& a, int L, bf16_t* DST) {
    const int lane = threadIdx.x & 63, wv = threadIdx.x >> 6;
    const bf16_t* P = (const bf16_t*)(a.ws + WS_P); const bf16_t* WAG = (const bf16_t*)(a.ws + WS_WAG); const bf16_t* Y = (const bf16_t*)(a.ws + WS_Y); const float* BD = (const float*)(a.ws + WS_BD);
    bf16_t* OA = (bf16_t*)(a.ws + WS_OA); const bf16_t* OB = (const bf16_t*)(a.ws + WS_OB);
    const float* mu = a.in[17] + (size_t)L * SHIFT_W + 2048; const float* shift0 = a.in[6] + (size_t)L * DBATCH * SHIFT_W + 2048;
    const int c0 = 16 * lane, h = lane >> 2;
    float lw[16], lb[16], muv[16];
#pragma unroll
    for (int i = 0; i < 16; ++i) { lw[i] = a.in[26][L * D + c0 + i]; lb[i] = a.in[27][L * D + c0 + i]; muv[i] = mu[c0 + i]; }
    for (int m = blockIdx.x * NWAVES + wv; m < M; m += gridDim.x * NWAVES) {
        float y[16];
        { u32x4 yv[2]; yv[0] = *(const u32x4*)(Y + (size_t)m * D + c0); yv[1] = *(const u32x4*)(Y + (size_t)m * D + c0 + 8);
#pragma unroll
          for (int i = 0; i < 16; ++i) y[i] = __uint_as_float((i & 1) ? (yv[i >> 3][(i >> 1) & 3] & 0xffff0000u) : (yv[i >> 3][(i >> 1) & 3] << 16)); }
        float s = 0.f;
#pragma unroll
        for (int i = 0; i < 16; ++i) s += y[i];
        s += __shfl_xor(s, 1); s += __shfl_xor(s, 2);
        const float mean = s * (1.f / 64.f);
        float q = 0.f;
#pragma unroll
        for (int i = 0; i < 16; ++i) { y[i] -= mean; q += y[i] * y[i]; }
        q += __shfl_xor(q, 1); q += __shfl_xor(q, 2);
        const float rstd = rsqrtf(q * (1.f / 64.f) + GN_EPS);
        const float bd = BD[(size_t)m * 16 + h];
        const bool first = m < MP ? (m % SEQ) == 0 : ((m - MP) % DSEQ) == 0;
        const bf16_t* pr = P + (size_t)m * NP + CRW + 2048 + c0;
#define BFX(v, i) __uint_as_float((((i) & 1) ? ((v)[(i) >> 3][((i) >> 1) & 3] & 0xffff0000u) : ((v)[(i) >> 3][((i) >> 1) & 3] << 16)))
        u32x4 pcv[2], ppv[2], gv[2], gav[2], gbv[2], gcv[2], oav[2], obv[2];
        pcv[0] = *(const u32x4*)pr; pcv[1] = *(const u32x4*)(pr + 8);
        ppv[0] = pcv[0]; ppv[1] = pcv[1];
        if (!first) { ppv[0] = *(const u32x4*)(pr - NP); ppv[1] = *(const u32x4*)(pr - NP + 8); }
        gv[0] = *(const u32x4*)(WAG + (size_t)m * D + c0); gv[1] = *(const u32x4*)(WAG + (size_t)m * D + c0 + 8);
        const bf16_t* pg = P + (size_t)m * NP + CG + c0;
        gav[0] = *(const u32x4*)pg; gav[1] = *(const u32x4*)(pg + 8);
        gbv[0] = *(const u32x4*)(pg + 1024); gbv[1] = *(const u32x4*)(pg + 1024 + 8);
        gcv[0] = *(const u32x4*)(pg + 2048); gcv[1] = *(const u32x4*)(pg + 2048 + 8);
        oav[0] = *(const u32x4*)(OA + (size_t)m * D + c0); oav[1] = *(const u32x4*)(OA + (size_t)m * D + c0 + 8);
        obv[0] = *(const u32x4*)(OB + (size_t)m * D + c0); obv[1] = *(const u32x4*)(OB + (size_t)m * D + c0 + 8);
        float o[16];
#pragma unroll
        for (int i = 0; i < 16; ++i) {
            const float pc = BFX(pcv, i);
            float pv;
            if (first) pv = m < MP ? 0.f : shift0[(size_t)((m - MP) / DSEQ) * SHIFT_W + c0 + i];
            else pv = BFX(ppv, i);
            const float vv = pc + muv[i] * (pv - pc);
            const float yn = y[i] * rstd * lw[i] + lb[i];
            const float oc = (yn + bd * vv) * BFX(gv, i);
            o[i] = BFX(gav, i) * BFX(oav, i) + BFX(gbv, i) * BFX(obv, i) + BFX(gcv, i) * oc;
        }
        u32x4 w0, w1;
        w0.x = pk2bf(o[0], o[1]); w0.y = pk2bf(o[2], o[3]); w0.z = pk2bf(o[4], o[5]); w0.w = pk2bf(o[6], o[7]);
        w1.x = pk2bf(o[8], o[9]); w1.y = pk2bf(o[10], o[11]); w1.z = pk2bf(o[12], o[13]); w1.w = pk2bf(o[14], o[15]);
        *(u32x4*)(DST + (size_t)m * D + c0) = w0; *(u32x4*)(DST + (size_t)m * D + c0 + 8) = w1;
    }
}

constexpr int CH_OFF_AA = 0, CH_OFF_RA = 2048, CH_OFF_MC = 4096, CH_OFF_TL = 5120  , CH_OFF_BT = 5632, CH_OFF_KT = 7808, CH_OFF_VT = 9984, CH_OFF_GM = 12160, CH_SLOT = 12416;
constexpr int CH_TP = 136;
__device__ __forceinline__ float row_prefix16(float x) {
    x += __builtin_bit_cast(float, __builtin_amdgcn_update_dpp(0, __builtin_bit_cast(int, x), 0x111, 0xF, 0xF, true));
    x += __builtin_bit_cast(float, __builtin_amdgcn_update_dpp(0, __builtin_bit_cast(int, x), 0x112, 0xF, 0xF, true));
    x += __builtin_bit_cast(float, __builtin_amdgcn_update_dpp(0, __builtin_bit_cast(int, x), 0x114, 0xF, 0xF, true));
    x += __builtin_bit_cast(float, __builtin_amdgcn_update_dpp(0, __builtin_bit_cast(int, x), 0x118, 0xF, 0xF, true));
    return x;
}
__device__ __forceinline__ f32x4 prod16(const f32x4 xt, const f32x4 y) {
    f32x4 z = (f32x4){0.f, 0.f, 0.f, 0.f};
#pragma unroll
    for (int r = 0; r < 4; ++r) z = __builtin_amdgcn_mfma_f32_16x16x4f32(xt[r], y[r], z, 0, 0, 0);
    return z;
}
__device__ __forceinline__ f32x4 gram(const bf16x8_t (&x)[2], const bf16x8_t (&y)[2]) {
    f32x4 z = (f32x4){0.f, 0.f, 0.f, 0.f};
    z = __builtin_amdgcn_mfma_f32_16x16x32_bf16(x[0], y[0], z, 0, 0, 0);
    z = __builtin_amdgcn_mfma_f32_16x16x32_bf16(x[1], y[1], z, 0, 0, 0);
    return z;
}

struct ChunkRaw { u32x2 cr[4], ck[4], cv[4], a[4], x[4]; };
constexpr int CH_PAR_OFF = 8 * CH_SLOT;
constexpr int CH_PAR_BYTES = 6 * 64 * 4;
__device__ __forceinline__ void stage_head_params(const Args& a, int L, int h, LAS unsigned char* par, int lane) {
    LAS float* p = (LAS float*)par; const int c = 64 * h + lane;
    p[lane] = a.in[17][(size_t)L * SHIFT_W + c]; p[64 + lane] = a.in[17][(size_t)L * SHIFT_W + 1024 + c]; p[128 + lane] = a.in[17][(size_t)L * SHIFT_W + 2048 + c];
    p[192 + lane] = a.in[23][L * D + c]; p[256 + lane] = a.in[24][L * D + c]; p[320 + lane] = a.in[25][L * D + c];
}
__device__ __forceinline__ void chunk_load(const Args& a, size_t m0, int h, int ntok, int lane, ChunkRaw& R) {
    asm volatile("" : "+v"(lane));
    const int i16 = lane & 15, qp = lane >> 4;
    const bf16_t* P = (const bf16_t*)(a.ws + WS_P); const bf16_t* WAW = (const bf16_t*)(a.ws + WS_WAW); const bf16_t* WAA = (const bf16_t*)(a.ws + WS_WAA);
    const size_t m = m0 + (i16 < ntok ? i16 : 0);
#pragma unroll
    for (int r = 0; r < 4; ++r) {
        const int c = 64 * h + 16 * r + 4 * qp;
        const bf16_t* pr = P + m * NP + CRW + c;
        R.cr[r] = *(const u32x2*)pr; R.ck[r] = *(const u32x2*)(pr + 1024); R.cv[r] = *(const u32x2*)(pr + 2048);
        R.x[r] = *(const u32x2*)(WAW + m * D + c);
        R.a[r] = *(const u32x2*)(WAA + m * D + c);
    }
}
__device__ __forceinline__ unsigned dpp_prev_row(unsigned old, unsigned src) { return (unsigned)__builtin_amdgcn_update_dpp((int)old, (int)src, 0x111, 0xF, 0xF, false); }
template <class PF> __device__ __forceinline__ void chunk_compute(const Args& a, const ChunkRaw& R, size_t m0, int h, int ntok, bool seq_start, const float* sh0, const LAS unsigned char* par_, LAS unsigned char* slot, int lane, PF pf) {
    asm volatile("" : "+v"(lane));
    const int i16 = lane & 15, qp = lane >> 4;
    float* BD = (float*)(a.ws + WS_BD);
    const LAS float* par = (const LAS float*)par_;
    const bool valid = i16 < ntok;
    const size_t m = m0 + (valid ? i16 : 0);
    u32x2 p0r[4], p0k[4], p0v[4];
    {
        const bf16_t* P = (const bf16_t*)(a.ws + WS_P);
#pragma unroll
        for (int r = 0; r < 4; ++r) {
            const int c = 64 * h + 16 * r + 4 * qp;
            if (!seq_start) { const bf16_t* pp = P + (m0 - 1) * NP + CRW + c; p0r[r] = *(const u32x2*)pp; p0k[r] = *(const u32x2*)(pp + 1024); p0v[r] = *(const u32x2*)(pp + 2048); }
            else if (sh0) { const f32x4 fr_ = *(const f32x4*)(sh0 + c), fk_ = *(const f32x4*)(sh0 + 1024 + c), fv_ = *(const f32x4*)(sh0 + 2048 + c);
                p0r[r] = pk4(fr_[0], fr_[1], fr_[2], fr_[3]); p0k[r] = pk4(fk_[0], fk_[1], fk_[2], fk_[3]); p0v[r] = pk4(fv_[0], fv_[1], fv_[2], fv_[3]); }
            else { p0r[r] = (u32x2){0u, 0u}; p0k[r] = p0r[r]; p0v[r] = p0r[r]; }
        }
    }
    float abu[16], bbu[16];
    u32x2 pa[4], pb[4], pkk[4], prr[4];
    float ssq = 0.f, bdp = 0.f;
#pragma unroll
    for (int r = 0; r < 4; ++r) {
        const int cb = 16 * r + 4 * qp, c = 64 * h + cb;
        const u32x2 cr = R.cr[r], ck_ = R.ck[r], cv_ = R.cv[r], a4 = R.a[r];
        u32x2 pr_, pk_, pv_;
        pr_.x = dpp_prev_row(p0r[r].x, cr.x); pr_.y = dpp_prev_row(p0r[r].y, cr.y); pk_.x = dpp_prev_row(p0k[r].x, ck_.x); pk_.y = dpp_prev_row(p0k[r].y, ck_.y);
        pv_.x = dpp_prev_row(p0v[r].x, cv_.x); pv_.y = dpp_prev_row(p0v[r].y, cv_.y);
        const u32x2 x4 = R.x[r];
        const f32x4 mur = *(const LAS f32x4*)(par + cb), muk = *(const LAS f32x4*)(par + 64 + cb), muv = *(const LAS f32x4*)(par + 128 + cb);
        const f32x4 kkc = *(const LAS f32x4*)(par + 192 + cb), kac = *(const LAS f32x4*)(par + 256 + cb), rkc = *(const LAS f32x4*)(par + 320 + cb);
        float vv[4], kb[4], rb[4];
#pragma unroll
        for (int i = 0; i < 4; ++i) {
            const unsigned wr_ = i < 2 ? cr.x : cr.y, wk_ = i < 2 ? ck_.x : ck_.y, wv_ = i < 2 ? cv_.x : cv_.y, wa_ = i < 2 ? a4.x : a4.y, wx_ = i < 2 ? x4.x : x4.y;
            const unsigned qr_ = i < 2 ? pr_.x : pr_.y, qk_ = i < 2 ? pk_.x : pk_.y, qv_ = i < 2 ? pv_.x : pv_.y;
            const float c_r = __uint_as_float((i & 1) ? (wr_ & 0xffff0000u) : (wr_ << 16)), c_k = __uint_as_float((i & 1) ? (wk_ & 0xffff0000u) : (wk_ << 16)),
                        c_v = __uint_as_float((i & 1) ? (wv_ & 0xffff0000u) : (wv_ << 16)), a_ = __uint_as_float((i & 1) ? (wa_ & 0xffff0000u) : (wa_ << 16));
            const float p_r = __uint_as_float((i & 1) ? (qr_ & 0xffff0000u) : (qr_ << 16)), p_k = __uint_as_float((i & 1) ? (qk_ & 0xffff0000u) : (qk_ << 16)),
                  p_v = __uint_as_float((i & 1) ? (qv_ & 0xffff0000u) : (qv_ << 16));
            float r_ = c_r + mur[i] * (p_r - c_r), kx = c_k + muk[i] * (p_k - c_k), v_ = c_v + muv[i] * (p_v - c_v);
            float lw_ = __uint_as_float((i & 1) ? (wx_ & 0xffff0000u) : (wx_ << 16));
            if (!valid) { r_ = 0.f; kx = 0.f; v_ = 0.f; lw_ = 0.f; }
            const float kkr = kx * kkc[i];
            const float k2_ = kx * (1.f + (a_ - 1.f) * kac[i]);
            ssq += kkr * kkr; bdp += r_ * k2_ * rkc[i];
            const float g = row_prefix16(lw_);
            const float eg = __expf(g), egx = __expf(g - lw_), eng = __expf(-g);
            const int e = 4 * r + i;
            abu[e] = -kkr * egx; bbu[e] = kkr * a_ * eng; kb[i] = k2_ * eng; rb[i] = r_ * eg; vv[i] = v_;
            if (i16 == 15) *(LAS float*)(slot + CH_OFF_GM + 4 * (cb + i)) = eg;
        }
        const int off = i16 * CH_TP + cb * 2;
        pkk[r] = pk4(kb[0], kb[1], kb[2], kb[3]); prr[r] = pk4(rb[0], rb[1], rb[2], rb[3]);
        *(LAS u32x2*)(slot + CH_OFF_VT + off) = pk4(vv[0], vv[1], vv[2], vv[3]);
        *(LAS u32x2*)(slot + CH_OFF_KT + off) = pkk[r];
        asm volatile("" : "+v"(ssq), "+v"(bdp));
        __builtin_amdgcn_sched_barrier(0);
    }
    __builtin_amdgcn_sched_barrier(0);
    pf();
    __builtin_amdgcn_sched_barrier(0);
    ssq += __shfl_xor(ssq, 16); ssq += __shfl_xor(ssq, 32);
    bdp += __shfl_xor(bdp, 16); bdp += __shfl_xor(bdp, 32);
    if (valid && qp == 0) BD[m * 16 + h] = bdp;
    const float inrm = __builtin_amdgcn_rcpf(fmaxf(__builtin_amdgcn_sqrtf(ssq), 1e-12f));
#pragma unroll
    for (int r = 0; r < 4; ++r) {
        pa[r] = pk4(abu[4 * r] * inrm, abu[4 * r + 1] * inrm, abu[4 * r + 2] * inrm, abu[4 * r + 3] * inrm);
        pb[r] = pk4(bbu[4 * r] * inrm, bbu[4 * r + 1] * inrm, bbu[4 * r + 2] * inrm, bbu[4 * r + 3] * inrm);
        const int off = i16 * CH_TP + (16 * r + 4 * qp) * 2;
        *(LAS u32x2*)(slot + CH_OFF_AA + off) = pa[r];
        *(LAS u32x2*)(slot + CH_OFF_BT + off) = pb[r];
    }
    __builtin_amdgcn_sched_barrier(0);
    bf16x8_t fa[2], fb[2], fk[2], fr[2];
#pragma unroll
    for (int ks = 0; ks < 2; ++ks) { fa[ks] = mk_frag(pa[2 * ks], pa[2 * ks + 1]); fb[ks] = mk_frag(pb[2 * ks], pb[2 * ks + 1]); fk[ks] = mk_frag(pkk[2 * ks], pkk[2 * ks + 1]); fr[ks] = mk_frag(prr[2 * ks], prr[2 * ks + 1]); }
    f32x4 Lc = gram(fa, fb), Nc = gram(fb, fa), Lak = gram(fa, fk), MrbT = gram(fb, fr), MrkT = gram(fk, fr);
#pragma unroll
    for (int r = 0; r < 4; ++r) {
        const int row = 4 * qp + r;
        Lc[r] = row > i16 ? Lc[r] : 0.f;
        Lak[r] = row > i16 ? Lak[r] : 0.f;
        Nc[r] = row < i16 ? Nc[r] : 0.f;
        MrbT[r] = row <= i16 ? MrbT[r] : 0.f;
        MrkT[r] = row <= i16 ? MrkT[r] : 0.f;
    }
    __builtin_amdgcn_sched_barrier(0);
    f32x4 eye;
#pragma unroll
    for (int r = 0; r < 4; ++r) eye[r] = (4 * qp + r == i16) ? 1.f : 0.f;
    const f32x4 L2 = prod16(Nc, Lc), N2 = prod16(Lc, Nc);
    const f32x4 L4 = prod16(N2, L2), N4 = prod16(L2, N2);
    const f32x4 N8 = prod16(L4, N4);
    const f32x4 Q1 = prod16(Lc + eye, N2 + eye), Q1T = prod16(N2 + eye, Lc + eye), Q2 = prod16(L4 + eye, N8 + eye);
    const f32x4 TT = prod16(Q1T, Q2);
    const f32x4 TLk = prod16(Lak, TT);
    __builtin_amdgcn_sched_barrier(0);
    LDSW();
    const bf16x8_t ttf = mk_frag(pk4(TT[0], TT[1], TT[2], TT[3]), (u32x2){0u, 0u});
    f32x4 at[4];
#pragma unroll
    for (int kt = 0; kt < 4; ++kt) {
        const u32x2 ac = tr_read4(slot + CH_OFF_AA + (4 * qp + (i16 >> 2)) * CH_TP + (16 * kt + 4 * (i16 & 3)) * 2);
        at[kt] = __builtin_amdgcn_mfma_f32_16x16x32_bf16(mk_frag(ac, (u32x2){0u, 0u}), ttf, (f32x4){0.f, 0.f, 0.f, 0.f}, 0, 0, 0);
    }
    LDSW();
#pragma unroll
    for (int ks = 0; ks < 2; ++ks) {
        const u32x2 lo = pk4(at[2 * ks][0], at[2 * ks][1], at[2 * ks][2], at[2 * ks][3]), hi = pk4(at[2 * ks + 1][0], at[2 * ks + 1][1], at[2 * ks + 1][2], at[2 * ks + 1][3]);
        *(LAS u32x4*)(slot + CH_OFF_AA + ks * 1024 + lane * 16) = (u32x4){lo.x, lo.y, hi.x, hi.y};
        *(LAS u32x4*)(slot + CH_OFF_RA + ks * 1024 + lane * 16) = __builtin_bit_cast(u32x4, fr[ks]);
    }
    {
        const u32x2 mb = pk4(MrbT[0], MrbT[1], MrbT[2], MrbT[3]), mk = pk4(MrkT[0], MrkT[1], MrkT[2], MrkT[3]), tl = pk4(TLk[0], TLk[1], TLk[2], TLk[3]);
        *(LAS u32x4*)(slot + CH_OFF_MC + lane * 16) = (u32x4){mb.x, mb.y, mk.x, mk.y};
        *(LAS u32x2*)(slot + CH_OFF_TL + lane * 8) = tl;
    }
}

struct ChainFrag { u32x4 aa0, aa1, ra0, ra1, mc, tl; u32x2 vq4, b4[4], k4[4]; f32x4 gm[4]; };
__device__ __forceinline__ void chain_fetch(LAS unsigned char* slot, int vq, int lane, ChainFrag& F) {
    const int i16 = lane & 15, qp = lane >> 4;
    const int troff = (4 * qp + (i16 >> 2)) * CH_TP + 8 * (i16 & 3);
    { const u32x2 t2 = *(const LAS u32x2*)(slot + CH_OFF_TL + lane * 8); F.tl = (u32x4){t2.x, t2.y, 0u, 0u}; }
    F.vq4 = tr_read4(slot + CH_OFF_VT + troff + 32 * vq);
    F.aa0 = *(const LAS u32x4*)(slot + CH_OFF_AA + lane * 16); F.aa1 = *(const LAS u32x4*)(slot + CH_OFF_AA + 1024 + lane * 16);
    F.ra0 = *(const LAS u32x4*)(slot + CH_OFF_RA + lane * 16); F.ra1 = *(const LAS u32x4*)(slot + CH_OFF_RA + 1024 + lane * 16);
    F.mc = *(const LAS u32x4*)(slot + CH_OFF_MC + lane * 16);
#pragma unroll
    for (int kt = 0; kt < 4; ++kt) {
        F.b4[kt] = tr_read4(slot + CH_OFF_BT + troff + 32 * kt); F.k4[kt] = tr_read4(slot + CH_OFF_KT + troff + 32 * kt);
        F.gm[kt] = *(const LAS f32x4*)(slot + CH_OFF_GM + 4 * (16 * kt + 4 * qp));
    }
}
__device__ __forceinline__ f32x4 chain_math(const ChainFrag& F, f32x4 (&ST)[4]) {
    const f32x4 z4 = (f32x4){0.f, 0.f, 0.f, 0.f};
    const f32x4 tlv = __builtin_amdgcn_mfma_f32_16x16x32_bf16(__builtin_bit_cast(bf16x8_t, F.tl), mk_frag(F.vq4, F.vq4), z4, 0, 0, 0);
    bf16x8_t sb[2];
#pragma unroll
    for (int ks = 0; ks < 2; ++ks) sb[ks] = mk_frag(pk4(ST[2 * ks][0], ST[2 * ks][1], ST[2 * ks][2], ST[2 * ks][3]), pk4(ST[2 * ks + 1][0], ST[2 * ks + 1][1], ST[2 * ks + 1][2], ST[2 * ks + 1][3]));
    const f32x4 u1 = __builtin_amdgcn_mfma_f32_16x16x32_bf16(__builtin_bit_cast(bf16x8_t, F.aa0), sb[0], z4, 0, 0, 0);
    const f32x4 u2 = __builtin_amdgcn_mfma_f32_16x16x32_bf16(__builtin_bit_cast(bf16x8_t, F.aa1), sb[1], tlv, 0, 0, 0);
    f32x4 Y = __builtin_amdgcn_mfma_f32_16x16x32_bf16(__builtin_bit_cast(bf16x8_t, F.ra0), sb[0], z4, 0, 0, 0);
    const f32x4 y2 = __builtin_amdgcn_mfma_f32_16x16x32_bf16(__builtin_bit_cast(bf16x8_t, F.ra1), sb[1], z4, 0, 0, 0);
    const f32x4 U = u1 + u2;
    const bf16x8_t uv = mk_frag(pk4(U[0], U[1], U[2], U[3]), F.vq4);
#pragma unroll
    for (int kt = 0; kt < 4; ++kt) {
        ST[kt] = __builtin_amdgcn_mfma_f32_16x16x32_bf16(mk_frag(F.b4[kt], F.k4[kt]), uv, ST[kt], 0, 0, 0);
        ST[kt] = ST[kt] * F.gm[kt];
    }
    Y = __builtin_amdgcn_mfma_f32_16x16x32_bf16(__builtin_bit_cast(bf16x8_t, F.mc), uv, Y, 0, 0, 0);
    return Y + y2;
}
struct ChainFrag2 { u32x4 aa0, aa1, ra0, ra1, mc, tl; u32x2 va, vb, b4[4], k4[4]; f32x4 gm[4]; };
__device__ __forceinline__ void chain_fetch2(LAS unsigned char* slot, int vq0, int lane, ChainFrag2& F) {
    const int i16 = lane & 15, qp = lane >> 4;
    const int troff = (4 * qp + (i16 >> 2)) * CH_TP + 8 * (i16 & 3);
    { const u32x2 t2 = *(const LAS u32x2*)(slot + CH_OFF_TL + lane * 8); F.tl = (u32x4){t2.x, t2.y, 0u, 0u}; }
    F.va = tr_read4(slot + CH_OFF_VT + troff + 32 * vq0); F.vb = tr_read4(slot + CH_OFF_VT + troff + 32 * (vq0 + 1));
    F.aa0 = *(const LAS u32x4*)(slot + CH_OFF_AA + lane * 16); F.aa1 = *(const LAS u32x4*)(slot + CH_OFF_AA + 1024 + lane * 16);
    F.ra0 = *(const LAS u32x4*)(slot + CH_OFF_RA + lane * 16); F.ra1 = *(const LAS u32x4*)(slot + CH_OFF_RA + 1024 + lane * 16);
    F.mc = *(const LAS u32x4*)(slot + CH_OFF_MC + lane * 16);
#pragma unroll
    for (int kt = 0; kt < 4; ++kt) {
        F.b4[kt] = tr_read4(slot + CH_OFF_BT + troff + 32 * kt); F.k4[kt] = tr_read4(slot + CH_OFF_KT + troff + 32 * kt);
        F.gm[kt] = *(const LAS f32x4*)(slot + CH_OFF_GM + 4 * (16 * kt + 4 * qp));
    }
}
__device__ __forceinline__ void chain_math2(const ChainFrag2& F, f32x4 (&SA)[4], f32x4 (&SB)[4], f32x4& YA, f32x4& YB) {
    const f32x4 z4 = (f32x4){0.f, 0.f, 0.f, 0.f};
    const bf16x8_t tl = __builtin_bit_cast(bf16x8_t, F.tl), aa0 = __builtin_bit_cast(bf16x8_t, F.aa0), aa1 = __builtin_bit_cast(bf16x8_t, F.aa1),
                   ra0 = __builtin_bit_cast(bf16x8_t, F.ra0), ra1 = __builtin_bit_cast(bf16x8_t, F.ra1), mc = __builtin_bit_cast(bf16x8_t, F.mc);
    const f32x4 tlva = __builtin_amdgcn_mfma_f32_16x16x32_bf16(tl, mk_frag(F.va, F.va), z4, 0, 0, 0);
    const f32x4 tlvb = __builtin_amdgcn_mfma_f32_16x16x32_bf16(tl, mk_frag(F.vb, F.vb), z4, 0, 0, 0);
    bf16x8_t sa[2], sb[2];
#pragma unroll
    for (int ks = 0; ks < 2; ++ks) {
        sa[ks] = mk_frag(pk4(SA[2 * ks][0], SA[2 * ks][1], SA[2 * ks][2], SA[2 * ks][3]), pk4(SA[2 * ks + 1][0], SA[2 * ks + 1][1], SA[2 * ks + 1][2], SA[2 * ks + 1][3]));
        sb[ks] = mk_frag(pk4(SB[2 * ks][0], SB[2 * ks][1], SB[2 * ks][2], SB[2 * ks][3]), pk4(SB[2 * ks + 1][0], SB[2 * ks + 1][1], SB[2 * ks + 1][2], SB[2 * ks + 1][3]));
    }
    const f32x4 ua1 = __builtin_amdgcn_mfma_f32_16x16x32_bf16(aa0, sa[0], z4, 0, 0, 0);
    const f32x4 ub1 = __builtin_amdgcn_mfma_f32_16x16x32_bf16(aa0, sb[0], z4, 0, 0, 0);
    const f32x4 ua2 = __builtin_amdgcn_mfma_f32_16x16x32_bf16(aa1, sa[1], tlva, 0, 0, 0);
    const f32x4 ub2 = __builtin_amdgcn_mfma_f32_16x16x32_bf16(aa1, sb[1], tlvb, 0, 0, 0);
    f32x4 ya = __builtin_amdgcn_mfma_f32_16x16x32_bf16(ra0, sa[0], z4, 0, 0, 0);
    f32x4 yb = __builtin_amdgcn_mfma_f32_16x16x32_bf16(ra0, sb[0], z4, 0, 0, 0);
    const f32x4 ya2 = __builtin_amdgcn_mfma_f32_16x16x32_bf16(ra1, sa[1], z4, 0, 0, 0);
    const f32x4 yb2 = __builtin_amdgcn_mfma_f32_16x16x32_bf16(ra1, sb[1], z4, 0, 0, 0);
    const f32x4 UA = ua1 + ua2, UB = ub1 + ub2;
    const bf16x8_t uva = mk_frag(pk4(UA[0], UA[1], UA[2], UA[3]), F.va), uvb = mk_frag(pk4(UB[0], UB[1], UB[2], UB[3]), F.vb);
#pragma unroll
    for (int kt = 0; kt < 4; ++kt) {
        const bf16x8_t bk = mk_frag(F.b4[kt], F.k4[kt]);
        SA[kt] = __builtin_amdgcn_mfma_f32_16x16x32_bf16(bk, uva, SA[kt], 0, 0, 0);
        SB[kt] = __builtin_amdgcn_mfma_f32_16x16x32_bf16(bk, uvb, SB[kt], 0, 0, 0);
    }
#pragma unroll
    for (int kt = 0; kt < 4; ++kt) { SA[kt] = SA[kt] * F.gm[kt]; SB[kt] = SB[kt] * F.gm[kt]; }
    ya = __builtin_amdgcn_mfma_f32_16x16x32_bf16(mc, uva, ya, 0, 0, 0);
    yb = __builtin_amdgcn_mfma_f32_16x16x32_bf16(mc, uvb, yb, 0, 0, 0);
    YA = ya + ya2; YB = yb + yb2;
}
__device__ __forceinline__ f32x4 chain_step(LAS unsigned char* slot, f32x4 (&ST)[4], int vq, int lane) { ChainFrag F; chain_fetch(slot, vq, lane, F); return chain_math(F, ST); }

constexpr int N_CH_P = MP / 16 * 16, N_CH_S = DBATCH * 16, N_CH = N_CH_P + N_CH_S;
static_assert(WS_CB + (size_t)N_CH * CH_SLOT <= (size_t)861000000, "chunk buffer fits the workspace");
constexpr int CH_VEC = CH_SLOT / 16;
__device__ __forceinline__ void slot_to_global(const LAS unsigned char* slot, unsigned char* g, int lane) {
#pragma unroll
    for (int i = 0; i < 13; ++i) { const int v = i * 64 + lane; if (v < CH_VEC) *(u32x4*)(g + (size_t)v * 16) = *(const LAS u32x4*)(slot + v * 16); }
}
struct SlotRegs { u32x4 v[13]; };
__device__ __forceinline__ void slot_load(const unsigned char* g, int lane, SlotRegs& S) {
    asm volatile("" : "+v"(lane));
#pragma unroll
    for (int i = 0; i < 13; ++i) { const int v = i * 64 + lane; S.v[i] = *(const u32x4*)(g + (size_t)(v < CH_VEC ? v : 0) * 16); }
}
__device__ __forceinline__ void slot_store(LAS unsigned char* slot, int lane, const SlotRegs& S) {
    asm volatile("" : "+v"(lane));
#pragma unroll
    for (int i = 0; i < 13; ++i) { const int v = i * 64 + lane; if (v < CH_VEC) *(LAS u32x4*)(slot + v * 16) = S.v[i]; }
}
__device__ __forceinline__ void phase_c1(const Args& a, int L, LAS unsigned char* lds) {
    const int tid = threadIdx.x, lane = tid & 63, wv = __builtin_amdgcn_readfirstlane(tid >> 6);
    LAS unsigned char* slot = lds + wv * CH_SLOT; LAS unsigned char* par = lds + CH_PAR_OFF + wv * CH_PAR_BYTES;
    unsigned char* CB = a.ws + WS_CB;
    rglru_prefix(a);
    const int stride = gridDim.x * NWAVES;
    auto item = [&](int ci, size_t& m0, int& ntok, bool& ss, const float*& sh0) {
        sh0 = nullptr;
        if (ci < N_CH_P) { const int chunk = ci >> 4; m0 = (size_t)chunk * 16; ntok = 16; ss = (chunk & (SEQ / 16 - 1)) == 0; }
        else { const int b = (ci - N_CH_P) >> 4; m0 = (size_t)MP + (size_t)b * DSEQ; ntok = DSEQ; ss = true; sh0 = a.in[6] + ((size_t)L * DBATCH + b) * SHIFT_W; }
    };
    auto fetch = [&](int ci, ChunkRaw& R) { size_t m0; int ntok; bool ss; const float* sh0; item(ci, m0, ntok, ss, sh0); chunk_load(a, m0, ci & 15, ntok, lane, R); };
    int ci = blockIdx.x * NWAVES + wv;
    ChunkRaw R;
    if (ci < N_CH) fetch(ci, R);
    for (; ci < N_CH; ci += stride) {
        const int h = ci & 15; size_t m0; int ntok; bool ss; const float* sh0; item(ci, m0, ntok, ss, sh0);
        stage_head_params(a, L, h, par, lane);
        LDSW();
        chunk_compute(a, R, m0, h, ntok, ss, sh0, par, slot, lane, [&]() { if (ci + stride < N_CH) fetch(ci + stride, R); });
        LDSW();
        const size_t sid = ci < N_CH_P ? ((size_t)((ci >> 4) >> 9) * 16 + h) * (SEQ / 16) + ((ci >> 4) & (SEQ / 16 - 1)) : (size_t)ci;
        slot_to_global(slot, CB + sid * CH_SLOT, lane);
        LDSW();
    }
}

#define WG_BAR() do { asm volatile("s_waitcnt lgkmcnt(0)" ::: "memory"); __builtin_amdgcn_s_barrier(); asm volatile("" ::: "memory"); } while (0)
template <int DRY> __device__ __forceinline__ void wkv_prompt_chain(const Args& a, int L, int b, int h, LAS unsigned char* lds) {
    const int tid = threadIdx.x, lane = tid & 63, wv = __builtin_amdgcn_readfirstlane(tid >> 6), i16 = lane & 15, qp = lane >> 4;
    bf16_t* Y = (bf16_t*)(a.ws + WS_Y);
    const unsigned char* CB = a.ws + WS_CB;
    constexpr int NR = SEQ / 64;
    const size_t ci0 = ((size_t)b * 16 + h) * (SEQ / 16);
    if (wv >= 4) {
        const int lw = wv - 4;
        SlotRegs S0, S1, S2;
#define CB_GROUP(k) (CB + (ci0 + (size_t)(4 * (k) + lw)) * CH_SLOT)
        slot_load(CB_GROUP(0), lane, S0);
        slot_store(lds + lw * CH_SLOT, lane, S0);
        slot_load(CB_GROUP(1), lane, S1); slot_load(CB_GROUP(2), lane, S2); slot_load(CB_GROUP(3), lane, S0);
        WG_BAR();
        for (int g = 0; g < NR; g += 6) {
#define LROUND(r, SET) do { if ((r) < NR) { if (DRY != 2) if ((r) + 1 < NR) slot_store(lds + ((((r) + 1) & 1) * 4 + lw) * CH_SLOT, lane, SET); if (DRY != 2) if ((r) + 4 < NR) slot_load(CB_GROUP((r) + 4), lane, SET); WG_BAR(); } } while (0)
            LROUND(g, S1); LROUND(g + 1, S2); LROUND(g + 2, S0); LROUND(g + 3, S1); LROUND(g + 4, S2); LROUND(g + 5, S0);
#undef LROUND
        }
#undef CB_GROUP
    } else if (wv < 2) {
        f32x4 SA[4], SB[4];
#pragma unroll
        for (int kt = 0; kt < 4; ++kt) { SA[kt] = (f32x4){0.f, 0.f, 0.f, 0.f}; SB[kt] = SA[kt]; }
        WG_BAR();
        bf16_t* yrow = Y + ((size_t)b * SEQ) * D + 64 * h + 32 * wv;
        for (int g = 0; g < NR; ++g) {
            LAS unsigned char* gs = lds + (g & 1) * 4 * CH_SLOT;
            ChainFrag2 FA, FB;
            f32x4 ya[4], yb[4];
#define SB0() __builtin_amdgcn_sched_barrier(0)
            if (DRY == 3) { WG_BAR(); continue; }
            chain_fetch2(gs, 2 * wv, lane, FA);
            chain_fetch2(gs + CH_SLOT, 2 * wv, lane, FB); SB0();
            chain_math2(FA, SA, SB, ya[0], yb[0]); SB0();
            chain_fetch2(gs + 2 * CH_SLOT, 2 * wv, lane, FA); SB0();
            chain_math2(FB, SA, SB, ya[1], yb[1]); SB0();
            chain_fetch2(gs + 3 * CH_SLOT, 2 * wv, lane, FB); SB0();
            chain_math2(FA, SA, SB, ya[2], yb[2]); SB0();
            chain_math2(FB, SA, SB, ya[3], yb[3]); SB0();
#undef SB0
            {
                LAS unsigned char* yt = lds + CH_PAR_OFF + wv * 4608;
#pragma unroll
                for (int j = 0; j < 4; ++j)
#pragma unroll
                    for (int r = 0; r < 4; ++r) {
                        *(LAS unsigned short*)(yt + (16 * j + 4 * qp + r) * 72 + 2 * i16) = f2bf(ya[j][r]);
                        *(LAS unsigned short*)(yt + (16 * j + 4 * qp + r) * 72 + 2 * (16 + i16)) = f2bf(yb[j][r]);
                    }
                LDSW();
#pragma unroll
                for (int j = 0; j < 4; ++j) {
                    const int row = 16 * j + (lane >> 2), pc = lane & 3;
                    const u32x2 lo = *(const LAS u32x2*)(yt + row * 72 + pc * 16), hi = *(const LAS u32x2*)(yt + row * 72 + pc * 16 + 8);
                    if (DRY == 0) *(u32x4*)(yrow + (size_t)row * D + 8 * pc) = (u32x4){lo.x, lo.y, hi.x, hi.y};
                    else asm volatile("" :: "v"(lo), "v"(hi));
                }
                LDSW();
            }
            yrow += (size_t)64 * D;
            WG_BAR();
        }
        float* o = a.out + O_PWKV + ((((size_t)L * NBATCH + b) * 16 + h) * 64 + 32 * wv + i16) * 64;
#pragma unroll
        for (int kt = 0; kt < 4; ++kt) { if (DRY == 0) { *(f32x4*)(o + 16 * kt + 4 * qp) = SA[kt]; *(f32x4*)(o + 16 * 64 + 16 * kt + 4 * qp) = SB[kt]; } else asm volatile("" :: "v"(SA[kt]), "v"(SB[kt])); }
    } else {
        WG_BAR();
        for (int g = 0; g < NR; ++g) WG_BAR();
    }
    __syncthreads();
}
#undef WG_BAR
__device__ __forceinline__ void wkv_sample_chain(const Args& a, int L, int b, int ho, LAS unsigned char* lds) {
    const int tid = threadIdx.x, lane = tid & 63, wv = __builtin_amdgcn_readfirstlane(tid >> 6), i16 = lane & 15, qp = lane >> 4;
    const int h = 8 * ho + wv;
    bf16_t* Y = (bf16_t*)(a.ws + WS_Y);
    LAS unsigned char* slot = lds + wv * CH_SLOT;
    const size_t m0 = (size_t)MP + (size_t)b * DSEQ;
    { SlotRegs S; slot_load(a.ws + WS_CB + ((size_t)N_CH_P + (size_t)b * 16 + h) * CH_SLOT, lane, S); slot_store(slot, lane, S); }
    LDSW();
    for (int vp = 0; vp < 2; ++vp) {
        const size_t so = ((((size_t)L * DBATCH + b) * 16 + h) * 64 + 32 * vp + i16) * 64;
        f32x4 SA[4], SB[4];
#pragma unroll
        for (int kt = 0; kt < 4; ++kt) { SA[kt] = *(const f32x4*)(a.in[7] + so + 16 * kt + 4 * qp); SB[kt] = *(const f32x4*)(a.in[7] + so + 16 * 64 + 16 * kt + 4 * qp); }
        ChainFrag2 F; chain_fetch2(slot, 2 * vp, lane, F);
        f32x4 ya, yb; chain_math2(F, SA, SB, ya, yb);
#pragma unroll
        for (int r = 0; r < 4; ++r) if (4 * qp + r < DSEQ) { Y[(m0 + 4 * qp + r) * D + 64 * h + 32 * vp + i16] = f2bf(ya[r]); Y[(m0 + 4 * qp + r) * D + 64 * h + 32 * vp + 16 + i16] = f2bf(yb[r]); }
#pragma unroll
        for (int kt = 0; kt < 4; ++kt) { *(f32x4*)(a.out + O_SWKV + so + 16 * kt + 4 * qp) = SA[kt]; *(f32x4*)(a.out + O_SWKV + so + 16 * 64 + 16 * kt + 4 * qp) = SB[kt]; }
    }
    __syncthreads();
}

#ifndef PROBE_MIXB
#define PROBE_MIXB 0
#endif
__device__ __forceinline__ void phase_mixb2(const Args& a, int L, LAS unsigned char* lds) {
    constexpr int N_PC = NBATCH * 16;
    const int G = gridDim.x, bx = blockIdx.x;
    const int first_other = (G > 2 * N_PC) ? N_PC : 0;
    for (int it = bx; it < N_PC; it += G) wkv_prompt_chain<0>(a, L, it >> 4, it & 15, lds);
    if (PROBE_MIXB & 1) for (int it = bx; it < N_PC; it += G) wkv_prompt_chain<0>(a, L, it >> 4, it & 15, lds);
    if (PROBE_MIXB & 8) for (int it = bx; it < N_PC; it += G) wkv_prompt_chain<1>(a, L, it >> 4, it & 15, lds);
    if (PROBE_MIXB & 16) for (int it = bx; it < N_PC; it += G) wkv_prompt_chain<2>(a, L, it >> 4, it & 15, lds);
    if (PROBE_MIXB & 32) for (int it = bx; it < N_PC; it += G) wkv_prompt_chain<3>(a, L, it >> 4, it & 15, lds);
    if (bx < first_other) return;
    const int nb = G - first_other, id = bx - first_other;
    constexpr int N_RG2 = M / 64, N_SC = DBATCH * 2;
    phase_state_copies(a, L, first_other);
    for (int it = id; it < N_RG2; it += nb) { rglru_unit2<true>(a, L, it, lds); __syncthreads(); }
    if (PROBE_MIXB & 4) for (int it = id; it < N_RG2; it += nb) { rglru_unit2<true>(a, L, it, lds); __syncthreads(); }
    {
        const int second = (N_RG2 > nb) ? N_RG2 - nb : 0;
        const int start = id >= second ? id - second : id + (nb - second);
        for (int it = start; it < N_SC; it += nb) wkv_sample_chain(a, L, it >> 1, it & 1, lds);
        if (PROBE_MIXB & 2) for (int it = start; it < N_SC; it += nb) wkv_sample_chain(a, L, it >> 1, it & 1, lds);
    }
}
#ifndef PROBE_MASK
#define PROBE_MASK 0
#endif
#define PH_IN(k) (lo <= (k) && (k) < hi)
#define RUN_PHASE(po, ...) do { { __VA_ARGS__ } if (((PROBE_MASK >> (po)) & 1) && PH_IN(base + (po))) { cg::this_grid().sync(); { __VA_ARGS__ } } } while (0)
#define PH_SYNC(k) do { if (lo < (k) && (k) < hi) cg::this_grid().sync(); } while (0)
template <int L> __device__ __forceinline__ void layer_phases(const Args& a, LAS unsigned char* lds, int lo, int hi) {
    unsigned char* ws = a.ws;
    const int G = gridDim.x;
    constexpr int base = PH_L0 + L * PH_PER_LAYER;
    PH_SYNC(base + PHO_IN);
    RUN_PHASE(PHO_IN, if (PH_IN(base + PHO_IN)) {
        pg8::Gemm g{(const bf16_t*)(ws + WS_XB), (const bf16_t*)(ws + WS_WIN), M, NP, D}; pg8::StaticOrder S; S.init(M, NP, G, (int)blockIdx.x);
        EpiIn E{(bf16_t*)(ws + WS_P), NP, CG / 256};
        pg8::gemm_phase<EpiIn, pg8::StaticOrder, true, true>(lds, g, S, E);
    });
    PH_SYNC(base + PHO_MIXA);
    RUN_PHASE(PHO_MIXA, if (PH_IN(base + PHO_MIXA)) phase_mixa(a, L, lds););
    PH_SYNC(base + PHO_LORA);
    RUN_PHASE(PHO_LORA, if (PH_IN(base + PHO_LORA)) {
        pg8::Gemm g{(const bf16_t*)(ws + WS_ACAT), (const bf16_t*)(ws + WS_WLORA), M, 3072, ACAT_K}; pg8::StaticOrder S; S.init(M, 3072, G, (int)blockIdx.x);
        EpiLora E{(bf16_t*)(ws + WS_WAW), (bf16_t*)(ws + WS_WAA), (bf16_t*)(ws + WS_WAG), a.in[18] + L * D, a.in[20] + L * D};
        pg8::gemm_phase<EpiLora, pg8::StaticOrder, true, true>(lds, g, S, E);
    });
    PH_SYNC(base + PHO_C1);
    RUN_PHASE(PHO_C1, if (PH_IN(base + PHO_C1)) phase_c1(a, L, lds););
    PH_SYNC(base + PHO_MIXB);
    RUN_PHASE(PHO_MIXB, if (PH_IN(base + PHO_MIXB)) phase_mixb2(a, L, lds););
    PH_SYNC(base + PHO_MIXC);
    if (PH_IN(base + PHO_MIXC)) {
#if defined(PROBE_MIXC)
        phase_mixc(a, L, (bf16_t*)(ws + WS_CB)); cg::this_grid().sync();
#endif
        phase_mixc(a, L, (bf16_t*)(ws + WS_OA));
    }
    PH_SYNC(base + PHO_OUT);
    RUN_PHASE(PHO_OUT, if (PH_IN(base + PHO_OUT)) {
        {
            pg8::Gemm g{(const bf16_t*)(ws + WS_MIX), (const bf16_t*)(ws + WS_WOUT), MP, D, D}; pg8::StaticOrder S; S.init(MP, D, G, (int)blockIdx.x);
            if (L == 0) { EpiZ<false> E{a.in[0], (float*)(ws + WS_Z), D}; pg8::gemm_phase<EpiZ<false>, pg8::StaticOrder, true, true>(lds, g, S, E); }
            else { EpiZ<true> E{ws + WS_XB, (float*)(ws + WS_Z), D}; pg8::gemm_phase<EpiZ<true>, pg8::StaticOrder, true, true>(lds, g, S, E); }
        }
        {
            pg8::Gemm g{(const bf16_t*)(ws + WS_MIX) + (size_t)MP * D, (const bf16_t*)(ws + WS_WOUTS), MS, 4 * D, 256, D, 256, 4, (size_t)512}; pg8::StaticOrder S; S.init(MS, 4 * D, G, (int)blockIdx.x);
            if (L == 0) { EpiZS<false> E{a.in[1], (float*)(ws + WS_ZS), D}; pg8::gemm_phase<EpiZS<false>, pg8::StaticOrder, true, true>(lds, g, S, E); }
            else { EpiZS<true> E{ws + WS_XB + (size_t)MP * D * 2, (float*)(ws + WS_ZS), D}; pg8::gemm_phase<EpiZS<true>, pg8::StaticOrder, true, true>(lds, g, S, E); }
        }
    });
    PH_SYNC(base + PHO_LN1);
    RUN_PHASE(PHO_LN1, if (PH_IN(base + PHO_LN1)) phase_ln<4>((const float*)(ws + WS_Z), (const float*)(ws + WS_ZS), a.in[29] + L * D, a.in[30] + L * D, nullptr, (bf16_t*)(ws + WS_X1B)););
    PH_SYNC(base + PHO_GU);
    RUN_PHASE(PHO_GU, if (PH_IN(base + PHO_GU)) {
        pg8::Gemm g{(const bf16_t*)(ws + WS_X1B), (const bf16_t*)(ws + WS_WGU), M, 2 * DFF, D}; pg8::StaticOrder S; S.init(M, 2 * DFF, G, (int)blockIdx.x);
        EpiSwiGLU E{(bf16_t*)(ws + WS_H), DFF};
        pg8::gemm_phase<EpiSwiGLU, pg8::StaticOrder, true, true>(lds, g, S, E);
    });
    PH_SYNC(base + PHO_DOWN);
    RUN_PHASE(PHO_DOWN, if (PH_IN(base + PHO_DOWN)) {
        {
            pg8::Gemm g{(const bf16_t*)(ws + WS_H), (const bf16_t*)(ws + WS_WDN), MP, D, DFF}; pg8::StaticOrder S; S.init(MP, D, G, (int)blockIdx.x);
            EpiZ<true> E{ws + WS_X1B, (float*)(ws + WS_Z), D};
            pg8::gemm_phase<EpiZ<true>, pg8::StaticOrder, true, true>(lds, g, S, E);
        }
        {
            pg8::Gemm g{(const bf16_t*)(ws + WS_H) + (size_t)MP * DFF, (const bf16_t*)(ws + WS_WDNS), MS, 11 * D, 256, DFF, 256, 4, (size_t)512}; pg8::StaticOrder S; S.init(MS, 11 * D, G, (int)blockIdx.x);
            EpiZS<true> E{ws + WS_X1B + (size_t)MP * D * 2, (float*)(ws + WS_ZS), D};
            pg8::gemm_phase<EpiZS<true>, pg8::StaticOrder, true, true>(lds, g, S, E);
        }
    });
    PH_SYNC(base + PHO_LN2);
    RUN_PHASE(PHO_LN2, if (PH_IN(base + PHO_LN2)) {
        if (L == DEPTH - 1) phase_ln<11>((const float*)(ws + WS_Z), (const float*)(ws + WS_ZS), a.in[33] + L * D, a.in[34] + L * D, a.out + O_YP, nullptr);
        else { phase_ln<11>((const float*)(ws + WS_Z), (const float*)(ws + WS_ZS), a.in[33] + L * D, a.in[34] + L * D, nullptr, (bf16_t*)(ws + WS_XB)); phase_prep_weights(a, L + 1, lds); }
    });
}
__global__ void __launch_bounds__(NTHREADS, 2) mega(Args a) {
    extern __shared__ __attribute__((aligned(16))) unsigned char lds_raw[];
    LAS unsigned char* lds = (LAS unsigned char*)lds_raw;
    const int lo = a.ph_lo, hi = a.ph_hi;
    if (PH_IN(PH_PREP)) { phase_prep_weights(a, 0, lds); phase_prep_x(a); }
    layer_phases<0>(a, lds, lo, hi);
    layer_phases<1>(a, lds, lo, hi);
}

static void launch_mega(Args a, int lo, int hi, int grid, hipStream_t s) {
    a.ph_lo = lo; a.ph_hi = hi;
    void* args[] = {&a};
    hipError_t e;
    if (hi - lo > 1) e = hipLaunchCooperativeKernel((void*)mega, dim3(grid), dim3(NTHREADS), args, LDS_BYTES, s);
    else e = hipLaunchKernel((void*)mega, dim3(grid), dim3(NTHREADS), args, LDS_BYTES, s);
    if (e != hipSuccess) fprintf(stderr, "mega launch [%d,%d) failed: %s (grid %d)\n", lo, hi, hipGetErrorString(e), grid);
}

extern "C" void kernel_launch(void* const* d_in, const int* in_sizes, int n_in, void* d_out, int out_size,
                              void* d_ws, size_t ws_size, hipStream_t stream) {
    if (ws_size < WS_END || out_size != (int)O_END || n_in != 35) { fprintf(stderr, "kernel_launch: unexpected sizes ws=%zu out=%d n_in=%d\n", ws_size, out_size, n_in); return; }
    static int grid = 0;
    if (!grid) {
        int dev = 0, cus = 0, per_cu = 0;
        (void)hipGetDevice(&dev);
        (void)hipDeviceGetAttribute(&cus, hipDeviceAttributeMultiprocessorCount, dev);
        (void)hipFuncSetAttribute((const void*)mega, hipFuncAttributeMaxDynamicSharedMemorySize, LDS_BYTES);
        (void)hipOccupancyMaxActiveBlocksPerMultiprocessor(&per_cu, (const void*)mega, NTHREADS, LDS_BYTES);
        if (per_cu < 1) { fprintf(stderr, "occupancy query says %d blocks per CU\n", per_cu); per_cu = 1; }
        grid = cus * per_cu;
    }
    const float* const* in = (const float* const*)d_in;
    unsigned char* ws = (unsigned char*)d_ws;
    float* out = (float*)d_out;
    Args a{};
    for (int i = 0; i < 35; ++i) a.in[i] = in[i];
    a.out = out; a.ws = ws;
    launch_mega(a, 0, N_PHASES, grid, stream);
}
```

```cpp
#include <hip/hip_runtime.h>
#include <cstdint>
#include <cstdio>

typedef unsigned short bf16_t;
__device__ __forceinline__ float bf2f(bf16_t v) { return __uint_as_float(((unsigned)v) << 16); }
typedef float f32x2c_t __attribute__((ext_vector_type(2))); typedef __bf16 bf16x2c_t __attribute__((ext_vector_type(2)));
__device__ __forceinline__ bf16_t f2bf(float f) { f32x2c_t v = {f, f}; bf16x2c_t b = __builtin_convertvector(v, bf16x2c_t); return (bf16_t)(__builtin_bit_cast(unsigned, b) & 0xffffu); }
__device__ __forceinline__ float sigmoidf_(float x) { return __builtin_amdgcn_rcpf(1.f + __expf(-x)); }
__device__ __forceinline__ float softplusf_(float x) { return fmaxf(x, 0.f) + log1pf(__expf(-fabsf(x))); }
__device__ __forceinline__ float wave_sum(float v) {
#pragma unroll
    for (int o = 1; o < 64; o <<= 1) v += __shfl_xor(v, o);
    return v;
}

constexpr int D = 1024, MP = 16384, MS = 1024, M = MP + MS, SEQ = 8192, DSEQ = 8, NBATCH = 2, DBATCH = 128, DEPTH = 2;
constexpr int NP = 9216, IN_COLS = 8992;
constexpr int CQ = 0, CK = 1024, CV = 1280, CRNN = 1536, CRW = 2560, CG = 6144;
constexpr int SHIFT_W = 3360, DFF = 2816;
constexpr float ALPHA = 1.4142135623730951f;
constexpr float LN_EPS = 1e-5f, GN_EPS = 64e-5f;

constexpr size_t O_YP = 0, O_YS = 16777216, O_PK = 17825792, O_PV = 17956864, O_PCONV = 18087936, O_PH = 18100224,
                 O_PSHIFT = 18104320, O_PWKV = 18117760, O_SK = 18379904, O_SV = 26768512, O_SCONV = 35157120,
                 O_SH = 35943552, O_SSHIFT = 36205696, O_SWKV = 37065856, O_END = 53843072;


constexpr size_t MiB = 1u << 20;
constexpr size_t WS_CTL = 0;
constexpr size_t WIN_T_BYTES = (size_t)NP * D * 2, WOUT_T_BYTES = (size_t)D * D * 2, WGU_T_BYTES = (size_t)2 * DFF * D * 2, WDN_T_BYTES = (size_t)D * DFF * 2;
constexpr int ACAT_K = 384;
constexpr size_t WLORA_BYTES = (size_t)3072 * ACAT_K * 2;
constexpr size_t WS_WIN = 1 * MiB;
constexpr size_t WS_WOUT = WS_WIN + WIN_T_BYTES;
constexpr size_t WS_WGU = WS_WOUT + WOUT_T_BYTES;
constexpr size_t WS_WDN = WS_WGU + WGU_T_BYTES;
constexpr size_t WS_WOUTS = WS_WDN + WDN_T_BYTES;
constexpr size_t WS_WDNS = WS_WOUTS + WOUT_T_BYTES;
constexpr size_t WS_WLORA = WS_WDNS + WDN_T_BYTES;
constexpr size_t WS_XB = WS_WLORA + WLORA_BYTES;
constexpr size_t WS_OA = WS_XB + (size_t)M * D * 2;
constexpr size_t WS_MIX = WS_OA;
constexpr size_t WS_OB = WS_OA + (size_t)M * D * 2;
constexpr size_t WS_P = WS_OB + (size_t)M * D * 2;
constexpr size_t WS_Z = WS_P;
constexpr size_t WS_ZS = WS_Z + (size_t)M * D * 4;
constexpr size_t WS_X1B = WS_ZS + (size_t)11 * MS * D * 4;
constexpr size_t WS_H = WS_X1B + (size_t)M * D * 2;
constexpr size_t WS_PEND = WS_P + (size_t)M * NP * 2;
constexpr size_t WS_RS = WS_PEND;
constexpr size_t WS_WAW = WS_RS + (size_t)2 * 128 * 1024 * 2 * 4;
constexpr size_t WS_WAA = WS_WAW + (size_t)M * D * 2;
constexpr size_t WS_WAG = WS_WAA + (size_t)M * D * 2;
constexpr size_t WS_Y = WS_WAG + (size_t)M * D * 2;
constexpr size_t WS_BD = WS_Y + (size_t)M * D * 2;
constexpr size_t WS_ACAT = WS_BD + (size_t)M * 16 * 4;
constexpr size_t WS_CB = WS_ACAT;
constexpr size_t WS_END = WS_ACAT + (size_t)M * ACAT_K * 2;
static_assert(WS_END <= (size_t)861000000, "workspace budget (4 x output bytes = 861.5 MB)");
static_assert(WS_H + (size_t)M * DFF * 2 <= WS_PEND, "overlay fits");
static_assert(WS_WAA == WS_WAW + (size_t)M * D * 2 && WS_WAG == WS_WAA + (size_t)M * D * 2, "lora outputs contiguous");
static_assert(WS_XB % 256 == 0 && WS_P % 256 == 0 && WS_WLORA % 256 == 0 && WS_ACAT % 256 == 0, "alignment");
namespace pg8 {
#define PG8_LAS __attribute__((address_space(3)))
typedef unsigned short bf16_t;
typedef short bf16x8 __attribute__((ext_vector_type(8)));
typedef float f32x4 __attribute__((ext_vector_type(4)));
typedef unsigned u32x4 __attribute__((ext_vector_type(4)));
constexpr int BM = 256, BK = 64, HALF = 128, HTB = HALF * BK * 2  , STAGE_BYTES = 8 * HTB, NXCD = 8, WGM = 8;

__host__ __device__ __forceinline__ int lds_byte(int r, int c) { const int st = (r >> 4) * 2 + (c >> 5), rr = r & 15, cc = c & 31, ob = rr * 64 + cc * 2; return st * 1024 + (ob ^ (((ob >> 9) & 1) << 5)); }
__host__ __device__ __forceinline__ void stage_rc(int b, int& R, int& C) { const int st = b / 1024, sb = b % 1024, swz = sb ^ (((sb >> 9) & 1) << 5); R = (st >> 1) * 16 + swz / 64; C = (st & 1) * 32 + (swz % 64) / 2; }
__host__ __device__ __forceinline__ int perm32(int rho) { const int n = rho >> 4, i = rho & 15; return 8 * (i >> 2) + 4 * n + (i & 3); }

struct Unit { int pm, pn; };
struct Gemm { const bf16_t* A; const bf16_t* Bt; int M, N, K; int lda = 0, ldb = 0, nsplit = 0; size_t a_koff = 0; };

struct StaticOrder {
    int nM, nN, nwg, G, c;
    __host__ __device__ void init(int M, int N, int G_, int c_) { nM = M / BM; nN = N / BM; nwg = nM * nN; G = G_; c = c_; }
    __host__ __device__ bool next(int i, Unit& u) const {
        const long L = (long)i * G + c; if (L >= nwg) return false;
        int wgid = (int)L; { const int q = nwg / NXCD, r = nwg % NXCD, xcd = wgid % NXCD, off = wgid / NXCD; wgid = (xcd < r ? xcd * (q + 1) : r * (q + 1) + (xcd - r) * q) + off; }
        const int nig = WGM * nN, gid = wgid / nig, fm = gid * WGM, gsz = (nM - fm) < WGM ? (nM - fm) : WGM;
        u.pm = fm + ((wgid % nig) % gsz); u.pn = (wgid % nig) / gsz; return true;
    }
    __device__ __forceinline__ void a_ready(const Unit&) const {}
    __device__ __forceinline__ void done(const Unit&) const {}
};

__device__ __forceinline__ unsigned cvt_pk_bf16(float lo, float hi) { unsigned r; asm volatile("v_cvt_pk_bf16_f32 %0, %1, %2" : "=v"(r) : "v"(lo), "v"(hi)); return r; }
typedef float f32x2 __attribute__((ext_vector_type(2)));
template <class Epi, class Sched, bool ALIGN_EPI = false, bool SP2 = false>
__device__ __forceinline__ void gemm_phase(PG8_LAS unsigned char* lds, const Gemm g, const Sched& S, const Epi& E) {
    const int tid = threadIdx.x, wid = __builtin_amdgcn_readfirstlane(tid >> 6), lane = tid & 63, wr = wid >> 2, wc = wid & 3, fr = lane & 15, fq = lane >> 4;
    const int K = g.K, nt = K / BK, lda = g.lda ? g.lda : K, ldb = g.ldb ? g.ldb : K;
    unsigned voffA[2], voffB[2];
#pragma unroll
    for (int i = 0; i < 2; ++i) { int R, C; stage_rc(tid * 16 + i * 8192, R, C); const int Rb = Epi::PERM ? ((R & ~31) + perm32(R & 31)) : R;
        voffA[i] = (unsigned)(R * lda + C) * 2u; voffB[i] = (unsigned)(Rb * ldb + C) * 2u; }
    const size_t kstep = (size_t)(BK * 2);
    const size_t hstepA = (size_t)HALF * lda * 2, hstepB = (size_t)HALF * ldb * 2;
    const size_t tstepA = 2 * hstepA, tstepB = 2 * hstepB;
#define PG8_ABASE(u) ((const char*)g.A + (size_t)(u).pm * tstepA + (g.nsplit ? (size_t)((u).pn / g.nsplit) * g.a_koff : (size_t)0))
    const unsigned ldsw = (unsigned)wid * 1024u;
    const int aoff = lds_byte(wr * 64 + fr, fq * 8), boff = lds_byte(wc * 32 + fr, fq * 8);
#define PG8_SA(b, h) (((b) * 2 + (h)) * HTB)
#define PG8_SB(b, h) ((4 + (b) * 2 + (h)) * HTB)
#define PG8_STAGE(bufoff, gbase, voff) do { _Pragma("unroll") for (int _i = 0; _i < 2; ++_i) \
        __builtin_amdgcn_global_load_lds((const unsigned*)((const char*)(gbase) + (voff)[_i]), (PG8_LAS unsigned*)(lds + (bufoff) + ldsw + _i * 8192), 16, 0, 0); } while (0)
#define PG8_LDA(dst, b, h) do { _Pragma("unroll") for (int m = 0; m < 4; ++m) _Pragma("unroll") for (int k = 0; k < 2; ++k) dst[m][k] = *(const PG8_LAS bf16x8*)(lds + PG8_SA(b, h) + aoff + m * 2048 + k * 1024); } while (0)
#define PG8_LDB(dst, b, h) do { _Pragma("unroll") for (int n = 0; n < 2; ++n) _Pragma("unroll") for (int k = 0; k < 2; ++k) dst[n][k] = *(const PG8_LAS bf16x8*)(lds + PG8_SB(b, h) + boff + n * 2048 + k * 1024); } while (0)
#define PG8_MMA(ai, bj, At, Bt) do { __builtin_amdgcn_s_setprio(1); _Pragma("unroll") for (int m = 0; m < 4; ++m) _Pragma("unroll") for (int n = 0; n < 2; ++n) _Pragma("unroll") for (int k = 0; k < 2; ++k) \
        acc[ai][bj][m][n] = __builtin_amdgcn_mfma_f32_16x16x32_bf16(Bt[n][k], At[m][k], acc[ai][bj][m][n], 0, 0, 0); __builtin_amdgcn_s_setprio(0); } while (0)
#define PG8_WAIT_V(n) asm volatile("s_waitcnt vmcnt(" #n ")" ::: "memory")
#define PG8_WAIT_L(n) asm volatile("s_waitcnt lgkmcnt(" #n ")" ::: "memory")
#define PG8_BAR __builtin_amdgcn_s_barrier()
#define PG8_SCHED __builtin_amdgcn_sched_barrier(0)
    Unit cur, nxt; int ui = 0;
    if (!S.next(0, cur)) return;
    f32x4 acc[2][2][4][2];
#pragma unroll
    for (int a = 0; a < 2; ++a)
#pragma unroll
        for (int b = 0; b < 2; ++b)
#pragma unroll
            for (int m = 0; m < 4; ++m)
#pragma unroll
                for (int n = 0; n < 2; ++n) acc[a][b][m][n] = (f32x4){0.f, 0.f, 0.f, 0.f};
    bf16x8 At[4][2], B0[2][2], B1[2][2];
    const char* cA = PG8_ABASE(cur); const char* cB = (const char*)g.Bt + (size_t)cur.pn * tstepB;
    S.a_ready(cur);
    if constexpr (SP2) {
        PG8_STAGE(PG8_SB(0, 0), cB, voffB); PG8_STAGE(PG8_SB(0, 1), cB + hstepB, voffB); PG8_STAGE(PG8_SA(0, 0), cA, voffA); PG8_STAGE(PG8_SA(0, 1), cA + hstepA, voffA);
        if (wr == 1) PG8_BAR;
        PG8_WAIT_V(2); PG8_BAR;
        PG8_STAGE(PG8_SB(1, 0), cB + kstep, voffB); PG8_STAGE(PG8_SA(1, 0), cA + kstep, voffA); PG8_STAGE(PG8_SB(1, 1), cB + hstepB + kstep, voffB);
        PG8_WAIT_V(6); PG8_BAR;
    } else {
        PG8_STAGE(PG8_SB(0, 0), cB, voffB); PG8_STAGE(PG8_SA(0, 0), cA, voffA); PG8_STAGE(PG8_SB(0, 1), cB + hstepB, voffB); PG8_STAGE(PG8_SA(0, 1), cA + hstepA, voffA);
        if (wr == 1) PG8_BAR;
        PG8_WAIT_V(4); PG8_BAR;
        PG8_STAGE(PG8_SB(1, 0), cB + kstep, voffB); PG8_STAGE(PG8_SA(1, 0), cA + kstep, voffA); PG8_STAGE(PG8_SB(1, 1), cB + hstepB + kstep, voffB);
        PG8_WAIT_V(6); PG8_BAR;
    }
    for (;;) {
        const bool has_next = S.next(ui + 1, nxt);
        const char* nA = has_next ? PG8_ABASE(nxt) : cA; const char* nB = has_next ? (const char*)g.Bt + (size_t)nxt.pn * tstepB : cB;
#pragma nounroll
        for (int t = 0; t < nt; t += 2) {
            const bool last = (t == nt - 2);
            const char* a1 = cA + (size_t)(t + 1) * kstep;
            const char* a2 = last ? nA : cA + (size_t)(t + 2) * kstep; const char* b2 = last ? nB : cB + (size_t)(t + 2) * kstep;
            const char* a3 = a2 + kstep; const char* b3 = b2 + kstep;
            if (last && has_next) S.a_ready(nxt);
            if constexpr (SP2) {
            PG8_LDB(B0, 0, 0); PG8_LDB(B1, 0, 1); PG8_SCHED; PG8_LDA(At, 0, 0); PG8_STAGE(PG8_SA(1, 1), a1 + hstepA, voffA);
            PG8_WAIT_V(8); PG8_WAIT_L(0); PG8_BAR; PG8_MMA(0, 0, At, B0); PG8_MMA(0, 1, At, B1); PG8_BAR; PG8_SCHED;
            PG8_LDA(At, 0, 1); PG8_STAGE(PG8_SB(0, 0), b2, voffB); PG8_STAGE(PG8_SB(0, 1), b2 + hstepB, voffB); PG8_STAGE(PG8_SA(0, 0), a2, voffA);
            PG8_WAIT_V(8); PG8_WAIT_L(0); PG8_BAR; PG8_MMA(1, 0, At, B0); PG8_MMA(1, 1, At, B1); PG8_BAR; PG8_SCHED;
            PG8_LDB(B0, 1, 0); PG8_LDB(B1, 1, 1); PG8_SCHED; PG8_LDA(At, 1, 0); PG8_STAGE(PG8_SA(0, 1), a2 + hstepA, voffA);
            PG8_WAIT_V(8); PG8_WAIT_L(0); PG8_BAR; PG8_MMA(0, 0, At, B0); PG8_MMA(0, 1, At, B1); PG8_BAR; PG8_SCHED;
            PG8_LDA(At, 1, 1); PG8_STAGE(PG8_SB(1, 0), b3, voffB); PG8_STAGE(PG8_SB(1, 1), b3 + hstepB, voffB); PG8_STAGE(PG8_SA(1, 0), a3, voffA);
            PG8_WAIT_V(8); PG8_WAIT_L(0); PG8_BAR; PG8_MMA(1, 0, At, B0); PG8_MMA(1, 1, At, B1); PG8_BAR; PG8_SCHED;
            } else {
            PG8_LDB(B0, 0, 0); PG8_SCHED; PG8_LDA(At, 0, 0); PG8_STAGE(PG8_SA(1, 1), a1 + hstepA, voffA);
            PG8_WAIT_L(8); PG8_BAR; PG8_WAIT_L(0); PG8_MMA(0, 0, At, B0); PG8_BAR; PG8_SCHED;
            PG8_LDB(B1, 0, 1); PG8_STAGE(PG8_SB(0, 0), b2, voffB);
            PG8_BAR; PG8_WAIT_L(0); PG8_MMA(0, 1, At, B1); PG8_BAR;
            PG8_LDA(At, 0, 1); PG8_STAGE(PG8_SA(0, 0), a2, voffA);
            PG8_BAR; PG8_WAIT_L(0); PG8_MMA(1, 0, At, B0); PG8_BAR; PG8_SCHED;
            PG8_STAGE(PG8_SB(0, 1), b2 + hstepB, voffB);
            PG8_WAIT_V(6); PG8_BAR; PG8_MMA(1, 1, At, B1); PG8_BAR;
            PG8_LDB(B0, 1, 0); PG8_SCHED; PG8_LDA(At, 1, 0); PG8_STAGE(PG8_SA(0, 1), a2 + hstepA, voffA);
            PG8_WAIT_L(8); PG8_BAR; PG8_WAIT_L(0); PG8_MMA(0, 0, At, B0); PG8_BAR; PG8_SCHED;
            PG8_LDB(B1, 1, 1); PG8_STAGE(PG8_SB(1, 0), b3, voffB);
            PG8_BAR; PG8_WAIT_L(0); PG8_MMA(0, 1, At, B1); PG8_BAR;
            PG8_LDA(At, 1, 1); PG8_STAGE(PG8_SA(1, 0), a3, voffA);
            PG8_BAR; PG8_WAIT_L(0); PG8_MMA(1, 0, At, B0); PG8_BAR; PG8_SCHED;
            PG8_STAGE(PG8_SB(1, 1), b3 + hstepB, voffB);
            PG8_WAIT_V(6); PG8_BAR; PG8_MMA(1, 1, At, B1); PG8_BAR;
            }
        }
        if constexpr (ALIGN_EPI) { if (wr == 0) PG8_BAR; }
        if constexpr (!Epi::AFTER_DRAIN) { E(acc, cur, wr, wc, fr, fq); S.done(cur); }
        if (!has_next) break;
#pragma unroll
        for (int a = 0; a < 2; ++a)
#pragma unroll
            for (int b = 0; b < 2; ++b)
#pragma unroll
                for (int m = 0; m < 4; ++m)
#pragma unroll
                    for (int n = 0; n < 2; ++n) acc[a][b][m][n] = (f32x4){0.f, 0.f, 0.f, 0.f};
        cur = nxt; cA = nA; cB = nB; ++ui;
        if constexpr (ALIGN_EPI) { if (wr == 1) PG8_BAR; }
    }
    PG8_WAIT_V(0);
    if constexpr (!ALIGN_EPI) { if (wr == 0) PG8_BAR; }
    PG8_BAR;
    if constexpr (Epi::AFTER_DRAIN) { E.fused(acc, cur, wr, wc, fr, fq, lds, wid, lane); S.done(cur); }
#undef PG8_ABASE
#undef PG8_SA
#undef PG8_SB
#undef PG8_STAGE
#undef PG8_LDA
#undef PG8_LDB
#undef PG8_MMA
#undef PG8_WAIT_V
#undef PG8_WAIT_L
#undef PG8_BAR
#undef PG8_SCHED
}
}

#include <hip/hip_cooperative_groups.h>
namespace cg = cooperative_groups;
#define LAS __attribute__((address_space(3)))
typedef float f32x4 __attribute__((ext_vector_type(4)));
typedef unsigned u32x4 __attribute__((ext_vector_type(4)));
typedef unsigned u32x2 __attribute__((ext_vector_type(2)));

constexpr int NTHREADS = 512, NWAVES = 8;
constexpr int LDS_PHASE_BYTES = 147456;
constexpr int BAR_LDS_OFF = LDS_PHASE_BYTES;
constexpr int LDS_BYTES = LDS_PHASE_BYTES + 256;
constexpr size_t WS_BAR = WS_CTL + 524288;

constexpr int PH_PREP = 0, PH_PER_LAYER = 11, PH_L0 = 1;
constexpr int PHO_IN = 0, PHO_MIXA = 1, PHO_LORA = 2, PHO_C1 = 3, PHO_MIXB = 4, PHO_MIXC = 5, PHO_OUT = 6, PHO_LN1 = 7, PHO_GU = 8, PHO_DOWN = 9, PHO_LN2 = 10;
constexpr int N_PHASES = PH_L0 + DEPTH * PH_PER_LAYER;

struct Args { const float* in[35]; float* out; unsigned char* ws; int ph_lo, ph_hi; };

#define XB_TMO      128
#define XB_XCNT(j)  (256  + 64 * (j))
#define XB_XSUB(j)  (1280 + 64 * (j))
#define XB_XGEN(j)  (2304 + 64 * (j))
#define XB_TOP      3328
#define XB_TOPGEN   3392
#define XCD_BAR_WORDS 3456
#define XB_SPIN_CAP (1u << 18)

__device__ __forceinline__ unsigned xb_ld(unsigned* p)              { return __hip_atomic_load(p, __ATOMIC_RELAXED, __HIP_MEMORY_SCOPE_AGENT); }
__device__ __forceinline__ unsigned xb_add(unsigned* p, unsigned v) { return __hip_atomic_fetch_add(p, v, __ATOMIC_RELAXED, __HIP_MEMORY_SCOPE_AGENT); }
__device__ __forceinline__ unsigned xb_xcc_id() { return (unsigned)__builtin_amdgcn_s_getreg((3 << 11) | 20) & 0xFu; }
#define XB_SPIN(cond, bar) do { unsigned _sp = 0; while (cond) { __builtin_amdgcn_s_sleep(1); \
    if ((++_sp & 255u) == 0u) { if (xb_ld(&(bar)[XB_TMO])) break; if (_sp > XB_SPIN_CAP) { atomicAdd(&(bar)[XB_TMO], 1u); break; } } } } while (0)

struct XcdBarrier {
    unsigned* bar; unsigned x;
    volatile LAS unsigned* st;
};

__device__ __forceinline__ XcdBarrier xcd_barrier_post(unsigned* bar, volatile LAS unsigned* st) {
    XcdBarrier b; b.bar = bar; b.x = xb_xcc_id(); b.st = st;
    if (threadIdx.x == 0) (void)xb_add(&bar[XB_XCNT(b.x)], 1u);
    return b;
}
__device__ __forceinline__ void xcd_barrier_complete(unsigned* bar, unsigned x, unsigned& nloc, unsigned& nx) {
    const unsigned G = gridDim.x * gridDim.y * gridDim.z;
    unsigned sum, cnt, mine, sp = 0u;
    for (;;) {
        sum = 0u; cnt = 0u; mine = 0u;
#pragma unroll
        for (unsigned j = 0; j < 16; ++j) { const unsigned c = xb_ld(&bar[XB_XCNT(j)]); sum += c; cnt += (c > 0u) ? 1u : 0u; mine = (j == x) ? c : mine; }
        if (sum == G) break;
        __builtin_amdgcn_s_sleep(1);
        if ((++sp & 255u) == 0u) { if (xb_ld(&bar[XB_TMO])) break; if (sp > XB_SPIN_CAP) { atomicAdd(&bar[XB_TMO], 1u); break; } }
    }
    nloc = mine > 0u ? mine : 1u; nx = cnt > 0u ? cnt : 1u;
}

__device__ __forceinline__ void xcd_barrier(const XcdBarrier& b) {
    asm volatile("s_waitcnt vmcnt(0)" ::: "memory");
    __syncthreads();
    if (threadIdx.x == 0) {
        unsigned* bar = b.bar;
        __builtin_amdgcn_s_waitcnt(0);
        unsigned nloc = b.st[0], nx = b.st[1];
        if (nloc == 0u) { xcd_barrier_complete(bar, b.x, nloc, nx); b.st[0] = nloc; b.st[1] = nx; }
        const unsigned old = xb_add(&bar[XB_XSUB(b.x)], 1u);
        const unsigned gen = old / nloc;
        if (old + 1u == (gen + 1u) * nloc) {
            __builtin_amdgcn_fence(__ATOMIC_RELEASE, "agent");
            asm volatile("s_waitcnt vmcnt(0)" ::: "memory");
            const unsigned og = xb_add(&bar[XB_TOP], 1u);
            const unsigned tg = og / nx;
            if (og + 1u == (tg + 1u) * nx) xb_add(&bar[XB_TOPGEN], 1u);
            else XB_SPIN(xb_ld(&bar[XB_TOPGEN]) == tg, bar);
            __builtin_amdgcn_fence(__ATOMIC_ACQUIRE, "agent");
            xb_add(&bar[XB_XGEN(b.x)], 1u);
            asm volatile("s_waitcnt vmcnt(0)" ::: "memory");
        } else {
            XB_SPIN(xb_ld(&bar[XB_XGEN(b.x)]) == gen, bar);
            __builtin_amdgcn_fence(__ATOMIC_ACQUIRE, "agent");
            asm volatile("s_waitcnt vmcnt(0)" ::: "memory");
        }
    }
    __syncthreads();
}


typedef float f32x2_t __attribute__((ext_vector_type(2))); typedef __bf16 bf16x2_t __attribute__((ext_vector_type(2)));
__device__ __forceinline__ unsigned pk2bf(float lo, float hi) { f32x2_t v = {lo, hi}; bf16x2_t b = __builtin_convertvector(v, bf16x2_t); return __builtin_bit_cast(unsigned, b); }

struct EpiIn {
    static constexpr bool PERM = true, AFTER_DRAIN = false;
    bf16_t* O; int ldc; int sig_pn;
    __device__ __forceinline__ void operator()(const f32x4 (&acc)[2][2][4][2], const pg8::Unit& u, int wr, int wc, int fr, int fq) const {
        const int row0 = u.pm * 256 + wr * 64 + fr, col0 = u.pn * 256 + wc * 32 + 8 * fq;
        const bool sg = u.pn >= sig_pn;
#pragma unroll
        for (int ai = 0; ai < 2; ++ai)
#pragma unroll
            for (int m = 0; m < 4; ++m) {
                bf16_t* rowp = O + (size_t)(row0 + ai * 128 + m * 16) * ldc + col0;
#pragma unroll
                for (int bj = 0; bj < 2; ++bj) {
                    f32x4 v0 = acc[ai][bj][m][0], v1 = acc[ai][bj][m][1];
                    if (sg) {
#pragma unroll
                        for (int i = 0; i < 4; ++i) { v0[i] = sigmoidf_(v0[i]); v1[i] = sigmoidf_(v1[i]); }
                    }
                    u32x4 w; w.x = pk2bf(v0[0], v0[1]); w.y = pk2bf(v0[2], v0[3]); w.z = pk2bf(v1[0], v1[1]); w.w = pk2bf(v1[2], v1[3]);
                    *(u32x4*)(rowp + bj * 128) = w;
                }
                asm volatile("" ::: "memory");
            }
    }
};
template <bool RESB> struct EpiZ {
    static constexpr bool PERM = false, AFTER_DRAIN = false;
    const void* res; float* Z; int ldc;
    __device__ __forceinline__ void operator()(const f32x4 (&acc)[2][2][4][2], const pg8::Unit& u, int wr, int wc, int fr, int fq) const {
        const int col0 = u.pn * 256 + wc * 32 + 4 * fq;
#pragma unroll
        for (int ai = 0; ai < 2; ++ai)
#pragma unroll
            for (int m = 0; m < 4; ++m) {
                const size_t off = (size_t)(u.pm * 256 + ai * 128 + wr * 64 + m * 16 + fr) * ldc + col0;
#pragma unroll
                for (int bj = 0; bj < 2; ++bj)
#pragma unroll
                    for (int n = 0; n < 2; ++n) {
                        f32x4 r;
                        if (RESB) { const u32x2 w = *(const u32x2*)((const bf16_t*)res + off + bj * 128 + n * 16);
                            r = (f32x4){__uint_as_float(w.x << 16), __uint_as_float(w.x & 0xffff0000u), __uint_as_float(w.y << 16), __uint_as_float(w.y & 0xffff0000u)}; }
                        else r = *(const f32x4*)((const float*)res + off + bj * 128 + n * 16);
                        *(f32x4*)(Z + off + bj * 128 + n * 16) = r * ALPHA + acc[ai][bj][m][n];
                    }
                asm volatile("" ::: "memory");
            }
    }
};
template <bool RESB> struct EpiZS {
    static constexpr bool PERM = false, AFTER_DRAIN = false;
    const void* res; float* ZS; int ldc;
    __device__ __forceinline__ void operator()(const f32x4 (&acc)[2][2][4][2], const pg8::Unit& u, int wr, int wc, int fr, int fq) const {
        const int ks = u.pn >> 2, col0 = (u.pn & 3) * 256 + wc * 32 + 4 * fq;
        float* Z = ZS + (size_t)ks * MS * D;
#pragma unroll
        for (int ai = 0; ai < 2; ++ai)
#pragma unroll
            for (int m = 0; m < 4; ++m) {
                const size_t off = (size_t)(u.pm * 256 + ai * 128 + wr * 64 + m * 16 + fr) * ldc + col0;
#pragma unroll
                for (int bj = 0; bj < 2; ++bj)
#pragma unroll
                    for (int n = 0; n < 2; ++n) {
                        f32x4 o = acc[ai][bj][m][n];
                        if (ks == 0) {
                            f32x4 r;
                            if (RESB) { const u32x2 w = *(const u32x2*)((const bf16_t*)res + off + bj * 128 + n * 16);
                                r = (f32x4){__uint_as_float(w.x << 16), __uint_as_float(w.x & 0xffff0000u), __uint_as_float(w.y << 16), __uint_as_float(w.y & 0xffff0000u)}; }
                            else r = *(const f32x4*)((const float*)res + off + bj * 128 + n * 16);
                            o = r * ALPHA + o;
                        }
                        *(f32x4*)(Z + off + bj * 128 + n * 16) = o;
                    }
                asm volatile("" ::: "memory");
            }
    }
};
struct EpiSwiGLU {
    static constexpr bool PERM = true, AFTER_DRAIN = false;
    bf16_t* H; int ldc;
    __device__ __forceinline__ void operator()(const f32x4 (&acc)[2][2][4][2], const pg8::Unit& u, int wr, int wc, int fr, int fq) const {
        const int row0 = u.pm * 256 + wr * 64 + fr, col0 = u.pn * 128 + wc * 32 + 8 * fq;
#pragma unroll
        for (int ai = 0; ai < 2; ++ai)
#pragma unroll
            for (int m = 0; m < 4; ++m) {
                bf16_t* rowp = H + (size_t)(row0 + ai * 128 + m * 16) * ldc + col0;
                float o[8];
#pragma unroll
                for (int n = 0; n < 2; ++n)
#pragma unroll
                    for (int i = 0; i < 4; ++i) { const float g = acc[ai][0][m][n][i], up = acc[ai][1][m][n][i]; o[n * 4 + i] = g * sigmoidf_(g) * up; }
                u32x4 w; w.x = pk2bf(o[0], o[1]); w.y = pk2bf(o[2], o[3]); w.z = pk2bf(o[4], o[5]); w.w = pk2bf(o[6], o[7]);
                *(u32x4*)rowp = w;
                asm volatile("" ::: "memory");
            }
    }
};

template <int MODE> __device__ __forceinline__ int colmap(int n) {
    if (MODE == 0) return n < 5920 ? n : (n < 6144 ? -1 : n - 224);
    if (MODE == 2) { const int pn = n >> 8, q = n & 255; return q < 128 ? pn * 128 + q : DFF + pn * 128 + (q - 128); }
    return n;
}
template <int MODE> __device__ __forceinline__ void transpose_item(const float* __restrict__ W, int K, int ldw, bf16_t* WT, int item, int nblk, LAS float* tile, int tid, bf16_t* WS2 = nullptr, int kpart = 0, int nrows = 0) {
    const int kb = item / nblk, nb = item % nblk, k0 = kb * 64, n0 = nb * 64;
    {
        const int n4 = tid & 15; const int col = colmap<MODE>(n0 + 4 * n4);
#pragma unroll
        for (int i = 0; i < 2; ++i) {
            const int kk = i * 32 + (tid >> 4);
            const f32x4 v = col >= 0 ? *(const f32x4*)(W + (size_t)(k0 + kk) * ldw + col) : (f32x4){0.f, 0.f, 0.f, 0.f};
            LAS float* t = tile + kk * 65 + 4 * n4; t[0] = v[0]; t[1] = v[1]; t[2] = v[2]; t[3] = v[3];
        }
    }
    __syncthreads();
    {
        const int nn = tid >> 3, c = tid & 7; const LAS float* s = tile + (8 * c) * 65 + nn;
        u32x4 o; o.x = pk2bf(s[0], s[65]); o.y = pk2bf(s[2 * 65], s[3 * 65]); o.z = pk2bf(s[4 * 65], s[5 * 65]); o.w = pk2bf(s[6 * 65], s[7 * 65]);
        *(u32x4*)(WT + (size_t)(n0 + nn) * K + k0 + 8 * c) = o;
        if (WS2) { const int ks = k0 / kpart; *(u32x4*)(WS2 + ((size_t)ks * nrows + n0 + nn) * kpart + (k0 - ks * kpart) + 8 * c) = o; }
    }
    __syncthreads();
}
__device__ __forceinline__ void prep_rg_weights(const Args& a, int l);
__device__ __forceinline__ void phase_prep_weights(const Args& a, int l, LAS unsigned char* lds) {
    const int tid = threadIdx.x, G = gridDim.x, bx = blockIdx.x;
    LAS float* tile = (LAS float*)lds;
    constexpr int I_IN = (D / 64) * (NP / 64), I_OUT = (D / 64) * (D / 64), I_GU = (D / 64) * (2 * DFF / 64), I_DN = (DFF / 64) * (D / 64);
    constexpr int I_LAYER = I_IN + I_OUT + I_GU + I_DN;
    for (int it = bx; it < I_LAYER; it += G) {
        int r = it;
        if (r < I_IN) { transpose_item<0>(a.in[8] + (size_t)l * D * IN_COLS, D, IN_COLS, (bf16_t*)(a.ws + WS_WIN), r, NP / 64, tile, tid); continue; } r -= I_IN;
        if (r < I_OUT) { transpose_item<1>(a.in[28] + (size_t)l * D * D, D, D, (bf16_t*)(a.ws + WS_WOUT), r, D / 64, tile, tid, (bf16_t*)(a.ws + WS_WOUTS), 256, D); continue; } r -= I_OUT;
        if (r < I_GU) { transpose_item<2>(a.in[31] + (size_t)l * D * 2 * DFF, D, 2 * DFF, (bf16_t*)(a.ws + WS_WGU), r, 2 * DFF / 64, tile, tid); continue; } r -= I_GU;
        transpose_item<1>(a.in[32] + (size_t)l * DFF * D, DFF, D, (bf16_t*)(a.ws + WS_WDN), r, D / 64, tile, tid, (bf16_t*)(a.ws + WS_WDNS), 256, D);
    }
    const size_t gt = (size_t)bx * NTHREADS + tid, gs = (size_t)G * NTHREADS;
    for (size_t i = gt; i < (size_t)3072 * ACAT_K; i += gs) {
        const int n = (int)(i / ACAT_K), k = (int)(i % ACAT_K), kind = n >> 10, c = n & 1023;
        float v = 0.f;
        if (kind == 0 && k < 64) v = a.in[19][((size_t)l * 64 + k) * D + c];
        else if (kind == 1 && k >= 64 && k < 128) v = a.in[21][((size_t)l * 64 + (k - 64)) * D + c];
        else if (kind == 2 && k >= 128 && k < 288) v = a.in[22][((size_t)l * 160 + (k - 128)) * D + c];
        ((bf16_t*)(a.ws + WS_WLORA))[i] = f2bf(v);
    }
    prep_rg_weights(a, l);
}
__device__ __forceinline__ void phase_prep_x(const Args& a) {
    bf16_t* XB = (bf16_t*)(a.ws + WS_XB);
    const size_t n4 = (size_t)M * D / 4, np4 = (size_t)MP * D / 4;
    for (size_t i = (size_t)blockIdx.x * NTHREADS + threadIdx.x; i < n4; i += (size_t)gridDim.x * NTHREADS) {
        const f32x4 v = i < np4 ? ((const f32x4*)a.in[0])[i] : ((const f32x4*)a.in[1])[i - np4];
        u32x2 w; w.x = pk2bf(v[0], v[1]); w.y = pk2bf(v[2], v[3]);
        ((u32x2*)XB)[i] = w;
    }
}

__device__ __forceinline__ float wave_sum_fast(float x) {
    x += __builtin_bit_cast(float, __builtin_amdgcn_update_dpp(0, __builtin_bit_cast(int, x), 0xB1, 0xF, 0xF, true));
    x += __builtin_bit_cast(float, __builtin_amdgcn_update_dpp(0, __builtin_bit_cast(int, x), 0x4E, 0xF, 0xF, true));
    x += __builtin_bit_cast(float, __builtin_amdgcn_update_dpp(0, __builtin_bit_cast(int, x), 0x124, 0xF, 0xF, true));
    x += __builtin_bit_cast(float, __builtin_amdgcn_update_dpp(0, __builtin_bit_cast(int, x), 0x128, 0xF, 0xF, true));
    x += __shfl_xor(x, 16); x += __shfl_xor(x, 32);
    return x;
}
template <int NS> __device__ __forceinline__ void phase_ln(const float* __restrict__ Z, const float* __restrict__ ZS, const float* __restrict__ g, const float* __restrict__ b, float* OF, bf16_t* OB) {
    const int lane = threadIdx.x & 63, wv = threadIdx.x >> 6;
    f32x4 gv[4], bv[4];
#pragma unroll
    for (int j = 0; j < 4; ++j) { gv[j] = ((const f32x4*)g)[j * 64 + lane]; bv[j] = ((const f32x4*)b)[j * 64 + lane]; }
    const int stride = gridDim.x * NWAVES;
    int m = blockIdx.x * NWAVES + wv;
    f32x4 nx[4];
    auto load_row = [&](int mm) {
        if (mm < MP) {
#pragma unroll
            for (int j = 0; j < 4; ++j) nx[j] = ((const f32x4*)(Z + (size_t)mm * D))[j * 64 + lane];
        } else {
#pragma unroll
            for (int j = 0; j < 4; ++j) nx[j] = ((const f32x4*)(ZS + (size_t)(mm - MP) * D))[j * 64 + lane];
#pragma unroll
            for (int ks = 1; ks < NS; ++ks)
#pragma unroll
                for (int j = 0; j < 4; ++j) nx[j] = nx[j] + ((const f32x4*)(ZS + ((size_t)ks * MS + (mm - MP)) * D))[j * 64 + lane];
        }
    };
    if (m < M) load_row(m);
    for (; m < M; m += stride) {
        f32x4 v[4]; float s = 0.f;
#pragma unroll
        for (int j = 0; j < 4; ++j) { v[j] = nx[j]; s += (v[j][0] + v[j][1]) + (v[j][2] + v[j][3]); }
        if (m + stride < M) load_row(m + stride);
        const float mean = wave_sum_fast(s) * (1.f / D);
        float q = 0.f;
#pragma unroll
        for (int j = 0; j < 4; ++j) { v[j] = v[j] - mean; q += (v[j][0] * v[j][0] + v[j][1] * v[j][1]) + (v[j][2] * v[j][2] + v[j][3] * v[j][3]); }
        const float rstd = rsqrtf(wave_sum_fast(q) * (1.f / D) + LN_EPS);
#pragma unroll
        for (int j = 0; j < 4; ++j) {
            const f32x4 y = v[j] * rstd * gv[j] + bv[j];
            if (OF) ((f32x4*)(OF + (size_t)m * D))[j * 64 + lane] = y;
            if (OB) { u32x2 w; w.x = pk2bf(y[0], y[1]); w.y = pk2bf(y[2], y[3]); ((u32x2*)(OB + (size_t)m * D))[j * 64 + lane] = w; }
        }
    }
}


typedef short bf16x8_t __attribute__((ext_vector_type(8)));
typedef short bf16x4_t __attribute__((ext_vector_type(4)));
typedef short v4i16_t __attribute__((ext_vector_type(4)));
#define LDSW() asm volatile("s_waitcnt lgkmcnt(0)" ::: "memory")
__device__ __forceinline__ u32x2 tr_read4(LAS unsigned char* p) { return __builtin_bit_cast(u32x2, __builtin_amdgcn_ds_read_tr16_b64_v4i16((LAS v4i16_t*)p)); }
__device__ __forceinline__ bf16x8_t mk_frag(u32x2 lo, u32x2 hi) { const u32x4 w = (u32x4){lo.x, lo.y, hi.x, hi.y}; return __builtin_bit_cast(bf16x8_t, w); }
__device__ __forceinline__ u32x2 pk4(float a, float b, float c, float d) { u32x2 w; w.x = pk2bf(a, b); w.y = pk2bf(c, d); return w; }

constexpr size_t WS_WRG = WS_CTL + 4096;
constexpr int RG_TP = 144;
__device__ __forceinline__ void prep_rg_weights(const Args& a, int l) {
    const size_t gt = (size_t)blockIdx.x * NTHREADS + threadIdx.x, gs = (size_t)gridDim.x * NTHREADS;
    bf16_t* W = (bf16_t*)(a.ws + WS_WRG);
    for (size_t i = gt; i < (size_t)2 * 16 * 4096; i += gs) {
        const int gate = (int)(i >> 16), bk = (int)(i >> 12) & 15, j = (int)(i >> 6) & 63, ii = (int)i & 63;
        W[i] = f2bf(a.in[gate ? 14 : 12][(size_t)l * 16 * 4096 + ((size_t)bk * 64 + ii) * 64 + j]);
    }
}
__device__ __forceinline__ float one_minus_exp(float x) {
    const float s = -x * (1.f + x * (0.5f + x * (0.16666667f + x * (0.041666668f + x * 0.0083333333f))));
    return x > -0.25f ? s : 1.f - __expf(x);
}
template <bool PASS2>
__device__ __forceinline__ void rglru_unit2(const Args& a, int L, int unit, LAS unsigned char* lds) {
    int lane = threadIdx.x & 63; const int wv = __builtin_amdgcn_readfirstlane(threadIdx.x >> 6);
    asm volatile("" : "+v"(lane));
    const int i16 = lane & 15, qp = lane >> 4;
    const bf16_t* P = (const bf16_t*)(a.ws + WS_P); bf16_t* OB = (bf16_t*)(a.ws + WS_OB); float* RS = (float*)(a.ws + WS_RS);
    const bf16_t* WRG = (const bf16_t*)(a.ws + WS_WRG);
    const float* cw = a.in[10] + (size_t)L * 4 * D; const float* cb = a.in[11] + L * D; const float* ba = a.in[13] + L * D;
    const float* bx = a.in[15] + L * D; const float* lam = a.in[16] + L * D;
    const float* conv0 = a.in[4] + (size_t)L * DBATCH * 3 * D; const float* h0 = a.in[5] + (size_t)L * DBATCH * D;
    LAS unsigned char* tile = lds + wv * (64 * RG_TP);
    LAS unsigned char* obt = lds + (NWAVES + wv) * (64 * RG_TP);
    const int m0 = unit * 64;
    const bool sample = m0 >= MP;
    const int bseq = sample ? 0 : m0 / SEQ, chunk = sample ? 0 : (m0 % SEQ) / 64;
    for (int bb = 0; bb < 2; ++bb) {
        const int bk = 2 * wv + bb, c0 = 64 * bk;
        bf16x8_t af[4][2];
#pragma unroll
        for (int ks = 0; ks < 2; ++ks) {
            const int cc = c0 + 32 * ks + 8 * qp;
            f32x4 w0[2], w1[2], w2[2], w3[2], wb[2];
#pragma unroll
            for (int hh = 0; hh < 2; ++hh) { w0[hh] = *(const f32x4*)(cw + 0 * D + cc + 4 * hh); w1[hh] = *(const f32x4*)(cw + 1 * D + cc + 4 * hh); w2[hh] = *(const f32x4*)(cw + 2 * D + cc + 4 * hh);
                w3[hh] = *(const f32x4*)(cw + 3 * D + cc + 4 * hh); wb[hh] = *(const f32x4*)(cb + cc + 4 * hh); }
#pragma unroll
            for (int mt = 0; mt < 4; ++mt) {
                const int tok = 16 * mt + i16; const size_t m = (size_t)m0 + tok;
                const int tseq = sample ? (tok & 7) : (chunk * 64 + tok);
                float xv[4][8];
#pragma unroll
                for (int k = 0; k < 4; ++k) {
                    const int back = 3 - k;
                    const bool ok = tseq - back >= 0;
                    const u32x4 v = *(const u32x4*)(P + (m - (ok ? back : 0)) * NP + CRNN + cc);
                    const unsigned w4[4] = {v.x, v.y, v.z, v.w};
#pragma unroll
                    for (int e = 0; e < 8; ++e) xv[k][e] = ok ? __uint_as_float((e & 1) ? (w4[e >> 1] & 0xffff0000u) : (w4[e >> 1] << 16)) : 0.f;
                    if (sample && back > 0) {
                        const int b = (int)(m - MP) >> 3; const int ci = ok ? 0 : 3 + tseq - back;
                        const float* cp = conv0 + ((size_t)b * 3 + ci) * D + cc;
                        const f32x4 v0 = *(const f32x4*)cp, v1 = *(const f32x4*)(cp + 4);
#pragma unroll
                        for (int e = 0; e < 4; ++e) { xv[k][e] = ok ? xv[k][e] : v0[e]; xv[k][4 + e] = ok ? xv[k][4 + e] : v1[e]; }
                    }
                }
                float xc[8];
#pragma unroll
                for (int e = 0; e < 8; ++e) xc[e] = wb[e >> 2][e & 3] + w0[e >> 2][e & 3] * xv[0][e] + w1[e >> 2][e & 3] * xv[1][e] + w2[e >> 2][e & 3] * xv[2][e] + w3[e >> 2][e & 3] * xv[3][e];
                const u32x4 pk = (u32x4){pk2bf(xc[0], xc[1]), pk2bf(xc[2], xc[3]), pk2bf(xc[4], xc[5]), pk2bf(xc[6], xc[7])};
                af[mt][ks] = __builtin_bit_cast(bf16x8_t, pk);
                *(LAS u32x4*)(tile + tok * RG_TP + (32 * ks + 8 * qp) * 2) = pk;
            }
        }
        LDSW();
#pragma unroll 1
        for (int nt = 0; nt < 4; ++nt) {
            const int j = 16 * nt + i16, c = c0 + j;
            bf16x8_t ba_[2], bx_[2];
#pragma unroll
            for (int ks = 0; ks < 2; ++ks) { ba_[ks] = *(const bf16x8_t*)(WRG + ((size_t)(0 * 16 + bk) * 64 + j) * 64 + 32 * ks + 8 * qp); bx_[ks] = *(const bf16x8_t*)(WRG + ((size_t)(1 * 16 + bk) * 64 + j) * 64 + 32 * ks + 8 * qp); }
            const float bac = ba[c], bxc = bx[c], spl = softplusf_(-lam[c]);
            float av[4][4], uv[4][4];
#pragma unroll
            for (int mt = 0; mt < 4; ++mt) {
                f32x4 ar = (f32x4){0.f, 0.f, 0.f, 0.f}, ai = ar;
#pragma unroll
                for (int ks = 0; ks < 2; ++ks) { ar = __builtin_amdgcn_mfma_f32_16x16x32_bf16(af[mt][ks], ba_[ks], ar, 0, 0, 0); ai = __builtin_amdgcn_mfma_f32_16x16x32_bf16(af[mt][ks], bx_[ks], ai, 0, 0, 0); }
                const u32x2 xcp = tr_read4(tile + (16 * mt + 4 * qp + (i16 >> 2)) * RG_TP + (16 * nt + 4 * (i16 & 3)) * 2);
#pragma unroll
                for (int r = 0; r < 4; ++r) {
                    const unsigned xw = r < 2 ? xcp.x : xcp.y;
                    const float xcv = __uint_as_float((r & 1) ? (xw & 0xffff0000u) : (xw << 16));
                    const float rg = sigmoidf_(ar[r] + bac), ig = sigmoidf_(ai[r] + bxc);
                    const float log_a = -8.f * rg * spl;
                    av[mt][r] = __expf(log_a);
                    uv[mt][r] = __builtin_amdgcn_sqrtf(one_minus_exp(2.f * log_a)) * (ig * xcv);
                }
            }
            float H = 0.f, Atot = 1.f;
            if (PASS2 && !sample && chunk > 0) H = RS[(((size_t)bseq * 128 + chunk) * D + c) * 2 + 1];
#pragma unroll
            for (int mt = 0; mt < 4; ++mt) {
                const float As = av[mt][0] * av[mt][1] * av[mt][2] * av[mt][3];
                const float Bs = ((uv[mt][0] * av[mt][1] + uv[mt][1]) * av[mt][2] + uv[mt][2]) * av[mt][3] + uv[mt][3];
                float Aq[4], Bq[4];
#pragma unroll
                for (int q = 0; q < 4; ++q) { Aq[q] = __shfl(As, i16 + 16 * q); Bq[q] = __shfl(Bs, i16 + 16 * q); }
                float hs;
                if (!sample) {
                    const float h1 = Aq[0] * H + Bq[0], h2 = Aq[1] * h1 + Bq[1], h3 = Aq[2] * h2 + Bq[2];
                    hs = qp == 0 ? H : (qp == 1 ? h1 : (qp == 2 ? h2 : h3));
                    H = Aq[3] * h3 + Bq[3]; Atot *= Aq[0] * Aq[1] * Aq[2] * Aq[3];
                } else {
                    const int b0 = ((m0 - MP) >> 3) + 2 * mt;
                    const float hA = h0[(size_t)b0 * D + c], hB = h0[(size_t)(b0 + 1) * D + c];
                    const float hA1 = Aq[0] * hA + Bq[0], hB1 = Aq[2] * hB + Bq[2];
                    hs = qp == 0 ? hA : (qp == 1 ? hA1 : (qp == 2 ? hB : hB1));
                    if (PASS2 && qp == 0) {
                        a.out[O_SH + ((size_t)L * DBATCH + b0) * D + c] = Aq[1] * hA1 + Bq[1];
                        a.out[O_SH + ((size_t)L * DBATCH + b0 + 1) * D + c] = Aq[3] * hB1 + Bq[3];
                    }
                }
                if (PASS2) {
                    float h = hs;
#pragma unroll
                    for (int r = 0; r < 4; ++r) { h = av[mt][r] * h + uv[mt][r]; *(LAS unsigned short*)(obt + (16 * mt + 4 * qp + r) * RG_TP + j * 2) = f2bf(h); }
                }
            }
            if (!sample && qp == 0) {
                if (!PASS2) *(float2*)(RS + (((size_t)bseq * 128 + chunk) * D + c) * 2) = make_float2(Atot, H);
                else if (chunk == 127) a.out[O_PH + ((size_t)L * NBATCH + bseq) * D + c] = H;
            }
        }
        LDSW();
        if (PASS2) {
#pragma unroll
            for (int p = 0; p < 8; ++p) {
                const int q = p * 64 + lane, row = q >> 3, pc = q & 7;
                *(u32x4*)(OB + ((size_t)m0 + row) * D + c0 + 8 * pc) = *(const LAS u32x4*)(obt + row * RG_TP + pc * 16);
            }
            LDSW();
        }
    }
    if (PASS2) {
        const int t = threadIdx.x;
        if (sample) {
            for (int i = t; i < 8 * 3 * D; i += NTHREADS) { const int s = i / (3 * D), k = (i / D) % 3, c = i % D; const int b = ((m0 - MP) >> 3) + s;
                a.out[O_SCONV + (((size_t)L * DBATCH + b) * 3 + k) * D + c] = bf2f(P[((size_t)MP + b * DSEQ + 5 + k) * NP + CRNN + c]); }
        } else if (chunk == 127) {
            for (int i = t; i < 3 * D; i += NTHREADS) { const int k = i / D, c = i % D;
                a.out[O_PCONV + (((size_t)L * NBATCH + bseq) * 3 + k) * D + c] = bf2f(P[((size_t)m0 + 61 + k) * NP + CRNN + c]); }
        }
    }
}
__device__ __forceinline__ void rglru_prefix(const Args& a) {
    float* RS = (float*)(a.ws + WS_RS);
    const int gid = blockIdx.x * NTHREADS + threadIdx.x;
    if (gid >= NBATCH * D) return;
    const int b = gid / D, c = gid % D;
    float h = 0.f;
    for (int c0 = 0; c0 < 128; c0 += 16) {
        float2 ab[16];
#pragma unroll
        for (int i = 0; i < 16; ++i) ab[i] = *(const float2*)(RS + (((size_t)b * 128 + c0 + i) * D + c) * 2);
#pragma unroll
        for (int i = 0; i < 16; ++i) { RS[(((size_t)b * 128 + c0 + i) * D + c) * 2 + 1] = h; h = ab[i].x * h + ab[i].y; }
    }
}


constexpr int AT_KPB = 144;
constexpr int AT_VPB = 528;
constexpr int AT_K_OFF = 0, AT_V_OFF = 256 * AT_KPB;
constexpr int AT_LDS = AT_V_OFF + 64 * AT_VPB;

template <bool SAMPLE>
__device__ __forceinline__ void attn_unit(const bf16_t* __restrict__ P, bf16_t* OA, const float* __restrict__ sinks, const float* __restrict__ ck, const float* __restrict__ cv,
                                          int b, int qb, int c, LAS unsigned char* lds) {
    const int tid = threadIdx.x, lane = tid & 63, wv = __builtin_amdgcn_readfirstlane(tid >> 6), i16 = lane & 15, qp = lane >> 4;
    LAS unsigned char* ldsK = lds + AT_K_OFF; LAS unsigned char* ldsV = lds + AT_V_OFF;
    if (!SAMPLE) {
        const size_t row_base = (size_t)b * SEQ + (size_t)(qb - 1) * 128;
#pragma unroll
        for (int it = 0; it < 4; ++it) {
            const int ci = tid + 512 * it, s = ci >> 3, part = ci & 7;
            u32x4 kv = (u32x4){0u, 0u, 0u, 0u}, vv = (u32x4){0u, 0u, 0u, 0u};
            if (qb > 0 || s >= 128) {
                const bf16_t* pr = P + (row_base + s) * NP;
                kv = *(const u32x4*)(pr + CK + 64 * c + 8 * part);
                vv = *(const u32x4*)(pr + CV + 64 * c + 8 * part);
            }
            *(LAS u32x4*)(ldsK + s * AT_KPB + part * 16) = kv;
            const unsigned w4[4] = {vv.x, vv.y, vv.z, vv.w};
#pragma unroll
            for (int e = 0; e < 8; ++e) *(LAS unsigned short*)(ldsV + (8 * part + e) * AT_VPB + 2 * s) = (unsigned short)((w4[e >> 1] >> (16 * (e & 1))) & 0xffffu);
        }
    } else {
        for (int ci = tid; ci < 144 * 16; ci += 512) {
            const int s = ci >> 4, part = ci & 15;
            float kf[4] = {0.f, 0.f, 0.f, 0.f}, vf[4] = {0.f, 0.f, 0.f, 0.f};
            if (s < 128) {
                const f32x4 k4 = *(const f32x4*)(ck + ((size_t)(b * 128 + s) * 4 + c) * 64 + 4 * part);
                const f32x4 v4 = *(const f32x4*)(cv + ((size_t)(b * 128 + s) * 4 + c) * 64 + 4 * part);
#pragma unroll
                for (int e = 0; e < 4; ++e) { kf[e] = k4[e]; vf[e] = v4[e]; }
            } else if (s < 136) {
                const bf16_t* pr = P + (size_t)(MP + b * DSEQ + (s - 128)) * NP;
#pragma unroll
                for (int e = 0; e < 4; ++e) { kf[e] = bf2f(pr[CK + 64 * c + 4 * part + e]); vf[e] = bf2f(pr[CV + 64 * c + 4 * part + e]); }
            }
            u32x2 kw; kw.x = pk2bf(kf[0], kf[1]); kw.y = pk2bf(kf[2], kf[3]);
            *(LAS u32x2*)(ldsK + s * AT_KPB + part * 8) = kw;
#pragma unroll
            for (int e = 0; e < 4; ++e) *(LAS unsigned short*)(ldsV + (4 * part + e) * AT_VPB + 2 * s) = f2bf(vf[e]);
        }
    }
    __syncthreads();
    const int n_mt = SAMPLE ? 1 : 4;
    if (!SAMPLE || wv < 2) {
        for (int mt = 0; mt < n_mt; ++mt) {
            int h, tq, nt0; size_t qrow;
            if (!SAMPLE) { const int g = wv >> 1, qh = wv & 1; h = 4 * c + g; tq = 64 * qh + 16 * mt + i16; nt0 = (64 * qh + 16 * mt) >> 4; qrow = (size_t)b * SEQ + (size_t)qb * 128 + tq; }
            else { const int rho = 16 * wv + i16; h = 4 * c + (rho >> 3); tq = rho & 7; nt0 = 0; qrow = (size_t)MP + b * DSEQ + tq; }
            const float slope = exp2f(-0.5f * (float)(h + 1)), sink = sinks[h];
            bf16x8_t qf[2];
#pragma unroll
            for (int ks = 0; ks < 2; ++ks) qf[ks] = *(const bf16x8_t*)(P + qrow * NP + CQ + 64 * h + 32 * ks + 8 * qp);
            f32x4 sc[9];
#pragma unroll
            for (int jn = 0; jn < 9; ++jn) {
                const int nt = nt0 + jn;
                f32x4 acc = (f32x4){0.f, 0.f, 0.f, 0.f};
                if (SAMPLE || qb > 0 || nt >= 8) {
#pragma unroll
                    for (int ks = 0; ks < 2; ++ks) {
                        const bf16x8_t kfr = *(const LAS bf16x8_t*)(ldsK + (16 * nt + i16) * AT_KPB + (32 * ks + 8 * qp) * 2);
                        acc = __builtin_amdgcn_mfma_f32_16x16x32_bf16(kfr, qf[ks], acc, 0, 0, 0);
                    }
                }
#pragma unroll
                for (int r = 0; r < 4; ++r) {
                    const int sidx = 16 * nt + 4 * qp + r;
                    const int rel = 128 + tq - sidx;
                    bool valid = rel >= 0 && rel < 128;
                    if (!SAMPLE) valid = valid && (qb > 0 || sidx >= 128);
                    acc[r] = valid ? acc[r] * 0.125f - slope * (float)rel : -INFINITY;
                }
                sc[jn] = acc;
            }
            float mx = sink;
#pragma unroll
            for (int jn = 0; jn < 9; ++jn)
#pragma unroll
                for (int r = 0; r < 4; ++r) mx = fmaxf(mx, sc[jn][r]);
            mx = fmaxf(mx, __shfl_xor(mx, 16)); mx = fmaxf(mx, __shfl_xor(mx, 32));
            float sum = 0.f;
#pragma unroll
            for (int jn = 0; jn < 9; ++jn)
#pragma unroll
                for (int r = 0; r < 4; ++r) { const float e = __expf(sc[jn][r] - mx); sc[jn][r] = e; sum += e; }
            sum += __shfl_xor(sum, 16); sum += __shfl_xor(sum, 32);
            const float inv = __builtin_amdgcn_rcpf(sum + __expf(sink - mx));
            bf16x8_t pf[5];
#pragma unroll
            for (int ks = 0; ks < 5; ++ks) {
                u32x4 w;
                w.x = pk2bf(sc[2 * ks][0] * inv, sc[2 * ks][1] * inv); w.y = pk2bf(sc[2 * ks][2] * inv, sc[2 * ks][3] * inv);
                if (ks < 4) { w.z = pk2bf(sc[2 * ks + 1][0] * inv, sc[2 * ks + 1][1] * inv); w.w = pk2bf(sc[2 * ks + 1][2] * inv, sc[2 * ks + 1][3] * inv); }
                else { w.z = 0u; w.w = 0u; }
                pf[ks] = __builtin_bit_cast(bf16x8_t, w);
            }
#pragma unroll
            for (int dt = 0; dt < 4; ++dt) {
                f32x4 o = (f32x4){0.f, 0.f, 0.f, 0.f};
#pragma unroll
                for (int ks = 0; ks < 5; ++ks) {
                    const int ntA = nt0 + 2 * ks, ntB = (ks < 4) ? nt0 + 2 * ks + 1 : nt0 + 2 * ks;
                    const LAS unsigned char* vr = ldsV + (16 * dt + i16) * AT_VPB;
                    const u32x2 lo = *(const LAS u32x2*)(vr + 2 * (16 * ntA + 4 * qp));
                    const u32x2 hi = *(const LAS u32x2*)(vr + 2 * (16 * ntB + 4 * qp));
                    const u32x4 w = (u32x4){lo.x, lo.y, hi.x, hi.y};
                    o = __builtin_amdgcn_mfma_f32_16x16x32_bf16(__builtin_bit_cast(bf16x8_t, w), pf[ks], o, 0, 0, 0);
                }
                u32x2 ow; ow.x = pk2bf(o[0], o[1]); ow.y = pk2bf(o[2], o[3]);
                *(u32x2*)(OA + qrow * D + 64 * h + 16 * dt + 4 * qp) = ow;
            }
        }
    }
    __syncthreads();
}

template <bool PASS2>
__device__ __forceinline__ void rglru_unit(const Args& a, int L, int unit, LAS unsigned char* lds) {
    const int tid = threadIdx.x, lane = tid & 63, wv = __builtin_amdgcn_readfirstlane(tid >> 6);
    const bf16_t* P = (const bf16_t*)(a.ws + WS_P); bf16_t* OB = (bf16_t*)(a.ws + WS_OB); float* RS = (float*)(a.ws + WS_RS);
    const float* cw = a.in[10] + (size_t)L * 4 * D; const float* cb = a.in[11] + L * D; const float* wa = a.in[12] + (size_t)L * 16 * 4096; const float* ba = a.in[13] + L * D;
    const float* wx = a.in[14] + (size_t)L * 16 * 4096; const float* bx = a.in[15] + L * D; const float* lam = a.in[16] + L * D;
    const float* conv0 = a.in[4] + (size_t)L * DBATCH * 3 * D; const float* h0 = a.in[5] + (size_t)L * DBATCH * D;
    LAS float* s_xc = (LAS float*)lds + wv * 64;
    const int m0 = unit * 64;
    const bool sample = m0 >= MP;
    for (int bb = 0; bb < 2; ++bb) {
        const int bk = 2 * wv + bb, c = 64 * bk + lane;
        float war[64], wxr[64];
#pragma unroll
        for (int i = 0; i < 64; ++i) { war[i] = wa[((size_t)bk * 64 + i) * 64 + lane]; wxr[i] = wx[((size_t)bk * 64 + i) * 64 + lane]; }
        const float c0 = cw[0 * D + c], c1 = cw[1 * D + c], c2 = cw[2 * D + c], c3 = cw[3 * D + c], cbc = cb[c], bac = ba[c], bxc = bx[c];
        const float spl = softplusf_(-lam[c]);
        float x1 = 0.f, x2 = 0.f, x3 = 0.f, h = 0.f, Ap = 1.f;
        int bseq = 0, chunk = 0;
        if (!sample) {
            bseq = m0 / SEQ; chunk = (m0 % SEQ) / 64;
            if (chunk > 0) {
                x1 = bf2f(P[(size_t)(m0 - 1) * NP + CRNN + c]); x2 = bf2f(P[(size_t)(m0 - 2) * NP + CRNN + c]); x3 = bf2f(P[(size_t)(m0 - 3) * NP + CRNN + c]);
                if (PASS2) { for (int cc = 0; cc < chunk; ++cc) { const float2 ab = *(const float2*)(RS + (((size_t)bseq * 128 + cc) * D + c) * 2); h = ab.x * h + ab.y; } }
            }
        }
        for (int t = 0; t < 64; ++t) {
            const size_t m = (size_t)m0 + t;
            if (sample && (t & 7) == 0) {
                if (!PASS2) break;
                const int b = (int)(m - MP) >> 3;
                x3 = conv0[((size_t)b * 3 + 0) * D + c]; x2 = conv0[((size_t)b * 3 + 1) * D + c]; x1 = conv0[((size_t)b * 3 + 2) * D + c]; h = h0[(size_t)b * D + c];
            }
            const float x = bf2f(P[m * NP + CRNN + c]);
            const float xc = cbc + c0 * x3 + c1 * x2 + c2 * x1 + c3 * x;
            LDSW(); s_xc[lane] = xc; LDSW();
            float r = bac, ig = bxc;
#pragma unroll
            for (int i4 = 0; i4 < 16; ++i4) { const f32x4 xv = *(const LAS f32x4*)(s_xc + 4 * i4);
#pragma unroll
                for (int e = 0; e < 4; ++e) { r += xv[e] * war[4 * i4 + e]; ig += xv[e] * wxr[4 * i4 + e]; } }
            r = sigmoidf_(r); ig = sigmoidf_(ig);
            const float log_a = -8.f * r * spl;
            const float av = __expf(log_a);
            const float u = sqrtf(-expm1f(2.f * log_a)) * (ig * xc);
            h = av * h + u; Ap *= av;
            if (PASS2) OB[m * D + c] = f2bf(h);
            x3 = x2; x2 = x1; x1 = x;
            if (PASS2 && sample && (t & 7) == 7) {
                const int b = (int)(m - MP) >> 3;
                float* oc = a.out + O_SCONV + ((size_t)L * DBATCH + b) * 3 * D; float* oh = a.out + O_SH + ((size_t)L * DBATCH + b) * D;
                oh[c] = h; oc[0 * D + c] = x3; oc[1 * D + c] = x2; oc[2 * D + c] = x1;
            }
        }
        if (!sample) {
            if (!PASS2) { *(float2*)(RS + (((size_t)bseq * 128 + chunk) * D + c) * 2) = make_float2(Ap, h); }
            else if (chunk == 127) {
                float* oc = a.out + O_PCONV + ((size_t)L * NBATCH + bseq) * 3 * D; float* oh = a.out + O_PH + ((size_t)L * NBATCH + bseq) * D;
                oh[c] = h; oc[0 * D + c] = x3; oc[1 * D + c] = x2; oc[2 * D + c] = x1;
            }
        }
    }
}

__device__ __forceinline__ void phase_elem_mixa(const Args& a, int L) {
    const bf16_t* P = (const bf16_t*)(a.ws + WS_P); bf16_t* AC = (bf16_t*)(a.ws + WS_ACAT);
    const float* mu = a.in[17] + (size_t)L * SHIFT_W; const float* shift0 = a.in[6] + (size_t)L * DBATCH * SHIFT_W;
    const size_t gt = (size_t)blockIdx.x * NTHREADS + threadIdx.x, gs = (size_t)gridDim.x * NTHREADS;
    for (unsigned i = (unsigned)gt; i < (unsigned)(M * ACAT_K); i += (unsigned)gs) {
        const unsigned m = i / ACAT_K; const int j = (int)(i - m * ACAT_K);
        float o = 0.f;
        if (j < 288) {
            const int ch = 3072 + j;
            const float pc = bf2f(P[(size_t)m * NP + CRW + ch]);
            float pv;
            if (m < (unsigned)MP) pv = (m % SEQ) == 0 ? 0.f : bf2f(P[(size_t)(m - 1) * NP + CRW + ch]);
            else pv = ((m - MP) % DSEQ) == 0 ? shift0[(size_t)((m - MP) / DSEQ) * SHIFT_W + ch] : bf2f(P[(size_t)(m - 1) * NP + CRW + ch]);
            const float ps = pc + mu[ch] * (pv - pc);
            o = j < 64 ? 1.f - 2.f * __builtin_amdgcn_rcpf(__expf(2.f * ps) + 1.f) : (j < 128 ? ps : sigmoidf_(ps));
        }
        AC[i] = f2bf(o);
    }
}
__device__ __forceinline__ void phase_state_copies(const Args& a, int L, int first) {
    const bf16_t* P = (const bf16_t*)(a.ws + WS_P);
    if ((int)blockIdx.x < first) return;
    const size_t gt = (size_t)(blockIdx.x - first) * NTHREADS + threadIdx.x, gs = (size_t)(gridDim.x - first) * NTHREADS;
    const float* ck = a.in[2] + (size_t)L * DBATCH * 128 * 256; const float* cv = a.in[3] + (size_t)L * DBATCH * 128 * 256;
    float* pk = a.out + O_PK + (size_t)L * NBATCH * 128 * 256; float* pv_ = a.out + O_PV + (size_t)L * NBATCH * 128 * 256;
    float* pshift = a.out + O_PSHIFT + (size_t)L * NBATCH * SHIFT_W; float* sk = a.out + O_SK + (size_t)L * DBATCH * 128 * 256; float* sv = a.out + O_SV + (size_t)L * DBATCH * 128 * 256;
    float* sshift = a.out + O_SSHIFT + (size_t)L * DBATCH * SHIFT_W;
    const size_t n_pk = (size_t)NBATCH * 128 * 256, n_sk = (size_t)DBATCH * 128 * 256, n_ps = (size_t)NBATCH * SHIFT_W, n_ss = (size_t)DBATCH * SHIFT_W;
    auto ld4 = [&](const bf16_t* p) -> f32x4 { const u32x2 w = *(const u32x2*)p; return (f32x4){__uint_as_float(w.x << 16), __uint_as_float(w.x & 0xffff0000u), __uint_as_float(w.y << 16), __uint_as_float(w.y & 0xffff0000u)}; };
    for (unsigned i4 = (unsigned)gt; i4 < (unsigned)((n_pk + n_sk + n_ps + n_ss) / 4); i4 += (unsigned)gs) {
        const unsigned i = 4 * i4;
        if (i < n_pk) {
            const int b = (int)(i / (128 * 256)), s = (int)((i / 256) % 128), e = (int)(i % 256);
            const size_t row = (size_t)b * SEQ + (SEQ - 128) + s;
            *(f32x4*)(pk + i) = ld4(P + row * NP + CK + e); *(f32x4*)(pv_ + i) = ld4(P + row * NP + CV + e);
            continue;
        }
        unsigned k = i - (unsigned)n_pk;
        if (k < n_sk) {
            const int b = (int)(k / (128 * 256)), s = (int)((k / 256) % 128), e = (int)(k % 256);
            if (s < 120) { *(f32x4*)(sk + k) = *(const f32x4*)(ck + ((size_t)b * 128 + s + 8) * 256 + e); *(f32x4*)(sv + k) = *(const f32x4*)(cv + ((size_t)b * 128 + s + 8) * 256 + e); }
            else { const size_t row = (size_t)MP + b * DSEQ + (s - 120); *(f32x4*)(sk + k) = ld4(P + row * NP + CK + e); *(f32x4*)(sv + k) = ld4(P + row * NP + CV + e); }
            continue;
        }
        k -= (unsigned)n_sk;
        if (k < n_ps) { const int b = (int)(k / SHIFT_W), ch = (int)(k % SHIFT_W); *(f32x4*)(pshift + k) = ld4(P + ((size_t)b * SEQ + SEQ - 1) * NP + CRW + ch); continue; }
        k -= (unsigned)n_ps;
        { const int b = (int)(k / SHIFT_W), ch = (int)(k % SHIFT_W); *(f32x4*)(sshift + k) = ld4(P + ((size_t)MP + b * DSEQ + DSEQ - 1) * NP + CRW + ch); }
    }
}

#ifndef PROBE_MIXA
#define PROBE_MIXA 0
#endif
__device__ __forceinline__ void phase_mixa(const Args& a, int L, LAS unsigned char* lds) {
    const bf16_t* P = (const bf16_t*)(a.ws + WS_P); bf16_t* OA = (bf16_t*)(a.ws + WS_OA);
    const float* sinks = a.in[9] + L * 16; const float* ck = a.in[2] + (size_t)L * DBATCH * 128 * 256; const float* cv = a.in[3] + (size_t)L * DBATCH * 128 * 256;
    constexpr int N_RG1 = MP / 64, N_AP = NBATCH * 64 * 4, N_AS = DBATCH * 4;
    phase_elem_mixa(a, L);
    if (PROBE_MIXA & 1) phase_elem_mixa(a, L);
    for (int it = blockIdx.x; it < N_RG1; it += gridDim.x) { rglru_unit2<false>(a, L, it, lds); __syncthreads(); }
    if (PROBE_MIXA & 2) for (int it = blockIdx.x; it < N_RG1; it += gridDim.x) { rglru_unit2<false>(a, L, it, lds); __syncthreads(); }
    for (int r = blockIdx.x; r < N_AP; r += gridDim.x) { const int c = r & 3, qb = (r >> 2) & 63, b = r >> 8; attn_unit<false>(P, OA, sinks, ck, cv, b, qb, c, lds); }
    if (PROBE_MIXA & 4) for (int r = blockIdx.x; r < N_AP; r += gridDim.x) { const int c = r & 3, qb = (r >> 2) & 63, b = r >> 8; attn_unit<false>(P, OA, sinks, ck, cv, b, qb, c, lds); }
    for (int r = blockIdx.x; r < N_AS; r += gridDim.x) { const int c = r & 3, b = r >> 2; attn_unit<true>(P, OA, sinks, ck, cv, b, 0, c, lds); }
    if (PROBE_MIXA & 8) for (int r = blockIdx.x; r < N_AS; r += gridDim.x) { const int c = r & 3, b = r >> 2; attn_unit<true>(P, OA, sinks, ck, cv, b, 0, c, lds); }
}

struct EpiLora {
    static constexpr bool PERM = true, AFTER_DRAIN = false;
    bf16_t* WAW; bf16_t* WAA; bf16_t* WAG; const float* w0; const float* a0;
    __device__ __forceinline__ void operator()(const f32x4 (&acc)[2][2][4][2], const pg8::Unit& u, int wr, int wc, int fr, int fq) const {
        const int row0 = u.pm * 256 + wr * 64 + fr, kind = u.pn >> 2, colb = (u.pn & 3) * 256 + wc * 32 + 8 * fq;
        const float* bsrc = kind == 0 ? w0 : a0;
        f32x4 bias[2][2];
#pragma unroll
        for (int bj = 0; bj < 2; ++bj)
#pragma unroll
            for (int n = 0; n < 2; ++n) bias[bj][n] = kind == 2 ? (f32x4){0.f, 0.f, 0.f, 0.f} : *(const f32x4*)(bsrc + colb + bj * 128 + 4 * n);
#pragma unroll
        for (int ai = 0; ai < 2; ++ai)
#pragma unroll
            for (int m = 0; m < 4; ++m) {
                const size_t off = (size_t)(row0 + ai * 128 + m * 16) * D + colb;
#pragma unroll
                for (int bj = 0; bj < 2; ++bj) {
                    f32x4 v0 = acc[ai][bj][m][0] + bias[bj][0], v1 = acc[ai][bj][m][1] + bias[bj][1];
                    if (kind == 0) {
#pragma unroll
                        for (int i = 0; i < 4; ++i) {
                            v0[i] = -__expf(-(fmaxf(-v0[i], 0.f) + __logf(1.f + __expf(-fabsf(v0[i])))) - 0.5f);
                            v1[i] = -__expf(-(fmaxf(-v1[i], 0.f) + __logf(1.f + __expf(-fabsf(v1[i])))) - 0.5f);
                        }
                    } else if (kind == 1) {
#pragma unroll
                        for (int i = 0; i < 4; ++i) { v0[i] = sigmoidf_(v0[i]); v1[i] = sigmoidf_(v1[i]); }
                    }
                    u32x4 w; w.x = pk2bf(v0[0], v0[1]); w.y = pk2bf(v0[2], v0[3]); w.z = pk2bf(v1[0], v1[1]); w.w = pk2bf(v1[2], v1[3]);
                    *(u32x4*)(WAW + (size_t)kind * ((size_t)M * D) + off + bj * 128) = w;
                }
                asm volatile("" ::: "memory");
            }
    }
};

__device__ __forceinline__ void phase_mixc(const Args& a, int L, bf16_t* DST) {
    const int lane = threadIdx.x & 63, wv = threadIdx.x >> 6;
    const bf16_t* P = (const bf16_t*)(a.ws + WS_P); const bf16_t* WAG = (const bf16_t*)(a.ws + WS_WAG); const bf16_t* Y = (const bf16_t*)(a.ws + WS_Y); const float* BD = (const float*)(a.ws + WS_BD);
    bf16_t* OA = (bf16_t*)(a.ws + WS_OA); const bf16_t* OB = (const bf16_t*)(a.ws + WS_OB);
    const float* mu = a.in[17] + (size_t)L * SHIFT_W + 2048; const float* shift0 = a.in[6] + (size_t)L * DBATCH * SHIFT_W + 2048;
    const int c0 = 16 * lane, h = lane >> 2;
    float lw[16], lb[16], muv[16];
#pragma unroll
    for (int i = 0; i < 16; ++i) { lw[i] = a.in[26][L * D + c0 + i]; lb[i] = a.in[27][L * D + c0 + i]; muv[i] = mu[c0 + i]; }
    for (int m = blockIdx.x * NWAVES + wv; m < M; m += gridDim.x * NWAVES) {
        float y[16];
        { u32x4 yv[2]; yv[0] = *(const u32x4*)(Y + (size_t)m * D + c0); yv[1] = *(const u32x4*)(Y + (size_t)m * D + c0 + 8);
#pragma unroll
          for (int i = 0; i < 16; ++i) y[i] = __uint_as_float((i & 1) ? (yv[i >> 3][(i >> 1) & 3] & 0xffff0000u) : (yv[i >> 3][(i >> 1) & 3] << 16)); }
        float s = 0.f;
#pragma unroll
        for (int i = 0; i < 16; ++i) s += y[i];
        s += __shfl_xor(s, 1); s += __shfl_xor(s, 2);
        const float mean = s * (1.f / 64.f);
        float q = 0.f;
#pragma unroll
        for (int i = 0; i < 16; ++i) { y[i] -= mean; q += y[i] * y[i]; }
        q += __shfl_xor(q, 1); q += __shfl_xor(q, 2);
        const float rstd = rsqrtf(q * (1.f / 64.f) + GN_EPS);
        const float bd = BD[(size_t)m * 16 + h];
        const bool first = m < MP ? (m % SEQ) == 0 : ((m - MP) % DSEQ) == 0;
        const bf16_t* pr = P + (size_t)m * NP + CRW + 2048 + c0;
#define BFX(v, i) __uint_as_float((((i) & 1) ? ((v)[(i) >> 3][((i) >> 1) & 3] & 0xffff0000u) : ((v)[(i) >> 3][((i) >> 1) & 3] << 16)))
        u32x4 pcv[2], ppv[2], gv[2], gav[2], gbv[2], gcv[2], oav[2], obv[2];
        pcv[0] = *(const u32x4*)pr; pcv[1] = *(const u32x4*)(pr + 8);
        ppv[0] = pcv[0]; ppv[1] = pcv[1];
        if (!first) { ppv[0] = *(const u32x4*)(pr - NP); ppv[1] = *(const u32x4*)(pr - NP + 8); }
        gv[0] = *(const u32x4*)(WAG + (size_t)m * D + c0); gv[1] = *(const u32x4*)(WAG + (size_t)m * D + c0 + 8);
        const bf16_t* pg = P + (size_t)m * NP + CG + c0;
        gav[0] = *(const u32x4*)pg; gav[1] = *(const u32x4*)(pg + 8);
        gbv[0] = *(const u32x4*)(pg + 1024); gbv[1] = *(const u32x4*)(pg + 1024 + 8);
        gcv[0] = *(const u32x4*)(pg + 2048); gcv[1] = *(const u32x4*)(pg + 2048 + 8);
        oav[0] = *(const u32x4*)(OA + (size_t)m * D + c0); oav[1] = *(const u32x4*)(OA + (size_t)m * D + c0 + 8);
        obv[0] = *(const u32x4*)(OB + (size_t)m * D + c0); obv[1] = *(const u32x4*)(OB + (size_t)m * D + c0 + 8);
        float o[16];
#pragma unroll
        for (int i = 0; i < 16; ++i) {
            const float pc = BFX(pcv, i);
            float pv;
            if (first) pv = m < MP ? 0.f : shift0[(size_t)((m - MP) / DSEQ) * SHIFT_W + c0 + i];
            else pv = BFX(ppv, i);
            const float vv = pc + muv[i] * (pv - pc);
            const float yn = y[i] * rstd * lw[i] + lb[i];
            const float oc = (yn + bd * vv) * BFX(gv, i);
            o[i] = BFX(gav, i) * BFX(oav, i) + BFX(gbv, i) * BFX(obv, i) + BFX(gcv, i) * oc;
        }
        u32x4 w0, w1;
        w0.x = pk2bf(o[0], o[1]); w0.y = pk2bf(o[2], o[3]); w0.z = pk2bf(o[4], o[5]); w0.w = pk2bf(o[6], o[7]);
        w1.x = pk2bf(o[8], o[9]); w1.y = pk2bf(o[10], o[11]); w1.z = pk2bf(o[12], o[13]); w1.w = pk2bf(o[14], o[15]);
        *(u32x4*)(DST + (size_t)m * D + c0) = w0; *(u32x4*)(DST + (size_t)m * D + c0 + 8) = w1;
    }
}

constexpr int CH_OFF_AA = 0, CH_OFF_RA = 2048, CH_OFF_MC = 4096, CH_OFF_TL = 5120  , CH_OFF_BT = 5632, CH_OFF_KT = 7808, CH_OFF_VT = 9984, CH_OFF_GM = 12160, CH_SLOT = 12416;
constexpr int CH_TP = 136;
__device__ __forceinline__ float row_prefix16(float x) {
    x += __builtin_bit_cast(float, __builtin_amdgcn_update_dpp(0, __builtin_bit_cast(int, x), 0x111, 0xF, 0xF, true));
    x += __builtin_bit_cast(float, __builtin_amdgcn_update_dpp(0, __builtin_bit_cast(int, x), 0x112, 0xF, 0xF, true));
    x += __builtin_bit_cast(float, __builtin_amdgcn_update_dpp(0, __builtin_bit_cast(int, x), 0x114, 0xF, 0xF, true));
    x += __builtin_bit_cast(float, __builtin_amdgcn_update_dpp(0, __builtin_bit_cast(int, x), 0x118, 0xF, 0xF, true));
    return x;
}
__device__ __forceinline__ f32x4 prod16(const f32x4 xt, const f32x4 y) {
    f32x4 z = (f32x4){0.f, 0.f, 0.f, 0.f};
#pragma unroll
    for (int r = 0; r < 4; ++r) z = __builtin_amdgcn_mfma_f32_16x16x4f32(xt[r], y[r], z, 0, 0, 0);
    return z;
}
__device__ __forceinline__ f32x4 gram(const bf16x8_t (&x)[2], const bf16x8_t (&y)[2]) {
    f32x4 z = (f32x4){0.f, 0.f, 0.f, 0.f};
    z = __builtin_amdgcn_mfma_f32_16x16x32_bf16(x[0], y[0], z, 0, 0, 0);
    z = __builtin_amdgcn_mfma_f32_16x16x32_bf16(x[1], y[1], z, 0, 0, 0);
    return z;
}

struct ChunkRaw { u32x2 cr[4], ck[4], cv[4], a[4], x[4]; };
constexpr int CH_PAR_OFF = 8 * CH_SLOT;
constexpr int CH_PAR_BYTES = 6 * 64 * 4;
__device__ __forceinline__ void stage_head_params(const Args& a, int L, int h, LAS unsigned char* par, int lane) {
    LAS float* p = (LAS float*)par; const int c = 64 * h + lane;
    p[lane] = a.in[17][(size_t)L * SHIFT_W + c]; p[64 + lane] = a.in[17][(size_t)L * SHIFT_W + 1024 + c]; p[128 + lane] = a.in[17][(size_t)L * SHIFT_W + 2048 + c];
    p[192 + lane] = a.in[23][L * D + c]; p[256 + lane] = a.in[24][L * D + c]; p[320 + lane] = a.in[25][L * D + c];
}
__device__ __forceinline__ void chunk_load(const Args& a, size_t m0, int h, int ntok, int lane, ChunkRaw& R) {
    asm volatile("" : "+v"(lane));
    const int i16 = lane & 15, qp = lane >> 4;
    const bf16_t* P = (const bf16_t*)(a.ws + WS_P); const bf16_t* WAW = (const bf16_t*)(a.ws + WS_WAW); const bf16_t* WAA = (const bf16_t*)(a.ws + WS_WAA);
    const size_t m = m0 + (i16 < ntok ? i16 : 0);
#pragma unroll
    for (int r = 0; r < 4; ++r) {
        const int c = 64 * h + 16 * r + 4 * qp;
        const bf16_t* pr = P + m * NP + CRW + c;
        R.cr[r] = *(const u32x2*)pr; R.ck[r] = *(const u32x2*)(pr + 1024); R.cv[r] = *(const u32x2*)(pr + 2048);
        R.x[r] = *(const u32x2*)(WAW + m * D + c);
        R.a[r] = *(const u32x2*)(WAA + m * D + c);
    }
}
__device__ __forceinline__ unsigned dpp_prev_row(unsigned old, unsigned src) { return (unsigned)__builtin_amdgcn_update_dpp((int)old, (int)src, 0x111, 0xF, 0xF, false); }
template <class PF> __device__ __forceinline__ void chunk_compute(const Args& a, const ChunkRaw& R, size_t m0, int h, int ntok, bool seq_start, const float* sh0, const LAS unsigned char* par_, LAS unsigned char* slot, int lane, PF pf) {
    asm volatile("" : "+v"(lane));
    const int i16 = lane & 15, qp = lane >> 4;
    float* BD = (float*)(a.ws + WS_BD);
    const LAS float* par = (const LAS float*)par_;
    const bool valid = i16 < ntok;
    const size_t m = m0 + (valid ? i16 : 0);
    u32x2 p0r[4], p0k[4], p0v[4];
    {
        const bf16_t* P = (const bf16_t*)(a.ws + WS_P);
#pragma unroll
        for (int r = 0; r < 4; ++r) {
            const int c = 64 * h + 16 * r + 4 * qp;
            if (!seq_start) { const bf16_t* pp = P + (m0 - 1) * NP + CRW + c; p0r[r] = *(const u32x2*)pp; p0k[r] = *(const u32x2*)(pp + 1024); p0v[r] = *(const u32x2*)(pp + 2048); }
            else if (sh0) { const f32x4 fr_ = *(const f32x4*)(sh0 + c), fk_ = *(const f32x4*)(sh0 + 1024 + c), fv_ = *(const f32x4*)(sh0 + 2048 + c);
                p0r[r] = pk4(fr_[0], fr_[1], fr_[2], fr_[3]); p0k[r] = pk4(fk_[0], fk_[1], fk_[2], fk_[3]); p0v[r] = pk4(fv_[0], fv_[1], fv_[2], fv_[3]); }
            else { p0r[r] = (u32x2){0u, 0u}; p0k[r] = p0r[r]; p0v[r] = p0r[r]; }
        }
    }
    float abu[16], bbu[16];
    u32x2 pa[4], pb[4], pkk[4], prr[4];
    float ssq = 0.f, bdp = 0.f;
#pragma unroll
    for (int r = 0; r < 4; ++r) {
        const int cb = 16 * r + 4 * qp, c = 64 * h + cb;
        const u32x2 cr = R.cr[r], ck_ = R.ck[r], cv_ = R.cv[r], a4 = R.a[r];
        u32x2 pr_, pk_, pv_;
        pr_.x = dpp_prev_row(p0r[r].x, cr.x); pr_.y = dpp_prev_row(p0r[r].y, cr.y); pk_.x = dpp_prev_row(p0k[r].x, ck_.x); pk_.y = dpp_prev_row(p0k[r].y, ck_.y);
        pv_.x = dpp_prev_row(p0v[r].x, cv_.x); pv_.y = dpp_prev_row(p0v[r].y, cv_.y);
        const u32x2 x4 = R.x[r];
        const f32x4 mur = *(const LAS f32x4*)(par + cb), muk = *(const LAS f32x4*)(par + 64 + cb), muv = *(const LAS f32x4*)(par + 128 + cb);
        const f32x4 kkc = *(const LAS f32x4*)(par + 192 + cb), kac = *(const LAS f32x4*)(par + 256 + cb), rkc = *(const LAS f32x4*)(par + 320 + cb);
        float vv[4], kb[4], rb[4];
#pragma unroll
        for (int i = 0; i < 4; ++i) {
            const unsigned wr_ = i < 2 ? cr.x : cr.y, wk_ = i < 2 ? ck_.x : ck_.y, wv_ = i < 2 ? cv_.x : cv_.y, wa_ = i < 2 ? a4.x : a4.y, wx_ = i < 2 ? x4.x : x4.y;
            const unsigned qr_ = i < 2 ? pr_.x : pr_.y, qk_ = i < 2 ? pk_.x : pk_.y, qv_ = i < 2 ? pv_.x : pv_.y;
            const float c_r = __uint_as_float((i & 1) ? (wr_ & 0xffff0000u) : (wr_ << 16)), c_k = __uint_as_float((i & 1) ? (wk_ & 0xffff0000u) : (wk_ << 16)),
                        c_v = __uint_as_float((i & 1) ? (wv_ & 0xffff0000u) : (wv_ << 16)), a_ = __uint_as_float((i & 1) ? (wa_ & 0xffff0000u) : (wa_ << 16));
            const float p_r = __uint_as_float((i & 1) ? (qr_ & 0xffff0000u) : (qr_ << 16)), p_k = __uint_as_float((i & 1) ? (qk_ & 0xffff0000u) : (qk_ << 16)),
                  p_v = __uint_as_float((i & 1) ? (qv_ & 0xffff0000u) : (qv_ << 16));
            float r_ = c_r + mur[i] * (p_r - c_r), kx = c_k + muk[i] * (p_k - c_k), v_ = c_v + muv[i] * (p_v - c_v);
            float lw_ = __uint_as_float((i & 1) ? (wx_ & 0xffff0000u) : (wx_ << 16));
            if (!valid) { r_ = 0.f; kx = 0.f; v_ = 0.f; lw_ = 0.f; }
            const float kkr = kx * kkc[i];
            const float k2_ = kx * (1.f + (a_ - 1.f) * kac[i]);
            ssq += kkr * kkr; bdp += r_ * k2_ * rkc[i];
            const float g = row_prefix16(lw_);
            const float eg = __expf(g), egx = __expf(g - lw_), eng = __expf(-g);
            const int e = 4 * r + i;
            abu[e] = -kkr * egx; bbu[e] = kkr * a_ * eng; kb[i] = k2_ * eng; rb[i] = r_ * eg; vv[i] = v_;
            if (i16 == 15) *(LAS float*)(slot + CH_OFF_GM + 4 * (cb + i)) = eg;
        }
        const int off = i16 * CH_TP + cb * 2;
        pkk[r] = pk4(kb[0], kb[1], kb[2], kb[3]); prr[r] = pk4(rb[0], rb[1], rb[2], rb[3]);
        *(LAS u32x2*)(slot + CH_OFF_VT + off) = pk4(vv[0], vv[1], vv[2], vv[3]);
        *(LAS u32x2*)(slot + CH_OFF_KT + off) = pkk[r];
        asm volatile("" : "+v"(ssq), "+v"(bdp));
        __builtin_amdgcn_sched_barrier(0);
    }
    __builtin_amdgcn_sched_barrier(0);
    pf();
    __builtin_amdgcn_sched_barrier(0);
    ssq += __shfl_xor(ssq, 16); ssq += __shfl_xor(ssq, 32);
    bdp += __shfl_xor(bdp, 16); bdp += __shfl_xor(bdp, 32);
    if (valid && qp == 0) BD[m * 16 + h] = bdp;
    const float inrm = __builtin_amdgcn_rcpf(fmaxf(__builtin_amdgcn_sqrtf(ssq), 1e-12f));
#pragma unroll
    for (int r = 0; r < 4; ++r) {
        pa[r] = pk4(abu[4 * r] * inrm, abu[4 * r + 1] * inrm, abu[4 * r + 2] * inrm, abu[4 * r + 3] * inrm);
        pb[r] = pk4(bbu[4 * r] * inrm, bbu[4 * r + 1] * inrm, bbu[4 * r + 2] * inrm, bbu[4 * r + 3] * inrm);
        const int off = i16 * CH_TP + (16 * r + 4 * qp) * 2;
        *(LAS u32x2*)(slot + CH_OFF_AA + off) = pa[r];
        *(LAS u32x2*)(slot + CH_OFF_BT + off) = pb[r];
    }
    __builtin_amdgcn_sched_barrier(0);
    bf16x8_t fa[2], fb[2], fk[2], fr[2];
#pragma unroll
    for (int ks = 0; ks < 2; ++ks) { fa[ks] = mk_frag(pa[2 * ks], pa[2 * ks + 1]); fb[ks] = mk_frag(pb[2 * ks], pb[2 * ks + 1]); fk[ks] = mk_frag(pkk[2 * ks], pkk[2 * ks + 1]); fr[ks] = mk_frag(prr[2 * ks], prr[2 * ks + 1]); }
    f32x4 Lc = gram(fa, fb), Nc = gram(fb, fa), Lak = gram(fa, fk), MrbT = gram(fb, fr), MrkT = gram(fk, fr);
#pragma unroll
    for (int r = 0; r < 4; ++r) {
        const int row = 4 * qp + r;
        Lc[r] = row > i16 ? Lc[r] : 0.f;
        Lak[r] = row > i16 ? Lak[r] : 0.f;
        Nc[r] = row < i16 ? Nc[r] : 0.f;
        MrbT[r] = row <= i16 ? MrbT[r] : 0.f;
        MrkT[r] = row <= i16 ? MrkT[r] : 0.f;
    }
    __builtin_amdgcn_sched_barrier(0);
    f32x4 eye;
#pragma unroll
    for (int r = 0; r < 4; ++r) eye[r] = (4 * qp + r == i16) ? 1.f : 0.f;
    const f32x4 L2 = prod16(Nc, Lc), N2 = prod16(Lc, Nc);
    const f32x4 L4 = prod16(N2, L2), N4 = prod16(L2, N2);
    const f32x4 N8 = prod16(L4, N4);
    const f32x4 Q1 = prod16(Lc + eye, N2 + eye), Q1T = prod16(N2 + eye, Lc + eye), Q2 = prod16(L4 + eye, N8 + eye);
    const f32x4 TT = prod16(Q1T, Q2);
    const f32x4 TLk = prod16(Lak, TT);
    __builtin_amdgcn_sched_barrier(0);
    LDSW();
    const bf16x8_t ttf = mk_frag(pk4(TT[0], TT[1], TT[2], TT[3]), (u32x2){0u, 0u});
    f32x4 at[4];
#pragma unroll
    for (int kt = 0; kt < 4; ++kt) {
        const u32x2 ac = tr_read4(slot + CH_OFF_AA + (4 * qp + (i16 >> 2)) * CH_TP + (16 * kt + 4 * (i16 & 3)) * 2);
        at[kt] = __builtin_amdgcn_mfma_f32_16x16x32_bf16(mk_frag(ac, (u32x2){0u, 0u}), ttf, (f32x4){0.f, 0.f, 0.f, 0.f}, 0, 0, 0);
    }
    LDSW();
#pragma unroll
    for (int ks = 0; ks < 2; ++ks) {
        const u32x2 lo = pk4(at[2 * ks][0], at[2 * ks][1], at[2 * ks][2], at[2 * ks][3]), hi = pk4(at[2 * ks + 1][0], at[2 * ks + 1][1], at[2 * ks + 1][2], at[2 * ks + 1][3]);
        *(LAS u32x4*)(slot + CH_OFF_AA + ks * 1024 + lane * 16) = (u32x4){lo.x, lo.y, hi.x, hi.y};
        *(LAS u32x4*)(slot + CH_OFF_RA + ks * 1024 + lane * 16) = __builtin_bit_cast(u32x4, fr[ks]);
    }
    {
        const u32x2 mb = pk4(MrbT[0], MrbT[1], MrbT[2], MrbT[3]), mk = pk4(MrkT[0], MrkT[1], MrkT[2], MrkT[3]), tl = pk4(TLk[0], TLk[1], TLk[2], TLk[3]);
        *(LAS u32x4*)(slot + CH_OFF_MC + lane * 16) = (u32x4){mb.x, mb.y, mk.x, mk.y};
        *(LAS u32x2*)(slot + CH_OFF_TL + lane * 8) = tl;
    }
}

struct ChainFrag { u32x4 aa0, aa1, ra0, ra1, mc, tl; u32x2 vq4, b4[4], k4[4]; f32x4 gm[4]; };
__device__ __forceinline__ void chain_fetch(LAS unsigned char* slot, int vq, int lane, ChainFrag& F) {
    const int i16 = lane & 15, qp = lane >> 4;
    const int troff = (4 * qp + (i16 >> 2)) * CH_TP + 8 * (i16 & 3);
    { const u32x2 t2 = *(const LAS u32x2*)(slot + CH_OFF_TL + lane * 8); F.tl = (u32x4){t2.x, t2.y, 0u, 0u}; }
    F.vq4 = tr_read4(slot + CH_OFF_VT + troff + 32 * vq);
    F.aa0 = *(const LAS u32x4*)(slot + CH_OFF_AA + lane * 16); F.aa1 = *(const LAS u32x4*)(slot + CH_OFF_AA + 1024 + lane * 16);
    F.ra0 = *(const LAS u32x4*)(slot + CH_OFF_RA + lane * 16); F.ra1 = *(const LAS u32x4*)(slot + CH_OFF_RA + 1024 + lane * 16);
    F.mc = *(const LAS u32x4*)(slot + CH_OFF_MC + lane * 16);
#pragma unroll
    for (int kt = 0; kt < 4; ++kt) {
        F.b4[kt] = tr_read4(slot + CH_OFF_BT + troff + 32 * kt); F.k4[kt] = tr_read4(slot + CH_OFF_KT + troff + 32 * kt);
        F.gm[kt] = *(const LAS f32x4*)(slot + CH_OFF_GM + 4 * (16 * kt + 4 * qp));
    }
}
__device__ __forceinline__ f32x4 chain_math(const ChainFrag& F, f32x4 (&ST)[4]) {
    const f32x4 z4 = (f32x4){0.f, 0.f, 0.f, 0.f};
    const f32x4 tlv = __builtin_amdgcn_mfma_f32_16x16x32_bf16(__builtin_bit_cast(bf16x8_t, F.tl), mk_frag(F.vq4, F.vq4), z4, 0, 0, 0);
    bf16x8_t sb[2];
#pragma unroll
    for (int ks = 0; ks < 2; ++ks) sb[ks] = mk_frag(pk4(ST[2 * ks][0], ST[2 * ks][1], ST[2 * ks][2], ST[2 * ks][3]), pk4(ST[2 * ks + 1][0], ST[2 * ks + 1][1], ST[2 * ks + 1][2], ST[2 * ks + 1][3]));
    const f32x4 u1 = __builtin_amdgcn_mfma_f32_16x16x32_bf16(__builtin_bit_cast(bf16x8_t, F.aa0), sb[0], z4, 0, 0, 0);
    const f32x4 u2 = __builtin_amdgcn_mfma_f32_16x16x32_bf16(__builtin_bit_cast(bf16x8_t, F.aa1), sb[1], tlv, 0, 0, 0);
    f32x4 Y = __builtin_amdgcn_mfma_f32_16x16x32_bf16(__builtin_bit_cast(bf16x8_t, F.ra0), sb[0], z4, 0, 0, 0);
    const f32x4 y2 = __builtin_amdgcn_mfma_f32_16x16x32_bf16(__builtin_bit_cast(bf16x8_t, F.ra1), sb[1], z4, 0, 0, 0);
    const f32x4 U = u1 + u2;
    const bf16x8_t uv = mk_frag(pk4(U[0], U[1], U[2], U[3]), F.vq4);
#pragma unroll
    for (int kt = 0; kt < 4; ++kt) {
        ST[kt] = __builtin_amdgcn_mfma_f32_16x16x32_bf16(mk_frag(F.b4[kt], F.k4[kt]), uv, ST[kt], 0, 0, 0);
        ST[kt] = ST[kt] * F.gm[kt];
    }
    Y = __builtin_amdgcn_mfma_f32_16x16x32_bf16(__builtin_bit_cast(bf16x8_t, F.mc), uv, Y, 0, 0, 0);
    return Y + y2;
}
struct ChainFrag2 { u32x4 aa0, aa1, ra0, ra1, mc, tl; u32x2 va, vb, b4[4], k4[4]; f32x4 gm[4]; };
__device__ __forceinline__ void chain_fetch2(LAS unsigned char* slot, int vq0, int lane, ChainFrag2& F) {
    const int i16 = lane & 15, qp = lane >> 4;
    const int troff = (4 * qp + (i16 >> 2)) * CH_TP + 8 * (i16 & 3);
    { const u32x2 t2 = *(const LAS u32x2*)(slot + CH_OFF_TL + lane * 8); F.tl = (u32x4){t2.x, t2.y, 0u, 0u}; }
    F.va = tr_read4(slot + CH_OFF_VT + troff + 32 * vq0); F.vb = tr_read4(slot + CH_OFF_VT + troff + 32 * (vq0 + 1));
    F.aa0 = *(const LAS u32x4*)(slot + CH_OFF_AA + lane * 16); F.aa1 = *(const LAS u32x4*)(slot + CH_OFF_AA + 1024 + lane * 16);
    F.ra0 = *(const LAS u32x4*)(slot + CH_OFF_RA + lane * 16); F.ra1 = *(const LAS u32x4*)(slot + CH_OFF_RA + 1024 + lane * 16);
    F.mc = *(const LAS u32x4*)(slot + CH_OFF_MC + lane * 16);
#pragma unroll
    for (int kt = 0; kt < 4; ++kt) {
        F.b4[kt] = tr_read4(slot + CH_OFF_BT + troff + 32 * kt); F.k4[kt] = tr_read4(slot + CH_OFF_KT + troff + 32 * kt);
        F.gm[kt] = *(const LAS f32x4*)(slot + CH_OFF_GM + 4 * (16 * kt + 4 * qp));
    }
}
__device__ __forceinline__ void chain_math2(const ChainFrag2& F, f32x4 (&SA)[4], f32x4 (&SB)[4], f32x4& YA, f32x4& YB) {
    const f32x4 z4 = (f32x4){0.f, 0.f, 0.f, 0.f};
    const bf16x8_t tl = __builtin_bit_cast(bf16x8_t, F.tl), aa0 = __builtin_bit_cast(bf16x8_t, F.aa0), aa1 = __builtin_bit_cast(bf16x8_t, F.aa1),
                   ra0 = __builtin_bit_cast(bf16x8_t, F.ra0), ra1 = __builtin_bit_cast(bf16x8_t, F.ra1), mc = __builtin_bit_cast(bf16x8_t, F.mc);
    const f32x4 tlva = __builtin_amdgcn_mfma_f32_16x16x32_bf16(tl, mk_frag(F.va, F.va), z4, 0, 0, 0);
    const f32x4 tlvb = __builtin_amdgcn_mfma_f32_16x16x32_bf16(tl, mk_frag(F.vb, F.vb), z4, 0, 0, 0);
    bf16x8_t sa[2], sb[2];
#pragma unroll
    for (int ks = 0; ks < 2; ++ks) {
        sa[ks] = mk_frag(pk4(SA[2 * ks][0], SA[2 * ks][1], SA[2 * ks][2], SA[2 * ks][3]), pk4(SA[2 * ks + 1][0], SA[2 * ks + 1][1], SA[2 * ks + 1][2], SA[2 * ks + 1][3]));
        sb[ks] = mk_frag(pk4(SB[2 * ks][0], SB[2 * ks][1], SB[2 * ks][2], SB[2 * ks][3]), pk4(SB[2 * ks + 1][0], SB[2 * ks + 1][1], SB[2 * ks + 1][2], SB[2 * ks + 1][3]));
    }
    const f32x4 ua1 = __builtin_amdgcn_mfma_f32_16x16x32_bf16(aa0, sa[0], z4, 0, 0, 0);
    const f32x4 ub1 = __builtin_amdgcn_mfma_f32_16x16x32_bf16(aa0, sb[0], z4, 0, 0, 0);
    const f32x4 ua2 = __builtin_amdgcn_mfma_f32_16x16x32_bf16(aa1, sa[1], tlva, 0, 0, 0);
    const f32x4 ub2 = __builtin_amdgcn_mfma_f32_16x16x32_bf16(aa1, sb[1], tlvb, 0, 0, 0);
    f32x4 ya = __builtin_amdgcn_mfma_f32_16x16x32_bf16(ra0, sa[0], z4, 0, 0, 0);
    f32x4 yb = __builtin_amdgcn_mfma_f32_16x16x32_bf16(ra0, sb[0], z4, 0, 0, 0);
    const f32x4 ya2 = __builtin_amdgcn_mfma_f32_16x16x32_bf16(ra1, sa[1], z4, 0, 0, 0);
    const f32x4 yb2 = __builtin_amdgcn_mfma_f32_16x16x32_bf16(ra1, sb[1], z4, 0, 0, 0);
    const f32x4 UA = ua1 + ua2, UB = ub1 + ub2;
    const bf16x8_t uva = mk_frag(pk4(UA[0], UA[1], UA[2], UA[3]), F.va), uvb = mk_frag(pk4(UB[0], UB[1], UB[2], UB[3]), F.vb);
#pragma unroll
    for (int kt = 0; kt < 4; ++kt) {
        const bf16x8_t bk = mk_frag(F.b4[kt], F.k4[kt]);
        SA[kt] = __builtin_amdgcn_mfma_f32_16x16x32_bf16(bk, uva, SA[kt], 0, 0, 0);
        SB[kt] = __builtin_amdgcn_mfma_f32_16x16x32_bf16(bk, uvb, SB[kt], 0, 0, 0);
    }
#pragma unroll
    for (int kt = 0; kt < 4; ++kt) { SA[kt] = SA[kt] * F.gm[kt]; SB[kt] = SB[kt] * F.gm[kt]; }
    ya = __builtin_amdgcn_mfma_f32_16x16x32_bf16(mc, uva, ya, 0, 0, 0);
    yb = __builtin_amdgcn_mfma_f32_16x16x32_bf16(mc, uvb, yb, 0, 0, 0);
    YA = ya + ya2; YB = yb + yb2;
}
__device__ __forceinline__ f32x4 chain_step(LAS unsigned char* slot, f32x4 (&ST)[4], int vq, int lane) { ChainFrag F; chain_fetch(slot, vq, lane, F); return chain_math(F, ST); }

constexpr int N_CH_P = MP / 16 * 16, N_CH_S = DBATCH * 16, N_CH = N_CH_P + N_CH_S;
static_assert(WS_CB + (size_t)N_CH * CH_SLOT <= (size_t)861000000, "chunk buffer fits the workspace");
constexpr int CH_VEC = CH_SLOT / 16;
__device__ __forceinline__ void slot_to_global(const LAS unsigned char* slot, unsigned char* g, int lane) {
#pragma unroll
    for (int i = 0; i < 13; ++i) { const int v = i * 64 + lane; if (v < CH_VEC) *(u32x4*)(g + (size_t)v * 16) = *(const LAS u32x4*)(slot + v * 16); }
}
struct SlotRegs { u32x4 v[13]; };
__device__ __forceinline__ void slot_load(const unsigned char* g, int lane, SlotRegs& S) {
    asm volatile("" : "+v"(lane));
#pragma unroll
    for (int i = 0; i < 13; ++i) { const int v = i * 64 + lane; S.v[i] = *(const u32x4*)(g + (size_t)(v < CH_VEC ? v : 0) * 16); }
}
__device__ __forceinline__ void slot_store(LAS unsigned char* slot, int lane, const SlotRegs& S) {
    asm volatile("" : "+v"(lane));
#pragma unroll
    for (int i = 0; i < 13; ++i) { const int v = i * 64 + lane; if (v < CH_VEC) *(LAS u32x4*)(slot + v * 16) = S.v[i]; }
}
__device__ __forceinline__ void phase_c1(const Args& a, int L, LAS unsigned char* lds) {
    const int tid = threadIdx.x, lane = tid & 63, wv = __builtin_amdgcn_readfirstlane(tid >> 6);
    LAS unsigned char* slot = lds + wv * CH_SLOT; LAS unsigned char* par = lds + CH_PAR_OFF + wv * CH_PAR_BYTES;
    unsigned char* CB = a.ws + WS_CB;
    rglru_prefix(a);
    const int stride = gridDim.x * NWAVES;
    auto item = [&](int ci, size_t& m0, int& ntok, bool& ss, const float*& sh0) {
        sh0 = nullptr;
        if (ci < N_CH_P) { const int chunk = ci >> 4; m0 = (size_t)chunk * 16; ntok = 16; ss = (chunk & (SEQ / 16 - 1)) == 0; }
        else { const int b = (ci - N_CH_P) >> 4; m0 = (size_t)MP + (size_t)b * DSEQ; ntok = DSEQ; ss = true; sh0 = a.in[6] + ((size_t)L * DBATCH + b) * SHIFT_W; }
    };
    auto fetch = [&](int ci, ChunkRaw& R) { size_t m0; int ntok; bool ss; const float* sh0; item(ci, m0, ntok, ss, sh0); chunk_load(a, m0, ci & 15, ntok, lane, R); };
    int ci = blockIdx.x * NWAVES + wv;
    ChunkRaw R;
    if (ci < N_CH) fetch(ci, R);
    for (; ci < N_CH; ci += stride) {
        const int h = ci & 15; size_t m0; int ntok; bool ss; const float* sh0; item(ci, m0, ntok, ss, sh0);
        stage_head_params(a, L, h, par, lane);
        LDSW();
        chunk_compute(a, R, m0, h, ntok, ss, sh0, par, slot, lane, [&]() { if (ci + stride < N_CH) fetch(ci + stride, R); });
        LDSW();
        const size_t sid = ci < N_CH_P ? ((size_t)((ci >> 4) >> 9) * 16 + h) * (SEQ / 16) + ((ci >> 4) & (SEQ / 16 - 1)) : (size_t)ci;
        slot_to_global(slot, CB + sid * CH_SLOT, lane);
        LDSW();
    }
}

#define WG_BAR() do { asm volatile("s_waitcnt lgkmcnt(0)" ::: "memory"); __builtin_amdgcn_s_barrier(); asm volatile("" ::: "memory"); } while (0)
template <int DRY> __device__ __forceinline__ void wkv_prompt_chain(const Args& a, int L, int b, int h, LAS unsigned char* lds) {
    const int tid = threadIdx.x, lane = tid & 63, wv = __builtin_amdgcn_readfirstlane(tid >> 6), i16 = lane & 15, qp = lane >> 4;
    bf16_t* Y = (bf16_t*)(a.ws + WS_Y);
    const unsigned char* CB = a.ws + WS_CB;
    constexpr int NR = SEQ / 64;
    const size_t ci0 = ((size_t)b * 16 + h) * (SEQ / 16);
    if (wv >= 2) {
        const int lw = wv - 2;
        constexpr int GV = 4 * CH_SLOT / 16;
        struct GrpRegs { u32x4 v[9]; };
        auto grp_load = [&](const unsigned char* gsrc, GrpRegs& S) {
#pragma unroll
            for (int i = 0; i < 9; ++i) { const int q = lw * 64 + lane + 384 * i; S.v[i] = *(const u32x4*)(gsrc + (size_t)(q < GV ? q : 0) * 16); }
        };
        auto grp_store = [&](LAS unsigned char* ldst, const GrpRegs& S) {
#pragma unroll
            for (int i = 0; i < 9; ++i) { const int q = lw * 64 + lane + 384 * i; if (q < GV) *(LAS u32x4*)(ldst + q * 16) = S.v[i]; }
        };
        GrpRegs S0, S1, S2, S3;
#define CB_GROUP(k) (CB + (ci0 + (size_t)(4 * (k))) * CH_SLOT)
        grp_load(CB_GROUP(0), S0);
        grp_store(lds, S0);
        grp_load(CB_GROUP(1), S1); grp_load(CB_GROUP(2), S2); grp_load(CB_GROUP(3), S3); grp_load(CB_GROUP(4), S0);
        WG_BAR();
        for (int g = 0; g < NR; g += 4) {
#define LROUND(r, SET) do { if (DRY != 2) if ((r) + 1 < NR) grp_store(lds + (((r) + 1) & 1) * 4 * CH_SLOT, SET); if (DRY != 2) if ((r) + 5 < NR) grp_load(CB_GROUP((r) + 5), SET); WG_BAR(); } while (0)
            LROUND(g, S1); LROUND(g + 1, S2); LROUND(g + 2, S3); LROUND(g + 3, S0);
#undef LROUND
        }
#undef CB_GROUP
    } else if (wv < 2) {
        f32x4 SA[4], SB[4];
#pragma unroll
        for (int kt = 0; kt < 4; ++kt) { SA[kt] = (f32x4){0.f, 0.f, 0.f, 0.f}; SB[kt] = SA[kt]; }
        WG_BAR();
        bf16_t* yrow = Y + ((size_t)b * SEQ) * D + 64 * h + 32 * wv;
        for (int g = 0; g < NR; ++g) {
            LAS unsigned char* gs = lds + (g & 1) * 4 * CH_SLOT;
            ChainFrag2 FA, FB;
            f32x4 ya[4], yb[4];
#define SB0() __builtin_amdgcn_sched_barrier(0)
            if (DRY == 3) { WG_BAR(); continue; }
            chain_fetch2(gs, 2 * wv, lane, FA);
            chain_fetch2(gs + CH_SLOT, 2 * wv, lane, FB); SB0();
            chain_math2(FA, SA, SB, ya[0], yb[0]); SB0();
            chain_fetch2(gs + 2 * CH_SLOT, 2 * wv, lane, FA); SB0();
            chain_math2(FB, SA, SB, ya[1], yb[1]); SB0();
            chain_fetch2(gs + 3 * CH_SLOT, 2 * wv, lane, FB); SB0();
            chain_math2(FA, SA, SB, ya[2], yb[2]); SB0();
            chain_math2(FB, SA, SB, ya[3], yb[3]); SB0();
#undef SB0
            {
                LAS unsigned char* yt = lds + CH_PAR_OFF + wv * 4608;
#pragma unroll
                for (int j = 0; j < 4; ++j)
#pragma unroll
                    for (int r = 0; r < 4; ++r) {
                        *(LAS unsigned short*)(yt + (16 * j + 4 * qp + r) * 72 + 2 * i16) = f2bf(ya[j][r]);
                        *(LAS unsigned short*)(yt + (16 * j + 4 * qp + r) * 72 + 2 * (16 + i16)) = f2bf(yb[j][r]);
                    }
                LDSW();
#pragma unroll
                for (int j = 0; j < 4; ++j) {
                    const int row = 16 * j + (lane >> 2), pc = lane & 3;
                    const u32x2 lo = *(const LAS u32x2*)(yt + row * 72 + pc * 16), hi = *(const LAS u32x2*)(yt + row * 72 + pc * 16 + 8);
                    if (DRY == 0) *(u32x4*)(yrow + (size_t)row * D + 8 * pc) = (u32x4){lo.x, lo.y, hi.x, hi.y};
                    else asm volatile("" :: "v"(lo), "v"(hi));
                }
                LDSW();
            }
            yrow += (size_t)64 * D;
            WG_BAR();
        }
        float* o = a.out + O_PWKV + ((((size_t)L * NBATCH + b) * 16 + h) * 64 + 32 * wv + i16) * 64;
#pragma unroll
        for (int kt = 0; kt < 4; ++kt) { if (DRY == 0) { *(f32x4*)(o + 16 * kt + 4 * qp) = SA[kt]; *(f32x4*)(o + 16 * 64 + 16 * kt + 4 * qp) = SB[kt]; } else asm volatile("" :: "v"(SA[kt]), "v"(SB[kt])); }
    }
    __syncthreads();
}
#undef WG_BAR
__device__ __forceinline__ void wkv_sample_chain(const Args& a, int L, int b, int ho, LAS unsigned char* lds) {
    const int tid = threadIdx.x, lane = tid & 63, wv = __builtin_amdgcn_readfirstlane(tid >> 6), i16 = lane & 15, qp = lane >> 4;
    const int h = 8 * ho + wv;
    bf16_t* Y = (bf16_t*)(a.ws + WS_Y);
    LAS unsigned char* slot = lds + wv * CH_SLOT;
    const size_t m0 = (size_t)MP + (size_t)b * DSEQ;
    { SlotRegs S; slot_load(a.ws + WS_CB + ((size_t)N_CH_P + (size_t)b * 16 + h) * CH_SLOT, lane, S); slot_store(slot, lane, S); }
    LDSW();
    for (int vp = 0; vp < 2; ++vp) {
        const size_t so = ((((size_t)L * DBATCH + b) * 16 + h) * 64 + 32 * vp + i16) * 64;
        f32x4 SA[4], SB[4];
#pragma unroll
        for (int kt = 0; kt < 4; ++kt) { SA[kt] = *(const f32x4*)(a.in[7] + so + 16 * kt + 4 * qp); SB[kt] = *(const f32x4*)(a.in[7] + so + 16 * 64 + 16 * kt + 4 * qp); }
        ChainFrag2 F; chain_fetch2(slot, 2 * vp, lane, F);
        f32x4 ya, yb; chain_math2(F, SA, SB, ya, yb);
#pragma unroll
        for (int r = 0; r < 4; ++r) if (4 * qp + r < DSEQ) { Y[(m0 + 4 * qp + r) * D + 64 * h + 32 * vp + i16] = f2bf(ya[r]); Y[(m0 + 4 * qp + r) * D + 64 * h + 32 * vp + 16 + i16] = f2bf(yb[r]); }
#pragma unroll
        for (int kt = 0; kt < 4; ++kt) { *(f32x4*)(a.out + O_SWKV + so + 16 * kt + 4 * qp) = SA[kt]; *(f32x4*)(a.out + O_SWKV + so + 16 * 64 + 16 * kt + 4 * qp) = SB[kt]; }
    }
    __syncthreads();
}

#ifndef PROBE_MIXB
#define PROBE_MIXB 0
#endif
__device__ __forceinline__ void phase_mixb2(const Args& a, int L, LAS unsigned char* lds) {
    constexpr int N_PC = NBATCH * 16;
    const int G = gridDim.x, bx = blockIdx.x;
    const int first_other = (G > 2 * N_PC) ? N_PC : 0;
    for (int it = bx; it < N_PC; it += G) wkv_prompt_chain<0>(a, L, it >> 4, it & 15, lds);
    if (PROBE_MIXB & 1) for (int it = bx; it < N_PC; it += G) wkv_prompt_chain<0>(a, L, it >> 4, it & 15, lds);
    if (PROBE_MIXB & 8) for (int it = bx; it < N_PC; it += G) wkv_prompt_chain<1>(a, L, it >> 4, it & 15, lds);
    if (PROBE_MIXB & 16) for (int it = bx; it < N_PC; it += G) wkv_prompt_chain<2>(a, L, it >> 4, it & 15, lds);
    if (PROBE_MIXB & 32) for (int it = bx; it < N_PC; it += G) wkv_prompt_chain<3>(a, L, it >> 4, it & 15, lds);
    if (bx < first_other) return;
    const int nb = G - first_other, id = bx - first_other;
    constexpr int N_RG2 = M / 64, N_SC = DBATCH * 2;
    phase_state_copies(a, L, first_other);
    for (int it = id; it < N_RG2; it += nb) { rglru_unit2<true>(a, L, it, lds); __syncthreads(); }
    if (PROBE_MIXB & 4) for (int it = id; it < N_RG2; it += nb) { rglru_unit2<true>(a, L, it, lds); __syncthreads(); }
    {
        const int second = (N_RG2 > nb) ? N_RG2 - nb : 0;
        const int start = id >= second ? id - second : id + (nb - second);
        for (int it = start; it < N_SC; it += nb) wkv_sample_chain(a, L, it >> 1, it & 1, lds);
        if (PROBE_MIXB & 2) for (int it = start; it < N_SC; it += nb) wkv_sample_chain(a, L, it >> 1, it & 1, lds);
    }
}
#ifndef PROBE_MASK
#define PROBE_MASK 0
#endif
#define PH_IN(k) (lo <= (k) && (k) < hi)
#define RUN_PHASE(po, ...) do { { __VA_ARGS__ } if (((PROBE_MASK >> (po)) & 1) && PH_IN(base + (po))) { xcd_barrier(bar); { __VA_ARGS__ } } } while (0)
#define PH_SYNC(k) do { if (lo < (k) && (k) < hi) xcd_barrier(bar); } while (0)
template <int L> __device__ __forceinline__ void layer_phases(const Args& a, LAS unsigned char* lds, int lo, int hi, const XcdBarrier& bar) {
    unsigned char* ws = a.ws;
    const int G = gridDim.x;
    constexpr int base = PH_L0 + L * PH_PER_LAYER;
    if (L > 0) PH_SYNC(base + PHO_IN);
    RUN_PHASE(PHO_IN, if (PH_IN(base + PHO_IN)) {
        pg8::Gemm g{(const bf16_t*)(ws + WS_XB), (const bf16_t*)(ws + WS_WIN), M, NP, D}; pg8::StaticOrder S; S.init(M, NP, G, (int)blockIdx.x);
        EpiIn E{(bf16_t*)(ws + WS_P), NP, CG / 256};
        pg8::gemm_phase<EpiIn, pg8::StaticOrder, true, true>(lds, g, S, E);
    });
    PH_SYNC(base + PHO_MIXA);
    RUN_PHASE(PHO_MIXA, if (PH_IN(base + PHO_MIXA)) phase_mixa(a, L, lds););
    PH_SYNC(base + PHO_LORA);
    RUN_PHASE(PHO_LORA, if (PH_IN(base + PHO_LORA)) {
        pg8::Gemm g{(const bf16_t*)(ws + WS_ACAT), (const bf16_t*)(ws + WS_WLORA), M, 3072, ACAT_K}; pg8::StaticOrder S; S.init(M, 3072, G, (int)blockIdx.x);
        EpiLora E{(bf16_t*)(ws + WS_WAW), (bf16_t*)(ws + WS_WAA), (bf16_t*)(ws + WS_WAG), a.in[18] + L * D, a.in[20] + L * D};
        pg8::gemm_phase<EpiLora, pg8::StaticOrder, true, true>(lds, g, S, E);
    });
    PH_SYNC(base + PHO_C1);
    RUN_PHASE(PHO_C1, if (PH_IN(base + PHO_C1)) phase_c1(a, L, lds););
    PH_SYNC(base + PHO_MIXB);
    RUN_PHASE(PHO_MIXB, if (PH_IN(base + PHO_MIXB)) phase_mixb2(a, L, lds););
    PH_SYNC(base + PHO_MIXC);
    if (PH_IN(base + PHO_MIXC)) {
#if defined(PROBE_MIXC)
        phase_mixc(a, L, (bf16_t*)(ws + WS_CB)); xcd_barrier(bar);
#endif
        phase_mixc(a, L, (bf16_t*)(ws + WS_OA));
    }
    PH_SYNC(base + PHO_OUT);
    RUN_PHASE(PHO_OUT, if (PH_IN(base + PHO_OUT)) {
        {
            pg8::Gemm g{(const bf16_t*)(ws + WS_MIX), (const bf16_t*)(ws + WS_WOUT), MP, D, D}; pg8::StaticOrder S; S.init(MP, D, G, (int)blockIdx.x);
            if (L == 0) { EpiZ<false> E{a.in[0], (float*)(ws + WS_Z), D}; pg8::gemm_phase<EpiZ<false>, pg8::StaticOrder, true, true>(lds, g, S, E); }
            else { EpiZ<true> E{ws + WS_XB, (float*)(ws + WS_Z), D}; pg8::gemm_phase<EpiZ<true>, pg8::StaticOrder, true, true>(lds, g, S, E); }
        }
        {
            pg8::Gemm g{(const bf16_t*)(ws + WS_MIX) + (size_t)MP * D, (const bf16_t*)(ws + WS_WOUTS), MS, 4 * D, 256, D, 256, 4, (size_t)512}; pg8::StaticOrder S; S.init(MS, 4 * D, G, (int)blockIdx.x);
            if (L == 0) { EpiZS<false> E{a.in[1], (float*)(ws + WS_ZS), D}; pg8::gemm_phase<EpiZS<false>, pg8::StaticOrder, true, true>(lds, g, S, E); }
            else { EpiZS<true> E{ws + WS_XB + (size_t)MP * D * 2, (float*)(ws + WS_ZS), D}; pg8::gemm_phase<EpiZS<true>, pg8::StaticOrder, true, true>(lds, g, S, E); }
        }
    });
    PH_SYNC(base + PHO_LN1);
    RUN_PHASE(PHO_LN1, if (PH_IN(base + PHO_LN1)) phase_ln<4>((const float*)(ws + WS_Z), (const float*)(ws + WS_ZS), a.in[29] + L * D, a.in[30] + L * D, nullptr, (bf16_t*)(ws + WS_X1B)););
    PH_SYNC(base + PHO_GU);
    RUN_PHASE(PHO_GU, if (PH_IN(base + PHO_GU)) {
        pg8::Gemm g{(const bf16_t*)(ws + WS_X1B), (const bf16_t*)(ws + WS_WGU), M, 2 * DFF, D}; pg8::StaticOrder S; S.init(M, 2 * DFF, G, (int)blockIdx.x);
        EpiSwiGLU E{(bf16_t*)(ws + WS_H), DFF};
        pg8::gemm_phase<EpiSwiGLU, pg8::StaticOrder, true, true>(lds, g, S, E);
    });
    PH_SYNC(base + PHO_DOWN);
    RUN_PHASE(PHO_DOWN, if (PH_IN(base + PHO_DOWN)) {
        {
            pg8::Gemm g{(const bf16_t*)(ws + WS_H), (const bf16_t*)(ws + WS_WDN), MP, D, DFF}; pg8::StaticOrder S; S.init(MP, D, G, (int)blockIdx.x);
            EpiZ<true> E{ws + WS_X1B, (float*)(ws + WS_Z), D};
            pg8::gemm_phase<EpiZ<true>, pg8::StaticOrder, true, true>(lds, g, S, E);
        }
        {
            pg8::Gemm g{(const bf16_t*)(ws + WS_H) + (size_t)MP * DFF, (const bf16_t*)(ws + WS_WDNS), MS, 11 * D, 256, DFF, 256, 4, (size_t)512}; pg8::StaticOrder S; S.init(MS, 11 * D, G, (int)blockIdx.x);
            EpiZS<true> E{ws + WS_X1B + (size_t)MP * D * 2, (float*)(ws + WS_ZS), D};
            pg8::gemm_phase<EpiZS<true>, pg8::StaticOrder, true, true>(lds, g, S, E);
        }
    });
    PH_SYNC(base + PHO_LN2);
    RUN_PHASE(PHO_LN2, if (PH_IN(base + PHO_LN2)) {
        if (L == DEPTH - 1) phase_ln<11>((const float*)(ws + WS_Z), (const float*)(ws + WS_ZS), a.in[33] + L * D, a.in[34] + L * D, a.out + O_YP, nullptr);
        else { phase_ln<11>((const float*)(ws + WS_Z), (const float*)(ws + WS_ZS), a.in[33] + L * D, a.in[34] + L * D, nullptr, (bf16_t*)(ws + WS_XB)); phase_prep_weights(a, L + 1, lds); }
    });
}
__global__ void __launch_bounds__(NTHREADS, 2) mega(Args a) {
    extern __shared__ __attribute__((aligned(16))) unsigned char lds_raw[];
    LAS unsigned char* lds = (LAS unsigned char*)lds_raw;
    const int lo = a.ph_lo, hi = a.ph_hi;
    volatile LAS unsigned* bst = (volatile LAS unsigned*)(lds + BAR_LDS_OFF);
    if (threadIdx.x < 4) bst[threadIdx.x] = 0u;
    __syncthreads();
    const XcdBarrier bar = xcd_barrier_post((unsigned*)(a.ws + WS_BAR), bst);
    if (PH_IN(PH_PREP)) { phase_prep_weights(a, 0, lds); phase_prep_x(a); }
    if (lo <= PH_PREP && PH_L0 < hi) cg::this_grid().sync();
    layer_phases<0>(a, lds, lo, hi, bar);
    layer_phases<1>(a, lds, lo, hi, bar);
}

static void launch_mega(Args a, int lo, int hi, int grid, hipStream_t s) {
    a.ph_lo = lo; a.ph_hi = hi;
    void* args[] = {&a};
    hipError_t e;
    if (hi - lo > 1) e = hipLaunchCooperativeKernel((void*)mega, dim3(grid), dim3(NTHREADS), args, LDS_BYTES, s);
    else e = hipLaunchKernel((void*)mega, dim3(grid), dim3(NTHREADS), args, LDS_BYTES, s);
    if (e != hipSuccess) fprintf(stderr, "mega launch [%d,%d) failed: %s (grid %d)\n", lo, hi, hipGetErrorString(e), grid);
}

extern "C" void kernel_launch(void* const* d_in, const int* in_sizes, int n_in, void* d_out, int out_size,
                              void* d_ws, size_t ws_size, hipStream_t stream) {
    if (ws_size < WS_END || out_size != (int)O_END || n_in != 35) { fprintf(stderr, "kernel_launch: unexpected sizes ws=%zu out=%d n_in=%d\n", ws_size, out_size, n_in); return; }
    static int grid = 0;
    if (!grid) {
        int dev = 0, cus = 0, per_cu = 0;
        (void)hipGetDevice(&dev);
        (void)hipDeviceGetAttribute(&cus, hipDeviceAttributeMultiprocessorCount, dev);
        (void)hipFuncSetAttribute((const void*)mega, hipFuncAttributeMaxDynamicSharedMemorySize, LDS_BYTES);
        (void)hipOccupancyMaxActiveBlocksPerMultiprocessor(&per_cu, (const void*)mega, NTHREADS, LDS_BYTES);
        if (per_cu < 1) { fprintf(stderr, "occupancy query says %d blocks per CU\n", per_cu); per_cu = 1; }
        grid = cus * per_cu;
    }
    const float* const* in = (const float* const*)d_in;
    unsigned char* ws = (unsigned char*)d_ws;
    float* out = (float*)d_out;
    Args a{};
    for (int i = 0; i < 35; ++i) a.in[i] = in[i];
    a.out = out; a.ws = ws;
    (void)hipMemsetAsync(ws + WS_BAR, 0, 16384, stream);
    launch_mega(a, 0, N_PHASES, grid, stream);
}
```

```cpp
#include <hip/hip_runtime.h>
#include <cstdint>
#include <cstdio>

typedef unsigned short bf16_t;
__device__ __forceinline__ float bf2f(bf16_t v) { return __uint_as_float(((unsigned)v) << 16); }
typedef float f32x2c_t __attribute__((ext_vector_type(2))); typedef __bf16 bf16x2c_t __attribute__((ext_vector_type(2)));
__device__ __forceinline__ bf16_t f2bf(float f) { f32x2c_t v = {f, f}; bf16x2c_t b = __builtin_convertvector(v, bf16x2c_t); return (bf16_t)(__builtin_bit_cast(unsigned, b) & 0xffffu); }
__device__ __forceinline__ float sigmoidf_(float x) { return __builtin_amdgcn_rcpf(1.f + __expf(-x)); }
__device__ __forceinline__ float softplusf_(float x) { return fmaxf(x, 0.f) + log1pf(__expf(-fabsf(x))); }
__device__ __forceinline__ float wave_sum(float v) {
#pragma unroll
    for (int o = 1; o < 64; o <<= 1) v += __shfl_xor(v, o);
    return v;
}

constexpr int D = 1024, MP = 16384, MS = 1024, M = MP + MS, SEQ = 8192, DSEQ = 8, NBATCH = 2, DBATCH = 128, DEPTH = 2;
constexpr int NP = 9216, IN_COLS = 8992;
constexpr int CQ = 0, CK = 1024, CV = 1280, CRNN = 1536, CRW = 2560, CG = 6144;
constexpr int SHIFT_W = 3360, DFF = 2816;
constexpr float ALPHA = 1.4142135623730951f;
constexpr float LN_EPS = 1e-5f, GN_EPS = 64e-5f;

constexpr size_t O_YP = 0, O_YS = 16777216, O_PK = 17825792, O_PV = 17956864, O_PCONV = 18087936, O_PH = 18100224,
                 O_PSHIFT = 18104320, O_PWKV = 18117760, O_SK = 18379904, O_SV = 26768512, O_SCONV = 35157120,
                 O_SH = 35943552, O_SSHIFT = 36205696, O_SWKV = 37065856, O_END = 53843072;


constexpr size_t MiB = 1u << 20;
constexpr size_t WS_CTL = 0;
constexpr size_t WIN_T_BYTES = (size_t)NP * D * 2, WOUT_T_BYTES = (size_t)D * D * 2, WGU_T_BYTES = (size_t)2 * DFF * D * 2, WDN_T_BYTES = (size_t)D * DFF * 2;
constexpr int ACAT_K = 384;
constexpr size_t WLORA_BYTES = (size_t)3072 * ACAT_K * 2;
constexpr size_t WS_WIN = 1 * MiB;
constexpr size_t WS_WOUT = WS_WIN + WIN_T_BYTES;
constexpr size_t WS_WGU = WS_WOUT + WOUT_T_BYTES;
constexpr size_t WS_WDN = WS_WGU + WGU_T_BYTES;
constexpr size_t WS_WOUTS = WS_WDN + WDN_T_BYTES;
constexpr size_t WS_WDNS = WS_WOUTS + WOUT_T_BYTES;
constexpr size_t WS_WLORA = WS_WDNS + WDN_T_BYTES;
constexpr size_t WS_XB = WS_WLORA + WLORA_BYTES;
constexpr size_t WS_OA = WS_XB + (size_t)M * D * 2;
constexpr size_t WS_MIX = WS_OA;
constexpr size_t WS_OB = WS_OA + (size_t)M * D * 2;
constexpr size_t WS_P = WS_OB + (size_t)M * D * 2;
constexpr size_t WS_Z = WS_P;
constexpr size_t WS_ZS = WS_Z + (size_t)M * D * 4;
constexpr size_t WS_X1B = WS_ZS + (size_t)11 * MS * D * 4;
constexpr size_t WS_H = WS_X1B + (size_t)M * D * 2;
constexpr size_t WS_PEND = WS_P + (size_t)M * NP * 2;
constexpr size_t WS_RS = WS_PEND;
constexpr size_t WS_WAW = WS_RS + (size_t)2 * 128 * 1024 * 2 * 4;
constexpr size_t WS_WAA = WS_WAW + (size_t)M * D * 2;
constexpr size_t WS_WAG = WS_WAA + (size_t)M * D * 2;
constexpr size_t WS_Y = WS_WAG + (size_t)M * D * 2;
constexpr size_t WS_BD = WS_Y + (size_t)M * D * 2;
constexpr size_t WS_ACAT = WS_BD + (size_t)M * 16 * 4;
constexpr size_t WS_CB = WS_ACAT;
constexpr size_t WS_END = WS_ACAT + (size_t)M * ACAT_K * 2;
static_assert(WS_END <= (size_t)861000000, "workspace budget (4 x output bytes = 861.5 MB)");
static_assert(WS_H + (size_t)M * DFF * 2 <= WS_PEND, "overlay fits");
static_assert(WS_WAA == WS_WAW + (size_t)M * D * 2 && WS_WAG == WS_WAA + (size_t)M * D * 2, "lora outputs contiguous");
static_assert(WS_XB % 256 == 0 && WS_P % 256 == 0 && WS_WLORA % 256 == 0 && WS_ACAT % 256 == 0, "alignment");
namespace pg8 {
#define PG8_LAS __attribute__((address_space(3)))
typedef unsigned short bf16_t;
typedef short bf16x8 __attribute__((ext_vector_type(8)));
typedef float f32x4 __attribute__((ext_vector_type(4)));
typedef unsigned u32x4 __attribute__((ext_vector_type(4)));
constexpr int BM = 256, BK = 64, HALF = 128, HTB = HALF * BK * 2  , STAGE_BYTES = 8 * HTB, NXCD = 8, WGM = 8;

__host__ __device__ __forceinline__ int lds_byte(int r, int c) { const int st = (r >> 4) * 2 + (c >> 5), rr = r & 15, cc = c & 31, ob = rr * 64 + cc * 2; return st * 1024 + (ob ^ (((ob >> 9) & 1) << 5)); }
__host__ __device__ __forceinline__ void stage_rc(int b, int& R, int& C) { const int st = b / 1024, sb = b % 1024, swz = sb ^ (((sb >> 9) & 1) << 5); R = (st >> 1) * 16 + swz / 64; C = (st & 1) * 32 + (swz % 64) / 2; }
__host__ __device__ __forceinline__ int perm32(int rho) { const int n = rho >> 4, i = rho & 15; return 8 * (i >> 2) + 4 * n + (i & 3); }

struct Unit { int pm, pn; };
struct Gemm { const bf16_t* A; const bf16_t* Bt; int M, N, K; int lda = 0, ldb = 0, nsplit = 0; size_t a_koff = 0; };

struct StaticOrder {
    int nM, nN, nwg, G, c;
    __host__ __device__ void init(int M, int N, int G_, int c_) { nM = M / BM; nN = N / BM; nwg = nM * nN; G = G_; c = c_; }
    __host__ __device__ bool next(int i, Unit& u) const {
        const long L = (long)i * G + c; if (L >= nwg) return false;
        int wgid = (int)L; { const int q = nwg / NXCD, r = nwg % NXCD, xcd = wgid % NXCD, off = wgid / NXCD; wgid = (xcd < r ? xcd * (q + 1) : r * (q + 1) + (xcd - r) * q) + off; }
        const int nig = WGM * nN, gid = wgid / nig, fm = gid * WGM, gsz = (nM - fm) < WGM ? (nM - fm) : WGM;
        u.pm = fm + ((wgid % nig) % gsz); u.pn = (wgid % nig) / gsz; return true;
    }
    __device__ __forceinline__ void a_ready(const Unit&) const {}
    __device__ __forceinline__ void done(const Unit&) const {}
};

__device__ __forceinline__ unsigned cvt_pk_bf16(float lo, float hi) { unsigned r; asm volatile("v_cvt_pk_bf16_f32 %0, %1, %2" : "=v"(r) : "v"(lo), "v"(hi)); return r; }
typedef float f32x2 __attribute__((ext_vector_type(2)));
template <class Epi, class Sched, bool ALIGN_EPI = false, bool SP2 = false>
__device__ __forceinline__ void gemm_phase(PG8_LAS unsigned char* lds, const Gemm g, const Sched& S, const Epi& E) {
    const int tid = threadIdx.x, wid = __builtin_amdgcn_readfirstlane(tid >> 6), lane = tid & 63, wr = wid >> 2, wc = wid & 3, fr = lane & 15, fq = lane >> 4;
    const int K = g.K, nt = K / BK, lda = g.lda ? g.lda : K, ldb = g.ldb ? g.ldb : K;
    unsigned voffA[2], voffB[2];
#pragma unroll
    for (int i = 0; i < 2; ++i) { int R, C; stage_rc(tid * 16 + i * 8192, R, C); const int Rb = Epi::PERM ? ((R & ~31) + perm32(R & 31)) : R;
        voffA[i] = (unsigned)(R * lda + C) * 2u; voffB[i] = (unsigned)(Rb * ldb + C) * 2u; }
    const size_t kstep = (size_t)(BK * 2);
    const size_t hstepA = (size_t)HALF * lda * 2, hstepB = (size_t)HALF * ldb * 2;
    const size_t tstepA = 2 * hstepA, tstepB = 2 * hstepB;
#define PG8_ABASE(u) ((const char*)g.A + (size_t)(u).pm * tstepA + (g.nsplit ? (size_t)((u).pn / g.nsplit) * g.a_koff : (size_t)0))
    const unsigned ldsw = (unsigned)wid * 1024u;
    const int aoff = lds_byte(wr * 64 + fr, fq * 8), boff = lds_byte(wc * 32 + fr, fq * 8);
#define PG8_SA(b, h) (((b) * 2 + (h)) * HTB)
#define PG8_SB(b, h) ((4 + (b) * 2 + (h)) * HTB)
#define PG8_STAGE(bufoff, gbase, voff) do { _Pragma("unroll") for (int _i = 0; _i < 2; ++_i) \
        __builtin_amdgcn_global_load_lds((const unsigned*)((const char*)(gbase) + (voff)[_i]), (PG8_LAS unsigned*)(lds + (bufoff) + ldsw + _i * 8192), 16, 0, 0); } while (0)
#define PG8_LDA(dst, b, h) do { _Pragma("unroll") for (int m = 0; m < 4; ++m) _Pragma("unroll") for (int k = 0; k < 2; ++k) dst[m][k] = *(const PG8_LAS bf16x8*)(lds + PG8_SA(b, h) + aoff + m * 2048 + k * 1024); } while (0)
#define PG8_LDB(dst, b, h) do { _Pragma("unroll") for (int n = 0; n < 2; ++n) _Pragma("unroll") for (int k = 0; k < 2; ++k) dst[n][k] = *(const PG8_LAS bf16x8*)(lds + PG8_SB(b, h) + boff + n * 2048 + k * 1024); } while (0)
#define PG8_MMA(ai, bj, At, Bt) do { __builtin_amdgcn_s_setprio(1); _Pragma("unroll") for (int m = 0; m < 4; ++m) _Pragma("unroll") for (int n = 0; n < 2; ++n) _Pragma("unroll") for (int k = 0; k < 2; ++k) \
        acc[ai][bj][m][n] = __builtin_amdgcn_mfma_f32_16x16x32_bf16(Bt[n][k], At[m][k], acc[ai][bj][m][n], 0, 0, 0); __builtin_amdgcn_s_setprio(0); } while (0)
#define PG8_WAIT_V(n) asm volatile("s_waitcnt vmcnt(" #n ")" ::: "memory")
#define PG8_WAIT_L(n) asm volatile("s_waitcnt lgkmcnt(" #n ")" ::: "memory")
#define PG8_BAR __builtin_amdgcn_s_barrier()
#define PG8_SCHED __builtin_amdgcn_sched_barrier(0)
    Unit cur, nxt; int ui = 0;
    if (!S.next(0, cur)) return;
    f32x4 acc[2][2][4][2];
#pragma unroll
    for (int a = 0; a < 2; ++a)
#pragma unroll
        for (int b = 0; b < 2; ++b)
#pragma unroll
            for (int m = 0; m < 4; ++m)
#pragma unroll
                for (int n = 0; n < 2; ++n) acc[a][b][m][n] = (f32x4){0.f, 0.f, 0.f, 0.f};
    bf16x8 At[4][2], B0[2][2], B1[2][2];
    const char* cA = PG8_ABASE(cur); const char* cB = (const char*)g.Bt + (size_t)cur.pn * tstepB;
    S.a_ready(cur);
    if constexpr (SP2) {
        PG8_STAGE(PG8_SB(0, 0), cB, voffB); PG8_STAGE(PG8_SB(0, 1), cB + hstepB, voffB); PG8_STAGE(PG8_SA(0, 0), cA, voffA); PG8_STAGE(PG8_SA(0, 1), cA + hstepA, voffA);
        if (wr == 1) PG8_BAR;
        PG8_WAIT_V(2); PG8_BAR;
        PG8_STAGE(PG8_SB(1, 0), cB + kstep, voffB); PG8_STAGE(PG8_SA(1, 0), cA + kstep, voffA); PG8_STAGE(PG8_SB(1, 1), cB + hstepB + kstep, voffB);
        PG8_WAIT_V(6); PG8_BAR;
    } else {
        PG8_STAGE(PG8_SB(0, 0), cB, voffB); PG8_STAGE(PG8_SA(0, 0), cA, voffA); PG8_STAGE(PG8_SB(0, 1), cB + hstepB, voffB); PG8_STAGE(PG8_SA(0, 1), cA + hstepA, voffA);
        if (wr == 1) PG8_BAR;
        PG8_WAIT_V(4); PG8_BAR;
        PG8_STAGE(PG8_SB(1, 0), cB + kstep, voffB); PG8_STAGE(PG8_SA(1, 0), cA + kstep, voffA); PG8_STAGE(PG8_SB(1, 1), cB + hstepB + kstep, voffB);
        PG8_WAIT_V(6); PG8_BAR;
    }
    for (;;) {
        const bool has_next = S.next(ui + 1, nxt);
        const char* nA = has_next ? PG8_ABASE(nxt) : cA; const char* nB = has_next ? (const char*)g.Bt + (size_t)nxt.pn * tstepB : cB;
#pragma nounroll
        for (int t = 0; t < nt; t += 2) {
            const bool last = (t == nt - 2);
            const char* a1 = cA + (size_t)(t + 1) * kstep;
            const char* a2 = last ? nA : cA + (size_t)(t + 2) * kstep; const char* b2 = last ? nB : cB + (size_t)(t + 2) * kstep;
            const char* a3 = a2 + kstep; const char* b3 = b2 + kstep;
            if (last && has_next) S.a_ready(nxt);
            if constexpr (SP2) {
            PG8_LDB(B0, 0, 0); PG8_LDB(B1, 0, 1); PG8_SCHED; PG8_LDA(At, 0, 0); PG8_STAGE(PG8_SA(1, 1), a1 + hstepA, voffA);
            PG8_WAIT_V(8); PG8_WAIT_L(0); PG8_BAR; PG8_MMA(0, 0, At, B0); PG8_MMA(0, 1, At, B1); PG8_BAR; PG8_SCHED;
            PG8_LDA(At, 0, 1); PG8_STAGE(PG8_SB(0, 0), b2, voffB); PG8_STAGE(PG8_SB(0, 1), b2 + hstepB, voffB); PG8_STAGE(PG8_SA(0, 0), a2, voffA);
            PG8_WAIT_V(8); PG8_WAIT_L(0); PG8_BAR; PG8_MMA(1, 0, At, B0); PG8_MMA(1, 1, At, B1); PG8_BAR; PG8_SCHED;
            PG8_LDB(B0, 1, 0); PG8_LDB(B1, 1, 1); PG8_SCHED; PG8_LDA(At, 1, 0); PG8_STAGE(PG8_SA(0, 1), a2 + hstepA, voffA);
            PG8_WAIT_V(8); PG8_WAIT_L(0); PG8_BAR; PG8_MMA(0, 0, At, B0); PG8_MMA(0, 1, At, B1); PG8_BAR; PG8_SCHED;
            PG8_LDA(At, 1, 1); PG8_STAGE(PG8_SB(1, 0), b3, voffB); PG8_STAGE(PG8_SB(1, 1), b3 + hstepB, voffB); PG8_STAGE(PG8_SA(1, 0), a3, voffA);
            PG8_WAIT_V(8); PG8_WAIT_L(0); PG8_BAR; PG8_MMA(1, 0, At, B0); PG8_MMA(1, 1, At, B1); PG8_BAR; PG8_SCHED;
            } else {
            PG8_LDB(B0, 0, 0); PG8_SCHED; PG8_LDA(At, 0, 0); PG8_STAGE(PG8_SA(1, 1), a1 + hstepA, voffA);
            PG8_WAIT_L(8); PG8_BAR; PG8_WAIT_L(0); PG8_MMA(0, 0, At, B0); PG8_BAR; PG8_SCHED;
            PG8_LDB(B1, 0, 1); PG8_STAGE(PG8_SB(0, 0), b2, voffB);
            PG8_BAR; PG8_WAIT_L(0); PG8_MMA(0, 1, At, B1); PG8_BAR;
            PG8_LDA(At, 0, 1); PG8_STAGE(PG8_SA(0, 0), a2, voffA);
            PG8_BAR; PG8_WAIT_L(0); PG8_MMA(1, 0, At, B0); PG8_BAR; PG8_SCHED;
            PG8_STAGE(PG8_SB(0, 1), b2 + hstepB, voffB);
            PG8_WAIT_V(6); PG8_BAR; PG8_MMA(1, 1, At, B1); PG8_BAR;
            PG8_LDB(B0, 1, 0); PG8_SCHED; PG8_LDA(At, 1, 0); PG8_STAGE(PG8_SA(0, 1), a2 + hstepA, voffA);
            PG8_WAIT_L(8); PG8_BAR; PG8_WAIT_L(0); PG8_MMA(0, 0, At, B0); PG8_BAR; PG8_SCHED;
            PG8_LDB(B1, 1, 1); PG8_STAGE(PG8_SB(1, 0), b3, voffB);
            PG8_BAR; PG8_WAIT_L(0); PG8_MMA(0, 1, At, B1); PG8_BAR;
            PG8_LDA(At, 1, 1); PG8_STAGE(PG8_SA(1, 0), a3, voffA);
            PG8_BAR; PG8_WAIT_L(0); PG8_MMA(1, 0, At, B0); PG8_BAR; PG8_SCHED;
            PG8_STAGE(PG8_SB(1, 1), b3 + hstepB, voffB);
            PG8_WAIT_V(6); PG8_BAR; PG8_MMA(1, 1, At, B1); PG8_BAR;
            }
        }
        if constexpr (ALIGN_EPI) { if (wr == 0) PG8_BAR; }
        if constexpr (!Epi::AFTER_DRAIN) { E(acc, cur, wr, wc, fr, fq); S.done(cur); }
        if (!has_next) break;
#pragma unroll
        for (int a = 0; a < 2; ++a)
#pragma unroll
            for (int b = 0; b < 2; ++b)
#pragma unroll
                for (int m = 0; m < 4; ++m)
#pragma unroll
                    for (int n = 0; n < 2; ++n) acc[a][b][m][n] = (f32x4){0.f, 0.f, 0.f, 0.f};
        cur = nxt; cA = nA; cB = nB; ++ui;
        if constexpr (ALIGN_EPI) { if (wr == 1) PG8_BAR; }
    }
    PG8_WAIT_V(0);
    if constexpr (!ALIGN_EPI) { if (wr == 0) PG8_BAR; }
    PG8_BAR;
    if constexpr (Epi::AFTER_DRAIN) { E.fused(acc, cur, wr, wc, fr, fq, lds, wid, lane); S.done(cur); }
#undef PG8_ABASE
#undef PG8_SA
#undef PG8_SB
#undef PG8_STAGE
#undef PG8_LDA
#undef PG8_LDB
#undef PG8_MMA
#undef PG8_WAIT_V
#undef PG8_WAIT_L
#undef PG8_BAR
#undef PG8_SCHED
}
}

#include <hip/hip_cooperative_groups.h>
namespace cg = cooperative_groups;
#define LAS __attribute__((address_space(3)))
typedef float f32x4 __attribute__((ext_vector_type(4)));
typedef unsigned u32x4 __attribute__((ext_vector_type(4)));
typedef unsigned u32x2 __attribute__((ext_vector_type(2)));

constexpr int NTHREADS = 512, NWAVES = 8;
constexpr int LDS_PHASE_BYTES = 147456;
constexpr int BAR_LDS_OFF = LDS_PHASE_BYTES;
constexpr int LDS_BYTES = LDS_PHASE_BYTES + 256;
constexpr size_t WS_BAR = WS_CTL + 524288;

constexpr int PH_PREP = 0, PH_PER_LAYER = 11, PH_L0 = 1;
constexpr int PHO_IN = 0, PHO_MIXA = 1, PHO_LORA = 2, PHO_C1 = 3, PHO_MIXB = 4, PHO_MIXC = 5, PHO_OUT = 6, PHO_LN1 = 7, PHO_GU = 8, PHO_DOWN = 9, PHO_LN2 = 10;
constexpr int N_PHASES = PH_L0 + DEPTH * PH_PER_LAYER;

struct Args { const float* in[35]; float* out; unsigned char* ws; int ph_lo, ph_hi; };

#define XB_TMO      128
#define XB_XCNT(j)  (256  + 64 * (j))
#define XB_XSUB(j)  (1280 + 64 * (j))
#define XB_XGEN(j)  (2304 + 64 * (j))
#define XB_TOP      3328
#define XB_TOPGEN   3392
#define XCD_BAR_WORDS 3456
#define XB_SPIN_CAP (1u << 18)

__device__ __forceinline__ unsigned xb_ld(unsigned* p)              { return __hip_atomic_load(p, __ATOMIC_RELAXED, __HIP_MEMORY_SCOPE_AGENT); }
__device__ __forceinline__ unsigned xb_add(unsigned* p, unsigned v) { return __hip_atomic_fetch_add(p, v, __ATOMIC_RELAXED, __HIP_MEMORY_SCOPE_AGENT); }
__device__ __forceinline__ unsigned xb_xcc_id() { return (unsigned)__builtin_amdgcn_s_getreg((3 << 11) | 20) & 0xFu; }
#define XB_SPIN(cond, bar) do { unsigned _sp = 0; while (cond) { __builtin_amdgcn_s_sleep(1); \
    if ((++_sp & 255u) == 0u) { if (xb_ld(&(bar)[XB_TMO])) break; if (_sp > XB_SPIN_CAP) { atomicAdd(&(bar)[XB_TMO], 1u); break; } } } } while (0)

struct XcdBarrier {
    unsigned* bar; unsigned x;
    volatile LAS unsigned* st;
};

__device__ __forceinline__ XcdBarrier xcd_barrier_post(unsigned* bar, volatile LAS unsigned* st) {
    XcdBarrier b; b.bar = bar; b.x = xb_xcc_id(); b.st = st;
    if (threadIdx.x == 0) (void)xb_add(&bar[XB_XCNT(b.x)], 1u);
    return b;
}
__device__ __forceinline__ void xcd_barrier_complete(unsigned* bar, unsigned x, unsigned& nloc, unsigned& nx) {
    const unsigned G = gridDim.x * gridDim.y * gridDim.z;
    unsigned sum, cnt, mine, sp = 0u;
    for (;;) {
        sum = 0u; cnt = 0u; mine = 0u;
#pragma unroll
        for (unsigned j = 0; j < 16; ++j) { const unsigned c = xb_ld(&bar[XB_XCNT(j)]); sum += c; cnt += (c > 0u) ? 1u : 0u; mine = (j == x) ? c : mine; }
        if (sum == G) break;
        __builtin_amdgcn_s_sleep(1);
        if ((++sp & 255u) == 0u) { if (xb_ld(&bar[XB_TMO])) break; if (sp > XB_SPIN_CAP) { atomicAdd(&bar[XB_TMO], 1u); break; } }
    }
    nloc = mine > 0u ? mine : 1u; nx = cnt > 0u ? cnt : 1u;
}

__device__ __forceinline__ void xcd_barrier(const XcdBarrier& b) {
    asm volatile("s_waitcnt vmcnt(0)" ::: "memory");
    __syncthreads();
    if (threadIdx.x == 0) {
        unsigned* bar = b.bar;
        __builtin_amdgcn_s_waitcnt(0);
        unsigned nloc = b.st[0], nx = b.st[1];
        if (nloc == 0u) { xcd_barrier_complete(bar, b.x, nloc, nx); b.st[0] = nloc; b.st[1] = nx; }
        const unsigned old = xb_add(&bar[XB_XSUB(b.x)], 1u);
        const unsigned gen = old / nloc;
        if (old + 1u == (gen + 1u) * nloc) {
            __builtin_amdgcn_fence(__ATOMIC_RELEASE, "agent");
            asm volatile("s_waitcnt vmcnt(0)" ::: "memory");
            const unsigned og = xb_add(&bar[XB_TOP], 1u);
            const unsigned tg = og / nx;
            if (og + 1u == (tg + 1u) * nx) xb_add(&bar[XB_TOPGEN], 1u);
            else XB_SPIN(xb_ld(&bar[XB_TOPGEN]) == tg, bar);
            __builtin_amdgcn_fence(__ATOMIC_ACQUIRE, "agent");
            xb_add(&bar[XB_XGEN(b.x)], 1u);
            asm volatile("s_waitcnt vmcnt(0)" ::: "memory");
        } else {
            XB_SPIN(xb_ld(&bar[XB_XGEN(b.x)]) == gen, bar);
            __builtin_amdgcn_fence(__ATOMIC_ACQUIRE, "agent");
            asm volatile("s_waitcnt vmcnt(0)" ::: "memory");
        }
    }
    __syncthreads();
}


typedef float f32x2_t __attribute__((ext_vector_type(2))); typedef __bf16 bf16x2_t __attribute__((ext_vector_type(2)));
__device__ __forceinline__ unsigned pk2bf(float lo, float hi) { f32x2_t v = {lo, hi}; bf16x2_t b = __builtin_convertvector(v, bf16x2_t); return __builtin_bit_cast(unsigned, b); }

struct EpiIn {
    static constexpr bool PERM = true, AFTER_DRAIN = false;
    bf16_t* O; int ldc; int sig_pn;
    __device__ __forceinline__ void operator()(const f32x4 (&acc)[2][2][4][2], const pg8::Unit& u, int wr, int wc, int fr, int fq) const {
        const int row0 = u.pm * 256 + wr * 64 + fr, col0 = u.pn * 256 + wc * 32 + 8 * fq;
        const bool sg = u.pn >= sig_pn;
#pragma unroll
        for (int ai = 0; ai < 2; ++ai)
#pragma unroll
            for (int m = 0; m < 4; ++m) {
                bf16_t* rowp = O + (size_t)(row0 + ai * 128 + m * 16) * ldc + col0;
#pragma unroll
                for (int bj = 0; bj < 2; ++bj) {
                    f32x4 v0 = acc[ai][bj][m][0], v1 = acc[ai][bj][m][1];
                    if (sg) {
#pragma unroll
                        for (int i = 0; i < 4; ++i) { v0[i] = sigmoidf_(v0[i]); v1[i] = sigmoidf_(v1[i]); }
                    }
                    u32x4 w; w.x = pk2bf(v0[0], v0[1]); w.y = pk2bf(v0[2], v0[3]); w.z = pk2bf(v1[0], v1[1]); w.w = pk2bf(v1[2], v1[3]);
                    *(u32x4*)(rowp + bj * 128) = w;
                }
                asm volatile("" ::: "memory");
            }
    }
};
template <bool RESB> struct EpiZ {
    static constexpr bool PERM = false, AFTER_DRAIN = false;
    const void* res; float* Z; int ldc;
    __device__ __forceinline__ void operator()(const f32x4 (&acc)[2][2][4][2], const pg8::Unit& u, int wr, int wc, int fr, int fq) const {
        const int col0 = u.pn * 256 + wc * 32 + 4 * fq;
#pragma unroll
        for (int ai = 0; ai < 2; ++ai)
#pragma unroll
            for (int m = 0; m < 4; ++m) {
                const size_t off = (size_t)(u.pm * 256 + ai * 128 + wr * 64 + m * 16 + fr) * ldc + col0;
#pragma unroll
                for (int bj = 0; bj < 2; ++bj)
#pragma unroll
                    for (int n = 0; n < 2; ++n) {
                        f32x4 r;
                        if (RESB) { const u32x2 w = *(const u32x2*)((const bf16_t*)res + off + bj * 128 + n * 16);
                            r = (f32x4){__uint_as_float(w.x << 16), __uint_as_float(w.x & 0xffff0000u), __uint_as_float(w.y << 16), __uint_as_float(w.y & 0xffff0000u)}; }
                        else r = *(const f32x4*)((const float*)res + off + bj * 128 + n * 16);
                        *(f32x4*)(Z + off + bj * 128 + n * 16) = r * ALPHA + acc[ai][bj][m][n];
                    }
                asm volatile("" ::: "memory");
            }
    }
};
template <bool RESB> struct EpiZS {
    static constexpr bool PERM = false, AFTER_DRAIN = false;
    const void* res; float* ZS; int ldc;
    __device__ __forceinline__ void operator()(const f32x4 (&acc)[2][2][4][2], const pg8::Unit& u, int wr, int wc, int fr, int fq) const {
        const int ks = u.pn >> 2, col0 = (u.pn & 3) * 256 + wc * 32 + 4 * fq;
        float* Z = ZS + (size_t)ks * MS * D;
#pragma unroll
        for (int ai = 0; ai < 2; ++ai)
#pragma unroll
            for (int m = 0; m < 4; ++m) {
                const size_t off = (size_t)(u.pm * 256 + ai * 128 + wr * 64 + m * 16 + fr) * ldc + col0;
#pragma unroll
                for (int bj = 0; bj < 2; ++bj)
#pragma unroll
                    for (int n = 0; n < 2; ++n) {
                        f32x4 o = acc[ai][bj][m][n];
                        if (ks == 0) {
                            f32x4 r;
                            if (RESB) { const u32x2 w = *(const u32x2*)((const bf16_t*)res + off + bj * 128 + n * 16);
                                r = (f32x4){__uint_as_float(w.x << 16), __uint_as_float(w.x & 0xffff0000u), __uint_as_float(w.y << 16), __uint_as_float(w.y & 0xffff0000u)}; }
                            else r = *(const f32x4*)((const float*)res + off + bj * 128 + n * 16);
                            o = r * ALPHA + o;
                        }
                        *(f32x4*)(Z + off + bj * 128 + n * 16) = o;
                    }
                asm volatile("" ::: "memory");
            }
    }
};
struct EpiSwiGLU {
    static constexpr bool PERM = true, AFTER_DRAIN = false;
    bf16_t* H; int ldc;
    __device__ __forceinline__ void operator()(const f32x4 (&acc)[2][2][4][2], const pg8::Unit& u, int wr, int wc, int fr, int fq) const {
        const int row0 = u.pm * 256 + wr * 64 + fr, col0 = u.pn * 128 + wc * 32 + 8 * fq;
#pragma unroll
        for (int ai = 0; ai < 2; ++ai)
#pragma unroll
            for (int m = 0; m < 4; ++m) {
                bf16_t* rowp = H + (size_t)(row0 + ai * 128 + m * 16) * ldc + col0;
                float o[8];
#pragma unroll
                for (int n = 0; n < 2; ++n)
#pragma unroll
                    for (int i = 0; i < 4; ++i) { const float g = acc[ai][0][m][n][i], up = acc[ai][1][m][n][i]; o[n * 4 + i] = g * sigmoidf_(g) * up; }
                u32x4 w; w.x = pk2bf(o[0], o[1]); w.y = pk2bf(o[2], o[3]); w.z = pk2bf(o[4], o[5]); w.w = pk2bf(o[6], o[7]);
                *(u32x4*)rowp = w;
                asm volatile("" ::: "memory");
            }
    }
};

template <int MODE> __device__ __forceinline__ int colmap(int n) {
    if (MODE == 0) return n < 5920 ? n : (n < 6144 ? -1 : n - 224);
    if (MODE == 2) { const int pn = n >> 8, q = n & 255; return q < 128 ? pn * 128 + q : DFF + pn * 128 + (q - 128); }
    return n;
}
template <int MODE> __device__ __forceinline__ void transpose_item(const float* __restrict__ W, int K, int ldw, bf16_t* WT, int item, int nblk, LAS float* tile, int tid, bf16_t* WS2 = nullptr, int kpart = 0, int nrows = 0) {
    const int kb = item / nblk, nb = item % nblk, k0 = kb * 64, n0 = nb * 64;
    {
        const int n4 = tid & 15; const int col = colmap<MODE>(n0 + 4 * n4);
#pragma unroll
        for (int i = 0; i < 2; ++i) {
            const int kk = i * 32 + (tid >> 4);
            const f32x4 v = col >= 0 ? *(const f32x4*)(W + (size_t)(k0 + kk) * ldw + col) : (f32x4){0.f, 0.f, 0.f, 0.f};
            LAS float* t = tile + kk * 65 + 4 * n4; t[0] = v[0]; t[1] = v[1]; t[2] = v[2]; t[3] = v[3];
        }
    }
    __syncthreads();
    {
        const int nn = tid >> 3, c = tid & 7; const LAS float* s = tile + (8 * c) * 65 + nn;
        u32x4 o; o.x = pk2bf(s[0], s[65]); o.y = pk2bf(s[2 * 65], s[3 * 65]); o.z = pk2bf(s[4 * 65], s[5 * 65]); o.w = pk2bf(s[6 * 65], s[7 * 65]);
        *(u32x4*)(WT + (size_t)(n0 + nn) * K + k0 + 8 * c) = o;
        if (WS2) { const int ks = k0 / kpart; *(u32x4*)(WS2 + ((size_t)ks * nrows + n0 + nn) * kpart + (k0 - ks * kpart) + 8 * c) = o; }
    }
    __syncthreads();
}
__device__ __forceinline__ void prep_rg_weights(const Args& a, int l);
__device__ __forceinline__ void prep_weights(const Args& a, int l, int what, int first, LAS unsigned char* lds) {
    const int tid = threadIdx.x, G = gridDim.x - first, bx = (int)blockIdx.x - first;
    if (bx < 0) return;
    LAS float* tile = (LAS float*)lds;
    constexpr int I_IN = (D / 64) * (NP / 64), I_OUT = (D / 64) * (D / 64), I_GU = (D / 64) * (2 * DFF / 64), I_DN = (DFF / 64) * (D / 64);
    if (what & 1) for (int r = bx; r < I_IN; r += G) transpose_item<0>(a.in[8] + (size_t)l * D * IN_COLS, D, IN_COLS, (bf16_t*)(a.ws + WS_WIN), r, NP / 64, tile, tid);
    if (what & 4) {
        for (int it = bx; it < I_OUT + I_GU + I_DN; it += G) {
            int r = it;
            if (r < I_OUT) { transpose_item<1>(a.in[28] + (size_t)l * D * D, D, D, (bf16_t*)(a.ws + WS_WOUT), r, D / 64, tile, tid, (bf16_t*)(a.ws + WS_WOUTS), 256, D); continue; } r -= I_OUT;
            if (r < I_GU) { transpose_item<2>(a.in[31] + (size_t)l * D * 2 * DFF, D, 2 * DFF, (bf16_t*)(a.ws + WS_WGU), r, 2 * DFF / 64, tile, tid); continue; } r -= I_GU;
            transpose_item<1>(a.in[32] + (size_t)l * DFF * D, DFF, D, (bf16_t*)(a.ws + WS_WDN), r, D / 64, tile, tid, (bf16_t*)(a.ws + WS_WDNS), 256, D);
        }
    }
    if (what & 2) {
        for (unsigned i = (unsigned)bx * NTHREADS + tid; i < (unsigned)(3072 * ACAT_K); i += (unsigned)G * NTHREADS) {
            const int n = (int)(i / ACAT_K), k = (int)(i % ACAT_K), kind = n >> 10, c = n & 1023;
            float v = 0.f;
            if (kind == 0 && k < 64) v = a.in[19][((size_t)l * 64 + k) * D + c];
            else if (kind == 1 && k >= 64 && k < 128) v = a.in[21][((size_t)l * 64 + (k - 64)) * D + c];
            else if (kind == 2 && k >= 128 && k < 288) v = a.in[22][((size_t)l * 160 + (k - 128)) * D + c];
            ((bf16_t*)(a.ws + WS_WLORA))[i] = f2bf(v);
        }
    }
    if (what & 8) prep_rg_weights(a, l);
}
__device__ __forceinline__ void phase_prep_x(const Args& a) {
    bf16_t* XB = (bf16_t*)(a.ws + WS_XB);
    const size_t n4 = (size_t)M * D / 4, np4 = (size_t)MP * D / 4;
    for (size_t i = (size_t)blockIdx.x * NTHREADS + threadIdx.x; i < n4; i += (size_t)gridDim.x * NTHREADS) {
        const f32x4 v = i < np4 ? ((const f32x4*)a.in[0])[i] : ((const f32x4*)a.in[1])[i - np4];
        u32x2 w; w.x = pk2bf(v[0], v[1]); w.y = pk2bf(v[2], v[3]);
        ((u32x2*)XB)[i] = w;
    }
}

__device__ __forceinline__ float wave_sum_fast(float x) {
    x += __builtin_bit_cast(float, __builtin_amdgcn_update_dpp(0, __builtin_bit_cast(int, x), 0xB1, 0xF, 0xF, true));
    x += __builtin_bit_cast(float, __builtin_amdgcn_update_dpp(0, __builtin_bit_cast(int, x), 0x4E, 0xF, 0xF, true));
    x += __builtin_bit_cast(float, __builtin_amdgcn_update_dpp(0, __builtin_bit_cast(int, x), 0x124, 0xF, 0xF, true));
    x += __builtin_bit_cast(float, __builtin_amdgcn_update_dpp(0, __builtin_bit_cast(int, x), 0x128, 0xF, 0xF, true));
    x += __shfl_xor(x, 16); x += __shfl_xor(x, 32);
    return x;
}
template <int NS> __device__ __forceinline__ void phase_ln(const float* __restrict__ Z, const float* __restrict__ ZS, const float* __restrict__ g, const float* __restrict__ b, float* OF, bf16_t* OB) {
    const int lane = threadIdx.x & 63, wv = threadIdx.x >> 6;
    f32x4 gv[4], bv[4];
#pragma unroll
    for (int j = 0; j < 4; ++j) { gv[j] = ((const f32x4*)g)[j * 64 + lane]; bv[j] = ((const f32x4*)b)[j * 64 + lane]; }
    const int stride = gridDim.x * NWAVES;
    int m = blockIdx.x * NWAVES + wv;
    f32x4 nx[4];
    auto load_row = [&](int mm) {
        if (mm < MP) {
#pragma unroll
            for (int j = 0; j < 4; ++j) nx[j] = ((const f32x4*)(Z + (size_t)mm * D))[j * 64 + lane];
        } else {
#pragma unroll
            for (int j = 0; j < 4; ++j) nx[j] = ((const f32x4*)(ZS + (size_t)(mm - MP) * D))[j * 64 + lane];
#pragma unroll
            for (int ks = 1; ks < NS; ++ks)
#pragma unroll
                for (int j = 0; j < 4; ++j) nx[j] = nx[j] + ((const f32x4*)(ZS + ((size_t)ks * MS + (mm - MP)) * D))[j * 64 + lane];
        }
    };
    if (m < M) load_row(m);
    for (; m < M; m += stride) {
        f32x4 v[4]; float s = 0.f;
#pragma unroll
        for (int j = 0; j < 4; ++j) { v[j] = nx[j]; s += (v[j][0] + v[j][1]) + (v[j][2] + v[j][3]); }
        if (m + stride < M) load_row(m + stride);
        const float mean = wave_sum_fast(s) * (1.f / D);
        float q = 0.f;
#pragma unroll
        for (int j = 0; j < 4; ++j) { v[j] = v[j] - mean; q += (v[j][0] * v[j][0] + v[j][1] * v[j][1]) + (v[j][2] * v[j][2] + v[j][3] * v[j][3]); }
        const float rstd = rsqrtf(wave_sum_fast(q) * (1.f / D) + LN_EPS);
#pragma unroll
        for (int j = 0; j < 4; ++j) {
            const f32x4 y = v[j] * rstd * gv[j] + bv[j];
            if (OF) ((f32x4*)(OF + (size_t)m * D))[j * 64 + lane] = y;
            if (OB) { u32x2 w; w.x = pk2bf(y[0], y[1]); w.y = pk2bf(y[2], y[3]); ((u32x2*)(OB + (size_t)m * D))[j * 64 + lane] = w; }
        }
    }
}


typedef short bf16x8_t __attribute__((ext_vector_type(8)));
typedef short bf16x4_t __attribute__((ext_vector_type(4)));
typedef short v4i16_t __attribute__((ext_vector_type(4)));
#define LDSW() asm volatile("s_waitcnt lgkmcnt(0)" ::: "memory")
__device__ __forceinline__ u32x2 tr_read4(LAS unsigned char* p) { return __builtin_bit_cast(u32x2, __builtin_amdgcn_ds_read_tr16_b64_v4i16((LAS v4i16_t*)p)); }
__device__ __forceinline__ bf16x8_t mk_frag(u32x2 lo, u32x2 hi) { const u32x4 w = (u32x4){lo.x, lo.y, hi.x, hi.y}; return __builtin_bit_cast(bf16x8_t, w); }
__device__ __forceinline__ u32x2 pk4(float a, float b, float c, float d) { u32x2 w; w.x = pk2bf(a, b); w.y = pk2bf(c, d); return w; }

constexpr size_t WS_WRG = WS_CTL + 4096;
constexpr int RG_TP = 144;
__device__ __forceinline__ void prep_rg_weights(const Args& a, int l) {
    const size_t gt = (size_t)blockIdx.x * NTHREADS + threadIdx.x, gs = (size_t)gridDim.x * NTHREADS;
    bf16_t* W = (bf16_t*)(a.ws + WS_WRG);
    for (size_t i = gt; i < (size_t)2 * 16 * 4096; i += gs) {
        const int gate = (int)(i >> 16), bk = (int)(i >> 12) & 15, j = (int)(i >> 6) & 63, ii = (int)i & 63;
        W[i] = f2bf(a.in[gate ? 14 : 12][(size_t)l * 16 * 4096 + ((size_t)bk * 64 + ii) * 64 + j]);
    }
}
__device__ __forceinline__ float one_minus_exp(float x) {
    const float s = -x * (1.f + x * (0.5f + x * (0.16666667f + x * (0.041666668f + x * 0.0083333333f))));
    return x > -0.25f ? s : 1.f - __expf(x);
}
template <bool PASS2>
__device__ __forceinline__ void rglru_unit2(const Args& a, int L, int unit, LAS unsigned char* lds) {
    int lane = threadIdx.x & 63; const int wv = __builtin_amdgcn_readfirstlane(threadIdx.x >> 6);
    asm volatile("" : "+v"(lane));
    const int i16 = lane & 15, qp = lane >> 4;
    const bf16_t* P = (const bf16_t*)(a.ws + WS_P); bf16_t* OB = (bf16_t*)(a.ws + WS_OB); float* RS = (float*)(a.ws + WS_RS);
    const bf16_t* WRG = (const bf16_t*)(a.ws + WS_WRG);
    const float* cw = a.in[10] + (size_t)L * 4 * D; const float* cb = a.in[11] + L * D; const float* ba = a.in[13] + L * D;
    const float* bx = a.in[15] + L * D; const float* lam = a.in[16] + L * D;
    const float* conv0 = a.in[4] + (size_t)L * DBATCH * 3 * D; const float* h0 = a.in[5] + (size_t)L * DBATCH * D;
    LAS unsigned char* tile = lds + wv * (64 * RG_TP);
    LAS unsigned char* obt = lds + (NWAVES + wv) * (64 * RG_TP);
    const int m0 = unit * 64;
    const bool sample = m0 >= MP;
    const int bseq = sample ? 0 : m0 / SEQ, chunk = sample ? 0 : (m0 % SEQ) / 64;
    for (int bb = 0; bb < 2; ++bb) {
        const int bk = 2 * wv + bb, c0 = 64 * bk;
        bf16x8_t af[4][2];
#pragma unroll
        for (int ks = 0; ks < 2; ++ks) {
            const int cc = c0 + 32 * ks + 8 * qp;
            f32x4 w0[2], w1[2], w2[2], w3[2], wb[2];
#pragma unroll
            for (int hh = 0; hh < 2; ++hh) { w0[hh] = *(const f32x4*)(cw + 0 * D + cc + 4 * hh); w1[hh] = *(const f32x4*)(cw + 1 * D + cc + 4 * hh); w2[hh] = *(const f32x4*)(cw + 2 * D + cc + 4 * hh);
                w3[hh] = *(const f32x4*)(cw + 3 * D + cc + 4 * hh); wb[hh] = *(const f32x4*)(cb + cc + 4 * hh); }
#pragma unroll
            for (int mt = 0; mt < 4; ++mt) {
                const int tok = 16 * mt + i16; const size_t m = (size_t)m0 + tok;
                const int tseq = sample ? (tok & 7) : (chunk * 64 + tok);
                float xv[4][8];
#pragma unroll
                for (int k = 0; k < 4; ++k) {
                    const int back = 3 - k;
                    const bool ok = tseq - back >= 0;
                    const u32x4 v = *(const u32x4*)(P + (m - (ok ? back : 0)) * NP + CRNN + cc);
                    const unsigned w4[4] = {v.x, v.y, v.z, v.w};
#pragma unroll
                    for (int e = 0; e < 8; ++e) xv[k][e] = ok ? __uint_as_float((e & 1) ? (w4[e >> 1] & 0xffff0000u) : (w4[e >> 1] << 16)) : 0.f;
                    if (sample && back > 0) {
                        const int b = (int)(m - MP) >> 3; const int ci = ok ? 0 : 3 + tseq - back;
                        const float* cp = conv0 + ((size_t)b * 3 + ci) * D + cc;
                        const f32x4 v0 = *(const f32x4*)cp, v1 = *(const f32x4*)(cp + 4);
#pragma unroll
                        for (int e = 0; e < 4; ++e) { xv[k][e] = ok ? xv[k][e] : v0[e]; xv[k][4 + e] = ok ? xv[k][4 + e] : v1[e]; }
                    }
                }
                float xc[8];
#pragma unroll
                for (int e = 0; e < 8; ++e) xc[e] = wb[e >> 2][e & 3] + w0[e >> 2][e & 3] * xv[0][e] + w1[e >> 2][e & 3] * xv[1][e] + w2[e >> 2][e & 3] * xv[2][e] + w3[e >> 2][e & 3] * xv[3][e];
                const u32x4 pk = (u32x4){pk2bf(xc[0], xc[1]), pk2bf(xc[2], xc[3]), pk2bf(xc[4], xc[5]), pk2bf(xc[6], xc[7])};
                af[mt][ks] = __builtin_bit_cast(bf16x8_t, pk);
                *(LAS u32x4*)(tile + tok * RG_TP + (32 * ks + 8 * qp) * 2) = pk;
            }
        }
        LDSW();
#pragma unroll 1
        for (int nt = 0; nt < 4; ++nt) {
            const int j = 16 * nt + i16, c = c0 + j;
            bf16x8_t ba_[2], bx_[2];
#pragma unroll
            for (int ks = 0; ks < 2; ++ks) { ba_[ks] = *(const bf16x8_t*)(WRG + ((size_t)(0 * 16 + bk) * 64 + j) * 64 + 32 * ks + 8 * qp); bx_[ks] = *(const bf16x8_t*)(WRG + ((size_t)(1 * 16 + bk) * 64 + j) * 64 + 32 * ks + 8 * qp); }
            const float bac = ba[c], bxc = bx[c], spl = softplusf_(-lam[c]);
            float av[4][4], uv[4][4];
#pragma unroll
            for (int mt = 0; mt < 4; ++mt) {
                f32x4 ar = (f32x4){0.f, 0.f, 0.f, 0.f}, ai = ar;
#pragma unroll
                for (int ks = 0; ks < 2; ++ks) { ar = __builtin_amdgcn_mfma_f32_16x16x32_bf16(af[mt][ks], ba_[ks], ar, 0, 0, 0); ai = __builtin_amdgcn_mfma_f32_16x16x32_bf16(af[mt][ks], bx_[ks], ai, 0, 0, 0); }
                const u32x2 xcp = tr_read4(tile + (16 * mt + 4 * qp + (i16 >> 2)) * RG_TP + (16 * nt + 4 * (i16 & 3)) * 2);
#pragma unroll
                for (int r = 0; r < 4; ++r) {
                    const unsigned xw = r < 2 ? xcp.x : xcp.y;
                    const float xcv = __uint_as_float((r & 1) ? (xw & 0xffff0000u) : (xw << 16));
                    const float rg = sigmoidf_(ar[r] + bac), ig = sigmoidf_(ai[r] + bxc);
                    const float log_a = -8.f * rg * spl;
                    av[mt][r] = __expf(log_a);
                    uv[mt][r] = __builtin_amdgcn_sqrtf(one_minus_exp(2.f * log_a)) * (ig * xcv);
                }
            }
            float H = 0.f, Atot = 1.f;
            if (PASS2 && !sample && chunk > 0) H = RS[(((size_t)bseq * 128 + chunk) * D + c) * 2 + 1];
#pragma unroll
            for (int mt = 0; mt < 4; ++mt) {
                const float As = av[mt][0] * av[mt][1] * av[mt][2] * av[mt][3];
                const float Bs = ((uv[mt][0] * av[mt][1] + uv[mt][1]) * av[mt][2] + uv[mt][2]) * av[mt][3] + uv[mt][3];
                float Aq[4], Bq[4];
#pragma unroll
                for (int q = 0; q < 4; ++q) { Aq[q] = __shfl(As, i16 + 16 * q); Bq[q] = __shfl(Bs, i16 + 16 * q); }
                float hs;
                if (!sample) {
                    const float h1 = Aq[0] * H + Bq[0], h2 = Aq[1] * h1 + Bq[1], h3 = Aq[2] * h2 + Bq[2];
                    hs = qp == 0 ? H : (qp == 1 ? h1 : (qp == 2 ? h2 : h3));
                    H = Aq[3] * h3 + Bq[3]; Atot *= Aq[0] * Aq[1] * Aq[2] * Aq[3];
                } else {
                    const int b0 = ((m0 - MP) >> 3) + 2 * mt;
                    const float hA = h0[(size_t)b0 * D + c], hB = h0[(size_t)(b0 + 1) * D + c];
                    const float hA1 = Aq[0] * hA + Bq[0], hB1 = Aq[2] * hB + Bq[2];
                    hs = qp == 0 ? hA : (qp == 1 ? hA1 : (qp == 2 ? hB : hB1));
                    if (PASS2 && qp == 0) {
                        a.out[O_SH + ((size_t)L * DBATCH + b0) * D + c] = Aq[1] * hA1 + Bq[1];
                        a.out[O_SH + ((size_t)L * DBATCH + b0 + 1) * D + c] = Aq[3] * hB1 + Bq[3];
                    }
                }
                if (PASS2) {
                    float h = hs;
#pragma unroll
                    for (int r = 0; r < 4; ++r) { h = av[mt][r] * h + uv[mt][r]; *(LAS unsigned short*)(obt + (16 * mt + 4 * qp + r) * RG_TP + j * 2) = f2bf(h); }
                }
            }
            if (!sample && qp == 0) {
                if (!PASS2) *(float2*)(RS + (((size_t)bseq * 128 + chunk) * D + c) * 2) = make_float2(Atot, H);
                else if (chunk == 127) a.out[O_PH + ((size_t)L * NBATCH + bseq) * D + c] = H;
            }
        }
        LDSW();
        if (PASS2) {
#pragma unroll
            for (int p = 0; p < 8; ++p) {
                const int q = p * 64 + lane, row = q >> 3, pc = q & 7;
                *(u32x4*)(OB + ((size_t)m0 + row) * D + c0 + 8 * pc) = *(const LAS u32x4*)(obt + row * RG_TP + pc * 16);
            }
            LDSW();
        }
    }
    if (PASS2) {
        const int t = threadIdx.x;
        if (sample) {
            for (int i = t; i < 8 * 3 * D; i += NTHREADS) { const int s = i / (3 * D), k = (i / D) % 3, c = i % D; const int b = ((m0 - MP) >> 3) + s;
                a.out[O_SCONV + (((size_t)L * DBATCH + b) * 3 + k) * D + c] = bf2f(P[((size_t)MP + b * DSEQ + 5 + k) * NP + CRNN + c]); }
        } else if (chunk == 127) {
            for (int i = t; i < 3 * D; i += NTHREADS) { const int k = i / D, c = i % D;
                a.out[O_PCONV + (((size_t)L * NBATCH + bseq) * 3 + k) * D + c] = bf2f(P[((size_t)m0 + 61 + k) * NP + CRNN + c]); }
        }
    }
}
__device__ __forceinline__ void rglru_prefix(const Args& a) {
    float* RS = (float*)(a.ws + WS_RS);
    const int gid = blockIdx.x * NTHREADS + threadIdx.x;
    if (gid >= NBATCH * D) return;
    const int b = gid / D, c = gid % D;
    float h = 0.f;
    for (int c0 = 0; c0 < 128; c0 += 16) {
        float2 ab[16];
#pragma unroll
        for (int i = 0; i < 16; ++i) ab[i] = *(const float2*)(RS + (((size_t)b * 128 + c0 + i) * D + c) * 2);
#pragma unroll
        for (int i = 0; i < 16; ++i) { RS[(((size_t)b * 128 + c0 + i) * D + c) * 2 + 1] = h; h = ab[i].x * h + ab[i].y; }
    }
}


constexpr int AT_KPB = 144;
constexpr int AT_VPB = 528;
constexpr int AT_K_OFF = 0, AT_V_OFF = 256 * AT_KPB;
constexpr int AT_LDS = AT_V_OFF + 64 * AT_VPB;

template <bool SAMPLE>
__device__ __forceinline__ void attn_unit(const bf16_t* __restrict__ P, bf16_t* OA, const float* __restrict__ sinks, const float* __restrict__ ck, const float* __restrict__ cv,
                                          int b, int qb, int c, LAS unsigned char* lds) {
    const int tid = threadIdx.x, lane = tid & 63, wv = __builtin_amdgcn_readfirstlane(tid >> 6), i16 = lane & 15, qp = lane >> 4;
    LAS unsigned char* ldsK = lds + AT_K_OFF; LAS unsigned char* ldsV = lds + AT_V_OFF;
    if (!SAMPLE) {
        const size_t row_base = (size_t)b * SEQ + (size_t)(qb - 1) * 128;
#pragma unroll
        for (int it = 0; it < 4; ++it) {
            const int ci = tid + 512 * it, s = ci >> 3, part = ci & 7;
            u32x4 kv = (u32x4){0u, 0u, 0u, 0u}, vv = (u32x4){0u, 0u, 0u, 0u};
            if (qb > 0 || s >= 128) {
                const bf16_t* pr = P + (row_base + s) * NP;
                kv = *(const u32x4*)(pr + CK + 64 * c + 8 * part);
                vv = *(const u32x4*)(pr + CV + 64 * c + 8 * part);
            }
            *(LAS u32x4*)(ldsK + s * AT_KPB + part * 16) = kv;
            const unsigned w4[4] = {vv.x, vv.y, vv.z, vv.w};
#pragma unroll
            for (int e = 0; e < 8; ++e) *(LAS unsigned short*)(ldsV + (8 * part + e) * AT_VPB + 2 * s) = (unsigned short)((w4[e >> 1] >> (16 * (e & 1))) & 0xffffu);
        }
    } else {
        for (int ci = tid; ci < 144 * 16; ci += 512) {
            const int s = ci >> 4, part = ci & 15;
            float kf[4] = {0.f, 0.f, 0.f, 0.f}, vf[4] = {0.f, 0.f, 0.f, 0.f};
            if (s < 128) {
                const f32x4 k4 = *(const f32x4*)(ck + ((size_t)(b * 128 + s) * 4 + c) * 64 + 4 * part);
                const f32x4 v4 = *(const f32x4*)(cv + ((size_t)(b * 128 + s) * 4 + c) * 64 + 4 * part);
#pragma unroll
                for (int e = 0; e < 4; ++e) { kf[e] = k4[e]; vf[e] = v4[e]; }
            } else if (s < 136) {
                const bf16_t* pr = P + (size_t)(MP + b * DSEQ + (s - 128)) * NP;
#pragma unroll
                for (int e = 0; e < 4; ++e) { kf[e] = bf2f(pr[CK + 64 * c + 4 * part + e]); vf[e] = bf2f(pr[CV + 64 * c + 4 * part + e]); }
            }
            u32x2 kw; kw.x = pk2bf(kf[0], kf[1]); kw.y = pk2bf(kf[2], kf[3]);
            *(LAS u32x2*)(ldsK + s * AT_KPB + part * 8) = kw;
#pragma unroll
            for (int e = 0; e < 4; ++e) *(LAS unsigned short*)(ldsV + (4 * part + e) * AT_VPB + 2 * s) = f2bf(vf[e]);
        }
    }
    __syncthreads();
    const int n_mt = SAMPLE ? 1 : 4;
    if (!SAMPLE || wv < 2) {
        for (int mt = 0; mt < n_mt; ++mt) {
            int h, tq, nt0; size_t qrow;
            if (!SAMPLE) { const int g = wv >> 1, qh = wv & 1; h = 4 * c + g; tq = 64 * qh + 16 * mt + i16; nt0 = (64 * qh + 16 * mt) >> 4; qrow = (size_t)b * SEQ + (size_t)qb * 128 + tq; }
            else { const int rho = 16 * wv + i16; h = 4 * c + (rho >> 3); tq = rho & 7; nt0 = 0; qrow = (size_t)MP + b * DSEQ + tq; }
            const float slope = exp2f(-0.5f * (float)(h + 1)), sink = sinks[h];
            bf16x8_t qf[2];
#pragma unroll
            for (int ks = 0; ks < 2; ++ks) qf[ks] = *(const bf16x8_t*)(P + qrow * NP + CQ + 64 * h + 32 * ks + 8 * qp);
            f32x4 sc[9];
#pragma unroll
            for (int jn = 0; jn < 9; ++jn) {
                const int nt = nt0 + jn;
                f32x4 acc = (f32x4){0.f, 0.f, 0.f, 0.f};
                if (SAMPLE || qb > 0 || nt >= 8) {
#pragma unroll
                    for (int ks = 0; ks < 2; ++ks) {
                        const bf16x8_t kfr = *(const LAS bf16x8_t*)(ldsK + (16 * nt + i16) * AT_KPB + (32 * ks + 8 * qp) * 2);
                        acc = __builtin_amdgcn_mfma_f32_16x16x32_bf16(kfr, qf[ks], acc, 0, 0, 0);
                    }
                }
#pragma unroll
                for (int r = 0; r < 4; ++r) {
                    const int sidx = 16 * nt + 4 * qp + r;
                    const int rel = 128 + tq - sidx;
                    bool valid = rel >= 0 && rel < 128;
                    if (!SAMPLE) valid = valid && (qb > 0 || sidx >= 128);
                    acc[r] = valid ? acc[r] * 0.125f - slope * (float)rel : -INFINITY;
                }
                sc[jn] = acc;
            }
            float mx = sink;
#pragma unroll
            for (int jn = 0; jn < 9; ++jn)
#pragma unroll
                for (int r = 0; r < 4; ++r) mx = fmaxf(mx, sc[jn][r]);
            mx = fmaxf(mx, __shfl_xor(mx, 16)); mx = fmaxf(mx, __shfl_xor(mx, 32));
            float sum = 0.f;
#pragma unroll
            for (int jn = 0; jn < 9; ++jn)
#pragma unroll
                for (int r = 0; r < 4; ++r) { const float e = __expf(sc[jn][r] - mx); sc[jn][r] = e; sum += e; }
            sum += __shfl_xor(sum, 16); sum += __shfl_xor(sum, 32);
            const float inv = __builtin_amdgcn_rcpf(sum + __expf(sink - mx));
            bf16x8_t pf[5];
#pragma unroll
            for (int ks = 0; ks < 5; ++ks) {
                u32x4 w;
                w.x = pk2bf(sc[2 * ks][0] * inv, sc[2 * ks][1] * inv); w.y = pk2bf(sc[2 * ks][2] * inv, sc[2 * ks][3] * inv);
                if (ks < 4) { w.z = pk2bf(sc[2 * ks + 1][0] * inv, sc[2 * ks + 1][1] * inv); w.w = pk2bf(sc[2 * ks + 1][2] * inv, sc[2 * ks + 1][3] * inv); }
                else { w.z = 0u; w.w = 0u; }
                pf[ks] = __builtin_bit_cast(bf16x8_t, w);
            }
#pragma unroll
            for (int dt = 0; dt < 4; ++dt) {
                f32x4 o = (f32x4){0.f, 0.f, 0.f, 0.f};
#pragma unroll
                for (int ks = 0; ks < 5; ++ks) {
                    const int ntA = nt0 + 2 * ks, ntB = (ks < 4) ? nt0 + 2 * ks + 1 : nt0 + 2 * ks;
                    const LAS unsigned char* vr = ldsV + (16 * dt + i16) * AT_VPB;
                    const u32x2 lo = *(const LAS u32x2*)(vr + 2 * (16 * ntA + 4 * qp));
                    const u32x2 hi = *(const LAS u32x2*)(vr + 2 * (16 * ntB + 4 * qp));
                    const u32x4 w = (u32x4){lo.x, lo.y, hi.x, hi.y};
                    o = __builtin_amdgcn_mfma_f32_16x16x32_bf16(__builtin_bit_cast(bf16x8_t, w), pf[ks], o, 0, 0, 0);
                }
                u32x2 ow; ow.x = pk2bf(o[0], o[1]); ow.y = pk2bf(o[2], o[3]);
                *(u32x2*)(OA + qrow * D + 64 * h + 16 * dt + 4 * qp) = ow;
            }
        }
    }
    __syncthreads();
}

template <bool PASS2>
__device__ __forceinline__ void rglru_unit(const Args& a, int L, int unit, LAS unsigned char* lds) {
    const int tid = threadIdx.x, lane = tid & 63, wv = __builtin_amdgcn_readfirstlane(tid >> 6);
    const bf16_t* P = (const bf16_t*)(a.ws + WS_P); bf16_t* OB = (bf16_t*)(a.ws + WS_OB); float* RS = (float*)(a.ws + WS_RS);
    const float* cw = a.in[10] + (size_t)L * 4 * D; const float* cb = a.in[11] + L * D; const float* wa = a.in[12] + (size_t)L * 16 * 4096; const float* ba = a.in[13] + L * D;
    const float* wx = a.in[14] + (size_t)L * 16 * 4096; const float* bx = a.in[15] + L * D; const float* lam = a.in[16] + L * D;
    const float* conv0 = a.in[4] + (size_t)L * DBATCH * 3 * D; const float* h0 = a.in[5] + (size_t)L * DBATCH * D;
    LAS float* s_xc = (LAS float*)lds + wv * 64;
    const int m0 = unit * 64;
    const bool sample = m0 >= MP;
    for (int bb = 0; bb < 2; ++bb) {
        const int bk = 2 * wv + bb, c = 64 * bk + lane;
        float war[64], wxr[64];
#pragma unroll
        for (int i = 0; i < 64; ++i) { war[i] = wa[((size_t)bk * 64 + i) * 64 + lane]; wxr[i] = wx[((size_t)bk * 64 + i) * 64 + lane]; }
        const float c0 = cw[0 * D + c], c1 = cw[1 * D + c], c2 = cw[2 * D + c], c3 = cw[3 * D + c], cbc = cb[c], bac = ba[c], bxc = bx[c];
        const float spl = softplusf_(-lam[c]);
        float x1 = 0.f, x2 = 0.f, x3 = 0.f, h = 0.f, Ap = 1.f;
        int bseq = 0, chunk = 0;
        if (!sample) {
            bseq = m0 / SEQ; chunk = (m0 % SEQ) / 64;
            if (chunk > 0) {
                x1 = bf2f(P[(size_t)(m0 - 1) * NP + CRNN + c]); x2 = bf2f(P[(size_t)(m0 - 2) * NP + CRNN + c]); x3 = bf2f(P[(size_t)(m0 - 3) * NP + CRNN + c]);
                if (PASS2) { for (int cc = 0; cc < chunk; ++cc) { const float2 ab = *(const float2*)(RS + (((size_t)bseq * 128 + cc) * D + c) * 2); h = ab.x * h + ab.y; } }
            }
        }
        for (int t = 0; t < 64; ++t) {
            const size_t m = (size_t)m0 + t;
            if (sample && (t & 7) == 0) {
                if (!PASS2) break;
                const int b = (int)(m - MP) >> 3;
                x3 = conv0[((size_t)b * 3 + 0) * D + c]; x2 = conv0[((size_t)b * 3 + 1) * D + c]; x1 = conv0[((size_t)b * 3 + 2) * D + c]; h = h0[(size_t)b * D + c];
            }
            const float x = bf2f(P[m * NP + CRNN + c]);
            const float xc = cbc + c0 * x3 + c1 * x2 + c2 * x1 + c3 * x;
            LDSW(); s_xc[lane] = xc; LDSW();
            float r = bac, ig = bxc;
#pragma unroll
            for (int i4 = 0; i4 < 16; ++i4) { const f32x4 xv = *(const LAS f32x4*)(s_xc + 4 * i4);
#pragma unroll
                for (int e = 0; e < 4; ++e) { r += xv[e] * war[4 * i4 + e]; ig += xv[e] * wxr[4 * i4 + e]; } }
            r = sigmoidf_(r); ig = sigmoidf_(ig);
            const float log_a = -8.f * r * spl;
            const float av = __expf(log_a);
            const float u = sqrtf(-expm1f(2.f * log_a)) * (ig * xc);
            h = av * h + u; Ap *= av;
            if (PASS2) OB[m * D + c] = f2bf(h);
            x3 = x2; x2 = x1; x1 = x;
            if (PASS2 && sample && (t & 7) == 7) {
                const int b = (int)(m - MP) >> 3;
                float* oc = a.out + O_SCONV + ((size_t)L * DBATCH + b) * 3 * D; float* oh = a.out + O_SH + ((size_t)L * DBATCH + b) * D;
                oh[c] = h; oc[0 * D + c] = x3; oc[1 * D + c] = x2; oc[2 * D + c] = x1;
            }
        }
        if (!sample) {
            if (!PASS2) { *(float2*)(RS + (((size_t)bseq * 128 + chunk) * D + c) * 2) = make_float2(Ap, h); }
            else if (chunk == 127) {
                float* oc = a.out + O_PCONV + ((size_t)L * NBATCH + bseq) * 3 * D; float* oh = a.out + O_PH + ((size_t)L * NBATCH + bseq) * D;
                oh[c] = h; oc[0 * D + c] = x3; oc[1 * D + c] = x2; oc[2 * D + c] = x1;
            }
        }
    }
}

__device__ __forceinline__ void phase_elem_mixa(const Args& a, int L) {
    const bf16_t* P = (const bf16_t*)(a.ws + WS_P); bf16_t* AC = (bf16_t*)(a.ws + WS_ACAT);
    const float* mu = a.in[17] + (size_t)L * SHIFT_W; const float* shift0 = a.in[6] + (size_t)L * DBATCH * SHIFT_W;
    const size_t gt = (size_t)blockIdx.x * NTHREADS + threadIdx.x, gs = (size_t)gridDim.x * NTHREADS;
    for (unsigned i = (unsigned)gt; i < (unsigned)(M * ACAT_K); i += (unsigned)gs) {
        const unsigned m = i / ACAT_K; const int j = (int)(i - m * ACAT_K);
        float o = 0.f;
        if (j < 288) {
            const int ch = 3072 + j;
            const float pc = bf2f(P[(size_t)m * NP + CRW + ch]);
            float pv;
            if (m < (unsigned)MP) pv = (m % SEQ) == 0 ? 0.f : bf2f(P[(size_t)(m - 1) * NP + CRW + ch]);
            else pv = ((m - MP) % DSEQ) == 0 ? shift0[(size_t)((m - MP) / DSEQ) * SHIFT_W + ch] : bf2f(P[(size_t)(m - 1) * NP + CRW + ch]);
            const float ps = pc + mu[ch] * (pv - pc);
            o = j < 64 ? 1.f - 2.f * __builtin_amdgcn_rcpf(__expf(2.f * ps) + 1.f) : (j < 128 ? ps : sigmoidf_(ps));
        }
        AC[i] = f2bf(o);
    }
}
__device__ __forceinline__ void phase_state_copies(const Args& a, int L, int first) {
    const bf16_t* P = (const bf16_t*)(a.ws + WS_P);
    if ((int)blockIdx.x < first) return;
    const size_t gt = (size_t)(blockIdx.x - first) * NTHREADS + threadIdx.x, gs = (size_t)(gridDim.x - first) * NTHREADS;
    const float* ck = a.in[2] + (size_t)L * DBATCH * 128 * 256; const float* cv = a.in[3] + (size_t)L * DBATCH * 128 * 256;
    float* pk = a.out + O_PK + (size_t)L * NBATCH * 128 * 256; float* pv_ = a.out + O_PV + (size_t)L * NBATCH * 128 * 256;
    float* pshift = a.out + O_PSHIFT + (size_t)L * NBATCH * SHIFT_W; float* sk = a.out + O_SK + (size_t)L * DBATCH * 128 * 256; float* sv = a.out + O_SV + (size_t)L * DBATCH * 128 * 256;
    float* sshift = a.out + O_SSHIFT + (size_t)L * DBATCH * SHIFT_W;
    const size_t n_pk = (size_t)NBATCH * 128 * 256, n_sk = (size_t)DBATCH * 128 * 256, n_ps = (size_t)NBATCH * SHIFT_W, n_ss = (size_t)DBATCH * SHIFT_W;
    auto ld4 = [&](const bf16_t* p) -> f32x4 { const u32x2 w = *(const u32x2*)p; return (f32x4){__uint_as_float(w.x << 16), __uint_as_float(w.x & 0xffff0000u), __uint_as_float(w.y << 16), __uint_as_float(w.y & 0xffff0000u)}; };
    for (unsigned i4 = (unsigned)gt; i4 < (unsigned)((n_pk + n_sk + n_ps + n_ss) / 4); i4 += (unsigned)gs) {
        const unsigned i = 4 * i4;
        if (i < n_pk) {
            const int b = (int)(i / (128 * 256)), s = (int)((i / 256) % 128), e = (int)(i % 256);
            const size_t row = (size_t)b * SEQ + (SEQ - 128) + s;
            *(f32x4*)(pk + i) = ld4(P + row * NP + CK + e); *(f32x4*)(pv_ + i) = ld4(P + row * NP + CV + e);
            continue;
        }
        unsigned k = i - (unsigned)n_pk;
        if (k < n_sk) {
            const int b = (int)(k / (128 * 256)), s = (int)((k / 256) % 128), e = (int)(k % 256);
            if (s < 120) { *(f32x4*)(sk + k) = *(const f32x4*)(ck + ((size_t)b * 128 + s + 8) * 256 + e); *(f32x4*)(sv + k) = *(const f32x4*)(cv + ((size_t)b * 128 + s + 8) * 256 + e); }
            else { const size_t row = (size_t)MP + b * DSEQ + (s - 120); *(f32x4*)(sk + k) = ld4(P + row * NP + CK + e); *(f32x4*)(sv + k) = ld4(P + row * NP + CV + e); }
            continue;
        }
        k -= (unsigned)n_sk;
        if (k < n_ps) { const int b = (int)(k / SHIFT_W), ch = (int)(k % SHIFT_W); *(f32x4*)(pshift + k) = ld4(P + ((size_t)b * SEQ + SEQ - 1) * NP + CRW + ch); continue; }
        k -= (unsigned)n_ps;
        { const int b = (int)(k / SHIFT_W), ch = (int)(k % SHIFT_W); *(f32x4*)(sshift + k) = ld4(P + ((size_t)MP + b * DSEQ + DSEQ - 1) * NP + CRW + ch); }
    }
}

#ifndef PROBE_MIXA
#define PROBE_MIXA 0
#endif
__device__ __forceinline__ void phase_mixa_units(const Args& a, int L, LAS unsigned char* lds) {
    const bf16_t* P = (const bf16_t*)(a.ws + WS_P); bf16_t* OA = (bf16_t*)(a.ws + WS_OA);
    const float* sinks = a.in[9] + L * 16; const float* ck = a.in[2] + (size_t)L * DBATCH * 128 * 256; const float* cv = a.in[3] + (size_t)L * DBATCH * 128 * 256;
    constexpr int N_RG1 = MP / 64, N_AP = NBATCH * 64 * 4, N_AS = DBATCH * 4;
    for (int it = blockIdx.x; it < N_RG1; it += gridDim.x) { rglru_unit2<false>(a, L, it, lds); __syncthreads(); }
    if (PROBE_MIXA & 2) for (int it = blockIdx.x; it < N_RG1; it += gridDim.x) { rglru_unit2<false>(a, L, it, lds); __syncthreads(); }
    for (int r = blockIdx.x; r < N_AP; r += gridDim.x) { const int c = r & 3, qb = (r >> 2) & 63, b = r >> 8; attn_unit<false>(P, OA, sinks, ck, cv, b, qb, c, lds); }
    if (PROBE_MIXA & 4) for (int r = blockIdx.x; r < N_AP; r += gridDim.x) { const int c = r & 3, qb = (r >> 2) & 63, b = r >> 8; attn_unit<false>(P, OA, sinks, ck, cv, b, qb, c, lds); }
    for (int r = blockIdx.x; r < N_AS; r += gridDim.x) { const int c = r & 3, b = r >> 2; attn_unit<true>(P, OA, sinks, ck, cv, b, 0, c, lds); }
    if (PROBE_MIXA & 8) for (int r = blockIdx.x; r < N_AS; r += gridDim.x) { const int c = r & 3, b = r >> 2; attn_unit<true>(P, OA, sinks, ck, cv, b, 0, c, lds); }
}

struct EpiLora {
    static constexpr bool PERM = true, AFTER_DRAIN = false;
    bf16_t* WAW; bf16_t* WAA; bf16_t* WAG; const float* w0; const float* a0;
    __device__ __forceinline__ void operator()(const f32x4 (&acc)[2][2][4][2], const pg8::Unit& u, int wr, int wc, int fr, int fq) const {
        const int row0 = u.pm * 256 + wr * 64 + fr, kind = u.pn >> 2, colb = (u.pn & 3) * 256 + wc * 32 + 8 * fq;
        const float* bsrc = kind == 0 ? w0 : a0;
        f32x4 bias[2][2];
#pragma unroll
        for (int bj = 0; bj < 2; ++bj)
#pragma unroll
            for (int n = 0; n < 2; ++n) bias[bj][n] = kind == 2 ? (f32x4){0.f, 0.f, 0.f, 0.f} : *(const f32x4*)(bsrc + colb + bj * 128 + 4 * n);
#pragma unroll
        for (int ai = 0; ai < 2; ++ai)
#pragma unroll
            for (int m = 0; m < 4; ++m) {
                const size_t off = (size_t)(row0 + ai * 128 + m * 16) * D + colb;
#pragma unroll
                for (int bj = 0; bj < 2; ++bj) {
                    f32x4 v0 = acc[ai][bj][m][0] + bias[bj][0], v1 = acc[ai][bj][m][1] + bias[bj][1];
                    if (kind == 0) {
#pragma unroll
                        for (int i = 0; i < 4; ++i) {
                            v0[i] = -__expf(-(fmaxf(-v0[i], 0.f) + __logf(1.f + __expf(-fabsf(v0[i])))) - 0.5f);
                            v1[i] = -__expf(-(fmaxf(-v1[i], 0.f) + __logf(1.f + __expf(-fabsf(v1[i])))) - 0.5f);
                        }
                    } else if (kind == 1) {
#pragma unroll
                        for (int i = 0; i < 4; ++i) { v0[i] = sigmoidf_(v0[i]); v1[i] = sigmoidf_(v1[i]); }
                    }
                    u32x4 w; w.x = pk2bf(v0[0], v0[1]); w.y = pk2bf(v0[2], v0[3]); w.z = pk2bf(v1[0], v1[1]); w.w = pk2bf(v1[2], v1[3]);
                    *(u32x4*)(WAW + (size_t)kind * ((size_t)M * D) + off + bj * 128) = w;
                }
                asm volatile("" ::: "memory");
            }
    }
};

__device__ __forceinline__ void phase_mixc(const Args& a, int L, bf16_t* DST) {
    const int lane = threadIdx.x & 63, wv = threadIdx.x >> 6;
    const bf16_t* P = (const bf16_t*)(a.ws + WS_P); const bf16_t* WAG = (const bf16_t*)(a.ws + WS_WAG); const bf16_t* Y = (const bf16_t*)(a.ws + WS_Y); const float* BD = (const float*)(a.ws + WS_BD);
    bf16_t* OA = (bf16_t*)(a.ws + WS_OA); const bf16_t* OB = (const bf16_t*)(a.ws + WS_OB);
    const float* mu = a.in[17] + (size_t)L * SHIFT_W + 2048; const float* shift0 = a.in[6] + (size_t)L * DBATCH * SHIFT_W + 2048;
    const int c0 = 16 * lane, h = lane >> 2;
    float lw[16], lb[16], muv[16];
#pragma unroll
    for (int i = 0; i < 16; ++i) { lw[i] = a.in[26][L * D + c0 + i]; lb[i] = a.in[27][L * D + c0 + i]; muv[i] = mu[c0 + i]; }
    for (int m = blockIdx.x * NWAVES + wv; m < M; m += gridDim.x * NWAVES) {
        float y[16];
        { u32x4 yv[2]; yv[0] = *(const u32x4*)(Y + (size_t)m * D + c0); yv[1] = *(const u32x4*)(Y + (size_t)m * D + c0 + 8);
#pragma unroll
          for (int i = 0; i < 16; ++i) y[i] = __uint_as_float((i & 1) ? (yv[i >> 3][(i >> 1) & 3] & 0xffff0000u) : (yv[i >> 3][(i >> 1) & 3] << 16)); }
        float s = 0.f;
#pragma unroll
        for (int i = 0; i < 16; ++i) s += y[i];
        s += __shfl_xor(s, 1); s += __shfl_xor(s, 2);
        const float mean = s * (1.f / 64.f);
        float q = 0.f;
#pragma unroll
        for (int i = 0; i < 16; ++i) { y[i] -= mean; q += y[i] * y[i]; }
        q += __shfl_xor(q, 1); q += __shfl_xor(q, 2);
        const float rstd = rsqrtf(q * (1.f / 64.f) + GN_EPS);
        const float bd = BD[(size_t)m * 16 + h];
        const bool first = m < MP ? (m % SEQ) == 0 : ((m - MP) % DSEQ) == 0;
        const bf16_t* pr = P + (size_t)m * NP + CRW + 2048 + c0;
#define BFX(v, i) __uint_as_float((((i) & 1) ? ((v)[(i) >> 3][((i) >> 1) & 3] & 0xffff0000u) : ((v)[(i) >> 3][((i) >> 1) & 3] << 16)))
        u32x4 pcv[2], ppv[2], gv[2], gav[2], gbv[2], gcv[2], oav[2], obv[2];
        pcv[0] = *(const u32x4*)pr; pcv[1] = *(const u32x4*)(pr + 8);
        ppv[0] = pcv[0]; ppv[1] = pcv[1];
        if (!first) { ppv[0] = *(const u32x4*)(pr - NP); ppv[1] = *(const u32x4*)(pr - NP + 8); }
        gv[0] = *(const u32x4*)(WAG + (size_t)m * D + c0); gv[1] = *(const u32x4*)(WAG + (size_t)m * D + c0 + 8);
        const bf16_t* pg = P + (size_t)m * NP + CG + c0;
        gav[0] = *(const u32x4*)pg; gav[1] = *(const u32x4*)(pg + 8);
        gbv[0] = *(const u32x4*)(pg + 1024); gbv[1] = *(const u32x4*)(pg + 1024 + 8);
        gcv[0] = *(const u32x4*)(pg + 2048); gcv[1] = *(const u32x4*)(pg + 2048 + 8);
        oav[0] = *(const u32x4*)(OA + (size_t)m * D + c0); oav[1] = *(const u32x4*)(OA + (size_t)m * D + c0 + 8);
        obv[0] = *(const u32x4*)(OB + (size_t)m * D + c0); obv[1] = *(const u32x4*)(OB + (size_t)m * D + c0 + 8);
        float o[16];
#pragma unroll
        for (int i = 0; i < 16; ++i) {
            const float pc = BFX(pcv, i);
            float pv;
            if (first) pv = m < MP ? 0.f : shift0[(size_t)((m - MP) / DSEQ) * SHIFT_W + c0 + i];
            else pv = BFX(ppv, i);
            const float vv = pc + muv[i] * (pv - pc);
            const float yn = y[i] * rstd * lw[i] + lb[i];
            const float oc = (yn + bd * vv) * BFX(gv, i);
            o[i] = BFX(gav, i) * BFX(oav, i) + BFX(gbv, i) * BFX(obv, i) + BFX(gcv, i) * oc;
        }
        u32x4 w0, w1;
        w0.x = pk2bf(o[0], o[1]); w0.y = pk2bf(o[2], o[3]); w0.z = pk2bf(o[4], o[5]); w0.w = pk2bf(o[6], o[7]);
        w1.x = pk2bf(o[8], o[9]); w1.y = pk2bf(o[10], o[11]); w1.z = pk2bf(o[12], o[13]); w1.w = pk2bf(o[14], o[15]);
        *(u32x4*)(DST + (size_t)m * D + c0) = w0; *(u32x4*)(DST + (size_t)m * D + c0 + 8) = w1;
    }
}

constexpr int CH_OFF_AA = 0, CH_OFF_RA = 2048, CH_OFF_MC = 4096, CH_OFF_TL = 5120  , CH_OFF_BT = 5632, CH_OFF_KT = 7808, CH_OFF_VT = 9984, CH_OFF_GM = 12160, CH_SLOT = 12416;
constexpr int CH_TP = 136;
__device__ __forceinline__ float row_prefix16(float x) {
    x += __builtin_bit_cast(float, __builtin_amdgcn_update_dpp(0, __builtin_bit_cast(int, x), 0x111, 0xF, 0xF, true));
    x += __builtin_bit_cast(float, __builtin_amdgcn_update_dpp(0, __builtin_bit_cast(int, x), 0x112, 0xF, 0xF, true));
    x += __builtin_bit_cast(float, __builtin_amdgcn_update_dpp(0, __builtin_bit_cast(int, x), 0x114, 0xF, 0xF, true));
    x += __builtin_bit_cast(float, __builtin_amdgcn_update_dpp(0, __builtin_bit_cast(int, x), 0x118, 0xF, 0xF, true));
    return x;
}
__device__ __forceinline__ f32x4 prod16(const f32x4 xt, const f32x4 y) {
    f32x4 z = (f32x4){0.f, 0.f, 0.f, 0.f};
#pragma unroll
    for (int r = 0; r < 4; ++r) z = __builtin_amdgcn_mfma_f32_16x16x4f32(xt[r], y[r], z, 0, 0, 0);
    return z;
}
__device__ __forceinline__ f32x4 gram(const bf16x8_t (&x)[2], const bf16x8_t (&y)[2]) {
    f32x4 z = (f32x4){0.f, 0.f, 0.f, 0.f};
    z = __builtin_amdgcn_mfma_f32_16x16x32_bf16(x[0], y[0], z, 0, 0, 0);
    z = __builtin_amdgcn_mfma_f32_16x16x32_bf16(x[1], y[1], z, 0, 0, 0);
    return z;
}

struct ChunkRaw { u32x2 cr[4], ck[4], cv[4], a[4], x[4]; };
constexpr int CH_PAR_OFF = 8 * CH_SLOT;
constexpr int CH_PAR_BYTES = 6 * 64 * 4;
__device__ __forceinline__ void stage_head_params(const Args& a, int L, int h, LAS unsigned char* par, int lane) {
    LAS float* p = (LAS float*)par; const int c = 64 * h + lane;
    p[lane] = a.in[17][(size_t)L * SHIFT_W + c]; p[64 + lane] = a.in[17][(size_t)L * SHIFT_W + 1024 + c]; p[128 + lane] = a.in[17][(size_t)L * SHIFT_W + 2048 + c];
    p[192 + lane] = a.in[23][L * D + c]; p[256 + lane] = a.in[24][L * D + c]; p[320 + lane] = a.in[25][L * D + c];
}
__device__ __forceinline__ void chunk_load(const Args& a, size_t m0, int h, int ntok, int lane, ChunkRaw& R) {
    asm volatile("" : "+v"(lane));
    const int i16 = lane & 15, qp = lane >> 4;
    const bf16_t* P = (const bf16_t*)(a.ws + WS_P); const bf16_t* WAW = (const bf16_t*)(a.ws + WS_WAW); const bf16_t* WAA = (const bf16_t*)(a.ws + WS_WAA);
    const size_t m = m0 + (i16 < ntok ? i16 : 0);
#pragma unroll
    for (int r = 0; r < 4; ++r) {
        const int c = 64 * h + 16 * r + 4 * qp;
        const bf16_t* pr = P + m * NP + CRW + c;
        R.cr[r] = *(const u32x2*)pr; R.ck[r] = *(const u32x2*)(pr + 1024); R.cv[r] = *(const u32x2*)(pr + 2048);
        R.x[r] = *(const u32x2*)(WAW + m * D + c);
        R.a[r] = *(const u32x2*)(WAA + m * D + c);
    }
}
__device__ __forceinline__ unsigned dpp_prev_row(unsigned old, unsigned src) { return (unsigned)__builtin_amdgcn_update_dpp((int)old, (int)src, 0x111, 0xF, 0xF, false); }
template <class PF> __device__ __forceinline__ void chunk_compute(const Args& a, const ChunkRaw& R, size_t m0, int h, int ntok, bool seq_start, const float* sh0, const LAS unsigned char* par_, LAS unsigned char* slot, int lane, PF pf) {
    asm volatile("" : "+v"(lane));
    const int i16 = lane & 15, qp = lane >> 4;
    float* BD = (float*)(a.ws + WS_BD);
    const LAS float* par = (const LAS float*)par_;
    const bool valid = i16 < ntok;
    const size_t m = m0 + (valid ? i16 : 0);
    u32x2 p0r[4], p0k[4], p0v[4];
    {
        const bf16_t* P = (const bf16_t*)(a.ws + WS_P);
#pragma unroll
        for (int r = 0; r < 4; ++r) {
            const int c = 64 * h + 16 * r + 4 * qp;
            if (!seq_start) { const bf16_t* pp = P + (m0 - 1) * NP + CRW + c; p0r[r] = *(const u32x2*)pp; p0k[r] = *(const u32x2*)(pp + 1024); p0v[r] = *(const u32x2*)(pp + 2048); }
            else if (sh0) { const f32x4 fr_ = *(const f32x4*)(sh0 + c), fk_ = *(const f32x4*)(sh0 + 1024 + c), fv_ = *(const f32x4*)(sh0 + 2048 + c);
                p0r[r] = pk4(fr_[0], fr_[1], fr_[2], fr_[3]); p0k[r] = pk4(fk_[0], fk_[1], fk_[2], fk_[3]); p0v[r] = pk4(fv_[0], fv_[1], fv_[2], fv_[3]); }
            else { p0r[r] = (u32x2){0u, 0u}; p0k[r] = p0r[r]; p0v[r] = p0r[r]; }
        }
    }
    float abu[16], bbu[16];
    u32x2 pa[4], pb[4], pkk[4], prr[4];
    float ssq = 0.f, bdp = 0.f;
#pragma unroll
    for (int r = 0; r < 4; ++r) {
        const int cb = 16 * r + 4 * qp, c = 64 * h + cb;
        const u32x2 cr = R.cr[r], ck_ = R.ck[r], cv_ = R.cv[r], a4 = R.a[r];
        u32x2 pr_, pk_, pv_;
        pr_.x = dpp_prev_row(p0r[r].x, cr.x); pr_.y = dpp_prev_row(p0r[r].y, cr.y); pk_.x = dpp_prev_row(p0k[r].x, ck_.x); pk_.y = dpp_prev_row(p0k[r].y, ck_.y);
        pv_.x = dpp_prev_row(p0v[r].x, cv_.x); pv_.y = dpp_prev_row(p0v[r].y, cv_.y);
        const u32x2 x4 = R.x[r];
        const f32x4 mur = *(const LAS f32x4*)(par + cb), muk = *(const LAS f32x4*)(par + 64 + cb), muv = *(const LAS f32x4*)(par + 128 + cb);
        const f32x4 kkc = *(const LAS f32x4*)(par + 192 + cb), kac = *(const LAS f32x4*)(par + 256 + cb), rkc = *(const LAS f32x4*)(par + 320 + cb);
        float vv[4], kb[4], rb[4];
#pragma unroll
        for (int i = 0; i < 4; ++i) {
            const unsigned wr_ = i < 2 ? cr.x : cr.y, wk_ = i < 2 ? ck_.x : ck_.y, wv_ = i < 2 ? cv_.x : cv_.y, wa_ = i < 2 ? a4.x : a4.y, wx_ = i < 2 ? x4.x : x4.y;
            const unsigned qr_ = i < 2 ? pr_.x : pr_.y, qk_ = i < 2 ? pk_.x : pk_.y, qv_ = i < 2 ? pv_.x : pv_.y;
            const float c_r = __uint_as_float((i & 1) ? (wr_ & 0xffff0000u) : (wr_ << 16)), c_k = __uint_as_float((i & 1) ? (wk_ & 0xffff0000u) : (wk_ << 16)),
                        c_v = __uint_as_float((i & 1) ? (wv_ & 0xffff0000u) : (wv_ << 16)), a_ = __uint_as_float((i & 1) ? (wa_ & 0xffff0000u) : (wa_ << 16));
            const float p_r = __uint_as_float((i & 1) ? (qr_ & 0xffff0000u) : (qr_ << 16)), p_k = __uint_as_float((i & 1) ? (qk_ & 0xffff0000u) : (qk_ << 16)),
                  p_v = __uint_as_float((i & 1) ? (qv_ & 0xffff0000u) : (qv_ << 16));
            float r_ = c_r + mur[i] * (p_r - c_r), kx = c_k + muk[i] * (p_k - c_k), v_ = c_v + muv[i] * (p_v - c_v);
            float lw_ = __uint_as_float((i & 1) ? (wx_ & 0xffff0000u) : (wx_ << 16));
            if (!valid) { r_ = 0.f; kx = 0.f; v_ = 0.f; lw_ = 0.f; }
            const float kkr = kx * kkc[i];
            const float k2_ = kx * (1.f + (a_ - 1.f) * kac[i]);
            ssq += kkr * kkr; bdp += r_ * k2_ * rkc[i];
            const float g = row_prefix16(lw_);
            const float eg = __expf(g), egx = __expf(g - lw_), eng = __expf(-g);
            const int e = 4 * r + i;
            abu[e] = -kkr * egx; bbu[e] = kkr * a_ * eng; kb[i] = k2_ * eng; rb[i] = r_ * eg; vv[i] = v_;
            if (i16 == 15) *(LAS float*)(slot + CH_OFF_GM + 4 * (cb + i)) = eg;
        }
        const int off = i16 * CH_TP + cb * 2;
        pkk[r] = pk4(kb[0], kb[1], kb[2], kb[3]); prr[r] = pk4(rb[0], rb[1], rb[2], rb[3]);
        *(LAS u32x2*)(slot + CH_OFF_VT + off) = pk4(vv[0], vv[1], vv[2], vv[3]);
        *(LAS u32x2*)(slot + CH_OFF_KT + off) = pkk[r];
        asm volatile("" : "+v"(ssq), "+v"(bdp));
        __builtin_amdgcn_sched_barrier(0);
    }
    __builtin_amdgcn_sched_barrier(0);
    pf();
    __builtin_amdgcn_sched_barrier(0);
    ssq += __shfl_xor(ssq, 16); ssq += __shfl_xor(ssq, 32);
    bdp += __shfl_xor(bdp, 16); bdp += __shfl_xor(bdp, 32);
    if (valid && qp == 0) BD[m * 16 + h] = bdp;
    const float inrm = __builtin_amdgcn_rcpf(fmaxf(__builtin_amdgcn_sqrtf(ssq), 1e-12f));
#pragma unroll
    for (int r = 0; r < 4; ++r) {
        pa[r] = pk4(abu[4 * r] * inrm, abu[4 * r + 1] * inrm, abu[4 * r + 2] * inrm, abu[4 * r + 3] * inrm);
        pb[r] = pk4(bbu[4 * r] * inrm, bbu[4 * r + 1] * inrm, bbu[4 * r + 2] * inrm, bbu[4 * r + 3] * inrm);
        const int off = i16 * CH_TP + (16 * r + 4 * qp) * 2;
        *(LAS u32x2*)(slot + CH_OFF_AA + off) = pa[r];
        *(LAS u32x2*)(slot + CH_OFF_BT + off) = pb[r];
    }
    __builtin_amdgcn_sched_barrier(0);
    bf16x8_t fa[2], fb[2], fk[2], fr[2];
#pragma unroll
    for (int ks = 0; ks < 2; ++ks) { fa[ks] = mk_frag(pa[2 * ks], pa[2 * ks + 1]); fb[ks] = mk_frag(pb[2 * ks], pb[2 * ks + 1]); fk[ks] = mk_frag(pkk[2 * ks], pkk[2 * ks + 1]); fr[ks] = mk_frag(prr[2 * ks], prr[2 * ks + 1]); }
    f32x4 Lc = gram(fa, fb), Nc = gram(fb, fa), Lak = gram(fa, fk), MrbT = gram(fb, fr), MrkT = gram(fk, fr);
#pragma unroll
    for (int r = 0; r < 4; ++r) {
        const int row = 4 * qp + r;
        Lc[r] = row > i16 ? Lc[r] : 0.f;
        Lak[r] = row > i16 ? Lak[r] : 0.f;
        Nc[r] = row < i16 ? Nc[r] : 0.f;
        MrbT[r] = row <= i16 ? MrbT[r] : 0.f;
        MrkT[r] = row <= i16 ? MrkT[r] : 0.f;
    }
    __builtin_amdgcn_sched_barrier(0);
    f32x4 eye;
#pragma unroll
    for (int r = 0; r < 4; ++r) eye[r] = (4 * qp + r == i16) ? 1.f : 0.f;
    const f32x4 L2 = prod16(Nc, Lc), N2 = prod16(Lc, Nc);
    const f32x4 L4 = prod16(N2, L2), N4 = prod16(L2, N2);
    const f32x4 N8 = prod16(L4, N4);
    const f32x4 Q1 = prod16(Lc + eye, N2 + eye), Q1T = prod16(N2 + eye, Lc + eye), Q2 = prod16(L4 + eye, N8 + eye);
    const f32x4 TT = prod16(Q1T, Q2);
    const f32x4 TLk = prod16(Lak, TT);
    __builtin_amdgcn_sched_barrier(0);
    LDSW();
    const bf16x8_t ttf = mk_frag(pk4(TT[0], TT[1], TT[2], TT[3]), (u32x2){0u, 0u});
    f32x4 at[4];
#pragma unroll
    for (int kt = 0; kt < 4; ++kt) {
        const u32x2 ac = tr_read4(slot + CH_OFF_AA + (4 * qp + (i16 >> 2)) * CH_TP + (16 * kt + 4 * (i16 & 3)) * 2);
        at[kt] = __builtin_amdgcn_mfma_f32_16x16x32_bf16(mk_frag(ac, (u32x2){0u, 0u}), ttf, (f32x4){0.f, 0.f, 0.f, 0.f}, 0, 0, 0);
    }
    LDSW();
#pragma unroll
    for (int ks = 0; ks < 2; ++ks) {
        const u32x2 lo = pk4(at[2 * ks][0], at[2 * ks][1], at[2 * ks][2], at[2 * ks][3]), hi = pk4(at[2 * ks + 1][0], at[2 * ks + 1][1], at[2 * ks + 1][2], at[2 * ks + 1][3]);
        *(LAS u32x4*)(slot + CH_OFF_AA + ks * 1024 + lane * 16) = (u32x4){lo.x, lo.y, hi.x, hi.y};
        *(LAS u32x4*)(slot + CH_OFF_RA + ks * 1024 + lane * 16) = __builtin_bit_cast(u32x4, fr[ks]);
    }
    {
        const u32x2 mb = pk4(MrbT[0], MrbT[1], MrbT[2], MrbT[3]), mk = pk4(MrkT[0], MrkT[1], MrkT[2], MrkT[3]), tl = pk4(TLk[0], TLk[1], TLk[2], TLk[3]);
        *(LAS u32x4*)(slot + CH_OFF_MC + lane * 16) = (u32x4){mb.x, mb.y, mk.x, mk.y};
        *(LAS u32x2*)(slot + CH_OFF_TL + lane * 8) = tl;
    }
}

struct ChainFrag { u32x4 aa0, aa1, ra0, ra1, mc, tl; u32x2 vq4, b4[4], k4[4]; f32x4 gm[4]; };
__device__ __forceinline__ void chain_fetch(LAS unsigned char* slot, int vq, int lane, ChainFrag& F) {
    const int i16 = lane & 15, qp = lane >> 4;
    const int troff = (4 * qp + (i16 >> 2)) * CH_TP + 8 * (i16 & 3);
    { const u32x2 t2 = *(const LAS u32x2*)(slot + CH_OFF_TL + lane * 8); F.tl = (u32x4){t2.x, t2.y, 0u, 0u}; }
    F.vq4 = tr_read4(slot + CH_OFF_VT + troff + 32 * vq);
    F.aa0 = *(const LAS u32x4*)(slot + CH_OFF_AA + lane * 16); F.aa1 = *(const LAS u32x4*)(slot + CH_OFF_AA + 1024 + lane * 16);
    F.ra0 = *(const LAS u32x4*)(slot + CH_OFF_RA + lane * 16); F.ra1 = *(const LAS u32x4*)(slot + CH_OFF_RA + 1024 + lane * 16);
    F.mc = *(const LAS u32x4*)(slot + CH_OFF_MC + lane * 16);
#pragma unroll
    for (int kt = 0; kt < 4; ++kt) {
        F.b4[kt] = tr_read4(slot + CH_OFF_BT + troff + 32 * kt); F.k4[kt] = tr_read4(slot + CH_OFF_KT + troff + 32 * kt);
        F.gm[kt] = *(const LAS f32x4*)(slot + CH_OFF_GM + 4 * (16 * kt + 4 * qp));
    }
}
__device__ __forceinline__ f32x4 chain_math(const ChainFrag& F, f32x4 (&ST)[4]) {
    const f32x4 z4 = (f32x4){0.f, 0.f, 0.f, 0.f};
    const f32x4 tlv = __builtin_amdgcn_mfma_f32_16x16x32_bf16(__builtin_bit_cast(bf16x8_t, F.tl), mk_frag(F.vq4, F.vq4), z4, 0, 0, 0);
    bf16x8_t sb[2];
#pragma unroll
    for (int ks = 0; ks < 2; ++ks) sb[ks] = mk_frag(pk4(ST[2 * ks][0], ST[2 * ks][1], ST[2 * ks][2], ST[2 * ks][3]), pk4(ST[2 * ks + 1][0], ST[2 * ks + 1][1], ST[2 * ks + 1][2], ST[2 * ks + 1][3]));
    const f32x4 u1 = __builtin_amdgcn_mfma_f32_16x16x32_bf16(__builtin_bit_cast(bf16x8_t, F.aa0), sb[0], z4, 0, 0, 0);
    const f32x4 u2 = __builtin_amdgcn_mfma_f32_16x16x32_bf16(__builtin_bit_cast(bf16x8_t, F.aa1), sb[1], tlv, 0, 0, 0);
    f32x4 Y = __builtin_amdgcn_mfma_f32_16x16x32_bf16(__builtin_bit_cast(bf16x8_t, F.ra0), sb[0], z4, 0, 0, 0);
    const f32x4 y2 = __builtin_amdgcn_mfma_f32_16x16x32_bf16(__builtin_bit_cast(bf16x8_t, F.ra1), sb[1], z4, 0, 0, 0);
    const f32x4 U = u1 + u2;
    const bf16x8_t uv = mk_frag(pk4(U[0], U[1], U[2], U[3]), F.vq4);
#pragma unroll
    for (int kt = 0; kt < 4; ++kt) {
        ST[kt] = __builtin_amdgcn_mfma_f32_16x16x32_bf16(mk_frag(F.b4[kt], F.k4[kt]), uv, ST[kt], 0, 0, 0);
        ST[kt] = ST[kt] * F.gm[kt];
    }
    Y = __builtin_amdgcn_mfma_f32_16x16x32_bf16(__builtin_bit_cast(bf16x8_t, F.mc), uv, Y, 0, 0, 0);
    return Y + y2;
}
struct ChainFrag2 { u32x4 aa0, aa1, ra0, ra1, mc, tl; u32x2 va, vb, b4[4], k4[4]; f32x4 gm[4]; };
__device__ __forceinline__ void chain_fetch2(LAS unsigned char* slot, int vq0, int lane, ChainFrag2& F) {
    const int i16 = lane & 15, qp = lane >> 4;
    const int troff = (4 * qp + (i16 >> 2)) * CH_TP + 8 * (i16 & 3);
    { const u32x2 t2 = *(const LAS u32x2*)(slot + CH_OFF_TL + lane * 8); F.tl = (u32x4){t2.x, t2.y, 0u, 0u}; }
    F.va = tr_read4(slot + CH_OFF_VT + troff + 32 * vq0); F.vb = tr_read4(slot + CH_OFF_VT + troff + 32 * (vq0 + 1));
    F.aa0 = *(const LAS u32x4*)(slot + CH_OFF_AA + lane * 16); F.aa1 = *(const LAS u32x4*)(slot + CH_OFF_AA + 1024 + lane * 16);
    F.ra0 = *(const LAS u32x4*)(slot + CH_OFF_RA + lane * 16); F.ra1 = *(const LAS u32x4*)(slot + CH_OFF_RA + 1024 + lane * 16);
    F.mc = *(const LAS u32x4*)(slot + CH_OFF_MC + lane * 16);
#pragma unroll
    for (int kt = 0; kt < 4; ++kt) {
        F.b4[kt] = tr_read4(slot + CH_OFF_BT + troff + 32 * kt); F.k4[kt] = tr_read4(slot + CH_OFF_KT + troff + 32 * kt);
        F.gm[kt] = *(const LAS f32x4*)(slot + CH_OFF_GM + 4 * (16 * kt + 4 * qp));
    }
}
__device__ __forceinline__ void chain_math2(const ChainFrag2& F, f32x4 (&SA)[4], f32x4 (&SB)[4], f32x4& YA, f32x4& YB) {
    const f32x4 z4 = (f32x4){0.f, 0.f, 0.f, 0.f};
    const bf16x8_t tl = __builtin_bit_cast(bf16x8_t, F.tl), aa0 = __builtin_bit_cast(bf16x8_t, F.aa0), aa1 = __builtin_bit_cast(bf16x8_t, F.aa1),
                   ra0 = __builtin_bit_cast(bf16x8_t, F.ra0), ra1 = __builtin_bit_cast(bf16x8_t, F.ra1), mc = __builtin_bit_cast(bf16x8_t, F.mc);
    const f32x4 tlva = __builtin_amdgcn_mfma_f32_16x16x32_bf16(tl, mk_frag(F.va, F.va), z4, 0, 0, 0);
    const f32x4 tlvb = __builtin_amdgcn_mfma_f32_16x16x32_bf16(tl, mk_frag(F.vb, F.vb), z4, 0, 0, 0);
    bf16x8_t sa[2], sb[2];
#pragma unroll
    for (int ks = 0; ks < 2; ++ks) {
        sa[ks] = mk_frag(pk4(SA[2 * ks][0], SA[2 * ks][1], SA[2 * ks][2], SA[2 * ks][3]), pk4(SA[2 * ks + 1][0], SA[2 * ks + 1][1], SA[2 * ks + 1][2], SA[2 * ks + 1][3]));
        sb[ks] = mk_frag(pk4(SB[2 * ks][0], SB[2 * ks][1], SB[2 * ks][2], SB[2 * ks][3]), pk4(SB[2 * ks + 1][0], SB[2 * ks + 1][1], SB[2 * ks + 1][2], SB[2 * ks + 1][3]));
    }
    const f32x4 ua1 = __builtin_amdgcn_mfma_f32_16x16x32_bf16(aa0, sa[0], z4, 0, 0, 0);
    const f32x4 ub1 = __builtin_amdgcn_mfma_f32_16x16x32_bf16(aa0, sb[0], z4, 0, 0, 0);
    const f32x4 ua2 = __builtin_amdgcn_mfma_f32_16x16x32_bf16(aa1, sa[1], tlva, 0, 0, 0);
    const f32x4 ub2 = __builtin_amdgcn_mfma_f32_16x16x32_bf16(aa1, sb[1], tlvb, 0, 0, 0);
    f32x4 ya = __builtin_amdgcn_mfma_f32_16x16x32_bf16(ra0, sa[0], z4, 0, 0, 0);
    f32x4 yb = __builtin_amdgcn_mfma_f32_16x16x32_bf16(ra0, sb[0], z4, 0, 0, 0);
    const f32x4 ya2 = __builtin_amdgcn_mfma_f32_16x16x32_bf16(ra1, sa[1], z4, 0, 0, 0);
    const f32x4 yb2 = __builtin_amdgcn_mfma_f32_16x16x32_bf16(ra1, sb[1], z4, 0, 0, 0);
    const f32x4 UA = ua1 + ua2, UB = ub1 + ub2;
    const bf16x8_t uva = mk_frag(pk4(UA[0], UA[1], UA[2], UA[3]), F.va), uvb = mk_frag(pk4(UB[0], UB[1], UB[2], UB[3]), F.vb);
#pragma unroll
    for (int kt = 0; kt < 4; ++kt) {
        const bf16x8_t bk = mk_frag(F.b4[kt], F.k4[kt]);
        SA[kt] = __builtin_amdgcn_mfma_f32_16x16x32_bf16(bk, uva, SA[kt], 0, 0, 0);
        SB[kt] = __builtin_amdgcn_mfma_f32_16x16x32_bf16(bk, uvb, SB[kt], 0, 0, 0);
    }
#pragma unroll
    for (int kt = 0; kt < 4; ++kt) { SA[kt] = SA[kt] * F.gm[kt]; SB[kt] = SB[kt] * F.gm[kt]; }
    ya = __builtin_amdgcn_mfma_f32_16x16x32_bf16(mc, uva, ya, 0, 0, 0);
    yb = __builtin_amdgcn_mfma_f32_16x16x32_bf16(mc, uvb, yb, 0, 0, 0);
    YA = ya + ya2; YB = yb + yb2;
}
__device__ __forceinline__ f32x4 chain_step(LAS unsigned char* slot, f32x4 (&ST)[4], int vq, int lane) { ChainFrag F; chain_fetch(slot, vq, lane, F); return chain_math(F, ST); }

constexpr int N_CH_P = MP / 16 * 16, N_CH_S = DBATCH * 16, N_CH = N_CH_P + N_CH_S;
static_assert(WS_CB + (size_t)N_CH * CH_SLOT <= (size_t)861000000, "chunk buffer fits the workspace");
constexpr int CH_VEC = CH_SLOT / 16;
__device__ __forceinline__ void slot_to_global(const LAS unsigned char* slot, unsigned char* g, int lane) {
#pragma unroll
    for (int i = 0; i < 13; ++i) { const int v = i * 64 + lane; if (v < CH_VEC) *(u32x4*)(g + (size_t)v * 16) = *(const LAS u32x4*)(slot + v * 16); }
}
struct SlotRegs { u32x4 v[13]; };
__device__ __forceinline__ void slot_load(const unsigned char* g, int lane, SlotRegs& S) {
    asm volatile("" : "+v"(lane));
#pragma unroll
    for (int i = 0; i < 13; ++i) { const int v = i * 64 + lane; S.v[i] = *(const u32x4*)(g + (size_t)(v < CH_VEC ? v : 0) * 16); }
}
__device__ __forceinline__ void slot_store(LAS unsigned char* slot, int lane, const SlotRegs& S) {
    asm volatile("" : "+v"(lane));
#pragma unroll
    for (int i = 0; i < 13; ++i) { const int v = i * 64 + lane; if (v < CH_VEC) *(LAS u32x4*)(slot + v * 16) = S.v[i]; }
}
__device__ __forceinline__ void phase_c1(const Args& a, int L, LAS unsigned char* lds) {
    const int tid = threadIdx.x, lane = tid & 63, wv = __builtin_amdgcn_readfirstlane(tid >> 6);
    LAS unsigned char* slot = lds + wv * CH_SLOT; LAS unsigned char* par = lds + CH_PAR_OFF + wv * CH_PAR_BYTES;
    unsigned char* CB = a.ws + WS_CB;
    rglru_prefix(a);
    const int stride = gridDim.x * NWAVES;
    auto item = [&](int ci, size_t& m0, int& ntok, bool& ss, const float*& sh0) {
        sh0 = nullptr;
        if (ci < N_CH_P) { const int chunk = ci >> 4; m0 = (size_t)chunk * 16; ntok = 16; ss = (chunk & (SEQ / 16 - 1)) == 0; }
        else { const int b = (ci - N_CH_P) >> 4; m0 = (size_t)MP + (size_t)b * DSEQ; ntok = DSEQ; ss = true; sh0 = a.in[6] + ((size_t)L * DBATCH + b) * SHIFT_W; }
    };
    auto fetch = [&](int ci, ChunkRaw& R) { size_t m0; int ntok; bool ss; const float* sh0; item(ci, m0, ntok, ss, sh0); chunk_load(a, m0, ci & 15, ntok, lane, R); };
    int ci = blockIdx.x * NWAVES + wv;
    ChunkRaw R;
    if (ci < N_CH) fetch(ci, R);
    for (; ci < N_CH; ci += stride) {
        const int h = ci & 15; size_t m0; int ntok; bool ss; const float* sh0; item(ci, m0, ntok, ss, sh0);
        stage_head_params(a, L, h, par, lane);
        LDSW();
        chunk_compute(a, R, m0, h, ntok, ss, sh0, par, slot, lane, [&]() { if (ci + stride < N_CH) fetch(ci + stride, R); });
        LDSW();
        const size_t sid = ci < N_CH_P ? ((size_t)((ci >> 4) >> 9) * 16 + h) * (SEQ / 16) + ((ci >> 4) & (SEQ / 16 - 1)) : (size_t)ci;
        slot_to_global(slot, CB + sid * CH_SLOT, lane);
        LDSW();
    }
}

#define WG_BAR() do { asm volatile("s_waitcnt lgkmcnt(0)" ::: "memory"); __builtin_amdgcn_s_barrier(); asm volatile("" ::: "memory"); } while (0)
template <int DRY> __device__ __forceinline__ void wkv_prompt_chain(const Args& a, int L, int b, int h, LAS unsigned char* lds) {
    const int tid = threadIdx.x, lane = tid & 63, wv = __builtin_amdgcn_readfirstlane(tid >> 6), i16 = lane & 15, qp = lane >> 4;
    bf16_t* Y = (bf16_t*)(a.ws + WS_Y);
    const unsigned char* CB = a.ws + WS_CB;
    constexpr int NR = SEQ / 64;
    const size_t ci0 = ((size_t)b * 16 + h) * (SEQ / 16);
    if (wv >= 2) {
        const int lw = wv - 2;
        constexpr int GV = 4 * CH_SLOT / 16;
        struct GrpRegs { u32x4 v[9]; };
        auto grp_load = [&](const unsigned char* gsrc, GrpRegs& S) {
#pragma unroll
            for (int i = 0; i < 9; ++i) { const int q = lw * 64 + lane + 384 * i; S.v[i] = *(const u32x4*)(gsrc + (size_t)(q < GV ? q : 0) * 16); }
        };
        auto grp_store = [&](LAS unsigned char* ldst, const GrpRegs& S) {
#pragma unroll
            for (int i = 0; i < 9; ++i) { const int q = lw * 64 + lane + 384 * i; if (q < GV) *(LAS u32x4*)(ldst + q * 16) = S.v[i]; }
        };
        GrpRegs S0, S1, S2, S3;
#define CB_GROUP(k) (CB + (ci0 + (size_t)(4 * (k))) * CH_SLOT)
        grp_load(CB_GROUP(0), S0);
        grp_store(lds, S0);
        grp_load(CB_GROUP(1), S1); grp_load(CB_GROUP(2), S2); grp_load(CB_GROUP(3), S3); grp_load(CB_GROUP(4), S0);
        WG_BAR();
        for (int g = 0; g < NR; g += 4) {
#define LROUND(r, SET) do { __builtin_amdgcn_s_sleep(16);   if (DRY != 2) if ((r) + 1 < NR) grp_store(lds + (((r) + 1) & 1) * 4 * CH_SLOT, SET); if (DRY != 2) if ((r) + 5 < NR) grp_load(CB_GROUP((r) + 5), SET); WG_BAR(); } while (0)
            LROUND(g, S1); LROUND(g + 1, S2); LROUND(g + 2, S3); LROUND(g + 3, S0);
#undef LROUND
        }
#undef CB_GROUP
    } else if (wv < 2) {
        f32x4 SA[4], SB[4];
#pragma unroll
        for (int kt = 0; kt < 4; ++kt) { SA[kt] = (f32x4){0.f, 0.f, 0.f, 0.f}; SB[kt] = SA[kt]; }
        WG_BAR();
        bf16_t* yrow = Y + ((size_t)b * SEQ) * D + 64 * h + 32 * wv;
        for (int g = 0; g < NR; ++g) {
            LAS unsigned char* gs = lds + (g & 1) * 4 * CH_SLOT;
            ChainFrag2 FA, FB;
            f32x4 ya[4], yb[4];
#define SB0() __builtin_amdgcn_sched_barrier(0)
            if (DRY == 3) { WG_BAR(); continue; }
            chain_fetch2(gs, 2 * wv, lane, FA);
            chain_fetch2(gs + CH_SLOT, 2 * wv, lane, FB); SB0();
            chain_math2(FA, SA, SB, ya[0], yb[0]); SB0();
            chain_fetch2(gs + 2 * CH_SLOT, 2 * wv, lane, FA); SB0();
            chain_math2(FB, SA, SB, ya[1], yb[1]); SB0();
            chain_fetch2(gs + 3 * CH_SLOT, 2 * wv, lane, FB); SB0();
            chain_math2(FA, SA, SB, ya[2], yb[2]); SB0();
            chain_math2(FB, SA, SB, ya[3], yb[3]); SB0();
#undef SB0
            {
                LAS unsigned char* yt = lds + CH_PAR_OFF + wv * 4608;
#pragma unroll
                for (int j = 0; j < 4; ++j)
#pragma unroll
                    for (int r = 0; r < 4; ++r) {
                        *(LAS unsigned short*)(yt + (16 * j + 4 * qp + r) * 72 + 2 * i16) = f2bf(ya[j][r]);
                        *(LAS unsigned short*)(yt + (16 * j + 4 * qp + r) * 72 + 2 * (16 + i16)) = f2bf(yb[j][r]);
                    }
                LDSW();
#pragma unroll
                for (int j = 0; j < 4; ++j) {
                    const int row = 16 * j + (lane >> 2), pc = lane & 3;
                    const u32x2 lo = *(const LAS u32x2*)(yt + row * 72 + pc * 16), hi = *(const LAS u32x2*)(yt + row * 72 + pc * 16 + 8);
                    if (DRY == 0) *(u32x4*)(yrow + (size_t)row * D + 8 * pc) = (u32x4){lo.x, lo.y, hi.x, hi.y};
                    else asm volatile("" :: "v"(lo), "v"(hi));
                }
                LDSW();
            }
            yrow += (size_t)64 * D;
            WG_BAR();
        }
        float* o = a.out + O_PWKV + ((((size_t)L * NBATCH + b) * 16 + h) * 64 + 32 * wv + i16) * 64;
#pragma unroll
        for (int kt = 0; kt < 4; ++kt) { if (DRY == 0) { *(f32x4*)(o + 16 * kt + 4 * qp) = SA[kt]; *(f32x4*)(o + 16 * 64 + 16 * kt + 4 * qp) = SB[kt]; } else asm volatile("" :: "v"(SA[kt]), "v"(SB[kt])); }
    }
    __syncthreads();
}
#undef WG_BAR
__device__ __forceinline__ void wkv_sample_chain(const Args& a, int L, int b, int ho, LAS unsigned char* lds) {
    const int tid = threadIdx.x, lane = tid & 63, wv = __builtin_amdgcn_readfirstlane(tid >> 6), i16 = lane & 15, qp = lane >> 4;
    const int h = 8 * ho + wv;
    bf16_t* Y = (bf16_t*)(a.ws + WS_Y);
    LAS unsigned char* slot = lds + wv * CH_SLOT;
    const size_t m0 = (size_t)MP + (size_t)b * DSEQ;
    { SlotRegs S; slot_load(a.ws + WS_CB + ((size_t)N_CH_P + (size_t)b * 16 + h) * CH_SLOT, lane, S); slot_store(slot, lane, S); }
    LDSW();
    for (int vp = 0; vp < 2; ++vp) {
        const size_t so = ((((size_t)L * DBATCH + b) * 16 + h) * 64 + 32 * vp + i16) * 64;
        f32x4 SA[4], SB[4];
#pragma unroll
        for (int kt = 0; kt < 4; ++kt) { SA[kt] = *(const f32x4*)(a.in[7] + so + 16 * kt + 4 * qp); SB[kt] = *(const f32x4*)(a.in[7] + so + 16 * 64 + 16 * kt + 4 * qp); }
        ChainFrag2 F; chain_fetch2(slot, 2 * vp, lane, F);
        f32x4 ya, yb; chain_math2(F, SA, SB, ya, yb);
#pragma unroll
        for (int r = 0; r < 4; ++r) if (4 * qp + r < DSEQ) { Y[(m0 + 4 * qp + r) * D + 64 * h + 32 * vp + i16] = f2bf(ya[r]); Y[(m0 + 4 * qp + r) * D + 64 * h + 32 * vp + 16 + i16] = f2bf(yb[r]); }
#pragma unroll
        for (int kt = 0; kt < 4; ++kt) { *(f32x4*)(a.out + O_SWKV + so + 16 * kt + 4 * qp) = SA[kt]; *(f32x4*)(a.out + O_SWKV + so + 16 * 64 + 16 * kt + 4 * qp) = SB[kt]; }
    }
    __syncthreads();
}

#ifndef PROBE_MIXB
#define PROBE_MIXB 0
#endif
__device__ __forceinline__ void phase_mixb2(const Args& a, int L, LAS unsigned char* lds) {
    constexpr int N_PC = NBATCH * 16;
    const int G = gridDim.x, bx = blockIdx.x;
    const int first_other = (G > 2 * N_PC) ? N_PC : 0;
    for (int it = bx; it < N_PC; it += G) wkv_prompt_chain<0>(a, L, it >> 4, it & 15, lds);
    if (PROBE_MIXB & 1) for (int it = bx; it < N_PC; it += G) wkv_prompt_chain<0>(a, L, it >> 4, it & 15, lds);
    if (PROBE_MIXB & 8) for (int it = bx; it < N_PC; it += G) wkv_prompt_chain<1>(a, L, it >> 4, it & 15, lds);
    if (PROBE_MIXB & 16) for (int it = bx; it < N_PC; it += G) wkv_prompt_chain<2>(a, L, it >> 4, it & 15, lds);
    if (PROBE_MIXB & 32) for (int it = bx; it < N_PC; it += G) wkv_prompt_chain<3>(a, L, it >> 4, it & 15, lds);
    if (bx < first_other) return;
    const int nb = G - first_other, id = bx - first_other;
    constexpr int N_RG2 = M / 64, N_SC = DBATCH * 2;
    phase_state_copies(a, L, first_other);
    if (PROBE_MIXB & 64) phase_state_copies(a, L, first_other);
    prep_weights(a, L, 4, first_other, lds);
    if (L + 1 < DEPTH) prep_weights(a, L + 1, 1 | 2, first_other, lds);
    __syncthreads();
    for (int it = id; it < N_RG2; it += nb) { rglru_unit2<true>(a, L, it, lds); __syncthreads(); }
    if (PROBE_MIXB & 4) for (int it = id; it < N_RG2; it += nb) { rglru_unit2<true>(a, L, it, lds); __syncthreads(); }
    {
        const int second = (N_RG2 > nb) ? N_RG2 - nb : 0;
        const int start = id >= second ? id - second : id + (nb - second);
        for (int it = start; it < N_SC; it += nb) wkv_sample_chain(a, L, it >> 1, it & 1, lds);
        if (PROBE_MIXB & 2) for (int it = start; it < N_SC; it += nb) wkv_sample_chain(a, L, it >> 1, it & 1, lds);
    }
}
#ifndef PROBE_MASK
#define PROBE_MASK 0
#endif
#define PH_IN(k) (lo <= (k) && (k) < hi)
#define RUN_PHASE(po, ...) do { { __VA_ARGS__ } if (((PROBE_MASK >> (po)) & 1) && PH_IN(base + (po))) { xcd_barrier(bar); { __VA_ARGS__ } } } while (0)
#define PH_SYNC(k) do { if (lo < (k) && (k) < hi) xcd_barrier(bar); } while (0)
template <int L> __device__ __forceinline__ void layer_phases(const Args& a, LAS unsigned char* lds, int lo, int hi, const XcdBarrier& bar) {
    unsigned char* ws = a.ws;
    const int G = gridDim.x;
    constexpr int base = PH_L0 + L * PH_PER_LAYER;
    if (L > 0) PH_SYNC(base + PHO_IN);
    RUN_PHASE(PHO_IN, if (PH_IN(base + PHO_IN)) {
        pg8::Gemm g{(const bf16_t*)(ws + WS_XB), (const bf16_t*)(ws + WS_WIN), M, NP, D}; pg8::StaticOrder S; S.init(M, NP, G, (int)blockIdx.x);
        EpiIn E{(bf16_t*)(ws + WS_P), NP, CG / 256};
        pg8::gemm_phase<EpiIn, pg8::StaticOrder, true, true>(lds, g, S, E);
    });
    PH_SYNC(base + PHO_MIXA);
    RUN_PHASE(PHO_MIXA, if (PH_IN(base + PHO_MIXA)) phase_elem_mixa(a, L););
    PH_SYNC(base + PHO_LORA);
    RUN_PHASE(PHO_LORA, if (PH_IN(base + PHO_LORA)) {
        pg8::Gemm g{(const bf16_t*)(ws + WS_ACAT), (const bf16_t*)(ws + WS_WLORA), M, 3072, ACAT_K}; pg8::StaticOrder S; S.init(M, 3072, G, (int)blockIdx.x);
        EpiLora E{(bf16_t*)(ws + WS_WAW), (bf16_t*)(ws + WS_WAA), (bf16_t*)(ws + WS_WAG), a.in[18] + L * D, a.in[20] + L * D};
        pg8::gemm_phase<EpiLora, pg8::StaticOrder, true, true>(lds, g, S, E);
        phase_mixa_units(a, L, lds);
    });
    PH_SYNC(base + PHO_C1);
    RUN_PHASE(PHO_C1, if (PH_IN(base + PHO_C1)) phase_c1(a, L, lds););
    PH_SYNC(base + PHO_MIXB);
    RUN_PHASE(PHO_MIXB, if (PH_IN(base + PHO_MIXB)) phase_mixb2(a, L, lds););
    PH_SYNC(base + PHO_MIXC);
    if (PH_IN(base + PHO_MIXC)) {
#if defined(PROBE_MIXC)
        phase_mixc(a, L, (bf16_t*)(ws + WS_CB)); xcd_barrier(bar);
#endif
        phase_mixc(a, L, (bf16_t*)(ws + WS_OA));
    }
    PH_SYNC(base + PHO_OUT);
    RUN_PHASE(PHO_OUT, if (PH_IN(base + PHO_OUT)) {
        {
            pg8::Gemm g{(const bf16_t*)(ws + WS_MIX), (const bf16_t*)(ws + WS_WOUT), MP, D, D}; pg8::StaticOrder S; S.init(MP, D, G, (int)blockIdx.x);
            if (L == 0) { EpiZ<false> E{a.in[0], (float*)(ws + WS_Z), D}; pg8::gemm_phase<EpiZ<false>, pg8::StaticOrder, true, true>(lds, g, S, E); }
            else { EpiZ<true> E{ws + WS_XB, (float*)(ws + WS_Z), D}; pg8::gemm_phase<EpiZ<true>, pg8::StaticOrder, true, true>(lds, g, S, E); }
        }
        {
            pg8::Gemm g{(const bf16_t*)(ws + WS_MIX) + (size_t)MP * D, (const bf16_t*)(ws + WS_WOUTS), MS, 4 * D, 256, D, 256, 4, (size_t)512}; pg8::StaticOrder S; S.init(MS, 4 * D, G, (int)blockIdx.x);
            if (L == 0) { EpiZS<false> E{a.in[1], (float*)(ws + WS_ZS), D}; pg8::gemm_phase<EpiZS<false>, pg8::StaticOrder, true, true>(lds, g, S, E); }
            else { EpiZS<true> E{ws + WS_XB + (size_t)MP * D * 2, (float*)(ws + WS_ZS), D}; pg8::gemm_phase<EpiZS<true>, pg8::StaticOrder, true, true>(lds, g, S, E); }
        }
    });
    PH_SYNC(base + PHO_LN1);
    RUN_PHASE(PHO_LN1, if (PH_IN(base + PHO_LN1)) phase_ln<4>((const float*)(ws + WS_Z), (const float*)(ws + WS_ZS), a.in[29] + L * D, a.in[30] + L * D, nullptr, (bf16_t*)(ws + WS_X1B)););
    PH_SYNC(base + PHO_GU);
    RUN_PHASE(PHO_GU, if (PH_IN(base + PHO_GU)) {
        pg8::Gemm g{(const bf16_t*)(ws + WS_X1B), (const bf16_t*)(ws + WS_WGU), M, 2 * DFF, D}; pg8::StaticOrder S; S.init(M, 2 * DFF, G, (int)blockIdx.x);
        EpiSwiGLU E{(bf16_t*)(ws + WS_H), DFF};
        pg8::gemm_phase<EpiSwiGLU, pg8::StaticOrder, true, true>(lds, g, S, E);
    });
    PH_SYNC(base + PHO_DOWN);
    RUN_PHASE(PHO_DOWN, if (PH_IN(base + PHO_DOWN)) {
        {
            pg8::Gemm g{(const bf16_t*)(ws + WS_H), (const bf16_t*)(ws + WS_WDN), MP, D, DFF}; pg8::StaticOrder S; S.init(MP, D, G, (int)blockIdx.x);
            EpiZ<true> E{ws + WS_X1B, (float*)(ws + WS_Z), D};
            pg8::gemm_phase<EpiZ<true>, pg8::StaticOrder, true, true>(lds, g, S, E);
        }
        {
            pg8::Gemm g{(const bf16_t*)(ws + WS_H) + (size_t)MP * DFF, (const bf16_t*)(ws + WS_WDNS), MS, 11 * D, 256, DFF, 256, 4, (size_t)512}; pg8::StaticOrder S; S.init(MS, 11 * D, G, (int)blockIdx.x);
            EpiZS<true> E{ws + WS_X1B + (size_t)MP * D * 2, (float*)(ws + WS_ZS), D};
            pg8::gemm_phase<EpiZS<true>, pg8::StaticOrder, true, true>(lds, g, S, E);
        }
    });
    PH_SYNC(base + PHO_LN2);
    RUN_PHASE(PHO_LN2, if (PH_IN(base + PHO_LN2)) {
        if (L == DEPTH - 1) phase_ln<11>((const float*)(ws + WS_Z), (const float*)(ws + WS_ZS), a.in[33] + L * D, a.in[34] + L * D, a.out + O_YP, nullptr);
        else { phase_ln<11>((const float*)(ws + WS_Z), (const float*)(ws + WS_ZS), a.in[33] + L * D, a.in[34] + L * D, nullptr, (bf16_t*)(ws + WS_XB)); prep_weights(a, L + 1, 8, 0, lds); }
    });
}
__global__ void __launch_bounds__(NTHREADS, 2) mega(Args a) {
    extern __shared__ __attribute__((aligned(16))) unsigned char lds_raw[];
    LAS unsigned char* lds = (LAS unsigned char*)lds_raw;
    const int lo = a.ph_lo, hi = a.ph_hi;
    volatile LAS unsigned* bst = (volatile LAS unsigned*)(lds + BAR_LDS_OFF);
    if (threadIdx.x < 4) bst[threadIdx.x] = 0u;
    __syncthreads();
    const XcdBarrier bar = xcd_barrier_post((unsigned*)(a.ws + WS_BAR), bst);
    if (PH_IN(PH_PREP)) { prep_weights(a, 0, 1 | 2 | 8, 0, lds); phase_prep_x(a); }
    if (lo <= PH_PREP && PH_L0 < hi) cg::this_grid().sync();
    layer_phases<0>(a, lds, lo, hi, bar);
    layer_phases<1>(a, lds, lo, hi, bar);
}

static void launch_mega(Args a, int lo, int hi, int grid, hipStream_t s) {
    a.ph_lo = lo; a.ph_hi = hi;
    void* args[] = {&a};
    hipError_t e;
    if (hi - lo > 1) e = hipLaunchCooperativeKernel((void*)mega, dim3(grid), dim3(NTHREADS), args, LDS_BYTES, s);
    else e = hipLaunchKernel((void*)mega, dim3(grid), dim3(NTHREADS), args, LDS_BYTES, s);
    if (e != hipSuccess) fprintf(stderr, "mega launch [%d,%d) failed: %s (grid %d)\n", lo, hi, hipGetErrorString(e), grid);
}

extern "C" void kernel_launch(void* const* d_in, const int* in_sizes, int n_in, void* d_out, int out_size,
                              void* d_ws, size_t ws_size, hipStream_t stream) {
    if (ws_size < WS_END || out_size != (int)O_END || n_in != 35) { fprintf(stderr, "kernel_launch: unexpected sizes ws=%zu out=%d n_in=%d\n", ws_size, out_size, n_in); return; }
    static int grid = 0;
    if (!grid) {
        int dev = 0, cus = 0, per_cu = 0;
        (void)hipGetDevice(&dev);
        (void)hipDeviceGetAttribute(&cus, hipDeviceAttributeMultiprocessorCount, dev);
        (void)hipFuncSetAttribute((const void*)mega, hipFuncAttributeMaxDynamicSharedMemorySize, LDS_BYTES);
        (void)hipOccupancyMaxActiveBlocksPerMultiprocessor(&per_cu, (const void*)mega, NTHREADS, LDS_BYTES);
        if (per_cu < 1) { fprintf(stderr, "occupancy query says %d blocks per CU\n", per_cu); per_cu = 1; }
        grid = cus * per_cu;
    }
    const float* const* in = (const float* const*)d_in;
    unsigned char* ws = (unsigned char*)d_ws;
    float* out = (float*)d_out;
    Args a{};
    for (int i = 0; i < 35; ++i) a.in[i] = in[i];
    a.out = out; a.ws = ws;
    (void)hipMemsetAsync(ws + WS_BAR, 0, 16384, stream);
    launch_mega(a, 0, N_PHASES, grid, stream);
}
```

```cpp
#include <hip/hip_runtime.h>
#include <cstdint>
#include <cstdio>

typedef unsigned short bf16_t;
__device__ __forceinline__ float bf2f(bf16_t v) { return __uint_as_float(((unsigned)v) << 16); }
typedef float f32x2c_t __attribute__((ext_vector_type(2))); typedef __bf16 bf16x2c_t __attribute__((ext_vector_type(2)));
__device__ __forceinline__ bf16_t f2bf(float f) { f32x2c_t v = {f, f}; bf16x2c_t b = __builtin_convertvector(v, bf16x2c_t); return (bf16_t)(__builtin_bit_cast(unsigned, b) & 0xffffu); }
__device__ __forceinline__ float sigmoidf_(float x) { return __builtin_amdgcn_rcpf(1.f + __expf(-x)); }
__device__ __forceinline__ float softplusf_(float x) { return fmaxf(x, 0.f) + log1pf(__expf(-fabsf(x))); }
__device__ __forceinline__ float wave_sum(float v) {
#pragma unroll
    for (int o = 1; o < 64; o <<= 1) v += __shfl_xor(v, o);
    return v;
}

constexpr int D = 1024, MP = 16384, MS = 1024, M = MP + MS, SEQ = 8192, DSEQ = 8, NBATCH = 2, DBATCH = 128, DEPTH = 2;
constexpr int NP = 9216, IN_COLS = 8992;
constexpr int CQ = 0, CK = 1024, CV = 1280, CRNN = 1536, CRW = 2560, CG = 6144;
constexpr int SHIFT_W = 3360, DFF = 2816;
constexpr float ALPHA = 1.4142135623730951f;
constexpr float LN_EPS = 1e-5f, GN_EPS = 64e-5f;

constexpr size_t O_YP = 0, O_YS = 16777216, O_PK = 17825792, O_PV = 17956864, O_PCONV = 18087936, O_PH = 18100224,
                 O_PSHIFT = 18104320, O_PWKV = 18117760, O_SK = 18379904, O_SV = 26768512, O_SCONV = 35157120,
                 O_SH = 35943552, O_SSHIFT = 36205696, O_SWKV = 37065856, O_END = 53843072;


constexpr size_t MiB = 1u << 20;
constexpr size_t WS_CTL = 0;
constexpr size_t WIN_T_BYTES = (size_t)NP * D * 2, WOUT_T_BYTES = (size_t)D * D * 2, WGU_T_BYTES = (size_t)2 * DFF * D * 2, WDN_T_BYTES = (size_t)D * DFF * 2;
constexpr int ACAT_K = 384;
constexpr size_t WLORA_BYTES = (size_t)3072 * ACAT_K * 2;
constexpr size_t WS_WIN = 1 * MiB;
constexpr size_t WS_WOUT = WS_WIN + WIN_T_BYTES;
constexpr size_t WS_WGU = WS_WOUT + WOUT_T_BYTES;
constexpr size_t WS_WDN = WS_WGU + WGU_T_BYTES;
constexpr size_t WS_WOUTS = WS_WDN + WDN_T_BYTES;
constexpr size_t WS_WDNS = WS_WOUTS + WOUT_T_BYTES;
constexpr size_t WS_WLORA = WS_WDNS + WDN_T_BYTES;
constexpr size_t WS_XB = WS_WLORA + WLORA_BYTES;
constexpr size_t WS_OA = WS_XB + (size_t)M * D * 2;
constexpr size_t WS_MIX = WS_OA;
constexpr size_t WS_OB = WS_OA + (size_t)M * D * 2;
constexpr size_t WS_P = WS_OB + (size_t)M * D * 2;
constexpr size_t WS_Z = WS_P;
constexpr size_t WS_ZS = WS_Z + (size_t)M * D * 4;
constexpr size_t WS_X1B = WS_ZS + (size_t)11 * MS * D * 4;
constexpr size_t WS_H = WS_X1B + (size_t)M * D * 2;
constexpr size_t WS_PEND = WS_P + (size_t)M * NP * 2;
constexpr size_t WS_RS = WS_PEND;
constexpr size_t WS_WAW = WS_RS + (size_t)2 * 128 * 1024 * 2 * 4;
constexpr size_t WS_WAA = WS_WAW + (size_t)M * D * 2;
constexpr size_t WS_WAG = WS_WAA + (size_t)M * D * 2;
constexpr size_t WS_Y = WS_WAG + (size_t)M * D * 2;
constexpr size_t WS_BD = WS_Y + (size_t)M * D * 2;
constexpr size_t WS_ACAT = WS_BD + (size_t)M * 16 * 4;
constexpr size_t WS_CB = WS_ACAT;
constexpr size_t WS_END = WS_ACAT + (size_t)M * ACAT_K * 2;
static_assert(WS_END <= (size_t)861000000, "workspace budget (4 x output bytes = 861.5 MB)");
static_assert(WS_H + (size_t)M * DFF * 2 <= WS_PEND, "overlay fits");
static_assert(WS_WAA == WS_WAW + (size_t)M * D * 2 && WS_WAG == WS_WAA + (size_t)M * D * 2, "lora outputs contiguous");
static_assert(WS_XB % 256 == 0 && WS_P % 256 == 0 && WS_WLORA % 256 == 0 && WS_ACAT % 256 == 0, "alignment");
namespace pg8 {
#define PG8_LAS __attribute__((address_space(3)))
typedef unsigned short bf16_t;
typedef short bf16x8 __attribute__((ext_vector_type(8)));
typedef float f32x4 __attribute__((ext_vector_type(4)));
typedef unsigned u32x4 __attribute__((ext_vector_type(4)));
constexpr int BM = 256, BK = 64, HALF = 128, HTB = HALF * BK * 2  , STAGE_BYTES = 8 * HTB, NXCD = 8, WGM = 8;

__host__ __device__ __forceinline__ int lds_byte(int r, int c) { const int st = (r >> 4) * 2 + (c >> 5), rr = r & 15, cc = c & 31, ob = rr * 64 + cc * 2; return st * 1024 + (ob ^ (((ob >> 9) & 1) << 5)); }
__host__ __device__ __forceinline__ void stage_rc(int b, int& R, int& C) { const int st = b / 1024, sb = b % 1024, swz = sb ^ (((sb >> 9) & 1) << 5); R = (st >> 1) * 16 + swz / 64; C = (st & 1) * 32 + (swz % 64) / 2; }
__host__ __device__ __forceinline__ int perm32(int rho) { const int n = rho >> 4, i = rho & 15; return 8 * (i >> 2) + 4 * n + (i & 3); }

struct Unit { int pm, pn; };
struct Gemm { const bf16_t* A; const bf16_t* Bt; int M, N, K; int lda = 0, ldb = 0, nsplit = 0; size_t a_koff = 0; };

struct StaticOrder {
    int nM, nN, nwg, G, c;
    __host__ __device__ void init(int M, int N, int G_, int c_) { nM = M / BM; nN = N / BM; nwg = nM * nN; G = G_; c = c_; }
    __host__ __device__ bool next(int i, Unit& u) const {
        const long L = (long)i * G + c; if (L >= nwg) return false;
        int wgid = (int)L; { const int q = nwg / NXCD, r = nwg % NXCD, xcd = wgid % NXCD, off = wgid / NXCD; wgid = (xcd < r ? xcd * (q + 1) : r * (q + 1) + (xcd - r) * q) + off; }
        const int nig = WGM * nN, gid = wgid / nig, fm = gid * WGM, gsz = (nM - fm) < WGM ? (nM - fm) : WGM;
        u.pm = fm + ((wgid % nig) % gsz); u.pn = (wgid % nig) / gsz; return true;
    }
    __device__ __forceinline__ void a_ready(const Unit&) const {}
    __device__ __forceinline__ void done(const Unit&) const {}
};

__device__ __forceinline__ unsigned cvt_pk_bf16(float lo, float hi) { unsigned r; asm volatile("v_cvt_pk_bf16_f32 %0, %1, %2" : "=v"(r) : "v"(lo), "v"(hi)); return r; }
typedef float f32x2 __attribute__((ext_vector_type(2)));
template <class Epi, class Sched, bool ALIGN_EPI = false, bool SP2 = false>
__device__ __forceinline__ void gemm_phase(PG8_LAS unsigned char* lds, const Gemm g, const Sched& S, const Epi& E) {
    const int tid = threadIdx.x, wid = __builtin_amdgcn_readfirstlane(tid >> 6), lane = tid & 63, wr = wid >> 2, wc = wid & 3, fr = lane & 15, fq = lane >> 4;
    const int K = g.K, nt = K / BK, lda = g.lda ? g.lda : K, ldb = g.ldb ? g.ldb : K;
    unsigned voffA[2], voffB[2];
#pragma unroll
    for (int i = 0; i < 2; ++i) { int R, C; stage_rc(tid * 16 + i * 8192, R, C); const int Rb = Epi::PERM ? ((R & ~31) + perm32(R & 31)) : R;
        voffA[i] = (unsigned)(R * lda + C) * 2u; voffB[i] = (unsigned)(Rb * ldb + C) * 2u; }
    const size_t kstep = (size_t)(BK * 2);
    const size_t hstepA = (size_t)HALF * lda * 2, hstepB = (size_t)HALF * ldb * 2;
    const size_t tstepA = 2 * hstepA, tstepB = 2 * hstepB;
#define PG8_ABASE(u) ((const char*)g.A + (size_t)(u).pm * tstepA + (g.nsplit ? (size_t)((u).pn / g.nsplit) * g.a_koff : (size_t)0))
    const unsigned ldsw = (unsigned)wid * 1024u;
    const int aoff = lds_byte(wr * 64 + fr, fq * 8), boff = lds_byte(wc * 32 + fr, fq * 8);
#define PG8_SA(b, h) (((b) * 2 + (h)) * HTB)
#define PG8_SB(b, h) ((4 + (b) * 2 + (h)) * HTB)
#define PG8_STAGE(bufoff, gbase, voff) do { _Pragma("unroll") for (int _i = 0; _i < 2; ++_i) \
        __builtin_amdgcn_global_load_lds((const unsigned*)((const char*)(gbase) + (voff)[_i]), (PG8_LAS unsigned*)(lds + (bufoff) + ldsw + _i * 8192), 16, 0, 0); } while (0)
#define PG8_LDA(dst, b, h) do { _Pragma("unroll") for (int m = 0; m < 4; ++m) _Pragma("unroll") for (int k = 0; k < 2; ++k) dst[m][k] = *(const PG8_LAS bf16x8*)(lds + PG8_SA(b, h) + aoff + m * 2048 + k * 1024); } while (0)
#define PG8_LDB(dst, b, h) do { _Pragma("unroll") for (int n = 0; n < 2; ++n) _Pragma("unroll") for (int k = 0; k < 2; ++k) dst[n][k] = *(const PG8_LAS bf16x8*)(lds + PG8_SB(b, h) + boff + n * 2048 + k * 1024); } while (0)
#define PG8_MMA(ai, bj, At, Bt) do { __builtin_amdgcn_s_setprio(1); _Pragma("unroll") for (int m = 0; m < 4; ++m) _Pragma("unroll") for (int n = 0; n < 2; ++n) _Pragma("unroll") for (int k = 0; k < 2; ++k) \
        acc[ai][bj][m][n] = __builtin_amdgcn_mfma_f32_16x16x32_bf16(Bt[n][k], At[m][k], acc[ai][bj][m][n], 0, 0, 0); __builtin_amdgcn_s_setprio(0); } while (0)
#define PG8_WAIT_V(n) asm volatile("s_waitcnt vmcnt(" #n ")" ::: "memory")
#define PG8_WAIT_L(n) asm volatile("s_waitcnt lgkmcnt(" #n ")" ::: "memory")
#define PG8_BAR __builtin_amdgcn_s_barrier()
#define PG8_SCHED __builtin_amdgcn_sched_barrier(0)
    Unit cur, nxt; int ui = 0;
    if (!S.next(0, cur)) return;
    f32x4 acc[2][2][4][2];
#pragma unroll
    for (int a = 0; a < 2; ++a)
#pragma unroll
        for (int b = 0; b < 2; ++b)
#pragma unroll
            for (int m = 0; m < 4; ++m)
#pragma unroll
                for (int n = 0; n < 2; ++n) acc[a][b][m][n] = (f32x4){0.f, 0.f, 0.f, 0.f};
    bf16x8 At[4][2], B0[2][2], B1[2][2];
    const char* cA = PG8_ABASE(cur); const char* cB = (const char*)g.Bt + (size_t)cur.pn * tstepB;
    S.a_ready(cur);
    if constexpr (SP2) {
        PG8_STAGE(PG8_SB(0, 0), cB, voffB); PG8_STAGE(PG8_SB(0, 1), cB + hstepB, voffB); PG8_STAGE(PG8_SA(0, 0), cA, voffA); PG8_STAGE(PG8_SA(0, 1), cA + hstepA, voffA);
        if (wr == 1) PG8_BAR;
        PG8_WAIT_V(2); PG8_BAR;
        PG8_STAGE(PG8_SB(1, 0), cB + kstep, voffB); PG8_STAGE(PG8_SA(1, 0), cA + kstep, voffA); PG8_STAGE(PG8_SB(1, 1), cB + hstepB + kstep, voffB);
        PG8_WAIT_V(6); PG8_BAR;
    } else {
        PG8_STAGE(PG8_SB(0, 0), cB, voffB); PG8_STAGE(PG8_SA(0, 0), cA, voffA); PG8_STAGE(PG8_SB(0, 1), cB + hstepB, voffB); PG8_STAGE(PG8_SA(0, 1), cA + hstepA, voffA);
        if (wr == 1) PG8_BAR;
        PG8_WAIT_V(4); PG8_BAR;
        PG8_STAGE(PG8_SB(1, 0), cB + kstep, voffB); PG8_STAGE(PG8_SA(1, 0), cA + kstep, voffA); PG8_STAGE(PG8_SB(1, 1), cB + hstepB + kstep, voffB);
        PG8_WAIT_V(6); PG8_BAR;
    }
    for (;;) {
        const bool has_next = S.next(ui + 1, nxt);
        const char* nA = has_next ? PG8_ABASE(nxt) : cA; const char* nB = has_next ? (const char*)g.Bt + (size_t)nxt.pn * tstepB : cB;
#pragma nounroll
        for (int t = 0; t < nt; t += 2) {
            const bool last = (t == nt - 2);
            const char* a1 = cA + (size_t)(t + 1) * kstep;
            const char* a2 = last ? nA : cA + (size_t)(t + 2) * kstep; const char* b2 = last ? nB : cB + (size_t)(t + 2) * kstep;
            const char* a3 = a2 + kstep; const char* b3 = b2 + kstep;
            if (last && has_next) S.a_ready(nxt);
            if constexpr (SP2) {
            PG8_LDB(B0, 0, 0); PG8_LDB(B1, 0, 1); PG8_SCHED; PG8_LDA(At, 0, 0); PG8_STAGE(PG8_SA(1, 1), a1 + hstepA, voffA);
            PG8_WAIT_V(8); PG8_WAIT_L(0); PG8_BAR; PG8_MMA(0, 0, At, B0); PG8_MMA(0, 1, At, B1); PG8_BAR; PG8_SCHED;
            PG8_LDA(At, 0, 1); PG8_STAGE(PG8_SB(0, 0), b2, voffB); PG8_STAGE(PG8_SB(0, 1), b2 + hstepB, voffB); PG8_STAGE(PG8_SA(0, 0), a2, voffA);
            PG8_WAIT_V(8); PG8_WAIT_L(0); PG8_BAR; PG8_MMA(1, 0, At, B0); PG8_MMA(1, 1, At, B1); PG8_BAR; PG8_SCHED;
            PG8_LDB(B0, 1, 0); PG8_LDB(B1, 1, 1); PG8_SCHED; PG8_LDA(At, 1, 0); PG8_STAGE(PG8_SA(0, 1), a2 + hstepA, voffA);
            PG8_WAIT_V(8); PG8_WAIT_L(0); PG8_BAR; PG8_MMA(0, 0, At, B0); PG8_MMA(0, 1, At, B1); PG8_BAR; PG8_SCHED;
            PG8_LDA(At, 1, 1); PG8_STAGE(PG8_SB(1, 0), b3, voffB); PG8_STAGE(PG8_SB(1, 1), b3 + hstepB, voffB); PG8_STAGE(PG8_SA(1, 0), a3, voffA);
            PG8_WAIT_V(8); PG8_WAIT_L(0); PG8_BAR; PG8_MMA(1, 0, At, B0); PG8_MMA(1, 1, At, B1); PG8_BAR; PG8_SCHED;
            } else {
            PG8_LDB(B0, 0, 0); PG8_SCHED; PG8_LDA(At, 0, 0); PG8_STAGE(PG8_SA(1, 1), a1 + hstepA, voffA);
            PG8_WAIT_L(8); PG8_BAR; PG8_WAIT_L(0); PG8_MMA(0, 0, At, B0); PG8_BAR; PG8_SCHED;
            PG8_LDB(B1, 0, 1); PG8_STAGE(PG8_SB(0, 0), b2, voffB);
            PG8_BAR; PG8_WAIT_L(0); PG8_MMA(0, 1, At, B1); PG8_BAR;
            PG8_LDA(At, 0, 1); PG8_STAGE(PG8_SA(0, 0), a2, voffA);
            PG8_BAR; PG8_WAIT_L(0); PG8_MMA(1, 0, At, B0); PG8_BAR; PG8_SCHED;
            PG8_STAGE(PG8_SB(0, 1), b2 + hstepB, voffB);
            PG8_WAIT_V(6); PG8_BAR; PG8_MMA(1, 1, At, B1); PG8_BAR;
            PG8_LDB(B0, 1, 0); PG8_SCHED; PG8_LDA(At, 1, 0); PG8_STAGE(PG8_SA(0, 1), a2 + hstepA, voffA);
            PG8_WAIT_L(8); PG8_BAR; PG8_WAIT_L(0); PG8_MMA(0, 0, At, B0); PG8_BAR; PG8_SCHED;
            PG8_LDB(B1, 1, 1); PG8_STAGE(PG8_SB(1, 0), b3, voffB);
            PG8_BAR; PG8_WAIT_L(0); PG8_MMA(0, 1, At, B1); PG8_BAR;
            PG8_LDA(At, 1, 1); PG8_STAGE(PG8_SA(1, 0), a3, voffA);
            PG8_BAR; PG8_WAIT_L(0); PG8_MMA(1, 0, At, B0); PG8_BAR; PG8_SCHED;
            PG8_STAGE(PG8_SB(1, 1), b3 + hstepB, voffB);
            PG8_WAIT_V(6); PG8_BAR; PG8_MMA(1, 1, At, B1); PG8_BAR;
            }
        }
        if constexpr (ALIGN_EPI) { if (wr == 0) PG8_BAR; }
        if constexpr (!Epi::AFTER_DRAIN) { E(acc, cur, wr, wc, fr, fq); S.done(cur); }
        if (!has_next) break;
#pragma unroll
        for (int a = 0; a < 2; ++a)
#pragma unroll
            for (int b = 0; b < 2; ++b)
#pragma unroll
                for (int m = 0; m < 4; ++m)
#pragma unroll
                    for (int n = 0; n < 2; ++n) acc[a][b][m][n] = (f32x4){0.f, 0.f, 0.f, 0.f};
        cur = nxt; cA = nA; cB = nB; ++ui;
        if constexpr (ALIGN_EPI) { if (wr == 1) PG8_BAR; }
    }
    PG8_WAIT_V(0);
    if constexpr (!ALIGN_EPI) { if (wr == 0) PG8_BAR; }
    PG8_BAR;
    if constexpr (Epi::AFTER_DRAIN) { E.fused(acc, cur, wr, wc, fr, fq, lds, wid, lane); S.done(cur); }
#undef PG8_ABASE
#undef PG8_SA
#undef PG8_SB
#undef PG8_STAGE
#undef PG8_LDA
#undef PG8_LDB
#undef PG8_MMA
#undef PG8_WAIT_V
#undef PG8_WAIT_L
#undef PG8_BAR
#undef PG8_SCHED
}
}

#include <hip/hip_cooperative_groups.h>
namespace cg = cooperative_groups;
#define LAS __attribute__((address_space(3)))
typedef float f32x4 __attribute__((ext_vector_type(4)));
typedef unsigned u32x4 __attribute__((ext_vector_type(4)));
typedef unsigned u32x2 __attribute__((ext_vector_type(2)));

constexpr int NTHREADS = 512, NWAVES = 8;
constexpr int LDS_PHASE_BYTES = 147456;
constexpr int BAR_LDS_OFF = LDS_PHASE_BYTES;
constexpr int LDS_BYTES = LDS_PHASE_BYTES + 256;
constexpr size_t WS_BAR = WS_CTL + 524288;

constexpr int PH_PREP = 0, PH_PER_LAYER = 11, PH_L0 = 1;
constexpr int PHO_IN = 0, PHO_MIXA = 1, PHO_LORA = 2, PHO_C1 = 3, PHO_MIXB = 4, PHO_MIXC = 5, PHO_OUT = 6, PHO_LN1 = 7, PHO_GU = 8, PHO_DOWN = 9, PHO_LN2 = 10;
constexpr int N_PHASES = PH_L0 + DEPTH * PH_PER_LAYER;

struct Args { const float* in[35]; float* out; unsigned char* ws; int ph_lo, ph_hi; };

#define XB_TMO      128
#define XB_XCNT(j)  (256  + 64 * (j))
#define XB_XSUB(j)  (1280 + 64 * (j))
#define XB_XGEN(j)  (2304 + 64 * (j))
#define XB_TOP      3328
#define XB_TOPGEN   3392
#define XCD_BAR_WORDS 3456
#define XB_SPIN_CAP (1u << 18)

__device__ __forceinline__ unsigned xb_ld(unsigned* p)              { return __hip_atomic_load(p, __ATOMIC_RELAXED, __HIP_MEMORY_SCOPE_AGENT); }
__device__ __forceinline__ unsigned xb_add(unsigned* p, unsigned v) { return __hip_atomic_fetch_add(p, v, __ATOMIC_RELAXED, __HIP_MEMORY_SCOPE_AGENT); }
__device__ __forceinline__ unsigned xb_xcc_id() { return (unsigned)__builtin_amdgcn_s_getreg((3 << 11) | 20) & 0xFu; }
#define XB_SPIN(cond, bar) do { unsigned _sp = 0; while (cond) { __builtin_amdgcn_s_sleep(1); \
    if ((++_sp & 255u) == 0u) { if (xb_ld(&(bar)[XB_TMO])) break; if (_sp > XB_SPIN_CAP) { atomicAdd(&(bar)[XB_TMO], 1u); break; } } } } while (0)

struct XcdBarrier {
    unsigned* bar; unsigned x;
    volatile LAS unsigned* st;
};

__device__ __forceinline__ XcdBarrier xcd_barrier_post(unsigned* bar, volatile LAS unsigned* st) {
    XcdBarrier b; b.bar = bar; b.x = xb_xcc_id(); b.st = st;
    if (threadIdx.x == 0) (void)xb_add(&bar[XB_XCNT(b.x)], 1u);
    return b;
}
__device__ __forceinline__ void xcd_barrier_complete(unsigned* bar, unsigned x, unsigned& nloc, unsigned& nx) {
    const unsigned G = gridDim.x * gridDim.y * gridDim.z;
    unsigned sum, cnt, mine, sp = 0u;
    for (;;) {
        sum = 0u; cnt = 0u; mine = 0u;
#pragma unroll
        for (unsigned j = 0; j < 16; ++j) { const unsigned c = xb_ld(&bar[XB_XCNT(j)]); sum += c; cnt += (c > 0u) ? 1u : 0u; mine = (j == x) ? c : mine; }
        if (sum == G) break;
        __builtin_amdgcn_s_sleep(1);
        if ((++sp & 255u) == 0u) { if (xb_ld(&bar[XB_TMO])) break; if (sp > XB_SPIN_CAP) { atomicAdd(&bar[XB_TMO], 1u); break; } }
    }
    nloc = mine > 0u ? mine : 1u; nx = cnt > 0u ? cnt : 1u;
}

__device__ __forceinline__ void xcd_barrier(const XcdBarrier& b) {
    asm volatile("s_waitcnt vmcnt(0)" ::: "memory");
    __syncthreads();
    if (threadIdx.x == 0) {
        unsigned* bar = b.bar;
        __builtin_amdgcn_s_waitcnt(0);
        unsigned nloc = b.st[0], nx = b.st[1];
        if (nloc == 0u) { xcd_barrier_complete(bar, b.x, nloc, nx); b.st[0] = nloc; b.st[1] = nx; }
        const unsigned old = xb_add(&bar[XB_XSUB(b.x)], 1u);
        const unsigned gen = old / nloc;
        if (old + 1u == (gen + 1u) * nloc) {
            __builtin_amdgcn_fence(__ATOMIC_RELEASE, "agent");
            asm volatile("s_waitcnt vmcnt(0)" ::: "memory");
            const unsigned og = xb_add(&bar[XB_TOP], 1u);
            const unsigned tg = og / nx;
            if (og + 1u == (tg + 1u) * nx) xb_add(&bar[XB_TOPGEN], 1u);
            else XB_SPIN(xb_ld(&bar[XB_TOPGEN]) == tg, bar);
            __builtin_amdgcn_fence(__ATOMIC_ACQUIRE, "agent");
            xb_add(&bar[XB_XGEN(b.x)], 1u);
            asm volatile("s_waitcnt vmcnt(0)" ::: "memory");
        } else {
            XB_SPIN(xb_ld(&bar[XB_XGEN(b.x)]) == gen, bar);
            __builtin_amdgcn_fence(__ATOMIC_ACQUIRE, "agent");
            asm volatile("s_waitcnt vmcnt(0)" ::: "memory");
        }
    }
    __syncthreads();
}


typedef float f32x2_t __attribute__((ext_vector_type(2))); typedef __bf16 bf16x2_t __attribute__((ext_vector_type(2)));
__device__ __forceinline__ unsigned pk2bf(float lo, float hi) { f32x2_t v = {lo, hi}; bf16x2_t b = __builtin_convertvector(v, bf16x2_t); return __builtin_bit_cast(unsigned, b); }

struct EpiIn {
    static constexpr bool PERM = true, AFTER_DRAIN = false;
    bf16_t* O; int ldc; int sig_pn;
    __device__ __forceinline__ void operator()(const f32x4 (&acc)[2][2][4][2], const pg8::Unit& u, int wr, int wc, int fr, int fq) const {
        const int row0 = u.pm * 256 + wr * 64 + fr, col0 = u.pn * 256 + wc * 32 + 8 * fq;
        const bool sg = u.pn >= sig_pn;
#pragma unroll
        for (int ai = 0; ai < 2; ++ai)
#pragma unroll
            for (int m = 0; m < 4; ++m) {
                bf16_t* rowp = O + (size_t)(row0 + ai * 128 + m * 16) * ldc + col0;
#pragma unroll
                for (int bj = 0; bj < 2; ++bj) {
                    f32x4 v0 = acc[ai][bj][m][0], v1 = acc[ai][bj][m][1];
                    if (sg) {
#pragma unroll
                        for (int i = 0; i < 4; ++i) { v0[i] = sigmoidf_(v0[i]); v1[i] = sigmoidf_(v1[i]); }
                    }
                    u32x4 w; w.x = pk2bf(v0[0], v0[1]); w.y = pk2bf(v0[2], v0[3]); w.z = pk2bf(v1[0], v1[1]); w.w = pk2bf(v1[2], v1[3]);
                    *(u32x4*)(rowp + bj * 128) = w;
                }
                asm volatile("" ::: "memory");
            }
    }
};
template <bool RESB> struct EpiZ {
    static constexpr bool PERM = true, AFTER_DRAIN = false;
    const void* res; bf16_t* Z; int ldc;
    __device__ __forceinline__ void operator()(const f32x4 (&acc)[2][2][4][2], const pg8::Unit& u, int wr, int wc, int fr, int fq) const {
        const int col0 = u.pn * 256 + wc * 32 + 8 * fq;
#pragma unroll
        for (int ai = 0; ai < 2; ++ai)
#pragma unroll
            for (int m = 0; m < 4; ++m) {
                const size_t off = (size_t)(u.pm * 256 + ai * 128 + wr * 64 + m * 16 + fr) * ldc + col0;
#pragma unroll
                for (int bj = 0; bj < 2; ++bj) {
                    f32x4 r0, r1;
                    if (RESB) { const u32x4 w = *(const u32x4*)((const bf16_t*)res + off + bj * 128);
                        r0 = (f32x4){__uint_as_float(w.x << 16), __uint_as_float(w.x & 0xffff0000u), __uint_as_float(w.y << 16), __uint_as_float(w.y & 0xffff0000u)};
                        r1 = (f32x4){__uint_as_float(w.z << 16), __uint_as_float(w.z & 0xffff0000u), __uint_as_float(w.w << 16), __uint_as_float(w.w & 0xffff0000u)}; }
                    else { r0 = *(const f32x4*)((const float*)res + off + bj * 128); r1 = *(const f32x4*)((const float*)res + off + bj * 128 + 4); }
                    const f32x4 v0 = r0 * ALPHA + acc[ai][bj][m][0], v1 = r1 * ALPHA + acc[ai][bj][m][1];
                    u32x4 w; w.x = pk2bf(v0[0], v0[1]); w.y = pk2bf(v0[2], v0[3]); w.z = pk2bf(v1[0], v1[1]); w.w = pk2bf(v1[2], v1[3]);
                    *(u32x4*)(Z + off + bj * 128) = w;
                }
                asm volatile("" ::: "memory");
            }
    }
};
template <bool RESB> struct EpiZS {
    static constexpr bool PERM = false, AFTER_DRAIN = false;
    const void* res; float* ZS; int ldc;
    __device__ __forceinline__ void operator()(const f32x4 (&acc)[2][2][4][2], const pg8::Unit& u, int wr, int wc, int fr, int fq) const {
        const int ks = u.pn >> 2, col0 = (u.pn & 3) * 256 + wc * 32 + 4 * fq;
        float* Z = ZS + (size_t)ks * MS * D;
#pragma unroll
        for (int ai = 0; ai < 2; ++ai)
#pragma unroll
            for (int m = 0; m < 4; ++m) {
                const size_t off = (size_t)(u.pm * 256 + ai * 128 + wr * 64 + m * 16 + fr) * ldc + col0;
#pragma unroll
                for (int bj = 0; bj < 2; ++bj)
#pragma unroll
                    for (int n = 0; n < 2; ++n) {
                        f32x4 o = acc[ai][bj][m][n];
                        if (ks == 0) {
                            f32x4 r;
                            if (RESB) { const u32x2 w = *(const u32x2*)((const bf16_t*)res + off + bj * 128 + n * 16);
                                r = (f32x4){__uint_as_float(w.x << 16), __uint_as_float(w.x & 0xffff0000u), __uint_as_float(w.y << 16), __uint_as_float(w.y & 0xffff0000u)}; }
                            else r = *(const f32x4*)((const float*)res + off + bj * 128 + n * 16);
                            o = r * ALPHA + o;
                        }
                        *(f32x4*)(Z + off + bj * 128 + n * 16) = o;
                    }
                asm volatile("" ::: "memory");
            }
    }
};
struct EpiSwiGLU {
    static constexpr bool PERM = true, AFTER_DRAIN = false;
    bf16_t* H; int ldc;
    __device__ __forceinline__ void operator()(const f32x4 (&acc)[2][2][4][2], const pg8::Unit& u, int wr, int wc, int fr, int fq) const {
        const int row0 = u.pm * 256 + wr * 64 + fr, col0 = u.pn * 128 + wc * 32 + 8 * fq;
#pragma unroll
        for (int ai = 0; ai < 2; ++ai)
#pragma unroll
            for (int m = 0; m < 4; ++m) {
                bf16_t* rowp = H + (size_t)(row0 + ai * 128 + m * 16) * ldc + col0;
                float o[8];
#pragma unroll
                for (int n = 0; n < 2; ++n)
#pragma unroll
                    for (int i = 0; i < 4; ++i) { const float g = acc[ai][0][m][n][i], up = acc[ai][1][m][n][i]; o[n * 4 + i] = g * sigmoidf_(g) * up; }
                u32x4 w; w.x = pk2bf(o[0], o[1]); w.y = pk2bf(o[2], o[3]); w.z = pk2bf(o[4], o[5]); w.w = pk2bf(o[6], o[7]);
                *(u32x4*)rowp = w;
                asm volatile("" ::: "memory");
            }
    }
};

template <int MODE> __device__ __forceinline__ int colmap(int n) {
    if (MODE == 0) return n < 5920 ? n : (n < 6144 ? -1 : n - 224);
    if (MODE == 2) { const int pn = n >> 8, q = n & 255; return q < 128 ? pn * 128 + q : DFF + pn * 128 + (q - 128); }
    return n;
}
template <int MODE> __device__ __forceinline__ void transpose_item(const float* __restrict__ W, int K, int ldw, bf16_t* WT, int item, int nblk, LAS float* tile, int tid, bf16_t* WS2 = nullptr, int kpart = 0, int nrows = 0) {
    const int kb = item / nblk, nb = item % nblk, k0 = kb * 64, n0 = nb * 64;
    {
        const int n4 = tid & 15; const int col = colmap<MODE>(n0 + 4 * n4);
#pragma unroll
        for (int i = 0; i < 2; ++i) {
            const int kk = i * 32 + (tid >> 4);
            const f32x4 v = col >= 0 ? *(const f32x4*)(W + (size_t)(k0 + kk) * ldw + col) : (f32x4){0.f, 0.f, 0.f, 0.f};
            LAS float* t = tile + kk * 65 + 4 * n4; t[0] = v[0]; t[1] = v[1]; t[2] = v[2]; t[3] = v[3];
        }
    }
    __syncthreads();
    {
        const int nn = tid >> 3, c = tid & 7; const LAS float* s = tile + (8 * c) * 65 + nn;
        u32x4 o; o.x = pk2bf(s[0], s[65]); o.y = pk2bf(s[2 * 65], s[3 * 65]); o.z = pk2bf(s[4 * 65], s[5 * 65]); o.w = pk2bf(s[6 * 65], s[7 * 65]);
        *(u32x4*)(WT + (size_t)(n0 + nn) * K + k0 + 8 * c) = o;
        if (WS2) { const int ks = k0 / kpart; *(u32x4*)(WS2 + ((size_t)ks * nrows + n0 + nn) * kpart + (k0 - ks * kpart) + 8 * c) = o; }
    }
    __syncthreads();
}
__device__ __forceinline__ void prep_rg_weights(const Args& a, int l);
__device__ __forceinline__ void prep_weights(const Args& a, int l, int what, int first, LAS unsigned char* lds) {
    const int tid = threadIdx.x, G = gridDim.x - first, bx = (int)blockIdx.x - first;
    if (bx < 0) return;
    LAS float* tile = (LAS float*)lds;
    constexpr int I_IN = (D / 64) * (NP / 64), I_OUT = (D / 64) * (D / 64), I_GU = (D / 64) * (2 * DFF / 64), I_DN = (DFF / 64) * (D / 64);
    if (what & 1) for (int r = bx; r < I_IN; r += G) transpose_item<0>(a.in[8] + (size_t)l * D * IN_COLS, D, IN_COLS, (bf16_t*)(a.ws + WS_WIN), r, NP / 64, tile, tid);
    if (what & 4) {
        for (int it = bx; it < I_OUT + I_GU + I_DN; it += G) {
            int r = it;
            if (r < I_OUT) { transpose_item<1>(a.in[28] + (size_t)l * D * D, D, D, (bf16_t*)(a.ws + WS_WOUT), r, D / 64, tile, tid, (bf16_t*)(a.ws + WS_WOUTS), 256, D); continue; } r -= I_OUT;
            if (r < I_GU) { transpose_item<2>(a.in[31] + (size_t)l * D * 2 * DFF, D, 2 * DFF, (bf16_t*)(a.ws + WS_WGU), r, 2 * DFF / 64, tile, tid); continue; } r -= I_GU;
            transpose_item<1>(a.in[32] + (size_t)l * DFF * D, DFF, D, (bf16_t*)(a.ws + WS_WDN), r, D / 64, tile, tid, (bf16_t*)(a.ws + WS_WDNS), 256, D);
        }
    }
    if (what & 2) {
        for (unsigned i = (unsigned)bx * NTHREADS + tid; i < (unsigned)(3072 * ACAT_K); i += (unsigned)G * NTHREADS) {
            const int n = (int)(i / ACAT_K), k = (int)(i % ACAT_K), kind = n >> 10, c = n & 1023;
            float v = 0.f;
            if (kind == 0 && k < 64) v = a.in[19][((size_t)l * 64 + k) * D + c];
            else if (kind == 1 && k >= 64 && k < 128) v = a.in[21][((size_t)l * 64 + (k - 64)) * D + c];
            else if (kind == 2 && k >= 128 && k < 288) v = a.in[22][((size_t)l * 160 + (k - 128)) * D + c];
            ((bf16_t*)(a.ws + WS_WLORA))[i] = f2bf(v);
        }
    }
    if (what & 8) prep_rg_weights(a, l);
}
__device__ __forceinline__ void phase_prep_x(const Args& a) {
    bf16_t* XB = (bf16_t*)(a.ws + WS_XB);
    const size_t n4 = (size_t)M * D / 4, np4 = (size_t)MP * D / 4;
    for (size_t i = (size_t)blockIdx.x * NTHREADS + threadIdx.x; i < n4; i += (size_t)gridDim.x * NTHREADS) {
        const f32x4 v = i < np4 ? ((const f32x4*)a.in[0])[i] : ((const f32x4*)a.in[1])[i - np4];
        u32x2 w; w.x = pk2bf(v[0], v[1]); w.y = pk2bf(v[2], v[3]);
        ((u32x2*)XB)[i] = w;
    }
}

__device__ __forceinline__ float wave_sum_fast(float x) {
    x += __builtin_bit_cast(float, __builtin_amdgcn_update_dpp(0, __builtin_bit_cast(int, x), 0xB1, 0xF, 0xF, true));
    x += __builtin_bit_cast(float, __builtin_amdgcn_update_dpp(0, __builtin_bit_cast(int, x), 0x4E, 0xF, 0xF, true));
    x += __builtin_bit_cast(float, __builtin_amdgcn_update_dpp(0, __builtin_bit_cast(int, x), 0x124, 0xF, 0xF, true));
    x += __builtin_bit_cast(float, __builtin_amdgcn_update_dpp(0, __builtin_bit_cast(int, x), 0x128, 0xF, 0xF, true));
    x += __shfl_xor(x, 16); x += __shfl_xor(x, 32);
    return x;
}
template <int NS> __device__ __forceinline__ void phase_ln(const bf16_t* __restrict__ Z, const float* __restrict__ ZS, const float* __restrict__ g, const float* __restrict__ b, float* OF, bf16_t* OB) {
    const int lane = threadIdx.x & 63, wv = threadIdx.x >> 6;
    f32x4 gv[4], bv[4];
#pragma unroll
    for (int j = 0; j < 4; ++j) { gv[j] = ((const f32x4*)g)[j * 64 + lane]; bv[j] = ((const f32x4*)b)[j * 64 + lane]; }
    const int stride = gridDim.x * NWAVES;
    int m = blockIdx.x * NWAVES + wv;
    f32x4 nx[4];
    auto load_row = [&](int mm) {
        if (mm < MP) {
#pragma unroll
            for (int j = 0; j < 4; ++j) { const u32x2 w = ((const u32x2*)(Z + (size_t)mm * D))[j * 64 + lane];
                nx[j] = (f32x4){__uint_as_float(w.x << 16), __uint_as_float(w.x & 0xffff0000u), __uint_as_float(w.y << 16), __uint_as_float(w.y & 0xffff0000u)}; }
        } else {
#pragma unroll
            for (int j = 0; j < 4; ++j) nx[j] = ((const f32x4*)(ZS + (size_t)(mm - MP) * D))[j * 64 + lane];
#pragma unroll
            for (int ks = 1; ks < NS; ++ks)
#pragma unroll
                for (int j = 0; j < 4; ++j) nx[j] = nx[j] + ((const f32x4*)(ZS + ((size_t)ks * MS + (mm - MP)) * D))[j * 64 + lane];
        }
    };
    if (m < M) load_row(m);
    for (; m < M; m += stride) {
        f32x4 v[4]; float s = 0.f;
#pragma unroll
        for (int j = 0; j < 4; ++j) { v[j] = nx[j]; s += (v[j][0] + v[j][1]) + (v[j][2] + v[j][3]); }
        if (m + stride < M) load_row(m + stride);
        const float mean = wave_sum_fast(s) * (1.f / D);
        float q = 0.f;
#pragma unroll
        for (int j = 0; j < 4; ++j) { v[j] = v[j] - mean; q += (v[j][0] * v[j][0] + v[j][1] * v[j][1]) + (v[j][2] * v[j][2] + v[j][3] * v[j][3]); }
        const float rstd = rsqrtf(wave_sum_fast(q) * (1.f / D) + LN_EPS);
#pragma unroll
        for (int j = 0; j < 4; ++j) {
            const f32x4 y = v[j] * rstd * gv[j] + bv[j];
            if (OF) ((f32x4*)(OF + (size_t)m * D))[j * 64 + lane] = y;
            if (OB) { u32x2 w; w.x = pk2bf(y[0], y[1]); w.y = pk2bf(y[2], y[3]); ((u32x2*)(OB + (size_t)m * D))[j * 64 + lane] = w; }
        }
    }
}


typedef short bf16x8_t __attribute__((ext_vector_type(8)));
typedef short bf16x4_t __attribute__((ext_vector_type(4)));
typedef short v4i16_t __attribute__((ext_vector_type(4)));
#define LDSW() asm volatile("s_waitcnt lgkmcnt(0)" ::: "memory")
__device__ __forceinline__ u32x2 tr_read4(LAS unsigned char* p) { return __builtin_bit_cast(u32x2, __builtin_amdgcn_ds_read_tr16_b64_v4i16((LAS v4i16_t*)p)); }
__device__ __forceinline__ bf16x8_t mk_frag(u32x2 lo, u32x2 hi) { const u32x4 w = (u32x4){lo.x, lo.y, hi.x, hi.y}; return __builtin_bit_cast(bf16x8_t, w); }
__device__ __forceinline__ u32x2 pk4(float a, float b, float c, float d) { u32x2 w; w.x = pk2bf(a, b); w.y = pk2bf(c, d); return w; }

constexpr size_t WS_WRG = WS_CTL + 4096;
constexpr int RG_TP = 144;
__device__ __forceinline__ void prep_rg_weights(const Args& a, int l) {
    const size_t gt = (size_t)blockIdx.x * NTHREADS + threadIdx.x, gs = (size_t)gridDim.x * NTHREADS;
    bf16_t* W = (bf16_t*)(a.ws + WS_WRG);
    for (size_t i = gt; i < (size_t)2 * 16 * 4096; i += gs) {
        const int gate = (int)(i >> 16), bk = (int)(i >> 12) & 15, j = (int)(i >> 6) & 63, ii = (int)i & 63;
        W[i] = f2bf(a.in[gate ? 14 : 12][(size_t)l * 16 * 4096 + ((size_t)bk * 64 + ii) * 64 + j]);
    }
}
__device__ __forceinline__ float one_minus_exp(float x) {
    const float s = -x * (1.f + x * (0.5f + x * (0.16666667f + x * (0.041666668f + x * 0.0083333333f))));
    return x > -0.25f ? s : 1.f - __expf(x);
}
template <bool PASS2>
__device__ __forceinline__ void rglru_unit2(const Args& a, int L, int unit, LAS unsigned char* lds) {
    int lane = threadIdx.x & 63; const int wv = __builtin_amdgcn_readfirstlane(threadIdx.x >> 6);
    asm volatile("" : "+v"(lane));
    const int i16 = lane & 15, qp = lane >> 4;
    const bf16_t* P = (const bf16_t*)(a.ws + WS_P); bf16_t* OB = (bf16_t*)(a.ws + WS_OB); float* RS = (float*)(a.ws + WS_RS);
    const bf16_t* WRG = (const bf16_t*)(a.ws + WS_WRG);
    const float* cw = a.in[10] + (size_t)L * 4 * D; const float* cb = a.in[11] + L * D; const float* ba = a.in[13] + L * D;
    const float* bx = a.in[15] + L * D; const float* lam = a.in[16] + L * D;
    const float* conv0 = a.in[4] + (size_t)L * DBATCH * 3 * D; const float* h0 = a.in[5] + (size_t)L * DBATCH * D;
    LAS unsigned char* tile = lds + wv * (64 * RG_TP);
    LAS unsigned char* obt = lds + (NWAVES + wv) * (64 * RG_TP);
    const int m0 = unit * 64;
    const bool sample = m0 >= MP;
    const int bseq = sample ? 0 : m0 / SEQ, chunk = sample ? 0 : (m0 % SEQ) / 64;
    for (int bb = 0; bb < 2; ++bb) {
        const int bk = 2 * wv + bb, c0 = 64 * bk;
        bf16x8_t af[4][2];
#pragma unroll
        for (int ks = 0; ks < 2; ++ks) {
            const int cc = c0 + 32 * ks + 8 * qp;
            f32x4 w0[2], w1[2], w2[2], w3[2], wb[2];
#pragma unroll
            for (int hh = 0; hh < 2; ++hh) { w0[hh] = *(const f32x4*)(cw + 0 * D + cc + 4 * hh); w1[hh] = *(const f32x4*)(cw + 1 * D + cc + 4 * hh); w2[hh] = *(const f32x4*)(cw + 2 * D + cc + 4 * hh);
                w3[hh] = *(const f32x4*)(cw + 3 * D + cc + 4 * hh); wb[hh] = *(const f32x4*)(cb + cc + 4 * hh); }
#pragma unroll
            for (int mt = 0; mt < 4; ++mt) {
                const int tok = 16 * mt + i16; const size_t m = (size_t)m0 + tok;
                const int tseq = sample ? (tok & 7) : (chunk * 64 + tok);
                float xv[4][8];
#pragma unroll
                for (int k = 0; k < 4; ++k) {
                    const int back = 3 - k;
                    const bool ok = tseq - back >= 0;
                    const u32x4 v = *(const u32x4*)(P + (m - (ok ? back : 0)) * NP + CRNN + cc);
                    const unsigned w4[4] = {v.x, v.y, v.z, v.w};
#pragma unroll
                    for (int e = 0; e < 8; ++e) xv[k][e] = ok ? __uint_as_float((e & 1) ? (w4[e >> 1] & 0xffff0000u) : (w4[e >> 1] << 16)) : 0.f;
                    if (sample && back > 0) {
                        const int b = (int)(m - MP) >> 3; const int ci = ok ? 0 : 3 + tseq - back;
                        const float* cp = conv0 + ((size_t)b * 3 + ci) * D + cc;
                        const f32x4 v0 = *(const f32x4*)cp, v1 = *(const f32x4*)(cp + 4);
#pragma unroll
                        for (int e = 0; e < 4; ++e) { xv[k][e] = ok ? xv[k][e] : v0[e]; xv[k][4 + e] = ok ? xv[k][4 + e] : v1[e]; }
                    }
                }
                float xc[8];
#pragma unroll
                for (int e = 0; e < 8; ++e) xc[e] = wb[e >> 2][e & 3] + w0[e >> 2][e & 3] * xv[0][e] + w1[e >> 2][e & 3] * xv[1][e] + w2[e >> 2][e & 3] * xv[2][e] + w3[e >> 2][e & 3] * xv[3][e];
                const u32x4 pk = (u32x4){pk2bf(xc[0], xc[1]), pk2bf(xc[2], xc[3]), pk2bf(xc[4], xc[5]), pk2bf(xc[6], xc[7])};
                af[mt][ks] = __builtin_bit_cast(bf16x8_t, pk);
                *(LAS u32x4*)(tile + tok * RG_TP + (32 * ks + 8 * qp) * 2) = pk;
            }
        }
        LDSW();
#pragma unroll 1
        for (int nt = 0; nt < 4; ++nt) {
            const int j = 16 * nt + i16, c = c0 + j;
            bf16x8_t ba_[2], bx_[2];
#pragma unroll
            for (int ks = 0; ks < 2; ++ks) { ba_[ks] = *(const bf16x8_t*)(WRG + ((size_t)(0 * 16 + bk) * 64 + j) * 64 + 32 * ks + 8 * qp); bx_[ks] = *(const bf16x8_t*)(WRG + ((size_t)(1 * 16 + bk) * 64 + j) * 64 + 32 * ks + 8 * qp); }
            const float bac = ba[c], bxc = bx[c], spl = softplusf_(-lam[c]);
            float av[4][4], uv[4][4];
#pragma unroll
            for (int mt = 0; mt < 4; ++mt) {
                f32x4 ar = (f32x4){0.f, 0.f, 0.f, 0.f}, ai = ar;
#pragma unroll
                for (int ks = 0; ks < 2; ++ks) { ar = __builtin_amdgcn_mfma_f32_16x16x32_bf16(af[mt][ks], ba_[ks], ar, 0, 0, 0); ai = __builtin_amdgcn_mfma_f32_16x16x32_bf16(af[mt][ks], bx_[ks], ai, 0, 0, 0); }
                const u32x2 xcp = tr_read4(tile + (16 * mt + 4 * qp + (i16 >> 2)) * RG_TP + (16 * nt + 4 * (i16 & 3)) * 2);
#pragma unroll
                for (int r = 0; r < 4; ++r) {
                    const unsigned xw = r < 2 ? xcp.x : xcp.y;
                    const float xcv = __uint_as_float((r & 1) ? (xw & 0xffff0000u) : (xw << 16));
                    const float rg = sigmoidf_(ar[r] + bac), ig = sigmoidf_(ai[r] + bxc);
                    const float log_a = -8.f * rg * spl;
                    av[mt][r] = __expf(log_a);
                    uv[mt][r] = __builtin_amdgcn_sqrtf(one_minus_exp(2.f * log_a)) * (ig * xcv);
                }
            }
            float H = 0.f, Atot = 1.f;
            if (PASS2 && !sample && chunk > 0) H = RS[(((size_t)bseq * 128 + chunk) * D + c) * 2 + 1];
#pragma unroll
            for (int mt = 0; mt < 4; ++mt) {
                const float As = av[mt][0] * av[mt][1] * av[mt][2] * av[mt][3];
                const float Bs = ((uv[mt][0] * av[mt][1] + uv[mt][1]) * av[mt][2] + uv[mt][2]) * av[mt][3] + uv[mt][3];
                float Aq[4], Bq[4];
#pragma unroll
                for (int q = 0; q < 4; ++q) { Aq[q] = __shfl(As, i16 + 16 * q); Bq[q] = __shfl(Bs, i16 + 16 * q); }
                float hs;
                if (!sample) {
                    const float h1 = Aq[0] * H + Bq[0], h2 = Aq[1] * h1 + Bq[1], h3 = Aq[2] * h2 + Bq[2];
                    hs = qp == 0 ? H : (qp == 1 ? h1 : (qp == 2 ? h2 : h3));
                    H = Aq[3] * h3 + Bq[3]; Atot *= Aq[0] * Aq[1] * Aq[2] * Aq[3];
                } else {
                    const int b0 = ((m0 - MP) >> 3) + 2 * mt;
                    const float hA = h0[(size_t)b0 * D + c], hB = h0[(size_t)(b0 + 1) * D + c];
                    const float hA1 = Aq[0] * hA + Bq[0], hB1 = Aq[2] * hB + Bq[2];
                    hs = qp == 0 ? hA : (qp == 1 ? hA1 : (qp == 2 ? hB : hB1));
                    if (PASS2 && qp == 0) {
                        a.out[O_SH + ((size_t)L * DBATCH + b0) * D + c] = Aq[1] * hA1 + Bq[1];
                        a.out[O_SH + ((size_t)L * DBATCH + b0 + 1) * D + c] = Aq[3] * hB1 + Bq[3];
                    }
                }
                if (PASS2) {
                    float h = hs;
#pragma unroll
                    for (int r = 0; r < 4; ++r) { h = av[mt][r] * h + uv[mt][r]; *(LAS unsigned short*)(obt + (16 * mt + 4 * qp + r) * RG_TP + j * 2) = f2bf(h); }
                }
            }
            if (!sample && qp == 0) {
                if (!PASS2) *(float2*)(RS + (((size_t)bseq * 128 + chunk) * D + c) * 2) = make_float2(Atot, H);
                else if (chunk == 127) a.out[O_PH + ((size_t)L * NBATCH + bseq) * D + c] = H;
            }
        }
        LDSW();
        if (PASS2) {
#pragma unroll
            for (int p = 0; p < 8; ++p) {
                const int q = p * 64 + lane, row = q >> 3, pc = q & 7;
                *(u32x4*)(OB + ((size_t)m0 + row) * D + c0 + 8 * pc) = *(const LAS u32x4*)(obt + row * RG_TP + pc * 16);
            }
            LDSW();
        }
    }
    if (PASS2) {
        const int t = threadIdx.x;
        if (sample) {
            for (int i = t; i < 8 * 3 * D; i += NTHREADS) { const int s = i / (3 * D), k = (i / D) % 3, c = i % D; const int b = ((m0 - MP) >> 3) + s;
                a.out[O_SCONV + (((size_t)L * DBATCH + b) * 3 + k) * D + c] = bf2f(P[((size_t)MP + b * DSEQ + 5 + k) * NP + CRNN + c]); }
        } else if (chunk == 127) {
            for (int i = t; i < 3 * D; i += NTHREADS) { const int k = i / D, c = i % D;
                a.out[O_PCONV + (((size_t)L * NBATCH + bseq) * 3 + k) * D + c] = bf2f(P[((size_t)m0 + 61 + k) * NP + CRNN + c]); }
        }
    }
}
__device__ __forceinline__ void rglru_prefix(const Args& a) {
    float* RS = (float*)(a.ws + WS_RS);
    const int gid = blockIdx.x * NTHREADS + threadIdx.x;
    if (gid >= NBATCH * D) return;
    const int b = gid / D, c = gid % D;
    float h = 0.f;
    for (int c0 = 0; c0 < 128; c0 += 16) {
        float2 ab[16];
#pragma unroll
        for (int i = 0; i < 16; ++i) ab[i] = *(const float2*)(RS + (((size_t)b * 128 + c0 + i) * D + c) * 2);
#pragma unroll
        for (int i = 0; i < 16; ++i) { RS[(((size_t)b * 128 + c0 + i) * D + c) * 2 + 1] = h; h = ab[i].x * h + ab[i].y; }
    }
}


constexpr int AT_KPB = 144;
constexpr int AT_VPB = 528;
constexpr int AT_K_OFF = 0, AT_V_OFF = 256 * AT_KPB;
constexpr int AT_LDS = AT_V_OFF + 64 * AT_VPB;

template <bool SAMPLE>
__device__ __forceinline__ void attn_unit(const bf16_t* __restrict__ P, bf16_t* OA, const float* __restrict__ sinks, const float* __restrict__ ck, const float* __restrict__ cv,
                                          int b, int qb, int c, LAS unsigned char* lds) {
    const int tid = threadIdx.x, lane = tid & 63, wv = __builtin_amdgcn_readfirstlane(tid >> 6), i16 = lane & 15, qp = lane >> 4;
    LAS unsigned char* ldsK = lds + AT_K_OFF; LAS unsigned char* ldsV = lds + AT_V_OFF;
    if (!SAMPLE) {
        const size_t row_base = (size_t)b * SEQ + (size_t)(qb - 1) * 128;
#pragma unroll
        for (int it = 0; it < 4; ++it) {
            const int ci = tid + 512 * it, s = ci >> 3, part = ci & 7;
            u32x4 kv = (u32x4){0u, 0u, 0u, 0u}, vv = (u32x4){0u, 0u, 0u, 0u};
            if (qb > 0 || s >= 128) {
                const bf16_t* pr = P + (row_base + s) * NP;
                kv = *(const u32x4*)(pr + CK + 64 * c + 8 * part);
                vv = *(const u32x4*)(pr + CV + 64 * c + 8 * part);
            }
            *(LAS u32x4*)(ldsK + s * AT_KPB + part * 16) = kv;
            const unsigned w4[4] = {vv.x, vv.y, vv.z, vv.w};
#pragma unroll
            for (int e = 0; e < 8; ++e) *(LAS unsigned short*)(ldsV + (8 * part + e) * AT_VPB + 2 * s) = (unsigned short)((w4[e >> 1] >> (16 * (e & 1))) & 0xffffu);
        }
    } else {
        for (int ci = tid; ci < 144 * 16; ci += 512) {
            const int s = ci >> 4, part = ci & 15;
            float kf[4] = {0.f, 0.f, 0.f, 0.f}, vf[4] = {0.f, 0.f, 0.f, 0.f};
            if (s < 128) {
                const f32x4 k4 = *(const f32x4*)(ck + ((size_t)(b * 128 + s) * 4 + c) * 64 + 4 * part);
                const f32x4 v4 = *(const f32x4*)(cv + ((size_t)(b * 128 + s) * 4 + c) * 64 + 4 * part);
#pragma unroll
                for (int e = 0; e < 4; ++e) { kf[e] = k4[e]; vf[e] = v4[e]; }
            } else if (s < 136) {
                const bf16_t* pr = P + (size_t)(MP + b * DSEQ + (s - 128)) * NP;
#pragma unroll
                for (int e = 0; e < 4; ++e) { kf[e] = bf2f(pr[CK + 64 * c + 4 * part + e]); vf[e] = bf2f(pr[CV + 64 * c + 4 * part + e]); }
            }
            u32x2 kw; kw.x = pk2bf(kf[0], kf[1]); kw.y = pk2bf(kf[2], kf[3]);
            *(LAS u32x2*)(ldsK + s * AT_KPB + part * 8) = kw;
#pragma unroll
            for (int e = 0; e < 4; ++e) *(LAS unsigned short*)(ldsV + (4 * part + e) * AT_VPB + 2 * s) = f2bf(vf[e]);
        }
    }
    __syncthreads();
    const int n_mt = SAMPLE ? 1 : 4;
    if (!SAMPLE || wv < 2) {
        for (int mt = 0; mt < n_mt; ++mt) {
            int h, tq, nt0; size_t qrow;
            if (!SAMPLE) { const int g = wv >> 1, qh = wv & 1; h = 4 * c + g; tq = 64 * qh + 16 * mt + i16; nt0 = (64 * qh + 16 * mt) >> 4; qrow = (size_t)b * SEQ + (size_t)qb * 128 + tq; }
            else { const int rho = 16 * wv + i16; h = 4 * c + (rho >> 3); tq = rho & 7; nt0 = 0; qrow = (size_t)MP + b * DSEQ + tq; }
            const float slope = exp2f(-0.5f * (float)(h + 1)), sink = sinks[h];
            bf16x8_t qf[2];
#pragma unroll
            for (int ks = 0; ks < 2; ++ks) qf[ks] = *(const bf16x8_t*)(P + qrow * NP + CQ + 64 * h + 32 * ks + 8 * qp);
            f32x4 sc[9];
#pragma unroll
            for (int jn = 0; jn < 9; ++jn) {
                const int nt = nt0 + jn;
                f32x4 acc = (f32x4){0.f, 0.f, 0.f, 0.f};
                if (SAMPLE || qb > 0 || nt >= 8) {
#pragma unroll
                    for (int ks = 0; ks < 2; ++ks) {
                        const bf16x8_t kfr = *(const LAS bf16x8_t*)(ldsK + (16 * nt + i16) * AT_KPB + (32 * ks + 8 * qp) * 2);
                        acc = __builtin_amdgcn_mfma_f32_16x16x32_bf16(kfr, qf[ks], acc, 0, 0, 0);
                    }
                }
#pragma unroll
                for (int r = 0; r < 4; ++r) {
                    const int sidx = 16 * nt + 4 * qp + r;
                    const int rel = 128 + tq - sidx;
                    bool valid = rel >= 0 && rel < 128;
                    if (!SAMPLE) valid = valid && (qb > 0 || sidx >= 128);
                    acc[r] = valid ? acc[r] * 0.125f - slope * (float)rel : -INFINITY;
                }
                sc[jn] = acc;
            }
            float mx = sink;
#pragma unroll
            for (int jn = 0; jn < 9; ++jn)
#pragma unroll
                for (int r = 0; r < 4; ++r) mx = fmaxf(mx, sc[jn][r]);
            mx = fmaxf(mx, __shfl_xor(mx, 16)); mx = fmaxf(mx, __shfl_xor(mx, 32));
            float sum = 0.f;
#pragma unroll
            for (int jn = 0; jn < 9; ++jn)
#pragma unroll
                for (int r = 0; r < 4; ++r) { const float e = __expf(sc[jn][r] - mx); sc[jn][r] = e; sum += e; }
            sum += __shfl_xor(sum, 16); sum += __shfl_xor(sum, 32);
            const float inv = __builtin_amdgcn_rcpf(sum + __expf(sink - mx));
            bf16x8_t pf[5];
#pragma unroll
            for (int ks = 0; ks < 5; ++ks) {
                u32x4 w;
                w.x = pk2bf(sc[2 * ks][0] * inv, sc[2 * ks][1] * inv); w.y = pk2bf(sc[2 * ks][2] * inv, sc[2 * ks][3] * inv);
                if (ks < 4) { w.z = pk2bf(sc[2 * ks + 1][0] * inv, sc[2 * ks + 1][1] * inv); w.w = pk2bf(sc[2 * ks + 1][2] * inv, sc[2 * ks + 1][3] * inv); }
                else { w.z = 0u; w.w = 0u; }
                pf[ks] = __builtin_bit_cast(bf16x8_t, w);
            }
#pragma unroll
            for (int dt = 0; dt < 4; ++dt) {
                f32x4 o = (f32x4){0.f, 0.f, 0.f, 0.f};
#pragma unroll
                for (int ks = 0; ks < 5; ++ks) {
                    const int ntA = nt0 + 2 * ks, ntB = (ks < 4) ? nt0 + 2 * ks + 1 : nt0 + 2 * ks;
                    const LAS unsigned char* vr = ldsV + (16 * dt + i16) * AT_VPB;
                    const u32x2 lo = *(const LAS u32x2*)(vr + 2 * (16 * ntA + 4 * qp));
                    const u32x2 hi = *(const LAS u32x2*)(vr + 2 * (16 * ntB + 4 * qp));
                    const u32x4 w = (u32x4){lo.x, lo.y, hi.x, hi.y};
                    o = __builtin_amdgcn_mfma_f32_16x16x32_bf16(__builtin_bit_cast(bf16x8_t, w), pf[ks], o, 0, 0, 0);
                }
                u32x2 ow; ow.x = pk2bf(o[0], o[1]); ow.y = pk2bf(o[2], o[3]);
                *(u32x2*)(OA + qrow * D + 64 * h + 16 * dt + 4 * qp) = ow;
            }
        }
    }
    __syncthreads();
}

template <bool PASS2>
__device__ __forceinline__ void rglru_unit(const Args& a, int L, int unit, LAS unsigned char* lds) {
    const int tid = threadIdx.x, lane = tid & 63, wv = __builtin_amdgcn_readfirstlane(tid >> 6);
    const bf16_t* P = (const bf16_t*)(a.ws + WS_P); bf16_t* OB = (bf16_t*)(a.ws + WS_OB); float* RS = (float*)(a.ws + WS_RS);
    const float* cw = a.in[10] + (size_t)L * 4 * D; const float* cb = a.in[11] + L * D; const float* wa = a.in[12] + (size_t)L * 16 * 4096; const float* ba = a.in[13] + L * D;
    const float* wx = a.in[14] + (size_t)L * 16 * 4096; const float* bx = a.in[15] + L * D; const float* lam = a.in[16] + L * D;
    const float* conv0 = a.in[4] + (size_t)L * DBATCH * 3 * D; const float* h0 = a.in[5] + (size_t)L * DBATCH * D;
    LAS float* s_xc = (LAS float*)lds + wv * 64;
    const int m0 = unit * 64;
    const bool sample = m0 >= MP;
    for (int bb = 0; bb < 2; ++bb) {
        const int bk = 2 * wv + bb, c = 64 * bk + lane;
        float war[64], wxr[64];
#pragma unroll
        for (int i = 0; i < 64; ++i) { war[i] = wa[((size_t)bk * 64 + i) * 64 + lane]; wxr[i] = wx[((size_t)bk * 64 + i) * 64 + lane]; }
        const float c0 = cw[0 * D + c], c1 = cw[1 * D + c], c2 = cw[2 * D + c], c3 = cw[3 * D + c], cbc = cb[c], bac = ba[c], bxc = bx[c];
        const float spl = softplusf_(-lam[c]);
        float x1 = 0.f, x2 = 0.f, x3 = 0.f, h = 0.f, Ap = 1.f;
        int bseq = 0, chunk = 0;
        if (!sample) {
            bseq = m0 / SEQ; chunk = (m0 % SEQ) / 64;
            if (chunk > 0) {
                x1 = bf2f(P[(size_t)(m0 - 1) * NP + CRNN + c]); x2 = bf2f(P[(size_t)(m0 - 2) * NP + CRNN + c]); x3 = bf2f(P[(size_t)(m0 - 3) * NP + CRNN + c]);
                if (PASS2) { for (int cc = 0; cc < chunk; ++cc) { const float2 ab = *(const float2*)(RS + (((size_t)bseq * 128 + cc) * D + c) * 2); h = ab.x * h + ab.y; } }
            }
        }
        for (int t = 0; t < 64; ++t) {
            const size_t m = (size_t)m0 + t;
            if (sample && (t & 7) == 0) {
                if (!PASS2) break;
                const int b = (int)(m - MP) >> 3;
                x3 = conv0[((size_t)b * 3 + 0) * D + c]; x2 = conv0[((size_t)b * 3 + 1) * D + c]; x1 = conv0[((size_t)b * 3 + 2) * D + c]; h = h0[(size_t)b * D + c];
            }
            const float x = bf2f(P[m * NP + CRNN + c]);
            const float xc = cbc + c0 * x3 + c1 * x2 + c2 * x1 + c3 * x;
            LDSW(); s_xc[lane] = xc; LDSW();
            float r = bac, ig = bxc;
#pragma unroll
            for (int i4 = 0; i4 < 16; ++i4) { const f32x4 xv = *(const LAS f32x4*)(s_xc + 4 * i4);
#pragma unroll
                for (int e = 0; e < 4; ++e) { r += xv[e] * war[4 * i4 + e]; ig += xv[e] * wxr[4 * i4 + e]; } }
            r = sigmoidf_(r); ig = sigmoidf_(ig);
            const float log_a = -8.f * r * spl;
            const float av = __expf(log_a);
            const float u = sqrtf(-expm1f(2.f * log_a)) * (ig * xc);
            h = av * h + u; Ap *= av;
            if (PASS2) OB[m * D + c] = f2bf(h);
            x3 = x2; x2 = x1; x1 = x;
            if (PASS2 && sample && (t & 7) == 7) {
                const int b = (int)(m - MP) >> 3;
                float* oc = a.out + O_SCONV + ((size_t)L * DBATCH + b) * 3 * D; float* oh = a.out + O_SH + ((size_t)L * DBATCH + b) * D;
                oh[c] = h; oc[0 * D + c] = x3; oc[1 * D + c] = x2; oc[2 * D + c] = x1;
            }
        }
        if (!sample) {
            if (!PASS2) { *(float2*)(RS + (((size_t)bseq * 128 + chunk) * D + c) * 2) = make_float2(Ap, h); }
            else if (chunk == 127) {
                float* oc = a.out + O_PCONV + ((size_t)L * NBATCH + bseq) * 3 * D; float* oh = a.out + O_PH + ((size_t)L * NBATCH + bseq) * D;
                oh[c] = h; oc[0 * D + c] = x3; oc[1 * D + c] = x2; oc[2 * D + c] = x1;
            }
        }
    }
}

__device__ __forceinline__ void phase_elem_mixa(const Args& a, int L) {
    const bf16_t* P = (const bf16_t*)(a.ws + WS_P); bf16_t* AC = (bf16_t*)(a.ws + WS_ACAT);
    const float* mu = a.in[17] + (size_t)L * SHIFT_W; const float* shift0 = a.in[6] + (size_t)L * DBATCH * SHIFT_W;
    const size_t gt = (size_t)blockIdx.x * NTHREADS + threadIdx.x, gs = (size_t)gridDim.x * NTHREADS;
    for (unsigned i = (unsigned)gt; i < (unsigned)(M * ACAT_K); i += (unsigned)gs) {
        const unsigned m = i / ACAT_K; const int j = (int)(i - m * ACAT_K);
        float o = 0.f;
        if (j < 288) {
            const int ch = 3072 + j;
            const float pc = bf2f(P[(size_t)m * NP + CRW + ch]);
            float pv;
            if (m < (unsigned)MP) pv = (m % SEQ) == 0 ? 0.f : bf2f(P[(size_t)(m - 1) * NP + CRW + ch]);
            else pv = ((m - MP) % DSEQ) == 0 ? shift0[(size_t)((m - MP) / DSEQ) * SHIFT_W + ch] : bf2f(P[(size_t)(m - 1) * NP + CRW + ch]);
            const float ps = pc + mu[ch] * (pv - pc);
            o = j < 64 ? 1.f - 2.f * __builtin_amdgcn_rcpf(__expf(2.f * ps) + 1.f) : (j < 128 ? ps : sigmoidf_(ps));
        }
        AC[i] = f2bf(o);
    }
}
__device__ __forceinline__ void phase_state_copies(const Args& a, int L, int first) {
    const bf16_t* P = (const bf16_t*)(a.ws + WS_P);
    if ((int)blockIdx.x < first) return;
    const size_t gt = (size_t)(blockIdx.x - first) * NTHREADS + threadIdx.x, gs = (size_t)(gridDim.x - first) * NTHREADS;
    const float* ck = a.in[2] + (size_t)L * DBATCH * 128 * 256; const float* cv = a.in[3] + (size_t)L * DBATCH * 128 * 256;
    float* pk = a.out + O_PK + (size_t)L * NBATCH * 128 * 256; float* pv_ = a.out + O_PV + (size_t)L * NBATCH * 128 * 256;
    float* pshift = a.out + O_PSHIFT + (size_t)L * NBATCH * SHIFT_W; float* sk = a.out + O_SK + (size_t)L * DBATCH * 128 * 256; float* sv = a.out + O_SV + (size_t)L * DBATCH * 128 * 256;
    float* sshift = a.out + O_SSHIFT + (size_t)L * DBATCH * SHIFT_W;
    const size_t n_pk = (size_t)NBATCH * 128 * 256, n_sk = (size_t)DBATCH * 128 * 256, n_ps = (size_t)NBATCH * SHIFT_W, n_ss = (size_t)DBATCH * SHIFT_W;
    auto ld4 = [&](const bf16_t* p) -> f32x4 { const u32x2 w = *(const u32x2*)p; return (f32x4){__uint_as_float(w.x << 16), __uint_as_float(w.x & 0xffff0000u), __uint_as_float(w.y << 16), __uint_as_float(w.y & 0xffff0000u)}; };
    for (unsigned i4 = (unsigned)gt; i4 < (unsigned)((n_pk + n_sk + n_ps + n_ss) / 4); i4 += (unsigned)gs) {
        const unsigned i = 4 * i4;
        if (i < n_pk) {
            const int b = (int)(i / (128 * 256)), s = (int)((i / 256) % 128), e = (int)(i % 256);
            const size_t row = (size_t)b * SEQ + (SEQ - 128) + s;
            *(f32x4*)(pk + i) = ld4(P + row * NP + CK + e); *(f32x4*)(pv_ + i) = ld4(P + row * NP + CV + e);
            continue;
        }
        unsigned k = i - (unsigned)n_pk;
        if (k < n_sk) {
            const int b = (int)(k / (128 * 256)), s = (int)((k / 256) % 128), e = (int)(k % 256);
            if (s < 120) { *(f32x4*)(sk + k) = *(const f32x4*)(ck + ((size_t)b * 128 + s + 8) * 256 + e); *(f32x4*)(sv + k) = *(const f32x4*)(cv + ((size_t)b * 128 + s + 8) * 256 + e); }
            else { const size_t row = (size_t)MP + b * DSEQ + (s - 120); *(f32x4*)(sk + k) = ld4(P + row * NP + CK + e); *(f32x4*)(sv + k) = ld4(P + row * NP + CV + e); }
            continue;
        }
        k -= (unsigned)n_sk;
        if (k < n_ps) { const int b = (int)(k / SHIFT_W), ch = (int)(k % SHIFT_W); *(f32x4*)(pshift + k) = ld4(P + ((size_t)b * SEQ + SEQ - 1) * NP + CRW + ch); continue; }
        k -= (unsigned)n_ps;
        { const int b = (int)(k / SHIFT_W), ch = (int)(k % SHIFT_W); *(f32x4*)(sshift + k) = ld4(P + ((size_t)MP + b * DSEQ + DSEQ - 1) * NP + CRW + ch); }
    }
}

#ifndef PROBE_MIXA
#define PROBE_MIXA 0
#endif
__device__ __forceinline__ void phase_mixa_units(const Args& a, int L, LAS unsigned char* lds) {
    const bf16_t* P = (const bf16_t*)(a.ws + WS_P); bf16_t* OA = (bf16_t*)(a.ws + WS_OA);
    const float* sinks = a.in[9] + L * 16; const float* ck = a.in[2] + (size_t)L * DBATCH * 128 * 256; const float* cv = a.in[3] + (size_t)L * DBATCH * 128 * 256;
    constexpr int N_RG1 = MP / 64, N_AP = NBATCH * 64 * 4, N_AS = DBATCH * 4;
    for (int it = blockIdx.x; it < N_RG1; it += gridDim.x) { rglru_unit2<false>(a, L, it, lds); __syncthreads(); }
    if (PROBE_MIXA & 2) for (int it = blockIdx.x; it < N_RG1; it += gridDim.x) { rglru_unit2<false>(a, L, it, lds); __syncthreads(); }
    for (int r = blockIdx.x; r < N_AP; r += gridDim.x) { const int c = r & 3, qb = (r >> 2) & 63, b = r >> 8; attn_unit<false>(P, OA, sinks, ck, cv, b, qb, c, lds); }
    if (PROBE_MIXA & 4) for (int r = blockIdx.x; r < N_AP; r += gridDim.x) { const int c = r & 3, qb = (r >> 2) & 63, b = r >> 8; attn_unit<false>(P, OA, sinks, ck, cv, b, qb, c, lds); }
    for (int r = blockIdx.x; r < N_AS; r += gridDim.x) { const int c = r & 3, b = r >> 2; attn_unit<true>(P, OA, sinks, ck, cv, b, 0, c, lds); }
    if (PROBE_MIXA & 8) for (int r = blockIdx.x; r < N_AS; r += gridDim.x) { const int c = r & 3, b = r >> 2; attn_unit<true>(P, OA, sinks, ck, cv, b, 0, c, lds); }
}

struct EpiLora {
    static constexpr bool PERM = true, AFTER_DRAIN = false;
    bf16_t* WAW; bf16_t* WAA; bf16_t* WAG; const float* w0; const float* a0;
    __device__ __forceinline__ void operator()(const f32x4 (&acc)[2][2][4][2], const pg8::Unit& u, int wr, int wc, int fr, int fq) const {
        const int row0 = u.pm * 256 + wr * 64 + fr, kind = u.pn >> 2, colb = (u.pn & 3) * 256 + wc * 32 + 8 * fq;
        const float* bsrc = kind == 0 ? w0 : a0;
        f32x4 bias[2][2];
#pragma unroll
        for (int bj = 0; bj < 2; ++bj)
#pragma unroll
            for (int n = 0; n < 2; ++n) bias[bj][n] = kind == 2 ? (f32x4){0.f, 0.f, 0.f, 0.f} : *(const f32x4*)(bsrc + colb + bj * 128 + 4 * n);
#pragma unroll
        for (int ai = 0; ai < 2; ++ai)
#pragma unroll
            for (int m = 0; m < 4; ++m) {
                const size_t off = (size_t)(row0 + ai * 128 + m * 16) * D + colb;
#pragma unroll
                for (int bj = 0; bj < 2; ++bj) {
                    f32x4 v0 = acc[ai][bj][m][0] + bias[bj][0], v1 = acc[ai][bj][m][1] + bias[bj][1];
                    if (kind == 0) {
#pragma unroll
                        for (int i = 0; i < 4; ++i) {
                            v0[i] = -__expf(-(fmaxf(-v0[i], 0.f) + __logf(1.f + __expf(-fabsf(v0[i])))) - 0.5f);
                            v1[i] = -__expf(-(fmaxf(-v1[i], 0.f) + __logf(1.f + __expf(-fabsf(v1[i])))) - 0.5f);
                        }
                    } else if (kind == 1) {
#pragma unroll
                        for (int i = 0; i < 4; ++i) { v0[i] = sigmoidf_(v0[i]); v1[i] = sigmoidf_(v1[i]); }
                    }
                    u32x4 w; w.x = pk2bf(v0[0], v0[1]); w.y = pk2bf(v0[2], v0[3]); w.z = pk2bf(v1[0], v1[1]); w.w = pk2bf(v1[2], v1[3]);
                    *(u32x4*)(WAW + (size_t)kind * ((size_t)M * D) + off + bj * 128) = w;
                }
                asm volatile("" ::: "memory");
            }
    }
};

__device__ __forceinline__ void phase_mixc(const Args& a, int L, bf16_t* DST) {
    const int lane = threadIdx.x & 63, wv = threadIdx.x >> 6;
    const bf16_t* P = (const bf16_t*)(a.ws + WS_P); const bf16_t* WAG = (const bf16_t*)(a.ws + WS_WAG); const bf16_t* Y = (const bf16_t*)(a.ws + WS_Y); const float* BD = (const float*)(a.ws + WS_BD);
    bf16_t* OA = (bf16_t*)(a.ws + WS_OA); const bf16_t* OB = (const bf16_t*)(a.ws + WS_OB);
    const float* mu = a.in[17] + (size_t)L * SHIFT_W + 2048; const float* shift0 = a.in[6] + (size_t)L * DBATCH * SHIFT_W + 2048;
    const int c0 = 16 * lane, h = lane >> 2;
    float lw[16], lb[16], muv[16];
#pragma unroll
    for (int i = 0; i < 16; ++i) { lw[i] = a.in[26][L * D + c0 + i]; lb[i] = a.in[27][L * D + c0 + i]; muv[i] = mu[c0 + i]; }
    for (int m = blockIdx.x * NWAVES + wv; m < M; m += gridDim.x * NWAVES) {
        float y[16];
        { u32x4 yv[2]; yv[0] = *(const u32x4*)(Y + (size_t)m * D + c0); yv[1] = *(const u32x4*)(Y + (size_t)m * D + c0 + 8);
#pragma unroll
          for (int i = 0; i < 16; ++i) y[i] = __uint_as_float((i & 1) ? (yv[i >> 3][(i >> 1) & 3] & 0xffff0000u) : (yv[i >> 3][(i >> 1) & 3] << 16)); }
        float s = 0.f;
#pragma unroll
        for (int i = 0; i < 16; ++i) s += y[i];
        s += __shfl_xor(s, 1); s += __shfl_xor(s, 2);
        const float mean = s * (1.f / 64.f);
        float q = 0.f;
#pragma unroll
        for (int i = 0; i < 16; ++i) { y[i] -= mean; q += y[i] * y[i]; }
        q += __shfl_xor(q, 1); q += __shfl_xor(q, 2);
        const float rstd = rsqrtf(q * (1.f / 64.f) + GN_EPS);
        const float bd = BD[(size_t)m * 16 + h];
        const bool first = m < MP ? (m % SEQ) == 0 : ((m - MP) % DSEQ) == 0;
        const bf16_t* pr = P + (size_t)m * NP + CRW + 2048 + c0;
#define BFX(v, i) __uint_as_float((((i) & 1) ? ((v)[(i) >> 3][((i) >> 1) & 3] & 0xffff0000u) : ((v)[(i) >> 3][((i) >> 1) & 3] << 16)))
        u32x4 pcv[2], ppv[2], gv[2], gav[2], gbv[2], gcv[2], oav[2], obv[2];
        pcv[0] = *(const u32x4*)pr; pcv[1] = *(const u32x4*)(pr + 8);
        ppv[0] = pcv[0]; ppv[1] = pcv[1];
        if (!first) { ppv[0] = *(const u32x4*)(pr - NP); ppv[1] = *(const u32x4*)(pr - NP + 8); }
        gv[0] = *(const u32x4*)(WAG + (size_t)m * D + c0); gv[1] = *(const u32x4*)(WAG + (size_t)m * D + c0 + 8);
        const bf16_t* pg = P + (size_t)m * NP + CG + c0;
        gav[0] = *(const u32x4*)pg; gav[1] = *(const u32x4*)(pg + 8);
        gbv[0] = *(const u32x4*)(pg + 1024); gbv[1] = *(const u32x4*)(pg + 1024 + 8);
        gcv[0] = *(const u32x4*)(pg + 2048); gcv[1] = *(const u32x4*)(pg + 2048 + 8);
        oav[0] = *(const u32x4*)(OA + (size_t)m * D + c0); oav[1] = *(const u32x4*)(OA + (size_t)m * D + c0 + 8);
        obv[0] = *(const u32x4*)(OB + (size_t)m * D + c0); obv[1] = *(const u32x4*)(OB + (size_t)m * D + c0 + 8);
        float o[16];
#pragma unroll
        for (int i = 0; i < 16; ++i) {
            const float pc = BFX(pcv, i);
            float pv;
            if (first) pv = m < MP ? 0.f : shift0[(size_t)((m - MP) / DSEQ) * SHIFT_W + c0 + i];
            else pv = BFX(ppv, i);
            const float vv = pc + muv[i] * (pv - pc);
            const float yn = y[i] * rstd * lw[i] + lb[i];
            const float oc = (yn + bd * vv) * BFX(gv, i);
            o[i] = BFX(gav, i) * BFX(oav, i) + BFX(gbv, i) * BFX(obv, i) + BFX(gcv, i) * oc;
        }
        u32x4 w0, w1;
        w0.x = pk2bf(o[0], o[1]); w0.y = pk2bf(o[2], o[3]); w0.z = pk2bf(o[4], o[5]); w0.w = pk2bf(o[6], o[7]);
        w1.x = pk2bf(o[8], o[9]); w1.y = pk2bf(o[10], o[11]); w1.z = pk2bf(o[12], o[13]); w1.w = pk2bf(o[14], o[15]);
        *(u32x4*)(DST + (size_t)m * D + c0) = w0; *(u32x4*)(DST + (size_t)m * D + c0 + 8) = w1;
    }
}

constexpr int CH_OFF_AA = 0, CH_OFF_RA = 2048, CH_OFF_MC = 4096, CH_OFF_TL = 5120  , CH_OFF_BT = 5632, CH_OFF_KT = 7808, CH_OFF_VT = 9984, CH_OFF_GM = 12160, CH_SLOT = 12416;
constexpr int CH_TP = 136;
__device__ __forceinline__ float row_prefix16(float x) {
    x += __builtin_bit_cast(float, __builtin_amdgcn_update_dpp(0, __builtin_bit_cast(int, x), 0x111, 0xF, 0xF, true));
    x += __builtin_bit_cast(float, __builtin_amdgcn_update_dpp(0, __builtin_bit_cast(int, x), 0x112, 0xF, 0xF, true));
    x += __builtin_bit_cast(float, __builtin_amdgcn_update_dpp(0, __builtin_bit_cast(int, x), 0x114, 0xF, 0xF, true));
    x += __builtin_bit_cast(float, __builtin_amdgcn_update_dpp(0, __builtin_bit_cast(int, x), 0x118, 0xF, 0xF, true));
    return x;
}
__device__ __forceinline__ f32x4 prod16(const f32x4 xt, const f32x4 y) {
    f32x4 z = (f32x4){0.f, 0.f, 0.f, 0.f};
#pragma unroll
    for (int r = 0; r < 4; ++r) z = __builtin_amdgcn_mfma_f32_16x16x4f32(xt[r], y[r], z, 0, 0, 0);
    return z;
}
__device__ __forceinline__ f32x4 gram(const bf16x8_t (&x)[2], const bf16x8_t (&y)[2]) {
    f32x4 z = (f32x4){0.f, 0.f, 0.f, 0.f};
    z = __builtin_amdgcn_mfma_f32_16x16x32_bf16(x[0], y[0], z, 0, 0, 0);
    z = __builtin_amdgcn_mfma_f32_16x16x32_bf16(x[1], y[1], z, 0, 0, 0);
    return z;
}

struct ChunkRaw { u32x2 cr[4], ck[4], cv[4], a[4], x[4]; };
constexpr int CH_PAR_OFF = 8 * CH_SLOT;
constexpr int CH_PAR_BYTES = 6 * 64 * 4;
__device__ __forceinline__ void stage_head_params(const Args& a, int L, int h, LAS unsigned char* par, int lane) {
    LAS float* p = (LAS float*)par; const int c = 64 * h + lane;
    p[lane] = a.in[17][(size_t)L * SHIFT_W + c]; p[64 + lane] = a.in[17][(size_t)L * SHIFT_W + 1024 + c]; p[128 + lane] = a.in[17][(size_t)L * SHIFT_W + 2048 + c];
    p[192 + lane] = a.in[23][L * D + c]; p[256 + lane] = a.in[24][L * D + c]; p[320 + lane] = a.in[25][L * D + c];
}
__device__ __forceinline__ void chunk_load(const Args& a, size_t m0, int h, int ntok, int lane, ChunkRaw& R) {
    asm volatile("" : "+v"(lane));
    const int i16 = lane & 15, qp = lane >> 4;
    const bf16_t* P = (const bf16_t*)(a.ws + WS_P); const bf16_t* WAW = (const bf16_t*)(a.ws + WS_WAW); const bf16_t* WAA = (const bf16_t*)(a.ws + WS_WAA);
    const size_t m = m0 + (i16 < ntok ? i16 : 0);
#pragma unroll
    for (int r = 0; r < 4; ++r) {
        const int c = 64 * h + 16 * r + 4 * qp;
        const bf16_t* pr = P + m * NP + CRW + c;
        R.cr[r] = *(const u32x2*)pr; R.ck[r] = *(const u32x2*)(pr + 1024); R.cv[r] = *(const u32x2*)(pr + 2048);
        R.x[r] = *(const u32x2*)(WAW + m * D + c);
        R.a[r] = *(const u32x2*)(WAA + m * D + c);
    }
}
__device__ __forceinline__ unsigned dpp_prev_row(unsigned old, unsigned src) { return (unsigned)__builtin_amdgcn_update_dpp((int)old, (int)src, 0x111, 0xF, 0xF, false); }
template <class PF> __device__ __forceinline__ void chunk_compute(const Args& a, const ChunkRaw& R, size_t m0, int h, int ntok, bool seq_start, const float* sh0, const LAS unsigned char* par_, LAS unsigned char* slot, int lane, PF pf) {
    asm volatile("" : "+v"(lane));
    const int i16 = lane & 15, qp = lane >> 4;
    float* BD = (float*)(a.ws + WS_BD);
    const LAS float* par = (const LAS float*)par_;
    const bool valid = i16 < ntok;
    const size_t m = m0 + (valid ? i16 : 0);
    u32x2 p0r[4], p0k[4], p0v[4];
    {
        const bf16_t* P = (const bf16_t*)(a.ws + WS_P);
#pragma unroll
        for (int r = 0; r < 4; ++r) {
            const int c = 64 * h + 16 * r + 4 * qp;
            if (!seq_start) { const bf16_t* pp = P + (m0 - 1) * NP + CRW + c; p0r[r] = *(const u32x2*)pp; p0k[r] = *(const u32x2*)(pp + 1024); p0v[r] = *(const u32x2*)(pp + 2048); }
            else if (sh0) { const f32x4 fr_ = *(const f32x4*)(sh0 + c), fk_ = *(const f32x4*)(sh0 + 1024 + c), fv_ = *(const f32x4*)(sh0 + 2048 + c);
                p0r[r] = pk4(fr_[0], fr_[1], fr_[2], fr_[3]); p0k[r] = pk4(fk_[0], fk_[1], fk_[2], fk_[3]); p0v[r] = pk4(fv_[0], fv_[1], fv_[2], fv_[3]); }
            else { p0r[r] = (u32x2){0u, 0u}; p0k[r] = p0r[r]; p0v[r] = p0r[r]; }
        }
    }
    float abu[16], bbu[16];
    u32x2 pa[4], pb[4], pkk[4], prr[4];
    float ssq = 0.f, bdp = 0.f;
#pragma unroll
    for (int r = 0; r < 4; ++r) {
        const int cb = 16 * r + 4 * qp, c = 64 * h + cb;
        const u32x2 cr = R.cr[r], ck_ = R.ck[r], cv_ = R.cv[r], a4 = R.a[r];
        u32x2 pr_, pk_, pv_;
        pr_.x = dpp_prev_row(p0r[r].x, cr.x); pr_.y = dpp_prev_row(p0r[r].y, cr.y); pk_.x = dpp_prev_row(p0k[r].x, ck_.x); pk_.y = dpp_prev_row(p0k[r].y, ck_.y);
        pv_.x = dpp_prev_row(p0v[r].x, cv_.x); pv_.y = dpp_prev_row(p0v[r].y, cv_.y);
        const u32x2 x4 = R.x[r];
        const f32x4 mur = *(const LAS f32x4*)(par + cb), muk = *(const LAS f32x4*)(par + 64 + cb), muv = *(const LAS f32x4*)(par + 128 + cb);
        const f32x4 kkc = *(const LAS f32x4*)(par + 192 + cb), kac = *(const LAS f32x4*)(par + 256 + cb), rkc = *(const LAS f32x4*)(par + 320 + cb);
        float vv[4], kb[4], rb[4];
#pragma unroll
        for (int i = 0; i < 4; ++i) {
            const unsigned wr_ = i < 2 ? cr.x : cr.y, wk_ = i < 2 ? ck_.x : ck_.y, wv_ = i < 2 ? cv_.x : cv_.y, wa_ = i < 2 ? a4.x : a4.y, wx_ = i < 2 ? x4.x : x4.y;
            const unsigned qr_ = i < 2 ? pr_.x : pr_.y, qk_ = i < 2 ? pk_.x : pk_.y, qv_ = i < 2 ? pv_.x : pv_.y;
            const float c_r = __uint_as_float((i & 1) ? (wr_ & 0xffff0000u) : (wr_ << 16)), c_k = __uint_as_float((i & 1) ? (wk_ & 0xffff0000u) : (wk_ << 16)),
                        c_v = __uint_as_float((i & 1) ? (wv_ & 0xffff0000u) : (wv_ << 16)), a_ = __uint_as_float((i & 1) ? (wa_ & 0xffff0000u) : (wa_ << 16));
            const float p_r = __uint_as_float((i & 1) ? (qr_ & 0xffff0000u) : (qr_ << 16)), p_k = __uint_as_float((i & 1) ? (qk_ & 0xffff0000u) : (qk_ << 16)),
                  p_v = __uint_as_float((i & 1) ? (qv_ & 0xffff0000u) : (qv_ << 16));
            float r_ = c_r + mur[i] * (p_r - c_r), kx = c_k + muk[i] * (p_k - c_k), v_ = c_v + muv[i] * (p_v - c_v);
            float lw_ = __uint_as_float((i & 1) ? (wx_ & 0xffff0000u) : (wx_ << 16));
            if (!valid) { r_ = 0.f; kx = 0.f; v_ = 0.f; lw_ = 0.f; }
            const float kkr = kx * kkc[i];
            const float k2_ = kx * (1.f + (a_ - 1.f) * kac[i]);
            ssq += kkr * kkr; bdp += r_ * k2_ * rkc[i];
            const float g = row_prefix16(lw_);
            const float eg = __expf(g), egx = __expf(g - lw_), eng = __expf(-g);
            const int e = 4 * r + i;
            abu[e] = -kkr * egx; bbu[e] = kkr * a_ * eng; kb[i] = k2_ * eng; rb[i] = r_ * eg; vv[i] = v_;
            if (i16 == 15) *(LAS float*)(slot + CH_OFF_GM + 4 * (cb + i)) = eg;
        }
        const int off = i16 * CH_TP + cb * 2;
        pkk[r] = pk4(kb[0], kb[1], kb[2], kb[3]); prr[r] = pk4(rb[0], rb[1], rb[2], rb[3]);
        *(LAS u32x2*)(slot + CH_OFF_VT + off) = pk4(vv[0], vv[1], vv[2], vv[3]);
        *(LAS u32x2*)(slot + CH_OFF_KT + off) = pkk[r];
        asm volatile("" : "+v"(ssq), "+v"(bdp));
        __builtin_amdgcn_sched_barrier(0);
    }
    __builtin_amdgcn_sched_barrier(0);
    pf();
    __builtin_amdgcn_sched_barrier(0);
    ssq += __shfl_xor(ssq, 16); ssq += __shfl_xor(ssq, 32);
    bdp += __shfl_xor(bdp, 16); bdp += __shfl_xor(bdp, 32);
    if (valid && qp == 0) BD[m * 16 + h] = bdp;
    const float inrm = __builtin_amdgcn_rcpf(fmaxf(__builtin_amdgcn_sqrtf(ssq), 1e-12f));
#pragma unroll
    for (int r = 0; r < 4; ++r) {
        pa[r] = pk4(abu[4 * r] * inrm, abu[4 * r + 1] * inrm, abu[4 * r + 2] * inrm, abu[4 * r + 3] * inrm);
        pb[r] = pk4(bbu[4 * r] * inrm, bbu[4 * r + 1] * inrm, bbu[4 * r + 2] * inrm, bbu[4 * r + 3] * inrm);
        const int off = i16 * CH_TP + (16 * r + 4 * qp) * 2;
        *(LAS u32x2*)(slot + CH_OFF_AA + off) = pa[r];
        *(LAS u32x2*)(slot + CH_OFF_BT + off) = pb[r];
    }
    __builtin_amdgcn_sched_barrier(0);
    bf16x8_t fa[2], fb[2], fk[2], fr[2];
#pragma unroll
    for (int ks = 0; ks < 2; ++ks) { fa[ks] = mk_frag(pa[2 * ks], pa[2 * ks + 1]); fb[ks] = mk_frag(pb[2 * ks], pb[2 * ks + 1]); fk[ks] = mk_frag(pkk[2 * ks], pkk[2 * ks + 1]); fr[ks] = mk_frag(prr[2 * ks], prr[2 * ks + 1]); }
    f32x4 Lc = gram(fa, fb), Nc = gram(fb, fa), Lak = gram(fa, fk), MrbT = gram(fb, fr), MrkT = gram(fk, fr);
#pragma unroll
    for (int r = 0; r < 4; ++r) {
        const int row = 4 * qp + r;
        Lc[r] = row > i16 ? Lc[r] : 0.f;
        Lak[r] = row > i16 ? Lak[r] : 0.f;
        Nc[r] = row < i16 ? Nc[r] : 0.f;
        MrbT[r] = row <= i16 ? MrbT[r] : 0.f;
        MrkT[r] = row <= i16 ? MrkT[r] : 0.f;
    }
    __builtin_amdgcn_sched_barrier(0);
    f32x4 eye;
#pragma unroll
    for (int r = 0; r < 4; ++r) eye[r] = (4 * qp + r == i16) ? 1.f : 0.f;
    const f32x4 L2 = prod16(Nc, Lc), N2 = prod16(Lc, Nc);
    const f32x4 L4 = prod16(N2, L2), N4 = prod16(L2, N2);
    const f32x4 N8 = prod16(L4, N4);
    const f32x4 Q1 = prod16(Lc + eye, N2 + eye), Q1T = prod16(N2 + eye, Lc + eye), Q2 = prod16(L4 + eye, N8 + eye);
    const f32x4 TT = prod16(Q1T, Q2);
    const f32x4 TLk = prod16(Lak, TT);
    __builtin_amdgcn_sched_barrier(0);
    LDSW();
    const bf16x8_t ttf = mk_frag(pk4(TT[0], TT[1], TT[2], TT[3]), (u32x2){0u, 0u});
    f32x4 at[4];
#pragma unroll
    for (int kt = 0; kt < 4; ++kt) {
        const u32x2 ac = tr_read4(slot + CH_OFF_AA + (4 * qp + (i16 >> 2)) * CH_TP + (16 * kt + 4 * (i16 & 3)) * 2);
        at[kt] = __builtin_amdgcn_mfma_f32_16x16x32_bf16(mk_frag(ac, (u32x2){0u, 0u}), ttf, (f32x4){0.f, 0.f, 0.f, 0.f}, 0, 0, 0);
    }
    LDSW();
#pragma unroll
    for (int ks = 0; ks < 2; ++ks) {
        const u32x2 lo = pk4(at[2 * ks][0], at[2 * ks][1], at[2 * ks][2], at[2 * ks][3]), hi = pk4(at[2 * ks + 1][0], at[2 * ks + 1][1], at[2 * ks + 1][2], at[2 * ks + 1][3]);
        *(LAS u32x4*)(slot + CH_OFF_AA + ks * 1024 + lane * 16) = (u32x4){lo.x, lo.y, hi.x, hi.y};
        *(LAS u32x4*)(slot + CH_OFF_RA + ks * 1024 + lane * 16) = __builtin_bit_cast(u32x4, fr[ks]);
    }
    {
        const u32x2 mb = pk4(MrbT[0], MrbT[1], MrbT[2], MrbT[3]), mk = pk4(MrkT[0], MrkT[1], MrkT[2], MrkT[3]), tl = pk4(TLk[0], TLk[1], TLk[2], TLk[3]);
        *(LAS u32x4*)(slot + CH_OFF_MC + lane * 16) = (u32x4){mb.x, mb.y, mk.x, mk.y};
        *(LAS u32x2*)(slot + CH_OFF_TL + lane * 8) = tl;
    }
}

struct ChainFrag { u32x4 aa0, aa1, ra0, ra1, mc, tl; u32x2 vq4, b4[4], k4[4]; f32x4 gm[4]; };
__device__ __forceinline__ void chain_fetch(LAS unsigned char* slot, int vq, int lane, ChainFrag& F) {
    const int i16 = lane & 15, qp = lane >> 4;
    const int troff = (4 * qp + (i16 >> 2)) * CH_TP + 8 * (i16 & 3);
    { const u32x2 t2 = *(const LAS u32x2*)(slot + CH_OFF_TL + lane * 8); F.tl = (u32x4){t2.x, t2.y, 0u, 0u}; }
    F.vq4 = tr_read4(slot + CH_OFF_VT + troff + 32 * vq);
    F.aa0 = *(const LAS u32x4*)(slot + CH_OFF_AA + lane * 16); F.aa1 = *(const LAS u32x4*)(slot + CH_OFF_AA + 1024 + lane * 16);
    F.ra0 = *(const LAS u32x4*)(slot + CH_OFF_RA + lane * 16); F.ra1 = *(const LAS u32x4*)(slot + CH_OFF_RA + 1024 + lane * 16);
    F.mc = *(const LAS u32x4*)(slot + CH_OFF_MC + lane * 16);
#pragma unroll
    for (int kt = 0; kt < 4; ++kt) {
        F.b4[kt] = tr_read4(slot + CH_OFF_BT + troff + 32 * kt); F.k4[kt] = tr_read4(slot + CH_OFF_KT + troff + 32 * kt);
        F.gm[kt] = *(const LAS f32x4*)(slot + CH_OFF_GM + 4 * (16 * kt + 4 * qp));
    }
}
__device__ __forceinline__ f32x4 chain_math(const ChainFrag& F, f32x4 (&ST)[4]) {
    const f32x4 z4 = (f32x4){0.f, 0.f, 0.f, 0.f};
    const f32x4 tlv = __builtin_amdgcn_mfma_f32_16x16x32_bf16(__builtin_bit_cast(bf16x8_t, F.tl), mk_frag(F.vq4, F.vq4), z4, 0, 0, 0);
    bf16x8_t sb[2];
#pragma unroll
    for (int ks = 0; ks < 2; ++ks) sb[ks] = mk_frag(pk4(ST[2 * ks][0], ST[2 * ks][1], ST[2 * ks][2], ST[2 * ks][3]), pk4(ST[2 * ks + 1][0], ST[2 * ks + 1][1], ST[2 * ks + 1][2], ST[2 * ks + 1][3]));
    const f32x4 u1 = __builtin_amdgcn_mfma_f32_16x16x32_bf16(__builtin_bit_cast(bf16x8_t, F.aa0), sb[0], z4, 0, 0, 0);
    const f32x4 u2 = __builtin_amdgcn_mfma_f32_16x16x32_bf16(__builtin_bit_cast(bf16x8_t, F.aa1), sb[1], tlv, 0, 0, 0);
    f32x4 Y = __builtin_amdgcn_mfma_f32_16x16x32_bf16(__builtin_bit_cast(bf16x8_t, F.ra0), sb[0], z4, 0, 0, 0);
    const f32x4 y2 = __builtin_amdgcn_mfma_f32_16x16x32_bf16(__builtin_bit_cast(bf16x8_t, F.ra1), sb[1], z4, 0, 0, 0);
    const f32x4 U = u1 + u2;
    const bf16x8_t uv = mk_frag(pk4(U[0], U[1], U[2], U[3]), F.vq4);
#pragma unroll
    for (int kt = 0; kt < 4; ++kt) {
        ST[kt] = __builtin_amdgcn_mfma_f32_16x16x32_bf16(mk_frag(F.b4[kt], F.k4[kt]), uv, ST[kt], 0, 0, 0);
        ST[kt] = ST[kt] * F.gm[kt];
    }
    Y = __builtin_amdgcn_mfma_f32_16x16x32_bf16(__builtin_bit_cast(bf16x8_t, F.mc), uv, Y, 0, 0, 0);
    return Y + y2;
}
struct ChainFrag2 { u32x4 aa0, aa1, ra0, ra1, mc, tl; u32x2 va, vb, b4[4], k4[4]; f32x4 gm[4]; };
__device__ __forceinline__ void chain_fetch2(LAS unsigned char* slot, int vq0, int lane, ChainFrag2& F) {
    const int i16 = lane & 15, qp = lane >> 4;
    const int troff = (4 * qp + (i16 >> 2)) * CH_TP + 8 * (i16 & 3);
    { const u32x2 t2 = *(const LAS u32x2*)(slot + CH_OFF_TL + lane * 8); F.tl = (u32x4){t2.x, t2.y, 0u, 0u}; }
    F.va = tr_read4(slot + CH_OFF_VT + troff + 32 * vq0); F.vb = tr_read4(slot + CH_OFF_VT + troff + 32 * (vq0 + 1));
    F.aa0 = *(const LAS u32x4*)(slot + CH_OFF_AA + lane * 16); F.aa1 = *(const LAS u32x4*)(slot + CH_OFF_AA + 1024 + lane * 16);
    F.ra0 = *(const LAS u32x4*)(slot + CH_OFF_RA + lane * 16); F.ra1 = *(const LAS u32x4*)(slot + CH_OFF_RA + 1024 + lane * 16);
    F.mc = *(const LAS u32x4*)(slot + CH_OFF_MC + lane * 16);
#pragma unroll
    for (int kt = 0; kt < 4; ++kt) {
        F.b4[kt] = tr_read4(slot + CH_OFF_BT + troff + 32 * kt); F.k4[kt] = tr_read4(slot + CH_OFF_KT + troff + 32 * kt);
        F.gm[kt] = *(const LAS f32x4*)(slot + CH_OFF_GM + 4 * (16 * kt + 4 * qp));
    }
}
__device__ __forceinline__ void chain_math2(const ChainFrag2& F, f32x4 (&SA)[4], f32x4 (&SB)[4], f32x4& YA, f32x4& YB) {
    const f32x4 z4 = (f32x4){0.f, 0.f, 0.f, 0.f};
    const bf16x8_t tl = __builtin_bit_cast(bf16x8_t, F.tl), aa0 = __builtin_bit_cast(bf16x8_t, F.aa0), aa1 = __builtin_bit_cast(bf16x8_t, F.aa1),
                   ra0 = __builtin_bit_cast(bf16x8_t, F.ra0), ra1 = __builtin_bit_cast(bf16x8_t, F.ra1), mc = __builtin_bit_cast(bf16x8_t, F.mc);
    const f32x4 tlva = __builtin_amdgcn_mfma_f32_16x16x32_bf16(tl, mk_frag(F.va, F.va), z4, 0, 0, 0);
    const f32x4 tlvb = __builtin_amdgcn_mfma_f32_16x16x32_bf16(tl, mk_frag(F.vb, F.vb), z4, 0, 0, 0);
    bf16x8_t sa[2], sb[2];
#pragma unroll
    for (int ks = 0; ks < 2; ++ks) {
        sa[ks] = mk_frag(pk4(SA[2 * ks][0], SA[2 * ks][1], SA[2 * ks][2], SA[2 * ks][3]), pk4(SA[2 * ks + 1][0], SA[2 * ks + 1][1], SA[2 * ks + 1][2], SA[2 * ks + 1][3]));
        sb[ks] = mk_frag(pk4(SB[2 * ks][0], SB[2 * ks][1], SB[2 * ks][2], SB[2 * ks][3]), pk4(SB[2 * ks + 1][0], SB[2 * ks + 1][1], SB[2 * ks + 1][2], SB[2 * ks + 1][3]));
    }
    const f32x4 ua1 = __builtin_amdgcn_mfma_f32_16x16x32_bf16(aa0, sa[0], z4, 0, 0, 0);
    const f32x4 ub1 = __builtin_amdgcn_mfma_f32_16x16x32_bf16(aa0, sb[0], z4, 0, 0, 0);
    const f32x4 ua2 = __builtin_amdgcn_mfma_f32_16x16x32_bf16(aa1, sa[1], tlva, 0, 0, 0);
    const f32x4 ub2 = __builtin_amdgcn_mfma_f32_16x16x32_bf16(aa1, sb[1], tlvb, 0, 0, 0);
    f32x4 ya = __builtin_amdgcn_mfma_f32_16x16x32_bf16(ra0, sa[0], z4, 0, 0, 0);
    f32x4 yb = __builtin_amdgcn_mfma_f32_16x16x32_bf16(ra0, sb[0], z4, 0, 0, 0);
    const f32x4 ya2 = __builtin_amdgcn_mfma_f32_16x16x32_bf16(ra1, sa[1], z4, 0, 0, 0);
    const f32x4 yb2 = __builtin_amdgcn_mfma_f32_16x16x32_bf16(ra1, sb[1], z4, 0, 0, 0);
    const f32x4 UA = ua1 + ua2, UB = ub1 + ub2;
    const bf16x8_t uva = mk_frag(pk4(UA[0], UA[1], UA[2], UA[3]), F.va), uvb = mk_frag(pk4(UB[0], UB[1], UB[2], UB[3]), F.vb);
#pragma unroll
    for (int kt = 0; kt < 4; ++kt) {
        const bf16x8_t bk = mk_frag(F.b4[kt], F.k4[kt]);
        SA[kt] = __builtin_amdgcn_mfma_f32_16x16x32_bf16(bk, uva, SA[kt], 0, 0, 0);
        SB[kt] = __builtin_amdgcn_mfma_f32_16x16x32_bf16(bk, uvb, SB[kt], 0, 0, 0);
    }
#pragma unroll
    for (int kt = 0; kt < 4; ++kt) { SA[kt] = SA[kt] * F.gm[kt]; SB[kt] = SB[kt] * F.gm[kt]; }
    ya = __builtin_amdgcn_mfma_f32_16x16x32_bf16(mc, uva, ya, 0, 0, 0);
    yb = __builtin_amdgcn_mfma_f32_16x16x32_bf16(mc, uvb, yb, 0, 0, 0);
    YA = ya + ya2; YB = yb + yb2;
}
__device__ __forceinline__ f32x4 chain_step(LAS unsigned char* slot, f32x4 (&ST)[4], int vq, int lane) { ChainFrag F; chain_fetch(slot, vq, lane, F); return chain_math(F, ST); }

constexpr int N_CH_P = MP / 16 * 16, N_CH_S = DBATCH * 16, N_CH = N_CH_P + N_CH_S;
static_assert(WS_CB + (size_t)N_CH * CH_SLOT <= (size_t)861000000, "chunk buffer fits the workspace");
constexpr int CH_VEC = CH_SLOT / 16;
__device__ __forceinline__ void slot_to_global(const LAS unsigned char* slot, unsigned char* g, int lane) {
#pragma unroll
    for (int i = 0; i < 13; ++i) { const int v = i * 64 + lane; if (v < CH_VEC) *(u32x4*)(g + (size_t)v * 16) = *(const LAS u32x4*)(slot + v * 16); }
}
struct SlotRegs { u32x4 v[13]; };
__device__ __forceinline__ void slot_load(const unsigned char* g, int lane, SlotRegs& S) {
    asm volatile("" : "+v"(lane));
#pragma unroll
    for (int i = 0; i < 13; ++i) { const int v = i * 64 + lane; S.v[i] = *(const u32x4*)(g + (size_t)(v < CH_VEC ? v : 0) * 16); }
}
__device__ __forceinline__ void slot_store(LAS unsigned char* slot, int lane, const SlotRegs& S) {
    asm volatile("" : "+v"(lane));
#pragma unroll
    for (int i = 0; i < 13; ++i) { const int v = i * 64 + lane; if (v < CH_VEC) *(LAS u32x4*)(slot + v * 16) = S.v[i]; }
}
__device__ __forceinline__ void phase_c1(const Args& a, int L, LAS unsigned char* lds) {
    const int tid = threadIdx.x, lane = tid & 63, wv = __builtin_amdgcn_readfirstlane(tid >> 6);
    LAS unsigned char* slot = lds + wv * CH_SLOT; LAS unsigned char* par = lds + CH_PAR_OFF + wv * CH_PAR_BYTES;
    unsigned char* CB = a.ws + WS_CB;
    rglru_prefix(a);
    const int stride = gridDim.x * NWAVES;
    auto item = [&](int ci, size_t& m0, int& ntok, bool& ss, const float*& sh0) {
        sh0 = nullptr;
        if (ci < N_CH_P) { const int chunk = ci >> 4; m0 = (size_t)chunk * 16; ntok = 16; ss = (chunk & (SEQ / 16 - 1)) == 0; }
        else { const int b = (ci - N_CH_P) >> 4; m0 = (size_t)MP + (size_t)b * DSEQ; ntok = DSEQ; ss = true; sh0 = a.in[6] + ((size_t)L * DBATCH + b) * SHIFT_W; }
    };
    auto fetch = [&](int ci, ChunkRaw& R) { size_t m0; int ntok; bool ss; const float* sh0; item(ci, m0, ntok, ss, sh0); chunk_load(a, m0, ci & 15, ntok, lane, R); };
    int ci = blockIdx.x * NWAVES + wv;
    ChunkRaw R;
    if (ci < N_CH) fetch(ci, R);
    for (; ci < N_CH; ci += stride) {
        const int h = ci & 15; size_t m0; int ntok; bool ss; const float* sh0; item(ci, m0, ntok, ss, sh0);
        stage_head_params(a, L, h, par, lane);
        LDSW();
        chunk_compute(a, R, m0, h, ntok, ss, sh0, par, slot, lane, [&]() { if (ci + stride < N_CH) fetch(ci + stride, R); });
        LDSW();
        const size_t sid = ci < N_CH_P ? ((size_t)((ci >> 4) >> 9) * 16 + h) * (SEQ / 16) + ((ci >> 4) & (SEQ / 16 - 1)) : (size_t)ci;
        slot_to_global(slot, CB + sid * CH_SLOT, lane);
        LDSW();
    }
}

#define WG_BAR() do { asm volatile("s_waitcnt lgkmcnt(0)" ::: "memory"); __builtin_amdgcn_s_barrier(); asm volatile("" ::: "memory"); } while (0)
template <int DRY> __device__ __forceinline__ void wkv_prompt_chain(const Args& a, int L, int b, int h, LAS unsigned char* lds) {
    const int tid = threadIdx.x, lane = tid & 63, wv = __builtin_amdgcn_readfirstlane(tid >> 6), i16 = lane & 15, qp = lane >> 4;
    bf16_t* Y = (bf16_t*)(a.ws + WS_Y);
    const unsigned char* CB = a.ws + WS_CB;
    constexpr int NR = SEQ / 64;
    const size_t ci0 = ((size_t)b * 16 + h) * (SEQ / 16);
    if (wv >= 2) {
        const int lw = wv - 2;
        constexpr int GV = 4 * CH_SLOT / 16;
        struct GrpRegs { u32x4 v[9]; };
        auto grp_load = [&](const unsigned char* gsrc, GrpRegs& S) {
#pragma unroll
            for (int i = 0; i < 9; ++i) { const int q = lw * 64 + lane + 384 * i; S.v[i] = *(const u32x4*)(gsrc + (size_t)(q < GV ? q : 0) * 16); }
        };
        auto grp_store = [&](LAS unsigned char* ldst, const GrpRegs& S) {
#pragma unroll
            for (int i = 0; i < 9; ++i) { const int q = lw * 64 + lane + 384 * i; if (q < GV) *(LAS u32x4*)(ldst + q * 16) = S.v[i]; }
        };
        GrpRegs S0, S1, S2, S3;
#define CB_GROUP(k) (CB + (ci0 + (size_t)(4 * (k))) * CH_SLOT)
        grp_load(CB_GROUP(0), S0);
        grp_store(lds, S0);
        grp_load(CB_GROUP(1), S1); grp_load(CB_GROUP(2), S2); grp_load(CB_GROUP(3), S3); grp_load(CB_GROUP(4), S0);
        WG_BAR();
        for (int g = 0; g < NR; g += 4) {
#define LROUND(r, SET) do { __builtin_amdgcn_s_sleep(16);   if (DRY != 2) if ((r) + 1 < NR) grp_store(lds + (((r) + 1) & 1) * 4 * CH_SLOT, SET); if (DRY != 2) if ((r) + 5 < NR) grp_load(CB_GROUP((r) + 5), SET); WG_BAR(); } while (0)
            LROUND(g, S1); LROUND(g + 1, S2); LROUND(g + 2, S3); LROUND(g + 3, S0);
#undef LROUND
        }
#undef CB_GROUP
    } else if (wv < 2) {
        f32x4 SA[4], SB[4];
#pragma unroll
        for (int kt = 0; kt < 4; ++kt) { SA[kt] = (f32x4){0.f, 0.f, 0.f, 0.f}; SB[kt] = SA[kt]; }
        WG_BAR();
        bf16_t* yrow = Y + ((size_t)b * SEQ) * D + 64 * h + 32 * wv;
        for (int g = 0; g < NR; ++g) {
            LAS unsigned char* gs = lds + (g & 1) * 4 * CH_SLOT;
            ChainFrag2 FA, FB;
            f32x4 ya[4], yb[4];
#define SB0() __builtin_amdgcn_sched_barrier(0)
            if (DRY == 3) { WG_BAR(); continue; }
            chain_fetch2(gs, 2 * wv, lane, FA);
            chain_fetch2(gs + CH_SLOT, 2 * wv, lane, FB); SB0();
            chain_math2(FA, SA, SB, ya[0], yb[0]); SB0();
            chain_fetch2(gs + 2 * CH_SLOT, 2 * wv, lane, FA); SB0();
            chain_math2(FB, SA, SB, ya[1], yb[1]); SB0();
            chain_fetch2(gs + 3 * CH_SLOT, 2 * wv, lane, FB); SB0();
            chain_math2(FA, SA, SB, ya[2], yb[2]); SB0();
            chain_math2(FB, SA, SB, ya[3], yb[3]); SB0();
#undef SB0
            {
                LAS unsigned char* yt = lds + CH_PAR_OFF + wv * 4608;
#pragma unroll
                for (int j = 0; j < 4; ++j)
#pragma unroll
                    for (int r = 0; r < 4; ++r) {
                        *(LAS unsigned short*)(yt + (16 * j + 4 * qp + r) * 72 + 2 * i16) = f2bf(ya[j][r]);
                        *(LAS unsigned short*)(yt + (16 * j + 4 * qp + r) * 72 + 2 * (16 + i16)) = f2bf(yb[j][r]);
                    }
                LDSW();
#pragma unroll
                for (int j = 0; j < 4; ++j) {
                    const int row = 16 * j + (lane >> 2), pc = lane & 3;
                    const u32x2 lo = *(const LAS u32x2*)(yt + row * 72 + pc * 16), hi = *(const LAS u32x2*)(yt + row * 72 + pc * 16 + 8);
                    if (DRY == 0) *(u32x4*)(yrow + (size_t)row * D + 8 * pc) = (u32x4){lo.x, lo.y, hi.x, hi.y};
                    else asm volatile("" :: "v"(lo), "v"(hi));
                }
                LDSW();
            }
            yrow += (size_t)64 * D;
            WG_BAR();
        }
        float* o = a.out + O_PWKV + ((((size_t)L * NBATCH + b) * 16 + h) * 64 + 32 * wv + i16) * 64;
#pragma unroll
        for (int kt = 0; kt < 4; ++kt) { if (DRY == 0) { *(f32x4*)(o + 16 * kt + 4 * qp) = SA[kt]; *(f32x4*)(o + 16 * 64 + 16 * kt + 4 * qp) = SB[kt]; } else asm volatile("" :: "v"(SA[kt]), "v"(SB[kt])); }
    }
    __syncthreads();
}
#undef WG_BAR
__device__ __forceinline__ void wkv_sample_chain(const Args& a, int L, int b, int ho, LAS unsigned char* lds) {
    const int tid = threadIdx.x, lane = tid & 63, wv = __builtin_amdgcn_readfirstlane(tid >> 6), i16 = lane & 15, qp = lane >> 4;
    const int h = 8 * ho + wv;
    bf16_t* Y = (bf16_t*)(a.ws + WS_Y);
    LAS unsigned char* slot = lds + wv * CH_SLOT;
    const size_t m0 = (size_t)MP + (size_t)b * DSEQ;
    { SlotRegs S; slot_load(a.ws + WS_CB + ((size_t)N_CH_P + (size_t)b * 16 + h) * CH_SLOT, lane, S); slot_store(slot, lane, S); }
    LDSW();
    for (int vp = 0; vp < 2; ++vp) {
        const size_t so = ((((size_t)L * DBATCH + b) * 16 + h) * 64 + 32 * vp + i16) * 64;
        f32x4 SA[4], SB[4];
#pragma unroll
        for (int kt = 0; kt < 4; ++kt) { SA[kt] = *(const f32x4*)(a.in[7] + so + 16 * kt + 4 * qp); SB[kt] = *(const f32x4*)(a.in[7] + so + 16 * 64 + 16 * kt + 4 * qp); }
        ChainFrag2 F; chain_fetch2(slot, 2 * vp, lane, F);
        f32x4 ya, yb; chain_math2(F, SA, SB, ya, yb);
#pragma unroll
        for (int r = 0; r < 4; ++r) if (4 * qp + r < DSEQ) { Y[(m0 + 4 * qp + r) * D + 64 * h + 32 * vp + i16] = f2bf(ya[r]); Y[(m0 + 4 * qp + r) * D + 64 * h + 32 * vp + 16 + i16] = f2bf(yb[r]); }
#pragma unroll
        for (int kt = 0; kt < 4; ++kt) { *(f32x4*)(a.out + O_SWKV + so + 16 * kt + 4 * qp) = SA[kt]; *(f32x4*)(a.out + O_SWKV + so + 16 * 64 + 16 * kt + 4 * qp) = SB[kt]; }
    }
    __syncthreads();
}

#ifndef PROBE_MIXB
#define PROBE_MIXB 0
#endif
__device__ __forceinline__ void phase_mixb2(const Args& a, int L, LAS unsigned char* lds) {
    constexpr int N_PC = NBATCH * 16;
    const int G = gridDim.x, bx = blockIdx.x;
    const int first_other = (G > 2 * N_PC) ? N_PC : 0;
    for (int it = bx; it < N_PC; it += G) wkv_prompt_chain<0>(a, L, it >> 4, it & 15, lds);
    if (PROBE_MIXB & 1) for (int it = bx; it < N_PC; it += G) wkv_prompt_chain<0>(a, L, it >> 4, it & 15, lds);
    if (PROBE_MIXB & 8) for (int it = bx; it < N_PC; it += G) wkv_prompt_chain<1>(a, L, it >> 4, it & 15, lds);
    if (PROBE_MIXB & 16) for (int it = bx; it < N_PC; it += G) wkv_prompt_chain<2>(a, L, it >> 4, it & 15, lds);
    if (PROBE_MIXB & 32) for (int it = bx; it < N_PC; it += G) wkv_prompt_chain<3>(a, L, it >> 4, it & 15, lds);
    if (bx < first_other) return;
    const int nb = G - first_other, id = bx - first_other;
    constexpr int N_RG2 = M / 64, N_SC = DBATCH * 2;
    phase_state_copies(a, L, first_other);
    if (PROBE_MIXB & 64) phase_state_copies(a, L, first_other);
    prep_weights(a, L, 4, first_other, lds);
    if (L + 1 < DEPTH) prep_weights(a, L + 1, 1 | 2, first_other, lds);
    __syncthreads();
    for (int it = id; it < N_RG2; it += nb) { rglru_unit2<true>(a, L, it, lds); __syncthreads(); }
    if (PROBE_MIXB & 4) for (int it = id; it < N_RG2; it += nb) { rglru_unit2<true>(a, L, it, lds); __syncthreads(); }
    {
        const int second = (N_RG2 > nb) ? N_RG2 - nb : 0;
        const int start = id >= second ? id - second : id + (nb - second);
        for (int it = start; it < N_SC; it += nb) wkv_sample_chain(a, L, it >> 1, it & 1, lds);
        if (PROBE_MIXB & 2) for (int it = start; it < N_SC; it += nb) wkv_sample_chain(a, L, it >> 1, it & 1, lds);
    }
}
#ifndef PROBE_MASK
#define PROBE_MASK 0
#endif
#define PH_IN(k) (lo <= (k) && (k) < hi)
#define RUN_PHASE(po, ...) do { { __VA_ARGS__ } if (((PROBE_MASK >> (po)) & 1) && PH_IN(base + (po))) { xcd_barrier(bar); { __VA_ARGS__ } } } while (0)
#define PH_SYNC(k) do { if (lo < (k) && (k) < hi) xcd_barrier(bar); } while (0)
template <int L> __device__ __forceinline__ void layer_phases(const Args& a, LAS unsigned char* lds, int lo, int hi, const XcdBarrier& bar) {
    unsigned char* ws = a.ws;
    const int G = gridDim.x;
    constexpr int base = PH_L0 + L * PH_PER_LAYER;
    if (L > 0) PH_SYNC(base + PHO_IN);
    RUN_PHASE(PHO_IN, if (PH_IN(base + PHO_IN)) {
        pg8::Gemm g{(const bf16_t*)(ws + WS_XB), (const bf16_t*)(ws + WS_WIN), M, NP, D}; pg8::StaticOrder S; S.init(M, NP, G, (int)blockIdx.x);
        EpiIn E{(bf16_t*)(ws + WS_P), NP, CG / 256};
        pg8::gemm_phase<EpiIn, pg8::StaticOrder, true, true>(lds, g, S, E);
    });
    PH_SYNC(base + PHO_MIXA);
    RUN_PHASE(PHO_MIXA, if (PH_IN(base + PHO_MIXA)) phase_elem_mixa(a, L););
    PH_SYNC(base + PHO_LORA);
    RUN_PHASE(PHO_LORA, if (PH_IN(base + PHO_LORA)) {
        pg8::Gemm g{(const bf16_t*)(ws + WS_ACAT), (const bf16_t*)(ws + WS_WLORA), M, 3072, ACAT_K}; pg8::StaticOrder S; S.init(M, 3072, G, (int)blockIdx.x);
        EpiLora E{(bf16_t*)(ws + WS_WAW), (bf16_t*)(ws + WS_WAA), (bf16_t*)(ws + WS_WAG), a.in[18] + L * D, a.in[20] + L * D};
        pg8::gemm_phase<EpiLora, pg8::StaticOrder, true, true>(lds, g, S, E);
        phase_mixa_units(a, L, lds);
    });
    PH_SYNC(base + PHO_C1);
    RUN_PHASE(PHO_C1, if (PH_IN(base + PHO_C1)) phase_c1(a, L, lds););
    PH_SYNC(base + PHO_MIXB);
    RUN_PHASE(PHO_MIXB, if (PH_IN(base + PHO_MIXB)) phase_mixb2(a, L, lds););
    PH_SYNC(base + PHO_MIXC);
    if (PH_IN(base + PHO_MIXC)) {
#if defined(PROBE_MIXC)
        phase_mixc(a, L, (bf16_t*)(ws + WS_CB)); xcd_barrier(bar);
#endif
        phase_mixc(a, L, (bf16_t*)(ws + WS_OA));
    }
    PH_SYNC(base + PHO_OUT);
    RUN_PHASE(PHO_OUT, if (PH_IN(base + PHO_OUT)) {
        {
            pg8::Gemm g{(const bf16_t*)(ws + WS_MIX), (const bf16_t*)(ws + WS_WOUT), MP, D, D}; pg8::StaticOrder S; S.init(MP, D, G, (int)blockIdx.x);
            if (L == 0) { EpiZ<false> E{a.in[0], (bf16_t*)(ws + WS_Z), D}; pg8::gemm_phase<EpiZ<false>, pg8::StaticOrder, true, true>(lds, g, S, E); }
            else { EpiZ<true> E{ws + WS_XB, (bf16_t*)(ws + WS_Z), D}; pg8::gemm_phase<EpiZ<true>, pg8::StaticOrder, true, true>(lds, g, S, E); }
        }
        {
            pg8::Gemm g{(const bf16_t*)(ws + WS_MIX) + (size_t)MP * D, (const bf16_t*)(ws + WS_WOUTS), MS, 4 * D, 256, D, 256, 4, (size_t)512}; pg8::StaticOrder S; S.init(MS, 4 * D, G, (int)blockIdx.x);
            if (L == 0) { EpiZS<false> E{a.in[1], (float*)(ws + WS_ZS), D}; pg8::gemm_phase<EpiZS<false>, pg8::StaticOrder, true, true>(lds, g, S, E); }
            else { EpiZS<true> E{ws + WS_XB + (size_t)MP * D * 2, (float*)(ws + WS_ZS), D}; pg8::gemm_phase<EpiZS<true>, pg8::StaticOrder, true, true>(lds, g, S, E); }
        }
    });
    PH_SYNC(base + PHO_LN1);
    RUN_PHASE(PHO_LN1, if (PH_IN(base + PHO_LN1)) phase_ln<4>((const bf16_t*)(ws + WS_Z), (const float*)(ws + WS_ZS), a.in[29] + L * D, a.in[30] + L * D, nullptr, (bf16_t*)(ws + WS_X1B)););
    PH_SYNC(base + PHO_GU);
    RUN_PHASE(PHO_GU, if (PH_IN(base + PHO_GU)) {
        pg8::Gemm g{(const bf16_t*)(ws + WS_X1B), (const bf16_t*)(ws + WS_WGU), M, 2 * DFF, D}; pg8::StaticOrder S; S.init(M, 2 * DFF, G, (int)blockIdx.x);
        EpiSwiGLU E{(bf16_t*)(ws + WS_H), DFF};
        pg8::gemm_phase<EpiSwiGLU, pg8::StaticOrder, true, true>(lds, g, S, E);
    });
    PH_SYNC(base + PHO_DOWN);
    RUN_PHASE(PHO_DOWN, if (PH_IN(base + PHO_DOWN)) {
        {
            pg8::Gemm g{(const bf16_t*)(ws + WS_H), (const bf16_t*)(ws + WS_WDN), MP, D, DFF}; pg8::StaticOrder S; S.init(MP, D, G, (int)blockIdx.x);
            EpiZ<true> E{ws + WS_X1B, (bf16_t*)(ws + WS_Z), D};
            pg8::gemm_phase<EpiZ<true>, pg8::StaticOrder, true, true>(lds, g, S, E);
        }
        {
            pg8::Gemm g{(const bf16_t*)(ws + WS_H) + (size_t)MP * DFF, (const bf16_t*)(ws + WS_WDNS), MS, 11 * D, 256, DFF, 256, 4, (size_t)512}; pg8::StaticOrder S; S.init(MS, 11 * D, G, (int)blockIdx.x);
            EpiZS<true> E{ws + WS_X1B + (size_t)MP * D * 2, (float*)(ws + WS_ZS), D};
            pg8::gemm_phase<EpiZS<true>, pg8::StaticOrder, true, true>(lds, g, S, E);
        }
    });
    PH_SYNC(base + PHO_LN2);
    RUN_PHASE(PHO_LN2, if (PH_IN(base + PHO_LN2)) {
        if (L == DEPTH - 1) phase_ln<11>((const bf16_t*)(ws + WS_Z), (const float*)(ws + WS_ZS), a.in[33] + L * D, a.in[34] + L * D, a.out + O_YP, nullptr);
        else { phase_ln<11>((const bf16_t*)(ws + WS_Z), (const float*)(ws + WS_ZS), a.in[33] + L * D, a.in[34] + L * D, nullptr, (bf16_t*)(ws + WS_XB)); prep_weights(a, L + 1, 8, 0, lds); }
    });
}
__global__ void __launch_bounds__(NTHREADS, 2) mega(Args a) {
    extern __shared__ __attribute__((aligned(16))) unsigned char lds_raw[];
    LAS unsigned char* lds = (LAS unsigned char*)lds_raw;
    const int lo = a.ph_lo, hi = a.ph_hi;
    volatile LAS unsigned* bst = (volatile LAS unsigned*)(lds + BAR_LDS_OFF);
    if (threadIdx.x < 4) bst[threadIdx.x] = 0u;
    __syncthreads();
    const XcdBarrier bar = xcd_barrier_post((unsigned*)(a.ws + WS_BAR), bst);
    if (PH_IN(PH_PREP)) { prep_weights(a, 0, 1 | 2 | 8, 0, lds); phase_prep_x(a); }
    if (lo <= PH_PREP && PH_L0 < hi) cg::this_grid().sync();
    layer_phases<0>(a, lds, lo, hi, bar);
    layer_phases<1>(a, lds, lo, hi, bar);
}

static void launch_mega(Args a, int lo, int hi, int grid, hipStream_t s) {
    a.ph_lo = lo; a.ph_hi = hi;
    void* args[] = {&a};
    hipError_t e;
    if (hi - lo > 1) e = hipLaunchCooperativeKernel((void*)mega, dim3(grid), dim3(NTHREADS), args, LDS_BYTES, s);
    else e = hipLaunchKernel((void*)mega, dim3(grid), dim3(NTHREADS), args, LDS_BYTES, s);
    if (e != hipSuccess) fprintf(stderr, "mega launch [%d,%d) failed: %s (grid %d)\n", lo, hi, hipGetErrorString(e), grid);
}

extern "C" void kernel_launch(void* const* d_in, const int* in_sizes, int n_in, void* d_out, int out_size,
                              void* d_ws, size_t ws_size, hipStream_t stream) {
    if (ws_size < WS_END || out_size != (int)O_END || n_in != 35) { fprintf(stderr, "kernel_launch: unexpected sizes ws=%zu out=%d n_in=%d\n", ws_size, out_size, n_in); return; }
    static int grid = 0;
    if (!grid) {
        int dev = 0, cus = 0, per_cu = 0;
        (void)hipGetDevice(&dev);
        (void)hipDeviceGetAttribute(&cus, hipDeviceAttributeMultiprocessorCount, dev);
        (void)hipFuncSetAttribute((const void*)mega, hipFuncAttributeMaxDynamicSharedMemorySize, LDS_BYTES);
        (void)hipOccupancyMaxActiveBlocksPerMultiprocessor(&per_cu, (const void*)mega, NTHREADS, LDS_BYTES);
        if (per_cu < 1) { fprintf(stderr, "occupancy query says %d blocks per CU\n", per_cu); per_cu = 1; }
        grid = cus * per_cu;
    }
    const float* const* in = (const float* const*)d_in;
    unsigned char* ws = (unsigned char*)d_ws;
    float* out = (float*)d_out;
    Args a{};
    for (int i = 0; i < 35; ++i) a.in[i] = in[i];
    a.out = out; a.ws = ws;
    (void)hipMemsetAsync(ws + WS_BAR, 0, 16384, stream);
    launch_mega(a, 0, N_PHASES, grid, stream);
}
```

```cpp
#include <hip/hip_runtime.h>
#include <cstdint>
#include <cstdio>

typedef unsigned short bf16_t;
__device__ __forceinline__ float bf2f(bf16_t v) { return __uint_as_float(((unsigned)v) << 16); }
typedef float f32x2c_t __attribute__((ext_vector_type(2))); typedef __bf16 bf16x2c_t __attribute__((ext_vector_type(2)));
__device__ __forceinline__ bf16_t f2bf(float f) { f32x2c_t v = {f, f}; bf16x2c_t b = __builtin_convertvector(v, bf16x2c_t); return (bf16_t)(__builtin_bit_cast(unsigned, b) & 0xffffu); }
__device__ __forceinline__ float sigmoidf_(float x) { return __builtin_amdgcn_rcpf(1.f + __expf(-x)); }
__device__ __forceinline__ float softplusf_(float x) { return fmaxf(x, 0.f) + log1pf(__expf(-fabsf(x))); }
__device__ __forceinline__ float wave_sum(float v) {
#pragma unroll
    for (int o = 1; o < 64; o <<= 1) v += __shfl_xor(v, o);
    return v;
}

constexpr int D = 1024, MP = 16384, MS = 1024, M = MP + MS, SEQ = 8192, DSEQ = 8, NBATCH = 2, DBATCH = 128, DEPTH = 2;
constexpr int NP = 9216, IN_COLS = 8992;
constexpr int CQ = 0, CK = 1024, CV = 1280, CRNN = 1536, CRW = 2560, CG = 6144;
constexpr int SHIFT_W = 3360, DFF = 2816;
constexpr float ALPHA = 1.4142135623730951f;
constexpr float LN_EPS = 1e-5f, GN_EPS = 64e-5f;

constexpr size_t O_YP = 0, O_YS = 16777216, O_PK = 17825792, O_PV = 17956864, O_PCONV = 18087936, O_PH = 18100224,
                 O_PSHIFT = 18104320, O_PWKV = 18117760, O_SK = 18379904, O_SV = 26768512, O_SCONV = 35157120,
                 O_SH = 35943552, O_SSHIFT = 36205696, O_SWKV = 37065856, O_END = 53843072;


constexpr size_t MiB = 1u << 20;
constexpr size_t WS_CTL = 0;
constexpr size_t WIN_T_BYTES = (size_t)NP * D * 2, WOUT_T_BYTES = (size_t)D * D * 2, WGU_T_BYTES = (size_t)2 * DFF * D * 2, WDN_T_BYTES = (size_t)D * DFF * 2;
constexpr int ACAT_K = 384;
constexpr size_t WLORA_BYTES = (size_t)3072 * ACAT_K * 2;
constexpr size_t WS_WIN = 1 * MiB;
constexpr size_t WS_WOUT = WS_WIN + WIN_T_BYTES;
constexpr size_t WS_WGU = WS_WOUT + WOUT_T_BYTES;
constexpr size_t WS_WDN = WS_WGU + WGU_T_BYTES;
constexpr size_t WS_WOUTS = WS_WDN + WDN_T_BYTES;
constexpr size_t WS_WDNS = WS_WOUTS + WOUT_T_BYTES;
constexpr size_t WS_WLORA = WS_WDNS + WDN_T_BYTES;
constexpr size_t WS_XB = WS_WLORA + WLORA_BYTES;
constexpr size_t WS_OA = WS_XB + (size_t)M * D * 2;
constexpr size_t WS_MIX = WS_OA;
constexpr size_t WS_OB = WS_OA + (size_t)M * D * 2;
constexpr size_t WS_P = WS_OB + (size_t)M * D * 2;
constexpr size_t WS_Z = WS_P;
constexpr size_t WS_ZS = WS_Z + (size_t)M * D * 4;
constexpr size_t WS_X1B = WS_ZS + (size_t)11 * MS * D * 4;
constexpr size_t WS_H = WS_X1B + (size_t)M * D * 2;
constexpr size_t WS_PEND = WS_P + (size_t)M * NP * 2;
constexpr size_t WS_RS = WS_PEND;
constexpr size_t WS_WAW = WS_RS + (size_t)2 * 128 * 1024 * 2 * 4;
constexpr size_t WS_WAA = WS_WAW + (size_t)M * D * 2;
constexpr size_t WS_WAG = WS_WAA + (size_t)M * D * 2;
constexpr size_t WS_Y = WS_WAG + (size_t)M * D * 2;
constexpr size_t WS_BD = WS_Y + (size_t)M * D * 2;
constexpr size_t WS_ACAT = WS_BD + (size_t)M * 16 * 4;
constexpr size_t WS_CB = WS_ACAT;
constexpr size_t WS_END = WS_ACAT + (size_t)M * ACAT_K * 2;
static_assert(WS_END <= (size_t)861000000, "workspace budget (4 x output bytes = 861.5 MB)");
static_assert(WS_H + (size_t)M * DFF * 2 <= WS_PEND, "overlay fits");
static_assert(WS_WAA == WS_WAW + (size_t)M * D * 2 && WS_WAG == WS_WAA + (size_t)M * D * 2, "lora outputs contiguous");
static_assert(WS_XB % 256 == 0 && WS_P % 256 == 0 && WS_WLORA % 256 == 0 && WS_ACAT % 256 == 0, "alignment");
namespace pg8 {
#define PG8_LAS __attribute__((address_space(3)))
typedef unsigned short bf16_t;
typedef short bf16x8 __attribute__((ext_vector_type(8)));
typedef float f32x4 __attribute__((ext_vector_type(4)));
typedef unsigned u32x4 __attribute__((ext_vector_type(4)));
constexpr int BM = 256, BK = 64, HALF = 128, HTB = HALF * BK * 2  , STAGE_BYTES = 8 * HTB, NXCD = 8, WGM = 8;

__host__ __device__ __forceinline__ int lds_byte(int r, int c) { const int st = (r >> 4) * 2 + (c >> 5), rr = r & 15, cc = c & 31, ob = rr * 64 + cc * 2; return st * 1024 + (ob ^ (((ob >> 9) & 1) << 5)); }
__host__ __device__ __forceinline__ void stage_rc(int b, int& R, int& C) { const int st = b / 1024, sb = b % 1024, swz = sb ^ (((sb >> 9) & 1) << 5); R = (st >> 1) * 16 + swz / 64; C = (st & 1) * 32 + (swz % 64) / 2; }
__host__ __device__ __forceinline__ int perm32(int rho) { const int n = rho >> 4, i = rho & 15; return 8 * (i >> 2) + 4 * n + (i & 3); }

struct Unit { int pm, pn; };
struct Gemm { const bf16_t* A; const bf16_t* Bt; int M, N, K; int lda = 0, ldb = 0, nsplit = 0; size_t a_koff = 0; };

struct StaticOrder {
    int nM, nN, nwg, G, c;
    __host__ __device__ void init(int M, int N, int G_, int c_) { nM = M / BM; nN = N / BM; nwg = nM * nN; G = G_; c = c_; }
    __host__ __device__ bool next(int i, Unit& u) const {
        const long L = (long)i * G + c; if (L >= nwg) return false;
        int wgid = (int)L; { const int q = nwg / NXCD, r = nwg % NXCD, xcd = wgid % NXCD, off = wgid / NXCD; wgid = (xcd < r ? xcd * (q + 1) : r * (q + 1) + (xcd - r) * q) + off; }
        const int nig = WGM * nN, gid = wgid / nig, fm = gid * WGM, gsz = (nM - fm) < WGM ? (nM - fm) : WGM;
        u.pm = fm + ((wgid % nig) % gsz); u.pn = (wgid % nig) / gsz; return true;
    }
    __device__ __forceinline__ void a_ready(const Unit&) const {}
    __device__ __forceinline__ void done(const Unit&) const {}
};

__device__ __forceinline__ unsigned cvt_pk_bf16(float lo, float hi) { unsigned r; asm volatile("v_cvt_pk_bf16_f32 %0, %1, %2" : "=v"(r) : "v"(lo), "v"(hi)); return r; }
typedef float f32x2 __attribute__((ext_vector_type(2)));
template <class Epi, class Sched, bool ALIGN_EPI = false, bool SP2 = false>
__device__ __forceinline__ void gemm_phase(PG8_LAS unsigned char* lds, const Gemm g, const Sched& S, const Epi& E) {
    const int tid = threadIdx.x, wid = __builtin_amdgcn_readfirstlane(tid >> 6), lane = tid & 63, wr = wid >> 2, wc = wid & 3, fr = lane & 15, fq = lane >> 4;
    const int K = g.K, nt = K / BK, lda = g.lda ? g.lda : K, ldb = g.ldb ? g.ldb : K;
    unsigned voffA[2], voffB[2];
#pragma unroll
    for (int i = 0; i < 2; ++i) { int R, C; stage_rc(tid * 16 + i * 8192, R, C); const int Rb = Epi::PERM ? ((R & ~31) + perm32(R & 31)) : R;
        voffA[i] = (unsigned)(R * lda + C) * 2u; voffB[i] = (unsigned)(Rb * ldb + C) * 2u; }
    const size_t kstep = (size_t)(BK * 2);
    const size_t hstepA = (size_t)HALF * lda * 2, hstepB = (size_t)HALF * ldb * 2;
    const size_t tstepA = 2 * hstepA, tstepB = 2 * hstepB;
#define PG8_ABASE(u) ((const char*)g.A + (size_t)(u).pm * tstepA + (g.nsplit ? (size_t)((u).pn / g.nsplit) * g.a_koff : (size_t)0))
    const unsigned ldsw = (unsigned)wid * 1024u;
    const int aoff = lds_byte(wr * 64 + fr, fq * 8), boff = lds_byte(wc * 32 + fr, fq * 8);
#define PG8_SA(b, h) (((b) * 2 + (h)) * HTB)
#define PG8_SB(b, h) ((4 + (b) * 2 + (h)) * HTB)
#define PG8_STAGE(bufoff, gbase, voff) do { _Pragma("unroll") for (int _i = 0; _i < 2; ++_i) \
        __builtin_amdgcn_global_load_lds((const unsigned*)((const char*)(gbase) + (voff)[_i]), (PG8_LAS unsigned*)(lds + (bufoff) + ldsw + _i * 8192), 16, 0, 0); } while (0)
#define PG8_LDA(dst, b, h) do { _Pragma("unroll") for (int m = 0; m < 4; ++m) _Pragma("unroll") for (int k = 0; k < 2; ++k) dst[m][k] = *(const PG8_LAS bf16x8*)(lds + PG8_SA(b, h) + aoff + m * 2048 + k * 1024); } while (0)
#define PG8_LDB(dst, b, h) do { _Pragma("unroll") for (int n = 0; n < 2; ++n) _Pragma("unroll") for (int k = 0; k < 2; ++k) dst[n][k] = *(const PG8_LAS bf16x8*)(lds + PG8_SB(b, h) + boff + n * 2048 + k * 1024); } while (0)
#define PG8_MMA(ai, bj, At, Bt) do { __builtin_amdgcn_s_setprio(1); _Pragma("unroll") for (int m = 0; m < 4; ++m) _Pragma("unroll") for (int n = 0; n < 2; ++n) _Pragma("unroll") for (int k = 0; k < 2; ++k) \
        acc[ai][bj][m][n] = __builtin_amdgcn_mfma_f32_16x16x32_bf16(Bt[n][k], At[m][k], acc[ai][bj][m][n], 0, 0, 0); __builtin_amdgcn_s_setprio(0); } while (0)
#define PG8_WAIT_V(n) asm volatile("s_waitcnt vmcnt(" #n ")" ::: "memory")
#define PG8_WAIT_L(n) asm volatile("s_waitcnt lgkmcnt(" #n ")" ::: "memory")
#define PG8_BAR __builtin_amdgcn_s_barrier()
#define PG8_SCHED __builtin_amdgcn_sched_barrier(0)
    Unit cur, nxt; int ui = 0;
    if (!S.next(0, cur)) return;
    f32x4 acc[2][2][4][2];
#pragma unroll
    for (int a = 0; a < 2; ++a)
#pragma unroll
        for (int b = 0; b < 2; ++b)
#pragma unroll
            for (int m = 0; m < 4; ++m)
#pragma unroll
                for (int n = 0; n < 2; ++n) acc[a][b][m][n] = (f32x4){0.f, 0.f, 0.f, 0.f};
    bf16x8 At[4][2], B0[2][2], B1[2][2];
    const char* cA = PG8_ABASE(cur); const char* cB = (const char*)g.Bt + (size_t)cur.pn * tstepB;
    S.a_ready(cur);
    if constexpr (SP2) {
        PG8_STAGE(PG8_SB(0, 0), cB, voffB); PG8_STAGE(PG8_SB(0, 1), cB + hstepB, voffB); PG8_STAGE(PG8_SA(0, 0), cA, voffA); PG8_STAGE(PG8_SA(0, 1), cA + hstepA, voffA);
        if (wr == 1) PG8_BAR;
        PG8_WAIT_V(2); PG8_BAR;
        PG8_STAGE(PG8_SB(1, 0), cB + kstep, voffB); PG8_STAGE(PG8_SA(1, 0), cA + kstep, voffA); PG8_STAGE(PG8_SB(1, 1), cB + hstepB + kstep, voffB);
        PG8_WAIT_V(6); PG8_BAR;
    } else {
        PG8_STAGE(PG8_SB(0, 0), cB, voffB); PG8_STAGE(PG8_SA(0, 0), cA, voffA); PG8_STAGE(PG8_SB(0, 1), cB + hstepB, voffB); PG8_STAGE(PG8_SA(0, 1), cA + hstepA, voffA);
        if (wr == 1) PG8_BAR;
        PG8_WAIT_V(4); PG8_BAR;
        PG8_STAGE(PG8_SB(1, 0), cB + kstep, voffB); PG8_STAGE(PG8_SA(1, 0), cA + kstep, voffA); PG8_STAGE(PG8_SB(1, 1), cB + hstepB + kstep, voffB);
        PG8_WAIT_V(6); PG8_BAR;
    }
    for (;;) {
        const bool has_next = S.next(ui + 1, nxt);
        const char* nA = has_next ? PG8_ABASE(nxt) : cA; const char* nB = has_next ? (const char*)g.Bt + (size_t)nxt.pn * tstepB : cB;
#pragma nounroll
        for (int t = 0; t < nt; t += 2) {
            const bool last = (t == nt - 2);
            const char* a1 = cA + (size_t)(t + 1) * kstep;
            const char* a2 = last ? nA : cA + (size_t)(t + 2) * kstep; const char* b2 = last ? nB : cB + (size_t)(t + 2) * kstep;
            const char* a3 = a2 + kstep; const char* b3 = b2 + kstep;
            if (last && has_next) S.a_ready(nxt);
            if constexpr (SP2) {
            PG8_LDB(B0, 0, 0); PG8_LDB(B1, 0, 1); PG8_SCHED; PG8_LDA(At, 0, 0); PG8_STAGE(PG8_SA(1, 1), a1 + hstepA, voffA);
            PG8_WAIT_V(8); PG8_WAIT_L(0); PG8_BAR; PG8_MMA(0, 0, At, B0); PG8_MMA(0, 1, At, B1); PG8_BAR; PG8_SCHED;
            PG8_LDA(At, 0, 1); PG8_STAGE(PG8_SB(0, 0), b2, voffB); PG8_STAGE(PG8_SB(0, 1), b2 + hstepB, voffB); PG8_STAGE(PG8_SA(0, 0), a2, voffA);
            PG8_WAIT_V(8); PG8_WAIT_L(0); PG8_BAR; PG8_MMA(1, 0, At, B0); PG8_MMA(1, 1, At, B1); PG8_BAR; PG8_SCHED;
            PG8_LDB(B0, 1, 0); PG8_LDB(B1, 1, 1); PG8_SCHED; PG8_LDA(At, 1, 0); PG8_STAGE(PG8_SA(0, 1), a2 + hstepA, voffA);
            PG8_WAIT_V(8); PG8_WAIT_L(0); PG8_BAR; PG8_MMA(0, 0, At, B0); PG8_MMA(0, 1, At, B1); PG8_BAR; PG8_SCHED;
            PG8_LDA(At, 1, 1); PG8_STAGE(PG8_SB(1, 0), b3, voffB); PG8_STAGE(PG8_SB(1, 1), b3 + hstepB, voffB); PG8_STAGE(PG8_SA(1, 0), a3, voffA);
            PG8_WAIT_V(8); PG8_WAIT_L(0); PG8_BAR; PG8_MMA(1, 0, At, B0); PG8_MMA(1, 1, At, B1); PG8_BAR; PG8_SCHED;
            } else {
            PG8_LDB(B0, 0, 0); PG8_SCHED; PG8_LDA(At, 0, 0); PG8_STAGE(PG8_SA(1, 1), a1 + hstepA, voffA);
            PG8_WAIT_L(8); PG8_BAR; PG8_WAIT_L(0); PG8_MMA(0, 0, At, B0); PG8_BAR; PG8_SCHED;
            PG8_LDB(B1, 0, 1); PG8_STAGE(PG8_SB(0, 0), b2, voffB);
            PG8_BAR; PG8_WAIT_L(0); PG8_MMA(0, 1, At, B1); PG8_BAR;
            PG8_LDA(At, 0, 1); PG8_STAGE(PG8_SA(0, 0), a2, voffA);
            PG8_BAR; PG8_WAIT_L(0); PG8_MMA(1, 0, At, B0); PG8_BAR; PG8_SCHED;
            PG8_STAGE(PG8_SB(0, 1), b2 + hstepB, voffB);
            PG8_WAIT_V(6); PG8_BAR; PG8_MMA(1, 1, At, B1); PG8_BAR;
            PG8_LDB(B0, 1, 0); PG8_SCHED; PG8_LDA(At, 1, 0); PG8_STAGE(PG8_SA(0, 1), a2 + hstepA, voffA);
            PG8_WAIT_L(8); PG8_BAR; PG8_WAIT_L(0); PG8_MMA(0, 0, At, B0); PG8_BAR; PG8_SCHED;
            PG8_LDB(B1, 1, 1); PG8_STAGE(PG8_SB(1, 0), b3, voffB);
            PG8_BAR; PG8_WAIT_L(0); PG8_MMA(0, 1, At, B1); PG8_BAR;
            PG8_LDA(At, 1, 1); PG8_STAGE(PG8_SA(1, 0), a3, voffA);
            PG8_BAR; PG8_WAIT_L(0); PG8_MMA(1, 0, At, B0); PG8_BAR; PG8_SCHED;
            PG8_STAGE(PG8_SB(1, 1), b3 + hstepB, voffB);
            PG8_WAIT_V(6); PG8_BAR; PG8_MMA(1, 1, At, B1); PG8_BAR;
            }
        }
        if constexpr (ALIGN_EPI) { if (wr == 0) PG8_BAR; }
        if constexpr (!Epi::AFTER_DRAIN) { E(acc, cur, wr, wc, fr, fq); S.done(cur); }
        if (!has_next) break;
#pragma unroll
        for (int a = 0; a < 2; ++a)
#pragma unroll
            for (int b = 0; b < 2; ++b)
#pragma unroll
                for (int m = 0; m < 4; ++m)
#pragma unroll
                    for (int n = 0; n < 2; ++n) acc[a][b][m][n] = (f32x4){0.f, 0.f, 0.f, 0.f};
        cur = nxt; cA = nA; cB = nB; ++ui;
        if constexpr (ALIGN_EPI) { if (wr == 1) PG8_BAR; }
    }
    PG8_WAIT_V(0);
    if constexpr (!ALIGN_EPI) { if (wr == 0) PG8_BAR; }
    PG8_BAR;
    if constexpr (Epi::AFTER_DRAIN) { E.fused(acc, cur, wr, wc, fr, fq, lds, wid, lane); S.done(cur); }
#undef PG8_ABASE
#undef PG8_SA
#undef PG8_SB
#undef PG8_STAGE
#undef PG8_LDA
#undef PG8_LDB
#undef PG8_MMA
#undef PG8_WAIT_V
#undef PG8_WAIT_L
#undef PG8_BAR
#undef PG8_SCHED
}
}

#include <hip/hip_cooperative_groups.h>
namespace cg = cooperative_groups;
#define LAS __attribute__((address_space(3)))
typedef float f32x4 __attribute__((ext_vector_type(4)));
typedef unsigned u32x4 __attribute__((ext_vector_type(4)));
typedef unsigned u32x2 __attribute__((ext_vector_type(2)));

constexpr int NTHREADS = 512, NWAVES = 8;
constexpr int LDS_PHASE_BYTES = 147456;
constexpr int BAR_LDS_OFF = LDS_PHASE_BYTES;
constexpr int LDS_BYTES = LDS_PHASE_BYTES + 256;
constexpr size_t WS_BAR = WS_CTL + 524288;

constexpr int PH_PREP = 0, PH_PER_LAYER = 11, PH_L0 = 1;
constexpr int PHO_IN = 0, PHO_MIXA = 1, PHO_LORA = 2, PHO_C1 = 3, PHO_MIXB = 4, PHO_MIXC = 5, PHO_OUT = 6, PHO_LN1 = 7, PHO_GU = 8, PHO_DOWN = 9, PHO_LN2 = 10;
constexpr int N_PHASES = PH_L0 + DEPTH * PH_PER_LAYER;

struct Args { const float* in[35]; float* out; unsigned char* ws; int ph_lo, ph_hi; };

#define XB_TMO      128
#define XB_XCNT(j)  (256  + 64 * (j))
#define XB_XSUB(j)  (1280 + 64 * (j))
#define XB_XGEN(j)  (2304 + 64 * (j))
#define XB_TOP      3328
#define XB_TOPGEN   3392
#define XCD_BAR_WORDS 3456
#define XB_SPIN_CAP (1u << 18)

__device__ __forceinline__ unsigned xb_ld(unsigned* p)              { return __hip_atomic_load(p, __ATOMIC_RELAXED, __HIP_MEMORY_SCOPE_AGENT); }
__device__ __forceinline__ unsigned xb_add(unsigned* p, unsigned v) { return __hip_atomic_fetch_add(p, v, __ATOMIC_RELAXED, __HIP_MEMORY_SCOPE_AGENT); }
__device__ __forceinline__ unsigned xb_xcc_id() { return (unsigned)__builtin_amdgcn_s_getreg((3 << 11) | 20) & 0xFu; }
#define XB_SPIN(cond, bar) do { unsigned _sp = 0; while (cond) { __builtin_amdgcn_s_sleep(1); \
    if ((++_sp & 255u) == 0u) { if (xb_ld(&(bar)[XB_TMO])) break; if (_sp > XB_SPIN_CAP) { atomicAdd(&(bar)[XB_TMO], 1u); break; } } } } while (0)

struct XcdBarrier {
    unsigned* bar; unsigned x;
    volatile LAS unsigned* st;
};

__device__ __forceinline__ XcdBarrier xcd_barrier_post(unsigned* bar, volatile LAS unsigned* st) {
    XcdBarrier b; b.bar = bar; b.x = xb_xcc_id(); b.st = st;
    if (threadIdx.x == 0) (void)xb_add(&bar[XB_XCNT(b.x)], 1u);
    return b;
}
__device__ __forceinline__ void xcd_barrier_complete(unsigned* bar, unsigned x, unsigned& nloc, unsigned& nx) {
    const unsigned G = gridDim.x * gridDim.y * gridDim.z;
    unsigned sum, cnt, mine, sp = 0u;
    for (;;) {
        sum = 0u; cnt = 0u; mine = 0u;
#pragma unroll
        for (unsigned j = 0; j < 16; ++j) { const unsigned c = xb_ld(&bar[XB_XCNT(j)]); sum += c; cnt += (c > 0u) ? 1u : 0u; mine = (j == x) ? c : mine; }
        if (sum == G) break;
        __builtin_amdgcn_s_sleep(1);
        if ((++sp & 255u) == 0u) { if (xb_ld(&bar[XB_TMO])) break; if (sp > XB_SPIN_CAP) { atomicAdd(&bar[XB_TMO], 1u); break; } }
    }
    nloc = mine > 0u ? mine : 1u; nx = cnt > 0u ? cnt : 1u;
}

__device__ __forceinline__ void xcd_barrier(const XcdBarrier& b) {
    asm volatile("s_waitcnt vmcnt(0)" ::: "memory");
    __syncthreads();
    if (threadIdx.x == 0) {
        unsigned* bar = b.bar;
        __builtin_amdgcn_s_waitcnt(0);
        unsigned nloc = b.st[0], nx = b.st[1];
        if (nloc == 0u) { xcd_barrier_complete(bar, b.x, nloc, nx); b.st[0] = nloc; b.st[1] = nx; }
        const unsigned old = xb_add(&bar[XB_XSUB(b.x)], 1u);
        const unsigned gen = old / nloc;
        if (old + 1u == (gen + 1u) * nloc) {
            __builtin_amdgcn_fence(__ATOMIC_RELEASE, "agent");
            asm volatile("s_waitcnt vmcnt(0)" ::: "memory");
            const unsigned og = xb_add(&bar[XB_TOP], 1u);
            const unsigned tg = og / nx;
            if (og + 1u == (tg + 1u) * nx) xb_add(&bar[XB_TOPGEN], 1u);
            else XB_SPIN(xb_ld(&bar[XB_TOPGEN]) == tg, bar);
            __builtin_amdgcn_fence(__ATOMIC_ACQUIRE, "agent");
            xb_add(&bar[XB_XGEN(b.x)], 1u);
            asm volatile("s_waitcnt vmcnt(0)" ::: "memory");
        } else {
            XB_SPIN(xb_ld(&bar[XB_XGEN(b.x)]) == gen, bar);
            __builtin_amdgcn_fence(__ATOMIC_ACQUIRE, "agent");
            asm volatile("s_waitcnt vmcnt(0)" ::: "memory");
        }
    }
    __syncthreads();
}


typedef float f32x2_t __attribute__((ext_vector_type(2))); typedef __bf16 bf16x2_t __attribute__((ext_vector_type(2)));
__device__ __forceinline__ unsigned pk2bf(float lo, float hi) { f32x2_t v = {lo, hi}; bf16x2_t b = __builtin_convertvector(v, bf16x2_t); return __builtin_bit_cast(unsigned, b); }

struct EpiIn {
    static constexpr bool PERM = true, AFTER_DRAIN = false;
    bf16_t* O; int ldc; int sig_pn;
    __device__ __forceinline__ void operator()(const f32x4 (&acc)[2][2][4][2], const pg8::Unit& u, int wr, int wc, int fr, int fq) const {
        const int row0 = u.pm * 256 + wr * 64 + fr, col0 = u.pn * 256 + wc * 32 + 8 * fq;
        const bool sg = u.pn >= sig_pn;
#pragma unroll
        for (int ai = 0; ai < 2; ++ai)
#pragma unroll
            for (int m = 0; m < 4; ++m) {
                bf16_t* rowp = O + (size_t)(row0 + ai * 128 + m * 16) * ldc + col0;
#pragma unroll
                for (int bj = 0; bj < 2; ++bj) {
                    f32x4 v0 = acc[ai][bj][m][0], v1 = acc[ai][bj][m][1];
                    if (sg) {
#pragma unroll
                        for (int i = 0; i < 4; ++i) { v0[i] = sigmoidf_(v0[i]); v1[i] = sigmoidf_(v1[i]); }
                    }
                    u32x4 w; w.x = pk2bf(v0[0], v0[1]); w.y = pk2bf(v0[2], v0[3]); w.z = pk2bf(v1[0], v1[1]); w.w = pk2bf(v1[2], v1[3]);
                    *(u32x4*)(rowp + bj * 128) = w;
                }
                asm volatile("" ::: "memory");
            }
    }
};
template <bool RESB> struct EpiZ {
    static constexpr bool PERM = true, AFTER_DRAIN = false;
    const void* res; bf16_t* Z; int ldc;
    __device__ __forceinline__ void operator()(const f32x4 (&acc)[2][2][4][2], const pg8::Unit& u, int wr, int wc, int fr, int fq) const {
        const int col0 = u.pn * 256 + wc * 32 + 8 * fq;
#pragma unroll
        for (int ai = 0; ai < 2; ++ai)
#pragma unroll
            for (int m = 0; m < 4; ++m) {
                const size_t off = (size_t)(u.pm * 256 + ai * 128 + wr * 64 + m * 16 + fr) * ldc + col0;
#pragma unroll
                for (int bj = 0; bj < 2; ++bj) {
                    f32x4 r0, r1;
                    if (RESB) { const u32x4 w = *(const u32x4*)((const bf16_t*)res + off + bj * 128);
                        r0 = (f32x4){__uint_as_float(w.x << 16), __uint_as_float(w.x & 0xffff0000u), __uint_as_float(w.y << 16), __uint_as_float(w.y & 0xffff0000u)};
                        r1 = (f32x4){__uint_as_float(w.z << 16), __uint_as_float(w.z & 0xffff0000u), __uint_as_float(w.w << 16), __uint_as_float(w.w & 0xffff0000u)}; }
                    else { r0 = *(const f32x4*)((const float*)res + off + bj * 128); r1 = *(const f32x4*)((const float*)res + off + bj * 128 + 4); }
                    const f32x4 v0 = r0 * ALPHA + acc[ai][bj][m][0], v1 = r1 * ALPHA + acc[ai][bj][m][1];
                    u32x4 w; w.x = pk2bf(v0[0], v0[1]); w.y = pk2bf(v0[2], v0[3]); w.z = pk2bf(v1[0], v1[1]); w.w = pk2bf(v1[2], v1[3]);
                    *(u32x4*)(Z + off + bj * 128) = w;
                }
                asm volatile("" ::: "memory");
            }
    }
};
template <bool RESB> struct EpiZS {
    static constexpr bool PERM = false, AFTER_DRAIN = false;
    const void* res; float* ZS; int ldc;
    __device__ __forceinline__ void operator()(const f32x4 (&acc)[2][2][4][2], const pg8::Unit& u, int wr, int wc, int fr, int fq) const {
        const int ks = u.pn >> 2, col0 = (u.pn & 3) * 256 + wc * 32 + 4 * fq;
        float* Z = ZS + (size_t)ks * MS * D;
#pragma unroll
        for (int ai = 0; ai < 2; ++ai)
#pragma unroll
            for (int m = 0; m < 4; ++m) {
                const size_t off = (size_t)(u.pm * 256 + ai * 128 + wr * 64 + m * 16 + fr) * ldc + col0;
#pragma unroll
                for (int bj = 0; bj < 2; ++bj)
#pragma unroll
                    for (int n = 0; n < 2; ++n) {
                        f32x4 o = acc[ai][bj][m][n];
                        if (ks == 0) {
                            f32x4 r;
                            if (RESB) { const u32x2 w = *(const u32x2*)((const bf16_t*)res + off + bj * 128 + n * 16);
                                r = (f32x4){__uint_as_float(w.x << 16), __uint_as_float(w.x & 0xffff0000u), __uint_as_float(w.y << 16), __uint_as_float(w.y & 0xffff0000u)}; }
                            else r = *(const f32x4*)((const float*)res + off + bj * 128 + n * 16);
                            o = r * ALPHA + o;
                        }
                        *(f32x4*)(Z + off + bj * 128 + n * 16) = o;
                    }
                asm volatile("" ::: "memory");
            }
    }
};
struct EpiSwiGLU {
    static constexpr bool PERM = true, AFTER_DRAIN = false;
    bf16_t* H; int ldc;
    __device__ __forceinline__ void operator()(const f32x4 (&acc)[2][2][4][2], const pg8::Unit& u, int wr, int wc, int fr, int fq) const {
        const int row0 = u.pm * 256 + wr * 64 + fr, col0 = u.pn * 128 + wc * 32 + 8 * fq;
#pragma unroll
        for (int ai = 0; ai < 2; ++ai)
#pragma unroll
            for (int m = 0; m < 4; ++m) {
                bf16_t* rowp = H + (size_t)(row0 + ai * 128 + m * 16) * ldc + col0;
                float o[8];
#pragma unroll
                for (int n = 0; n < 2; ++n)
#pragma unroll
                    for (int i = 0; i < 4; ++i) { const float g = acc[ai][0][m][n][i], up = acc[ai][1][m][n][i]; o[n * 4 + i] = g * sigmoidf_(g) * up; }
                u32x4 w; w.x = pk2bf(o[0], o[1]); w.y = pk2bf(o[2], o[3]); w.z = pk2bf(o[4], o[5]); w.w = pk2bf(o[6], o[7]);
                *(u32x4*)rowp = w;
                asm volatile("" ::: "memory");
            }
    }
};

template <int MODE> __device__ __forceinline__ int colmap(int n) {
    if (MODE == 0) return n < 5920 ? n : (n < 6144 ? -1 : n - 224);
    if (MODE == 2) { const int pn = n >> 8, q = n & 255; return q < 128 ? pn * 128 + q : DFF + pn * 128 + (q - 128); }
    return n;
}
template <int MODE> __device__ __forceinline__ void transpose_item(const float* __restrict__ W, int K, int ldw, bf16_t* WT, int item, int nblk, LAS float* tile, int tid, bf16_t* WS2 = nullptr, int kpart = 0, int nrows = 0) {
    const int kb = item / nblk, nb = item % nblk, k0 = kb * 64, n0 = nb * 64;
    {
        const int n4 = tid & 15; const int col = colmap<MODE>(n0 + 4 * n4);
#pragma unroll
        for (int i = 0; i < 2; ++i) {
            const int kk = i * 32 + (tid >> 4);
            const f32x4 v = col >= 0 ? *(const f32x4*)(W + (size_t)(k0 + kk) * ldw + col) : (f32x4){0.f, 0.f, 0.f, 0.f};
            LAS float* t = tile + kk * 65 + 4 * n4; t[0] = v[0]; t[1] = v[1]; t[2] = v[2]; t[3] = v[3];
        }
    }
    __syncthreads();
    {
        const int nn = tid >> 3, c = tid & 7; const LAS float* s = tile + (8 * c) * 65 + nn;
        u32x4 o; o.x = pk2bf(s[0], s[65]); o.y = pk2bf(s[2 * 65], s[3 * 65]); o.z = pk2bf(s[4 * 65], s[5 * 65]); o.w = pk2bf(s[6 * 65], s[7 * 65]);
        *(u32x4*)(WT + (size_t)(n0 + nn) * K + k0 + 8 * c) = o;
        if (WS2) { const int ks = k0 / kpart; *(u32x4*)(WS2 + ((size_t)ks * nrows + n0 + nn) * kpart + (k0 - ks * kpart) + 8 * c) = o; }
    }
    __syncthreads();
}
__device__ __forceinline__ void prep_rg_weights(const Args& a, int l);
__device__ __forceinline__ void prep_weights(const Args& a, int l, int what, int first, LAS unsigned char* lds) {
    const int tid = threadIdx.x, G = gridDim.x - first, bx = (int)blockIdx.x - first;
    if (bx < 0) return;
    LAS float* tile = (LAS float*)lds;
    constexpr int I_IN = (D / 64) * (NP / 64), I_OUT = (D / 64) * (D / 64), I_GU = (D / 64) * (2 * DFF / 64), I_DN = (DFF / 64) * (D / 64);
    if (what & 1) for (int r = bx; r < I_IN; r += G) transpose_item<0>(a.in[8] + (size_t)l * D * IN_COLS, D, IN_COLS, (bf16_t*)(a.ws + WS_WIN), r, NP / 64, tile, tid);
    if (what & 4) {
        for (int it = bx; it < I_OUT + I_GU + I_DN; it += G) {
            int r = it;
            if (r < I_OUT) { transpose_item<1>(a.in[28] + (size_t)l * D * D, D, D, (bf16_t*)(a.ws + WS_WOUT), r, D / 64, tile, tid, (bf16_t*)(a.ws + WS_WOUTS), 256, D); continue; } r -= I_OUT;
            if (r < I_GU) { transpose_item<2>(a.in[31] + (size_t)l * D * 2 * DFF, D, 2 * DFF, (bf16_t*)(a.ws + WS_WGU), r, 2 * DFF / 64, tile, tid); continue; } r -= I_GU;
            transpose_item<1>(a.in[32] + (size_t)l * DFF * D, DFF, D, (bf16_t*)(a.ws + WS_WDN), r, D / 64, tile, tid, (bf16_t*)(a.ws + WS_WDNS), 256, D);
        }
    }
    if (what & 2) {
        for (unsigned i = (unsigned)bx * NTHREADS + tid; i < (unsigned)(3072 * ACAT_K); i += (unsigned)G * NTHREADS) {
            const int n = (int)(i / ACAT_K), k = (int)(i % ACAT_K), kind = n >> 10, c = n & 1023;
            float v = 0.f;
            if (kind == 0 && k < 64) v = a.in[19][((size_t)l * 64 + k) * D + c];
            else if (kind == 1 && k >= 64 && k < 128) v = a.in[21][((size_t)l * 64 + (k - 64)) * D + c];
            else if (kind == 2 && k >= 128 && k < 288) v = a.in[22][((size_t)l * 160 + (k - 128)) * D + c];
            ((bf16_t*)(a.ws + WS_WLORA))[i] = f2bf(v);
        }
    }
    if (what & 8) prep_rg_weights(a, l);
}
__device__ __forceinline__ void phase_prep_x(const Args& a) {
    bf16_t* XB = (bf16_t*)(a.ws + WS_XB);
    const size_t n4 = (size_t)M * D / 4, np4 = (size_t)MP * D / 4;
    for (size_t i = (size_t)blockIdx.x * NTHREADS + threadIdx.x; i < n4; i += (size_t)gridDim.x * NTHREADS) {
        const f32x4 v = i < np4 ? ((const f32x4*)a.in[0])[i] : ((const f32x4*)a.in[1])[i - np4];
        u32x2 w; w.x = pk2bf(v[0], v[1]); w.y = pk2bf(v[2], v[3]);
        ((u32x2*)XB)[i] = w;
    }
}

__device__ __forceinline__ float wave_sum_fast(float x) {
    x += __builtin_bit_cast(float, __builtin_amdgcn_update_dpp(0, __builtin_bit_cast(int, x), 0xB1, 0xF, 0xF, true));
    x += __builtin_bit_cast(float, __builtin_amdgcn_update_dpp(0, __builtin_bit_cast(int, x), 0x4E, 0xF, 0xF, true));
    x += __builtin_bit_cast(float, __builtin_amdgcn_update_dpp(0, __builtin_bit_cast(int, x), 0x124, 0xF, 0xF, true));
    x += __builtin_bit_cast(float, __builtin_amdgcn_update_dpp(0, __builtin_bit_cast(int, x), 0x128, 0xF, 0xF, true));
    x += __shfl_xor(x, 16); x += __shfl_xor(x, 32);
    return x;
}
template <int NS> __device__ __forceinline__ void phase_ln(const bf16_t* __restrict__ Z, const float* __restrict__ ZS, const float* __restrict__ g, const float* __restrict__ b, float* OF, bf16_t* OB) {
    const int lane = threadIdx.x & 63, wv = threadIdx.x >> 6;
    f32x4 gv[4], bv[4];
#pragma unroll
    for (int j = 0; j < 4; ++j) { gv[j] = ((const f32x4*)g)[j * 64 + lane]; bv[j] = ((const f32x4*)b)[j * 64 + lane]; }
    const int stride = gridDim.x * NWAVES;
    int m = blockIdx.x * NWAVES + wv;
    f32x4 nx[4];
    auto load_row = [&](int mm) {
        if (mm < MP) {
#pragma unroll
            for (int j = 0; j < 4; ++j) { const u32x2 w = ((const u32x2*)(Z + (size_t)mm * D))[j * 64 + lane];
                nx[j] = (f32x4){__uint_as_float(w.x << 16), __uint_as_float(w.x & 0xffff0000u), __uint_as_float(w.y << 16), __uint_as_float(w.y & 0xffff0000u)}; }
        } else {
#pragma unroll
            for (int j = 0; j < 4; ++j) nx[j] = ((const f32x4*)(ZS + (size_t)(mm - MP) * D))[j * 64 + lane];
#pragma unroll
            for (int ks = 1; ks < NS; ++ks)
#pragma unroll
                for (int j = 0; j < 4; ++j) nx[j] = nx[j] + ((const f32x4*)(ZS + ((size_t)ks * MS + (mm - MP)) * D))[j * 64 + lane];
        }
    };
    if (m < M) load_row(m);
    for (; m < M; m += stride) {
        f32x4 v[4]; float s = 0.f;
#pragma unroll
        for (int j = 0; j < 4; ++j) { v[j] = nx[j]; s += (v[j][0] + v[j][1]) + (v[j][2] + v[j][3]); }
        if (m + stride < M) load_row(m + stride);
        const float mean = wave_sum_fast(s) * (1.f / D);
        float q = 0.f;
#pragma unroll
        for (int j = 0; j < 4; ++j) { v[j] = v[j] - mean; q += (v[j][0] * v[j][0] + v[j][1] * v[j][1]) + (v[j][2] * v[j][2] + v[j][3] * v[j][3]); }
        const float rstd = rsqrtf(wave_sum_fast(q) * (1.f / D) + LN_EPS);
#pragma unroll
        for (int j = 0; j < 4; ++j) {
            const f32x4 y = v[j] * rstd * gv[j] + bv[j];
            if (OF) ((f32x4*)(OF + (size_t)m * D))[j * 64 + lane] = y;
            if (OB) { u32x2 w; w.x = pk2bf(y[0], y[1]); w.y = pk2bf(y[2], y[3]); ((u32x2*)(OB + (size_t)m * D))[j * 64 + lane] = w; }
        }
    }
}


typedef short bf16x8_t __attribute__((ext_vector_type(8)));
typedef short bf16x4_t __attribute__((ext_vector_type(4)));
typedef short v4i16_t __attribute__((ext_vector_type(4)));
#define LDSW() asm volatile("s_waitcnt lgkmcnt(0)" ::: "memory")
__device__ __forceinline__ u32x2 tr_read4(LAS unsigned char* p) { return __builtin_bit_cast(u32x2, __builtin_amdgcn_ds_read_tr16_b64_v4i16((LAS v4i16_t*)p)); }
__device__ __forceinline__ bf16x8_t mk_frag(u32x2 lo, u32x2 hi) { const u32x4 w = (u32x4){lo.x, lo.y, hi.x, hi.y}; return __builtin_bit_cast(bf16x8_t, w); }
__device__ __forceinline__ u32x2 pk4(float a, float b, float c, float d) { u32x2 w; w.x = pk2bf(a, b); w.y = pk2bf(c, d); return w; }

constexpr size_t WS_WRG = WS_CTL + 4096;
constexpr int RG_TP = 144;
__device__ __forceinline__ void prep_rg_weights(const Args& a, int l) {
    const size_t gt = (size_t)blockIdx.x * NTHREADS + threadIdx.x, gs = (size_t)gridDim.x * NTHREADS;
    bf16_t* W = (bf16_t*)(a.ws + WS_WRG);
    for (size_t i = gt; i < (size_t)2 * 16 * 4096; i += gs) {
        const int gate = (int)(i >> 16), bk = (int)(i >> 12) & 15, j = (int)(i >> 6) & 63, ii = (int)i & 63;
        W[i] = f2bf(a.in[gate ? 14 : 12][(size_t)l * 16 * 4096 + ((size_t)bk * 64 + ii) * 64 + j]);
    }
}
__device__ __forceinline__ float one_minus_exp(float x) {
    const float s = -x * (1.f + x * (0.5f + x * (0.16666667f + x * (0.041666668f + x * 0.0083333333f))));
    return x > -0.25f ? s : 1.f - __expf(x);
}
template <bool PASS2>
__device__ __forceinline__ void rglru_unit2(const Args& a, int L, int unit, LAS unsigned char* lds) {
    int lane = threadIdx.x & 63; const int wv = __builtin_amdgcn_readfirstlane(threadIdx.x >> 6);
    asm volatile("" : "+v"(lane));
    const int i16 = lane & 15, qp = lane >> 4;
    const bf16_t* P = (const bf16_t*)(a.ws + WS_P); bf16_t* OB = (bf16_t*)(a.ws + WS_OB); float* RS = (float*)(a.ws + WS_RS);
    const bf16_t* WRG = (const bf16_t*)(a.ws + WS_WRG);
    const float* cw = a.in[10] + (size_t)L * 4 * D; const float* cb = a.in[11] + L * D; const float* ba = a.in[13] + L * D;
    const float* bx = a.in[15] + L * D; const float* lam = a.in[16] + L * D;
    const float* conv0 = a.in[4] + (size_t)L * DBATCH * 3 * D; const float* h0 = a.in[5] + (size_t)L * DBATCH * D;
    LAS unsigned char* tile = lds + wv * (64 * RG_TP);
    LAS unsigned char* obt = lds + (NWAVES + wv) * (64 * RG_TP);
    const int m0 = unit * 64;
    const bool sample = m0 >= MP;
    const int bseq = sample ? 0 : m0 / SEQ, chunk = sample ? 0 : (m0 % SEQ) / 64;
    for (int bb = 0; bb < 2; ++bb) {
        const int bk = 2 * wv + bb, c0 = 64 * bk;
        bf16x8_t af[4][2];
#pragma unroll
        for (int ks = 0; ks < 2; ++ks) {
            const int cc = c0 + 32 * ks + 8 * qp;
            f32x4 w0[2], w1[2], w2[2], w3[2], wb[2];
#pragma unroll
            for (int hh = 0; hh < 2; ++hh) { w0[hh] = *(const f32x4*)(cw + 0 * D + cc + 4 * hh); w1[hh] = *(const f32x4*)(cw + 1 * D + cc + 4 * hh); w2[hh] = *(const f32x4*)(cw + 2 * D + cc + 4 * hh);
                w3[hh] = *(const f32x4*)(cw + 3 * D + cc + 4 * hh); wb[hh] = *(const f32x4*)(cb + cc + 4 * hh); }
#pragma unroll
            for (int mt = 0; mt < 4; ++mt) {
                const int tok = 16 * mt + i16; const size_t m = (size_t)m0 + tok;
                const int tseq = sample ? (tok & 7) : (chunk * 64 + tok);
                float xv[4][8];
#pragma unroll
                for (int k = 0; k < 4; ++k) {
                    const int back = 3 - k;
                    const bool ok = tseq - back >= 0;
                    const u32x4 v = *(const u32x4*)(P + (m - (ok ? back : 0)) * NP + CRNN + cc);
                    const unsigned w4[4] = {v.x, v.y, v.z, v.w};
#pragma unroll
                    for (int e = 0; e < 8; ++e) xv[k][e] = ok ? __uint_as_float((e & 1) ? (w4[e >> 1] & 0xffff0000u) : (w4[e >> 1] << 16)) : 0.f;
                    if (sample && back > 0) {
                        const int b = (int)(m - MP) >> 3; const int ci = ok ? 0 : 3 + tseq - back;
                        const float* cp = conv0 + ((size_t)b * 3 + ci) * D + cc;
                        const f32x4 v0 = *(const f32x4*)cp, v1 = *(const f32x4*)(cp + 4);
#pragma unroll
                        for (int e = 0; e < 4; ++e) { xv[k][e] = ok ? xv[k][e] : v0[e]; xv[k][4 + e] = ok ? xv[k][4 + e] : v1[e]; }
                    }
                }
                float xc[8];
#pragma unroll
                for (int e = 0; e < 8; ++e) xc[e] = wb[e >> 2][e & 3] + w0[e >> 2][e & 3] * xv[0][e] + w1[e >> 2][e & 3] * xv[1][e] + w2[e >> 2][e & 3] * xv[2][e] + w3[e >> 2][e & 3] * xv[3][e];
                const u32x4 pk = (u32x4){pk2bf(xc[0], xc[1]), pk2bf(xc[2], xc[3]), pk2bf(xc[4], xc[5]), pk2bf(xc[6], xc[7])};
                af[mt][ks] = __builtin_bit_cast(bf16x8_t, pk);
                *(LAS u32x4*)(tile + tok * RG_TP + (32 * ks + 8 * qp) * 2) = pk;
            }
        }
        LDSW();
#pragma unroll 1
        for (int nt = 0; nt < 4; ++nt) {
            const int j = 16 * nt + i16, c = c0 + j;
            bf16x8_t ba_[2], bx_[2];
#pragma unroll
            for (int ks = 0; ks < 2; ++ks) { ba_[ks] = *(const bf16x8_t*)(WRG + ((size_t)(0 * 16 + bk) * 64 + j) * 64 + 32 * ks + 8 * qp); bx_[ks] = *(const bf16x8_t*)(WRG + ((size_t)(1 * 16 + bk) * 64 + j) * 64 + 32 * ks + 8 * qp); }
            const float bac = ba[c], bxc = bx[c], spl = softplusf_(-lam[c]);
            float av[4][4], uv[4][4];
#pragma unroll
            for (int mt = 0; mt < 4; ++mt) {
                f32x4 ar = (f32x4){0.f, 0.f, 0.f, 0.f}, ai = ar;
#pragma unroll
                for (int ks = 0; ks < 2; ++ks) { ar = __builtin_amdgcn_mfma_f32_16x16x32_bf16(af[mt][ks], ba_[ks], ar, 0, 0, 0); ai = __builtin_amdgcn_mfma_f32_16x16x32_bf16(af[mt][ks], bx_[ks], ai, 0, 0, 0); }
                const u32x2 xcp = tr_read4(tile + (16 * mt + 4 * qp + (i16 >> 2)) * RG_TP + (16 * nt + 4 * (i16 & 3)) * 2);
#pragma unroll
                for (int r = 0; r < 4; ++r) {
                    const unsigned xw = r < 2 ? xcp.x : xcp.y;
                    const float xcv = __uint_as_float((r & 1) ? (xw & 0xffff0000u) : (xw << 16));
                    const float rg = sigmoidf_(ar[r] + bac), ig = sigmoidf_(ai[r] + bxc);
                    const float log_a = -8.f * rg * spl;
                    av[mt][r] = __expf(log_a);
                    uv[mt][r] = __builtin_amdgcn_sqrtf(one_minus_exp(2.f * log_a)) * (ig * xcv);
                }
            }
            float H = 0.f, Atot = 1.f;
            if (PASS2 && !sample && chunk > 0) H = RS[(((size_t)bseq * 128 + chunk) * D + c) * 2 + 1];
#pragma unroll
            for (int mt = 0; mt < 4; ++mt) {
                const float As = av[mt][0] * av[mt][1] * av[mt][2] * av[mt][3];
                const float Bs = ((uv[mt][0] * av[mt][1] + uv[mt][1]) * av[mt][2] + uv[mt][2]) * av[mt][3] + uv[mt][3];
                float Aq[4], Bq[4];
#pragma unroll
                for (int q = 0; q < 4; ++q) { Aq[q] = __shfl(As, i16 + 16 * q); Bq[q] = __shfl(Bs, i16 + 16 * q); }
                float hs;
                if (!sample) {
                    const float h1 = Aq[0] * H + Bq[0], h2 = Aq[1] * h1 + Bq[1], h3 = Aq[2] * h2 + Bq[2];
                    hs = qp == 0 ? H : (qp == 1 ? h1 : (qp == 2 ? h2 : h3));
                    H = Aq[3] * h3 + Bq[3]; Atot *= Aq[0] * Aq[1] * Aq[2] * Aq[3];
                } else {
                    const int b0 = ((m0 - MP) >> 3) + 2 * mt;
                    const float hA = h0[(size_t)b0 * D + c], hB = h0[(size_t)(b0 + 1) * D + c];
                    const float hA1 = Aq[0] * hA + Bq[0], hB1 = Aq[2] * hB + Bq[2];
                    hs = qp == 0 ? hA : (qp == 1 ? hA1 : (qp == 2 ? hB : hB1));
                    if (PASS2 && qp == 0) {
                        a.out[O_SH + ((size_t)L * DBATCH + b0) * D + c] = Aq[1] * hA1 + Bq[1];
                        a.out[O_SH + ((size_t)L * DBATCH + b0 + 1) * D + c] = Aq[3] * hB1 + Bq[3];
                    }
                }
                if (PASS2) {
                    float h = hs;
#pragma unroll
                    for (int r = 0; r < 4; ++r) { h = av[mt][r] * h + uv[mt][r]; *(LAS unsigned short*)(obt + (16 * mt + 4 * qp + r) * RG_TP + j * 2) = f2bf(h); }
                }
            }
            if (!sample && qp == 0) {
                if (!PASS2) *(float2*)(RS + (((size_t)bseq * 128 + chunk) * D + c) * 2) = make_float2(Atot, H);
                else if (chunk == 127) a.out[O_PH + ((size_t)L * NBATCH + bseq) * D + c] = H;
            }
        }
        LDSW();
        if (PASS2) {
#pragma unroll
            for (int p = 0; p < 8; ++p) {
                const int q = p * 64 + lane, row = q >> 3, pc = q & 7;
                *(u32x4*)(OB + ((size_t)m0 + row) * D + c0 + 8 * pc) = *(const LAS u32x4*)(obt + row * RG_TP + pc * 16);
            }
            LDSW();
        }
    }
    if (PASS2) {
        const int t = threadIdx.x;
        if (sample) {
            for (int i = t; i < 8 * 3 * D; i += NTHREADS) { const int s = i / (3 * D), k = (i / D) % 3, c = i % D; const int b = ((m0 - MP) >> 3) + s;
                a.out[O_SCONV + (((size_t)L * DBATCH + b) * 3 + k) * D + c] = bf2f(P[((size_t)MP + b * DSEQ + 5 + k) * NP + CRNN + c]); }
        } else if (chunk == 127) {
            for (int i = t; i < 3 * D; i += NTHREADS) { const int k = i / D, c = i % D;
                a.out[O_PCONV + (((size_t)L * NBATCH + bseq) * 3 + k) * D + c] = bf2f(P[((size_t)m0 + 61 + k) * NP + CRNN + c]); }
        }
    }
}
__device__ __forceinline__ void rglru_prefix(const Args& a) {
    float* RS = (float*)(a.ws + WS_RS);
    const int gid = blockIdx.x * NTHREADS + threadIdx.x;
    if (gid >= NBATCH * D) return;
    const int b = gid / D, c = gid % D;
    float h = 0.f;
    for (int c0 = 0; c0 < 128; c0 += 16) {
        float2 ab[16];
#pragma unroll
        for (int i = 0; i < 16; ++i) ab[i] = *(const float2*)(RS + (((size_t)b * 128 + c0 + i) * D + c) * 2);
#pragma unroll
        for (int i = 0; i < 16; ++i) { RS[(((size_t)b * 128 + c0 + i) * D + c) * 2 + 1] = h; h = ab[i].x * h + ab[i].y; }
    }
}


constexpr int AT_KPB = 144;
constexpr int AT_VPB = 528;
constexpr int AT_K_OFF = 0, AT_V_OFF = 256 * AT_KPB;
constexpr int AT_LDS = AT_V_OFF + 64 * AT_VPB;

template <bool SAMPLE>
__device__ __forceinline__ void attn_unit(const bf16_t* __restrict__ P, bf16_t* OA, const float* __restrict__ sinks, const float* __restrict__ ck, const float* __restrict__ cv,
                                          int b, int qb, int c, LAS unsigned char* lds) {
    const int tid = threadIdx.x, lane = tid & 63, wv = __builtin_amdgcn_readfirstlane(tid >> 6), i16 = lane & 15, qp = lane >> 4;
    LAS unsigned char* ldsK = lds + AT_K_OFF; LAS unsigned char* ldsV = lds + AT_V_OFF;
    if (!SAMPLE) {
        const size_t row_base = (size_t)b * SEQ + (size_t)(qb - 1) * 128;
#pragma unroll
        for (int it = 0; it < 4; ++it) {
            const int ci = tid + 512 * it, s = ci >> 3, part = ci & 7;
            u32x4 kv = (u32x4){0u, 0u, 0u, 0u}, vv = (u32x4){0u, 0u, 0u, 0u};
            if (qb > 0 || s >= 128) {
                const bf16_t* pr = P + (row_base + s) * NP;
                kv = *(const u32x4*)(pr + CK + 64 * c + 8 * part);
                vv = *(const u32x4*)(pr + CV + 64 * c + 8 * part);
            }
            *(LAS u32x4*)(ldsK + s * AT_KPB + part * 16) = kv;
            const unsigned w4[4] = {vv.x, vv.y, vv.z, vv.w};
#pragma unroll
            for (int e = 0; e < 8; ++e) *(LAS unsigned short*)(ldsV + (8 * part + e) * AT_VPB + 2 * s) = (unsigned short)((w4[e >> 1] >> (16 * (e & 1))) & 0xffffu);
        }
    } else {
        for (int ci = tid; ci < 144 * 16; ci += 512) {
            const int s = ci >> 4, part = ci & 15;
            float kf[4] = {0.f, 0.f, 0.f, 0.f}, vf[4] = {0.f, 0.f, 0.f, 0.f};
            if (s < 128) {
                const f32x4 k4 = *(const f32x4*)(ck + ((size_t)(b * 128 + s) * 4 + c) * 64 + 4 * part);
                const f32x4 v4 = *(const f32x4*)(cv + ((size_t)(b * 128 + s) * 4 + c) * 64 + 4 * part);
#pragma unroll
                for (int e = 0; e < 4; ++e) { kf[e] = k4[e]; vf[e] = v4[e]; }
            } else if (s < 136) {
                const bf16_t* pr = P + (size_t)(MP + b * DSEQ + (s - 128)) * NP;
#pragma unroll
                for (int e = 0; e < 4; ++e) { kf[e] = bf2f(pr[CK + 64 * c + 4 * part + e]); vf[e] = bf2f(pr[CV + 64 * c + 4 * part + e]); }
            }
            u32x2 kw; kw.x = pk2bf(kf[0], kf[1]); kw.y = pk2bf(kf[2], kf[3]);
            *(LAS u32x2*)(ldsK + s * AT_KPB + part * 8) = kw;
#pragma unroll
            for (int e = 0; e < 4; ++e) *(LAS unsigned short*)(ldsV + (4 * part + e) * AT_VPB + 2 * s) = f2bf(vf[e]);
        }
    }
    __syncthreads();
    const int n_mt = SAMPLE ? 1 : 4;
    if (!SAMPLE || wv < 2) {
        for (int mt = 0; mt < n_mt; ++mt) {
            int h, tq, nt0; size_t qrow;
            if (!SAMPLE) { const int g = wv >> 1, qh = wv & 1; h = 4 * c + g; tq = 64 * qh + 16 * mt + i16; nt0 = (64 * qh + 16 * mt) >> 4; qrow = (size_t)b * SEQ + (size_t)qb * 128 + tq; }
            else { const int rho = 16 * wv + i16; h = 4 * c + (rho >> 3); tq = rho & 7; nt0 = 0; qrow = (size_t)MP + b * DSEQ + tq; }
            const float slope = exp2f(-0.5f * (float)(h + 1)), sink = sinks[h];
            bf16x8_t qf[2];
#pragma unroll
            for (int ks = 0; ks < 2; ++ks) qf[ks] = *(const bf16x8_t*)(P + qrow * NP + CQ + 64 * h + 32 * ks + 8 * qp);
            f32x4 sc[9];
#pragma unroll
            for (int jn = 0; jn < 9; ++jn) {
                const int nt = nt0 + jn;
                f32x4 acc = (f32x4){0.f, 0.f, 0.f, 0.f};
                if (SAMPLE || qb > 0 || nt >= 8) {
#pragma unroll
                    for (int ks = 0; ks < 2; ++ks) {
                        const bf16x8_t kfr = *(const LAS bf16x8_t*)(ldsK + (16 * nt + i16) * AT_KPB + (32 * ks + 8 * qp) * 2);
                        acc = __builtin_amdgcn_mfma_f32_16x16x32_bf16(kfr, qf[ks], acc, 0, 0, 0);
                    }
                }
#pragma unroll
                for (int r = 0; r < 4; ++r) {
                    const int sidx = 16 * nt + 4 * qp + r;
                    const int rel = 128 + tq - sidx;
                    bool valid = rel >= 0 && rel < 128;
                    if (!SAMPLE) valid = valid && (qb > 0 || sidx >= 128);
                    acc[r] = valid ? acc[r] * 0.125f - slope * (float)rel : -INFINITY;
                }
                sc[jn] = acc;
            }
            float mx = sink;
#pragma unroll
            for (int jn = 0; jn < 9; ++jn)
#pragma unroll
                for (int r = 0; r < 4; ++r) mx = fmaxf(mx, sc[jn][r]);
            mx = fmaxf(mx, __shfl_xor(mx, 16)); mx = fmaxf(mx, __shfl_xor(mx, 32));
            float sum = 0.f;
#pragma unroll
            for (int jn = 0; jn < 9; ++jn)
#pragma unroll
                for (int r = 0; r < 4; ++r) { const float e = __expf(sc[jn][r] - mx); sc[jn][r] = e; sum += e; }
            sum += __shfl_xor(sum, 16); sum += __shfl_xor(sum, 32);
            const float inv = __builtin_amdgcn_rcpf(sum + __expf(sink - mx));
            bf16x8_t pf[5];
#pragma unroll
            for (int ks = 0; ks < 5; ++ks) {
                u32x4 w;
                w.x = pk2bf(sc[2 * ks][0] * inv, sc[2 * ks][1] * inv); w.y = pk2bf(sc[2 * ks][2] * inv, sc[2 * ks][3] * inv);
                if (ks < 4) { w.z = pk2bf(sc[2 * ks + 1][0] * inv, sc[2 * ks + 1][1] * inv); w.w = pk2bf(sc[2 * ks + 1][2] * inv, sc[2 * ks + 1][3] * inv); }
                else { w.z = 0u; w.w = 0u; }
                pf[ks] = __builtin_bit_cast(bf16x8_t, w);
            }
#pragma unroll
            for (int dt = 0; dt < 4; ++dt) {
                f32x4 o = (f32x4){0.f, 0.f, 0.f, 0.f};
#pragma unroll
                for (int ks = 0; ks < 5; ++ks) {
                    const int ntA = nt0 + 2 * ks, ntB = (ks < 4) ? nt0 + 2 * ks + 1 : nt0 + 2 * ks;
                    const LAS unsigned char* vr = ldsV + (16 * dt + i16) * AT_VPB;
                    const u32x2 lo = *(const LAS u32x2*)(vr + 2 * (16 * ntA + 4 * qp));
                    const u32x2 hi = *(const LAS u32x2*)(vr + 2 * (16 * ntB + 4 * qp));
                    const u32x4 w = (u32x4){lo.x, lo.y, hi.x, hi.y};
                    o = __builtin_amdgcn_mfma_f32_16x16x32_bf16(__builtin_bit_cast(bf16x8_t, w), pf[ks], o, 0, 0, 0);
                }
                u32x2 ow; ow.x = pk2bf(o[0], o[1]); ow.y = pk2bf(o[2], o[3]);
                *(u32x2*)(OA + qrow * D + 64 * h + 16 * dt + 4 * qp) = ow;
            }
        }
    }
    __syncthreads();
}

template <bool PASS2>
__device__ __forceinline__ void rglru_unit(const Args& a, int L, int unit, LAS unsigned char* lds) {
    const int tid = threadIdx.x, lane = tid & 63, wv = __builtin_amdgcn_readfirstlane(tid >> 6);
    const bf16_t* P = (const bf16_t*)(a.ws + WS_P); bf16_t* OB = (bf16_t*)(a.ws + WS_OB); float* RS = (float*)(a.ws + WS_RS);
    const float* cw = a.in[10] + (size_t)L * 4 * D; const float* cb = a.in[11] + L * D; const float* wa = a.in[12] + (size_t)L * 16 * 4096; const float* ba = a.in[13] + L * D;
    const float* wx = a.in[14] + (size_t)L * 16 * 4096; const float* bx = a.in[15] + L * D; const float* lam = a.in[16] + L * D;
    const float* conv0 = a.in[4] + (size_t)L * DBATCH * 3 * D; const float* h0 = a.in[5] + (size_t)L * DBATCH * D;
    LAS float* s_xc = (LAS float*)lds + wv * 64;
    const int m0 = unit * 64;
    const bool sample = m0 >= MP;
    for (int bb = 0; bb < 2; ++bb) {
        const int bk = 2 * wv + bb, c = 64 * bk + lane;
        float war[64], wxr[64];
#pragma unroll
        for (int i = 0; i < 64; ++i) { war[i] = wa[((size_t)bk * 64 + i) * 64 + lane]; wxr[i] = wx[((size_t)bk * 64 + i) * 64 + lane]; }
        const float c0 = cw[0 * D + c], c1 = cw[1 * D + c], c2 = cw[2 * D + c], c3 = cw[3 * D + c], cbc = cb[c], bac = ba[c], bxc = bx[c];
        const float spl = softplusf_(-lam[c]);
        float x1 = 0.f, x2 = 0.f, x3 = 0.f, h = 0.f, Ap = 1.f;
        int bseq = 0, chunk = 0;
        if (!sample) {
            bseq = m0 / SEQ; chunk = (m0 % SEQ) / 64;
            if (chunk > 0) {
                x1 = bf2f(P[(size_t)(m0 - 1) * NP + CRNN + c]); x2 = bf2f(P[(size_t)(m0 - 2) * NP + CRNN + c]); x3 = bf2f(P[(size_t)(m0 - 3) * NP + CRNN + c]);
                if (PASS2) { for (int cc = 0; cc < chunk; ++cc) { const float2 ab = *(const float2*)(RS + (((size_t)bseq * 128 + cc) * D + c) * 2); h = ab.x * h + ab.y; } }
            }
        }
        for (int t = 0; t < 64; ++t) {
            const size_t m = (size_t)m0 + t;
            if (sample && (t & 7) == 0) {
                if (!PASS2) break;
                const int b = (int)(m - MP) >> 3;
                x3 = conv0[((size_t)b * 3 + 0) * D + c]; x2 = conv0[((size_t)b * 3 + 1) * D + c]; x1 = conv0[((size_t)b * 3 + 2) * D + c]; h = h0[(size_t)b * D + c];
            }
            const float x = bf2f(P[m * NP + CRNN + c]);
            const float xc = cbc + c0 * x3 + c1 * x2 + c2 * x1 + c3 * x;
            LDSW(); s_xc[lane] = xc; LDSW();
            float r = bac, ig = bxc;
#pragma unroll
            for (int i4 = 0; i4 < 16; ++i4) { const f32x4 xv = *(const LAS f32x4*)(s_xc + 4 * i4);
#pragma unroll
                for (int e = 0; e < 4; ++e) { r += xv[e] * war[4 * i4 + e]; ig += xv[e] * wxr[4 * i4 + e]; } }
            r = sigmoidf_(r); ig = sigmoidf_(ig);
            const float log_a = -8.f * r * spl;
            const float av = __expf(log_a);
            const float u = sqrtf(-expm1f(2.f * log_a)) * (ig * xc);
            h = av * h + u; Ap *= av;
            if (PASS2) OB[m * D + c] = f2bf(h);
            x3 = x2; x2 = x1; x1 = x;
            if (PASS2 && sample && (t & 7) == 7) {
                const int b = (int)(m - MP) >> 3;
                float* oc = a.out + O_SCONV + ((size_t)L * DBATCH + b) * 3 * D; float* oh = a.out + O_SH + ((size_t)L * DBATCH + b) * D;
                oh[c] = h; oc[0 * D + c] = x3; oc[1 * D + c] = x2; oc[2 * D + c] = x1;
            }
        }
        if (!sample) {
            if (!PASS2) { *(float2*)(RS + (((size_t)bseq * 128 + chunk) * D + c) * 2) = make_float2(Ap, h); }
            else if (chunk == 127) {
                float* oc = a.out + O_PCONV + ((size_t)L * NBATCH + bseq) * 3 * D; float* oh = a.out + O_PH + ((size_t)L * NBATCH + bseq) * D;
                oh[c] = h; oc[0 * D + c] = x3; oc[1 * D + c] = x2; oc[2 * D + c] = x1;
            }
        }
    }
}

__device__ __forceinline__ void phase_elem_mixa(const Args& a, int L) {
    const bf16_t* P = (const bf16_t*)(a.ws + WS_P); bf16_t* AC = (bf16_t*)(a.ws + WS_ACAT);
    const float* mu = a.in[17] + (size_t)L * SHIFT_W; const float* shift0 = a.in[6] + (size_t)L * DBATCH * SHIFT_W;
    const size_t gt = (size_t)blockIdx.x * NTHREADS + threadIdx.x, gs = (size_t)gridDim.x * NTHREADS;
    for (unsigned i = (unsigned)gt; i < (unsigned)(M * ACAT_K); i += (unsigned)gs) {
        const unsigned m = i / ACAT_K; const int j = (int)(i - m * ACAT_K);
        float o = 0.f;
        if (j < 288) {
            const int ch = 3072 + j;
            const float pc = bf2f(P[(size_t)m * NP + CRW + ch]);
            float pv;
            if (m < (unsigned)MP) pv = (m % SEQ) == 0 ? 0.f : bf2f(P[(size_t)(m - 1) * NP + CRW + ch]);
            else pv = ((m - MP) % DSEQ) == 0 ? shift0[(size_t)((m - MP) / DSEQ) * SHIFT_W + ch] : bf2f(P[(size_t)(m - 1) * NP + CRW + ch]);
            const float ps = pc + mu[ch] * (pv - pc);
            o = j < 64 ? 1.f - 2.f * __builtin_amdgcn_rcpf(__expf(2.f * ps) + 1.f) : (j < 128 ? ps : sigmoidf_(ps));
        }
        AC[i] = f2bf(o);
    }
}
__device__ __forceinline__ void phase_state_copies(const Args& a, int L, int first) {
    const bf16_t* P = (const bf16_t*)(a.ws + WS_P);
    if ((int)blockIdx.x < first) return;
    const size_t gt = (size_t)(blockIdx.x - first) * NTHREADS + threadIdx.x, gs = (size_t)(gridDim.x - first) * NTHREADS;
    const float* ck = a.in[2] + (size_t)L * DBATCH * 128 * 256; const float* cv = a.in[3] + (size_t)L * DBATCH * 128 * 256;
    float* pk = a.out + O_PK + (size_t)L * NBATCH * 128 * 256; float* pv_ = a.out + O_PV + (size_t)L * NBATCH * 128 * 256;
    float* pshift = a.out + O_PSHIFT + (size_t)L * NBATCH * SHIFT_W; float* sk = a.out + O_SK + (size_t)L * DBATCH * 128 * 256; float* sv = a.out + O_SV + (size_t)L * DBATCH * 128 * 256;
    float* sshift = a.out + O_SSHIFT + (size_t)L * DBATCH * SHIFT_W;
    const size_t n_pk = (size_t)NBATCH * 128 * 256, n_sk = (size_t)DBATCH * 128 * 256, n_ps = (size_t)NBATCH * SHIFT_W, n_ss = (size_t)DBATCH * SHIFT_W;
    auto ld4 = [&](const bf16_t* p) -> f32x4 { const u32x2 w = *(const u32x2*)p; return (f32x4){__uint_as_float(w.x << 16), __uint_as_float(w.x & 0xffff0000u), __uint_as_float(w.y << 16), __uint_as_float(w.y & 0xffff0000u)}; };
    for (unsigned i4 = (unsigned)gt; i4 < (unsigned)((n_pk + n_sk + n_ps + n_ss) / 4); i4 += (unsigned)gs) {
        const unsigned i = 4 * i4;
        if (i < n_pk) {
            const int b = (int)(i / (128 * 256)), s = (int)((i / 256) % 128), e = (int)(i % 256);
            const size_t row = (size_t)b * SEQ + (SEQ - 128) + s;
            *(f32x4*)(pk + i) = ld4(P + row * NP + CK + e); *(f32x4*)(pv_ + i) = ld4(P + row * NP + CV + e);
            continue;
        }
        unsigned k = i - (unsigned)n_pk;
        if (k < n_sk) {
            const int b = (int)(k / (128 * 256)), s = (int)((k / 256) % 128), e = (int)(k % 256);
            if (s < 120) { *(f32x4*)(sk + k) = *(const f32x4*)(ck + ((size_t)b * 128 + s + 8) * 256 + e); *(f32x4*)(sv + k) = *(const f32x4*)(cv + ((size_t)b * 128 + s + 8) * 256 + e); }
            else { const size_t row = (size_t)MP + b * DSEQ + (s - 120); *(f32x4*)(sk + k) = ld4(P + row * NP + CK + e); *(f32x4*)(sv + k) = ld4(P + row * NP + CV + e); }
            continue;
        }
        k -= (unsigned)n_sk;
        if (k < n_ps) { const int b = (int)(k / SHIFT_W), ch = (int)(k % SHIFT_W); *(f32x4*)(pshift + k) = ld4(P + ((size_t)b * SEQ + SEQ - 1) * NP + CRW + ch); continue; }
        k -= (unsigned)n_ps;
        { const int b = (int)(k / SHIFT_W), ch = (int)(k % SHIFT_W); *(f32x4*)(sshift + k) = ld4(P + ((size_t)MP + b * DSEQ + DSEQ - 1) * NP + CRW + ch); }
    }
}

#ifndef PROBE_MIXA
#define PROBE_MIXA 0
#endif
__device__ __forceinline__ void phase_mixa_units(const Args& a, int L, LAS unsigned char* lds) {
    const bf16_t* P = (const bf16_t*)(a.ws + WS_P); bf16_t* OA = (bf16_t*)(a.ws + WS_OA);
    const float* sinks = a.in[9] + L * 16; const float* ck = a.in[2] + (size_t)L * DBATCH * 128 * 256; const float* cv = a.in[3] + (size_t)L * DBATCH * 128 * 256;
    constexpr int N_RG1 = MP / 64, N_AP = NBATCH * 64 * 4, N_AS = DBATCH * 4;
    for (int it = blockIdx.x; it < N_RG1; it += gridDim.x) { rglru_unit2<false>(a, L, it, lds); __syncthreads(); }
    if (PROBE_MIXA & 2) for (int it = blockIdx.x; it < N_RG1; it += gridDim.x) { rglru_unit2<false>(a, L, it, lds); __syncthreads(); }
    for (int r = blockIdx.x; r < N_AP; r += gridDim.x) { const int c = r & 3, qb = (r >> 2) & 63, b = r >> 8; attn_unit<false>(P, OA, sinks, ck, cv, b, qb, c, lds); }
    if (PROBE_MIXA & 4) for (int r = blockIdx.x; r < N_AP; r += gridDim.x) { const int c = r & 3, qb = (r >> 2) & 63, b = r >> 8; attn_unit<false>(P, OA, sinks, ck, cv, b, qb, c, lds); }
    for (int r = blockIdx.x; r < N_AS; r += gridDim.x) { const int c = r & 3, b = r >> 2; attn_unit<true>(P, OA, sinks, ck, cv, b, 0, c, lds); }
    if (PROBE_MIXA & 8) for (int r = blockIdx.x; r < N_AS; r += gridDim.x) { const int c = r & 3, b = r >> 2; attn_unit<true>(P, OA, sinks, ck, cv, b, 0, c, lds); }
}

struct EpiLora {
    static constexpr bool PERM = true, AFTER_DRAIN = false;
    bf16_t* WAW; bf16_t* WAA; bf16_t* WAG; const float* w0; const float* a0;
    __device__ __forceinline__ void operator()(const f32x4 (&acc)[2][2][4][2], const pg8::Unit& u, int wr, int wc, int fr, int fq) const {
        const int row0 = u.pm * 256 + wr * 64 + fr, kind = u.pn >> 2, colb = (u.pn & 3) * 256 + wc * 32 + 8 * fq;
        const float* bsrc = kind == 0 ? w0 : a0;
        f32x4 bias[2][2];
#pragma unroll
        for (int bj = 0; bj < 2; ++bj)
#pragma unroll
            for (int n = 0; n < 2; ++n) bias[bj][n] = kind == 2 ? (f32x4){0.f, 0.f, 0.f, 0.f} : *(const f32x4*)(bsrc + colb + bj * 128 + 4 * n);
#pragma unroll
        for (int ai = 0; ai < 2; ++ai)
#pragma unroll
            for (int m = 0; m < 4; ++m) {
                const size_t off = (size_t)(row0 + ai * 128 + m * 16) * D + colb;
#pragma unroll
                for (int bj = 0; bj < 2; ++bj) {
                    f32x4 v0 = acc[ai][bj][m][0] + bias[bj][0], v1 = acc[ai][bj][m][1] + bias[bj][1];
                    if (kind == 0) {
#pragma unroll
                        for (int i = 0; i < 4; ++i) {
                            v0[i] = -__expf(-(fmaxf(-v0[i], 0.f) + __logf(1.f + __expf(-fabsf(v0[i])))) - 0.5f);
                            v1[i] = -__expf(-(fmaxf(-v1[i], 0.f) + __logf(1.f + __expf(-fabsf(v1[i])))) - 0.5f);
                        }
                    } else if (kind == 1) {
#pragma unroll
                        for (int i = 0; i < 4; ++i) { v0[i] = sigmoidf_(v0[i]); v1[i] = sigmoidf_(v1[i]); }
                    }
                    u32x4 w; w.x = pk2bf(v0[0], v0[1]); w.y = pk2bf(v0[2], v0[3]); w.z = pk2bf(v1[0], v1[1]); w.w = pk2bf(v1[2], v1[3]);
                    *(u32x4*)(WAW + (size_t)kind * ((size_t)M * D) + off + bj * 128) = w;
                }
                asm volatile("" ::: "memory");
            }
    }
};

__device__ __forceinline__ void phase_mixc(const Args& a, int L, bf16_t* DST) {
    const int lane = threadIdx.x & 63, wv = threadIdx.x >> 6;
    const bf16_t* P = (const bf16_t*)(a.ws + WS_P); const bf16_t* WAG = (const bf16_t*)(a.ws + WS_WAG); const bf16_t* Y = (const bf16_t*)(a.ws + WS_Y); const float* BD = (const float*)(a.ws + WS_BD);
    bf16_t* OA = (bf16_t*)(a.ws + WS_OA); const bf16_t* OB = (const bf16_t*)(a.ws + WS_OB);
    const float* mu = a.in[17] + (size_t)L * SHIFT_W + 2048; const float* shift0 = a.in[6] + (size_t)L * DBATCH * SHIFT_W + 2048;
    const int c0 = 16 * lane, h = lane >> 2;
    float lw[16], lb[16], muv[16];
#pragma unroll
    for (int i = 0; i < 16; ++i) { lw[i] = a.in[26][L * D + c0 + i]; lb[i] = a.in[27][L * D + c0 + i]; muv[i] = mu[c0 + i]; }
    for (int m = blockIdx.x * NWAVES + wv; m < M; m += gridDim.x * NWAVES) {
        float y[16];
        { u32x4 yv[2]; yv[0] = *(const u32x4*)(Y + (size_t)m * D + c0); yv[1] = *(const u32x4*)(Y + (size_t)m * D + c0 + 8);
#pragma unroll
          for (int i = 0; i < 16; ++i) y[i] = __uint_as_float((i & 1) ? (yv[i >> 3][(i >> 1) & 3] & 0xffff0000u) : (yv[i >> 3][(i >> 1) & 3] << 16)); }
        float s = 0.f;
#pragma unroll
        for (int i = 0; i < 16; ++i) s += y[i];
        s += __shfl_xor(s, 1); s += __shfl_xor(s, 2);
        const float mean = s * (1.f / 64.f);
        float q = 0.f;
#pragma unroll
        for (int i = 0; i < 16; ++i) { y[i] -= mean; q += y[i] * y[i]; }
        q += __shfl_xor(q, 1); q += __shfl_xor(q, 2);
        const float rstd = rsqrtf(q * (1.f / 64.f) + GN_EPS);
        const float bd = BD[(size_t)m * 16 + h];
        const bool first = m < MP ? (m % SEQ) == 0 : ((m - MP) % DSEQ) == 0;
        const bf16_t* pr = P + (size_t)m * NP + CRW + 2048 + c0;
#define BFX(v, i) __uint_as_float((((i) & 1) ? ((v)[(i) >> 3][((i) >> 1) & 3] & 0xffff0000u) : ((v)[(i) >> 3][((i) >> 1) & 3] << 16)))
        u32x4 pcv[2], ppv[2], gv[2], gav[2], gbv[2], gcv[2], oav[2], obv[2];
        pcv[0] = *(const u32x4*)pr; pcv[1] = *(const u32x4*)(pr + 8);
        ppv[0] = pcv[0]; ppv[1] = pcv[1];
        if (!first) { ppv[0] = *(const u32x4*)(pr - NP); ppv[1] = *(const u32x4*)(pr - NP + 8); }
        gv[0] = *(const u32x4*)(WAG + (size_t)m * D + c0); gv[1] = *(const u32x4*)(WAG + (size_t)m * D + c0 + 8);
        const bf16_t* pg = P + (size_t)m * NP + CG + c0;
        gav[0] = *(const u32x4*)pg; gav[1] = *(const u32x4*)(pg + 8);
        gbv[0] = *(const u32x4*)(pg + 1024); gbv[1] = *(const u32x4*)(pg + 1024 + 8);
        gcv[0] = *(const u32x4*)(pg + 2048); gcv[1] = *(const u32x4*)(pg + 2048 + 8);
        oav[0] = *(const u32x4*)(OA + (size_t)m * D + c0); oav[1] = *(const u32x4*)(OA + (size_t)m * D + c0 + 8);
        obv[0] = *(const u32x4*)(OB + (size_t)m * D + c0); obv[1] = *(const u32x4*)(OB + (size_t)m * D + c0 + 8);
        float o[16];
#pragma unroll
        for (int i = 0; i < 16; ++i) {
            const float pc = BFX(pcv, i);
            float pv;
            if (first) pv = m < MP ? 0.f : shift0[(size_t)((m - MP) / DSEQ) * SHIFT_W + c0 + i];
            else pv = BFX(ppv, i);
            const float vv = pc + muv[i] * (pv - pc);
            const float yn = y[i] * rstd * lw[i] + lb[i];
            const float oc = (yn + bd * vv) * BFX(gv, i);
            o[i] = BFX(gav, i) * BFX(oav, i) + BFX(gbv, i) * BFX(obv, i) + BFX(gcv, i) * oc;
        }
        u32x4 w0, w1;
        w0.x = pk2bf(o[0], o[1]); w0.y = pk2bf(o[2], o[3]); w0.z = pk2bf(o[4], o[5]); w0.w = pk2bf(o[6], o[7]);
        w1.x = pk2bf(o[8], o[9]); w1.y = pk2bf(o[10], o[11]); w1.z = pk2bf(o[12], o[13]); w1.w = pk2bf(o[14], o[15]);
        *(u32x4*)(DST + (size_t)m * D + c0) = w0; *(u32x4*)(DST + (size_t)m * D + c0 + 8) = w1;
    }
}

constexpr int CH_OFF_AA = 0, CH_OFF_RA = 2048, CH_OFF_MC = 4096, CH_OFF_TL = 5120  , CH_OFF_BT = 5632, CH_OFF_KT = 7808, CH_OFF_VT = 9984, CH_OFF_GM = 12160, CH_SLOT = 12416;
constexpr int CH_TP = 136;
__device__ __forceinline__ float row_prefix16(float x) {
    x += __builtin_bit_cast(float, __builtin_amdgcn_update_dpp(0, __builtin_bit_cast(int, x), 0x111, 0xF, 0xF, true));
    x += __builtin_bit_cast(float, __builtin_amdgcn_update_dpp(0, __builtin_bit_cast(int, x), 0x112, 0xF, 0xF, true));
    x += __builtin_bit_cast(float, __builtin_amdgcn_update_dpp(0, __builtin_bit_cast(int, x), 0x114, 0xF, 0xF, true));
    x += __builtin_bit_cast(float, __builtin_amdgcn_update_dpp(0, __builtin_bit_cast(int, x), 0x118, 0xF, 0xF, true));
    return x;
}
__device__ __forceinline__ f32x4 prod16(const f32x4 xt, const f32x4 y) {
    f32x4 z = (f32x4){0.f, 0.f, 0.f, 0.f};
#pragma unroll
    for (int r = 0; r < 4; ++r) z = __builtin_amdgcn_mfma_f32_16x16x4f32(xt[r], y[r], z, 0, 0, 0);
    return z;
}
__device__ __forceinline__ f32x4 gram(const bf16x8_t (&x)[2], const bf16x8_t (&y)[2]) {
    f32x4 z = (f32x4){0.f, 0.f, 0.f, 0.f};
    z = __builtin_amdgcn_mfma_f32_16x16x32_bf16(x[0], y[0], z, 0, 0, 0);
    z = __builtin_amdgcn_mfma_f32_16x16x32_bf16(x[1], y[1], z, 0, 0, 0);
    return z;
}

struct ChunkRaw { u32x2 cr[4], ck[4], cv[4], a[4], x[4]; };
constexpr int CH_PAR_OFF = 8 * CH_SLOT;
constexpr int CH_PAR_BYTES = 6 * 64 * 4;
__device__ __forceinline__ void stage_head_params(const Args& a, int L, int h, LAS unsigned char* par, int lane) {
    LAS float* p = (LAS float*)par; const int c = 64 * h + lane;
    p[lane] = a.in[17][(size_t)L * SHIFT_W + c]; p[64 + lane] = a.in[17][(size_t)L * SHIFT_W + 1024 + c]; p[128 + lane] = a.in[17][(size_t)L * SHIFT_W + 2048 + c];
    p[192 + lane] = a.in[23][L * D + c]; p[256 + lane] = a.in[24][L * D + c]; p[320 + lane] = a.in[25][L * D + c];
}
__device__ __forceinline__ void chunk_load(const Args& a, size_t m0, int h, int ntok, int lane, ChunkRaw& R) {
    asm volatile("" : "+v"(lane));
    const int i16 = lane & 15, qp = lane >> 4;
    const bf16_t* P = (const bf16_t*)(a.ws + WS_P); const bf16_t* WAW = (const bf16_t*)(a.ws + WS_WAW); const bf16_t* WAA = (const bf16_t*)(a.ws + WS_WAA);
    const size_t m = m0 + (i16 < ntok ? i16 : 0);
#pragma unroll
    for (int r = 0; r < 4; ++r) {
        const int c = 64 * h + 16 * r + 4 * qp;
        const bf16_t* pr = P + m * NP + CRW + c;
        R.cr[r] = *(const u32x2*)pr; R.ck[r] = *(const u32x2*)(pr + 1024); R.cv[r] = *(const u32x2*)(pr + 2048);
        R.x[r] = *(const u32x2*)(WAW + m * D + c);
        R.a[r] = *(const u32x2*)(WAA + m * D + c);
    }
}
__device__ __forceinline__ unsigned dpp_prev_row(unsigned old, unsigned src) { return (unsigned)__builtin_amdgcn_update_dpp((int)old, (int)src, 0x111, 0xF, 0xF, false); }
template <class PF> __device__ __forceinline__ void chunk_compute(const Args& a, const ChunkRaw& R, size_t m0, int h, int ntok, bool seq_start, const float* sh0, const LAS unsigned char* par_, LAS unsigned char* slot, int lane, PF pf) {
    asm volatile("" : "+v"(lane));
    const int i16 = lane & 15, qp = lane >> 4;
    float* BD = (float*)(a.ws + WS_BD);
    const LAS float* par = (const LAS float*)par_;
    const bool valid = i16 < ntok;
    const size_t m = m0 + (valid ? i16 : 0);
    u32x2 p0r[4], p0k[4], p0v[4];
    {
        const bf16_t* P = (const bf16_t*)(a.ws + WS_P);
#pragma unroll
        for (int r = 0; r < 4; ++r) {
            const int c = 64 * h + 16 * r + 4 * qp;
            if (!seq_start) { const bf16_t* pp = P + (m0 - 1) * NP + CRW + c; p0r[r] = *(const u32x2*)pp; p0k[r] = *(const u32x2*)(pp + 1024); p0v[r] = *(const u32x2*)(pp + 2048); }
            else if (sh0) { const f32x4 fr_ = *(const f32x4*)(sh0 + c), fk_ = *(const f32x4*)(sh0 + 1024 + c), fv_ = *(const f32x4*)(sh0 + 2048 + c);
                p0r[r] = pk4(fr_[0], fr_[1], fr_[2], fr_[3]); p0k[r] = pk4(fk_[0], fk_[1], fk_[2], fk_[3]); p0v[r] = pk4(fv_[0], fv_[1], fv_[2], fv_[3]); }
            else { p0r[r] = (u32x2){0u, 0u}; p0k[r] = p0r[r]; p0v[r] = p0r[r]; }
        }
    }
    float abu[16], bbu[16];
    u32x2 pa[4], pb[4], pkk[4], prr[4];
    float ssq = 0.f, bdp = 0.f;
#pragma unroll
    for (int r = 0; r < 4; ++r) {
        const int cb = 16 * r + 4 * qp, c = 64 * h + cb;
        const u32x2 cr = R.cr[r], ck_ = R.ck[r], cv_ = R.cv[r], a4 = R.a[r];
        u32x2 pr_, pk_, pv_;
        pr_.x = dpp_prev_row(p0r[r].x, cr.x); pr_.y = dpp_prev_row(p0r[r].y, cr.y); pk_.x = dpp_prev_row(p0k[r].x, ck_.x); pk_.y = dpp_prev_row(p0k[r].y, ck_.y);
        pv_.x = dpp_prev_row(p0v[r].x, cv_.x); pv_.y = dpp_prev_row(p0v[r].y, cv_.y);
        const u32x2 x4 = R.x[r];
        const f32x4 mur = *(const LAS f32x4*)(par + cb), muk = *(const LAS f32x4*)(par + 64 + cb), muv = *(const LAS f32x4*)(par + 128 + cb);
        const f32x4 kkc = *(const LAS f32x4*)(par + 192 + cb), kac = *(const LAS f32x4*)(par + 256 + cb), rkc = *(const LAS f32x4*)(par + 320 + cb);
        float vv[4], kb[4], rb[4];
#pragma unroll
        for (int i = 0; i < 4; ++i) {
            const unsigned wr_ = i < 2 ? cr.x : cr.y, wk_ = i < 2 ? ck_.x : ck_.y, wv_ = i < 2 ? cv_.x : cv_.y, wa_ = i < 2 ? a4.x : a4.y, wx_ = i < 2 ? x4.x : x4.y;
            const unsigned qr_ = i < 2 ? pr_.x : pr_.y, qk_ = i < 2 ? pk_.x : pk_.y, qv_ = i < 2 ? pv_.x : pv_.y;
            const float c_r = __uint_as_float((i & 1) ? (wr_ & 0xffff0000u) : (wr_ << 16)), c_k = __uint_as_float((i & 1) ? (wk_ & 0xffff0000u) : (wk_ << 16)),
                        c_v = __uint_as_float((i & 1) ? (wv_ & 0xffff0000u) : (wv_ << 16)), a_ = __uint_as_float((i & 1) ? (wa_ & 0xffff0000u) : (wa_ << 16));
            const float p_r = __uint_as_float((i & 1) ? (qr_ & 0xffff0000u) : (qr_ << 16)), p_k = __uint_as_float((i & 1) ? (qk_ & 0xffff0000u) : (qk_ << 16)),
                  p_v = __uint_as_float((i & 1) ? (qv_ & 0xffff0000u) : (qv_ << 16));
            float r_ = c_r + mur[i] * (p_r - c_r), kx = c_k + muk[i] * (p_k - c_k), v_ = c_v + muv[i] * (p_v - c_v);
            float lw_ = __uint_as_float((i & 1) ? (wx_ & 0xffff0000u) : (wx_ << 16));
            if (!valid) { r_ = 0.f; kx = 0.f; v_ = 0.f; lw_ = 0.f; }
            const float kkr = kx * kkc[i];
            const float k2_ = kx * (1.f + (a_ - 1.f) * kac[i]);
            ssq += kkr * kkr; bdp += r_ * k2_ * rkc[i];
            const float g = row_prefix16(lw_);
            const float eg = __expf(g), egx = __expf(g - lw_), eng = __expf(-g);
            const int e = 4 * r + i;
            abu[e] = -kkr * egx; bbu[e] = kkr * a_ * eng; kb[i] = k2_ * eng; rb[i] = r_ * eg; vv[i] = v_;
            if (i16 == 15) *(LAS float*)(slot + CH_OFF_GM + 4 * (cb + i)) = eg;
        }
        const int off = i16 * CH_TP + cb * 2;
        pkk[r] = pk4(kb[0], kb[1], kb[2], kb[3]); prr[r] = pk4(rb[0], rb[1], rb[2], rb[3]);
        *(LAS u32x2*)(slot + CH_OFF_VT + off) = pk4(vv[0], vv[1], vv[2], vv[3]);
        *(LAS u32x2*)(slot + CH_OFF_KT + off) = pkk[r];
        asm volatile("" : "+v"(ssq), "+v"(bdp));
        __builtin_amdgcn_sched_barrier(0);
    }
    __builtin_amdgcn_sched_barrier(0);
    pf();
    __builtin_amdgcn_sched_barrier(0);
    ssq += __shfl_xor(ssq, 16); ssq += __shfl_xor(ssq, 32);
    bdp += __shfl_xor(bdp, 16); bdp += __shfl_xor(bdp, 32);
    if (valid && qp == 0) BD[m * 16 + h] = bdp;
    const float inrm = __builtin_amdgcn_rcpf(fmaxf(__builtin_amdgcn_sqrtf(ssq), 1e-12f));
#pragma unroll
    for (int r = 0; r < 4; ++r) {
        pa[r] = pk4(abu[4 * r] * inrm, abu[4 * r + 1] * inrm, abu[4 * r + 2] * inrm, abu[4 * r + 3] * inrm);
        pb[r] = pk4(bbu[4 * r] * inrm, bbu[4 * r + 1] * inrm, bbu[4 * r + 2] * inrm, bbu[4 * r + 3] * inrm);
        const int off = i16 * CH_TP + (16 * r + 4 * qp) * 2;
        *(LAS u32x2*)(slot + CH_OFF_AA + off) = pa[r];
        *(LAS u32x2*)(slot + CH_OFF_BT + off) = pb[r];
    }
    __builtin_amdgcn_sched_barrier(0);
    bf16x8_t fa[2], fb[2], fk[2], fr[2];
#pragma unroll
    for (int ks = 0; ks < 2; ++ks) { fa[ks] = mk_frag(pa[2 * ks], pa[2 * ks + 1]); fb[ks] = mk_frag(pb[2 * ks], pb[2 * ks + 1]); fk[ks] = mk_frag(pkk[2 * ks], pkk[2 * ks + 1]); fr[ks] = mk_frag(prr[2 * ks], prr[2 * ks + 1]); }
    f32x4 Lc = gram(fa, fb), Nc = gram(fb, fa), Lak = gram(fa, fk), MrbT = gram(fb, fr), MrkT = gram(fk, fr);
#pragma unroll
    for (int r = 0; r < 4; ++r) {
        const int row = 4 * qp + r;
        Lc[r] = row > i16 ? Lc[r] : 0.f;
        Lak[r] = row > i16 ? Lak[r] : 0.f;
        Nc[r] = row < i16 ? Nc[r] : 0.f;
        MrbT[r] = row <= i16 ? MrbT[r] : 0.f;
        MrkT[r] = row <= i16 ? MrkT[r] : 0.f;
    }
    __builtin_amdgcn_sched_barrier(0);
    f32x4 eye;
#pragma unroll
    for (int r = 0; r < 4; ++r) eye[r] = (4 * qp + r == i16) ? 1.f : 0.f;
    const f32x4 L2 = prod16(Nc, Lc), N2 = prod16(Lc, Nc);
    const f32x4 L4 = prod16(N2, L2), N4 = prod16(L2, N2);
    const f32x4 N8 = prod16(L4, N4);
    const f32x4 Q1 = prod16(Lc + eye, N2 + eye), Q1T = prod16(N2 + eye, Lc + eye), Q2 = prod16(L4 + eye, N8 + eye);
    const f32x4 TT = prod16(Q1T, Q2);
    const f32x4 TLk = prod16(Lak, TT);
    __builtin_amdgcn_sched_barrier(0);
    LDSW();
    const bf16x8_t ttf = mk_frag(pk4(TT[0], TT[1], TT[2], TT[3]), (u32x2){0u, 0u});
    f32x4 at[4];
#pragma unroll
    for (int kt = 0; kt < 4; ++kt) {
        const u32x2 ac = tr_read4(slot + CH_OFF_AA + (4 * qp + (i16 >> 2)) * CH_TP + (16 * kt + 4 * (i16 & 3)) * 2);
        at[kt] = __builtin_amdgcn_mfma_f32_16x16x32_bf16(mk_frag(ac, (u32x2){0u, 0u}), ttf, (f32x4){0.f, 0.f, 0.f, 0.f}, 0, 0, 0);
    }
    LDSW();
#pragma unroll
    for (int ks = 0; ks < 2; ++ks) {
        const u32x2 lo = pk4(at[2 * ks][0], at[2 * ks][1], at[2 * ks][2], at[2 * ks][3]), hi = pk4(at[2 * ks + 1][0], at[2 * ks + 1][1], at[2 * ks + 1][2], at[2 * ks + 1][3]);
        *(LAS u32x4*)(slot + CH_OFF_AA + ks * 1024 + lane * 16) = (u32x4){lo.x, lo.y, hi.x, hi.y};
        *(LAS u32x4*)(slot + CH_OFF_RA + ks * 1024 + lane * 16) = __builtin_bit_cast(u32x4, fr[ks]);
    }
    {
        const u32x2 mb = pk4(MrbT[0], MrbT[1], MrbT[2], MrbT[3]), mk = pk4(MrkT[0], MrkT[1], MrkT[2], MrkT[3]), tl = pk4(TLk[0], TLk[1], TLk[2], TLk[3]);
        *(LAS u32x4*)(slot + CH_OFF_MC + lane * 16) = (u32x4){mb.x, mb.y, mk.x, mk.y};
        *(LAS u32x2*)(slot + CH_OFF_TL + lane * 8) = tl;
    }
}

struct ChainFrag { u32x4 aa0, aa1, ra0, ra1, mc, tl; u32x2 vq4, b4[4], k4[4]; f32x4 gm[4]; };
__device__ __forceinline__ void chain_fetch(LAS unsigned char* slot, int vq, int lane, ChainFrag& F) {
    const int i16 = lane & 15, qp = lane >> 4;
    const int troff = (4 * qp + (i16 >> 2)) * CH_TP + 8 * (i16 & 3);
    { const u32x2 t2 = *(const LAS u32x2*)(slot + CH_OFF_TL + lane * 8); F.tl = (u32x4){t2.x, t2.y, 0u, 0u}; }
    F.vq4 = tr_read4(slot + CH_OFF_VT + troff + 32 * vq);
    F.aa0 = *(const LAS u32x4*)(slot + CH_OFF_AA + lane * 16); F.aa1 = *(const LAS u32x4*)(slot + CH_OFF_AA + 1024 + lane * 16);
    F.ra0 = *(const LAS u32x4*)(slot + CH_OFF_RA + lane * 16); F.ra1 = *(const LAS u32x4*)(slot + CH_OFF_RA + 1024 + lane * 16);
    F.mc = *(const LAS u32x4*)(slot + CH_OFF_MC + lane * 16);
#pragma unroll
    for (int kt = 0; kt < 4; ++kt) {
        F.b4[kt] = tr_read4(slot + CH_OFF_BT + troff + 32 * kt); F.k4[kt] = tr_read4(slot + CH_OFF_KT + troff + 32 * kt);
        F.gm[kt] = *(const LAS f32x4*)(slot + CH_OFF_GM + 4 * (16 * kt + 4 * qp));
    }
}
__device__ __forceinline__ f32x4 chain_math(const ChainFrag& F, f32x4 (&ST)[4]) {
    const f32x4 z4 = (f32x4){0.f, 0.f, 0.f, 0.f};
    const f32x4 tlv = __builtin_amdgcn_mfma_f32_16x16x32_bf16(__builtin_bit_cast(bf16x8_t, F.tl), mk_frag(F.vq4, F.vq4), z4, 0, 0, 0);
    bf16x8_t sb[2];
#pragma unroll
    for (int ks = 0; ks < 2; ++ks) sb[ks] = mk_frag(pk4(ST[2 * ks][0], ST[2 * ks][1], ST[2 * ks][2], ST[2 * ks][3]), pk4(ST[2 * ks + 1][0], ST[2 * ks + 1][1], ST[2 * ks + 1][2], ST[2 * ks + 1][3]));
    const f32x4 u1 = __builtin_amdgcn_mfma_f32_16x16x32_bf16(__builtin_bit_cast(bf16x8_t, F.aa0), sb[0], z4, 0, 0, 0);
    const f32x4 u2 = __builtin_amdgcn_mfma_f32_16x16x32_bf16(__builtin_bit_cast(bf16x8_t, F.aa1), sb[1], tlv, 0, 0, 0);
    f32x4 Y = __builtin_amdgcn_mfma_f32_16x16x32_bf16(__builtin_bit_cast(bf16x8_t, F.ra0), sb[0], z4, 0, 0, 0);
    const f32x4 y2 = __builtin_amdgcn_mfma_f32_16x16x32_bf16(__builtin_bit_cast(bf16x8_t, F.ra1), sb[1], z4, 0, 0, 0);
    const f32x4 U = u1 + u2;
    const bf16x8_t uv = mk_frag(pk4(U[0], U[1], U[2], U[3]), F.vq4);
#pragma unroll
    for (int kt = 0; kt < 4; ++kt) {
        ST[kt] = __builtin_amdgcn_mfma_f32_16x16x32_bf16(mk_frag(F.b4[kt], F.k4[kt]), uv, ST[kt], 0, 0, 0);
        ST[kt] = ST[kt] * F.gm[kt];
    }
    Y = __builtin_amdgcn_mfma_f32_16x16x32_bf16(__builtin_bit_cast(bf16x8_t, F.mc), uv, Y, 0, 0, 0);
    return Y + y2;
}
struct ChainFrag2 { u32x4 aa0, aa1, ra0, ra1, mc, tl; u32x2 va, vb, b4[4], k4[4]; f32x4 gm[4]; };
__device__ __forceinline__ void chain_fetch2(LAS unsigned char* slot, int vq0, int lane, ChainFrag2& F) {
    const int i16 = lane & 15, qp = lane >> 4;
    const int troff = (4 * qp + (i16 >> 2)) * CH_TP + 8 * (i16 & 3);
    { const u32x2 t2 = *(const LAS u32x2*)(slot + CH_OFF_TL + lane * 8); F.tl = (u32x4){t2.x, t2.y, 0u, 0u}; }
    F.va = tr_read4(slot + CH_OFF_VT + troff + 32 * vq0); F.vb = tr_read4(slot + CH_OFF_VT + troff + 32 * (vq0 + 1));
    F.aa0 = *(const LAS u32x4*)(slot + CH_OFF_AA + lane * 16); F.aa1 = *(const LAS u32x4*)(slot + CH_OFF_AA + 1024 + lane * 16);
    F.ra0 = *(const LAS u32x4*)(slot + CH_OFF_RA + lane * 16); F.ra1 = *(const LAS u32x4*)(slot + CH_OFF_RA + 1024 + lane * 16);
    F.mc = *(const LAS u32x4*)(slot + CH_OFF_MC + lane * 16);
#pragma unroll
    for (int kt = 0; kt < 4; ++kt) {
        F.b4[kt] = tr_read4(slot + CH_OFF_BT + troff + 32 * kt); F.k4[kt] = tr_read4(slot + CH_OFF_KT + troff + 32 * kt);
        F.gm[kt] = *(const LAS f32x4*)(slot + CH_OFF_GM + 4 * (16 * kt + 4 * qp));
    }
}
__device__ __forceinline__ void chain_math2(const ChainFrag2& F, f32x4 (&SA)[4], f32x4 (&SB)[4], f32x4& YA, f32x4& YB) {
    const f32x4 z4 = (f32x4){0.f, 0.f, 0.f, 0.f};
    const bf16x8_t tl = __builtin_bit_cast(bf16x8_t, F.tl), aa0 = __builtin_bit_cast(bf16x8_t, F.aa0), aa1 = __builtin_bit_cast(bf16x8_t, F.aa1),
                   ra0 = __builtin_bit_cast(bf16x8_t, F.ra0), ra1 = __builtin_bit_cast(bf16x8_t, F.ra1), mc = __builtin_bit_cast(bf16x8_t, F.mc);
    const f32x4 tlva = __builtin_amdgcn_mfma_f32_16x16x32_bf16(tl, mk_frag(F.va, F.va), z4, 0, 0, 0);
    const f32x4 tlvb = __builtin_amdgcn_mfma_f32_16x16x32_bf16(tl, mk_frag(F.vb, F.vb), z4, 0, 0, 0);
    bf16x8_t sa[2], sb[2];
#pragma unroll
    for (int ks = 0; ks < 2; ++ks) {
        sa[ks] = mk_frag(pk4(SA[2 * ks][0], SA[2 * ks][1], SA[2 * ks][2], SA[2 * ks][3]), pk4(SA[2 * ks + 1][0], SA[2 * ks + 1][1], SA[2 * ks + 1][2], SA[2 * ks + 1][3]));
        sb[ks] = mk_frag(pk4(SB[2 * ks][0], SB[2 * ks][1], SB[2 * ks][2], SB[2 * ks][3]), pk4(SB[2 * ks + 1][0], SB[2 * ks + 1][1], SB[2 * ks + 1][2], SB[2 * ks + 1][3]));
    }
    const f32x4 ua1 = __builtin_amdgcn_mfma_f32_16x16x32_bf16(aa0, sa[0], z4, 0, 0, 0);
    const f32x4 ub1 = __builtin_amdgcn_mfma_f32_16x16x32_bf16(aa0, sb[0], z4, 0, 0, 0);
    const f32x4 ua2 = __builtin_amdgcn_mfma_f32_16x16x32_bf16(aa1, sa[1], tlva, 0, 0, 0);
    const f32x4 ub2 = __builtin_amdgcn_mfma_f32_16x16x32_bf16(aa1, sb[1], tlvb, 0, 0, 0);
    f32x4 ya = __builtin_amdgcn_mfma_f32_16x16x32_bf16(ra0, sa[0], z4, 0, 0, 0);
    f32x4 yb = __builtin_amdgcn_mfma_f32_16x16x32_bf16(ra0, sb[0], z4, 0, 0, 0);
    const f32x4 ya2 = __builtin_amdgcn_mfma_f32_16x16x32_bf16(ra1, sa[1], z4, 0, 0, 0);
    const f32x4 yb2 = __builtin_amdgcn_mfma_f32_16x16x32_bf16(ra1, sb[1], z4, 0, 0, 0);
    const f32x4 UA = ua1 + ua2, UB = ub1 + ub2;
    const bf16x8_t uva = mk_frag(pk4(UA[0], UA[1], UA[2], UA[3]), F.va), uvb = mk_frag(pk4(UB[0], UB[1], UB[2], UB[3]), F.vb);
#pragma unroll
    for (int kt = 0; kt < 4; ++kt) {
        const bf16x8_t bk = mk_frag(F.b4[kt], F.k4[kt]);
        SA[kt] = __builtin_amdgcn_mfma_f32_16x16x32_bf16(bk, uva, SA[kt], 0, 0, 0);
        SB[kt] = __builtin_amdgcn_mfma_f32_16x16x32_bf16(bk, uvb, SB[kt], 0, 0, 0);
    }
#pragma unroll
    for (int kt = 0; kt < 4; ++kt) { SA[kt] = SA[kt] * F.gm[kt]; SB[kt] = SB[kt] * F.gm[kt]; }
    ya = __builtin_amdgcn_mfma_f32_16x16x32_bf16(mc, uva, ya, 0, 0, 0);
    yb = __builtin_amdgcn_mfma_f32_16x16x32_bf16(mc, uvb, yb, 0, 0, 0);
    YA = ya + ya2; YB = yb + yb2;
}
__device__ __forceinline__ f32x4 chain_step(LAS unsigned char* slot, f32x4 (&ST)[4], int vq, int lane) { ChainFrag F; chain_fetch(slot, vq, lane, F); return chain_math(F, ST); }

constexpr int N_CH_P = MP / 16 * 16, N_CH_S = DBATCH * 16, N_CH = N_CH_P + N_CH_S;
static_assert(WS_CB + (size_t)N_CH * CH_SLOT <= (size_t)861000000, "chunk buffer fits the workspace");
constexpr int CH_VEC = CH_SLOT / 16;
__device__ __forceinline__ void slot_to_global(const LAS unsigned char* slot, unsigned char* g, int lane) {
#pragma unroll
    for (int i = 0; i < 13; ++i) { const int v = i * 64 + lane; if (v < CH_VEC) *(u32x4*)(g + (size_t)v * 16) = *(const LAS u32x4*)(slot + v * 16); }
}
struct SlotRegs { u32x4 v[13]; };
__device__ __forceinline__ void slot_load(const unsigned char* g, int lane, SlotRegs& S) {
    asm volatile("" : "+v"(lane));
#pragma unroll
    for (int i = 0; i < 13; ++i) { const int v = i * 64 + lane; S.v[i] = *(const u32x4*)(g + (size_t)(v < CH_VEC ? v : 0) * 16); }
}
__device__ __forceinline__ void slot_store(LAS unsigned char* slot, int lane, const SlotRegs& S) {
    asm volatile("" : "+v"(lane));
#pragma unroll
    for (int i = 0; i < 13; ++i) { const int v = i * 64 + lane; if (v < CH_VEC) *(LAS u32x4*)(slot + v * 16) = S.v[i]; }
}
__device__ __forceinline__ void phase_c1(const Args& a, int L, LAS unsigned char* lds) {
    const int tid = threadIdx.x, lane = tid & 63, wv = __builtin_amdgcn_readfirstlane(tid >> 6);
    LAS unsigned char* slot = lds + wv * CH_SLOT; LAS unsigned char* par = lds + CH_PAR_OFF + wv * CH_PAR_BYTES;
    unsigned char* CB = a.ws + WS_CB;
    rglru_prefix(a);
    const int stride = gridDim.x * NWAVES;
    auto item = [&](int ci, size_t& m0, int& ntok, bool& ss, const float*& sh0) {
        sh0 = nullptr;
        if (ci < N_CH_P) { const int chunk = ci >> 4; m0 = (size_t)chunk * 16; ntok = 16; ss = (chunk & (SEQ / 16 - 1)) == 0; }
        else { const int b = (ci - N_CH_P) >> 4; m0 = (size_t)MP + (size_t)b * DSEQ; ntok = DSEQ; ss = true; sh0 = a.in[6] + ((size_t)L * DBATCH + b) * SHIFT_W; }
    };
    auto fetch = [&](int ci, ChunkRaw& R) { size_t m0; int ntok; bool ss; const float* sh0; item(ci, m0, ntok, ss, sh0); chunk_load(a, m0, ci & 15, ntok, lane, R); };
    int ci = blockIdx.x * NWAVES + wv;
    ChunkRaw R;
    if (ci < N_CH) fetch(ci, R);
    for (; ci < N_CH; ci += stride) {
        const int h = ci & 15; size_t m0; int ntok; bool ss; const float* sh0; item(ci, m0, ntok, ss, sh0);
        stage_head_params(a, L, h, par, lane);
        LDSW();
        chunk_compute(a, R, m0, h, ntok, ss, sh0, par, slot, lane, [&]() { if (ci + stride < N_CH) fetch(ci + stride, R); });
        LDSW();
        const size_t sid = ci < N_CH_P ? ((size_t)((ci >> 4) >> 9) * 16 + h) * (SEQ / 16) + ((ci >> 4) & (SEQ / 16 - 1)) : (size_t)ci;
        slot_to_global(slot, CB + sid * CH_SLOT, lane);
        LDSW();
    }
}

#define WG_BAR() do { asm volatile("s_waitcnt lgkmcnt(0)" ::: "memory"); __builtin_amdgcn_s_barrier(); asm volatile("" ::: "memory"); } while (0)
template <int DRY> __device__ __forceinline__ void wkv_prompt_chain(const Args& a, int L, int b, int h, LAS unsigned char* lds) {
    const int tid = threadIdx.x, lane = tid & 63, wv = __builtin_amdgcn_readfirstlane(tid >> 6), i16 = lane & 15, qp = lane >> 4;
    bf16_t* Y = (bf16_t*)(a.ws + WS_Y);
    const unsigned char* CB = a.ws + WS_CB;
    constexpr int NR = SEQ / 64;
    const size_t ci0 = ((size_t)b * 16 + h) * (SEQ / 16);
    if (wv >= 2) {
        const int lw = wv - 2;
        constexpr int GV = 4 * CH_SLOT / 16;
        struct GrpRegs { u32x4 v[9]; };
        auto grp_load = [&](const unsigned char* gsrc, GrpRegs& S) {
#pragma unroll
            for (int i = 0; i < 9; ++i) { const int q = lw * 64 + lane + 384 * i; S.v[i] = *(const u32x4*)(gsrc + (size_t)(q < GV ? q : 0) * 16); }
        };
        auto grp_store = [&](LAS unsigned char* ldst, const GrpRegs& S) {
#pragma unroll
            for (int i = 0; i < 9; ++i) { const int q = lw * 64 + lane + 384 * i; if (q < GV) *(LAS u32x4*)(ldst + q * 16) = S.v[i]; }
        };
        GrpRegs S0, S1, S2, S3;
#define CB_GROUP(k) (CB + (ci0 + (size_t)(4 * (k))) * CH_SLOT)
        grp_load(CB_GROUP(0), S0);
        grp_store(lds, S0);
        grp_load(CB_GROUP(1), S1); grp_load(CB_GROUP(2), S2); grp_load(CB_GROUP(3), S3); grp_load(CB_GROUP(4), S0);
        WG_BAR();
        for (int g = 0; g < NR; g += 4) {
#define LROUND(r, SET) do { __builtin_amdgcn_s_sleep(16);   if (DRY != 2) if ((r) + 1 < NR) grp_store(lds + (((r) + 1) & 1) * 4 * CH_SLOT, SET); if (DRY != 2) if ((r) + 5 < NR) grp_load(CB_GROUP((r) + 5), SET); WG_BAR(); } while (0)
            LROUND(g, S1); LROUND(g + 1, S2); LROUND(g + 2, S3); LROUND(g + 3, S0);
#undef LROUND
        }
#undef CB_GROUP
    } else if (wv < 2) {
        f32x4 SA[4], SB[4];
#pragma unroll
        for (int kt = 0; kt < 4; ++kt) { SA[kt] = (f32x4){0.f, 0.f, 0.f, 0.f}; SB[kt] = SA[kt]; }
        WG_BAR();
        bf16_t* yrow = Y + ((size_t)b * SEQ) * D + 64 * h + 32 * wv;
        for (int g = 0; g < NR; ++g) {
            LAS unsigned char* gs = lds + (g & 1) * 4 * CH_SLOT;
            ChainFrag2 FA, FB;
            f32x4 ya[4], yb[4];
#define SB0() __builtin_amdgcn_sched_barrier(0)
            if (DRY == 3) { WG_BAR(); continue; }
            chain_fetch2(gs, 2 * wv, lane, FA);
            chain_fetch2(gs + CH_SLOT, 2 * wv, lane, FB); SB0();
            chain_math2(FA, SA, SB, ya[0], yb[0]); SB0();
            chain_fetch2(gs + 2 * CH_SLOT, 2 * wv, lane, FA); SB0();
            chain_math2(FB, SA, SB, ya[1], yb[1]); SB0();
            chain_fetch2(gs + 3 * CH_SLOT, 2 * wv, lane, FB); SB0();
            chain_math2(FA, SA, SB, ya[2], yb[2]); SB0();
            chain_math2(FB, SA, SB, ya[3], yb[3]); SB0();
#undef SB0
            {
                LAS unsigned char* yt = lds + CH_PAR_OFF + wv * 4608;
#pragma unroll
                for (int j = 0; j < 4; ++j)
#pragma unroll
                    for (int r = 0; r < 4; ++r) {
                        *(LAS unsigned short*)(yt + (16 * j + 4 * qp + r) * 72 + 2 * i16) = f2bf(ya[j][r]);
                        *(LAS unsigned short*)(yt + (16 * j + 4 * qp + r) * 72 + 2 * (16 + i16)) = f2bf(yb[j][r]);
                    }
                LDSW();
#pragma unroll
                for (int j = 0; j < 4; ++j) {
                    const int row = 16 * j + (lane >> 2), pc = lane & 3;
                    const u32x2 lo = *(const LAS u32x2*)(yt + row * 72 + pc * 16), hi = *(const LAS u32x2*)(yt + row * 72 + pc * 16 + 8);
                    if (DRY == 0) *(u32x4*)(yrow + (size_t)row * D + 8 * pc) = (u32x4){lo.x, lo.y, hi.x, hi.y};
                    else asm volatile("" :: "v"(lo), "v"(hi));
                }
                LDSW();
            }
            yrow += (size_t)64 * D;
            WG_BAR();
        }
        float* o = a.out + O_PWKV + ((((size_t)L * NBATCH + b) * 16 + h) * 64 + 32 * wv + i16) * 64;
#pragma unroll
        for (int kt = 0; kt < 4; ++kt) { if (DRY == 0) { *(f32x4*)(o + 16 * kt + 4 * qp) = SA[kt]; *(f32x4*)(o + 16 * 64 + 16 * kt + 4 * qp) = SB[kt]; } else asm volatile("" :: "v"(SA[kt]), "v"(SB[kt])); }
    }
    __syncthreads();
}
#undef WG_BAR
__device__ __forceinline__ void wkv_sample_chain(const Args& a, int L, int b, int ho, LAS unsigned char* lds) {
    const int tid = threadIdx.x, lane = tid & 63, wv = __builtin_amdgcn_readfirstlane(tid >> 6), i16 = lane & 15, qp = lane >> 4;
    const int h = 8 * ho + wv;
    bf16_t* Y = (bf16_t*)(a.ws + WS_Y);
    LAS unsigned char* slot = lds + wv * CH_SLOT;
    const size_t m0 = (size_t)MP + (size_t)b * DSEQ;
    { SlotRegs S; slot_load(a.ws + WS_CB + ((size_t)N_CH_P + (size_t)b * 16 + h) * CH_SLOT, lane, S); slot_store(slot, lane, S); }
    LDSW();
    for (int vp = 0; vp < 2; ++vp) {
        const size_t so = ((((size_t)L * DBATCH + b) * 16 + h) * 64 + 32 * vp + i16) * 64;
        f32x4 SA[4], SB[4];
#pragma unroll
        for (int kt = 0; kt < 4; ++kt) { SA[kt] = *(const f32x4*)(a.in[7] + so + 16 * kt + 4 * qp); SB[kt] = *(const f32x4*)(a.in[7] + so + 16 * 64 + 16 * kt + 4 * qp); }
        ChainFrag2 F; chain_fetch2(slot, 2 * vp, lane, F);
        f32x4 ya, yb; chain_math2(F, SA, SB, ya, yb);
#pragma unroll
        for (int r = 0; r < 4; ++r) if (4 * qp + r < DSEQ) { Y[(m0 + 4 * qp + r) * D + 64 * h + 32 * vp + i16] = f2bf(ya[r]); Y[(m0 + 4 * qp + r) * D + 64 * h + 32 * vp + 16 + i16] = f2bf(yb[r]); }
#pragma unroll
        for (int kt = 0; kt < 4; ++kt) { *(f32x4*)(a.out + O_SWKV + so + 16 * kt + 4 * qp) = SA[kt]; *(f32x4*)(a.out + O_SWKV + so + 16 * 64 + 16 * kt + 4 * qp) = SB[kt]; }
    }
    __syncthreads();
}

#ifndef PROBE_MIXB
#define PROBE_MIXB 0
#endif
__device__ __forceinline__ void phase_mixb2(const Args& a, int L, LAS unsigned char* lds) {
    constexpr int N_PC = NBATCH * 16;
    const int G = gridDim.x, bx = blockIdx.x;
    const int first_other = (G > 2 * N_PC) ? N_PC : 0;
    for (int it = bx; it < N_PC; it += G) wkv_prompt_chain<0>(a, L, it >> 4, it & 15, lds);
    if (PROBE_MIXB & 1) for (int it = bx; it < N_PC; it += G) wkv_prompt_chain<0>(a, L, it >> 4, it & 15, lds);
    if (PROBE_MIXB & 8) for (int it = bx; it < N_PC; it += G) wkv_prompt_chain<1>(a, L, it >> 4, it & 15, lds);
    if (PROBE_MIXB & 16) for (int it = bx; it < N_PC; it += G) wkv_prompt_chain<2>(a, L, it >> 4, it & 15, lds);
    if (PROBE_MIXB & 32) for (int it = bx; it < N_PC; it += G) wkv_prompt_chain<3>(a, L, it >> 4, it & 15, lds);
    if (bx < first_other) return;
    const int nb = G - first_other, id = bx - first_other;
    constexpr int N_RG2 = M / 64, N_SC = DBATCH * 2;
    phase_state_copies(a, L, first_other);
    if (PROBE_MIXB & 64) phase_state_copies(a, L, first_other);
    prep_weights(a, L, 4, first_other, lds);
    if (L + 1 < DEPTH) prep_weights(a, L + 1, 1 | 2, first_other, lds);
    __syncthreads();
    for (int it = id; it < N_RG2; it += nb) { rglru_unit2<true>(a, L, it, lds); __syncthreads(); }
    if (PROBE_MIXB & 4) for (int it = id; it < N_RG2; it += nb) { rglru_unit2<true>(a, L, it, lds); __syncthreads(); }
    {
        const int second = (N_RG2 > nb) ? N_RG2 - nb : 0;
        const int start = id >= second ? id - second : id + (nb - second);
        for (int it = start; it < N_SC; it += nb) wkv_sample_chain(a, L, it >> 1, it & 1, lds);
        if (PROBE_MIXB & 2) for (int it = start; it < N_SC; it += nb) wkv_sample_chain(a, L, it >> 1, it & 1, lds);
    }
}
#ifndef PROBE_MASK
#define PROBE_MASK 0
#endif
#define PH_IN(k) (lo <= (k) && (k) < hi)
#define RUN_PHASE(po, ...) do { { __VA_ARGS__ } if (((PROBE_MASK >> (po)) & 1) && PH_IN(base + (po))) { xcd_barrier(bar); { __VA_ARGS__ } } } while (0)
#define PH_SYNC(k) do { if (lo < (k) && (k) < hi) xcd_barrier(bar); } while (0)
template <int L> __device__ __forceinline__ void layer_phases(const Args& a, LAS unsigned char* lds, int lo, int hi, const XcdBarrier& bar) {
    unsigned char* ws = a.ws;
    const int G = gridDim.x;
    constexpr int base = PH_L0 + L * PH_PER_LAYER;
    if (L > 0) PH_SYNC(base + PHO_IN);
    RUN_PHASE(PHO_IN, if (PH_IN(base + PHO_IN)) {
        pg8::Gemm g{(const bf16_t*)(ws + WS_XB), (const bf16_t*)(ws + WS_WIN), M, NP, D}; pg8::StaticOrder S; S.init(M, NP, G, (int)blockIdx.x);
        EpiIn E{(bf16_t*)(ws + WS_P), NP, CG / 256};
        pg8::gemm_phase<EpiIn, pg8::StaticOrder, true, true>(lds, g, S, E);
    });
    PH_SYNC(base + PHO_MIXA);
    RUN_PHASE(PHO_MIXA, if (PH_IN(base + PHO_MIXA)) phase_elem_mixa(a, L););
    PH_SYNC(base + PHO_LORA);
    RUN_PHASE(PHO_LORA, if (PH_IN(base + PHO_LORA)) {
        pg8::Gemm g{(const bf16_t*)(ws + WS_ACAT), (const bf16_t*)(ws + WS_WLORA), M, 3072, ACAT_K}; pg8::StaticOrder S; S.init(M, 3072, G, (int)blockIdx.x);
        EpiLora E{(bf16_t*)(ws + WS_WAW), (bf16_t*)(ws + WS_WAA), (bf16_t*)(ws + WS_WAG), a.in[18] + L * D, a.in[20] + L * D};
        pg8::gemm_phase<EpiLora, pg8::StaticOrder, true, true>(lds, g, S, E);
        phase_mixa_units(a, L, lds);
    });
    PH_SYNC(base + PHO_C1);
    RUN_PHASE(PHO_C1, if (PH_IN(base + PHO_C1)) phase_c1(a, L, lds););
    PH_SYNC(base + PHO_MIXB);
    RUN_PHASE(PHO_MIXB, if (PH_IN(base + PHO_MIXB)) phase_mixb2(a, L, lds););
    PH_SYNC(base + PHO_MIXC);
    if (PH_IN(base + PHO_MIXC)) {
#if defined(PROBE_MIXC)
        phase_mixc(a, L, (bf16_t*)(ws + WS_CB)); xcd_barrier(bar);
#endif
        phase_mixc(a, L, (bf16_t*)(ws + WS_OA));
    }
    PH_SYNC(base + PHO_OUT);
    RUN_PHASE(PHO_OUT, if (PH_IN(base + PHO_OUT)) {
        {
            pg8::Gemm g{(const bf16_t*)(ws + WS_MIX), (const bf16_t*)(ws + WS_WOUT), MP, D, D}; pg8::StaticOrder S; S.init(MP, D, G, (int)blockIdx.x);
            if (L == 0) { EpiZ<false> E{a.in[0], (bf16_t*)(ws + WS_Z), D}; pg8::gemm_phase<EpiZ<false>, pg8::StaticOrder, true, true>(lds, g, S, E); }
            else { EpiZ<true> E{ws + WS_XB, (bf16_t*)(ws + WS_Z), D}; pg8::gemm_phase<EpiZ<true>, pg8::StaticOrder, true, true>(lds, g, S, E); }
        }
        {
            pg8::Gemm g{(const bf16_t*)(ws + WS_MIX) + (size_t)MP * D, (const bf16_t*)(ws + WS_WOUTS), MS, 4 * D, 256, D, 256, 4, (size_t)512}; pg8::StaticOrder S; S.init(MS, 4 * D, G, (int)blockIdx.x);
            if (L == 0) { EpiZS<false> E{a.in[1], (float*)(ws + WS_ZS), D}; pg8::gemm_phase<EpiZS<false>, pg8::StaticOrder, true, true>(lds, g, S, E); }
            else { EpiZS<true> E{ws + WS_XB + (size_t)MP * D * 2, (float*)(ws + WS_ZS), D}; pg8::gemm_phase<EpiZS<true>, pg8::StaticOrder, true, true>(lds, g, S, E); }
        }
    });
    PH_SYNC(base + PHO_LN1);
    RUN_PHASE(PHO_LN1, if (PH_IN(base + PHO_LN1)) phase_ln<4>((const bf16_t*)(ws + WS_Z), (const float*)(ws + WS_ZS), a.in[29] + L * D, a.in[30] + L * D, nullptr, (bf16_t*)(ws + WS_X1B)););
    PH_SYNC(base + PHO_GU);
    RUN_PHASE(PHO_GU, if (PH_IN(base + PHO_GU)) {
        pg8::Gemm g{(const bf16_t*)(ws + WS_X1B), (const bf16_t*)(ws + WS_WGU), M, 2 * DFF, D}; pg8::StaticOrder S; S.init(M, 2 * DFF, G, (int)blockIdx.x);
        EpiSwiGLU E{(bf16_t*)(ws + WS_H), DFF};
        pg8::gemm_phase<EpiSwiGLU, pg8::StaticOrder, true, true>(lds, g, S, E);
    });
    PH_SYNC(base + PHO_DOWN);
    RUN_PHASE(PHO_DOWN, if (PH_IN(base + PHO_DOWN)) {
        {
            pg8::Gemm g{(const bf16_t*)(ws + WS_H), (const bf16_t*)(ws + WS_WDN), MP, D, DFF}; pg8::StaticOrder S; S.init(MP, D, G, (int)blockIdx.x);
            EpiZ<true> E{ws + WS_X1B, (bf16_t*)(ws + WS_Z), D};
            pg8::gemm_phase<EpiZ<true>, pg8::StaticOrder, true, true>(lds, g, S, E);
        }
        {
            pg8::Gemm g{(const bf16_t*)(ws + WS_H) + (size_t)MP * DFF, (const bf16_t*)(ws + WS_WDNS), MS, 11 * D, 256, DFF, 256, 4, (size_t)512}; pg8::StaticOrder S; S.init(MS, 11 * D, G, (int)blockIdx.x);
            EpiZS<true> E{ws + WS_X1B + (size_t)MP * D * 2, (float*)(ws + WS_ZS), D};
            pg8::gemm_phase<EpiZS<true>, pg8::StaticOrder, true, true>(lds, g, S, E);
        }
    });
    PH_SYNC(base + PHO_LN2);
    RUN_PHASE(PHO_LN2, if (PH_IN(base + PHO_LN2)) {
        if (L == DEPTH - 1) phase_ln<11>((const bf16_t*)(ws + WS_Z), (const float*)(ws + WS_ZS), a.in[33] + L * D, a.in[34] + L * D, a.out + O_YP, nullptr);
        else { phase_ln<11>((const bf16_t*)(ws + WS_Z), (const float*)(ws + WS_ZS), a.in[33] + L * D, a.in[34] + L * D, nullptr, (bf16_t*)(ws + WS_XB)); prep_weights(a, L + 1, 8, 0, lds); }
    });
}
__global__ void __launch_bounds__(NTHREADS, 2) mega(Args a) {
    extern __shared__ __attribute__((aligned(16))) unsigned char lds_raw[];
    LAS unsigned char* lds = (LAS unsigned char*)lds_raw;
    const int lo = a.ph_lo, hi = a.ph_hi;
    volatile LAS unsigned* bst = (volatile LAS unsigned*)(lds + BAR_LDS_OFF);
    if (threadIdx.x < 4) bst[threadIdx.x] = 0u;
    __syncthreads();
    const XcdBarrier bar = xcd_barrier_post((unsigned*)(a.ws + WS_BAR), bst);
    if (PH_IN(PH_PREP)) { prep_weights(a, 0, 1 | 2 | 8, 0, lds); phase_prep_x(a); }
    if (lo <= PH_PREP && PH_L0 < hi) xcd_barrier(bar);
    layer_phases<0>(a, lds, lo, hi, bar);
    layer_phases<1>(a, lds, lo, hi, bar);
}

static void launch_mega(Args a, int lo, int hi, int grid, hipStream_t s) {
    a.ph_lo = lo; a.ph_hi = hi;
    void* args[] = {&a};
    hipError_t e;
    if (hi - lo > 1) e = hipLaunchCooperativeKernel((void*)mega, dim3(grid), dim3(NTHREADS), args, LDS_BYTES, s);
    else e = hipLaunchKernel((void*)mega, dim3(grid), dim3(NTHREADS), args, LDS_BYTES, s);
    if (e != hipSuccess) fprintf(stderr, "mega launch [%d,%d) failed: %s (grid %d)\n", lo, hi, hipGetErrorString(e), grid);
}

extern "C" void kernel_launch(void* const* d_in, const int* in_sizes, int n_in, void* d_out, int out_size,
                              void* d_ws, size_t ws_size, hipStream_t stream) {
    if (ws_size < WS_END || out_size != (int)O_END || n_in != 35) { fprintf(stderr, "kernel_launch: unexpected sizes ws=%zu out=%d n_in=%d\n", ws_size, out_size, n_in); return; }
    static int grid = 0;
    if (!grid) {
        int dev = 0, cus = 0, per_cu = 0;
        (void)hipGetDevice(&dev);
        (void)hipDeviceGetAttribute(&cus, hipDeviceAttributeMultiprocessorCount, dev);
        (void)hipFuncSetAttribute((const void*)mega, hipFuncAttributeMaxDynamicSharedMemorySize, LDS_BYTES);
        (void)hipOccupancyMaxActiveBlocksPerMultiprocessor(&per_cu, (const void*)mega, NTHREADS, LDS_BYTES);
        if (per_cu < 1) { fprintf(stderr, "occupancy query says %d blocks per CU\n", per_cu); per_cu = 1; }
        grid = cus * per_cu;
    }
    const float* const* in = (const float* const*)d_in;
    unsigned char* ws = (unsigned char*)d_ws;
    float* out = (float*)d_out;
    Args a{};
    for (int i = 0; i < 35; ++i) a.in[i] = in[i];
    a.out = out; a.ws = ws;
    (void)hipMemsetAsync(ws + WS_BAR, 0, 16384, stream);
    launch_mega(a, 0, N_PHASES, grid, stream);
}
```
